# Optimizing an MI355X kernel written in HIP

```python
import math
import jax
import jax.numpy as jnp
from jax import lax
import numpy as np

D_MODEL = 2048
BATCH = 8
SEQ = 2048
DEPTH = 4

D_MIX = D_MODEL
HEAD_DIM = 64
SSD_WIDTH = D_MIX // 2
RWKV_WIDTH = D_MIX - SSD_WIDTH
SSD_HEADS = SSD_WIDTH // HEAD_DIM
SSD_GROUPS = 2
SSD_HEADS_PER_GROUP = SSD_HEADS // SSD_GROUPS
SSD_STATE = 128
SSD_CONV_WIDTH = 4
SSD_CHUNK = 128
SSD_CONV_DIM = SSD_WIDTH + 2 * SSD_GROUPS * SSD_STATE
RWKV_HEADS = RWKV_WIDTH // HEAD_DIM
W_LORA = 64
A_LORA = 64
V_LORA = 32
G_LORA = 160
RWKV_SHIFT_DIM = 3 * RWKV_WIDTH + W_LORA + A_LORA + G_LORA
IN_DIM = SSD_WIDTH + SSD_CONV_DIM + SSD_HEADS + RWKV_SHIFT_DIM
D_FF = 11 * D_MODEL // 4
N_EXPERTS = 8
TOP_K = 2
D_FF_EXPERT = D_FF // 2
N_DENSE = (DEPTH + 1) // 2
N_MOE = DEPTH // 2
DEEPNORM_ALPHA = (2 * DEPTH) ** 0.25
DEEPNORM_BETA = (8 * DEPTH) ** -0.25
LN_EPS = 1e-5
RMS_EPS = 1e-5
RWKV_GN_EPS = 64e-5
L2_EPS = 1e-12

kernel_name = "hymba_ssd_rwkv7_deepnorm_moe"


def _split(u, sizes):
    idx = []
    acc = 0
    for s in sizes:
        acc += s
        idx.append(acc)
    return jnp.split(u, idx, axis=-1)


def layer_norm(x, g, b):
    xf = x.astype(jnp.float32)
    mu = jnp.mean(xf, axis=-1, keepdims=True)
    var = jnp.mean(jnp.square(xf - mu), axis=-1, keepdims=True)
    y = (xf - mu) * lax.rsqrt(var + LN_EPS)
    return (y * g + b).astype(x.dtype)


def token_shift(u):
    return jnp.pad(u[:, :-1], ((0, 0), (1, 0), (0, 0)))


def causal_depthwise_conv(u, w, b):
    k = w.shape[0]
    out = lax.conv_general_dilated(
        u, w[:, None, :].astype(u.dtype), window_strides=(1,), padding=[(k - 1, 0)],
        dimension_numbers=("NWC", "WIO", "NWC"), feature_group_count=u.shape[-1])
    return out + b


def ssd_chunked_scan(xdt, dA, bm, cm):
    bsz, t, g, e, p = xdt.shape
    n = bm.shape[-1]
    L = SSD_CHUNK
    nc = t // L
    xc = xdt.reshape(bsz, nc, L, g, e, p)
    bc = bm.reshape(bsz, nc, L, g, n)
    cc = cm.reshape(bsz, nc, L, g, n)
    a = jnp.transpose(dA.reshape(bsz, nc, L, g, e), (0, 1, 3, 4, 2))
    a_cum = jnp.cumsum(a, axis=-1)
    causal = jnp.tril(jnp.ones((L, L), dtype=bool))
    seg = a_cum[..., :, None] - a_cum[..., None, :]
    decay_ls = jnp.exp(jnp.where(causal, seg, -jnp.inf))
    cb = jnp.einsum("bclgn,bcsgn->bcgls", cc, bc)
    y_diag = jnp.einsum("bcgels,bcsgep->bclgep", cb[:, :, :, None] * decay_ls, xc)
    decay_to_end = jnp.exp(a_cum[..., -1:] - a_cum)
    chunk_states = jnp.einsum("bcsgn,bcges,bcsgep->bcgepn", bc, decay_to_end, xc)
    chunk_decay = jnp.exp(a_cum[..., -1])

    def step(h, inp):
        dec, st = inp
        return h * dec[..., None, None] + st, h

    h0 = jnp.zeros((bsz, g, e, p, n), xdt.dtype)
    _, h_prev = lax.scan(step, h0, (jnp.moveaxis(chunk_decay, 1, 0), jnp.moveaxis(chunk_states, 1, 0)))
    h_prev = jnp.moveaxis(h_prev, 0, 1)
    y_off = jnp.einsum("bclgn,bcgepn,bcgel->bclgep", cc, h_prev, jnp.exp(a_cum))
    return (y_diag + y_off).reshape(bsz, t, g, e, p)


def ssd_mixer(z, xbc, dt_raw, conv_w, conv_b, dt_bias, a_log, d_skip, norm_w):
    f32 = jnp.float32
    bsz, t, _ = z.shape
    xbc = jax.nn.silu(causal_depthwise_conv(xbc, conv_w, conv_b))
    xs, bm, cm = _split(xbc, (SSD_WIDTH, SSD_GROUPS * SSD_STATE))
    xs = xs.astype(f32).reshape(bsz, t, SSD_GROUPS, SSD_HEADS_PER_GROUP, HEAD_DIM)
    bm = bm.astype(f32).reshape(bsz, t, SSD_GROUPS, SSD_STATE)
    cm = cm.astype(f32).reshape(bsz, t, SSD_GROUPS, SSD_STATE)
    dt = jax.nn.softplus(dt_raw.astype(f32) + dt_bias.astype(f32)).reshape(bsz, t, SSD_GROUPS, SSD_HEADS_PER_GROUP)
    a = -jnp.exp(a_log.astype(f32)).reshape(SSD_GROUPS, SSD_HEADS_PER_GROUP)
    y = ssd_chunked_scan(xs * dt[..., None], dt * a, bm, cm)
    y = y + xs * d_skip.astype(f32).reshape(SSD_GROUPS, SSD_HEADS_PER_GROUP, 1)
    u = y.reshape(bsz, t, SSD_WIDTH) * jax.nn.silu(z.astype(f32))
    u = u.reshape(bsz, t, SSD_GROUPS, SSD_WIDTH // SSD_GROUPS)
    u = u * lax.rsqrt(jnp.mean(jnp.square(u), axis=-1, keepdims=True) + RMS_EPS)
    return (u.reshape(bsz, t, SSD_WIDTH) * norm_w).astype(z.dtype)


def wkv7_scan(r, w, k, v, a, b):
    bsz, t, h, n = r.shape

    def step(s, inp):
        r_t, w_t, k_t, v_t, a_t, b_t = inp
        sa = jnp.einsum("bhij,bhj->bhi", s, a_t)
        s = s * w_t[:, :, None, :] + sa[..., None] * b_t[:, :, None, :] + v_t[..., None] * k_t[:, :, None, :]
        return s, jnp.einsum("bhij,bhj->bhi", s, r_t)

    s0 = jnp.zeros((bsz, h, n, n), jnp.float32)
    seq = tuple(jnp.moveaxis(u, 1, 0) for u in (r, w, k, v, a, b))
    _, y = lax.scan(step, s0, seq)
    return jnp.moveaxis(y, 0, 1)


def rwkv7_mixer(p, mix, w0, w_up, a0, a_up, g_up, k_k, k_a, r_k, ln_w, ln_b, v_res):
    f32 = jnp.float32
    bsz, t, _ = p.shape
    p = p + (token_shift(p) - p) * mix
    r, k, v, w_lo, a_lo, g_lo = _split(p, (RWKV_WIDTH, RWKV_WIDTH, RWKV_WIDTH, W_LORA, A_LORA))
    w = -jax.nn.softplus(-(w0 + jnp.tanh(w_lo) @ w_up).astype(f32)) - 0.5
    decay = jnp.exp(-jnp.exp(w))
    if v_res is None:
        v_first = v
    else:
        v_lo, v_mix, v0, v_up, v_first = v_res
        v_lo = v_lo + (token_shift(v_lo) - v_lo) * v_mix
        v = v + (v_first - v) * jax.nn.sigmoid(v0 + v_lo @ v_up)
    a = jax.nn.sigmoid(a0 + a_lo @ a_up)
    g = jax.nn.sigmoid(g_lo) @ g_up

    def heads(u):
        return u.astype(f32).reshape(bsz, t, RWKV_HEADS, HEAD_DIM)

    kk = heads(k * k_k)
    kk = kk / jnp.maximum(jnp.linalg.norm(kk, axis=-1, keepdims=True), L2_EPS)
    k = k * (1 + (a - 1) * k_a)
    rh, kh, vh, ah = heads(r), heads(k), heads(v), heads(a)
    y = wkv7_scan(rh, heads(decay), kh, vh, -kk, kk * ah)
    mu = jnp.mean(y, axis=-1, keepdims=True)
    var = jnp.mean(jnp.square(y - mu), axis=-1, keepdims=True)
    y = ((y - mu) * lax.rsqrt(var + RWKV_GN_EPS)).reshape(bsz, t, RWKV_WIDTH) * ln_w + ln_b
    bonus = jnp.sum(rh * kh * r_k, axis=-1, keepdims=True) * vh
    y = y + bonus.reshape(bsz, t, RWKV_WIDTH)
    return (y * g).astype(p.dtype), v_first


def swiglu(h, w1, w3, w2):
    return (jax.nn.silu(h @ w1) * (h @ w3)) @ w2


def moe_swiglu(h, router, w1, w3, w2):
    bsz, t, d = h.shape
    tok = h.reshape(bsz * t, d)
    logits = (tok @ router).astype(jnp.float32)
    top_logits, top_idx = lax.top_k(logits, TOP_K)
    gates = jax.nn.softmax(top_logits, axis=-1)
    combine = jnp.sum(jax.nn.one_hot(top_idx, N_EXPERTS, dtype=jnp.float32) * gates[..., None], axis=1).astype(h.dtype)
    out = jnp.zeros_like(tok)
    for e in range(N_EXPERTS):
        out = out + combine[:, e:e + 1] * swiglu(tok, w1[e], w3[e], w2[e])
    return out.reshape(bsz, t, d)


def setup_inputs(seed: int = 0) -> dict:
    key = jax.random.key(seed)
    ks = iter(jax.random.split(key, 64))
    f32 = jnp.float32

    def nrm(shape, scale):
        return scale * jax.random.normal(next(ks), shape, f32)

    def gain(shape):
        return 1.0 + nrm(shape, 0.02)

    x = nrm((BATCH, SEQ, D_MODEL), 1.0)
    w_in = nrm((DEPTH, D_MODEL, IN_DIM), D_MODEL ** -0.5)
    w_in_vres = nrm((DEPTH - 1, D_MODEL, V_LORA), D_MODEL ** -0.5)
    ssd_conv_w = nrm((DEPTH, SSD_CONV_WIDTH, SSD_CONV_DIM), SSD_CONV_WIDTH ** -0.5)
    ssd_conv_b = nrm((DEPTH, SSD_CONV_DIM), 0.02)
    dt0 = jnp.exp(jax.random.uniform(next(ks), (DEPTH, SSD_HEADS), f32, minval=math.log(1e-3), maxval=math.log(1e-1)))
    ssd_dt_bias = dt0 + jnp.log(-jnp.expm1(-dt0))
    ssd_a_log = jnp.log(jax.random.uniform(next(ks), (DEPTH, SSD_HEADS), f32, minval=1.0, maxval=16.0))
    ssd_d = gain((DEPTH, SSD_HEADS))
    ssd_norm_w = gain((DEPTH, SSD_WIDTH))
    rw_mix = jax.random.uniform(next(ks), (DEPTH, RWKV_SHIFT_DIM), f32)
    rw_vres_mix = jax.random.uniform(next(ks), (DEPTH - 1, V_LORA), f32)
    ratio = jnp.linspace(0.0, 1.0, RWKV_WIDTH, dtype=f32)
    rw_w0 = (-6.0 + 5.0 * ratio ** 0.85 + 0.5)[None, :] + nrm((DEPTH, RWKV_WIDTH), 0.05)
    rw_w_up = nrm((DEPTH, W_LORA, RWKV_WIDTH), 0.5 * W_LORA ** -0.5)
    rw_a0 = nrm((DEPTH, RWKV_WIDTH), 0.1)
    rw_a_up = nrm((DEPTH, A_LORA, RWKV_WIDTH), A_LORA ** -0.5)
    rw_v0 = nrm((DEPTH - 1, RWKV_WIDTH), 0.1)
    rw_v_up = nrm((DEPTH - 1, V_LORA, RWKV_WIDTH), V_LORA ** -0.5)
    rw_g_up = nrm((DEPTH, G_LORA, RWKV_WIDTH), G_LORA ** -0.5)
    rw_k_k = 0.85 + nrm((DEPTH, RWKV_WIDTH), 0.02)
    rw_k_a = gain((DEPTH, RWKV_WIDTH))
    rw_r_k = nrm((DEPTH, RWKV_HEADS, HEAD_DIM), 0.1)
    rw_ln_w = gain((DEPTH, RWKV_WIDTH))
    rw_ln_b = nrm((DEPTH, RWKV_WIDTH), 0.02)
    w_out = nrm((DEPTH, D_MIX, D_MODEL), DEEPNORM_BETA * D_MIX ** -0.5)
    ln1_g = gain((DEPTH, D_MODEL))
    ln1_b = nrm((DEPTH, D_MODEL), 0.02)
    ln2_g = gain((DEPTH, D_MODEL))
    ln2_b = nrm((DEPTH, D_MODEL), 0.02)
    ffn_w1 = nrm((N_DENSE, D_MODEL, D_FF), D_MODEL ** -0.5)
    ffn_w3 = nrm((N_DENSE, D_MODEL, D_FF), D_MODEL ** -0.5)
    ffn_w2 = nrm((N_DENSE, D_FF, D_MODEL), DEEPNORM_BETA * D_FF ** -0.5)
    moe_router = nrm((N_MOE, D_MODEL, N_EXPERTS), D_MODEL ** -0.5)
    moe_w1 = nrm((N_MOE, N_EXPERTS, D_MODEL, D_FF_EXPERT), D_MODEL ** -0.5)
    moe_w3 = nrm((N_MOE, N_EXPERTS, D_MODEL, D_FF_EXPERT), D_MODEL ** -0.5)
    moe_w2 = nrm((N_MOE, N_EXPERTS, D_FF_EXPERT, D_MODEL), DEEPNORM_BETA * D_FF_EXPERT ** -0.5)
    return {
        "x": x, "w_in": w_in, "w_in_vres": w_in_vres,
        "ssd_conv_w": ssd_conv_w, "ssd_conv_b": ssd_conv_b, "ssd_dt_bias": ssd_dt_bias,
        "ssd_a_log": ssd_a_log, "ssd_d": ssd_d, "ssd_norm_w": ssd_norm_w,
        "rw_mix": rw_mix, "rw_vres_mix": rw_vres_mix, "rw_w0": rw_w0, "rw_w_up": rw_w_up,
        "rw_a0": rw_a0, "rw_a_up": rw_a_up, "rw_v0": rw_v0, "rw_v_up": rw_v_up,
        "rw_g_up": rw_g_up, "rw_k_k": rw_k_k, "rw_k_a": rw_k_a, "rw_r_k": rw_r_k,
        "rw_ln_w": rw_ln_w, "rw_ln_b": rw_ln_b, "w_out": w_out,
        "ln1_g": ln1_g, "ln1_b": ln1_b, "ln2_g": ln2_g, "ln2_b": ln2_b,
        "ffn_w1": ffn_w1, "ffn_w3": ffn_w3, "ffn_w2": ffn_w2,
        "moe_router": moe_router, "moe_w1": moe_w1, "moe_w3": moe_w3, "moe_w2": moe_w2,
    }


def reference(x, w_in, w_in_vres, ssd_conv_w, ssd_conv_b, ssd_dt_bias, ssd_a_log, ssd_d, ssd_norm_w,
              rw_mix, rw_vres_mix, rw_w0, rw_w_up, rw_a0, rw_a_up, rw_v0, rw_v_up, rw_g_up,
              rw_k_k, rw_k_a, rw_r_k, rw_ln_w, rw_ln_b, w_out, ln1_g, ln1_b, ln2_g, ln2_b,
              ffn_w1, ffn_w3, ffn_w2, moe_router, moe_w1, moe_w3, moe_w2):
    v_first = None
    for l in range(DEPTH):
        if l == 0:
            w_comb = w_in[0]
        else:
            w_comb = jnp.concatenate([w_in[l], w_in_vres[l - 1]], axis=-1)
        proj = jnp.einsum("btd,dc->btc", x, w_comb)
        z, xbc, dt_raw, rw_p, v_lo = _split(proj, (SSD_WIDTH, SSD_CONV_DIM, SSD_HEADS, RWKV_SHIFT_DIM))
        y_ssd = ssd_mixer(z, xbc, dt_raw, ssd_conv_w[l], ssd_conv_b[l], ssd_dt_bias[l], ssd_a_log[l],
                          ssd_d[l], ssd_norm_w[l])
        if l == 0:
            v_res = None
        else:
            v_res = (v_lo, rw_vres_mix[l - 1], rw_v0[l - 1], rw_v_up[l - 1], v_first)
        y_rw, v_first = rwkv7_mixer(rw_p, rw_mix[l], rw_w0[l], rw_w_up[l], rw_a0[l], rw_a_up[l], rw_g_up[l],
                                    rw_k_k[l], rw_k_a[l], rw_r_k[l], rw_ln_w[l], rw_ln_b[l], v_res)
        mixed = jnp.einsum("btc,cd->btd", jnp.concatenate([y_ssd, y_rw], axis=-1), w_out[l])
        x = layer_norm(DEEPNORM_ALPHA * x + mixed, ln1_g[l], ln1_b[l])
        if l % 2 == 0:
            f = swiglu(x, ffn_w1[l // 2], ffn_w3[l // 2], ffn_w2[l // 2])
        else:
            f = moe_swiglu(x, moe_router[l // 2], moe_w1[l // 2], moe_w3[l // 2], moe_w2[l // 2])
        x = layer_norm(DEEPNORM_ALPHA * x + f, ln2_g[l], ln2_b[l])
    return x
```

```cpp
#include <hip/hip_runtime.h>
#include <cstdint>
#include <cstdio>

namespace {
constexpr int BATCH = 8, SEQ = 2048, M = BATCH * SEQ, D = 2048;
constexpr int HD = 64, SSD_H = 16, SSD_N = 128, CONV_DIM = 1536;
constexpr int RW_H = 16;
constexpr int IN_DIM = 5936, PROJ_LD = 5968;
constexpr int OFF_Z = 0, OFF_XBC = 1024, OFF_DT = 2560, OFF_RW = 2576, OFF_R = 2576, OFF_K = 3600, OFF_V = 4624, OFF_WLO = 5648, OFF_ALO = 5712, OFF_GLO = 5776, OFF_VLO = 5936;
constexpr int RW_SHIFT = 3360;
constexpr int DFF = 5632, NE = 8, DFE = 2816;
constexpr float ALPHA = 1.681792830507429f;
constexpr int LORA_LD = 320;

__device__ __forceinline__ float sigmoidf_(float x) { return 1.f / (1.f + expf(-x)); }
__device__ __forceinline__ float siluf_(float x) { return x / (1.f + expf(-x)); }
__device__ __forceinline__ float softplusf_(float x) { return fmaxf(x, 0.f) + log1pf(expf(-fabsf(x))); }
__device__ __forceinline__ float wave_sum(float v) {
#pragma unroll
    for (int o = 32; o >= 1; o >>= 1) v += __shfl_xor(v, o);
    return v;
}


#define LAS __attribute__((address_space(3)))
typedef unsigned short bf16_t;
typedef short bf16x8 __attribute__((ext_vector_type(8)));
typedef float f32x4 __attribute__((ext_vector_type(4)));
typedef float f32x2 __attribute__((ext_vector_type(2)));
typedef unsigned u32x4 __attribute__((ext_vector_type(4)));
typedef unsigned u32x2 __attribute__((ext_vector_type(2)));

__device__ __forceinline__ unsigned cvt_pk_bf16(float lo, float hi) { unsigned r; asm volatile("v_cvt_pk_bf16_f32 %0, %1, %2" : "=v"(r) : "v"(lo), "v"(hi)); return r; }
__device__ __forceinline__ float bf_lo(unsigned w) { return __uint_as_float(w << 16); }
__device__ __forceinline__ float bf_hi(unsigned w) { return __uint_as_float(w & 0xffff0000u); }
__device__ __forceinline__ float bf2f(bf16_t b) { return __uint_as_float(((unsigned)b) << 16); }
__device__ __forceinline__ float fast_silu(float x) { return x * __builtin_amdgcn_rcpf(1.f + __builtin_amdgcn_exp2f(-1.4426950408889634f * x)); }

namespace pg8 {
constexpr int BM = 256, BK = 64, HALF = 128, HTB = HALF * BK * 2, STAGE_BYTES = 8 * HTB, NXCD = 8, WGM = 8;
__host__ __device__ __forceinline__ int lds_byte(int r, int c) { const int st = (r >> 4) * 2 + (c >> 5), rr = r & 15, cc = c & 31, ob = rr * 64 + cc * 2; return st * 1024 + (ob ^ (((ob >> 9) & 1) << 5)); }
__host__ __device__ __forceinline__ void stage_rc(int b, int& R, int& C) { const int st = b / 1024, sb = b % 1024, swz = sb ^ (((sb >> 9) & 1) << 5); R = (st >> 1) * 16 + swz / 64; C = (st & 1) * 32 + (swz % 64) / 2; }
__host__ __device__ __forceinline__ int perm32(int rho) { const int n = rho >> 4, i = rho & 15; return 8 * (i >> 2) + 4 * n + (i & 3); }

struct Unit { int pm, pn, pb; };
struct Gemm { const bf16_t* A; const bf16_t* Bt; int K; };

__device__ __forceinline__ void decode_unit(int wgid, int nM, int nN, int& pm, int& pn) {
    const int nwg = nM * nN;
    { const int q = nwg / NXCD, r = nwg % NXCD, xcd = wgid % NXCD, off = wgid / NXCD; wgid = (xcd < r ? xcd * (q + 1) : r * (q + 1) + (xcd - r) * q) + off; }
    const int nig = WGM * nN, gid = wgid / nig, fm = gid * WGM, gsz = (nM - fm) < WGM ? (nM - fm) : WGM;
    pm = fm + ((wgid % nig) % gsz); pn = (wgid % nig) / gsz;
}
struct StaticOrder {
    int nM, nN, nwg, G, c;
    __device__ void init(int Mrows, int N, int G_, int c_) { nM = Mrows / BM; nN = N / BM; nwg = nM * nN; G = G_; c = c_; }
    __device__ __forceinline__ bool next(int i, Unit& u) const {
        const long L = (long)i * G + c; if (L >= nwg) return false;
        decode_unit((int)L, nM, nN, u.pm, u.pn); u.pb = u.pn; return true;
    }
};
struct GroupedOrder {
    int nM, nN, nwg, G, c; int cum[9];
    __device__ void init(const int* cnt, int N, int G_, int c_) {
        int acc = 0;
#pragma unroll
        for (int e = 0; e < 8; ++e) { cum[e] = acc; acc += (cnt[e] + 255) >> 8; }
        cum[8] = acc; nM = acc; nN = N / BM; nwg = nM * nN; G = G_; c = c_;
    }
    __device__ __forceinline__ bool next(int i, Unit& u) const {
        const long L = (long)i * G + c; if (L >= nwg) return false;
        decode_unit((int)L, nM, nN, u.pm, u.pn);
        int e = 0;
#pragma unroll
        for (int q = 1; q < 8; ++q) e += (u.pm >= cum[q]) ? 1 : 0;
        u.pb = e * nN + u.pn; return true;
    }
};

struct EpiF32 {
    static constexpr bool PERM = false;
    float* C; int ldc;
    __device__ __forceinline__ void operator()(const f32x4 (&acc)[2][2][4][2], const Unit& u, int wr, int wc, int fr, int fq) const {
        const int row0 = u.pm * BM + wr * 64 + fr, col0 = u.pn * BM + wc * 32 + 4 * fq;
#pragma unroll
        for (int ai = 0; ai < 2; ++ai)
#pragma unroll
            for (int m = 0; m < 4; ++m) { float* rowp = C + (size_t)(row0 + ai * HALF + m * 16) * ldc + col0;
#pragma unroll
                for (int bj = 0; bj < 2; ++bj)
#pragma unroll
                    for (int n = 0; n < 2; ++n) *(f32x4*)(rowp + bj * HALF + n * 16) = acc[ai][bj][m][n]; }
    }
};
struct EpiBf16 {
    static constexpr bool PERM = true;
    bf16_t* O; int ldc;
    __device__ __forceinline__ void operator()(const f32x4 (&acc)[2][2][4][2], const Unit& u, int wr, int wc, int fr, int fq) const {
        const int row0 = u.pm * BM + wr * 64 + fr, col0 = u.pn * BM + wc * 32 + 8 * fq;
#pragma unroll
        for (int ai = 0; ai < 2; ++ai)
#pragma unroll
            for (int m = 0; m < 4; ++m) { bf16_t* rowp = O + (size_t)(row0 + ai * HALF + m * 16) * ldc + col0;
#pragma unroll
                for (int bj = 0; bj < 2; ++bj) { const f32x4 v0 = acc[ai][bj][m][0], v1 = acc[ai][bj][m][1];
                    u32x4 w; w.x = cvt_pk_bf16(v0[0], v0[1]); w.y = cvt_pk_bf16(v0[2], v0[3]); w.z = cvt_pk_bf16(v1[0], v1[1]); w.w = cvt_pk_bf16(v1[2], v1[3]);
                    *(u32x4*)(rowp + bj * HALF) = w; } }
    }
};
struct EpiSwiglu {
    static constexpr bool PERM = true;
    bf16_t* O; int ldc;
    __device__ __forceinline__ void operator()(const f32x4 (&acc)[2][2][4][2], const Unit& u, int wr, int wc, int fr, int fq) const {
        const int row0 = u.pm * BM + wr * 64 + fr, col0 = u.pn * HALF + wc * 32 + 8 * fq;
#pragma unroll
        for (int ai = 0; ai < 2; ++ai)
#pragma unroll
            for (int m = 0; m < 4; ++m) { bf16_t* rowp = O + (size_t)(row0 + ai * HALF + m * 16) * ldc + col0;
                float o[8];
#pragma unroll
                for (int n = 0; n < 2; ++n)
#pragma unroll
                    for (int i = 0; i < 4; ++i) o[n * 4 + i] = fast_silu(acc[ai][0][m][n][i]) * acc[ai][1][m][n][i];
                u32x4 w; w.x = cvt_pk_bf16(o[0], o[1]); w.y = cvt_pk_bf16(o[2], o[3]); w.z = cvt_pk_bf16(o[4], o[5]); w.w = cvt_pk_bf16(o[6], o[7]);
                *(u32x4*)rowp = w; }
    }
};

template <class Epi, class Sched>
__device__ __forceinline__ void gemm_phase(LAS unsigned char* lds, const Gemm g, const Sched& S, const Epi& E, const int tid) {
    const int wid = __builtin_amdgcn_readfirstlane(tid >> 6), lane = tid & 63, wr = wid >> 2, wc = wid & 3, fr = lane & 15, fq = lane >> 4;
    const int K = g.K, nt = K / BK;
    unsigned voffA[2], voffB[2];
#pragma unroll
    for (int i = 0; i < 2; ++i) { int R, C; stage_rc(tid * 16 + i * 8192, R, C); const int Rb = Epi::PERM ? ((R & ~31) + perm32(R & 31)) : R;
        voffA[i] = (unsigned)(R * K + C) * 2u; voffB[i] = (unsigned)(Rb * K + C) * 2u; }
    const size_t kstep = (size_t)(BK * 2);
    const size_t hstep = (size_t)HALF * K * 2;
    const size_t tstep = 2 * hstep;
    const unsigned ldsw = (unsigned)wid * 1024u;
    const int aoff = lds_byte(wr * 64 + fr, fq * 8), boff = lds_byte(wc * 32 + fr, fq * 8);
#define PG8_SA(b, h) (((b) * 2 + (h)) * HTB)
#define PG8_SB(b, h) ((4 + (b) * 2 + (h)) * HTB)
#define PG8_STAGE(bufoff, gbase, voff) do { _Pragma("unroll") for (int _i = 0; _i < 2; ++_i) \
        __builtin_amdgcn_global_load_lds((const unsigned*)((const char*)(gbase) + (voff)[_i]), (LAS unsigned*)(lds + (bufoff) + ldsw + _i * 8192), 16, 0, 0); } while (0)
#define PG8_LDA(dst, b, h) do { _Pragma("unroll") for (int m = 0; m < 4; ++m) _Pragma("unroll") for (int k = 0; k < 2; ++k) dst[m][k] = *(const LAS bf16x8*)(lds + PG8_SA(b, h) + aoff + m * 2048 + k * 1024); } while (0)
#define PG8_LDB(dst, b, h) do { _Pragma("unroll") for (int n = 0; n < 2; ++n) _Pragma("unroll") for (int k = 0; k < 2; ++k) dst[n][k] = *(const LAS bf16x8*)(lds + PG8_SB(b, h) + boff + n * 2048 + k * 1024); } while (0)
#define PG8_MMA(ai, bj, At, Bt) do { __builtin_amdgcn_s_setprio(1); _Pragma("unroll") for (int m = 0; m < 4; ++m) _Pragma("unroll") for (int n = 0; n < 2; ++n) _Pragma("unroll") for (int k = 0; k < 2; ++k) \
        acc[ai][bj][m][n] = __builtin_amdgcn_mfma_f32_16x16x32_bf16(Bt[n][k], At[m][k], acc[ai][bj][m][n], 0, 0, 0); __builtin_amdgcn_s_setprio(0); } while (0)
#define PG8_WAIT_V(n) asm volatile("s_waitcnt vmcnt(" #n ")" ::: "memory")
#define PG8_WAIT_L(n) asm volatile("s_waitcnt lgkmcnt(" #n ")" ::: "memory")
#define PG8_BAR __builtin_amdgcn_s_barrier()
#define PG8_SCHED __builtin_amdgcn_sched_barrier(0)
    Unit cur, nxt; int ui = 0;
    if (!S.next(0, cur)) return;
    f32x4 acc[2][2][4][2];
#pragma unroll
    for (int a = 0; a < 2; ++a)
#pragma unroll
        for (int b = 0; b < 2; ++b)
#pragma unroll
            for (int m = 0; m < 4; ++m)
#pragma unroll
                for (int n = 0; n < 2; ++n) acc[a][b][m][n] = (f32x4){0.f, 0.f, 0.f, 0.f};
    bf16x8 At[4][2], B0[2][2], B1[2][2];
    const char* cA = (const char*)g.A + (size_t)cur.pm * tstep; const char* cB = (const char*)g.Bt + (size_t)cur.pb * tstep;
    PG8_STAGE(PG8_SB(0, 0), cB, voffB); PG8_STAGE(PG8_SB(0, 1), cB + hstep, voffB); PG8_STAGE(PG8_SA(0, 0), cA, voffA); PG8_STAGE(PG8_SA(0, 1), cA + hstep, voffA);
    if (wr == 1) PG8_BAR;
    PG8_WAIT_V(2); PG8_BAR;
    PG8_STAGE(PG8_SB(1, 0), cB + kstep, voffB); PG8_STAGE(PG8_SA(1, 0), cA + kstep, voffA); PG8_STAGE(PG8_SB(1, 1), cB + hstep + kstep, voffB);
    PG8_WAIT_V(6); PG8_BAR;
    for (;;) {
        const bool has_next = S.next(ui + 1, nxt);
        const char* nA = has_next ? (const char*)g.A + (size_t)nxt.pm * tstep : cA; const char* nB = has_next ? (const char*)g.Bt + (size_t)nxt.pb * tstep : cB;
        for (int t = 0; t < nt; t += 2) {
            const bool last = (t == nt - 2);
            const char* a1 = cA + (size_t)(t + 1) * kstep;
            const char* a2 = last ? nA : cA + (size_t)(t + 2) * kstep; const char* b2 = last ? nB : cB + (size_t)(t + 2) * kstep;
            const char* a3 = a2 + kstep; const char* b3 = b2 + kstep;
            PG8_LDB(B0, 0, 0); PG8_LDB(B1, 0, 1); PG8_SCHED; PG8_LDA(At, 0, 0); PG8_STAGE(PG8_SA(1, 1), a1 + hstep, voffA);
            PG8_WAIT_V(8); PG8_WAIT_L(0); PG8_BAR; PG8_MMA(0, 0, At, B0); PG8_MMA(0, 1, At, B1); PG8_BAR; PG8_SCHED;
            PG8_LDA(At, 0, 1); PG8_STAGE(PG8_SB(0, 0), b2, voffB); PG8_STAGE(PG8_SB(0, 1), b2 + hstep, voffB); PG8_STAGE(PG8_SA(0, 0), a2, voffA);
            PG8_WAIT_V(8); PG8_WAIT_L(0); PG8_BAR; PG8_MMA(1, 0, At, B0); PG8_MMA(1, 1, At, B1); PG8_BAR; PG8_SCHED;
            PG8_LDB(B0, 1, 0); PG8_LDB(B1, 1, 1); PG8_SCHED; PG8_LDA(At, 1, 0); PG8_STAGE(PG8_SA(0, 1), a2 + hstep, voffA);
            PG8_WAIT_V(8); PG8_WAIT_L(0); PG8_BAR; PG8_MMA(0, 0, At, B0); PG8_MMA(0, 1, At, B1); PG8_BAR; PG8_SCHED;
            PG8_LDA(At, 1, 1); PG8_STAGE(PG8_SB(1, 0), b3, voffB); PG8_STAGE(PG8_SB(1, 1), b3 + hstep, voffB); PG8_STAGE(PG8_SA(1, 0), a3, voffA);
            PG8_WAIT_V(8); PG8_WAIT_L(0); PG8_BAR; PG8_MMA(1, 0, At, B0); PG8_MMA(1, 1, At, B1); PG8_BAR; PG8_SCHED;
        }
        if (wr == 0) PG8_BAR;
        E(acc, cur, wr, wc, fr, fq);
        if (!has_next) break;
#pragma unroll
        for (int a = 0; a < 2; ++a)
#pragma unroll
            for (int b = 0; b < 2; ++b)
#pragma unroll
                for (int m = 0; m < 4; ++m)
#pragma unroll
                    for (int n = 0; n < 2; ++n) acc[a][b][m][n] = (f32x4){0.f, 0.f, 0.f, 0.f};
        cur = nxt; cA = nA; cB = nB; ++ui;
        if (wr == 1) PG8_BAR;
    }
    PG8_WAIT_V(0);
    PG8_BAR;
#undef PG8_SA
#undef PG8_SB
#undef PG8_STAGE
#undef PG8_LDA
#undef PG8_LDB
#undef PG8_MMA
#undef PG8_WAIT_V
#undef PG8_WAIT_L
#undef PG8_BAR
#undef PG8_SCHED
}
}

#define XB_TMO      128
#define XB_XCNT(j)  (256  + 64 * (j))
#define XB_XSUB(j)  (1280 + 64 * (j))
#define XB_XGEN(j)  (2304 + 64 * (j))
#define XB_TOP      3328
#define XB_TOPGEN   3392
#define XCD_BAR_WORDS 3456
#define XB_SPIN_CAP (1u << 18)
__device__ __forceinline__ unsigned xb_ld(unsigned* p)              { return __hip_atomic_load(p, __ATOMIC_RELAXED, __HIP_MEMORY_SCOPE_AGENT); }
__device__ __forceinline__ unsigned xb_add(unsigned* p, unsigned v) { return __hip_atomic_fetch_add(p, v, __ATOMIC_RELAXED, __HIP_MEMORY_SCOPE_AGENT); }
__device__ __forceinline__ unsigned xb_xcc_id() { return (unsigned)__builtin_amdgcn_s_getreg((3 << 11) | 20) & 0xFu; }
#define XB_SPIN(cond, bar) do { unsigned _sp = 0; while (cond) { __builtin_amdgcn_s_sleep(1); \
    if ((++_sp & 255u) == 0u) { if (xb_ld(&(bar)[XB_TMO])) break; if (_sp > XB_SPIN_CAP) { atomicAdd(&(bar)[XB_TMO], 1u); break; } } } } while (0)
struct XcdBarrier { unsigned* bar; unsigned x; volatile LAS unsigned* st; };
__device__ __forceinline__ XcdBarrier xcd_barrier_post(unsigned* bar, volatile LAS unsigned* st) {
    XcdBarrier b; b.bar = bar; b.x = xb_xcc_id(); b.st = st;
    if (threadIdx.x == 0) (void)xb_add(&bar[XB_XCNT(b.x)], 1u);
    return b;
}
__device__ __forceinline__ void xcd_barrier_complete(unsigned* bar, unsigned x, unsigned& nloc, unsigned& nx) {
    const unsigned G = gridDim.x * gridDim.y * gridDim.z;
    unsigned sum, cnt, mine, sp = 0u;
    for (;;) {
        sum = 0u; cnt = 0u; mine = 0u;
#pragma unroll
        for (unsigned j = 0; j < 16; ++j) { const unsigned c = xb_ld(&bar[XB_XCNT(j)]); sum += c; cnt += (c > 0u) ? 1u : 0u; mine = (j == x) ? c : mine; }
        if (sum == G) break;
        __builtin_amdgcn_s_sleep(1);
        if ((++sp & 255u) == 0u) { if (xb_ld(&bar[XB_TMO])) break; if (sp > XB_SPIN_CAP) { atomicAdd(&bar[XB_TMO], 1u); break; } }
    }
    nloc = mine > 0u ? mine : 1u; nx = cnt > 0u ? cnt : 1u;
}
__device__ __forceinline__ void xcd_barrier(const XcdBarrier& b) {
    asm volatile("s_waitcnt vmcnt(0)" ::: "memory");
    __syncthreads();
    if (threadIdx.x == 0) {
        unsigned* bar = b.bar;
        __builtin_amdgcn_s_waitcnt(0);
        unsigned nloc = b.st[0], nx = b.st[1];
        if (nloc == 0u) { xcd_barrier_complete(bar, b.x, nloc, nx); b.st[0] = nloc; b.st[1] = nx; }
        const unsigned old = xb_add(&bar[XB_XSUB(b.x)], 1u);
        const unsigned gen = old / nloc;
        if (old + 1u == (gen + 1u) * nloc) {
            __builtin_amdgcn_fence(__ATOMIC_RELEASE, "agent");
            asm volatile("s_waitcnt vmcnt(0)" ::: "memory");
            const unsigned og = xb_add(&bar[XB_TOP], 1u);
            const unsigned tg = og / nx;
            if (og + 1u == (tg + 1u) * nx) xb_add(&bar[XB_TOPGEN], 1u);
            else XB_SPIN(xb_ld(&bar[XB_TOPGEN]) == tg, bar);
            __builtin_amdgcn_fence(__ATOMIC_ACQUIRE, "agent");
            xb_add(&bar[XB_XGEN(b.x)], 1u);
            asm volatile("s_waitcnt vmcnt(0)" ::: "memory");
        } else {
            XB_SPIN(xb_ld(&bar[XB_XGEN(b.x)]) == gen, bar);
            __builtin_amdgcn_fence(__ATOMIC_ACQUIRE, "agent");
            asm volatile("s_waitcnt vmcnt(0)" ::: "memory");
        }
    }
    __syncthreads();
}

constexpr size_t MiB = 1u << 20;
constexpr int NWAVES = 8;
constexpr int PROJ_BLD = 6144;
constexpr int PMAX = 34816;
constexpr size_t WS_CTL = 0, CTL_BYTES = 1 * MiB;
constexpr size_t WS_WIN = 1 * MiB, WS_WOUT = 25 * MiB, WS_WLORA = 33 * MiB;
constexpr size_t WS_XF = 34 * MiB, WS_XB = 162 * MiB, WS_VFIRST = 226 * MiB, WS_YMIXB = 290 * MiB, WS_TOK = 354 * MiB, WS_SCR = 356 * MiB;
constexpr size_t WS_PROJB = WS_SCR, WS_LW = WS_PROJB + 192 * MiB, WS_YRW = WS_LW + 128 * MiB, WS_BON = WS_YRW + 64 * MiB, WS_XBCC = WS_BON + 64 * MiB, WS_DTB = WS_XBCC + 48 * MiB, WS_YSSD = WS_DTB + 1 * MiB, WS_MIXED = WS_YSSD + 64 * MiB;
constexpr size_t WS_HBUF = WS_SCR, WS_XG = WS_HBUF + 187 * MiB, WS_YSLOT = WS_XG + 136 * MiB;
constexpr size_t WS_WFFN = WS_SCR + 860 * MiB, WS_END = WS_WFFN + 264 * MiB;
static_assert(WS_MIXED + 128 * MiB <= WS_WFFN && WS_YSLOT + 272 * MiB <= WS_WFFN, "scratch inside the map");
static_assert((size_t)PMAX * DFE * 2 <= 187 * MiB && (size_t)PMAX * D * 2 <= 136 * MiB && (size_t)PMAX * D * 4 <= 272 * MiB, "moe buffers");
constexpr int CW_CNT = 16;
constexpr int CW_BAR = 4096;
constexpr int MAX_BAR_REGIONS = 48;
static_assert((CW_BAR + MAX_BAR_REGIONS * XCD_BAR_WORDS) * 4 <= (int)CTL_BYTES, "ctl");
constexpr int RING_BYTES = 131072, LDS_BYTES = 147456, MISC_OFF = LDS_BYTES - 256;

struct Params { const float* in[35]; float* out; unsigned char* ws; int ph_lo, ph_hi, bar_idx, pad; };

__device__ __forceinline__ float wave_sum_f(float v) {
#pragma unroll
    for (int o = 32; o >= 1; o >>= 1) v += __shfl_xor(v, o);
    return v;
}

__device__ __forceinline__ void cvt_item(const float* W, int K, int N, bf16_t* WT, int dst_row0, LAS float* scr, int k0, int n0, int lane) {
#pragma unroll 8
    for (int i = 0; i < 32; ++i) { const int kk = 2 * i + (lane >> 5), col = lane & 31;
        scr[kk * 33 + col] = (k0 + kk < K && n0 + col < N) ? W[(size_t)(k0 + kk) * N + n0 + col] : 0.f; }
    asm volatile("s_waitcnt lgkmcnt(0)" ::: "memory");
    const int c = lane & 7;
#pragma unroll
    for (int j = 0; j < 4; ++j) { const int n = (lane >> 3) + 8 * j; const LAS float* s = scr + (8 * c) * 33 + n;
        u32x4 o; o.x = cvt_pk_bf16(s[0 * 33], s[1 * 33]); o.y = cvt_pk_bf16(s[2 * 33], s[3 * 33]); o.z = cvt_pk_bf16(s[4 * 33], s[5 * 33]); o.w = cvt_pk_bf16(s[6 * 33], s[7 * 33]);
        if (n0 + n < N && k0 + 8 * c < K) *(u32x4*)(WT + (size_t)(dst_row0 + n) * K + k0 + 8 * c) = o; }
    asm volatile("s_waitcnt lgkmcnt(0)" ::: "memory");
}
template <int MODE>
__device__ __forceinline__ void cvt_job(const float* W, int K, int N, bf16_t* WT, int row_off, int half, LAS float* scr, int gw, int ngw, int lane) {
    const int nkb = (K + 63) / 64, nnb = (N + 31) / 32, nitems = nkb * nnb;
    for (int it = gw; it < nitems; it += ngw) {
        const int kb = it / nnb, nb = it % nnb, n0 = nb * 32;
        const int dr = MODE == 0 ? row_off + n0 : row_off + 256 * (n0 / 128) + half * 128 + (n0 % 128);
        cvt_item(W, K, N, WT, dr, scr, kb * 64, n0, lane);
    }
}

struct LnOut { float* xf; bf16_t* xb; };
__device__ __forceinline__ void ln_finish(f32x4 (&v)[8], const float* gam, const float* bet, int lane, float* xf_row, bf16_t* xb_row) {
    float s = 0.f;
#pragma unroll
    for (int j = 0; j < 8; ++j) s += (v[j][0] + v[j][1]) + (v[j][2] + v[j][3]);
    const float mean = wave_sum_f(s) * (1.f / D);
    float q = 0.f;
#pragma unroll
    for (int j = 0; j < 8; ++j) { v[j] = v[j] - mean; q += (v[j][0] * v[j][0] + v[j][1] * v[j][1]) + (v[j][2] * v[j][2] + v[j][3] * v[j][3]); }
    const float rstd = rsqrtf(wave_sum_f(q) * (1.f / D) + 1e-5f);
#pragma unroll
    for (int j = 0; j < 8; ++j) { const int c = 4 * lane + 256 * j;
        const f32x4 g = *(const f32x4*)(gam + c), b = *(const f32x4*)(bet + c);
        v[j] = v[j] * rstd * g + b;
        *(f32x4*)(xf_row + c) = v[j];
        if (xb_row) { u32x2 w; w.x = cvt_pk_bf16(v[j][0], v[j][1]); w.y = cvt_pk_bf16(v[j][2], v[j][3]); *(u32x2*)(xb_row + c) = w; } }
}

#define DPP_ROR(z, n) __uint_as_float(__builtin_amdgcn_update_dpp(0u, __float_as_uint(z), 0x120 + (n), 0xf, 0xf, false))
__device__ __forceinline__ float wave_allsum(float x) {
    { auto s = __builtin_amdgcn_permlane32_swap(__float_as_uint(x), __float_as_uint(x), false, false); x = __uint_as_float(s[0]) + __uint_as_float(s[1]); }
    { auto s = __builtin_amdgcn_permlane16_swap(__float_as_uint(x), __float_as_uint(x), false, false); x = __uint_as_float(s[0]) + __uint_as_float(s[1]); }
    x += DPP_ROR(x, 8); x += DPP_ROR(x, 4); x += DPP_ROR(x, 2); x += DPP_ROR(x, 1);
    return x;
}
__device__ __forceinline__ float reduce4(float x0, float x1, float x2, float x3) {
    float y0, y1, z;
    { auto s = __builtin_amdgcn_permlane32_swap(__float_as_uint(x0), __float_as_uint(x2), false, false); y0 = __uint_as_float(s[0]) + __uint_as_float(s[1]); }
    { auto s = __builtin_amdgcn_permlane32_swap(__float_as_uint(x1), __float_as_uint(x3), false, false); y1 = __uint_as_float(s[0]) + __uint_as_float(s[1]); }
    { auto s = __builtin_amdgcn_permlane16_swap(__float_as_uint(y0), __float_as_uint(y1), false, false); z = __uint_as_float(s[0]) + __uint_as_float(s[1]); }
    z += DPP_ROR(z, 8); z += DPP_ROR(z, 4); z += DPP_ROR(z, 2); z += DPP_ROR(z, 1);
    return z;
}
__device__ __forceinline__ float rdlane(float v, int l) { return __int_as_float(__builtin_amdgcn_readlane(__float_as_int(v), l)); }
__device__ __forceinline__ float fast_sigmoid(float x) { return __builtin_amdgcn_rcpf(1.f + __builtin_amdgcn_exp2f(-1.4426950408889634f * x)); }
__device__ __forceinline__ float fast_tanh(float x) { return 1.f - 2.f * __builtin_amdgcn_rcpf(1.f + __builtin_amdgcn_exp2f(2.8853900817779268f * x)); }

constexpr int LORA_PITCH = 328;
__device__ __forceinline__ void lora_phase(LAS unsigned char* lds, const bf16_t* projb, const float* mix, const float* vmix, const bf16_t* Wl_w, const bf16_t* Wl_a, const bf16_t* Wl_g, const bf16_t* Wl_v,
                                           bf16_t* lw, const bool has_v, const int vcu, const int G, const int tid) {
    const int wave = __builtin_amdgcn_readfirstlane(tid >> 6), lane = tid & 63, fr = lane & 15, fq = lane >> 4;
    LAS bf16_t* Aimg = (LAS bf16_t*)lds;
    for (int u = vcu; u < M / 64; u += G) {
        {
            const int tau = tid >> 3, part = tid & 7, m = u * 64 + tau; const bool first = (m % SEQ) == 0;
#pragma unroll
            for (int i = 0; i < 5; ++i) {
                const int j0 = 40 * part + 8 * i;
                const u32x4 cur = *(const u32x4*)(projb + (size_t)m * PROJ_BLD + OFF_WLO + j0);
                u32x4 prv = (u32x4){0u, 0u, 0u, 0u};
                if (!first) prv = *(const u32x4*)(projb + (size_t)(m - 1) * PROJ_BLD + OFF_WLO + j0);
                f32x4 mx0, mx1;
                if (j0 < 288) { mx0 = *(const f32x4*)(mix + (OFF_WLO - OFF_RW) + j0); mx1 = *(const f32x4*)(mix + (OFF_WLO - OFF_RW) + j0 + 4); }
                else if (has_v) { mx0 = *(const f32x4*)(vmix + (j0 - 288)); mx1 = *(const f32x4*)(vmix + (j0 - 288) + 4); }
                else { mx0 = (f32x4){0.f, 0.f, 0.f, 0.f}; mx1 = mx0; }
                float o[8];
#pragma unroll
                for (int e = 0; e < 4; ++e) {
                    const float c0 = bf_lo(cur[e]), c1 = bf_hi(cur[e]), p0 = bf_lo(prv[e]), p1 = bf_hi(prv[e]);
                    const float m0 = (e < 2) ? mx0[2 * e] : mx1[2 * e - 4], m1 = (e < 2) ? mx0[2 * e + 1] : mx1[2 * e - 3];
                    o[2 * e] = c0 + (p0 - c0) * m0; o[2 * e + 1] = c1 + (p1 - c1) * m1;
                }
                if (j0 < 64) {
#pragma unroll
                    for (int e = 0; e < 8; ++e) o[e] = fast_tanh(o[e]);
                } else if (j0 >= 128 && j0 < 288) {
#pragma unroll
                    for (int e = 0; e < 8; ++e) o[e] = fast_sigmoid(o[e]);
                }
                u32x4 w; w.x = cvt_pk_bf16(o[0], o[1]); w.y = cvt_pk_bf16(o[2], o[3]); w.z = cvt_pk_bf16(o[4], o[5]); w.w = cvt_pk_bf16(o[6], o[7]);
                *(LAS u32x4*)(Aimg + tau * LORA_PITCH + j0) = w;
            }
        }
        __syncthreads();
        for (int q = 0; q < 4; ++q) {
            if (q == 3 && !has_v) break;
            const int K = (q == 2) ? 160 : (q == 3 ? 32 : 64), koff = (q == 0) ? 0 : (q == 1 ? 64 : (q == 2 ? 128 : 288));
            const bf16_t* W = (q == 0) ? Wl_w : (q == 1 ? Wl_a : (q == 2 ? Wl_g : Wl_v));
            f32x4 acc[8][4];
#pragma unroll
            for (int ct = 0; ct < 8; ++ct)
#pragma unroll
                for (int tt = 0; tt < 4; ++tt) acc[ct][tt] = (f32x4){0.f, 0.f, 0.f, 0.f};
            for (int ks = 0; ks < K / 32; ++ks) {
                bf16x8 af[8], bfr[4];
#pragma unroll
                for (int ct = 0; ct < 8; ++ct) af[ct] = *(const bf16x8*)(W + (size_t)(128 * wave + 16 * ct + fr) * K + 32 * ks + 8 * fq);
#pragma unroll
                for (int tt = 0; tt < 4; ++tt) bfr[tt] = *(const LAS bf16x8*)(Aimg + (16 * tt + fr) * LORA_PITCH + koff + 32 * ks + 8 * fq);
#pragma unroll
                for (int ct = 0; ct < 8; ++ct)
#pragma unroll
                    for (int tt = 0; tt < 4; ++tt) acc[ct][tt] = __builtin_amdgcn_mfma_f32_16x16x32_bf16(af[ct], bfr[tt], acc[ct][tt], 0, 0, 0);
            }
            bf16_t* out = lw + (size_t)q * M * 1024;
#pragma unroll
            for (int ct = 0; ct < 8; ++ct)
#pragma unroll
                for (int tt = 0; tt < 4; ++tt) { u32x2 w; w.x = cvt_pk_bf16(acc[ct][tt][0], acc[ct][tt][1]); w.y = cvt_pk_bf16(acc[ct][tt][2], acc[ct][tt][3]);
                    *(u32x2*)(out + (size_t)(u * 64 + 16 * tt + fr) * 1024 + 128 * wave + 16 * ct + 4 * fq) = w; }
        }
        __syncthreads();
    }
}

struct RwScan { const bf16_t* projb; const bf16_t* lw; const float* mix; const float* w0; const float* a0; const float* v0; const float* k_k; const float* k_a; const float* r_k; float* vfirst; float* yrw; float* bon; int layer; int pad; };
constexpr int RWB_R = 0, RWB_DEC = 8192, RWB_KM = 16384, RWB_A = 24576, RWB_B = 32768, RWB_V = 40960, RWB_RK = 45056, RWB_SIZE = 45184, RW_YST = 2 * RWB_SIZE, RW_TB = 32;
__device__ __forceinline__ void rwkv_scan_phase(LAS unsigned char* lds, const RwScan& a, const int vcu, const int G, const int tid) {
    const int wave = __builtin_amdgcn_readfirstlane(tid >> 6), lane = tid & 63;
    for (int u = vcu; u < BATCH * RW_H * 2; u += G) {
        const int b = u >> 5, h = (u >> 1) & 15, half = u & 1, c = h * 64 + lane;
        const float mix_r = a.mix[c], mix_k = a.mix[1024 + c], mix_v = a.mix[2048 + c];
        const float w0c = a.w0[c], a0c = a.a0[c], v0c = a.layer ? a.v0[c] : 0.f, kkc = a.k_k[c], kac = a.k_a[c], rkc = a.r_k[c];
        float S0 = 0.f, S1 = 0.f, S2 = 0.f, S3 = 0.f;
        unsigned pr[5], pk[5], pv[5], pw[4], pa[4], pvp[4]; float pvf[4];
        const bf16_t* lw_w = a.lw; const bf16_t* lw_a = a.lw + (size_t)M * 1024; const bf16_t* lw_v = a.lw + (size_t)3 * M * 1024;
#define RW_PREFETCH(t0_) do { const int tb_ = (t0_) + 4 * wave; \
        _Pragma("unroll") for (int i = 0; i < 5; ++i) { const int t_ = tb_ + i - 1; \
            if (t_ >= 0) { const bf16_t* row_ = a.projb + (size_t)(b * SEQ + t_) * PROJ_BLD + h * 64 + lane; pr[i] = row_[OFF_R]; pk[i] = row_[OFF_K]; pv[i] = row_[OFF_V]; } \
            else { pr[i] = 0u; pk[i] = 0u; pv[i] = 0u; } } \
        _Pragma("unroll") for (int i = 0; i < 4; ++i) { const size_t o_ = (size_t)(b * SEQ + tb_ + i) * 1024 + c; pw[i] = lw_w[o_]; pa[i] = lw_a[o_]; \
            if (a.layer) { pvp[i] = lw_v[o_]; pvf[i] = a.vfirst[o_]; } else { pvp[i] = 0u; pvf[i] = 0.f; } } } while (0)
        RW_PREFETCH(0);
        for (int ch = 0; ch < SEQ / RW_TB; ++ch) {
            const int t0 = ch * RW_TB;
            LAS unsigned char* buf = lds + (ch & 1) * RWB_SIZE;
#pragma unroll
            for (int i = 0; i < 4; ++i) {
                const int tau = 4 * wave + i;
                const float rc = __uint_as_float(pr[i + 1] << 16), rp = __uint_as_float(pr[i] << 16), kc = __uint_as_float(pk[i + 1] << 16), kp = __uint_as_float(pk[i] << 16), vc = __uint_as_float(pv[i + 1] << 16), vp = __uint_as_float(pv[i] << 16);
                const float r = rc + (rp - rc) * mix_r, kraw = kc + (kp - kc) * mix_k, vraw = vc + (vp - vc) * mix_v;
                const float sg = fast_sigmoid(w0c + __uint_as_float(pw[i] << 16));
                const float dec = __builtin_amdgcn_exp2f(-1.4426950408889634f * 0.6065306597126334f * sg);
                const float as = fast_sigmoid(a0c + __uint_as_float(pa[i] << 16));
                float v = vraw;
                if (a.layer) v = vraw + (pvf[i] - vraw) * fast_sigmoid(v0c + __uint_as_float(pvp[i] << 16));
                const float kkv = kraw * kkc;
                const float nrm = sqrtf(wave_allsum(kkv * kkv));
                const float kkn = kkv / fmaxf(nrm, 1e-12f);
                const float km = kraw * (1.f + (as - 1.f) * kac);
                const float rks = wave_allsum(r * km * rkc);
                ((LAS float*)(buf + RWB_R))[tau * 64 + lane] = r; ((LAS float*)(buf + RWB_DEC))[tau * 64 + lane] = dec; ((LAS float*)(buf + RWB_KM))[tau * 64 + lane] = km;
                ((LAS float*)(buf + RWB_A))[tau * 64 + lane] = -kkn; ((LAS float*)(buf + RWB_B))[tau * 64 + lane] = kkn * as;
                if ((lane >> 5) == half) { ((LAS float*)(buf + RWB_V))[tau * 32 + (lane & 31)] = v;
                    if (a.layer == 0) a.vfirst[(size_t)(b * SEQ + t0 + tau) * 1024 + c] = vraw; }
                if (lane == 0) ((LAS float*)(buf + RWB_RK))[tau] = rks;
            }
            __syncthreads();
            if (ch + 1 < SEQ / RW_TB) RW_PREFETCH(t0 + RW_TB);
            {
                const LAS float* Rb = (const LAS float*)(buf + RWB_R) + lane; const LAS float* Vb = (const LAS float*)(buf + RWB_V) + 4 * wave;
                LAS float* Yst = (LAS float*)(lds + RW_YST);
#pragma unroll 4
                for (int tau = 0; tau < RW_TB; ++tau) {
                    const float r = Rb[tau * 64], d = Rb[tau * 64 + 2048], k = Rb[tau * 64 + 4096], aa = Rb[tau * 64 + 6144], bb = Rb[tau * 64 + 8192];
                    const f32x4 vv = *(const LAS f32x4*)(Vb + tau * 32);
                    const float z = reduce4(S0 * aa, S1 * aa, S2 * aa, S3 * aa);
                    const float sa0 = rdlane(z, 0), sa1 = rdlane(z, 16), sa2 = rdlane(z, 32), sa3 = rdlane(z, 48);
                    S0 = S0 * d + sa0 * bb + vv[0] * k; S1 = S1 * d + sa1 * bb + vv[1] * k; S2 = S2 * d + sa2 * bb + vv[2] * k; S3 = S3 * d + sa3 * bb + vv[3] * k;
                    const float y = reduce4(S0 * r, S1 * r, S2 * r, S3 * r);
                    if ((lane & 15) == 0) Yst[tau * 32 + 4 * wave + (lane >> 4)] = y;
                }
            }
            __syncthreads();
#pragma unroll
            for (int q = 0; q < 2; ++q) {
                const int idx = tid + 512 * q, tau = idx >> 5, i = idx & 31;
                const float y = ((const LAS float*)(lds + RW_YST))[idx];
                const float bo = ((const LAS float*)(buf + RWB_RK))[tau] * ((const LAS float*)(buf + RWB_V))[tau * 32 + i];
                const size_t o = (size_t)(b * SEQ + t0 + tau) * 1024 + h * 64 + half * 32 + i;
                a.yrw[o] = y; a.bon[o] = bo;
            }
        }
#undef RW_PREFETCH
        __syncthreads();
    }
}

__device__ __forceinline__ void rwkv_post_phase(const float* yrw, const float* bon, const bf16_t* lw_g, const float* ln_w, const float* ln_b, bf16_t* ymixb, const int gw, const int NGW, const int lane) {
    const int c0 = 16 * lane;
    f32x4 lw4[4], lb4[4];
#pragma unroll
    for (int j = 0; j < 4; ++j) { lw4[j] = *(const f32x4*)(ln_w + c0 + 4 * j); lb4[j] = *(const f32x4*)(ln_b + c0 + 4 * j); }
    for (int m = gw; m < M; m += NGW) {
        f32x4 y[4], bo[4];
#pragma unroll
        for (int j = 0; j < 4; ++j) { y[j] = *(const f32x4*)(yrw + (size_t)m * 1024 + c0 + 4 * j); bo[j] = *(const f32x4*)(bon + (size_t)m * 1024 + c0 + 4 * j); }
        const u32x4 g0 = *(const u32x4*)(lw_g + (size_t)m * 1024 + c0), g1 = *(const u32x4*)(lw_g + (size_t)m * 1024 + c0 + 8);
        float s = 0.f;
#pragma unroll
        for (int j = 0; j < 4; ++j) s += (y[j][0] + y[j][1]) + (y[j][2] + y[j][3]);
        s += __shfl_xor(s, 1); s += __shfl_xor(s, 2);
        const float mu = s * (1.f / 64.f);
        float q = 0.f;
#pragma unroll
        for (int j = 0; j < 4; ++j) { y[j] = y[j] - mu; q += (y[j][0] * y[j][0] + y[j][1] * y[j][1]) + (y[j][2] * y[j][2] + y[j][3] * y[j][3]); }
        q += __shfl_xor(q, 1); q += __shfl_xor(q, 2);
        const float rstd = rsqrtf(q * (1.f / 64.f) + 64e-5f);
        float o[16];
#pragma unroll
        for (int j = 0; j < 4; ++j) { const f32x4 t = y[j] * rstd * lw4[j] + lb4[j] + bo[j]; o[4 * j] = t[0]; o[4 * j + 1] = t[1]; o[4 * j + 2] = t[2]; o[4 * j + 3] = t[3]; }
        const unsigned gw_[8] = {g0.x, g0.y, g0.z, g0.w, g1.x, g1.y, g1.z, g1.w};
        u32x4 w0, w1;
        w0.x = cvt_pk_bf16(o[0] * bf_lo(gw_[0]), o[1] * bf_hi(gw_[0])); w0.y = cvt_pk_bf16(o[2] * bf_lo(gw_[1]), o[3] * bf_hi(gw_[1]));
        w0.z = cvt_pk_bf16(o[4] * bf_lo(gw_[2]), o[5] * bf_hi(gw_[2])); w0.w = cvt_pk_bf16(o[6] * bf_lo(gw_[3]), o[7] * bf_hi(gw_[3]));
        w1.x = cvt_pk_bf16(o[8] * bf_lo(gw_[4]), o[9] * bf_hi(gw_[4])); w1.y = cvt_pk_bf16(o[10] * bf_lo(gw_[5]), o[11] * bf_hi(gw_[5]));
        w1.z = cvt_pk_bf16(o[12] * bf_lo(gw_[6]), o[13] * bf_hi(gw_[6])); w1.w = cvt_pk_bf16(o[14] * bf_lo(gw_[7]), o[15] * bf_hi(gw_[7]));
        *(u32x4*)(ymixb + (size_t)m * 2048 + 1024 + c0) = w0; *(u32x4*)(ymixb + (size_t)m * 2048 + 1024 + c0 + 8) = w1;
    }
}

__device__ __forceinline__ void ssd_conv_phase(const bf16_t* projb, const float* cw, const float* cb, const float* dt_bias, bf16_t* xbcc, float* dtb, const int vcu, const int G, const int tid) {
    for (int u = vcu; u < M / 64; u += G) {
        if (tid < 384) {
            const int cg = tid % 192, hf = tid / 192, c0 = 8 * cg, m0 = u * 64 + 32 * hf, t_in_seq = m0 % SEQ;
            float w[4][8], bias[8];
#pragma unroll
            for (int q = 0; q < 4; ++q) { const f32x4 a = *(const f32x4*)(cw + q * CONV_DIM + c0), b = *(const f32x4*)(cw + q * CONV_DIM + c0 + 4);
                w[q][0] = a[0]; w[q][1] = a[1]; w[q][2] = a[2]; w[q][3] = a[3]; w[q][4] = b[0]; w[q][5] = b[1]; w[q][6] = b[2]; w[q][7] = b[3]; }
            { const f32x4 a = *(const f32x4*)(cb + c0), b = *(const f32x4*)(cb + c0 + 4); bias[0] = a[0]; bias[1] = a[1]; bias[2] = a[2]; bias[3] = a[3]; bias[4] = b[0]; bias[5] = b[1]; bias[6] = b[2]; bias[7] = b[3]; }
            float win[3][8];
#pragma unroll
            for (int q = 0; q < 3; ++q) {
                u32x4 r = (u32x4){0u, 0u, 0u, 0u};
                if (t_in_seq - 3 + q >= 0) r = *(const u32x4*)(projb + (size_t)(m0 - 3 + q) * PROJ_BLD + OFF_XBC + c0);
                win[q][0] = bf_lo(r.x); win[q][1] = bf_hi(r.x); win[q][2] = bf_lo(r.y); win[q][3] = bf_hi(r.y); win[q][4] = bf_lo(r.z); win[q][5] = bf_hi(r.z); win[q][6] = bf_lo(r.w); win[q][7] = bf_hi(r.w);
            }
            for (int i = 0; i < 32; ++i) {
                const u32x4 r = *(const u32x4*)(projb + (size_t)(m0 + i) * PROJ_BLD + OFF_XBC + c0);
                float cur[8] = {bf_lo(r.x), bf_hi(r.x), bf_lo(r.y), bf_hi(r.y), bf_lo(r.z), bf_hi(r.z), bf_lo(r.w), bf_hi(r.w)};
                float o[8];
#pragma unroll
                for (int e = 0; e < 8; ++e) { const float acc = bias[e] + w[0][e] * win[0][e] + w[1][e] * win[1][e] + w[2][e] * win[2][e] + w[3][e] * cur[e]; o[e] = fast_silu(acc);
                    win[0][e] = win[1][e]; win[1][e] = win[2][e]; win[2][e] = cur[e]; }
                u32x4 wv; wv.x = cvt_pk_bf16(o[0], o[1]); wv.y = cvt_pk_bf16(o[2], o[3]); wv.z = cvt_pk_bf16(o[4], o[5]); wv.w = cvt_pk_bf16(o[6], o[7]);
                *(u32x4*)(xbcc + (size_t)(m0 + i) * CONV_DIM + c0) = wv;
            }
        }
#pragma unroll
        for (int q = 0; q < 2; ++q) { const int idx = tid + 512 * q, m = u * 64 + (idx >> 4), h = idx & 15;
            const float x = bf2f(projb[(size_t)m * PROJ_BLD + OFF_DT + h]) + dt_bias[h];
            dtb[(size_t)m * SSD_H + h] = fmaxf(x, 0.f) + log1pf(expf(-fabsf(x))); }
    }
}

constexpr int SP = 136;
constexpr int SS_C = 0, SS_B = 34816, SS_BT = 69632, SS_XT = 104448, SS_XW = 113152, SS_HT = 121856, SS_AC = 130560, SS_DT = 131072, SS_END = 131584;
__device__ __forceinline__ void ssd_scan_phase(LAS unsigned char* lds, const bf16_t* xbcc, const float* dtb, const float* a_log, const float* dskip, float* yssd, const int vcu, const int G, const int tid) {
    const int wave = __builtin_amdgcn_readfirstlane(tid >> 6), lane = tid & 63, fr = lane & 15, fq = lane >> 4;
    LAS bf16_t* Cimg = (LAS bf16_t*)(lds + SS_C); LAS bf16_t* Bimg = (LAS bf16_t*)(lds + SS_B); LAS bf16_t* BTimg = (LAS bf16_t*)(lds + SS_BT);
    LAS bf16_t* xT = (LAS bf16_t*)(lds + SS_XT); LAS bf16_t* xwT = (LAS bf16_t*)(lds + SS_XW); LAS bf16_t* hT = (LAS bf16_t*)(lds + SS_HT);
    LAS float* acum = (LAS float*)(lds + SS_AC); LAS float* dtv = (LAS float*)(lds + SS_DT);
    for (int u = vcu; u < BATCH * SSD_H * 2; u += G) {
        const int b = u >> 5, h = (u >> 1) & 15, phalf = u & 1, g = h >> 3;
        const float Ah = -expf(a_log[h]) * 1.4426950408889634f;
        const float dsk = dskip[h];
        f32x4 hs[2] = {(f32x4){0.f, 0.f, 0.f, 0.f}, (f32x4){0.f, 0.f, 0.f, 0.f}};
        for (int i = tid; i < 32 * SP / 2; i += 512) ((LAS unsigned*)hT)[i] = 0u;
        const int row = tid >> 2, part = tid & 3;
        for (int ch = 0; ch < SEQ / 128; ++ch) {
            const int mrow0 = b * SEQ + ch * 128;
            u32x4 xr;
            {
                const bf16_t* src = xbcc + (size_t)(mrow0 + row) * CONV_DIM;
                u32x4 cv[4], bv[4];
#pragma unroll
                for (int j = 0; j < 4; ++j) { cv[j] = *(const u32x4*)(src + 1280 + g * 128 + 32 * part + 8 * j); bv[j] = *(const u32x4*)(src + 1024 + g * 128 + 32 * part + 8 * j); }
                xr = *(const u32x4*)(src + h * 64 + phalf * 32 + 8 * part);
                if (tid < 128) dtv[tid] = dtb[(size_t)(mrow0 + tid) * SSD_H + h];
#pragma unroll
                for (int j = 0; j < 4; ++j) { *(LAS u32x4*)(Cimg + row * SP + 32 * part + 8 * j) = cv[j]; *(LAS u32x4*)(Bimg + row * SP + 32 * part + 8 * j) = bv[j]; }
#pragma unroll
                for (int j = 0; j < 4; ++j) { const unsigned wv[4] = {bv[j].x, bv[j].y, bv[j].z, bv[j].w};
#pragma unroll
                    for (int e = 0; e < 4; ++e) { const int n = 32 * part + 8 * j + 2 * e; BTimg[n * SP + row] = (bf16_t)(wv[e] & 0xffffu); BTimg[(n + 1) * SP + row] = (bf16_t)(wv[e] >> 16); } }
            }
            __syncthreads();
            if (wave == 0) {
                const float v0 = dtv[2 * lane] * Ah, v1 = dtv[2 * lane + 1] * Ah;
                float s = v0 + v1;
#pragma unroll
                for (int o = 1; o < 64; o <<= 1) { const float t = __shfl_up(s, o); if (lane >= o) s += t; }
                acum[2 * lane] = s - v1; acum[2 * lane + 1] = s;
            }
            __syncthreads();
            const float atot = acum[127];
            {
                const float wgt = dtv[row] * __builtin_amdgcn_exp2f(atot - acum[row]);
                const unsigned wv[4] = {xr.x, xr.y, xr.z, xr.w};
#pragma unroll
                for (int e = 0; e < 4; ++e) { const int p = 8 * part + 2 * e; const float x0 = bf_lo(wv[e]), x1 = bf_hi(wv[e]);
                    xT[p * SP + row] = (bf16_t)(wv[e] & 0xffffu); xT[(p + 1) * SP + row] = (bf16_t)(wv[e] >> 16);
                    const unsigned pk = cvt_pk_bf16(x0 * wgt, x1 * wgt); xwT[p * SP + row] = (bf16_t)(pk & 0xffffu); xwT[(p + 1) * SP + row] = (bf16_t)(pk >> 16); }
            }
            f32x4 gacc[8];
#pragma unroll
            for (int st = 0; st < 8; ++st) gacc[st] = (f32x4){0.f, 0.f, 0.f, 0.f};
            {
                bf16x8 cf[4];
#pragma unroll
                for (int ks = 0; ks < 4; ++ks) cf[ks] = *(const LAS bf16x8*)(Cimg + (16 * wave + fr) * SP + 32 * ks + 8 * fq);
#pragma unroll
                for (int st = 0; st < 8; ++st) if (st <= wave) {
#pragma unroll
                    for (int ks = 0; ks < 4; ++ks) { const bf16x8 bfg = *(const LAS bf16x8*)(Bimg + (16 * st + fr) * SP + 32 * ks + 8 * fq);
                        gacc[st] = __builtin_amdgcn_mfma_f32_16x16x32_bf16(bfg, cf[ks], gacc[st], 0, 0, 0); }
                }
            }
            __syncthreads();
            {
                LAS bf16_t* Mimg = Bimg;
                const int l = 16 * wave + fr; const float al = acum[l];
#pragma unroll
                for (int st = 0; st < 8; ++st) if (st <= wave + 1) {
                    u32x2 wv = (u32x2){0u, 0u};
                    if (st <= wave) {
                        const f32x4 as4 = *(const LAS f32x4*)(acum + 16 * st + 4 * fq), dt4 = *(const LAS f32x4*)(dtv + 16 * st + 4 * fq);
                        float mv[4];
#pragma unroll
                        for (int r = 0; r < 4; ++r) { const int s = 16 * st + 4 * fq + r; mv[r] = (s <= l) ? gacc[st][r] * dt4[r] * __builtin_amdgcn_exp2f(al - as4[r]) : 0.f; }
                        wv.x = cvt_pk_bf16(mv[0], mv[1]); wv.y = cvt_pk_bf16(mv[2], mv[3]);
                    }
                    *(LAS u32x2*)(Mimg + l * SP + 16 * st + 4 * fq) = wv;
                }
            }
            __syncthreads();
            {
                const LAS bf16_t* Mimg = Bimg;
                f32x4 yd[2] = {(f32x4){0.f, 0.f, 0.f, 0.f}, (f32x4){0.f, 0.f, 0.f, 0.f}}, yo[2] = {(f32x4){0.f, 0.f, 0.f, 0.f}, (f32x4){0.f, 0.f, 0.f, 0.f}};
#pragma unroll
                for (int ks = 0; ks < 4; ++ks) {
                    const bf16x8 cfr = *(const LAS bf16x8*)(Cimg + (16 * wave + fr) * SP + 32 * ks + 8 * fq);
#pragma unroll
                    for (int pt = 0; pt < 2; ++pt) { const bf16x8 hf = *(const LAS bf16x8*)(hT + (16 * pt + fr) * SP + 32 * ks + 8 * fq);
                        yo[pt] = __builtin_amdgcn_mfma_f32_16x16x32_bf16(hf, cfr, yo[pt], 0, 0, 0); }
                    if (2 * ks <= wave) {
                        const bf16x8 mf = *(const LAS bf16x8*)(Mimg + (16 * wave + fr) * SP + 32 * ks + 8 * fq);
#pragma unroll
                        for (int pt = 0; pt < 2; ++pt) { const bf16x8 xf_ = *(const LAS bf16x8*)(xT + (16 * pt + fr) * SP + 32 * ks + 8 * fq);
                            yd[pt] = __builtin_amdgcn_mfma_f32_16x16x32_bf16(xf_, mf, yd[pt], 0, 0, 0); }
                    }
                }
                const int l = 16 * wave + fr; const float el = __builtin_amdgcn_exp2f(acum[l]);
#pragma unroll
                for (int pt = 0; pt < 2; ++pt) {
                    f32x4 o;
#pragma unroll
                    for (int r = 0; r < 4; ++r) o[r] = yd[pt][r] + el * yo[pt][r] + dsk * bf2f(xT[(16 * pt + 4 * fq + r) * SP + l]);
                    *(f32x4*)(yssd + (size_t)(mrow0 + l) * 1024 + h * 64 + phalf * 32 + 16 * pt + 4 * fq) = o;
                }
            }
            {
                const float ea = __builtin_amdgcn_exp2f(atot);
                hs[0] = hs[0] * ea; hs[1] = hs[1] * ea;
#pragma unroll
                for (int ks = 0; ks < 4; ++ks) {
                    const bf16x8 btf = *(const LAS bf16x8*)(BTimg + (16 * wave + fr) * SP + 32 * ks + 8 * fq);
#pragma unroll
                    for (int pt = 0; pt < 2; ++pt) { const bf16x8 xwf = *(const LAS bf16x8*)(xwT + (16 * pt + fr) * SP + 32 * ks + 8 * fq);
                        hs[pt] = __builtin_amdgcn_mfma_f32_16x16x32_bf16(btf, xwf, hs[pt], 0, 0, 0); }
                }
            }
            __syncthreads();
#pragma unroll
            for (int pt = 0; pt < 2; ++pt) { u32x2 wv; wv.x = cvt_pk_bf16(hs[pt][0], hs[pt][1]); wv.y = cvt_pk_bf16(hs[pt][2], hs[pt][3]);
                *(LAS u32x2*)(hT + (16 * pt + fr) * SP + 16 * wave + 4 * fq) = wv; }
        }
        __syncthreads();
    }
}

__device__ __forceinline__ void ssd_post_phase(const float* yssd, const bf16_t* projb, const float* norm_w, bf16_t* ymixb, const int gw, const int NGW, const int lane) {
    const int c0 = 16 * lane;
    f32x4 nw[4];
#pragma unroll
    for (int j = 0; j < 4; ++j) nw[j] = *(const f32x4*)(norm_w + c0 + 4 * j);
    for (int m = gw; m < M; m += NGW) {
        f32x4 y[4];
#pragma unroll
        for (int j = 0; j < 4; ++j) y[j] = *(const f32x4*)(yssd + (size_t)m * 1024 + c0 + 4 * j);
        const u32x4 z0 = *(const u32x4*)(projb + (size_t)m * PROJ_BLD + OFF_Z + c0), z1 = *(const u32x4*)(projb + (size_t)m * PROJ_BLD + OFF_Z + c0 + 8);
        const unsigned zw[8] = {z0.x, z0.y, z0.z, z0.w, z1.x, z1.y, z1.z, z1.w};
        float uu[16]; float ss = 0.f;
#pragma unroll
        for (int e = 0; e < 8; ++e) { uu[2 * e] = y[e >> 1][(2 * e) & 3] * fast_silu(bf_lo(zw[e])); uu[2 * e + 1] = y[e >> 1][(2 * e + 1) & 3] * fast_silu(bf_hi(zw[e])); ss += uu[2 * e] * uu[2 * e] + uu[2 * e + 1] * uu[2 * e + 1]; }
#pragma unroll
        for (int o = 1; o < 32; o <<= 1) ss += __shfl_xor(ss, o);
        const float rs = rsqrtf(ss * (1.f / 512.f) + 1e-5f);
        u32x4 w0, w1;
        w0.x = cvt_pk_bf16(uu[0] * rs * nw[0][0], uu[1] * rs * nw[0][1]); w0.y = cvt_pk_bf16(uu[2] * rs * nw[0][2], uu[3] * rs * nw[0][3]);
        w0.z = cvt_pk_bf16(uu[4] * rs * nw[1][0], uu[5] * rs * nw[1][1]); w0.w = cvt_pk_bf16(uu[6] * rs * nw[1][2], uu[7] * rs * nw[1][3]);
        w1.x = cvt_pk_bf16(uu[8] * rs * nw[2][0], uu[9] * rs * nw[2][1]); w1.y = cvt_pk_bf16(uu[10] * rs * nw[2][2], uu[11] * rs * nw[2][3]);
        w1.z = cvt_pk_bf16(uu[12] * rs * nw[3][0], uu[13] * rs * nw[3][1]); w1.w = cvt_pk_bf16(uu[14] * rs * nw[3][2], uu[15] * rs * nw[3][3]);
        *(u32x4*)(ymixb + (size_t)m * 2048 + c0) = w0; *(u32x4*)(ymixb + (size_t)m * 2048 + c0 + 8) = w1;
    }
}

__global__ void __launch_bounds__(NWAVES * 64, 2) fwd(Params P) {
    extern __shared__ __attribute__((aligned(16))) unsigned char lds_raw[];
    LAS unsigned char* lds = (LAS unsigned char*)lds_raw;
    volatile LAS unsigned* MISC = (volatile LAS unsigned*)(lds + MISC_OFF);
    const int tid_base = threadIdx.x;
    const int G = gridDim.x, bx = blockIdx.x;
    const int vcu = (G % 8 == 0) ? (bx % 8) * (G / 8) + bx / 8 : bx;
    const int NGW = G * NWAVES;
    unsigned char* ws = P.ws;
    unsigned* ctl = (unsigned*)(ws + WS_CTL);
    if (tid_base < 64) MISC[tid_base] = 0u;
    __syncthreads();
    const int lo = P.ph_lo, hi = P.ph_hi;
    XcdBarrier bar; bar.bar = ctl + CW_BAR + P.bar_idx * XCD_BAR_WORDS; bar.x = 0; bar.st = MISC + 8;
    if (hi - lo > 1) bar = xcd_barrier_post(ctl + CW_BAR + P.bar_idx * XCD_BAR_WORDS, MISC + 8);
#define IN(k) (lo <= (k) && (k) < hi)
#define SEAM(k) do { if ((k) + 1 < hi) xcd_barrier(bar); } while (0)

    bf16_t* Win_t = (bf16_t*)(ws + WS_WIN); bf16_t* Wout_t = (bf16_t*)(ws + WS_WOUT); bf16_t* Wffn = (bf16_t*)(ws + WS_WFFN);
    bf16_t* Wl_w = (bf16_t*)(ws + WS_WLORA); bf16_t* Wl_a = Wl_w + 1024 * 64; bf16_t* Wl_g = Wl_a + 1024 * 64; bf16_t* Wl_v = Wl_g + 1024 * 160;
    float* xf = (float*)(ws + WS_XF); bf16_t* xb = (bf16_t*)(ws + WS_XB);
    bf16_t* projb = (bf16_t*)(ws + WS_PROJB); bf16_t* ymixb = (bf16_t*)(ws + WS_YMIXB); float* mixed = (float*)(ws + WS_MIXED);
    bf16_t* hbuf = (bf16_t*)(ws + WS_HBUF); bf16_t* xg = (bf16_t*)(ws + WS_XG); float* yslot = (float*)(ws + WS_YSLOT);
    bf16_t* xbcc = (bf16_t*)(ws + WS_XBCC); float* dtb = (float*)(ws + WS_DTB); float* yssd = (float*)(ws + WS_YSSD);
    bf16_t* lw = (bf16_t*)(ws + WS_LW); float* yrw = (float*)(ws + WS_YRW); float* bon = (float*)(ws + WS_BON); float* vfirst = (float*)(ws + WS_VFIRST);
    int* tok_e = (int*)(ws + WS_TOK); int* tok_pos = tok_e + 2 * M; float* tok_g = (float*)(tok_pos + 2 * M); int* tok_dest = (int*)(tok_g + 2 * M);

    const int tid0 = tid_base;
    for (int l = 0; l < 4; ++l) {
        int tid = tid0; asm volatile("" : "+v"(tid));
        const int lane = tid & 63, wave = __builtin_amdgcn_readfirstlane(tid >> 6); const int gw = vcu * NWAVES + wave;
        const int pb = l * 16, li = l >> 1; const bool moe = (l & 1) != 0;
        int* cnt = (int*)(ctl + CW_CNT + 8 * li);
        if (IN(pb + 0)) {
            LAS float* scr = (LAS float*)(lds + wave * 16384);
            cvt_job<0>(P.in[1] + (size_t)l * D * IN_DIM, D, IN_DIM, Win_t, 0, 0, scr, gw, NGW, lane);
            if (l > 0) cvt_job<0>(P.in[2] + (size_t)(l - 1) * D * 32, D, 32, Win_t, IN_DIM, 0, scr, gw, NGW, lane);
            { const int r0 = l > 0 ? IN_DIM + 32 : IN_DIM, nz = (PROJ_BLD - r0) * (D / 8);
              for (int i = bx * 512 + tid; i < nz; i += G * 512) *(u32x4*)(Win_t + (size_t)r0 * D + (size_t)i * 8) = (u32x4){0u, 0u, 0u, 0u}; }
            cvt_job<0>(P.in[23] + (size_t)l * D * D, D, D, Wout_t, 0, 0, scr, gw, NGW, lane);
            cvt_job<0>(P.in[12] + (size_t)l * 64 * 1024, 64, 1024, Wl_w, 0, 0, scr, gw, NGW, lane);
            cvt_job<0>(P.in[14] + (size_t)l * 64 * 1024, 64, 1024, Wl_a, 0, 0, scr, gw, NGW, lane);
            cvt_job<0>(P.in[17] + (size_t)l * 160 * 1024, 160, 1024, Wl_g, 0, 0, scr, gw, NGW, lane);
            if (l > 0) cvt_job<0>(P.in[16] + (size_t)(l - 1) * 32 * 1024, 32, 1024, Wl_v, 0, 0, scr, gw, NGW, lane);
            if (l == 0) {
                const float* x = P.in[0];
                for (size_t i = (size_t)bx * 512 + tid; i < (size_t)M * D / 8; i += (size_t)G * 512) {
                    const f32x4 a = *(const f32x4*)(x + i * 8), b = *(const f32x4*)(x + i * 8 + 4);
                    u32x4 w; w.x = cvt_pk_bf16(a[0], a[1]); w.y = cvt_pk_bf16(a[2], a[3]); w.z = cvt_pk_bf16(b[0], b[1]); w.w = cvt_pk_bf16(b[2], b[3]);
                    *(u32x4*)(xb + i * 8) = w; }
            }
            __syncthreads();
            SEAM(pb + 0);
        }
        if (IN(pb + 1)) {
            pg8::Gemm g{xb, Win_t, D}; pg8::StaticOrder S; S.init(M, PROJ_BLD, G, bx);
            pg8::EpiBf16 E{projb, PROJ_BLD};
            pg8::gemm_phase<pg8::EpiBf16, pg8::StaticOrder>(lds, g, S, E, tid);
            SEAM(pb + 1);
        }
        if (IN(pb + 2)) {
            lora_phase(lds, projb, P.in[9] + (size_t)l * RW_SHIFT, P.in[10] + (size_t)(l > 0 ? l - 1 : 0) * 32, Wl_w, Wl_a, Wl_g, Wl_v, lw, l > 0, vcu, G, tid);
            ssd_conv_phase(projb, P.in[3] + (size_t)l * 4 * CONV_DIM, P.in[4] + (size_t)l * CONV_DIM, P.in[5] + l * SSD_H, xbcc, dtb, vcu, G, tid);
            SEAM(pb + 2);
        }
        if (IN(pb + 3)) {
            RwScan a; a.projb = projb; a.lw = lw; a.mix = P.in[9] + (size_t)l * RW_SHIFT; a.w0 = P.in[11] + l * 1024; a.a0 = P.in[13] + l * 1024; a.v0 = P.in[15] + (l > 0 ? l - 1 : 0) * 1024;
            a.k_k = P.in[18] + l * 1024; a.k_a = P.in[19] + l * 1024; a.r_k = P.in[20] + l * 1024; a.vfirst = vfirst; a.yrw = yrw; a.bon = bon; a.layer = l; a.pad = 0;
            rwkv_scan_phase(lds, a, vcu, G, tid);
            ssd_scan_phase(lds, xbcc, dtb, P.in[6] + l * SSD_H, P.in[7] + l * SSD_H, yssd, vcu, G, tid);
            SEAM(pb + 3);
        }
        if (IN(pb + 4)) {
            rwkv_post_phase(yrw, bon, lw + (size_t)2 * M * 1024, P.in[21] + l * 1024, P.in[22] + l * 1024, ymixb, gw, NGW, lane);
            ssd_post_phase(yssd, projb, P.in[8] + l * 1024, ymixb, gw, NGW, lane);
            SEAM(pb + 4);
        }
        if (IN(pb + 5)) {
            pg8::Gemm g{ymixb, Wout_t, D}; pg8::StaticOrder S; S.init(M, D, G, bx);
            pg8::EpiF32 E{mixed, D};
            pg8::gemm_phase<pg8::EpiF32, pg8::StaticOrder>(lds, g, S, E, tid);
            SEAM(pb + 5);
        }
        if (IN(pb + 6)) {
            const float* xin = (l == 0) ? P.in[0] : xf;
            const float* gam = P.in[24] + l * D; const float* bet = P.in[25] + l * D;
            LAS float* rs = (LAS float*)lds;
            if (moe) { const float* router = P.in[31] + (size_t)li * D * NE;
                for (int i = tid; i < D * NE; i += 512) rs[(i & 7) * D + (i >> 3)] = router[i];
                __syncthreads(); }
            for (int m = gw; m < M; m += NGW) {
                f32x4 v[8];
#pragma unroll
                for (int j = 0; j < 8; ++j) { const size_t o = (size_t)m * D + 4 * lane + 256 * j; v[j] = ALPHA * *(const f32x4*)(xin + o) + *(const f32x4*)(mixed + o); }
                ln_finish(v, gam, bet, lane, xf + (size_t)m * D, xb + (size_t)m * D);
                if (moe) {
                    float lg[8];
#pragma unroll
                    for (int e = 0; e < 8; ++e) { float s = 0.f;
#pragma unroll
                        for (int j = 0; j < 8; ++j) { const f32x4 r = *(const LAS f32x4*)(rs + e * D + 4 * lane + 256 * j); s += (v[j][0] * r[0] + v[j][1] * r[1]) + (v[j][2] * r[2] + v[j][3] * r[3]); }
                        lg[e] = wave_sum_f(s); }
                    if (lane == 0) {
                        int i0 = 0; float v0 = lg[0];
#pragma unroll
                        for (int e = 1; e < 8; ++e) if (lg[e] > v0) { v0 = lg[e]; i0 = e; }
                        int i1 = -1; float v1 = -3.4e38f;
#pragma unroll
                        for (int e = 0; e < 8; ++e) if (e != i0 && lg[e] > v1) { v1 = lg[e]; i1 = e; }
                        const float e1 = expf(v1 - v0);
                        tok_e[2 * m] = i0; tok_e[2 * m + 1] = i1; tok_g[2 * m] = 1.f / (1.f + e1); tok_g[2 * m + 1] = e1 / (1.f + e1);
                        tok_pos[2 * m] = atomicAdd(&cnt[i0], 1); tok_pos[2 * m + 1] = atomicAdd(&cnt[i1], 1);
                    }
                }
            }
            __syncthreads();
            SEAM(pb + 6);
        }
        if (IN(pb + 7)) {
            LAS float* scr = (LAS float*)(lds + wave * 16384);
            if (!moe) {
                cvt_job<1>(P.in[28] + (size_t)li * D * DFF, D, DFF, Wffn, 0, 0, scr, gw, NGW, lane);
                cvt_job<1>(P.in[29] + (size_t)li * D * DFF, D, DFF, Wffn, 0, 1, scr, gw, NGW, lane);
                cvt_job<0>(P.in[30] + (size_t)li * DFF * D, DFF, D, Wffn + (size_t)2 * DFF * D, 0, 0, scr, gw, NGW, lane);
            } else {
                for (int e = 0; e < NE; ++e) {
                    cvt_job<1>(P.in[32] + ((size_t)li * NE + e) * D * DFE, D, DFE, Wffn, e * 2 * DFE, 0, scr, gw, NGW, lane);
                    cvt_job<1>(P.in[33] + ((size_t)li * NE + e) * D * DFE, D, DFE, Wffn, e * 2 * DFE, 1, scr, gw, NGW, lane);
                    cvt_job<0>(P.in[34] + ((size_t)li * NE + e) * DFE * D, DFE, D, Wffn + (size_t)NE * 2 * DFE * D, e * D, 0, scr, gw, NGW, lane);
                }
                int start[8]; { int acc = 0;
#pragma unroll
                    for (int e = 0; e < 8; ++e) { start[e] = acc; acc += ((cnt[e] + 255) >> 8) << 8; } }
                for (int m = gw; m < M; m += NGW) {
                    u32x4 r[4];
#pragma unroll
                    for (int j = 0; j < 4; ++j) r[j] = *(const u32x4*)(xb + (size_t)m * D + 8 * lane + 512 * j);
#pragma unroll
                    for (int s = 0; s < 2; ++s) {
                        const int e = tok_e[2 * m + s], pos = tok_pos[2 * m + s];
                        int st = 0;
#pragma unroll
                        for (int q = 0; q < 8; ++q) st = (e == q) ? start[q] : st;
                        const int dest = st + pos;
#pragma unroll
                        for (int j = 0; j < 4; ++j) *(u32x4*)(xg + (size_t)dest * D + 8 * lane + 512 * j) = r[j];
                        if (lane == 0) tok_dest[2 * m + s] = dest;
                    }
                }
            }
            __syncthreads();
            SEAM(pb + 7);
        }
        if (IN(pb + 8)) {
            if (!moe) {
                pg8::Gemm g{xb, Wffn, D}; pg8::StaticOrder S; S.init(M, 2 * DFF, G, bx);
                pg8::EpiSwiglu E{hbuf, DFF};
                pg8::gemm_phase<pg8::EpiSwiglu, pg8::StaticOrder>(lds, g, S, E, tid);
            } else {
                pg8::Gemm g{xg, Wffn, D}; pg8::GroupedOrder S; S.init(cnt, 2 * DFE, G, bx);
                pg8::EpiSwiglu E{hbuf, DFE};
                pg8::gemm_phase<pg8::EpiSwiglu, pg8::GroupedOrder>(lds, g, S, E, tid);
            }
            SEAM(pb + 8);
        }
        if (IN(pb + 9)) {
            if (!moe) {
                pg8::Gemm g{hbuf, Wffn + (size_t)2 * DFF * D, DFF}; pg8::StaticOrder S; S.init(M, D, G, bx);
                pg8::EpiF32 E{yslot, D};
                pg8::gemm_phase<pg8::EpiF32, pg8::StaticOrder>(lds, g, S, E, tid);
            } else {
                pg8::Gemm g{hbuf, Wffn + (size_t)NE * 2 * DFE * D, DFE}; pg8::GroupedOrder S; S.init(cnt, D, G, bx);
                pg8::EpiF32 E{yslot, D};
                pg8::gemm_phase<pg8::EpiF32, pg8::GroupedOrder>(lds, g, S, E, tid);
            }
            SEAM(pb + 9);
        }
        if (IN(pb + 10)) {
            const float* gam = P.in[26] + l * D; const float* bet = P.in[27] + l * D;
            float* dst = (l == 3) ? P.out : xf;
            for (int m = gw; m < M; m += NGW) {
                f32x4 v[8];
                if (!moe) {
#pragma unroll
                    for (int j = 0; j < 8; ++j) { const size_t o = (size_t)m * D + 4 * lane + 256 * j; v[j] = ALPHA * *(const f32x4*)(xf + o) + *(const f32x4*)(yslot + o); }
                } else {
                    const int d0 = tok_dest[2 * m], d1 = tok_dest[2 * m + 1]; const float g0 = tok_g[2 * m], g1 = tok_g[2 * m + 1];
#pragma unroll
                    for (int j = 0; j < 8; ++j) { const int c = 4 * lane + 256 * j;
                        v[j] = ALPHA * *(const f32x4*)(xf + (size_t)m * D + c) + g0 * *(const f32x4*)(yslot + (size_t)d0 * D + c) + g1 * *(const f32x4*)(yslot + (size_t)d1 * D + c); }
                }
                ln_finish(v, gam, bet, lane, dst + (size_t)m * D, (l == 3) ? (bf16_t*)nullptr : xb + (size_t)m * D);
            }
            SEAM(pb + 10);
        }
    }
#undef IN
#undef SEAM
}


}

extern "C" void kernel_launch(void* const* d_in, const int* in_sizes, int n_in, void* d_out, int out_size, void* d_ws, size_t ws_size, hipStream_t stream) {
    (void)in_sizes; (void)out_size;
    static int grid = 0;
    if (grid == 0) {
        if (n_in != 35 || ws_size < WS_END) { fprintf(stderr, "kernel_launch: need 35 inputs and %zu bytes of workspace (got %d, %zu)\n", (size_t)WS_END, n_in, ws_size); grid = -1; return; }
        int dev = 0, cus = 0;
        if (hipGetDevice(&dev) != hipSuccess || hipDeviceGetAttribute(&cus, hipDeviceAttributeMultiprocessorCount, dev) != hipSuccess) { grid = -1; return; }
        if (hipFuncSetAttribute((const void*)fwd, hipFuncAttributeMaxDynamicSharedMemorySize, LDS_BYTES) != hipSuccess) { fprintf(stderr, "kernel_launch: hipFuncSetAttribute failed\n"); grid = -1; return; }
        int per_cu = 0;
        if (hipOccupancyMaxActiveBlocksPerMultiprocessor(&per_cu, (const void*)fwd, NWAVES * 64, LDS_BYTES) != hipSuccess || per_cu < 1) { fprintf(stderr, "kernel_launch: occupancy query says %d blocks per CU\n", per_cu); }
        (void)hipGetLastError();
        grid = cus;
    }
    if (grid < 0) return;
    unsigned char* ws = (unsigned char*)d_ws;
    (void)hipMemsetAsync(ws + WS_CTL, 0, CTL_BYTES, stream);
    Params P{};
    for (int i = 0; i < 35; ++i) P.in[i] = (const float*)d_in[i];
    P.out = (float*)d_out; P.ws = ws; P.pad = 0;
    int nbar = 0;
    auto run = [&](int lo, int hi) {
        P.ph_lo = lo; P.ph_hi = hi; P.bar_idx = (hi - lo > 1) ? nbar++ : 0;
        hipLaunchKernelGGL(fwd, dim3(grid), dim3(NWAVES * 64), LDS_BYTES, stream, P);
    };
#ifndef MK_LAUNCH_MODE
#define MK_LAUNCH_MODE 1
#endif
    if (MK_LAUNCH_MODE == 1) run(0, 64);
    else if (MK_LAUNCH_MODE == 4) { for (int l = 0; l < 4; ++l) run(l * 16, l * 16 + 16); }
    else { for (int l = 0; l < 4; ++l) for (int k = 0; k <= 10; ++k) run(l * 16 + k, l * 16 + k + 1); }
}
```

```cpp
#define MK_DBL 0
#include <hip/hip_runtime.h>
#include <cstdint>
#include <cstdio>

namespace {
constexpr int BATCH = 8, SEQ = 2048, M = BATCH * SEQ, D = 2048;
constexpr int HD = 64, SSD_H = 16, SSD_N = 128, CONV_DIM = 1536;
constexpr int RW_H = 16;
constexpr int IN_DIM = 5936, PROJ_LD = 5968;
constexpr int OFF_Z = 0, OFF_XBC = 1024, OFF_DT = 2560, OFF_RW = 2576, OFF_R = 2576, OFF_K = 3600, OFF_V = 4624, OFF_WLO = 5648, OFF_ALO = 5712, OFF_GLO = 5776, OFF_VLO = 5936;
constexpr int RW_SHIFT = 3360;
constexpr int DFF = 5632, NE = 8, DFE = 2816;
constexpr float ALPHA = 1.681792830507429f;
constexpr int LORA_LD = 320;

__device__ __forceinline__ float sigmoidf_(float x) { return 1.f / (1.f + expf(-x)); }
__device__ __forceinline__ float siluf_(float x) { return x / (1.f + expf(-x)); }
__device__ __forceinline__ float softplusf_(float x) { return fmaxf(x, 0.f) + log1pf(expf(-fabsf(x))); }
__device__ __forceinline__ float wave_sum(float v) {
#pragma unroll
    for (int o = 32; o >= 1; o >>= 1) v += __shfl_xor(v, o);
    return v;
}


#define LAS __attribute__((address_space(3)))
typedef unsigned short bf16_t;
typedef short bf16x8 __attribute__((ext_vector_type(8)));
typedef float f32x4 __attribute__((ext_vector_type(4)));
typedef float f32x2 __attribute__((ext_vector_type(2)));
typedef unsigned u32x4 __attribute__((ext_vector_type(4)));
typedef unsigned u32x2 __attribute__((ext_vector_type(2)));

__device__ __forceinline__ unsigned cvt_pk_bf16(float lo, float hi) { unsigned r; asm volatile("v_cvt_pk_bf16_f32 %0, %1, %2" : "=v"(r) : "v"(lo), "v"(hi)); return r; }
__device__ __forceinline__ float bf_lo(unsigned w) { return __uint_as_float(w << 16); }
__device__ __forceinline__ float bf_hi(unsigned w) { return __uint_as_float(w & 0xffff0000u); }
__device__ __forceinline__ float bf2f(bf16_t b) { return __uint_as_float(((unsigned)b) << 16); }
__device__ __forceinline__ float fast_silu(float x) { return x * __builtin_amdgcn_rcpf(1.f + __builtin_amdgcn_exp2f(-1.4426950408889634f * x)); }

namespace pg8 {
constexpr int BM = 256, BK = 64, HALF = 128, HTB = HALF * BK * 2, STAGE_BYTES = 8 * HTB, NXCD = 8, WGM = 8;
__host__ __device__ __forceinline__ int lds_byte(int r, int c) { const int st = (r >> 4) * 2 + (c >> 5), rr = r & 15, cc = c & 31, ob = rr * 64 + cc * 2; return st * 1024 + (ob ^ (((ob >> 9) & 1) << 5)); }
__host__ __device__ __forceinline__ void stage_rc(int b, int& R, int& C) { const int st = b / 1024, sb = b % 1024, swz = sb ^ (((sb >> 9) & 1) << 5); R = (st >> 1) * 16 + swz / 64; C = (st & 1) * 32 + (swz % 64) / 2; }
__host__ __device__ __forceinline__ int perm32(int rho) { const int n = rho >> 4, i = rho & 15; return 8 * (i >> 2) + 4 * n + (i & 3); }

struct Unit { int pm, pn, pb; };
struct Gemm { const bf16_t* A; const bf16_t* Bt; int K; };

__device__ __forceinline__ void decode_unit(int wgid, int nM, int nN, int& pm, int& pn) {
    const int nwg = nM * nN;
    { const int q = nwg / NXCD, r = nwg % NXCD, xcd = wgid % NXCD, off = wgid / NXCD; wgid = (xcd < r ? xcd * (q + 1) : r * (q + 1) + (xcd - r) * q) + off; }
    const int nig = WGM * nN, gid = wgid / nig, fm = gid * WGM, gsz = (nM - fm) < WGM ? (nM - fm) : WGM;
    pm = fm + ((wgid % nig) % gsz); pn = (wgid % nig) / gsz;
}
struct StaticOrder {
    int nM, nN, nwg, G, c;
    __device__ void init(int Mrows, int N, int G_, int c_) { nM = Mrows / BM; nN = N / BM; nwg = nM * nN; G = G_; c = c_; }
    __device__ __forceinline__ bool next(int i, Unit& u) const {
        const long L = (long)i * G + c; if (L >= nwg) return false;
        decode_unit((int)L, nM, nN, u.pm, u.pn); u.pb = u.pn; return true;
    }
};
struct GroupedOrder {
    int nM, nN, nwg, G, c; int cum[9];
    __device__ void init(const int* cnt, int N, int G_, int c_) {
        int acc = 0;
#pragma unroll
        for (int e = 0; e < 8; ++e) { cum[e] = acc; acc += (cnt[e] + 255) >> 8; }
        cum[8] = acc; nM = acc; nN = N / BM; nwg = nM * nN; G = G_; c = c_;
    }
    __device__ __forceinline__ bool next(int i, Unit& u) const {
        const long L = (long)i * G + c; if (L >= nwg) return false;
        decode_unit((int)L, nM, nN, u.pm, u.pn);
        int e = 0;
#pragma unroll
        for (int q = 1; q < 8; ++q) e += (u.pm >= cum[q]) ? 1 : 0;
        u.pb = e * nN + u.pn; return true;
    }
};

struct EpiF32 {
    static constexpr bool PERM = false;
    float* C; int ldc;
    __device__ __forceinline__ void operator()(const f32x4 (&acc)[2][2][4][2], const Unit& u, int wr, int wc, int fr, int fq) const {
        const int row0 = u.pm * BM + wr * 64 + fr, col0 = u.pn * BM + wc * 32 + 4 * fq;
#pragma unroll
        for (int ai = 0; ai < 2; ++ai)
#pragma unroll
            for (int m = 0; m < 4; ++m) { float* rowp = C + (size_t)(row0 + ai * HALF + m * 16) * ldc + col0;
#pragma unroll
                for (int bj = 0; bj < 2; ++bj)
#pragma unroll
                    for (int n = 0; n < 2; ++n) *(f32x4*)(rowp + bj * HALF + n * 16) = acc[ai][bj][m][n]; }
    }
};
struct EpiBf16 {
    static constexpr bool PERM = true;
    bf16_t* O; int ldc;
    __device__ __forceinline__ void operator()(const f32x4 (&acc)[2][2][4][2], const Unit& u, int wr, int wc, int fr, int fq) const {
        const int row0 = u.pm * BM + wr * 64 + fr, col0 = u.pn * BM + wc * 32 + 8 * fq;
#pragma unroll
        for (int ai = 0; ai < 2; ++ai)
#pragma unroll
            for (int m = 0; m < 4; ++m) { bf16_t* rowp = O + (size_t)(row0 + ai * HALF + m * 16) * ldc + col0;
#pragma unroll
                for (int bj = 0; bj < 2; ++bj) { const f32x4 v0 = acc[ai][bj][m][0], v1 = acc[ai][bj][m][1];
                    u32x4 w; w.x = cvt_pk_bf16(v0[0], v0[1]); w.y = cvt_pk_bf16(v0[2], v0[3]); w.z = cvt_pk_bf16(v1[0], v1[1]); w.w = cvt_pk_bf16(v1[2], v1[3]);
                    *(u32x4*)(rowp + bj * HALF) = w; } }
    }
};
struct EpiSwiglu {
    static constexpr bool PERM = true;
    bf16_t* O; int ldc;
    __device__ __forceinline__ void operator()(const f32x4 (&acc)[2][2][4][2], const Unit& u, int wr, int wc, int fr, int fq) const {
        const int row0 = u.pm * BM + wr * 64 + fr, col0 = u.pn * HALF + wc * 32 + 8 * fq;
#pragma unroll
        for (int ai = 0; ai < 2; ++ai)
#pragma unroll
            for (int m = 0; m < 4; ++m) { bf16_t* rowp = O + (size_t)(row0 + ai * HALF + m * 16) * ldc + col0;
                float o[8];
#pragma unroll
                for (int n = 0; n < 2; ++n)
#pragma unroll
                    for (int i = 0; i < 4; ++i) o[n * 4 + i] = fast_silu(acc[ai][0][m][n][i]) * acc[ai][1][m][n][i];
                u32x4 w; w.x = cvt_pk_bf16(o[0], o[1]); w.y = cvt_pk_bf16(o[2], o[3]); w.z = cvt_pk_bf16(o[4], o[5]); w.w = cvt_pk_bf16(o[6], o[7]);
                *(u32x4*)rowp = w; }
    }
};

template <class Epi, class Sched>
__device__ __forceinline__ void gemm_phase(LAS unsigned char* lds, const Gemm g, const Sched& S, const Epi& E, const int tid) {
    const int wid = __builtin_amdgcn_readfirstlane(tid >> 6), lane = tid & 63, wr = wid >> 2, wc = wid & 3, fr = lane & 15, fq = lane >> 4;
    const int K = g.K, nt = K / BK;
    unsigned voffA[2], voffB[2];
#pragma unroll
    for (int i = 0; i < 2; ++i) { int R, C; stage_rc(tid * 16 + i * 8192, R, C); const int Rb = Epi::PERM ? ((R & ~31) + perm32(R & 31)) : R;
        voffA[i] = (unsigned)(R * K + C) * 2u; voffB[i] = (unsigned)(Rb * K + C) * 2u; }
    const size_t kstep = (size_t)(BK * 2);
    const size_t hstep = (size_t)HALF * K * 2;
    const size_t tstep = 2 * hstep;
    const unsigned ldsw = (unsigned)wid * 1024u;
    const int aoff = lds_byte(wr * 64 + fr, fq * 8), boff = lds_byte(wc * 32 + fr, fq * 8);
#define PG8_SA(b, h) (((b) * 2 + (h)) * HTB)
#define PG8_SB(b, h) ((4 + (b) * 2 + (h)) * HTB)
#define PG8_STAGE(bufoff, gbase, voff) do { _Pragma("unroll") for (int _i = 0; _i < 2; ++_i) \
        __builtin_amdgcn_global_load_lds((const unsigned*)((const char*)(gbase) + (voff)[_i]), (LAS unsigned*)(lds + (bufoff) + ldsw + _i * 8192), 16, 0, 0); } while (0)
#define PG8_LDA(dst, b, h) do { _Pragma("unroll") for (int m = 0; m < 4; ++m) _Pragma("unroll") for (int k = 0; k < 2; ++k) dst[m][k] = *(const LAS bf16x8*)(lds + PG8_SA(b, h) + aoff + m * 2048 + k * 1024); } while (0)
#define PG8_LDB(dst, b, h) do { _Pragma("unroll") for (int n = 0; n < 2; ++n) _Pragma("unroll") for (int k = 0; k < 2; ++k) dst[n][k] = *(const LAS bf16x8*)(lds + PG8_SB(b, h) + boff + n * 2048 + k * 1024); } while (0)
#define PG8_MMA(ai, bj, At, Bt) do { __builtin_amdgcn_s_setprio(1); _Pragma("unroll") for (int m = 0; m < 4; ++m) _Pragma("unroll") for (int n = 0; n < 2; ++n) _Pragma("unroll") for (int k = 0; k < 2; ++k) \
        acc[ai][bj][m][n] = __builtin_amdgcn_mfma_f32_16x16x32_bf16(Bt[n][k], At[m][k], acc[ai][bj][m][n], 0, 0, 0); __builtin_amdgcn_s_setprio(0); } while (0)
#define PG8_WAIT_V(n) asm volatile("s_waitcnt vmcnt(" #n ")" ::: "memory")
#define PG8_WAIT_L(n) asm volatile("s_waitcnt lgkmcnt(" #n ")" ::: "memory")
#define PG8_BAR __builtin_amdgcn_s_barrier()
#define PG8_SCHED __builtin_amdgcn_sched_barrier(0)
    Unit cur, nxt; int ui = 0;
    if (!S.next(0, cur)) return;
    f32x4 acc[2][2][4][2];
#pragma unroll
    for (int a = 0; a < 2; ++a)
#pragma unroll
        for (int b = 0; b < 2; ++b)
#pragma unroll
            for (int m = 0; m < 4; ++m)
#pragma unroll
                for (int n = 0; n < 2; ++n) acc[a][b][m][n] = (f32x4){0.f, 0.f, 0.f, 0.f};
    bf16x8 At[4][2], B0[2][2], B1[2][2];
    const char* cA = (const char*)g.A + (size_t)cur.pm * tstep; const char* cB = (const char*)g.Bt + (size_t)cur.pb * tstep;
    PG8_STAGE(PG8_SB(0, 0), cB, voffB); PG8_STAGE(PG8_SB(0, 1), cB + hstep, voffB); PG8_STAGE(PG8_SA(0, 0), cA, voffA); PG8_STAGE(PG8_SA(0, 1), cA + hstep, voffA);
    if (wr == 1) PG8_BAR;
    PG8_WAIT_V(2); PG8_BAR;
    PG8_STAGE(PG8_SB(1, 0), cB + kstep, voffB); PG8_STAGE(PG8_SA(1, 0), cA + kstep, voffA); PG8_STAGE(PG8_SB(1, 1), cB + hstep + kstep, voffB);
    PG8_WAIT_V(6); PG8_BAR;
    for (;;) {
        const bool has_next = S.next(ui + 1, nxt);
        const char* nA = has_next ? (const char*)g.A + (size_t)nxt.pm * tstep : cA; const char* nB = has_next ? (const char*)g.Bt + (size_t)nxt.pb * tstep : cB;
        for (int t = 0; t < nt; t += 2) {
            const bool last = (t == nt - 2);
            const char* a1 = cA + (size_t)(t + 1) * kstep;
            const char* a2 = last ? nA : cA + (size_t)(t + 2) * kstep; const char* b2 = last ? nB : cB + (size_t)(t + 2) * kstep;
            const char* a3 = a2 + kstep; const char* b3 = b2 + kstep;
            PG8_LDB(B0, 0, 0); PG8_LDB(B1, 0, 1); PG8_SCHED; PG8_LDA(At, 0, 0); PG8_STAGE(PG8_SA(1, 1), a1 + hstep, voffA);
            PG8_WAIT_V(8); PG8_WAIT_L(0); PG8_BAR; PG8_MMA(0, 0, At, B0); PG8_MMA(0, 1, At, B1); PG8_BAR; PG8_SCHED;
            PG8_LDA(At, 0, 1); PG8_STAGE(PG8_SB(0, 0), b2, voffB); PG8_STAGE(PG8_SB(0, 1), b2 + hstep, voffB); PG8_STAGE(PG8_SA(0, 0), a2, voffA);
            PG8_WAIT_V(8); PG8_WAIT_L(0); PG8_BAR; PG8_MMA(1, 0, At, B0); PG8_MMA(1, 1, At, B1); PG8_BAR; PG8_SCHED;
            PG8_LDB(B0, 1, 0); PG8_LDB(B1, 1, 1); PG8_SCHED; PG8_LDA(At, 1, 0); PG8_STAGE(PG8_SA(0, 1), a2 + hstep, voffA);
            PG8_WAIT_V(8); PG8_WAIT_L(0); PG8_BAR; PG8_MMA(0, 0, At, B0); PG8_MMA(0, 1, At, B1); PG8_BAR; PG8_SCHED;
            PG8_LDA(At, 1, 1); PG8_STAGE(PG8_SB(1, 0), b3, voffB); PG8_STAGE(PG8_SB(1, 1), b3 + hstep, voffB); PG8_STAGE(PG8_SA(1, 0), a3, voffA);
            PG8_WAIT_V(8); PG8_WAIT_L(0); PG8_BAR; PG8_MMA(1, 0, At, B0); PG8_MMA(1, 1, At, B1); PG8_BAR; PG8_SCHED;
        }
        if (wr == 0) PG8_BAR;
        E(acc, cur, wr, wc, fr, fq);
        if (!has_next) break;
#pragma unroll
        for (int a = 0; a < 2; ++a)
#pragma unroll
            for (int b = 0; b < 2; ++b)
#pragma unroll
                for (int m = 0; m < 4; ++m)
#pragma unroll
                    for (int n = 0; n < 2; ++n) acc[a][b][m][n] = (f32x4){0.f, 0.f, 0.f, 0.f};
        cur = nxt; cA = nA; cB = nB; ++ui;
        if (wr == 1) PG8_BAR;
    }
    PG8_WAIT_V(0);
    PG8_BAR;
#undef PG8_SA
#undef PG8_SB
#undef PG8_STAGE
#undef PG8_LDA
#undef PG8_LDB
#undef PG8_MMA
#undef PG8_WAIT_V
#undef PG8_WAIT_L
#undef PG8_BAR
#undef PG8_SCHED
}
}

#define XB_TMO      128
#define XB_XCNT(j)  (256  + 64 * (j))
#define XB_XSUB(j)  (1280 + 64 * (j))
#define XB_XGEN(j)  (2304 + 64 * (j))
#define XB_TOP      3328
#define XB_TOPGEN   3392
#define XCD_BAR_WORDS 3456
#define XB_SPIN_CAP (1u << 18)
__device__ __forceinline__ unsigned xb_ld(unsigned* p)              { return __hip_atomic_load(p, __ATOMIC_RELAXED, __HIP_MEMORY_SCOPE_AGENT); }
__device__ __forceinline__ unsigned xb_add(unsigned* p, unsigned v) { return __hip_atomic_fetch_add(p, v, __ATOMIC_RELAXED, __HIP_MEMORY_SCOPE_AGENT); }
__device__ __forceinline__ unsigned xb_xcc_id() { return (unsigned)__builtin_amdgcn_s_getreg((3 << 11) | 20) & 0xFu; }
#define XB_SPIN(cond, bar) do { unsigned _sp = 0; while (cond) { __builtin_amdgcn_s_sleep(1); \
    if ((++_sp & 255u) == 0u) { if (xb_ld(&(bar)[XB_TMO])) break; if (_sp > XB_SPIN_CAP) { atomicAdd(&(bar)[XB_TMO], 1u); break; } } } } while (0)
struct XcdBarrier { unsigned* bar; unsigned x; volatile LAS unsigned* st; };
__device__ __forceinline__ XcdBarrier xcd_barrier_post(unsigned* bar, volatile LAS unsigned* st) {
    XcdBarrier b; b.bar = bar; b.x = xb_xcc_id(); b.st = st;
    if (threadIdx.x == 0) (void)xb_add(&bar[XB_XCNT(b.x)], 1u);
    return b;
}
__device__ __forceinline__ void xcd_barrier_complete(unsigned* bar, unsigned x, unsigned& nloc, unsigned& nx) {
    const unsigned G = gridDim.x * gridDim.y * gridDim.z;
    asm volatile("" : "+s"(x));
    unsigned sum, cnt, mine, sp = 0u;
    for (;;) {
        sum = 0u; cnt = 0u; mine = 0u;
#pragma unroll
        for (unsigned j = 0; j < 16; ++j) { const unsigned c = xb_ld(&bar[XB_XCNT(j)]); sum += c; cnt += (c > 0u) ? 1u : 0u; mine = (j == x) ? c : mine; }
        if (sum == G) break;
        __builtin_amdgcn_s_sleep(1);
        if ((++sp & 255u) == 0u) { if (xb_ld(&bar[XB_TMO])) break; if (sp > XB_SPIN_CAP) { atomicAdd(&bar[XB_TMO], 1u); break; } }
    }
    nloc = mine > 0u ? mine : 1u; nx = cnt > 0u ? cnt : 1u;
}
__device__ __forceinline__ void xcd_barrier(const XcdBarrier& b) {
    asm volatile("s_waitcnt vmcnt(0)" ::: "memory");
    __syncthreads();
    if (threadIdx.x == 0) {
        unsigned* bar = b.bar;
        __builtin_amdgcn_s_waitcnt(0);
        unsigned nloc = b.st[0], nx = b.st[1];
        if (nloc == 0u) { xcd_barrier_complete(bar, b.x, nloc, nx); b.st[0] = nloc; b.st[1] = nx; }
        const unsigned old = xb_add(&bar[XB_XSUB(b.x)], 1u);
        const unsigned gen = old / nloc;
        if (old + 1u == (gen + 1u) * nloc) {
            __builtin_amdgcn_fence(__ATOMIC_RELEASE, "agent");
            asm volatile("s_waitcnt vmcnt(0)" ::: "memory");
            const unsigned og = xb_add(&bar[XB_TOP], 1u);
            const unsigned tg = og / nx;
            if (og + 1u == (tg + 1u) * nx) xb_add(&bar[XB_TOPGEN], 1u);
            else XB_SPIN(xb_ld(&bar[XB_TOPGEN]) == tg, bar);
            __builtin_amdgcn_fence(__ATOMIC_ACQUIRE, "agent");
            xb_add(&bar[XB_XGEN(b.x)], 1u);
            asm volatile("s_waitcnt vmcnt(0)" ::: "memory");
        } else {
            XB_SPIN(xb_ld(&bar[XB_XGEN(b.x)]) == gen, bar);
            __builtin_amdgcn_fence(__ATOMIC_ACQUIRE, "agent");
            asm volatile("s_waitcnt vmcnt(0)" ::: "memory");
        }
    }
    __syncthreads();
}

constexpr size_t MiB = 1u << 20;
constexpr int NWAVES = 8;
constexpr int PROJ_BLD = 6144;
constexpr int PMAX = 34816;
constexpr size_t WS_CTL = 0, CTL_BYTES = 1 * MiB;
constexpr size_t WS_WIN = 1 * MiB, WS_WOUT = 25 * MiB, WS_WLORA = 33 * MiB;
constexpr size_t WS_XF = 34 * MiB, WS_XB = 162 * MiB, WS_VFIRST = 226 * MiB, WS_YMIXB = 290 * MiB, WS_TOK = 354 * MiB, WS_SCR = 356 * MiB;
constexpr size_t WS_PROJB = WS_SCR, WS_LW = WS_PROJB + 192 * MiB, WS_YRW = WS_LW + 128 * MiB, WS_BON = WS_YRW + 64 * MiB, WS_XBCC = WS_BON + 64 * MiB, WS_DTB = WS_XBCC + 48 * MiB, WS_YSSD = WS_DTB + 1 * MiB, WS_MIXED = WS_YSSD + 64 * MiB;
constexpr size_t WS_HBUF = WS_SCR, WS_XG = WS_HBUF + 187 * MiB, WS_YSLOT = WS_XG + 136 * MiB;
constexpr size_t WS_WFFN = WS_SCR + 860 * MiB, WS_END = WS_WFFN + 264 * MiB;
static_assert(WS_MIXED + 128 * MiB <= WS_WFFN && WS_YSLOT + 272 * MiB <= WS_WFFN, "scratch inside the map");
static_assert((size_t)PMAX * DFE * 2 <= 187 * MiB && (size_t)PMAX * D * 2 <= 136 * MiB && (size_t)PMAX * D * 4 <= 272 * MiB, "moe buffers");
constexpr int CW_CNT = 16;
constexpr int CW_BAR = 4096;
constexpr int MAX_BAR_REGIONS = 48;
static_assert((CW_BAR + MAX_BAR_REGIONS * XCD_BAR_WORDS) * 4 <= (int)CTL_BYTES, "ctl");
constexpr int RING_BYTES = 131072, LDS_BYTES = 147456, MISC_OFF = LDS_BYTES - 256;

struct Params { const float* in[35]; float* out; unsigned char* ws; int ph_lo, ph_hi, bar_idx, pad; };

__device__ __forceinline__ float wave_sum_f(float v) {
#pragma unroll
    for (int o = 32; o >= 1; o >>= 1) v += __shfl_xor(v, o);
    return v;
}

__device__ __forceinline__ void cvt_item(const float* W, int K, int N, bf16_t* WT, int dst_row0, LAS float* scr, int k0, int n0, int lane) {
#pragma unroll 8
    for (int i = 0; i < 32; ++i) { const int kk = 2 * i + (lane >> 5), col = lane & 31;
        scr[kk * 33 + col] = (k0 + kk < K && n0 + col < N) ? W[(size_t)(k0 + kk) * N + n0 + col] : 0.f; }
    asm volatile("s_waitcnt lgkmcnt(0)" ::: "memory");
    const int c = lane & 7;
#pragma unroll
    for (int j = 0; j < 4; ++j) { const int n = (lane >> 3) + 8 * j; const LAS float* s = scr + (8 * c) * 33 + n;
        u32x4 o; o.x = cvt_pk_bf16(s[0 * 33], s[1 * 33]); o.y = cvt_pk_bf16(s[2 * 33], s[3 * 33]); o.z = cvt_pk_bf16(s[4 * 33], s[5 * 33]); o.w = cvt_pk_bf16(s[6 * 33], s[7 * 33]);
        if (n0 + n < N && k0 + 8 * c < K) *(u32x4*)(WT + (size_t)(dst_row0 + n) * K + k0 + 8 * c) = o; }
    asm volatile("s_waitcnt lgkmcnt(0)" ::: "memory");
}
template <int MODE>
__device__ __forceinline__ void cvt_job(const float* W, int K, int N, bf16_t* WT, int row_off, int half, LAS float* scr, int gw, int ngw, int lane) {
    const int nkb = (K + 63) / 64, nnb = (N + 31) / 32, nitems = nkb * nnb;
    for (int it = gw; it < nitems; it += ngw) {
        const int kb = it / nnb, nb = it % nnb, n0 = nb * 32;
        const int dr = MODE == 0 ? row_off + n0 : row_off + 256 * (n0 / 128) + half * 128 + (n0 % 128);
        cvt_item(W, K, N, WT, dr, scr, kb * 64, n0, lane);
    }
}

struct LnOut { float* xf; bf16_t* xb; };
__device__ __forceinline__ void ln_finish(f32x4 (&v)[8], const float* gam, const float* bet, int lane, float* xf_row, bf16_t* xb_row) {
    float s = 0.f;
#pragma unroll
    for (int j = 0; j < 8; ++j) s += (v[j][0] + v[j][1]) + (v[j][2] + v[j][3]);
    const float mean = wave_sum_f(s) * (1.f / D);
    float q = 0.f;
#pragma unroll
    for (int j = 0; j < 8; ++j) { v[j] = v[j] - mean; q += (v[j][0] * v[j][0] + v[j][1] * v[j][1]) + (v[j][2] * v[j][2] + v[j][3] * v[j][3]); }
    const float rstd = rsqrtf(wave_sum_f(q) * (1.f / D) + 1e-5f);
#pragma unroll
    for (int j = 0; j < 8; ++j) { const int c = 4 * lane + 256 * j;
        const f32x4 g = *(const f32x4*)(gam + c), b = *(const f32x4*)(bet + c);
        v[j] = v[j] * rstd * g + b;
        *(f32x4*)(xf_row + c) = v[j];
        if (xb_row) { u32x2 w; w.x = cvt_pk_bf16(v[j][0], v[j][1]); w.y = cvt_pk_bf16(v[j][2], v[j][3]); *(u32x2*)(xb_row + c) = w; } }
}

#define DPP_ROR(z, n) __uint_as_float(__builtin_amdgcn_update_dpp(0u, __float_as_uint(z), 0x120 + (n), 0xf, 0xf, false))
__device__ __forceinline__ float wave_allsum(float x) {
    { auto s = __builtin_amdgcn_permlane32_swap(__float_as_uint(x), __float_as_uint(x), false, false); x = __uint_as_float(s[0]) + __uint_as_float(s[1]); }
    { auto s = __builtin_amdgcn_permlane16_swap(__float_as_uint(x), __float_as_uint(x), false, false); x = __uint_as_float(s[0]) + __uint_as_float(s[1]); }
    x += DPP_ROR(x, 8); x += DPP_ROR(x, 4); x += DPP_ROR(x, 2); x += DPP_ROR(x, 1);
    return x;
}
__device__ __forceinline__ float reduce4(float x0, float x1, float x2, float x3) {
    float y0, y1, z;
    { auto s = __builtin_amdgcn_permlane32_swap(__float_as_uint(x0), __float_as_uint(x2), false, false); y0 = __uint_as_float(s[0]) + __uint_as_float(s[1]); }
    { auto s = __builtin_amdgcn_permlane32_swap(__float_as_uint(x1), __float_as_uint(x3), false, false); y1 = __uint_as_float(s[0]) + __uint_as_float(s[1]); }
    { auto s = __builtin_amdgcn_permlane16_swap(__float_as_uint(y0), __float_as_uint(y1), false, false); z = __uint_as_float(s[0]) + __uint_as_float(s[1]); }
    z += DPP_ROR(z, 8); z += DPP_ROR(z, 4); z += DPP_ROR(z, 2); z += DPP_ROR(z, 1);
    return z;
}
__device__ __forceinline__ float rdlane(float v, int l) { return __int_as_float(__builtin_amdgcn_readlane(__float_as_int(v), l)); }
__device__ __forceinline__ float fast_sigmoid(float x) { return __builtin_amdgcn_rcpf(1.f + __builtin_amdgcn_exp2f(-1.4426950408889634f * x)); }
__device__ __forceinline__ float fast_tanh(float x) { return 1.f - 2.f * __builtin_amdgcn_rcpf(1.f + __builtin_amdgcn_exp2f(2.8853900817779268f * x)); }

constexpr int LORA_PITCH = 328;
__device__ __forceinline__ void lora_phase(LAS unsigned char* lds, const bf16_t* projb, const float* mix, const float* vmix, const bf16_t* Wl_w, const bf16_t* Wl_a, const bf16_t* Wl_g, const bf16_t* Wl_v,
                                           bf16_t* lw, const bool has_v, const int vcu, const int G, const int tid) {
    const int wave = __builtin_amdgcn_readfirstlane(tid >> 6), lane = tid & 63, fr = lane & 15, fq = lane >> 4;
    LAS bf16_t* Aimg = (LAS bf16_t*)lds;
    for (int u = vcu; u < M / 64; u += G) {
        {
            const int tau = tid >> 3, part = tid & 7, m = u * 64 + tau; const bool first = (m % SEQ) == 0;
#pragma unroll
            for (int i = 0; i < 5; ++i) {
                const int j0 = 40 * part + 8 * i;
                const u32x4 cur = *(const u32x4*)(projb + (size_t)m * PROJ_BLD + OFF_WLO + j0);
                u32x4 prv = (u32x4){0u, 0u, 0u, 0u};
                if (!first) prv = *(const u32x4*)(projb + (size_t)(m - 1) * PROJ_BLD + OFF_WLO + j0);
                f32x4 mx0, mx1;
                if (j0 < 288) { mx0 = *(const f32x4*)(mix + (OFF_WLO - OFF_RW) + j0); mx1 = *(const f32x4*)(mix + (OFF_WLO - OFF_RW) + j0 + 4); }
                else if (has_v) { mx0 = *(const f32x4*)(vmix + (j0 - 288)); mx1 = *(const f32x4*)(vmix + (j0 - 288) + 4); }
                else { mx0 = (f32x4){0.f, 0.f, 0.f, 0.f}; mx1 = mx0; }
                float o[8];
#pragma unroll
                for (int e = 0; e < 4; ++e) {
                    const float c0 = bf_lo(cur[e]), c1 = bf_hi(cur[e]), p0 = bf_lo(prv[e]), p1 = bf_hi(prv[e]);
                    const float m0 = (e < 2) ? mx0[2 * e] : mx1[2 * e - 4], m1 = (e < 2) ? mx0[2 * e + 1] : mx1[2 * e - 3];
                    o[2 * e] = c0 + (p0 - c0) * m0; o[2 * e + 1] = c1 + (p1 - c1) * m1;
                }
                if (j0 < 64) {
#pragma unroll
                    for (int e = 0; e < 8; ++e) o[e] = fast_tanh(o[e]);
                } else if (j0 >= 128 && j0 < 288) {
#pragma unroll
                    for (int e = 0; e < 8; ++e) o[e] = fast_sigmoid(o[e]);
                }
                u32x4 w; w.x = cvt_pk_bf16(o[0], o[1]); w.y = cvt_pk_bf16(o[2], o[3]); w.z = cvt_pk_bf16(o[4], o[5]); w.w = cvt_pk_bf16(o[6], o[7]);
                *(LAS u32x4*)(Aimg + tau * LORA_PITCH + j0) = w;
            }
        }
        __syncthreads();
        for (int q = 0; q < 4; ++q) {
            if (q == 3 && !has_v) break;
            const int K = (q == 2) ? 160 : (q == 3 ? 32 : 64), koff = (q == 0) ? 0 : (q == 1 ? 64 : (q == 2 ? 128 : 288));
            const bf16_t* W = (q == 0) ? Wl_w : (q == 1 ? Wl_a : (q == 2 ? Wl_g : Wl_v));
            f32x4 acc[8][4];
#pragma unroll
            for (int ct = 0; ct < 8; ++ct)
#pragma unroll
                for (int tt = 0; tt < 4; ++tt) acc[ct][tt] = (f32x4){0.f, 0.f, 0.f, 0.f};
            for (int ks = 0; ks < K / 32; ++ks) {
                bf16x8 af[8], bfr[4];
#pragma unroll
                for (int ct = 0; ct < 8; ++ct) af[ct] = *(const bf16x8*)(W + (size_t)(128 * wave + 16 * ct + fr) * K + 32 * ks + 8 * fq);
#pragma unroll
                for (int tt = 0; tt < 4; ++tt) bfr[tt] = *(const LAS bf16x8*)(Aimg + (16 * tt + fr) * LORA_PITCH + koff + 32 * ks + 8 * fq);
#pragma unroll
                for (int ct = 0; ct < 8; ++ct)
#pragma unroll
                    for (int tt = 0; tt < 4; ++tt) acc[ct][tt] = __builtin_amdgcn_mfma_f32_16x16x32_bf16(af[ct], bfr[tt], acc[ct][tt], 0, 0, 0);
            }
            bf16_t* out = lw + (size_t)q * M * 1024;
#pragma unroll
            for (int ct = 0; ct < 8; ++ct)
#pragma unroll
                for (int tt = 0; tt < 4; ++tt) { u32x2 w; w.x = cvt_pk_bf16(acc[ct][tt][0], acc[ct][tt][1]); w.y = cvt_pk_bf16(acc[ct][tt][2], acc[ct][tt][3]);
                    *(u32x2*)(out + (size_t)(u * 64 + 16 * tt + fr) * 1024 + 128 * wave + 16 * ct + 4 * fq) = w; }
        }
        __syncthreads();
    }
}

struct RwScan { const bf16_t* proj_; const bf16_t* lw_; const float* mix; const float* w0; const float* a0; const float* v0; const float* k_k; const float* k_a; const float* r_k; float* vf_; float* y_; float* bon_; int layer; int pad; };
constexpr int RWB_A = 0, RWB_DR = 8192, RWB_D = 16384, RWB_B = 24576, RWB_K = 32768, RWB_V = 40960, RWB_SC = 45056, RWB_SIZE = 45568, RW_YST = 2 * RWB_SIZE, RW_TB = 32;
__device__ __forceinline__ float rowsum16(float z) { z += DPP_ROR(z, 8); z += DPP_ROR(z, 4); z += DPP_ROR(z, 2); z += DPP_ROR(z, 1); return z; }
__device__ __forceinline__ void rwkv_scan_phase(LAS unsigned char* lds, const RwScan& a, const int vcu, const int G, const int tid) {
    const int wave = __builtin_amdgcn_readfirstlane(tid >> 6), lane = tid & 63, jj = lane & 15, rg = lane >> 4;
    for (int u = vcu; u < BATCH * RW_H * 2; u += G) {
        const int b = u >> 5, h = (u >> 1) & 15, half = u & 1, c = h * 64 + lane;
        const float mix_r = a.mix[c], mix_k = a.mix[1024 + c], mix_v = a.mix[2048 + c];
        const float w0c = a.w0[c], a0c = a.a0[c], v0c = a.layer ? a.v0[c] : 0.f, kkc = a.k_k[c], kac = a.k_a[c], rkc = a.r_k[c];
        float S0 = 0.f, S1 = 0.f, S2 = 0.f, S3 = 0.f;
        unsigned pr[5], pk[5], pv[5], pw[4], pa[4], pvp[4]; float pvf[4];
        const bf16_t* lw_w = a.lw_; const bf16_t* lw_a = a.lw_ + (size_t)M * 1024; const bf16_t* lw_v = a.lw_ + (size_t)3 * M * 1024;
#define RW_PREFETCH(t0_) do { const int tb_ = (t0_) + 4 * wave; \
        _Pragma("unroll") for (int i = 0; i < 5; ++i) { const int t_ = tb_ + i - 1; \
            if (t_ >= 0) { const bf16_t* row_ = a.proj_ + (size_t)(b * SEQ + t_) * PROJ_BLD + h * 64 + lane; pr[i] = row_[OFF_R]; pk[i] = row_[OFF_K]; pv[i] = row_[OFF_V]; } \
            else { pr[i] = 0u; pk[i] = 0u; pv[i] = 0u; } } \
        _Pragma("unroll") for (int i = 0; i < 4; ++i) { const size_t o_ = (size_t)(b * SEQ + tb_ + i) * 1024 + c; pw[i] = lw_w[o_]; pa[i] = lw_a[o_]; \
            if (a.layer) { pvp[i] = lw_v[o_]; pvf[i] = a.vf_[o_]; } else { pvp[i] = 0u; pvf[i] = 0.f; } } } while (0)
        RW_PREFETCH(0);
        const int woff = jj * 16 + rg * 4;
        for (int ch = 0; ch < SEQ / RW_TB; ++ch) {
            const int t0 = ch * RW_TB;
            LAS unsigned char* buf = lds + (ch & 1) * RWB_SIZE;
#pragma unroll
            for (int i = 0; i < 4; ++i) {
                const int tau = 4 * wave + i;
                const float rc = __uint_as_float(pr[i + 1] << 16), rp = __uint_as_float(pr[i] << 16), kc = __uint_as_float(pk[i + 1] << 16), kp = __uint_as_float(pk[i] << 16), vc = __uint_as_float(pv[i + 1] << 16), vp = __uint_as_float(pv[i] << 16);
                const float r = rc + (rp - rc) * mix_r, kraw = kc + (kp - kc) * mix_k, vraw = vc + (vp - vc) * mix_v;
                const float sg = fast_sigmoid(w0c + __uint_as_float(pw[i] << 16));
                const float dec = __builtin_amdgcn_exp2f(-1.4426950408889634f * 0.6065306597126334f * sg);
                const float as = fast_sigmoid(a0c + __uint_as_float(pa[i] << 16));
                float v = vraw;
                if (a.layer) v = vraw + (pvf[i] - vraw) * fast_sigmoid(v0c + __uint_as_float(pvp[i] << 16));
                const float kkv = kraw * kkc;
                const float km = kraw * (1.f + (as - 1.f) * kac);
                const float z = reduce4(kkv * kkv, r * km * rkc, kkv * as * r, km * r);
                const float nrm2 = rdlane(z, 0), rks = rdlane(z, 16), bru = rdlane(z, 32), kr = rdlane(z, 48);
                const float inv = 1.f / fmaxf(sqrtf(nrm2), 1e-12f);
                const float kkn = kkv * inv;
                *(LAS float*)(buf + RWB_A + tau * 256 + woff) = -kkn; *(LAS float*)(buf + RWB_DR + tau * 256 + woff) = dec * r; *(LAS float*)(buf + RWB_D + tau * 256 + woff) = dec;
                *(LAS float*)(buf + RWB_B + tau * 256 + woff) = kkn * as; *(LAS float*)(buf + RWB_K + tau * 256 + woff) = km;
                if ((lane >> 5) == half) { ((LAS float*)(buf + RWB_V))[tau * 32 + (lane & 31)] = v;
                    if (a.layer == 0) a.vf_[(size_t)(b * SEQ + t0 + tau) * 1024 + c] = vraw; }
                if (lane == 0) { ((LAS float*)(buf + RWB_SC))[tau] = bru * inv; ((LAS float*)(buf + RWB_SC))[32 + tau] = kr; ((LAS float*)(buf + RWB_SC))[64 + tau] = rks; }
            }
            __syncthreads();
            if (ch + 1 < SEQ / RW_TB) RW_PREFETCH(t0 + RW_TB);
            {
                const LAS unsigned char* ob = buf + jj * 16;
                const LAS float* Vb = (const LAS float*)(buf + RWB_V) + 4 * wave + rg; const LAS float* SC = (const LAS float*)(buf + RWB_SC);
                LAS float* Yst = (LAS float*)(lds + RW_YST);
                f32x4 a4 = *(const LAS f32x4*)(ob + RWB_A), q4 = *(const LAS f32x4*)(ob + RWB_DR), d4 = *(const LAS f32x4*)(ob + RWB_D), b4 = *(const LAS f32x4*)(ob + RWB_B), k4 = *(const LAS f32x4*)(ob + RWB_K);
                float vi = Vb[0], br = SC[0], kr = SC[32];
#pragma unroll
                for (int blk = 0; blk < 2; ++blk) {
                    float yacc = 0.f;
#pragma unroll
                    for (int s = 0; s < 16; ++s) {
                        const int tn = blk * 16 + s + 1;
                        const f32x4 na4 = *(const LAS f32x4*)(ob + RWB_A + tn * 256), nq4 = *(const LAS f32x4*)(ob + RWB_DR + tn * 256), nd4 = *(const LAS f32x4*)(ob + RWB_D + tn * 256),
                                    nb4 = *(const LAS f32x4*)(ob + RWB_B + tn * 256), nk4 = *(const LAS f32x4*)(ob + RWB_K + tn * 256);
                        const float nvi = Vb[(tn & 31) * 32], nbr = SC[tn & 31], nkr = SC[32 + (tn & 31)];
                        const float pa_ = (S0 * a4[0] + S1 * a4[1]) + (S2 * a4[2] + S3 * a4[3]);
                        const float pq_ = (S0 * q4[0] + S1 * q4[1]) + (S2 * q4[2] + S3 * q4[3]);
                        const float sa = rowsum16(pa_);
                        const float zq = rowsum16(pq_);
                        S0 = S0 * d4[0] + sa * b4[0] + vi * k4[0]; S1 = S1 * d4[1] + sa * b4[1] + vi * k4[1]; S2 = S2 * d4[2] + sa * b4[2] + vi * k4[2]; S3 = S3 * d4[3] + sa * b4[3] + vi * k4[3];
                        const float y = zq + sa * br + vi * kr;
                        yacc = (jj == s) ? y : yacc;
                        a4 = na4; q4 = nq4; d4 = nd4; b4 = nb4; k4 = nk4; vi = nvi; br = nbr; kr = nkr;
                    }
                    Yst[(blk * 8 + wave) * 64 + lane] = yacc;
                }
            }
            __syncthreads();
#pragma unroll
            for (int q = 0; q < 2; ++q) {
                const int idx = tid + 512 * q, tau = idx >> 5, i = idx & 31;
                const float y = ((const LAS float*)(lds + RW_YST))[((tau >> 4) * 8 + (i >> 2)) * 64 + (i & 3) * 16 + (tau & 15)];
                const float bo = ((const LAS float*)(buf + RWB_SC))[64 + tau] * ((const LAS float*)(buf + RWB_V))[tau * 32 + i];
                const size_t o = (size_t)(b * SEQ + t0 + tau) * 1024 + h * 64 + half * 32 + i;
                a.y_[o] = y; a.bon_[o] = bo;
            }
        }
#undef RW_PREFETCH
        __syncthreads();
    }
}

__device__ __forceinline__ void rwkv_post_phase(const float* yrw, const float* bon, const bf16_t* lw_g, const float* ln_w, const float* ln_b, bf16_t* ymixb, const int gw, const int NGW, const int lane) {
    const int c0 = 16 * lane;
    f32x4 lw4[4], lb4[4];
#pragma unroll
    for (int j = 0; j < 4; ++j) { lw4[j] = *(const f32x4*)(ln_w + c0 + 4 * j); lb4[j] = *(const f32x4*)(ln_b + c0 + 4 * j); }
    for (int m = gw; m < M; m += NGW) {
        f32x4 y[4], bo[4];
#pragma unroll
        for (int j = 0; j < 4; ++j) { y[j] = *(const f32x4*)(yrw + (size_t)m * 1024 + c0 + 4 * j); bo[j] = *(const f32x4*)(bon + (size_t)m * 1024 + c0 + 4 * j); }
        const u32x4 g0 = *(const u32x4*)(lw_g + (size_t)m * 1024 + c0), g1 = *(const u32x4*)(lw_g + (size_t)m * 1024 + c0 + 8);
        float s = 0.f;
#pragma unroll
        for (int j = 0; j < 4; ++j) s += (y[j][0] + y[j][1]) + (y[j][2] + y[j][3]);
        s += __shfl_xor(s, 1); s += __shfl_xor(s, 2);
        const float mu = s * (1.f / 64.f);
        float q = 0.f;
#pragma unroll
        for (int j = 0; j < 4; ++j) { y[j] = y[j] - mu; q += (y[j][0] * y[j][0] + y[j][1] * y[j][1]) + (y[j][2] * y[j][2] + y[j][3] * y[j][3]); }
        q += __shfl_xor(q, 1); q += __shfl_xor(q, 2);
        const float rstd = rsqrtf(q * (1.f / 64.f) + 64e-5f);
        float o[16];
#pragma unroll
        for (int j = 0; j < 4; ++j) { const f32x4 t = y[j] * rstd * lw4[j] + lb4[j] + bo[j]; o[4 * j] = t[0]; o[4 * j + 1] = t[1]; o[4 * j + 2] = t[2]; o[4 * j + 3] = t[3]; }
        const unsigned gw_[8] = {g0.x, g0.y, g0.z, g0.w, g1.x, g1.y, g1.z, g1.w};
        u32x4 w0, w1;
        w0.x = cvt_pk_bf16(o[0] * bf_lo(gw_[0]), o[1] * bf_hi(gw_[0])); w0.y = cvt_pk_bf16(o[2] * bf_lo(gw_[1]), o[3] * bf_hi(gw_[1]));
        w0.z = cvt_pk_bf16(o[4] * bf_lo(gw_[2]), o[5] * bf_hi(gw_[2])); w0.w = cvt_pk_bf16(o[6] * bf_lo(gw_[3]), o[7] * bf_hi(gw_[3]));
        w1.x = cvt_pk_bf16(o[8] * bf_lo(gw_[4]), o[9] * bf_hi(gw_[4])); w1.y = cvt_pk_bf16(o[10] * bf_lo(gw_[5]), o[11] * bf_hi(gw_[5]));
        w1.z = cvt_pk_bf16(o[12] * bf_lo(gw_[6]), o[13] * bf_hi(gw_[6])); w1.w = cvt_pk_bf16(o[14] * bf_lo(gw_[7]), o[15] * bf_hi(gw_[7]));
        *(u32x4*)(ymixb + (size_t)m * 2048 + 1024 + c0) = w0; *(u32x4*)(ymixb + (size_t)m * 2048 + 1024 + c0 + 8) = w1;
    }
}

__device__ __forceinline__ void ssd_conv_phase(const bf16_t* projb, const float* cw, const float* cb, const float* dt_bias, bf16_t* xbcc, float* dtb, const int vcu, const int G, const int tid) {
    for (int u = vcu; u < M / 64; u += G) {
        if (tid < 384) {
            const int cg = tid % 192, hf = tid / 192, c0 = 8 * cg, m0 = u * 64 + 32 * hf, t_in_seq = m0 % SEQ;
            float w[4][8], bias[8];
#pragma unroll
            for (int q = 0; q < 4; ++q) { const f32x4 a = *(const f32x4*)(cw + q * CONV_DIM + c0), b = *(const f32x4*)(cw + q * CONV_DIM + c0 + 4);
                w[q][0] = a[0]; w[q][1] = a[1]; w[q][2] = a[2]; w[q][3] = a[3]; w[q][4] = b[0]; w[q][5] = b[1]; w[q][6] = b[2]; w[q][7] = b[3]; }
            { const f32x4 a = *(const f32x4*)(cb + c0), b = *(const f32x4*)(cb + c0 + 4); bias[0] = a[0]; bias[1] = a[1]; bias[2] = a[2]; bias[3] = a[3]; bias[4] = b[0]; bias[5] = b[1]; bias[6] = b[2]; bias[7] = b[3]; }
            float win[3][8];
#pragma unroll
            for (int q = 0; q < 3; ++q) {
                u32x4 r = (u32x4){0u, 0u, 0u, 0u};
                if (t_in_seq - 3 + q >= 0) r = *(const u32x4*)(projb + (size_t)(m0 - 3 + q) * PROJ_BLD + OFF_XBC + c0);
                win[q][0] = bf_lo(r.x); win[q][1] = bf_hi(r.x); win[q][2] = bf_lo(r.y); win[q][3] = bf_hi(r.y); win[q][4] = bf_lo(r.z); win[q][5] = bf_hi(r.z); win[q][6] = bf_lo(r.w); win[q][7] = bf_hi(r.w);
            }
            for (int i = 0; i < 32; ++i) {
                const u32x4 r = *(const u32x4*)(projb + (size_t)(m0 + i) * PROJ_BLD + OFF_XBC + c0);
                float cur[8] = {bf_lo(r.x), bf_hi(r.x), bf_lo(r.y), bf_hi(r.y), bf_lo(r.z), bf_hi(r.z), bf_lo(r.w), bf_hi(r.w)};
                float o[8];
#pragma unroll
                for (int e = 0; e < 8; ++e) { const float acc = bias[e] + w[0][e] * win[0][e] + w[1][e] * win[1][e] + w[2][e] * win[2][e] + w[3][e] * cur[e]; o[e] = fast_silu(acc);
                    win[0][e] = win[1][e]; win[1][e] = win[2][e]; win[2][e] = cur[e]; }
                u32x4 wv; wv.x = cvt_pk_bf16(o[0], o[1]); wv.y = cvt_pk_bf16(o[2], o[3]); wv.z = cvt_pk_bf16(o[4], o[5]); wv.w = cvt_pk_bf16(o[6], o[7]);
                *(u32x4*)(xbcc + (size_t)(m0 + i) * CONV_DIM + c0) = wv;
            }
        }
#pragma unroll
        for (int q = 0; q < 2; ++q) { const int idx = tid + 512 * q, m = u * 64 + (idx >> 4), h = idx & 15;
            const float x = bf2f(projb[(size_t)m * PROJ_BLD + OFF_DT + h]) + dt_bias[h];
            dtb[(size_t)m * SSD_H + h] = fmaxf(x, 0.f) + log1pf(expf(-fabsf(x))); }
    }
}

constexpr int SP = 136;
constexpr int SS_C = 0, SS_B = 34816, SS_BT = 69632, SS_XT = 104448, SS_XW = 113152, SS_HT = 121856, SS_AC = 130560, SS_DT = 131072, SS_END = 131584;
__device__ __forceinline__ void ssd_scan_phase(LAS unsigned char* lds, const bf16_t* xbcc, const float* dtb, const float* a_log, const float* dskip, float* yssd, const int vcu, const int G, const int tid) {
    const int wave = __builtin_amdgcn_readfirstlane(tid >> 6), lane = tid & 63, fr = lane & 15, fq = lane >> 4;
    LAS bf16_t* Cimg = (LAS bf16_t*)(lds + SS_C); LAS bf16_t* Bimg = (LAS bf16_t*)(lds + SS_B); LAS bf16_t* BTimg = (LAS bf16_t*)(lds + SS_BT);
    LAS bf16_t* xT = (LAS bf16_t*)(lds + SS_XT); LAS bf16_t* xwT = (LAS bf16_t*)(lds + SS_XW); LAS bf16_t* hT = (LAS bf16_t*)(lds + SS_HT);
    LAS float* acum = (LAS float*)(lds + SS_AC); LAS float* dtv = (LAS float*)(lds + SS_DT);
    for (int u = vcu; u < BATCH * SSD_H * 2; u += G) {
        const int b = u >> 5, h = (u >> 1) & 15, phalf = u & 1, g = h >> 3;
        const float Ah = -expf(a_log[h]) * 1.4426950408889634f;
        const float dsk = dskip[h];
        f32x4 hs[2] = {(f32x4){0.f, 0.f, 0.f, 0.f}, (f32x4){0.f, 0.f, 0.f, 0.f}};
        for (int i = tid; i < 32 * SP / 2; i += 512) ((LAS unsigned*)hT)[i] = 0u;
        const int row = tid >> 2, part = tid & 3;
        for (int ch = 0; ch < SEQ / 128; ++ch) {
            const int mrow0 = b * SEQ + ch * 128;
            u32x4 xr;
            {
                const bf16_t* src = xbcc + (size_t)(mrow0 + row) * CONV_DIM;
                u32x4 cv[4], bv[4];
#pragma unroll
                for (int j = 0; j < 4; ++j) { cv[j] = *(const u32x4*)(src + 1280 + g * 128 + 32 * part + 8 * j); bv[j] = *(const u32x4*)(src + 1024 + g * 128 + 32 * part + 8 * j); }
                xr = *(const u32x4*)(src + h * 64 + phalf * 32 + 8 * part);
                if (tid < 128) dtv[tid] = dtb[(size_t)(mrow0 + tid) * SSD_H + h];
#pragma unroll
                for (int j = 0; j < 4; ++j) { *(LAS u32x4*)(Cimg + row * SP + 32 * part + 8 * j) = cv[j]; *(LAS u32x4*)(Bimg + row * SP + 32 * part + 8 * j) = bv[j]; }
#pragma unroll
                for (int j = 0; j < 4; ++j) { const unsigned wv[4] = {bv[j].x, bv[j].y, bv[j].z, bv[j].w};
#pragma unroll
                    for (int e = 0; e < 4; ++e) { const int n = 32 * part + 8 * j + 2 * e; BTimg[n * SP + row] = (bf16_t)(wv[e] & 0xffffu); BTimg[(n + 1) * SP + row] = (bf16_t)(wv[e] >> 16); } }
            }
            __syncthreads();
            if (wave == 0) {
                const float v0 = dtv[2 * lane] * Ah, v1 = dtv[2 * lane + 1] * Ah;
                float s = v0 + v1;
#pragma unroll
                for (int o = 1; o < 64; o <<= 1) { const float t = __shfl_up(s, o); if (lane >= o) s += t; }
                acum[2 * lane] = s - v1; acum[2 * lane + 1] = s;
            }
            __syncthreads();
            const float atot = acum[127];
            {
                const float wgt = dtv[row] * __builtin_amdgcn_exp2f(atot - acum[row]);
                const unsigned wv[4] = {xr.x, xr.y, xr.z, xr.w};
#pragma unroll
                for (int e = 0; e < 4; ++e) { const int p = 8 * part + 2 * e; const float x0 = bf_lo(wv[e]), x1 = bf_hi(wv[e]);
                    xT[p * SP + row] = (bf16_t)(wv[e] & 0xffffu); xT[(p + 1) * SP + row] = (bf16_t)(wv[e] >> 16);
                    const unsigned pk = cvt_pk_bf16(x0 * wgt, x1 * wgt); xwT[p * SP + row] = (bf16_t)(pk & 0xffffu); xwT[(p + 1) * SP + row] = (bf16_t)(pk >> 16); }
            }
            f32x4 gacc[8];
#pragma unroll
            for (int st = 0; st < 8; ++st) gacc[st] = (f32x4){0.f, 0.f, 0.f, 0.f};
            {
                bf16x8 cf[4];
#pragma unroll
                for (int ks = 0; ks < 4; ++ks) cf[ks] = *(const LAS bf16x8*)(Cimg + (16 * wave + fr) * SP + 32 * ks + 8 * fq);
#pragma unroll
                for (int st = 0; st < 8; ++st) if (st <= wave) {
#pragma unroll
                    for (int ks = 0; ks < 4; ++ks) { const bf16x8 bfg = *(const LAS bf16x8*)(Bimg + (16 * st + fr) * SP + 32 * ks + 8 * fq);
                        gacc[st] = __builtin_amdgcn_mfma_f32_16x16x32_bf16(bfg, cf[ks], gacc[st], 0, 0, 0); }
                }
            }
            __syncthreads();
            {
                LAS bf16_t* Mimg = Bimg;
                const int l = 16 * wave + fr; const float al = acum[l];
#pragma unroll
                for (int st = 0; st < 8; ++st) if (st <= wave + 1) {
                    u32x2 wv = (u32x2){0u, 0u};
                    if (st <= wave) {
                        const f32x4 as4 = *(const LAS f32x4*)(acum + 16 * st + 4 * fq), dt4 = *(const LAS f32x4*)(dtv + 16 * st + 4 * fq);
                        float mv[4];
#pragma unroll
                        for (int r = 0; r < 4; ++r) { const int s = 16 * st + 4 * fq + r; mv[r] = (s <= l) ? gacc[st][r] * dt4[r] * __builtin_amdgcn_exp2f(al - as4[r]) : 0.f; }
                        wv.x = cvt_pk_bf16(mv[0], mv[1]); wv.y = cvt_pk_bf16(mv[2], mv[3]);
                    }
                    *(LAS u32x2*)(Mimg + l * SP + 16 * st + 4 * fq) = wv;
                }
            }
            __syncthreads();
            {
                const LAS bf16_t* Mimg = Bimg;
                f32x4 yd[2] = {(f32x4){0.f, 0.f, 0.f, 0.f}, (f32x4){0.f, 0.f, 0.f, 0.f}}, yo[2] = {(f32x4){0.f, 0.f, 0.f, 0.f}, (f32x4){0.f, 0.f, 0.f, 0.f}};
#pragma unroll
                for (int ks = 0; ks < 4; ++ks) {
                    const bf16x8 cfr = *(const LAS bf16x8*)(Cimg + (16 * wave + fr) * SP + 32 * ks + 8 * fq);
#pragma unroll
                    for (int pt = 0; pt < 2; ++pt) { const bf16x8 hf = *(const LAS bf16x8*)(hT + (16 * pt + fr) * SP + 32 * ks + 8 * fq);
                        yo[pt] = __builtin_amdgcn_mfma_f32_16x16x32_bf16(hf, cfr, yo[pt], 0, 0, 0); }
                    if (2 * ks <= wave) {
                        const bf16x8 mf = *(const LAS bf16x8*)(Mimg + (16 * wave + fr) * SP + 32 * ks + 8 * fq);
#pragma unroll
                        for (int pt = 0; pt < 2; ++pt) { const bf16x8 xf_ = *(const LAS bf16x8*)(xT + (16 * pt + fr) * SP + 32 * ks + 8 * fq);
                            yd[pt] = __builtin_amdgcn_mfma_f32_16x16x32_bf16(xf_, mf, yd[pt], 0, 0, 0); }
                    }
                }
                const int l = 16 * wave + fr; const float el = __builtin_amdgcn_exp2f(acum[l]);
#pragma unroll
                for (int pt = 0; pt < 2; ++pt) {
                    f32x4 o;
#pragma unroll
                    for (int r = 0; r < 4; ++r) o[r] = yd[pt][r] + el * yo[pt][r] + dsk * bf2f(xT[(16 * pt + 4 * fq + r) * SP + l]);
                    *(f32x4*)(yssd + (size_t)(mrow0 + l) * 1024 + h * 64 + phalf * 32 + 16 * pt + 4 * fq) = o;
                }
            }
            {
                const float ea = __builtin_amdgcn_exp2f(atot);
                hs[0] = hs[0] * ea; hs[1] = hs[1] * ea;
#pragma unroll
                for (int ks = 0; ks < 4; ++ks) {
                    const bf16x8 btf = *(const LAS bf16x8*)(BTimg + (16 * wave + fr) * SP + 32 * ks + 8 * fq);
#pragma unroll
                    for (int pt = 0; pt < 2; ++pt) { const bf16x8 xwf = *(const LAS bf16x8*)(xwT + (16 * pt + fr) * SP + 32 * ks + 8 * fq);
                        hs[pt] = __builtin_amdgcn_mfma_f32_16x16x32_bf16(btf, xwf, hs[pt], 0, 0, 0); }
                }
            }
            __syncthreads();
#pragma unroll
            for (int pt = 0; pt < 2; ++pt) { u32x2 wv; wv.x = cvt_pk_bf16(hs[pt][0], hs[pt][1]); wv.y = cvt_pk_bf16(hs[pt][2], hs[pt][3]);
                *(LAS u32x2*)(hT + (16 * pt + fr) * SP + 16 * wave + 4 * fq) = wv; }
        }
        __syncthreads();
    }
}

__device__ __forceinline__ void ssd_post_phase(const float* yssd, const bf16_t* projb, const float* norm_w, bf16_t* ymixb, const int gw, const int NGW, const int lane) {
    const int c0 = 16 * lane;
    f32x4 nw[4];
#pragma unroll
    for (int j = 0; j < 4; ++j) nw[j] = *(const f32x4*)(norm_w + c0 + 4 * j);
    for (int m = gw; m < M; m += NGW) {
        f32x4 y[4];
#pragma unroll
        for (int j = 0; j < 4; ++j) y[j] = *(const f32x4*)(yssd + (size_t)m * 1024 + c0 + 4 * j);
        const u32x4 z0 = *(const u32x4*)(projb + (size_t)m * PROJ_BLD + OFF_Z + c0), z1 = *(const u32x4*)(projb + (size_t)m * PROJ_BLD + OFF_Z + c0 + 8);
        const unsigned zw[8] = {z0.x, z0.y, z0.z, z0.w, z1.x, z1.y, z1.z, z1.w};
        float uu[16]; float ss = 0.f;
#pragma unroll
        for (int e = 0; e < 8; ++e) { uu[2 * e] = y[e >> 1][(2 * e) & 3] * fast_silu(bf_lo(zw[e])); uu[2 * e + 1] = y[e >> 1][(2 * e + 1) & 3] * fast_silu(bf_hi(zw[e])); ss += uu[2 * e] * uu[2 * e] + uu[2 * e + 1] * uu[2 * e + 1]; }
#pragma unroll
        for (int o = 1; o < 32; o <<= 1) ss += __shfl_xor(ss, o);
        const float rs = rsqrtf(ss * (1.f / 512.f) + 1e-5f);
        u32x4 w0, w1;
        w0.x = cvt_pk_bf16(uu[0] * rs * nw[0][0], uu[1] * rs * nw[0][1]); w0.y = cvt_pk_bf16(uu[2] * rs * nw[0][2], uu[3] * rs * nw[0][3]);
        w0.z = cvt_pk_bf16(uu[4] * rs * nw[1][0], uu[5] * rs * nw[1][1]); w0.w = cvt_pk_bf16(uu[6] * rs * nw[1][2], uu[7] * rs * nw[1][3]);
        w1.x = cvt_pk_bf16(uu[8] * rs * nw[2][0], uu[9] * rs * nw[2][1]); w1.y = cvt_pk_bf16(uu[10] * rs * nw[2][2], uu[11] * rs * nw[2][3]);
        w1.z = cvt_pk_bf16(uu[12] * rs * nw[3][0], uu[13] * rs * nw[3][1]); w1.w = cvt_pk_bf16(uu[14] * rs * nw[3][2], uu[15] * rs * nw[3][3]);
        *(u32x4*)(ymixb + (size_t)m * 2048 + c0) = w0; *(u32x4*)(ymixb + (size_t)m * 2048 + c0 + 8) = w1;
    }
}

#define PH_BEGIN int z_ = 0; asm volatile("" : "+s"(z_)); unsigned char* const wsq = P.ws + z_; int tid = tid0; asm volatile("" : "+v"(tid)); \
    const int G = G0 + z_, bx = bx0 + z_, vcu = vcu0 + z_, lane = tid & 63, wave = __builtin_amdgcn_readfirstlane(tid >> 6), gw = vcu * NWAVES + wave, NGW = G * NWAVES; (void)bx; (void)lane; (void)gw; (void)NGW; (void)wave;
#define INP(i) (P.in[(i) + z_])
#define Win_t ((bf16_t*)(wsq + WS_WIN))
#define Wout_t ((bf16_t*)(wsq + WS_WOUT))
#define Wffn ((bf16_t*)(wsq + WS_WFFN))
#define Wl_w ((bf16_t*)(wsq + WS_WLORA))
#define Wl_a (Wl_w + 1024 * 64)
#define Wl_g (Wl_a + 1024 * 64)
#define Wl_v (Wl_g + 1024 * 160)
#define xf ((float*)(wsq + WS_XF))
#define xb ((bf16_t*)(wsq + WS_XB))
#define projb ((bf16_t*)(wsq + WS_PROJB))
#define ymixb ((bf16_t*)(wsq + WS_YMIXB))
#define mixed ((float*)(wsq + WS_MIXED))
#define hbuf ((bf16_t*)(wsq + WS_HBUF))
#define xg ((bf16_t*)(wsq + WS_XG))
#define yslot ((float*)(wsq + WS_YSLOT))
#define xbcc ((bf16_t*)(wsq + WS_XBCC))
#define dtb ((float*)(wsq + WS_DTB))
#define yssd ((float*)(wsq + WS_YSSD))
#define lw ((bf16_t*)(wsq + WS_LW))
#define yrw ((float*)(wsq + WS_YRW))
#define bon ((float*)(wsq + WS_BON))
#define vfirst ((float*)(wsq + WS_VFIRST))
#define tok_e ((int*)(wsq + WS_TOK))
#define tok_pos (tok_e + 2 * M)
#define tok_g ((float*)(tok_pos + 2 * M))
#define tok_dest ((int*)(tok_g + 2 * M))
#define cnt ((int*)(wsq + WS_CTL) + CW_CNT + 8 * li)
#ifndef MK_DBL
#define MK_DBL 0
#endif
#ifndef MK_LAUNCH_MODE
#define MK_LAUNCH_MODE 1
#endif
__global__ void __launch_bounds__(NWAVES * 64, 2) fwd(Params P) {
    extern __shared__ __attribute__((aligned(16))) unsigned char lds_raw[];
    LAS unsigned char* lds = (LAS unsigned char*)lds_raw;
    volatile LAS unsigned* MISC = (volatile LAS unsigned*)(lds + MISC_OFF);
    const int tid0 = threadIdx.x;
    const int G0 = gridDim.x, bx0 = blockIdx.x;
    const int vcu0 = (G0 % 8 == 0) ? (bx0 % 8) * (G0 / 8) + bx0 / 8 : bx0;
    unsigned* ctl = (unsigned*)(P.ws + WS_CTL);
    if (tid0 < 64) MISC[tid0] = 0u;
    __syncthreads();
#if MK_LAUNCH_MODE == 1
    constexpr int lo = 0, hi = 64;
#else
    const int lo = P.ph_lo, hi = P.ph_hi;
#endif
    XcdBarrier bar; bar.bar = ctl + CW_BAR + P.bar_idx * XCD_BAR_WORDS; bar.x = 0; bar.st = MISC + 8;
    if (hi - lo > 1) bar = xcd_barrier_post(ctl + CW_BAR + P.bar_idx * XCD_BAR_WORDS, MISC + 8);
#define IN(k) (lo <= (k) && (k) < hi)
#define SEAM(k) do { if ((k) + 1 < hi) xcd_barrier(bar); } while (0)

    for (int l = 0; l < 4; ++l) {
        const int pb = l * 16, li = l >> 1; const bool moe = (l & 1) != 0;
        if (IN(pb + 0)) {
            PH_BEGIN
            LAS float* scr = (LAS float*)(lds + wave * 16384);
            cvt_job<0>(INP(1) + (size_t)l * D * IN_DIM, D, IN_DIM, Win_t, 0, 0, scr, gw, NGW, lane);
            if (l > 0) cvt_job<0>(INP(2) + (size_t)(l - 1) * D * 32, D, 32, Win_t, IN_DIM, 0, scr, gw, NGW, lane);
            { const int r0 = l > 0 ? IN_DIM + 32 : IN_DIM, nz = (PROJ_BLD - r0) * (D / 8);
              for (int i = bx * 512 + tid; i < nz; i += G * 512) *(u32x4*)(Win_t + (size_t)r0 * D + (size_t)i * 8) = (u32x4){0u, 0u, 0u, 0u}; }
            cvt_job<0>(INP(23) + (size_t)l * D * D, D, D, Wout_t, 0, 0, scr, gw, NGW, lane);
            cvt_job<0>(INP(12) + (size_t)l * 64 * 1024, 64, 1024, Wl_w, 0, 0, scr, gw, NGW, lane);
            cvt_job<0>(INP(14) + (size_t)l * 64 * 1024, 64, 1024, Wl_a, 0, 0, scr, gw, NGW, lane);
            cvt_job<0>(INP(17) + (size_t)l * 160 * 1024, 160, 1024, Wl_g, 0, 0, scr, gw, NGW, lane);
            if (l > 0) cvt_job<0>(INP(16) + (size_t)(l - 1) * 32 * 1024, 32, 1024, Wl_v, 0, 0, scr, gw, NGW, lane);
            if (l == 0) {
                const float* x = INP(0);
                for (size_t i = (size_t)bx * 512 + tid; i < (size_t)M * D / 8; i += (size_t)G * 512) {
                    const f32x4 a = *(const f32x4*)(x + i * 8), b = *(const f32x4*)(x + i * 8 + 4);
                    u32x4 w; w.x = cvt_pk_bf16(a[0], a[1]); w.y = cvt_pk_bf16(a[2], a[3]); w.z = cvt_pk_bf16(b[0], b[1]); w.w = cvt_pk_bf16(b[2], b[3]);
                    *(u32x4*)(xb + i * 8) = w; }
            }
            __syncthreads();
            SEAM(pb + 0);
        }
        if (IN(pb + 1)) {
            PH_BEGIN
            pg8::Gemm g{xb, Win_t, D}; pg8::StaticOrder S; S.init(M, PROJ_BLD, G, bx);
            pg8::EpiBf16 E{projb, PROJ_BLD};
            pg8::gemm_phase<pg8::EpiBf16, pg8::StaticOrder>(lds, g, S, E, tid);
#if (MK_DBL >> 1) & 1
            pg8::gemm_phase<pg8::EpiBf16, pg8::StaticOrder>(lds, g, S, E, tid);
#endif
            SEAM(pb + 1);
        }
        if (IN(pb + 2)) {
            PH_BEGIN
            lora_phase(lds, projb, INP(9) + (size_t)l * RW_SHIFT, INP(10) + (size_t)(l > 0 ? l - 1 : 0) * 32, Wl_w, Wl_a, Wl_g, Wl_v, lw, l > 0, vcu, G, tid);
#if (MK_DBL >> 2) & 1
            lora_phase(lds, projb, INP(9) + (size_t)l * RW_SHIFT, INP(10) + (size_t)(l > 0 ? l - 1 : 0) * 32, Wl_w, Wl_a, Wl_g, Wl_v, lw, l > 0, vcu, G, tid);
#endif
            ssd_conv_phase(projb, INP(3) + (size_t)l * 4 * CONV_DIM, INP(4) + (size_t)l * CONV_DIM, INP(5) + l * SSD_H, xbcc, dtb, vcu, G, tid);
#if (MK_DBL >> 11) & 1
            ssd_conv_phase(projb, INP(3) + (size_t)l * 4 * CONV_DIM, INP(4) + (size_t)l * CONV_DIM, INP(5) + l * SSD_H, xbcc, dtb, vcu, G, tid);
#endif
            SEAM(pb + 2);
        }
        if (IN(pb + 3)) {
            PH_BEGIN
            RwScan a; a.proj_ = projb; a.lw_ = lw; a.mix = INP(9) + (size_t)l * RW_SHIFT; a.w0 = INP(11) + l * 1024; a.a0 = INP(13) + l * 1024; a.v0 = INP(15) + (l > 0 ? l - 1 : 0) * 1024;
            a.k_k = INP(18) + l * 1024; a.k_a = INP(19) + l * 1024; a.r_k = INP(20) + l * 1024; a.vf_ = vfirst; a.y_ = yrw; a.bon_ = bon; a.layer = l; a.pad = 0;
            rwkv_scan_phase(lds, a, vcu, G, tid);
#if (MK_DBL >> 3) & 1
            rwkv_scan_phase(lds, a, vcu, G, tid);
#endif
            ssd_scan_phase(lds, xbcc, dtb, INP(6) + l * SSD_H, INP(7) + l * SSD_H, yssd, vcu, G, tid);
#if (MK_DBL >> 10) & 1
            ssd_scan_phase(lds, xbcc, dtb, INP(6) + l * SSD_H, INP(7) + l * SSD_H, yssd, vcu, G, tid);
#endif
            SEAM(pb + 3);
        }
        if (IN(pb + 4)) {
            PH_BEGIN
            rwkv_post_phase(yrw, bon, lw + (size_t)2 * M * 1024, INP(21) + l * 1024, INP(22) + l * 1024, ymixb, gw, NGW, lane);
#if (MK_DBL >> 4) & 1
            rwkv_post_phase(yrw, bon, lw + (size_t)2 * M * 1024, INP(21) + l * 1024, INP(22) + l * 1024, ymixb, gw, NGW, lane);
#endif
            ssd_post_phase(yssd, projb, INP(8) + l * 1024, ymixb, gw, NGW, lane);
#if (MK_DBL >> 4) & 1
            ssd_post_phase(yssd, projb, INP(8) + l * 1024, ymixb, gw, NGW, lane);
#endif
            SEAM(pb + 4);
        }
        if (IN(pb + 5)) {
            PH_BEGIN
            pg8::Gemm g{ymixb, Wout_t, D}; pg8::StaticOrder S; S.init(M, D, G, bx);
            pg8::EpiF32 E{mixed, D};
            pg8::gemm_phase<pg8::EpiF32, pg8::StaticOrder>(lds, g, S, E, tid);
#if (MK_DBL >> 5) & 1
            pg8::gemm_phase<pg8::EpiF32, pg8::StaticOrder>(lds, g, S, E, tid);
#endif
            SEAM(pb + 5);
        }
        if (IN(pb + 6)) {
            PH_BEGIN
            const float* xin = (l == 0) ? INP(0) : xf;
            const float* gam = INP(24) + l * D; const float* bet = INP(25) + l * D;
            LAS float* rs = (LAS float*)lds;
            if (moe) { const float* router = INP(31) + (size_t)li * D * NE;
                for (int i = tid; i < D * NE; i += 512) rs[(i & 7) * D + (i >> 3)] = router[i];
                __syncthreads(); }
            for (int m = gw; m < M; m += NGW) {
                f32x4 v[8];
#pragma unroll
                for (int j = 0; j < 8; ++j) { const size_t o = (size_t)m * D + 4 * lane + 256 * j; v[j] = ALPHA * *(const f32x4*)(xin + o) + *(const f32x4*)(mixed + o); }
                ln_finish(v, gam, bet, lane, xf + (size_t)m * D, xb + (size_t)m * D);
                if (moe) {
                    float lg[8];
#pragma unroll
                    for (int e = 0; e < 8; ++e) { float s = 0.f;
#pragma unroll
                        for (int j = 0; j < 8; ++j) { const f32x4 r = *(const LAS f32x4*)(rs + e * D + 4 * lane + 256 * j); s += (v[j][0] * r[0] + v[j][1] * r[1]) + (v[j][2] * r[2] + v[j][3] * r[3]); }
                        lg[e] = wave_sum_f(s); }
                    if (lane == 0) {
                        int i0 = 0; float v0 = lg[0];
#pragma unroll
                        for (int e = 1; e < 8; ++e) if (lg[e] > v0) { v0 = lg[e]; i0 = e; }
                        int i1 = -1; float v1 = -3.4e38f;
#pragma unroll
                        for (int e = 0; e < 8; ++e) if (e != i0 && lg[e] > v1) { v1 = lg[e]; i1 = e; }
                        const float e1 = expf(v1 - v0);
                        tok_e[2 * m] = i0; tok_e[2 * m + 1] = i1; tok_g[2 * m] = 1.f / (1.f + e1); tok_g[2 * m + 1] = e1 / (1.f + e1);
                        tok_pos[2 * m] = atomicAdd(&cnt[i0], 1); tok_pos[2 * m + 1] = atomicAdd(&cnt[i1], 1);
                    }
                }
            }
            __syncthreads();
            SEAM(pb + 6);
        }
        if (IN(pb + 7)) {
            PH_BEGIN
            LAS float* scr = (LAS float*)(lds + wave * 16384);
            if (!moe) {
                cvt_job<1>(INP(28) + (size_t)li * D * DFF, D, DFF, Wffn, 0, 0, scr, gw, NGW, lane);
                cvt_job<1>(INP(29) + (size_t)li * D * DFF, D, DFF, Wffn, 0, 1, scr, gw, NGW, lane);
                cvt_job<0>(INP(30) + (size_t)li * DFF * D, DFF, D, Wffn + (size_t)2 * DFF * D, 0, 0, scr, gw, NGW, lane);
            } else {
                for (int e = 0; e < NE; ++e) {
                    cvt_job<1>(INP(32) + ((size_t)li * NE + e) * D * DFE, D, DFE, Wffn, e * 2 * DFE, 0, scr, gw, NGW, lane);
                    cvt_job<1>(INP(33) + ((size_t)li * NE + e) * D * DFE, D, DFE, Wffn, e * 2 * DFE, 1, scr, gw, NGW, lane);
                    cvt_job<0>(INP(34) + ((size_t)li * NE + e) * DFE * D, DFE, D, Wffn + (size_t)NE * 2 * DFE * D, e * D, 0, scr, gw, NGW, lane);
                }
                int start[8]; { int acc = 0;
#pragma unroll
                    for (int e = 0; e < 8; ++e) { start[e] = acc; acc += ((cnt[e] + 255) >> 8) << 8; } }
                for (int m = gw; m < M; m += NGW) {
                    u32x4 r[4];
#pragma unroll
                    for (int j = 0; j < 4; ++j) r[j] = *(const u32x4*)(xb + (size_t)m * D + 8 * lane + 512 * j);
#pragma unroll
                    for (int s = 0; s < 2; ++s) {
                        const int e = tok_e[2 * m + s], pos = tok_pos[2 * m + s];
                        int st = 0;
#pragma unroll
                        for (int q = 0; q < 8; ++q) st = (e == q) ? start[q] : st;
                        const int dest = st + pos;
#pragma unroll
                        for (int j = 0; j < 4; ++j) *(u32x4*)(xg + (size_t)dest * D + 8 * lane + 512 * j) = r[j];
                        if (lane == 0) tok_dest[2 * m + s] = dest;
                    }
                }
            }
            __syncthreads();
            SEAM(pb + 7);
        }
        if (IN(pb + 8)) {
            PH_BEGIN
            if (!moe) {
                pg8::Gemm g{xb, Wffn, D}; pg8::StaticOrder S; S.init(M, 2 * DFF, G, bx);
                pg8::EpiSwiglu E{hbuf, DFF};
                pg8::gemm_phase<pg8::EpiSwiglu, pg8::StaticOrder>(lds, g, S, E, tid);
#if (MK_DBL >> 8) & 1
                pg8::gemm_phase<pg8::EpiSwiglu, pg8::StaticOrder>(lds, g, S, E, tid);
#endif
            } else {
                pg8::Gemm g{xg, Wffn, D}; pg8::GroupedOrder S; S.init(cnt, 2 * DFE, G, bx);
                pg8::EpiSwiglu E{hbuf, DFE};
                pg8::gemm_phase<pg8::EpiSwiglu, pg8::GroupedOrder>(lds, g, S, E, tid);
#if (MK_DBL >> 8) & 1
                pg8::gemm_phase<pg8::EpiSwiglu, pg8::GroupedOrder>(lds, g, S, E, tid);
#endif
            }
            SEAM(pb + 8);
        }
        if (IN(pb + 9)) {
            PH_BEGIN
            if (!moe) {
                pg8::Gemm g{hbuf, Wffn + (size_t)2 * DFF * D, DFF}; pg8::StaticOrder S; S.init(M, D, G, bx);
                pg8::EpiF32 E{yslot, D};
                pg8::gemm_phase<pg8::EpiF32, pg8::StaticOrder>(lds, g, S, E, tid);
#if (MK_DBL >> 9) & 1
                pg8::gemm_phase<pg8::EpiF32, pg8::StaticOrder>(lds, g, S, E, tid);
#endif
#if (MK_DBL >> 5) & 1
            pg8::gemm_phase<pg8::EpiF32, pg8::StaticOrder>(lds, g, S, E, tid);
#endif
            } else {
                pg8::Gemm g{hbuf, Wffn + (size_t)NE * 2 * DFE * D, DFE}; pg8::GroupedOrder S; S.init(cnt, D, G, bx);
                pg8::EpiF32 E{yslot, D};
                pg8::gemm_phase<pg8::EpiF32, pg8::GroupedOrder>(lds, g, S, E, tid);
#if (MK_DBL >> 9) & 1
                pg8::gemm_phase<pg8::EpiF32, pg8::GroupedOrder>(lds, g, S, E, tid);
#endif
            }
            SEAM(pb + 9);
        }
        if (IN(pb + 10)) {
            PH_BEGIN
            const float* gam = INP(26) + l * D; const float* bet = INP(27) + l * D;
            float* dst = (l == 3) ? P.out : xf;
            for (int m = gw; m < M; m += NGW) {
                f32x4 v[8];
                if (!moe) {
#pragma unroll
                    for (int j = 0; j < 8; ++j) { const size_t o = (size_t)m * D + 4 * lane + 256 * j; v[j] = ALPHA * *(const f32x4*)(xf + o) + *(const f32x4*)(yslot + o); }
                } else {
                    const int d0 = tok_dest[2 * m], d1 = tok_dest[2 * m + 1]; const float g0 = tok_g[2 * m], g1 = tok_g[2 * m + 1];
#pragma unroll
                    for (int j = 0; j < 8; ++j) { const int c = 4 * lane + 256 * j;
                        v[j] = ALPHA * *(const f32x4*)(xf + (size_t)m * D + c) + g0 * *(const f32x4*)(yslot + (size_t)d0 * D + c) + g1 * *(const f32x4*)(yslot + (size_t)d1 * D + c); }
                }
                ln_finish(v, gam, bet, lane, dst + (size_t)m * D, (l == 3) ? (bf16_t*)nullptr : xb + (size_t)m * D);
            }
            SEAM(pb + 10);
        }
    }
#undef IN
#undef SEAM
}
#undef PH_BEGIN
#undef INP
#undef Win_t
#undef Wout_t
#undef Wffn
#undef Wl_w
#undef Wl_a
#undef Wl_g
#undef Wl_v
#undef xf
#undef xb
#undef projb
#undef ymixb
#undef mixed
#undef hbuf
#undef xg
#undef yslot
#undef xbcc
#undef dtb
#undef yssd
#undef lw
#undef yrw
#undef bon
#undef vfirst
#undef tok_e
#undef tok_pos
#undef tok_g
#undef tok_dest
#undef cnt


}

extern "C" void kernel_launch(void* const* d_in, const int* in_sizes, int n_in, void* d_out, int out_size, void* d_ws, size_t ws_size, hipStream_t stream) {
    (void)in_sizes; (void)out_size;
    static int grid = 0;
    if (grid == 0) {
        if (n_in != 35 || ws_size < WS_END) { fprintf(stderr, "kernel_launch: need 35 inputs and %zu bytes of workspace (got %d, %zu)\n", (size_t)WS_END, n_in, ws_size); grid = -1; return; }
        int dev = 0, cus = 0;
        if (hipGetDevice(&dev) != hipSuccess || hipDeviceGetAttribute(&cus, hipDeviceAttributeMultiprocessorCount, dev) != hipSuccess) { grid = -1; return; }
        if (hipFuncSetAttribute((const void*)fwd, hipFuncAttributeMaxDynamicSharedMemorySize, LDS_BYTES) != hipSuccess) { fprintf(stderr, "kernel_launch: hipFuncSetAttribute failed\n"); grid = -1; return; }
        int per_cu = 0;
        if (hipOccupancyMaxActiveBlocksPerMultiprocessor(&per_cu, (const void*)fwd, NWAVES * 64, LDS_BYTES) != hipSuccess || per_cu < 1) { fprintf(stderr, "kernel_launch: occupancy query says %d blocks per CU\n", per_cu); }
        (void)hipGetLastError();
        grid = cus;
    }
    if (grid < 0) return;
    unsigned char* ws = (unsigned char*)d_ws;
    (void)hipMemsetAsync(ws + WS_CTL, 0, CTL_BYTES, stream);
    Params P{};
    for (int i = 0; i < 35; ++i) P.in[i] = (const float*)d_in[i];
    P.out = (float*)d_out; P.ws = ws; P.pad = 0;
    int nbar = 0;
    auto run = [&](int lo, int hi) {
        P.ph_lo = lo; P.ph_hi = hi; P.bar_idx = (hi - lo > 1) ? nbar++ : 0;
        hipLaunchKernelGGL(fwd, dim3(grid), dim3(NWAVES * 64), LDS_BYTES, stream, P);
    };
    if (MK_LAUNCH_MODE == 1) run(0, 64);
    else if (MK_LAUNCH_MODE == 4) { for (int l = 0; l < 4; ++l) run(l * 16, l * 16 + 16); }
    else { for (int l = 0; l < 4; ++l) for (int k = 0; k <= 10; ++k) run(l * 16 + k, l * 16 + k + 1); }
}
```

```cpp
#define MK_DBL 0
#include <hip/hip_runtime.h>
#include <cstdint>
#include <cstdio>

#ifndef MK_DBL
#define MK_DBL 0
#endif
#ifndef MK_LAUNCH_MODE
#define MK_LAUNCH_MODE 1
#endif
namespace {
constexpr int BATCH = 8, SEQ = 2048, M = BATCH * SEQ, D = 2048;
constexpr int HD = 64, SSD_H = 16, SSD_N = 128, CONV_DIM = 1536;
constexpr int RW_H = 16;
constexpr int IN_DIM = 5936, PROJ_LD = 5968;
constexpr int OFF_Z = 0, OFF_XBC = 1024, OFF_DT = 2560, OFF_RW = 2576, OFF_R = 2576, OFF_K = 3600, OFF_V = 4624, OFF_WLO = 5648, OFF_ALO = 5712, OFF_GLO = 5776, OFF_VLO = 5936;
constexpr int RW_SHIFT = 3360;
constexpr int DFF = 5632, NE = 8, DFE = 2816;
constexpr float ALPHA = 1.681792830507429f;
constexpr int LORA_LD = 320;

__device__ __forceinline__ float sigmoidf_(float x) { return 1.f / (1.f + expf(-x)); }
__device__ __forceinline__ float siluf_(float x) { return x / (1.f + expf(-x)); }
__device__ __forceinline__ float softplusf_(float x) { return fmaxf(x, 0.f) + log1pf(expf(-fabsf(x))); }
__device__ __forceinline__ float wave_sum(float v) {
#pragma unroll
    for (int o = 32; o >= 1; o >>= 1) v += __shfl_xor(v, o);
    return v;
}


#define LAS __attribute__((address_space(3)))
typedef unsigned short bf16_t;
typedef short bf16x8 __attribute__((ext_vector_type(8)));
typedef float f32x4 __attribute__((ext_vector_type(4)));
typedef float f32x2 __attribute__((ext_vector_type(2)));
typedef unsigned u32x4 __attribute__((ext_vector_type(4)));
typedef unsigned u32x2 __attribute__((ext_vector_type(2)));

__device__ __forceinline__ unsigned cvt_pk_bf16(float lo, float hi) { unsigned r; asm volatile("v_cvt_pk_bf16_f32 %0, %1, %2" : "=v"(r) : "v"(lo), "v"(hi)); return r; }
__device__ __forceinline__ float bf_lo(unsigned w) { return __uint_as_float(w << 16); }
__device__ __forceinline__ float bf_hi(unsigned w) { return __uint_as_float(w & 0xffff0000u); }
__device__ __forceinline__ float bf2f(bf16_t b) { return __uint_as_float(((unsigned)b) << 16); }
__device__ __forceinline__ float fast_silu(float x) { return x * __builtin_amdgcn_rcpf(1.f + __builtin_amdgcn_exp2f(-1.4426950408889634f * x)); }

namespace pg8 {
constexpr int BM = 256, BK = 64, HALF = 128, HTB = HALF * BK * 2, STAGE_BYTES = 8 * HTB, NXCD = 8, WGM = 8;
__host__ __device__ __forceinline__ int lds_byte(int r, int c) { const int st = (r >> 4) * 2 + (c >> 5), rr = r & 15, cc = c & 31, ob = rr * 64 + cc * 2; return st * 1024 + (ob ^ (((ob >> 9) & 1) << 5)); }
__host__ __device__ __forceinline__ void stage_rc(int b, int& R, int& C) { const int st = b / 1024, sb = b % 1024, swz = sb ^ (((sb >> 9) & 1) << 5); R = (st >> 1) * 16 + swz / 64; C = (st & 1) * 32 + (swz % 64) / 2; }
__host__ __device__ __forceinline__ int perm32(int rho) { const int n = rho >> 4, i = rho & 15; return 8 * (i >> 2) + 4 * n + (i & 3); }

struct Unit { int pm, pn, pb; };
struct Gemm { const bf16_t* A; const bf16_t* Bt; int K; };

__device__ __forceinline__ void decode_unit(int wgid, int nM, int nN, int& pm, int& pn) {
    const int nwg = nM * nN;
    { const int q = nwg / NXCD, r = nwg % NXCD, xcd = wgid % NXCD, off = wgid / NXCD; wgid = (xcd < r ? xcd * (q + 1) : r * (q + 1) + (xcd - r) * q) + off; }
    const int nig = WGM * nN, gid = wgid / nig, fm = gid * WGM, gsz = (nM - fm) < WGM ? (nM - fm) : WGM;
    pm = fm + ((wgid % nig) % gsz); pn = (wgid % nig) / gsz;
}
struct StaticOrder {
    int nM, nN, nwg, G, c;
    __device__ void init(int Mrows, int N, int G_, int c_) { nM = Mrows / BM; nN = N / BM; nwg = nM * nN; G = G_; c = c_; }
    __device__ __forceinline__ bool next(int i, Unit& u) const {
        const long L = (long)i * G + c; if (L >= nwg) return false;
        decode_unit((int)L, nM, nN, u.pm, u.pn); u.pb = u.pn; return true;
    }
};
struct GroupedOrder {
    int nM, nN, nwg, G, c; int cum[9];
    __device__ void init(const int* cnt, int N, int G_, int c_) {
        int acc = 0;
#pragma unroll
        for (int e = 0; e < 8; ++e) { cum[e] = acc; acc += (cnt[e] + 255) >> 8; }
        cum[8] = acc; nM = acc; nN = N / BM; nwg = nM * nN; G = G_; c = c_;
    }
    __device__ __forceinline__ bool next(int i, Unit& u) const {
        const long L = (long)i * G + c; if (L >= nwg) return false;
        decode_unit((int)L, nM, nN, u.pm, u.pn);
        int e = 0;
#pragma unroll
        for (int q = 1; q < 8; ++q) e += (u.pm >= cum[q]) ? 1 : 0;
        u.pb = e * nN + u.pn; return true;
    }
};

struct EpiF32 {
    static constexpr bool PERM = false;
    float* C; int ldc;
    __device__ __forceinline__ void operator()(const f32x4 (&acc)[2][2][4][2], const Unit& u, int wr, int wc, int fr, int fq) const {
        const int row0 = u.pm * BM + wr * 64 + fr, col0 = u.pn * BM + wc * 32 + 4 * fq;
#pragma unroll
        for (int ai = 0; ai < 2; ++ai)
#pragma unroll
            for (int m = 0; m < 4; ++m) { float* rowp = C + (size_t)(row0 + ai * HALF + m * 16) * ldc + col0;
#pragma unroll
                for (int bj = 0; bj < 2; ++bj)
#pragma unroll
                    for (int n = 0; n < 2; ++n) *(f32x4*)(rowp + bj * HALF + n * 16) = acc[ai][bj][m][n]; }
    }
};
struct EpiBf16 {
    static constexpr bool PERM = true;
    bf16_t* O; int ldc;
    __device__ __forceinline__ void operator()(const f32x4 (&acc)[2][2][4][2], const Unit& u, int wr, int wc, int fr, int fq) const {
        const int row0 = u.pm * BM + wr * 64 + fr, col0 = u.pn * BM + wc * 32 + 8 * fq;
#pragma unroll
        for (int ai = 0; ai < 2; ++ai)
#pragma unroll
            for (int m = 0; m < 4; ++m) { bf16_t* rowp = O + (size_t)(row0 + ai * HALF + m * 16) * ldc + col0;
#pragma unroll
                for (int bj = 0; bj < 2; ++bj) { const f32x4 v0 = acc[ai][bj][m][0], v1 = acc[ai][bj][m][1];
                    u32x4 w; w.x = cvt_pk_bf16(v0[0], v0[1]); w.y = cvt_pk_bf16(v0[2], v0[3]); w.z = cvt_pk_bf16(v1[0], v1[1]); w.w = cvt_pk_bf16(v1[2], v1[3]);
                    *(u32x4*)(rowp + bj * HALF) = w; } }
    }
};
struct EpiSwiglu {
    static constexpr bool PERM = true;
    bf16_t* O; int ldc;
    __device__ __forceinline__ void operator()(const f32x4 (&acc)[2][2][4][2], const Unit& u, int wr, int wc, int fr, int fq) const {
        const int row0 = u.pm * BM + wr * 64 + fr, col0 = u.pn * HALF + wc * 32 + 8 * fq;
#pragma unroll
        for (int ai = 0; ai < 2; ++ai)
#pragma unroll
            for (int m = 0; m < 4; ++m) { bf16_t* rowp = O + (size_t)(row0 + ai * HALF + m * 16) * ldc + col0;
                float o[8];
#pragma unroll
                for (int n = 0; n < 2; ++n)
#pragma unroll
                    for (int i = 0; i < 4; ++i) o[n * 4 + i] = fast_silu(acc[ai][0][m][n][i]) * acc[ai][1][m][n][i];
                u32x4 w; w.x = cvt_pk_bf16(o[0], o[1]); w.y = cvt_pk_bf16(o[2], o[3]); w.z = cvt_pk_bf16(o[4], o[5]); w.w = cvt_pk_bf16(o[6], o[7]);
                *(u32x4*)rowp = w; }
    }
};

template <class Epi, class Sched>
__device__ __forceinline__ void gemm_phase(LAS unsigned char* lds, const Gemm g, const Sched& S, const Epi& E, const int tid) {
    const int wid = __builtin_amdgcn_readfirstlane(tid >> 6), lane = tid & 63, wr = wid >> 2, wc = wid & 3, fr = lane & 15, fq = lane >> 4;
    const int K = g.K, nt = K / BK;
    unsigned voffA[2], voffB[2];
#pragma unroll
    for (int i = 0; i < 2; ++i) { int R, C; stage_rc(tid * 16 + i * 8192, R, C); const int Rb = Epi::PERM ? ((R & ~31) + perm32(R & 31)) : R;
        voffA[i] = (unsigned)(R * K + C) * 2u; voffB[i] = (unsigned)(Rb * K + C) * 2u; }
    const size_t kstep = (size_t)(BK * 2);
    const size_t hstep = (size_t)HALF * K * 2;
    const size_t tstep = 2 * hstep;
    const unsigned ldsw = (unsigned)wid * 1024u;
    const int aoff = lds_byte(wr * 64 + fr, fq * 8), boff = lds_byte(wc * 32 + fr, fq * 8);
#define PG8_SA(b, h) (((b) * 2 + (h)) * HTB)
#define PG8_SB(b, h) ((4 + (b) * 2 + (h)) * HTB)
#define PG8_STAGE(bufoff, gbase, voff) do { _Pragma("unroll") for (int _i = 0; _i < 2; ++_i) \
        __builtin_amdgcn_global_load_lds((const unsigned*)((const char*)(gbase) + (voff)[_i]), (LAS unsigned*)(lds + (bufoff) + ldsw + _i * 8192), 16, 0, 0); } while (0)
#define PG8_LDA(dst, b, h) do { _Pragma("unroll") for (int m = 0; m < 4; ++m) _Pragma("unroll") for (int k = 0; k < 2; ++k) dst[m][k] = *(const LAS bf16x8*)(lds + PG8_SA(b, h) + aoff + m * 2048 + k * 1024); } while (0)
#define PG8_LDB(dst, b, h) do { _Pragma("unroll") for (int n = 0; n < 2; ++n) _Pragma("unroll") for (int k = 0; k < 2; ++k) dst[n][k] = *(const LAS bf16x8*)(lds + PG8_SB(b, h) + boff + n * 2048 + k * 1024); } while (0)
#define PG8_MMA(ai, bj, At, Bt) do { __builtin_amdgcn_s_setprio(1); _Pragma("unroll") for (int m = 0; m < 4; ++m) _Pragma("unroll") for (int n = 0; n < 2; ++n) _Pragma("unroll") for (int k = 0; k < 2; ++k) \
        acc[ai][bj][m][n] = __builtin_amdgcn_mfma_f32_16x16x32_bf16(Bt[n][k], At[m][k], acc[ai][bj][m][n], 0, 0, 0); __builtin_amdgcn_s_setprio(0); } while (0)
#define PG8_WAIT_V(n) asm volatile("s_waitcnt vmcnt(" #n ")" ::: "memory")
#define PG8_WAIT_L(n) asm volatile("s_waitcnt lgkmcnt(" #n ")" ::: "memory")
#define PG8_BAR __builtin_amdgcn_s_barrier()
#define PG8_SCHED __builtin_amdgcn_sched_barrier(0)
    Unit cur, nxt; int ui = 0;
    if (!S.next(0, cur)) return;
    f32x4 acc[2][2][4][2];
#pragma unroll
    for (int a = 0; a < 2; ++a)
#pragma unroll
        for (int b = 0; b < 2; ++b)
#pragma unroll
            for (int m = 0; m < 4; ++m)
#pragma unroll
                for (int n = 0; n < 2; ++n) acc[a][b][m][n] = (f32x4){0.f, 0.f, 0.f, 0.f};
    bf16x8 At[4][2], B0[2][2], B1[2][2];
    const char* cA = (const char*)g.A + (size_t)cur.pm * tstep; const char* cB = (const char*)g.Bt + (size_t)cur.pb * tstep;
    PG8_STAGE(PG8_SB(0, 0), cB, voffB); PG8_STAGE(PG8_SB(0, 1), cB + hstep, voffB); PG8_STAGE(PG8_SA(0, 0), cA, voffA); PG8_STAGE(PG8_SA(0, 1), cA + hstep, voffA);
    if (wr == 1) PG8_BAR;
    PG8_WAIT_V(2); PG8_BAR;
    PG8_STAGE(PG8_SB(1, 0), cB + kstep, voffB); PG8_STAGE(PG8_SA(1, 0), cA + kstep, voffA); PG8_STAGE(PG8_SB(1, 1), cB + hstep + kstep, voffB);
    PG8_WAIT_V(6); PG8_BAR;
    for (;;) {
        const bool has_next = S.next(ui + 1, nxt);
        const char* nA = has_next ? (const char*)g.A + (size_t)nxt.pm * tstep : cA; const char* nB = has_next ? (const char*)g.Bt + (size_t)nxt.pb * tstep : cB;
        for (int t = 0; t < nt; t += 2) {
            const bool last = (t == nt - 2);
            const char* a1 = cA + (size_t)(t + 1) * kstep;
            const char* a2 = last ? nA : cA + (size_t)(t + 2) * kstep; const char* b2 = last ? nB : cB + (size_t)(t + 2) * kstep;
            const char* a3 = a2 + kstep; const char* b3 = b2 + kstep;
            PG8_LDB(B0, 0, 0); PG8_LDB(B1, 0, 1); PG8_SCHED; PG8_LDA(At, 0, 0); PG8_STAGE(PG8_SA(1, 1), a1 + hstep, voffA);
            PG8_WAIT_V(8); PG8_WAIT_L(0); PG8_BAR; PG8_MMA(0, 0, At, B0); PG8_MMA(0, 1, At, B1); PG8_BAR; PG8_SCHED;
            PG8_LDA(At, 0, 1); PG8_STAGE(PG8_SB(0, 0), b2, voffB); PG8_STAGE(PG8_SB(0, 1), b2 + hstep, voffB); PG8_STAGE(PG8_SA(0, 0), a2, voffA);
            PG8_WAIT_V(8); PG8_WAIT_L(0); PG8_BAR; PG8_MMA(1, 0, At, B0); PG8_MMA(1, 1, At, B1); PG8_BAR; PG8_SCHED;
            PG8_LDB(B0, 1, 0); PG8_LDB(B1, 1, 1); PG8_SCHED; PG8_LDA(At, 1, 0); PG8_STAGE(PG8_SA(0, 1), a2 + hstep, voffA);
            PG8_WAIT_V(8); PG8_WAIT_L(0); PG8_BAR; PG8_MMA(0, 0, At, B0); PG8_MMA(0, 1, At, B1); PG8_BAR; PG8_SCHED;
            PG8_LDA(At, 1, 1); PG8_STAGE(PG8_SB(1, 0), b3, voffB); PG8_STAGE(PG8_SB(1, 1), b3 + hstep, voffB); PG8_STAGE(PG8_SA(1, 0), a3, voffA);
            PG8_WAIT_V(8); PG8_WAIT_L(0); PG8_BAR; PG8_MMA(1, 0, At, B0); PG8_MMA(1, 1, At, B1); PG8_BAR; PG8_SCHED;
        }
        if (wr == 0) PG8_BAR;
        E(acc, cur, wr, wc, fr, fq);
        if (!has_next) break;
#pragma unroll
        for (int a = 0; a < 2; ++a)
#pragma unroll
            for (int b = 0; b < 2; ++b)
#pragma unroll
                for (int m = 0; m < 4; ++m)
#pragma unroll
                    for (int n = 0; n < 2; ++n) acc[a][b][m][n] = (f32x4){0.f, 0.f, 0.f, 0.f};
        cur = nxt; cA = nA; cB = nB; ++ui;
        if (wr == 1) PG8_BAR;
    }
    PG8_WAIT_V(0);
    PG8_BAR;
#undef PG8_SA
#undef PG8_SB
#undef PG8_STAGE
#undef PG8_LDA
#undef PG8_LDB
#undef PG8_MMA
#undef PG8_WAIT_V
#undef PG8_WAIT_L
#undef PG8_BAR
#undef PG8_SCHED
}
}

#define XB_TMO      128
#define XB_XCNT(j)  (256  + 64 * (j))
#define XB_XSUB(j)  (1280 + 64 * (j))
#define XB_XGEN(j)  (2304 + 64 * (j))
#define XB_TOP      3328
#define XB_TOPGEN   3392
#define XCD_BAR_WORDS 3456
#define XB_SPIN_CAP (1u << 18)
__device__ __forceinline__ unsigned xb_ld(unsigned* p)              { return __hip_atomic_load(p, __ATOMIC_RELAXED, __HIP_MEMORY_SCOPE_AGENT); }
__device__ __forceinline__ unsigned xb_add(unsigned* p, unsigned v) { return __hip_atomic_fetch_add(p, v, __ATOMIC_RELAXED, __HIP_MEMORY_SCOPE_AGENT); }
__device__ __forceinline__ unsigned xb_xcc_id() { return (unsigned)__builtin_amdgcn_s_getreg((3 << 11) | 20) & 0xFu; }
#define XB_SPIN(cond, bar) do { unsigned _sp = 0; while (cond) { __builtin_amdgcn_s_sleep(1); \
    if ((++_sp & 255u) == 0u) { if (xb_ld(&(bar)[XB_TMO])) break; if (_sp > XB_SPIN_CAP) { atomicAdd(&(bar)[XB_TMO], 1u); break; } } } } while (0)
struct XcdBarrier { unsigned* bar; unsigned x; volatile LAS unsigned* st; };
__device__ __forceinline__ XcdBarrier xcd_barrier_post(unsigned* bar, volatile LAS unsigned* st) {
    XcdBarrier b; b.bar = bar; b.x = xb_xcc_id(); b.st = st;
    if (threadIdx.x == 0) (void)xb_add(&bar[XB_XCNT(b.x)], 1u);
    return b;
}
__device__ __forceinline__ void xcd_barrier_complete(unsigned* bar, unsigned x, unsigned& nloc, unsigned& nx) {
    const unsigned G = gridDim.x * gridDim.y * gridDim.z;
    asm volatile("" : "+s"(x));
    unsigned sum, cnt, mine, sp = 0u;
    for (;;) {
        sum = 0u; cnt = 0u; mine = 0u;
#pragma unroll
        for (unsigned j = 0; j < 16; ++j) { const unsigned c = xb_ld(&bar[XB_XCNT(j)]); sum += c; cnt += (c > 0u) ? 1u : 0u; mine = (j == x) ? c : mine; }
        if (sum == G) break;
        __builtin_amdgcn_s_sleep(1);
        if ((++sp & 255u) == 0u) { if (xb_ld(&bar[XB_TMO])) break; if (sp > XB_SPIN_CAP) { atomicAdd(&bar[XB_TMO], 1u); break; } }
    }
    nloc = mine > 0u ? mine : 1u; nx = cnt > 0u ? cnt : 1u;
}
__device__ __forceinline__ void xcd_barrier(const XcdBarrier& b) {
    asm volatile("s_waitcnt vmcnt(0)" ::: "memory");
    __syncthreads();
    if (threadIdx.x == 0) {
        unsigned* bar = b.bar;
        __builtin_amdgcn_s_waitcnt(0);
        unsigned nloc = b.st[0], nx = b.st[1];
        if (nloc == 0u) { xcd_barrier_complete(bar, b.x, nloc, nx); b.st[0] = nloc; b.st[1] = nx; }
        const unsigned old = xb_add(&bar[XB_XSUB(b.x)], 1u);
        const unsigned gen = old / nloc;
        if (old + 1u == (gen + 1u) * nloc) {
            __builtin_amdgcn_fence(__ATOMIC_RELEASE, "agent");
            asm volatile("s_waitcnt vmcnt(0)" ::: "memory");
            const unsigned og = xb_add(&bar[XB_TOP], 1u);
            const unsigned tg = og / nx;
            if (og + 1u == (tg + 1u) * nx) xb_add(&bar[XB_TOPGEN], 1u);
            else XB_SPIN(xb_ld(&bar[XB_TOPGEN]) == tg, bar);
            __builtin_amdgcn_fence(__ATOMIC_ACQUIRE, "agent");
            xb_add(&bar[XB_XGEN(b.x)], 1u);
            asm volatile("s_waitcnt vmcnt(0)" ::: "memory");
        } else {
            XB_SPIN(xb_ld(&bar[XB_XGEN(b.x)]) == gen, bar);
            __builtin_amdgcn_fence(__ATOMIC_ACQUIRE, "agent");
            asm volatile("s_waitcnt vmcnt(0)" ::: "memory");
        }
    }
    __syncthreads();
}

constexpr size_t MiB = 1u << 20;
constexpr int NWAVES = 8;
constexpr int PROJ_BLD = 6144;
constexpr int PMAX = 34816;
constexpr size_t WS_CTL = 0, CTL_BYTES = 1 * MiB;
constexpr size_t WS_WIN = 1 * MiB, WS_WOUT = 25 * MiB, WS_WLORA = 33 * MiB;
constexpr size_t WS_XF = 34 * MiB, WS_XB = 162 * MiB, WS_VFIRST = 226 * MiB, WS_YMIXB = 290 * MiB, WS_TOK = 354 * MiB, WS_SCR = 356 * MiB;
constexpr size_t WS_PROJB = WS_SCR, WS_LW = WS_PROJB + 192 * MiB, WS_YRW = WS_LW + 128 * MiB, WS_BON = WS_YRW + 64 * MiB, WS_XBCC = WS_BON + 64 * MiB, WS_DTB = WS_XBCC + 48 * MiB, WS_YSSD = WS_DTB + 1 * MiB, WS_MIXED = WS_YSSD + 64 * MiB;
constexpr size_t WS_HBUF = WS_SCR, WS_XG = WS_HBUF + 187 * MiB, WS_YSLOT = WS_XG + 136 * MiB;
constexpr size_t WS_WFFN = WS_SCR + 860 * MiB, WS_END = WS_WFFN + 264 * MiB;
static_assert(WS_MIXED + 128 * MiB <= WS_WFFN && WS_YSLOT + 272 * MiB <= WS_WFFN, "scratch inside the map");
static_assert((size_t)PMAX * DFE * 2 <= 187 * MiB && (size_t)PMAX * D * 2 <= 136 * MiB && (size_t)PMAX * D * 4 <= 272 * MiB, "moe buffers");
constexpr int CW_CNT = 16;
constexpr int CW_BAR = 4096;
constexpr int MAX_BAR_REGIONS = 48;
static_assert((CW_BAR + MAX_BAR_REGIONS * XCD_BAR_WORDS) * 4 <= (int)CTL_BYTES, "ctl");
constexpr int RING_BYTES = 131072, LDS_BYTES = 147456, MISC_OFF = LDS_BYTES - 256;

struct Params { const float* in[35]; float* out; unsigned char* ws; int ph_lo, ph_hi, bar_idx, pad; };

__device__ __forceinline__ float wave_sum_f(float v) {
#pragma unroll
    for (int o = 32; o >= 1; o >>= 1) v += __shfl_xor(v, o);
    return v;
}

__device__ __forceinline__ void cvt_item(const float* W, int K, int N, bf16_t* WT, int dst_row0, LAS float* scr, int k0, int n0, int lane) {
#pragma unroll 8
    for (int i = 0; i < 32; ++i) { const int kk = 2 * i + (lane >> 5), col = lane & 31;
        scr[kk * 33 + col] = (k0 + kk < K && n0 + col < N) ? W[(size_t)(k0 + kk) * N + n0 + col] : 0.f; }
    asm volatile("s_waitcnt lgkmcnt(0)" ::: "memory");
    const int c = lane & 7;
#pragma unroll
    for (int j = 0; j < 4; ++j) { const int n = (lane >> 3) + 8 * j; const LAS float* s = scr + (8 * c) * 33 + n;
        u32x4 o; o.x = cvt_pk_bf16(s[0 * 33], s[1 * 33]); o.y = cvt_pk_bf16(s[2 * 33], s[3 * 33]); o.z = cvt_pk_bf16(s[4 * 33], s[5 * 33]); o.w = cvt_pk_bf16(s[6 * 33], s[7 * 33]);
        if (n0 + n < N && k0 + 8 * c < K) *(u32x4*)(WT + (size_t)(dst_row0 + n) * K + k0 + 8 * c) = o; }
    asm volatile("s_waitcnt lgkmcnt(0)" ::: "memory");
}
template <int MODE>
__device__ __forceinline__ void cvt_job(const float* W, int K, int N, bf16_t* WT, int row_off, int half, LAS float* scr, int gw, int ngw, int lane) {
    const int nkb = (K + 63) / 64, nnb = (N + 31) / 32, nitems = nkb * nnb;
    for (int it = gw; it < nitems; it += ngw) {
        const int kb = it / nnb, nb = it % nnb, n0 = nb * 32;
        const int dr = MODE == 0 ? row_off + n0 : row_off + 256 * (n0 / 128) + half * 128 + (n0 % 128);
        cvt_item(W, K, N, WT, dr, scr, kb * 64, n0, lane);
    }
}

struct LnOut { float* xf; bf16_t* xb; };
__device__ __forceinline__ void ln_finish(f32x4 (&v)[8], const float* gam, const float* bet, int lane, float* xf_row, bf16_t* xb_row) {
    float s = 0.f;
#pragma unroll
    for (int j = 0; j < 8; ++j) s += (v[j][0] + v[j][1]) + (v[j][2] + v[j][3]);
    const float mean = wave_sum_f(s) * (1.f / D);
    float q = 0.f;
#pragma unroll
    for (int j = 0; j < 8; ++j) { v[j] = v[j] - mean; q += (v[j][0] * v[j][0] + v[j][1] * v[j][1]) + (v[j][2] * v[j][2] + v[j][3] * v[j][3]); }
    const float rstd = rsqrtf(wave_sum_f(q) * (1.f / D) + 1e-5f);
#pragma unroll
    for (int j = 0; j < 8; ++j) { const int c = 4 * lane + 256 * j;
        const f32x4 g = *(const f32x4*)(gam + c), b = *(const f32x4*)(bet + c);
        v[j] = v[j] * rstd * g + b;
        *(f32x4*)(xf_row + c) = v[j];
        if (xb_row) { u32x2 w; w.x = cvt_pk_bf16(v[j][0], v[j][1]); w.y = cvt_pk_bf16(v[j][2], v[j][3]); *(u32x2*)(xb_row + c) = w; } }
}

#define DPP_ROR(z, n) __uint_as_float(__builtin_amdgcn_update_dpp(0u, __float_as_uint(z), 0x120 + (n), 0xf, 0xf, false))
__device__ __forceinline__ float wave_allsum(float x) {
    { auto s = __builtin_amdgcn_permlane32_swap(__float_as_uint(x), __float_as_uint(x), false, false); x = __uint_as_float(s[0]) + __uint_as_float(s[1]); }
    { auto s = __builtin_amdgcn_permlane16_swap(__float_as_uint(x), __float_as_uint(x), false, false); x = __uint_as_float(s[0]) + __uint_as_float(s[1]); }
    x += DPP_ROR(x, 8); x += DPP_ROR(x, 4); x += DPP_ROR(x, 2); x += DPP_ROR(x, 1);
    return x;
}
__device__ __forceinline__ float reduce4(float x0, float x1, float x2, float x3) {
    float y0, y1, z;
    { auto s = __builtin_amdgcn_permlane32_swap(__float_as_uint(x0), __float_as_uint(x2), false, false); y0 = __uint_as_float(s[0]) + __uint_as_float(s[1]); }
    { auto s = __builtin_amdgcn_permlane32_swap(__float_as_uint(x1), __float_as_uint(x3), false, false); y1 = __uint_as_float(s[0]) + __uint_as_float(s[1]); }
    { auto s = __builtin_amdgcn_permlane16_swap(__float_as_uint(y0), __float_as_uint(y1), false, false); z = __uint_as_float(s[0]) + __uint_as_float(s[1]); }
    z += DPP_ROR(z, 8); z += DPP_ROR(z, 4); z += DPP_ROR(z, 2); z += DPP_ROR(z, 1);
    return z;
}
__device__ __forceinline__ float rdlane(float v, int l) { return __int_as_float(__builtin_amdgcn_readlane(__float_as_int(v), l)); }
__device__ __forceinline__ float fast_sigmoid(float x) { return __builtin_amdgcn_rcpf(1.f + __builtin_amdgcn_exp2f(-1.4426950408889634f * x)); }
__device__ __forceinline__ float fast_tanh(float x) { return 1.f - 2.f * __builtin_amdgcn_rcpf(1.f + __builtin_amdgcn_exp2f(2.8853900817779268f * x)); }

constexpr int LORA_PITCH = 328;
__device__ __forceinline__ void lora_phase(LAS unsigned char* lds, const bf16_t* projb, const float* mix, const float* vmix, const bf16_t* Wl_w, const bf16_t* Wl_a, const bf16_t* Wl_g, const bf16_t* Wl_v,
                                           bf16_t* lw, const bool has_v, const int vcu, const int G, const int tid) {
    const int wave = __builtin_amdgcn_readfirstlane(tid >> 6), lane = tid & 63, fr = lane & 15, fq = lane >> 4;
    LAS bf16_t* Aimg = (LAS bf16_t*)lds;
    for (int u = vcu; u < M / 64; u += G) {
        {
            const int tau = tid >> 3, part = tid & 7, m = u * 64 + tau; const bool first = (m % SEQ) == 0;
#pragma unroll
            for (int i = 0; i < 5; ++i) {
                const int j0 = 40 * part + 8 * i;
                const u32x4 cur = *(const u32x4*)(projb + (size_t)m * PROJ_BLD + OFF_WLO + j0);
                u32x4 prv = (u32x4){0u, 0u, 0u, 0u};
                if (!first) prv = *(const u32x4*)(projb + (size_t)(m - 1) * PROJ_BLD + OFF_WLO + j0);
                f32x4 mx0, mx1;
                if (j0 < 288) { mx0 = *(const f32x4*)(mix + (OFF_WLO - OFF_RW) + j0); mx1 = *(const f32x4*)(mix + (OFF_WLO - OFF_RW) + j0 + 4); }
                else if (has_v) { mx0 = *(const f32x4*)(vmix + (j0 - 288)); mx1 = *(const f32x4*)(vmix + (j0 - 288) + 4); }
                else { mx0 = (f32x4){0.f, 0.f, 0.f, 0.f}; mx1 = mx0; }
                float o[8];
#pragma unroll
                for (int e = 0; e < 4; ++e) {
                    const float c0 = bf_lo(cur[e]), c1 = bf_hi(cur[e]), p0 = bf_lo(prv[e]), p1 = bf_hi(prv[e]);
                    const float m0 = (e < 2) ? mx0[2 * e] : mx1[2 * e - 4], m1 = (e < 2) ? mx0[2 * e + 1] : mx1[2 * e - 3];
                    o[2 * e] = c0 + (p0 - c0) * m0; o[2 * e + 1] = c1 + (p1 - c1) * m1;
                }
                if (j0 < 64) {
#pragma unroll
                    for (int e = 0; e < 8; ++e) o[e] = fast_tanh(o[e]);
                } else if (j0 >= 128 && j0 < 288) {
#pragma unroll
                    for (int e = 0; e < 8; ++e) o[e] = fast_sigmoid(o[e]);
                }
                u32x4 w; w.x = cvt_pk_bf16(o[0], o[1]); w.y = cvt_pk_bf16(o[2], o[3]); w.z = cvt_pk_bf16(o[4], o[5]); w.w = cvt_pk_bf16(o[6], o[7]);
                *(LAS u32x4*)(Aimg + tau * LORA_PITCH + j0) = w;
            }
        }
        __syncthreads();
        for (int q = 0; q < 4; ++q) {
            if (q == 3 && !has_v) break;
            const int K = (q == 2) ? 160 : (q == 3 ? 32 : 64), koff = (q == 0) ? 0 : (q == 1 ? 64 : (q == 2 ? 128 : 288));
            const bf16_t* W = (q == 0) ? Wl_w : (q == 1 ? Wl_a : (q == 2 ? Wl_g : Wl_v));
            f32x4 acc[8][4];
#pragma unroll
            for (int ct = 0; ct < 8; ++ct)
#pragma unroll
                for (int tt = 0; tt < 4; ++tt) acc[ct][tt] = (f32x4){0.f, 0.f, 0.f, 0.f};
            for (int ks = 0; ks < K / 32; ++ks) {
                bf16x8 af[8], bfr[4];
#pragma unroll
                for (int ct = 0; ct < 8; ++ct) af[ct] = *(const bf16x8*)(W + (size_t)(128 * wave + 16 * ct + fr) * K + 32 * ks + 8 * fq);
#pragma unroll
                for (int tt = 0; tt < 4; ++tt) bfr[tt] = *(const LAS bf16x8*)(Aimg + (16 * tt + fr) * LORA_PITCH + koff + 32 * ks + 8 * fq);
#pragma unroll
                for (int ct = 0; ct < 8; ++ct)
#pragma unroll
                    for (int tt = 0; tt < 4; ++tt) acc[ct][tt] = __builtin_amdgcn_mfma_f32_16x16x32_bf16(af[ct], bfr[tt], acc[ct][tt], 0, 0, 0);
            }
            bf16_t* out = lw + (size_t)q * M * 1024;
#pragma unroll
            for (int ct = 0; ct < 8; ++ct)
#pragma unroll
                for (int tt = 0; tt < 4; ++tt) { u32x2 w; w.x = cvt_pk_bf16(acc[ct][tt][0], acc[ct][tt][1]); w.y = cvt_pk_bf16(acc[ct][tt][2], acc[ct][tt][3]);
                    *(u32x2*)(out + (size_t)(u * 64 + 16 * tt + fr) * 1024 + 128 * wave + 16 * ct + 4 * fq) = w; }
        }
        __syncthreads();
    }
}

struct RwScan { const bf16_t* proj_; const bf16_t* lw_; const float* mix; const float* w0; const float* a0; const float* v0; const float* k_k; const float* k_a; const float* r_k; float* vf_; float* y_; float* bon_; int layer; int pad; };
constexpr int RWB_A = 0, RWB_DR = 8192, RWB_D = 16384, RWB_B = 24576, RWB_K = 32768, RWB_V = 40960, RWB_SC = 45056, RWB_SIZE = 45568, RW_YST = 3 * RWB_SIZE, RW_YST_SIZE = 4096, RW_TB = 32, RW_NCH = SEQ / RW_TB;
static_assert(RW_YST + 2 * RW_YST_SIZE <= MISC_OFF, "rwkv scan LDS map");
__device__ __forceinline__ float rowsum16(float z) { z += DPP_ROR(z, 8); asm("" : "+v"(z)); z += DPP_ROR(z, 4); asm("" : "+v"(z)); z += DPP_ROR(z, 2); asm("" : "+v"(z)); z += DPP_ROR(z, 1); asm("" : "+v"(z)); return z; }
__device__ __forceinline__ void rwkv_scan_phase(LAS unsigned char* lds, const RwScan& a, const int vcu, const int G, const int tid) {
    const int wave = __builtin_amdgcn_readfirstlane(tid >> 6), lane = tid & 63, jj = lane & 15, rg = lane >> 4;
    for (int u = vcu; u < BATCH * RW_H * 2; u += G) {
        const int b = u >> 5, h = (u >> 1) & 15, half = u & 1;
        if (wave >= 4) {
            const int pw_ = wave - 4, c = h * 64 + lane, ptid = tid - 256;
            const float mix_r = a.mix[c], mix_k = a.mix[1024 + c], mix_v = a.mix[2048 + c];
            const float w0c = a.w0[c], a0c = a.a0[c], v0c = a.layer ? a.v0[c] : 0.f, kkc = a.k_k[c], kac = a.k_a[c], rkc = a.r_k[c];
            const bf16_t* lw_w = a.lw_; const bf16_t* lw_a = a.lw_ + (size_t)M * 1024; const bf16_t* lw_v = a.lw_ + (size_t)3 * M * 1024;
            const int woff = jj * 16 + rg * 4;
            unsigned pr[9], pk[9], pv[9], pw[8], pa[8], pvp[8]; float pvf[8];
#define RW_PREFETCH(t0_) do { const int tb_ = (t0_) + 8 * pw_; \
            _Pragma("unroll") for (int i = 0; i < 9; ++i) { const int t_ = tb_ + i - 1; \
                if (t_ >= 0) { const bf16_t* row_ = a.proj_ + (size_t)(b * SEQ + t_) * PROJ_BLD + h * 64 + lane; pr[i] = row_[OFF_R]; pk[i] = row_[OFF_K]; pv[i] = row_[OFF_V]; } \
                else { pr[i] = 0u; pk[i] = 0u; pv[i] = 0u; } } \
            _Pragma("unroll") for (int i = 0; i < 8; ++i) { const size_t o_ = (size_t)(b * SEQ + tb_ + i) * 1024 + c; pw[i] = lw_w[o_]; pa[i] = lw_a[o_]; \
                if (a.layer) { pvp[i] = lw_v[o_]; pvf[i] = a.vf_[o_]; } else { pvp[i] = 0u; pvf[i] = 0.f; } } } while (0)
#define RW_PREP(ch_) do { const int t0_ = (ch_) * RW_TB; LAS unsigned char* buf_ = lds + ((ch_) % 3) * RWB_SIZE; \
            _Pragma("unroll") for (int i = 0; i < 8; ++i) { \
                const int tau = 8 * pw_ + i; \
                const float rc = __uint_as_float(pr[i + 1] << 16), rp = __uint_as_float(pr[i] << 16), kc = __uint_as_float(pk[i + 1] << 16), kp = __uint_as_float(pk[i] << 16), vc = __uint_as_float(pv[i + 1] << 16), vp = __uint_as_float(pv[i] << 16); \
                const float r = rc + (rp - rc) * mix_r, kraw = kc + (kp - kc) * mix_k, vraw = vc + (vp - vc) * mix_v; \
                const float sg = fast_sigmoid(w0c + __uint_as_float(pw[i] << 16)); \
                const float dec = __builtin_amdgcn_exp2f(-1.4426950408889634f * 0.6065306597126334f * sg);     \
                const float as = fast_sigmoid(a0c + __uint_as_float(pa[i] << 16)); \
                float v = vraw; \
                if (a.layer) v = vraw + (pvf[i] - vraw) * fast_sigmoid(v0c + __uint_as_float(pvp[i] << 16)); \
                const float kkv = kraw * kkc; \
                const float km = kraw * (1.f + (as - 1.f) * kac); \
                const float z = reduce4(kkv * kkv, r * km * rkc, kkv * as * r, km * r);     \
                const float nrm2 = rdlane(z, 0), rks = rdlane(z, 16), bru = rdlane(z, 32), kr = rdlane(z, 48); \
                const float inv = 1.f / fmaxf(sqrtf(nrm2), 1e-12f); \
                const float kkn = kkv * inv; \
                *(LAS float*)(buf_ + RWB_A + tau * 256 + woff) = -kkn; *(LAS float*)(buf_ + RWB_DR + tau * 256 + woff) = dec * r; *(LAS float*)(buf_ + RWB_D + tau * 256 + woff) = dec; \
                *(LAS float*)(buf_ + RWB_B + tau * 256 + woff) = kkn * as; *(LAS float*)(buf_ + RWB_K + tau * 256 + woff) = km; \
                if ((lane >> 5) == half) { ((LAS float*)(buf_ + RWB_V))[tau * 32 + (lane & 31)] = v; \
                    if (a.layer == 0) a.vf_[(size_t)(b * SEQ + t0_ + tau) * 1024 + c] = vraw; } \
                if (lane == 0) { ((LAS float*)(buf_ + RWB_SC))[tau] = bru * inv; ((LAS float*)(buf_ + RWB_SC))[32 + tau] = kr; ((LAS float*)(buf_ + RWB_SC))[64 + tau] = rks; } \
            } } while (0)
#define RW_FLUSH(ch_) do { const int t0_ = (ch_) * RW_TB; const LAS unsigned char* buf_ = lds + ((ch_) % 3) * RWB_SIZE; const LAS float* yst_ = (const LAS float*)(lds + RW_YST + ((ch_) & 1) * RW_YST_SIZE); \
            _Pragma("unroll") for (int q = 0; q < 4; ++q) { const int idx = ptid + 256 * q, tau = idx >> 5, i = idx & 31; \
                const float y = yst_[((((tau >> 4) * 4 + (i >> 3)) * 64 + ((i & 7) >> 1) * 16 + (tau & 15)) << 1) + (i & 1)]; \
                const float bo = ((const LAS float*)(buf_ + RWB_SC))[64 + tau] * ((const LAS float*)(buf_ + RWB_V))[tau * 32 + i]; \
                const size_t o = (size_t)(b * SEQ + t0_ + tau) * 1024 + h * 64 + half * 32 + i; \
                a.y_[o] = y; a.bon_[o] = bo; } } while (0)
            RW_PREFETCH(0);
            RW_PREP(0);
            RW_PREFETCH(RW_TB);
            __syncthreads();
            for (int ch = 0; ch < RW_NCH; ++ch) {
                if (ch > 0) RW_FLUSH(ch - 1);
                if (ch + 1 < RW_NCH) { RW_PREP(ch + 1); if (ch + 2 < RW_NCH) RW_PREFETCH((ch + 2) * RW_TB); }
                __syncthreads();
            }
            RW_FLUSH(RW_NCH - 1);
#undef RW_PREFETCH
#undef RW_PREP
#undef RW_FLUSH
        } else {
            f32x2 S0 = (f32x2){0.f, 0.f}, S1 = S0, S2 = S0, S3 = S0;
            __syncthreads();
            for (int ch = 0; ch < RW_NCH; ++ch) {
                const LAS unsigned char* buf = lds + (ch % 3) * RWB_SIZE;
                const LAS unsigned char* ob = buf + jj * 16;
                const LAS float* Vb = (const LAS float*)(buf + RWB_V) + 8 * wave + 2 * rg; const LAS float* SC = (const LAS float*)(buf + RWB_SC);
                LAS f32x2* Yst = (LAS f32x2*)(lds + RW_YST + (ch & 1) * RW_YST_SIZE);
                f32x4 a4 = *(const LAS f32x4*)(ob + RWB_A), q4 = *(const LAS f32x4*)(ob + RWB_DR), d4 = *(const LAS f32x4*)(ob + RWB_D), b4 = *(const LAS f32x4*)(ob + RWB_B), k4 = *(const LAS f32x4*)(ob + RWB_K);
                f32x2 vi = *(const LAS f32x2*)Vb; float br = SC[0], kr = SC[32];
#pragma unroll
                for (int blk = 0; blk < 2; ++blk) {
                    f32x2 yacc = (f32x2){0.f, 0.f};
#pragma unroll
                    for (int s = 0; s < 16; ++s) {
                        const int tn = blk * 16 + s + 1;
                        const f32x4 na4 = *(const LAS f32x4*)(ob + RWB_A + tn * 256), nq4 = *(const LAS f32x4*)(ob + RWB_DR + tn * 256), nd4 = *(const LAS f32x4*)(ob + RWB_D + tn * 256),
                                    nb4 = *(const LAS f32x4*)(ob + RWB_B + tn * 256), nk4 = *(const LAS f32x4*)(ob + RWB_K + tn * 256);
                        const f32x2 nvi = *(const LAS f32x2*)(Vb + (tn & 31) * 32); const float nbr = SC[tn & 31], nkr = SC[32 + (tn & 31)];
                        const f32x2 pa_ = (S0 * a4[0] + S1 * a4[1]) + (S2 * a4[2] + S3 * a4[3]);
                        const f32x2 pq_ = (S0 * q4[0] + S1 * q4[1]) + (S2 * q4[2] + S3 * q4[3]);
                        f32x2 sa, zq;
                        sa.x = rowsum16(pa_.x); sa.y = rowsum16(pa_.y); zq.x = rowsum16(pq_.x); zq.y = rowsum16(pq_.y);
                        S0 = S0 * d4[0] + sa * b4[0] + vi * k4[0]; S1 = S1 * d4[1] + sa * b4[1] + vi * k4[1]; S2 = S2 * d4[2] + sa * b4[2] + vi * k4[2]; S3 = S3 * d4[3] + sa * b4[3] + vi * k4[3];
                        const f32x2 y = zq + sa * br + vi * kr;
                        yacc.x = (jj == s) ? y.x : yacc.x; yacc.y = (jj == s) ? y.y : yacc.y;
                        a4 = na4; q4 = nq4; d4 = nd4; b4 = nb4; k4 = nk4; vi = nvi; br = nbr; kr = nkr;
                    }
                    Yst[(blk * 4 + wave) * 64 + lane] = yacc;
                }
                __syncthreads();
            }
        }
        __syncthreads();
    }
}

__device__ __forceinline__ void rwkv_post_phase(const float* yrw, const float* bon, const bf16_t* lw_g, const float* ln_w, const float* ln_b, bf16_t* ymixb, const int gw, const int NGW, const int lane) {
    const int c0 = 16 * lane;
    f32x4 lw4[4], lb4[4];
#pragma unroll
    for (int j = 0; j < 4; ++j) { lw4[j] = *(const f32x4*)(ln_w + c0 + 4 * j); lb4[j] = *(const f32x4*)(ln_b + c0 + 4 * j); }
    for (int m = gw; m < M; m += NGW) {
        f32x4 y[4], bo[4];
#pragma unroll
        for (int j = 0; j < 4; ++j) { y[j] = *(const f32x4*)(yrw + (size_t)m * 1024 + c0 + 4 * j); bo[j] = *(const f32x4*)(bon + (size_t)m * 1024 + c0 + 4 * j); }
        const u32x4 g0 = *(const u32x4*)(lw_g + (size_t)m * 1024 + c0), g1 = *(const u32x4*)(lw_g + (size_t)m * 1024 + c0 + 8);
        float s = 0.f;
#pragma unroll
        for (int j = 0; j < 4; ++j) s += (y[j][0] + y[j][1]) + (y[j][2] + y[j][3]);
        s += __shfl_xor(s, 1); s += __shfl_xor(s, 2);
        const float mu = s * (1.f / 64.f);
        float q = 0.f;
#pragma unroll
        for (int j = 0; j < 4; ++j) { y[j] = y[j] - mu; q += (y[j][0] * y[j][0] + y[j][1] * y[j][1]) + (y[j][2] * y[j][2] + y[j][3] * y[j][3]); }
        q += __shfl_xor(q, 1); q += __shfl_xor(q, 2);
        const float rstd = rsqrtf(q * (1.f / 64.f) + 64e-5f);
        float o[16];
#pragma unroll
        for (int j = 0; j < 4; ++j) { const f32x4 t = y[j] * rstd * lw4[j] + lb4[j] + bo[j]; o[4 * j] = t[0]; o[4 * j + 1] = t[1]; o[4 * j + 2] = t[2]; o[4 * j + 3] = t[3]; }
        const unsigned gw_[8] = {g0.x, g0.y, g0.z, g0.w, g1.x, g1.y, g1.z, g1.w};
        u32x4 w0, w1;
        w0.x = cvt_pk_bf16(o[0] * bf_lo(gw_[0]), o[1] * bf_hi(gw_[0])); w0.y = cvt_pk_bf16(o[2] * bf_lo(gw_[1]), o[3] * bf_hi(gw_[1]));
        w0.z = cvt_pk_bf16(o[4] * bf_lo(gw_[2]), o[5] * bf_hi(gw_[2])); w0.w = cvt_pk_bf16(o[6] * bf_lo(gw_[3]), o[7] * bf_hi(gw_[3]));
        w1.x = cvt_pk_bf16(o[8] * bf_lo(gw_[4]), o[9] * bf_hi(gw_[4])); w1.y = cvt_pk_bf16(o[10] * bf_lo(gw_[5]), o[11] * bf_hi(gw_[5]));
        w1.z = cvt_pk_bf16(o[12] * bf_lo(gw_[6]), o[13] * bf_hi(gw_[6])); w1.w = cvt_pk_bf16(o[14] * bf_lo(gw_[7]), o[15] * bf_hi(gw_[7]));
        *(u32x4*)(ymixb + (size_t)m * 2048 + 1024 + c0) = w0; *(u32x4*)(ymixb + (size_t)m * 2048 + 1024 + c0 + 8) = w1;
    }
}

__device__ __forceinline__ void ssd_conv_phase(const bf16_t* projb, const float* cw, const float* cb, const float* dt_bias, bf16_t* xbcc, float* dtb, const int vcu, const int G, const int tid) {
    for (int u = vcu; u < M / 64; u += G) {
        if (tid < 384) {
            const int cg = tid % 192, hf = tid / 192, c0 = 8 * cg, m0 = u * 64 + 32 * hf, t_in_seq = m0 % SEQ;
            float w[4][8], bias[8];
#pragma unroll
            for (int q = 0; q < 4; ++q) { const f32x4 a = *(const f32x4*)(cw + q * CONV_DIM + c0), b = *(const f32x4*)(cw + q * CONV_DIM + c0 + 4);
                w[q][0] = a[0]; w[q][1] = a[1]; w[q][2] = a[2]; w[q][3] = a[3]; w[q][4] = b[0]; w[q][5] = b[1]; w[q][6] = b[2]; w[q][7] = b[3]; }
            { const f32x4 a = *(const f32x4*)(cb + c0), b = *(const f32x4*)(cb + c0 + 4); bias[0] = a[0]; bias[1] = a[1]; bias[2] = a[2]; bias[3] = a[3]; bias[4] = b[0]; bias[5] = b[1]; bias[6] = b[2]; bias[7] = b[3]; }
            float win[3][8];
#pragma unroll
            for (int q = 0; q < 3; ++q) {
                u32x4 r = (u32x4){0u, 0u, 0u, 0u};
                if (t_in_seq - 3 + q >= 0) r = *(const u32x4*)(projb + (size_t)(m0 - 3 + q) * PROJ_BLD + OFF_XBC + c0);
                win[q][0] = bf_lo(r.x); win[q][1] = bf_hi(r.x); win[q][2] = bf_lo(r.y); win[q][3] = bf_hi(r.y); win[q][4] = bf_lo(r.z); win[q][5] = bf_hi(r.z); win[q][6] = bf_lo(r.w); win[q][7] = bf_hi(r.w);
            }
            for (int i = 0; i < 32; ++i) {
                const u32x4 r = *(const u32x4*)(projb + (size_t)(m0 + i) * PROJ_BLD + OFF_XBC + c0);
                float cur[8] = {bf_lo(r.x), bf_hi(r.x), bf_lo(r.y), bf_hi(r.y), bf_lo(r.z), bf_hi(r.z), bf_lo(r.w), bf_hi(r.w)};
                float o[8];
#pragma unroll
                for (int e = 0; e < 8; ++e) { const float acc = bias[e] + w[0][e] * win[0][e] + w[1][e] * win[1][e] + w[2][e] * win[2][e] + w[3][e] * cur[e]; o[e] = fast_silu(acc);
                    win[0][e] = win[1][e]; win[1][e] = win[2][e]; win[2][e] = cur[e]; }
                u32x4 wv; wv.x = cvt_pk_bf16(o[0], o[1]); wv.y = cvt_pk_bf16(o[2], o[3]); wv.z = cvt_pk_bf16(o[4], o[5]); wv.w = cvt_pk_bf16(o[6], o[7]);
                *(u32x4*)(xbcc + (size_t)(m0 + i) * CONV_DIM + c0) = wv;
            }
        }
#pragma unroll
        for (int q = 0; q < 2; ++q) { const int idx = tid + 512 * q, m = u * 64 + (idx >> 4), h = idx & 15;
            const float x = bf2f(projb[(size_t)m * PROJ_BLD + OFF_DT + h]) + dt_bias[h];
            dtb[(size_t)m * SSD_H + h] = fmaxf(x, 0.f) + log1pf(expf(-fabsf(x))); }
    }
}

constexpr int SP = 136;
constexpr int SS_C = 0, SS_B = 34816, SS_BT = 69632, SS_XT = 104448, SS_XW = 113152, SS_HT = 121856, SS_AC = 130560, SS_DT = 131072, SS_END = 131584;
__device__ __forceinline__ void ssd_scan_phase(LAS unsigned char* lds, const bf16_t* xbcc, const float* dtb, const float* a_log, const float* dskip, float* yssd, const int vcu, const int G, const int tid) {
    const int wave = __builtin_amdgcn_readfirstlane(tid >> 6), lane = tid & 63, fr = lane & 15, fq = lane >> 4;
    LAS bf16_t* Cimg = (LAS bf16_t*)(lds + SS_C); LAS bf16_t* Bimg = (LAS bf16_t*)(lds + SS_B); LAS bf16_t* BTimg = (LAS bf16_t*)(lds + SS_BT);
    LAS bf16_t* xT = (LAS bf16_t*)(lds + SS_XT); LAS bf16_t* xwT = (LAS bf16_t*)(lds + SS_XW); LAS bf16_t* hT = (LAS bf16_t*)(lds + SS_HT);
    LAS float* acum = (LAS float*)(lds + SS_AC); LAS float* dtv = (LAS float*)(lds + SS_DT);
    for (int u = vcu; u < BATCH * SSD_H * 2; u += G) {
        const int b = u >> 5, h = (u >> 1) & 15, phalf = u & 1, g = h >> 3;
        const float Ah = -expf(a_log[h]) * 1.4426950408889634f;
        const float dsk = dskip[h];
        f32x4 hs[2] = {(f32x4){0.f, 0.f, 0.f, 0.f}, (f32x4){0.f, 0.f, 0.f, 0.f}};
        for (int i = tid; i < 32 * SP / 2; i += 512) ((LAS unsigned*)hT)[i] = 0u;
        const int row = tid >> 2, part = tid & 3;
        for (int ch = 0; ch < SEQ / 128; ++ch) {
            const int mrow0 = b * SEQ + ch * 128;
            u32x4 xr;
            {
                const bf16_t* src = xbcc + (size_t)(mrow0 + row) * CONV_DIM;
                u32x4 cv[4], bv[4];
#pragma unroll
                for (int j = 0; j < 4; ++j) { cv[j] = *(const u32x4*)(src + 1280 + g * 128 + 32 * part + 8 * j); bv[j] = *(const u32x4*)(src + 1024 + g * 128 + 32 * part + 8 * j); }
                xr = *(const u32x4*)(src + h * 64 + phalf * 32 + 8 * part);
                if (tid < 128) dtv[tid] = dtb[(size_t)(mrow0 + tid) * SSD_H + h];
#pragma unroll
                for (int j = 0; j < 4; ++j) { *(LAS u32x4*)(Cimg + row * SP + 32 * part + 8 * j) = cv[j]; *(LAS u32x4*)(Bimg + row * SP + 32 * part + 8 * j) = bv[j]; }
#pragma unroll
                for (int j = 0; j < 4; ++j) { const unsigned wv[4] = {bv[j].x, bv[j].y, bv[j].z, bv[j].w};
#pragma unroll
                    for (int e = 0; e < 4; ++e) { const int n = 32 * part + 8 * j + 2 * e; BTimg[n * SP + row] = (bf16_t)(wv[e] & 0xffffu); BTimg[(n + 1) * SP + row] = (bf16_t)(wv[e] >> 16); } }
            }
            __syncthreads();
            if (wave == 0) {
                const float v0 = dtv[2 * lane] * Ah, v1 = dtv[2 * lane + 1] * Ah;
                float s = v0 + v1;
#pragma unroll
                for (int o = 1; o < 64; o <<= 1) { const float t = __shfl_up(s, o); if (lane >= o) s += t; }
                acum[2 * lane] = s - v1; acum[2 * lane + 1] = s;
            }
            __syncthreads();
            const float atot = acum[127];
            {
                const float wgt = dtv[row] * __builtin_amdgcn_exp2f(atot - acum[row]);
                const unsigned wv[4] = {xr.x, xr.y, xr.z, xr.w};
#pragma unroll
                for (int e = 0; e < 4; ++e) { const int p = 8 * part + 2 * e; const float x0 = bf_lo(wv[e]), x1 = bf_hi(wv[e]);
                    xT[p * SP + row] = (bf16_t)(wv[e] & 0xffffu); xT[(p + 1) * SP + row] = (bf16_t)(wv[e] >> 16);
                    const unsigned pk = cvt_pk_bf16(x0 * wgt, x1 * wgt); xwT[p * SP + row] = (bf16_t)(pk & 0xffffu); xwT[(p + 1) * SP + row] = (bf16_t)(pk >> 16); }
            }
            f32x4 gacc[8];
#pragma unroll
            for (int st = 0; st < 8; ++st) gacc[st] = (f32x4){0.f, 0.f, 0.f, 0.f};
            {
                bf16x8 cf[4];
#pragma unroll
                for (int ks = 0; ks < 4; ++ks) cf[ks] = *(const LAS bf16x8*)(Cimg + (16 * wave + fr) * SP + 32 * ks + 8 * fq);
#pragma unroll
                for (int st = 0; st < 8; ++st) if (st <= wave) {
#pragma unroll
                    for (int ks = 0; ks < 4; ++ks) { const bf16x8 bfg = *(const LAS bf16x8*)(Bimg + (16 * st + fr) * SP + 32 * ks + 8 * fq);
                        gacc[st] = __builtin_amdgcn_mfma_f32_16x16x32_bf16(bfg, cf[ks], gacc[st], 0, 0, 0); }
                }
            }
            __syncthreads();
            {
                LAS bf16_t* Mimg = Bimg;
                const int l = 16 * wave + fr; const float al = acum[l];
#pragma unroll
                for (int st = 0; st < 8; ++st) if (st <= wave + 1) {
                    u32x2 wv = (u32x2){0u, 0u};
                    if (st <= wave) {
                        const f32x4 as4 = *(const LAS f32x4*)(acum + 16 * st + 4 * fq), dt4 = *(const LAS f32x4*)(dtv + 16 * st + 4 * fq);
                        float mv[4];
#pragma unroll
                        for (int r = 0; r < 4; ++r) { const int s = 16 * st + 4 * fq + r; mv[r] = (s <= l) ? gacc[st][r] * dt4[r] * __builtin_amdgcn_exp2f(al - as4[r]) : 0.f; }
                        wv.x = cvt_pk_bf16(mv[0], mv[1]); wv.y = cvt_pk_bf16(mv[2], mv[3]);
                    }
                    *(LAS u32x2*)(Mimg + l * SP + 16 * st + 4 * fq) = wv;
                }
            }
            __syncthreads();
            {
                const LAS bf16_t* Mimg = Bimg;
                f32x4 yd[2] = {(f32x4){0.f, 0.f, 0.f, 0.f}, (f32x4){0.f, 0.f, 0.f, 0.f}}, yo[2] = {(f32x4){0.f, 0.f, 0.f, 0.f}, (f32x4){0.f, 0.f, 0.f, 0.f}};
#pragma unroll
                for (int ks = 0; ks < 4; ++ks) {
                    const bf16x8 cfr = *(const LAS bf16x8*)(Cimg + (16 * wave + fr) * SP + 32 * ks + 8 * fq);
#pragma unroll
                    for (int pt = 0; pt < 2; ++pt) { const bf16x8 hf = *(const LAS bf16x8*)(hT + (16 * pt + fr) * SP + 32 * ks + 8 * fq);
                        yo[pt] = __builtin_amdgcn_mfma_f32_16x16x32_bf16(hf, cfr, yo[pt], 0, 0, 0); }
                    if (2 * ks <= wave) {
                        const bf16x8 mf = *(const LAS bf16x8*)(Mimg + (16 * wave + fr) * SP + 32 * ks + 8 * fq);
#pragma unroll
                        for (int pt = 0; pt < 2; ++pt) { const bf16x8 xf_ = *(const LAS bf16x8*)(xT + (16 * pt + fr) * SP + 32 * ks + 8 * fq);
                            yd[pt] = __builtin_amdgcn_mfma_f32_16x16x32_bf16(xf_, mf, yd[pt], 0, 0, 0); }
                    }
                }
                const int l = 16 * wave + fr; const float el = __builtin_amdgcn_exp2f(acum[l]);
#pragma unroll
                for (int pt = 0; pt < 2; ++pt) {
                    f32x4 o;
#pragma unroll
                    for (int r = 0; r < 4; ++r) o[r] = yd[pt][r] + el * yo[pt][r] + dsk * bf2f(xT[(16 * pt + 4 * fq + r) * SP + l]);
                    *(f32x4*)(yssd + (size_t)(mrow0 + l) * 1024 + h * 64 + phalf * 32 + 16 * pt + 4 * fq) = o;
                }
            }
            {
                const float ea = __builtin_amdgcn_exp2f(atot);
                hs[0] = hs[0] * ea; hs[1] = hs[1] * ea;
#pragma unroll
                for (int ks = 0; ks < 4; ++ks) {
                    const bf16x8 btf = *(const LAS bf16x8*)(BTimg + (16 * wave + fr) * SP + 32 * ks + 8 * fq);
#pragma unroll
                    for (int pt = 0; pt < 2; ++pt) { const bf16x8 xwf = *(const LAS bf16x8*)(xwT + (16 * pt + fr) * SP + 32 * ks + 8 * fq);
                        hs[pt] = __builtin_amdgcn_mfma_f32_16x16x32_bf16(btf, xwf, hs[pt], 0, 0, 0); }
                }
            }
            __syncthreads();
#pragma unroll
            for (int pt = 0; pt < 2; ++pt) { u32x2 wv; wv.x = cvt_pk_bf16(hs[pt][0], hs[pt][1]); wv.y = cvt_pk_bf16(hs[pt][2], hs[pt][3]);
                *(LAS u32x2*)(hT + (16 * pt + fr) * SP + 16 * wave + 4 * fq) = wv; }
        }
        __syncthreads();
    }
}

__device__ __forceinline__ void ssd_post_phase(const float* yssd, const bf16_t* projb, const float* norm_w, bf16_t* ymixb, const int gw, const int NGW, const int lane) {
    const int c0 = 16 * lane;
    f32x4 nw[4];
#pragma unroll
    for (int j = 0; j < 4; ++j) nw[j] = *(const f32x4*)(norm_w + c0 + 4 * j);
    for (int m = gw; m < M; m += NGW) {
        f32x4 y[4];
#pragma unroll
        for (int j = 0; j < 4; ++j) y[j] = *(const f32x4*)(yssd + (size_t)m * 1024 + c0 + 4 * j);
        const u32x4 z0 = *(const u32x4*)(projb + (size_t)m * PROJ_BLD + OFF_Z + c0), z1 = *(const u32x4*)(projb + (size_t)m * PROJ_BLD + OFF_Z + c0 + 8);
        const unsigned zw[8] = {z0.x, z0.y, z0.z, z0.w, z1.x, z1.y, z1.z, z1.w};
        float uu[16]; float ss = 0.f;
#pragma unroll
        for (int e = 0; e < 8; ++e) { uu[2 * e] = y[e >> 1][(2 * e) & 3] * fast_silu(bf_lo(zw[e])); uu[2 * e + 1] = y[e >> 1][(2 * e + 1) & 3] * fast_silu(bf_hi(zw[e])); ss += uu[2 * e] * uu[2 * e] + uu[2 * e + 1] * uu[2 * e + 1]; }
#pragma unroll
        for (int o = 1; o < 32; o <<= 1) ss += __shfl_xor(ss, o);
        const float rs = rsqrtf(ss * (1.f / 512.f) + 1e-5f);
        u32x4 w0, w1;
        w0.x = cvt_pk_bf16(uu[0] * rs * nw[0][0], uu[1] * rs * nw[0][1]); w0.y = cvt_pk_bf16(uu[2] * rs * nw[0][2], uu[3] * rs * nw[0][3]);
        w0.z = cvt_pk_bf16(uu[4] * rs * nw[1][0], uu[5] * rs * nw[1][1]); w0.w = cvt_pk_bf16(uu[6] * rs * nw[1][2], uu[7] * rs * nw[1][3]);
        w1.x = cvt_pk_bf16(uu[8] * rs * nw[2][0], uu[9] * rs * nw[2][1]); w1.y = cvt_pk_bf16(uu[10] * rs * nw[2][2], uu[11] * rs * nw[2][3]);
        w1.z = cvt_pk_bf16(uu[12] * rs * nw[3][0], uu[13] * rs * nw[3][1]); w1.w = cvt_pk_bf16(uu[14] * rs * nw[3][2], uu[15] * rs * nw[3][3]);
        *(u32x4*)(ymixb + (size_t)m * 2048 + c0) = w0; *(u32x4*)(ymixb + (size_t)m * 2048 + c0 + 8) = w1;
    }
}

#define PH_BEGIN int z_ = 0; asm volatile("" : "+s"(z_)); unsigned char* const wsq = P.ws + z_; int tid = tid0; asm volatile("" : "+v"(tid)); \
    const int G = G0 + z_, bx = bx0 + z_, vcu = vcu0 + z_, lane = tid & 63, wave = __builtin_amdgcn_readfirstlane(tid >> 6), gw = vcu * NWAVES + wave, NGW = G * NWAVES; (void)bx; (void)lane; (void)gw; (void)NGW; (void)wave;
#define INP(i) (P.in[(i) + z_])
#define Win_t ((bf16_t*)(wsq + WS_WIN))
#define Wout_t ((bf16_t*)(wsq + WS_WOUT))
#define Wffn ((bf16_t*)(wsq + WS_WFFN))
#define Wl_w ((bf16_t*)(wsq + WS_WLORA))
#define Wl_a (Wl_w + 1024 * 64)
#define Wl_g (Wl_a + 1024 * 64)
#define Wl_v (Wl_g + 1024 * 160)
#define xf ((float*)(wsq + WS_XF))
#define xb ((bf16_t*)(wsq + WS_XB))
#define projb ((bf16_t*)(wsq + WS_PROJB))
#define ymixb ((bf16_t*)(wsq + WS_YMIXB))
#define mixed ((float*)(wsq + WS_MIXED))
#define hbuf ((bf16_t*)(wsq + WS_HBUF))
#define xg ((bf16_t*)(wsq + WS_XG))
#define yslot ((float*)(wsq + WS_YSLOT))
#define xbcc ((bf16_t*)(wsq + WS_XBCC))
#define dtb ((float*)(wsq + WS_DTB))
#define yssd ((float*)(wsq + WS_YSSD))
#define lw ((bf16_t*)(wsq + WS_LW))
#define yrw ((float*)(wsq + WS_YRW))
#define bon ((float*)(wsq + WS_BON))
#define vfirst ((float*)(wsq + WS_VFIRST))
#define tok_e ((int*)(wsq + WS_TOK))
#define tok_pos (tok_e + 2 * M)
#define tok_g ((float*)(tok_pos + 2 * M))
#define tok_dest ((int*)(tok_g + 2 * M))
#define cnt ((int*)(wsq + WS_CTL) + CW_CNT + 8 * li)
__global__ void __launch_bounds__(NWAVES * 64, 2) fwd(Params P) {
    extern __shared__ __attribute__((aligned(16))) unsigned char lds_raw[];
    LAS unsigned char* lds = (LAS unsigned char*)lds_raw;
    volatile LAS unsigned* MISC = (volatile LAS unsigned*)(lds + MISC_OFF);
    const int tid0 = threadIdx.x;
    const int G0 = gridDim.x, bx0 = blockIdx.x;
    const int vcu0 = (G0 % 8 == 0) ? (bx0 % 8) * (G0 / 8) + bx0 / 8 : bx0;
    unsigned* ctl = (unsigned*)(P.ws + WS_CTL);
    if (tid0 < 64) MISC[tid0] = 0u;
    __syncthreads();
#if MK_LAUNCH_MODE == 1
    constexpr int lo = 0, hi = 64;
#else
    const int lo = P.ph_lo, hi = P.ph_hi;
#endif
    XcdBarrier bar; bar.bar = ctl + CW_BAR + P.bar_idx * XCD_BAR_WORDS; bar.x = 0; bar.st = MISC + 8;
    if (hi - lo > 1) bar = xcd_barrier_post(ctl + CW_BAR + P.bar_idx * XCD_BAR_WORDS, MISC + 8);
#define IN(k) (lo <= (k) && (k) < hi)
#define SEAM(k) do { if ((k) + 1 < hi) xcd_barrier(bar); } while (0)

    for (int l = 0; l < 4; ++l) {
        const int pb = l * 16, li = l >> 1; const bool moe = (l & 1) != 0;
        if (IN(pb + 0)) {
            PH_BEGIN
            LAS float* scr = (LAS float*)(lds + wave * 16384);
            cvt_job<0>(INP(1) + (size_t)l * D * IN_DIM, D, IN_DIM, Win_t, 0, 0, scr, gw, NGW, lane);
            if (l > 0) cvt_job<0>(INP(2) + (size_t)(l - 1) * D * 32, D, 32, Win_t, IN_DIM, 0, scr, gw, NGW, lane);
            { const int r0 = l > 0 ? IN_DIM + 32 : IN_DIM, nz = (PROJ_BLD - r0) * (D / 8);
              for (int i = bx * 512 + tid; i < nz; i += G * 512) *(u32x4*)(Win_t + (size_t)r0 * D + (size_t)i * 8) = (u32x4){0u, 0u, 0u, 0u}; }
            cvt_job<0>(INP(23) + (size_t)l * D * D, D, D, Wout_t, 0, 0, scr, gw, NGW, lane);
            cvt_job<0>(INP(12) + (size_t)l * 64 * 1024, 64, 1024, Wl_w, 0, 0, scr, gw, NGW, lane);
            cvt_job<0>(INP(14) + (size_t)l * 64 * 1024, 64, 1024, Wl_a, 0, 0, scr, gw, NGW, lane);
            cvt_job<0>(INP(17) + (size_t)l * 160 * 1024, 160, 1024, Wl_g, 0, 0, scr, gw, NGW, lane);
            if (l > 0) cvt_job<0>(INP(16) + (size_t)(l - 1) * 32 * 1024, 32, 1024, Wl_v, 0, 0, scr, gw, NGW, lane);
            if (l == 0) {
                const float* x = INP(0);
                for (size_t i = (size_t)bx * 512 + tid; i < (size_t)M * D / 8; i += (size_t)G * 512) {
                    const f32x4 a = *(const f32x4*)(x + i * 8), b = *(const f32x4*)(x + i * 8 + 4);
                    u32x4 w; w.x = cvt_pk_bf16(a[0], a[1]); w.y = cvt_pk_bf16(a[2], a[3]); w.z = cvt_pk_bf16(b[0], b[1]); w.w = cvt_pk_bf16(b[2], b[3]);
                    *(u32x4*)(xb + i * 8) = w; }
            }
            __syncthreads();
            SEAM(pb + 0);
        }
        if (IN(pb + 1)) {
            PH_BEGIN
            pg8::Gemm g{xb, Win_t, D}; pg8::StaticOrder S; S.init(M, PROJ_BLD, G, bx);
            pg8::EpiBf16 E{projb, PROJ_BLD};
            pg8::gemm_phase<pg8::EpiBf16, pg8::StaticOrder>(lds, g, S, E, tid);
#if (MK_DBL >> 1) & 1
            pg8::gemm_phase<pg8::EpiBf16, pg8::StaticOrder>(lds, g, S, E, tid);
#endif
            SEAM(pb + 1);
        }
        if (IN(pb + 2)) {
            PH_BEGIN
            lora_phase(lds, projb, INP(9) + (size_t)l * RW_SHIFT, INP(10) + (size_t)(l > 0 ? l - 1 : 0) * 32, Wl_w, Wl_a, Wl_g, Wl_v, lw, l > 0, vcu, G, tid);
#if (MK_DBL >> 2) & 1
            lora_phase(lds, projb, INP(9) + (size_t)l * RW_SHIFT, INP(10) + (size_t)(l > 0 ? l - 1 : 0) * 32, Wl_w, Wl_a, Wl_g, Wl_v, lw, l > 0, vcu, G, tid);
#endif
            ssd_conv_phase(projb, INP(3) + (size_t)l * 4 * CONV_DIM, INP(4) + (size_t)l * CONV_DIM, INP(5) + l * SSD_H, xbcc, dtb, vcu, G, tid);
#if (MK_DBL >> 11) & 1
            ssd_conv_phase(projb, INP(3) + (size_t)l * 4 * CONV_DIM, INP(4) + (size_t)l * CONV_DIM, INP(5) + l * SSD_H, xbcc, dtb, vcu, G, tid);
#endif
            SEAM(pb + 2);
        }
        if (IN(pb + 3)) {
            PH_BEGIN
            RwScan a; a.proj_ = projb; a.lw_ = lw; a.mix = INP(9) + (size_t)l * RW_SHIFT; a.w0 = INP(11) + l * 1024; a.a0 = INP(13) + l * 1024; a.v0 = INP(15) + (l > 0 ? l - 1 : 0) * 1024;
            a.k_k = INP(18) + l * 1024; a.k_a = INP(19) + l * 1024; a.r_k = INP(20) + l * 1024; a.vf_ = vfirst; a.y_ = yrw; a.bon_ = bon; a.layer = l; a.pad = 0;
            rwkv_scan_phase(lds, a, vcu, G, tid);
#if (MK_DBL >> 3) & 1
            rwkv_scan_phase(lds, a, vcu, G, tid);
#endif
            ssd_scan_phase(lds, xbcc, dtb, INP(6) + l * SSD_H, INP(7) + l * SSD_H, yssd, vcu, G, tid);
#if (MK_DBL >> 10) & 1
            ssd_scan_phase(lds, xbcc, dtb, INP(6) + l * SSD_H, INP(7) + l * SSD_H, yssd, vcu, G, tid);
#endif
            SEAM(pb + 3);
        }
        if (IN(pb + 4)) {
            PH_BEGIN
            rwkv_post_phase(yrw, bon, lw + (size_t)2 * M * 1024, INP(21) + l * 1024, INP(22) + l * 1024, ymixb, gw, NGW, lane);
#if (MK_DBL >> 4) & 1
            rwkv_post_phase(yrw, bon, lw + (size_t)2 * M * 1024, INP(21) + l * 1024, INP(22) + l * 1024, ymixb, gw, NGW, lane);
#endif
            ssd_post_phase(yssd, projb, INP(8) + l * 1024, ymixb, gw, NGW, lane);
#if (MK_DBL >> 4) & 1
            ssd_post_phase(yssd, projb, INP(8) + l * 1024, ymixb, gw, NGW, lane);
#endif
            SEAM(pb + 4);
        }
        if (IN(pb + 5)) {
            PH_BEGIN
            pg8::Gemm g{ymixb, Wout_t, D}; pg8::StaticOrder S; S.init(M, D, G, bx);
            pg8::EpiF32 E{mixed, D};
            pg8::gemm_phase<pg8::EpiF32, pg8::StaticOrder>(lds, g, S, E, tid);
#if (MK_DBL >> 5) & 1
            pg8::gemm_phase<pg8::EpiF32, pg8::StaticOrder>(lds, g, S, E, tid);
#endif
            SEAM(pb + 5);
        }
        if (IN(pb + 6)) {
            PH_BEGIN
            const float* xin = (l == 0) ? INP(0) : xf;
            const float* gam = INP(24) + l * D; const float* bet = INP(25) + l * D;
            LAS float* rs = (LAS float*)lds;
            if (moe) { const float* router = INP(31) + (size_t)li * D * NE;
                for (int i = tid; i < D * NE; i += 512) rs[(i & 7) * D + (i >> 3)] = router[i];
                __syncthreads(); }
            for (int m = gw; m < M; m += NGW) {
                f32x4 v[8];
#pragma unroll
                for (int j = 0; j < 8; ++j) { const size_t o = (size_t)m * D + 4 * lane + 256 * j; v[j] = ALPHA * *(const f32x4*)(xin + o) + *(const f32x4*)(mixed + o); }
                ln_finish(v, gam, bet, lane, xf + (size_t)m * D, xb + (size_t)m * D);
                if (moe) {
                    float lg[8];
#pragma unroll
                    for (int e = 0; e < 8; ++e) { float s = 0.f;
#pragma unroll
                        for (int j = 0; j < 8; ++j) { const f32x4 r = *(const LAS f32x4*)(rs + e * D + 4 * lane + 256 * j); s += (v[j][0] * r[0] + v[j][1] * r[1]) + (v[j][2] * r[2] + v[j][3] * r[3]); }
                        lg[e] = wave_sum_f(s); }
                    if (lane == 0) {
                        int i0 = 0; float v0 = lg[0];
#pragma unroll
                        for (int e = 1; e < 8; ++e) if (lg[e] > v0) { v0 = lg[e]; i0 = e; }
                        int i1 = -1; float v1 = -3.4e38f;
#pragma unroll
                        for (int e = 0; e < 8; ++e) if (e != i0 && lg[e] > v1) { v1 = lg[e]; i1 = e; }
                        const float e1 = expf(v1 - v0);
                        tok_e[2 * m] = i0; tok_e[2 * m + 1] = i1; tok_g[2 * m] = 1.f / (1.f + e1); tok_g[2 * m + 1] = e1 / (1.f + e1);
                        tok_pos[2 * m] = atomicAdd(&cnt[i0], 1); tok_pos[2 * m + 1] = atomicAdd(&cnt[i1], 1);
                    }
                }
            }
            __syncthreads();
            SEAM(pb + 6);
        }
        if (IN(pb + 7)) {
            PH_BEGIN
            LAS float* scr = (LAS float*)(lds + wave * 16384);
            if (!moe) {
                cvt_job<1>(INP(28) + (size_t)li * D * DFF, D, DFF, Wffn, 0, 0, scr, gw, NGW, lane);
                cvt_job<1>(INP(29) + (size_t)li * D * DFF, D, DFF, Wffn, 0, 1, scr, gw, NGW, lane);
                cvt_job<0>(INP(30) + (size_t)li * DFF * D, DFF, D, Wffn + (size_t)2 * DFF * D, 0, 0, scr, gw, NGW, lane);
            } else {
                for (int e = 0; e < NE; ++e) {
                    cvt_job<1>(INP(32) + ((size_t)li * NE + e) * D * DFE, D, DFE, Wffn, e * 2 * DFE, 0, scr, gw, NGW, lane);
                    cvt_job<1>(INP(33) + ((size_t)li * NE + e) * D * DFE, D, DFE, Wffn, e * 2 * DFE, 1, scr, gw, NGW, lane);
                    cvt_job<0>(INP(34) + ((size_t)li * NE + e) * DFE * D, DFE, D, Wffn + (size_t)NE * 2 * DFE * D, e * D, 0, scr, gw, NGW, lane);
                }
                int start[8]; { int acc = 0;
#pragma unroll
                    for (int e = 0; e < 8; ++e) { start[e] = acc; acc += ((cnt[e] + 255) >> 8) << 8; } }
                for (int m = gw; m < M; m += NGW) {
                    u32x4 r[4];
#pragma unroll
                    for (int j = 0; j < 4; ++j) r[j] = *(const u32x4*)(xb + (size_t)m * D + 8 * lane + 512 * j);
#pragma unroll
                    for (int s = 0; s < 2; ++s) {
                        const int e = tok_e[2 * m + s], pos = tok_pos[2 * m + s];
                        int st = 0;
#pragma unroll
                        for (int q = 0; q < 8; ++q) st = (e == q) ? start[q] : st;
                        const int dest = st + pos;
#pragma unroll
                        for (int j = 0; j < 4; ++j) *(u32x4*)(xg + (size_t)dest * D + 8 * lane + 512 * j) = r[j];
                        if (lane == 0) tok_dest[2 * m + s] = dest;
                    }
                }
            }
            __syncthreads();
            SEAM(pb + 7);
        }
        if (IN(pb + 8)) {
            PH_BEGIN
            if (!moe) {
                pg8::Gemm g{xb, Wffn, D}; pg8::StaticOrder S; S.init(M, 2 * DFF, G, bx);
                pg8::EpiSwiglu E{hbuf, DFF};
                pg8::gemm_phase<pg8::EpiSwiglu, pg8::StaticOrder>(lds, g, S, E, tid);
#if (MK_DBL >> 8) & 1
                pg8::gemm_phase<pg8::EpiSwiglu, pg8::StaticOrder>(lds, g, S, E, tid);
#endif
            } else {
                pg8::Gemm g{xg, Wffn, D}; pg8::GroupedOrder S; S.init(cnt, 2 * DFE, G, bx);
                pg8::EpiSwiglu E{hbuf, DFE};
                pg8::gemm_phase<pg8::EpiSwiglu, pg8::GroupedOrder>(lds, g, S, E, tid);
#if (MK_DBL >> 8) & 1
                pg8::gemm_phase<pg8::EpiSwiglu, pg8::GroupedOrder>(lds, g, S, E, tid);
#endif
            }
            SEAM(pb + 8);
        }
        if (IN(pb + 9)) {
            PH_BEGIN
            if (!moe) {
                pg8::Gemm g{hbuf, Wffn + (size_t)2 * DFF * D, DFF}; pg8::StaticOrder S; S.init(M, D, G, bx);
                pg8::EpiF32 E{yslot, D};
                pg8::gemm_phase<pg8::EpiF32, pg8::StaticOrder>(lds, g, S, E, tid);
#if (MK_DBL >> 9) & 1
                pg8::gemm_phase<pg8::EpiF32, pg8::StaticOrder>(lds, g, S, E, tid);
#endif
#if (MK_DBL >> 5) & 1
            pg8::gemm_phase<pg8::EpiF32, pg8::StaticOrder>(lds, g, S, E, tid);
#endif
            } else {
                pg8::Gemm g{hbuf, Wffn + (size_t)NE * 2 * DFE * D, DFE}; pg8::GroupedOrder S; S.init(cnt, D, G, bx);
                pg8::EpiF32 E{yslot, D};
                pg8::gemm_phase<pg8::EpiF32, pg8::GroupedOrder>(lds, g, S, E, tid);
#if (MK_DBL >> 9) & 1
                pg8::gemm_phase<pg8::EpiF32, pg8::GroupedOrder>(lds, g, S, E, tid);
#endif
            }
            SEAM(pb + 9);
        }
        if (IN(pb + 10)) {
            PH_BEGIN
            const float* gam = INP(26) + l * D; const float* bet = INP(27) + l * D;
            float* dst = (l == 3) ? P.out : xf;
            for (int m = gw; m < M; m += NGW) {
                f32x4 v[8];
                if (!moe) {
#pragma unroll
                    for (int j = 0; j < 8; ++j) { const size_t o = (size_t)m * D + 4 * lane + 256 * j; v[j] = ALPHA * *(const f32x4*)(xf + o) + *(const f32x4*)(yslot + o); }
                } else {
                    const int d0 = tok_dest[2 * m], d1 = tok_dest[2 * m + 1]; const float g0 = tok_g[2 * m], g1 = tok_g[2 * m + 1];
#pragma unroll
                    for (int j = 0; j < 8; ++j) { const int c = 4 * lane + 256 * j;
                        v[j] = ALPHA * *(const f32x4*)(xf + (size_t)m * D + c) + g0 * *(const f32x4*)(yslot + (size_t)d0 * D + c) + g1 * *(const f32x4*)(yslot + (size_t)d1 * D + c); }
                }
                ln_finish(v, gam, bet, lane, dst + (size_t)m * D, (l == 3) ? (bf16_t*)nullptr : xb + (size_t)m * D);
            }
            SEAM(pb + 10);
        }
    }
#undef IN
#undef SEAM
}
#undef PH_BEGIN
#undef INP
#undef Win_t
#undef Wout_t
#undef Wffn
#undef Wl_w
#undef Wl_a
#undef Wl_g
#undef Wl_v
#undef xf
#undef xb
#undef projb
#undef ymixb
#undef mixed
#undef hbuf
#undef xg
#undef yslot
#undef xbcc
#undef dtb
#undef yssd
#undef lw
#undef yrw
#undef bon
#undef vfirst
#undef tok_e
#undef tok_pos
#undef tok_g
#undef tok_dest
#undef cnt


}

extern "C" void kernel_launch(void* const* d_in, const int* in_sizes, int n_in, void* d_out, int out_size, void* d_ws, size_t ws_size, hipStream_t stream) {
    (void)in_sizes; (void)out_size;
    static int grid = 0;
    if (grid == 0) {
        if (n_in != 35 || ws_size < WS_END) { fprintf(stderr, "kernel_launch: need 35 inputs and %zu bytes of workspace (got %d, %zu)\n", (size_t)WS_END, n_in, ws_size); grid = -1; return; }
        int dev = 0, cus = 0;
        if (hipGetDevice(&dev) != hipSuccess || hipDeviceGetAttribute(&cus, hipDeviceAttributeMultiprocessorCount, dev) != hipSuccess) { grid = -1; return; }
        if (hipFuncSetAttribute((const void*)fwd, hipFuncAttributeMaxDynamicSharedMemorySize, LDS_BYTES) != hipSuccess) { fprintf(stderr, "kernel_launch: hipFuncSetAttribute failed\n"); grid = -1; return; }
        int per_cu = 0;
        if (hipOccupancyMaxActiveBlocksPerMultiprocessor(&per_cu, (const void*)fwd, NWAVES * 64, LDS_BYTES) != hipSuccess || per_cu < 1) { fprintf(stderr, "kernel_launch: occupancy query says %d blocks per CU\n", per_cu); }
        (void)hipGetLastError();
        grid = cus;
    }
    if (grid < 0) return;
    unsigned char* ws = (unsigned char*)d_ws;
    (void)hipMemsetAsync(ws + WS_CTL, 0, CTL_BYTES, stream);
    Params P{};
    for (int i = 0; i < 35; ++i) P.in[i] = (const float*)d_in[i];
    P.out = (float*)d_out; P.ws = ws; P.pad = 0;
    int nbar = 0;
    auto run = [&](int lo, int hi) {
        P.ph_lo = lo; P.ph_hi = hi; P.bar_idx = (hi - lo > 1) ? nbar++ : 0;
        hipLaunchKernelGGL(fwd, dim3(grid), dim3(NWAVES * 64), LDS_BYTES, stream, P);
    };
    if (MK_LAUNCH_MODE == 1) run(0, 64);
    else if (MK_LAUNCH_MODE == 4) { for (int l = 0; l < 4; ++l) run(l * 16, l * 16 + 16); }
    else { for (int l = 0; l < 4; ++l) for (int k = 0; k <= 10; ++k) run(l * 16 + k, l * 16 + k + 1); }
}
```

```cpp
#define MK_DBL 0
#include <hip/hip_runtime.h>
#include <cstdint>
#include <cstdio>

#ifndef MK_DBL
#define MK_DBL 0
#endif
#ifndef MK_LAUNCH_MODE
#define MK_LAUNCH_MODE 1
#endif
namespace {
constexpr int BATCH = 8, SEQ = 2048, M = BATCH * SEQ, D = 2048;
constexpr int HD = 64, SSD_H = 16, SSD_N = 128, CONV_DIM = 1536;
constexpr int RW_H = 16;
constexpr int IN_DIM = 5936, PROJ_LD = 5968;
constexpr int OFF_Z = 0, OFF_XBC = 1024, OFF_DT = 2560, OFF_RW = 2576, OFF_R = 2576, OFF_K = 3600, OFF_V = 4624, OFF_WLO = 5648, OFF_ALO = 5712, OFF_GLO = 5776, OFF_VLO = 5936;
constexpr int RW_SHIFT = 3360;
constexpr int DFF = 5632, NE = 8, DFE = 2816;
constexpr float ALPHA = 1.681792830507429f;
constexpr int LORA_LD = 320;

__device__ __forceinline__ float sigmoidf_(float x) { return 1.f / (1.f + expf(-x)); }
__device__ __forceinline__ float siluf_(float x) { return x / (1.f + expf(-x)); }
__device__ __forceinline__ float softplusf_(float x) { return fmaxf(x, 0.f) + log1pf(expf(-fabsf(x))); }
__device__ __forceinline__ float wave_sum(float v) {
#pragma unroll
    for (int o = 32; o >= 1; o >>= 1) v += __shfl_xor(v, o);
    return v;
}


#define LAS __attribute__((address_space(3)))
typedef unsigned short bf16_t;
typedef short bf16x8 __attribute__((ext_vector_type(8)));
typedef float f32x4 __attribute__((ext_vector_type(4)));
typedef float f32x2 __attribute__((ext_vector_type(2)));
typedef unsigned u32x4 __attribute__((ext_vector_type(4)));
typedef unsigned u32x2 __attribute__((ext_vector_type(2)));

__device__ __forceinline__ unsigned cvt_pk_bf16(float lo, float hi) { unsigned r; asm volatile("v_cvt_pk_bf16_f32 %0, %1, %2" : "=v"(r) : "v"(lo), "v"(hi)); return r; }
__device__ __forceinline__ float bf_lo(unsigned w) { return __uint_as_float(w << 16); }
__device__ __forceinline__ float bf_hi(unsigned w) { return __uint_as_float(w & 0xffff0000u); }
__device__ __forceinline__ float bf2f(bf16_t b) { return __uint_as_float(((unsigned)b) << 16); }
__device__ __forceinline__ float fast_silu(float x) { return x * __builtin_amdgcn_rcpf(1.f + __builtin_amdgcn_exp2f(-1.4426950408889634f * x)); }

namespace pg8 {
constexpr int BM = 256, BK = 64, HALF = 128, HTB = HALF * BK * 2, STAGE_BYTES = 8 * HTB, NXCD = 8, WGM = 8;
__host__ __device__ __forceinline__ int lds_byte(int r, int c) { const int st = (r >> 4) * 2 + (c >> 5), rr = r & 15, cc = c & 31, ob = rr * 64 + cc * 2; return st * 1024 + (ob ^ (((ob >> 9) & 1) << 5)); }
__host__ __device__ __forceinline__ void stage_rc(int b, int& R, int& C) { const int st = b / 1024, sb = b % 1024, swz = sb ^ (((sb >> 9) & 1) << 5); R = (st >> 1) * 16 + swz / 64; C = (st & 1) * 32 + (swz % 64) / 2; }
__host__ __device__ __forceinline__ int perm32(int rho) { const int n = rho >> 4, i = rho & 15; return 8 * (i >> 2) + 4 * n + (i & 3); }

struct Unit { int pm, pn, pb; };
struct Gemm { const bf16_t* A; const bf16_t* Bt; int K; };

__device__ __forceinline__ void decode_unit(int wgid, int nM, int nN, int& pm, int& pn) {
    const int nwg = nM * nN;
    { const int q = nwg / NXCD, r = nwg % NXCD, xcd = wgid % NXCD, off = wgid / NXCD; wgid = (xcd < r ? xcd * (q + 1) : r * (q + 1) + (xcd - r) * q) + off; }
    const int nig = WGM * nN, gid = wgid / nig, fm = gid * WGM, gsz = (nM - fm) < WGM ? (nM - fm) : WGM;
    pm = fm + ((wgid % nig) % gsz); pn = (wgid % nig) / gsz;
}
struct StaticOrder {
    int nM, nN, nwg, G, c;
    __device__ void init(int Mrows, int N, int G_, int c_) { nM = Mrows / BM; nN = N / BM; nwg = nM * nN; G = G_; c = c_; }
    __device__ __forceinline__ bool next(int i, Unit& u) const {
        const long L = (long)i * G + c; if (L >= nwg) return false;
        decode_unit((int)L, nM, nN, u.pm, u.pn); u.pb = u.pn; return true;
    }
};
struct GroupedOrder {
    int nM, nN, nwg, G, c; int cum[9];
    __device__ void init(const int* cnt, int N, int G_, int c_) {
        int acc = 0;
#pragma unroll
        for (int e = 0; e < 8; ++e) { cum[e] = acc; acc += (cnt[e] + 255) >> 8; }
        cum[8] = acc; nM = acc; nN = N / BM; nwg = nM * nN; G = G_; c = c_;
    }
    __device__ __forceinline__ bool next(int i, Unit& u) const {
        const long L = (long)i * G + c; if (L >= nwg) return false;
        decode_unit((int)L, nM, nN, u.pm, u.pn);
        int e = 0;
#pragma unroll
        for (int q = 1; q < 8; ++q) e += (u.pm >= cum[q]) ? 1 : 0;
        u.pb = e * nN + u.pn; return true;
    }
};

struct EpiF32 {
    static constexpr bool PERM = false;
    float* C; int ldc;
    __device__ __forceinline__ void operator()(const f32x4 (&acc)[2][2][4][2], const Unit& u, int wr, int wc, int fr, int fq) const {
        const int row0 = u.pm * BM + wr * 64 + fr, col0 = u.pn * BM + wc * 32 + 4 * fq;
#pragma unroll
        for (int ai = 0; ai < 2; ++ai)
#pragma unroll
            for (int m = 0; m < 4; ++m) { float* rowp = C + (size_t)(row0 + ai * HALF + m * 16) * ldc + col0;
#pragma unroll
                for (int bj = 0; bj < 2; ++bj)
#pragma unroll
                    for (int n = 0; n < 2; ++n) *(f32x4*)(rowp + bj * HALF + n * 16) = acc[ai][bj][m][n]; }
    }
};
struct EpiBf16 {
    static constexpr bool PERM = true;
    bf16_t* O; int ldc;
    __device__ __forceinline__ void operator()(const f32x4 (&acc)[2][2][4][2], const Unit& u, int wr, int wc, int fr, int fq) const {
        const int row0 = u.pm * BM + wr * 64 + fr, col0 = u.pn * BM + wc * 32 + 8 * fq;
#pragma unroll
        for (int ai = 0; ai < 2; ++ai)
#pragma unroll
            for (int m = 0; m < 4; ++m) { bf16_t* rowp = O + (size_t)(row0 + ai * HALF + m * 16) * ldc + col0;
#pragma unroll
                for (int bj = 0; bj < 2; ++bj) { const f32x4 v0 = acc[ai][bj][m][0], v1 = acc[ai][bj][m][1];
                    u32x4 w; w.x = cvt_pk_bf16(v0[0], v0[1]); w.y = cvt_pk_bf16(v0[2], v0[3]); w.z = cvt_pk_bf16(v1[0], v1[1]); w.w = cvt_pk_bf16(v1[2], v1[3]);
                    *(u32x4*)(rowp + bj * HALF) = w; } }
    }
};
struct EpiSwiglu {
    static constexpr bool PERM = true;
    bf16_t* O; int ldc;
    __device__ __forceinline__ void operator()(const f32x4 (&acc)[2][2][4][2], const Unit& u, int wr, int wc, int fr, int fq) const {
        const int row0 = u.pm * BM + wr * 64 + fr, col0 = u.pn * HALF + wc * 32 + 8 * fq;
#pragma unroll
        for (int ai = 0; ai < 2; ++ai)
#pragma unroll
            for (int m = 0; m < 4; ++m) { bf16_t* rowp = O + (size_t)(row0 + ai * HALF + m * 16) * ldc + col0;
                float o[8];
#pragma unroll
                for (int n = 0; n < 2; ++n)
#pragma unroll
                    for (int i = 0; i < 4; ++i) o[n * 4 + i] = fast_silu(acc[ai][0][m][n][i]) * acc[ai][1][m][n][i];
                u32x4 w; w.x = cvt_pk_bf16(o[0], o[1]); w.y = cvt_pk_bf16(o[2], o[3]); w.z = cvt_pk_bf16(o[4], o[5]); w.w = cvt_pk_bf16(o[6], o[7]);
                *(u32x4*)rowp = w; }
    }
};

template <class Epi, class Sched>
__device__ __forceinline__ void gemm_phase(LAS unsigned char* lds, const Gemm g, const Sched& S, const Epi& E, const int tid) {
    const int wid = __builtin_amdgcn_readfirstlane(tid >> 6), lane = tid & 63, wr = wid >> 2, wc = wid & 3, fr = lane & 15, fq = lane >> 4;
    const int K = g.K, nt = K / BK;
    unsigned voffA[2], voffB[2];
#pragma unroll
    for (int i = 0; i < 2; ++i) { int R, C; stage_rc(tid * 16 + i * 8192, R, C); const int Rb = Epi::PERM ? ((R & ~31) + perm32(R & 31)) : R;
        voffA[i] = (unsigned)(R * K + C) * 2u; voffB[i] = (unsigned)(Rb * K + C) * 2u; }
    const size_t kstep = (size_t)(BK * 2);
    const size_t hstep = (size_t)HALF * K * 2;
    const size_t tstep = 2 * hstep;
    const unsigned ldsw = (unsigned)wid * 1024u;
    const int aoff = lds_byte(wr * 64 + fr, fq * 8), boff = lds_byte(wc * 32 + fr, fq * 8);
#define PG8_SA(b, h) (((b) * 2 + (h)) * HTB)
#define PG8_SB(b, h) ((4 + (b) * 2 + (h)) * HTB)
#define PG8_STAGE(bufoff, gbase, voff) do { _Pragma("unroll") for (int _i = 0; _i < 2; ++_i) \
        __builtin_amdgcn_global_load_lds((const unsigned*)((const char*)(gbase) + (voff)[_i]), (LAS unsigned*)(lds + (bufoff) + ldsw + _i * 8192), 16, 0, 0); } while (0)
#define PG8_LDA(dst, b, h) do { _Pragma("unroll") for (int m = 0; m < 4; ++m) _Pragma("unroll") for (int k = 0; k < 2; ++k) dst[m][k] = *(const LAS bf16x8*)(lds + PG8_SA(b, h) + aoff + m * 2048 + k * 1024); } while (0)
#define PG8_LDB(dst, b, h) do { _Pragma("unroll") for (int n = 0; n < 2; ++n) _Pragma("unroll") for (int k = 0; k < 2; ++k) dst[n][k] = *(const LAS bf16x8*)(lds + PG8_SB(b, h) + boff + n * 2048 + k * 1024); } while (0)
#define PG8_MMA(ai, bj, At, Bt) do { __builtin_amdgcn_s_setprio(1); _Pragma("unroll") for (int m = 0; m < 4; ++m) _Pragma("unroll") for (int n = 0; n < 2; ++n) _Pragma("unroll") for (int k = 0; k < 2; ++k) \
        acc[ai][bj][m][n] = __builtin_amdgcn_mfma_f32_16x16x32_bf16(Bt[n][k], At[m][k], acc[ai][bj][m][n], 0, 0, 0); __builtin_amdgcn_s_setprio(0); } while (0)
#define PG8_WAIT_V(n) asm volatile("s_waitcnt vmcnt(" #n ")" ::: "memory")
#define PG8_WAIT_L(n) asm volatile("s_waitcnt lgkmcnt(" #n ")" ::: "memory")
#define PG8_BAR __builtin_amdgcn_s_barrier()
#define PG8_SCHED __builtin_amdgcn_sched_barrier(0)
    Unit cur, nxt; int ui = 0;
    if (!S.next(0, cur)) return;
    f32x4 acc[2][2][4][2];
#pragma unroll
    for (int a = 0; a < 2; ++a)
#pragma unroll
        for (int b = 0; b < 2; ++b)
#pragma unroll
            for (int m = 0; m < 4; ++m)
#pragma unroll
                for (int n = 0; n < 2; ++n) acc[a][b][m][n] = (f32x4){0.f, 0.f, 0.f, 0.f};
    bf16x8 At[4][2], B0[2][2], B1[2][2];
    const char* cA = (const char*)g.A + (size_t)cur.pm * tstep; const char* cB = (const char*)g.Bt + (size_t)cur.pb * tstep;
    PG8_STAGE(PG8_SB(0, 0), cB, voffB); PG8_STAGE(PG8_SB(0, 1), cB + hstep, voffB); PG8_STAGE(PG8_SA(0, 0), cA, voffA); PG8_STAGE(PG8_SA(0, 1), cA + hstep, voffA);
    if (wr == 1) PG8_BAR;
    PG8_WAIT_V(2); PG8_BAR;
    PG8_STAGE(PG8_SB(1, 0), cB + kstep, voffB); PG8_STAGE(PG8_SA(1, 0), cA + kstep, voffA); PG8_STAGE(PG8_SB(1, 1), cB + hstep + kstep, voffB);
    PG8_WAIT_V(6); PG8_BAR;
    for (;;) {
        const bool has_next = S.next(ui + 1, nxt);
        const char* nA = has_next ? (const char*)g.A + (size_t)nxt.pm * tstep : cA; const char* nB = has_next ? (const char*)g.Bt + (size_t)nxt.pb * tstep : cB;
        for (int t = 0; t < nt; t += 2) {
            const bool last = (t == nt - 2);
            const char* a1 = cA + (size_t)(t + 1) * kstep;
            const char* a2 = last ? nA : cA + (size_t)(t + 2) * kstep; const char* b2 = last ? nB : cB + (size_t)(t + 2) * kstep;
            const char* a3 = a2 + kstep; const char* b3 = b2 + kstep;
            PG8_LDB(B0, 0, 0); PG8_LDB(B1, 0, 1); PG8_SCHED; PG8_LDA(At, 0, 0); PG8_STAGE(PG8_SA(1, 1), a1 + hstep, voffA);
            PG8_WAIT_V(8); PG8_WAIT_L(0); PG8_BAR; PG8_MMA(0, 0, At, B0); PG8_MMA(0, 1, At, B1); PG8_BAR; PG8_SCHED;
            PG8_LDA(At, 0, 1); PG8_STAGE(PG8_SB(0, 0), b2, voffB); PG8_STAGE(PG8_SB(0, 1), b2 + hstep, voffB); PG8_STAGE(PG8_SA(0, 0), a2, voffA);
            PG8_WAIT_V(8); PG8_WAIT_L(0); PG8_BAR; PG8_MMA(1, 0, At, B0); PG8_MMA(1, 1, At, B1); PG8_BAR; PG8_SCHED;
            PG8_LDB(B0, 1, 0); PG8_LDB(B1, 1, 1); PG8_SCHED; PG8_LDA(At, 1, 0); PG8_STAGE(PG8_SA(0, 1), a2 + hstep, voffA);
            PG8_WAIT_V(8); PG8_WAIT_L(0); PG8_BAR; PG8_MMA(0, 0, At, B0); PG8_MMA(0, 1, At, B1); PG8_BAR; PG8_SCHED;
            PG8_LDA(At, 1, 1); PG8_STAGE(PG8_SB(1, 0), b3, voffB); PG8_STAGE(PG8_SB(1, 1), b3 + hstep, voffB); PG8_STAGE(PG8_SA(1, 0), a3, voffA);
            PG8_WAIT_V(8); PG8_WAIT_L(0); PG8_BAR; PG8_MMA(1, 0, At, B0); PG8_MMA(1, 1, At, B1); PG8_BAR; PG8_SCHED;
        }
        if (wr == 0) PG8_BAR;
        E(acc, cur, wr, wc, fr, fq);
        if (!has_next) break;
#pragma unroll
        for (int a = 0; a < 2; ++a)
#pragma unroll
            for (int b = 0; b < 2; ++b)
#pragma unroll
                for (int m = 0; m < 4; ++m)
#pragma unroll
                    for (int n = 0; n < 2; ++n) acc[a][b][m][n] = (f32x4){0.f, 0.f, 0.f, 0.f};
        cur = nxt; cA = nA; cB = nB; ++ui;
        if (wr == 1) PG8_BAR;
    }
    PG8_WAIT_V(0);
    PG8_BAR;
#undef PG8_SA
#undef PG8_SB
#undef PG8_STAGE
#undef PG8_LDA
#undef PG8_LDB
#undef PG8_MMA
#undef PG8_WAIT_V
#undef PG8_WAIT_L
#undef PG8_BAR
#undef PG8_SCHED
}
}

#define XB_TMO      128
#define XB_XCNT(j)  (256  + 64 * (j))
#define XB_XSUB(j)  (1280 + 64 * (j))
#define XB_XGEN(j)  (2304 + 64 * (j))
#define XB_TOP      3328
#define XB_TOPGEN   3392
#define XCD_BAR_WORDS 3456
#define XB_SPIN_CAP (1u << 18)
__device__ __forceinline__ unsigned xb_ld(unsigned* p)              { return __hip_atomic_load(p, __ATOMIC_RELAXED, __HIP_MEMORY_SCOPE_AGENT); }
__device__ __forceinline__ unsigned xb_add(unsigned* p, unsigned v) { return __hip_atomic_fetch_add(p, v, __ATOMIC_RELAXED, __HIP_MEMORY_SCOPE_AGENT); }
__device__ __forceinline__ unsigned xb_xcc_id() { return (unsigned)__builtin_amdgcn_s_getreg((3 << 11) | 20) & 0xFu; }
#define XB_SPIN(cond, bar) do { unsigned _sp = 0; while (cond) { __builtin_amdgcn_s_sleep(1); \
    if ((++_sp & 255u) == 0u) { if (xb_ld(&(bar)[XB_TMO])) break; if (_sp > XB_SPIN_CAP) { atomicAdd(&(bar)[XB_TMO], 1u); break; } } } } while (0)
struct XcdBarrier { unsigned* bar; unsigned x; volatile LAS unsigned* st; };
__device__ __forceinline__ XcdBarrier xcd_barrier_post(unsigned* bar, volatile LAS unsigned* st) {
    XcdBarrier b; b.bar = bar; b.x = xb_xcc_id(); b.st = st;
    if (threadIdx.x == 0) (void)xb_add(&bar[XB_XCNT(b.x)], 1u);
    return b;
}
__device__ __forceinline__ void xcd_barrier_complete(unsigned* bar, unsigned x, unsigned& nloc, unsigned& nx) {
    const unsigned G = gridDim.x * gridDim.y * gridDim.z;
    asm volatile("" : "+s"(x));
    unsigned sum, cnt, mine, sp = 0u;
    for (;;) {
        sum = 0u; cnt = 0u; mine = 0u;
#pragma unroll
        for (unsigned j = 0; j < 16; ++j) { const unsigned c = xb_ld(&bar[XB_XCNT(j)]); sum += c; cnt += (c > 0u) ? 1u : 0u; mine = (j == x) ? c : mine; }
        if (sum == G) break;
        __builtin_amdgcn_s_sleep(1);
        if ((++sp & 255u) == 0u) { if (xb_ld(&bar[XB_TMO])) break; if (sp > XB_SPIN_CAP) { atomicAdd(&bar[XB_TMO], 1u); break; } }
    }
    nloc = mine > 0u ? mine : 1u; nx = cnt > 0u ? cnt : 1u;
}
__device__ __forceinline__ void xcd_barrier(const XcdBarrier& b) {
    asm volatile("s_waitcnt vmcnt(0)" ::: "memory");
    __syncthreads();
    if (threadIdx.x == 0) {
        unsigned* bar = b.bar;
        __builtin_amdgcn_s_waitcnt(0);
        unsigned nloc = b.st[0], nx = b.st[1];
        if (nloc == 0u) { xcd_barrier_complete(bar, b.x, nloc, nx); b.st[0] = nloc; b.st[1] = nx; }
        const unsigned old = xb_add(&bar[XB_XSUB(b.x)], 1u);
        const unsigned gen = old / nloc;
        if (old + 1u == (gen + 1u) * nloc) {
            __builtin_amdgcn_fence(__ATOMIC_RELEASE, "agent");
            asm volatile("s_waitcnt vmcnt(0)" ::: "memory");
            const unsigned og = xb_add(&bar[XB_TOP], 1u);
            const unsigned tg = og / nx;
            if (og + 1u == (tg + 1u) * nx) xb_add(&bar[XB_TOPGEN], 1u);
            else XB_SPIN(xb_ld(&bar[XB_TOPGEN]) == tg, bar);
            __builtin_amdgcn_fence(__ATOMIC_ACQUIRE, "agent");
            xb_add(&bar[XB_XGEN(b.x)], 1u);
            asm volatile("s_waitcnt vmcnt(0)" ::: "memory");
        } else {
            XB_SPIN(xb_ld(&bar[XB_XGEN(b.x)]) == gen, bar);
            __builtin_amdgcn_fence(__ATOMIC_ACQUIRE, "agent");
            asm volatile("s_waitcnt vmcnt(0)" ::: "memory");
        }
    }
    __syncthreads();
}

constexpr size_t MiB = 1u << 20;
constexpr int NWAVES = 8;
constexpr int PROJ_BLD = 6144;
constexpr int PMAX = 34816;
constexpr int FLD = 2048 + 64;
constexpr size_t WS_CTL = 0, CTL_BYTES = 1 * MiB;
constexpr size_t WS_WIN = 1 * MiB, WS_WOUT = 25 * MiB, WS_WLORA = 33 * MiB;
constexpr size_t WS_XF = 34 * MiB, WS_XB = 162 * MiB, WS_VFIRST = 226 * MiB, WS_YMIXB = 290 * MiB, WS_TOK = 354 * MiB, WS_SCR = 356 * MiB;
constexpr size_t WS_PROJB = WS_SCR, WS_LW = WS_PROJB + 192 * MiB, WS_YRW = WS_LW + 128 * MiB, WS_BON = WS_YRW + 64 * MiB, WS_XBCC = WS_BON + 64 * MiB, WS_DTB = WS_XBCC + 48 * MiB, WS_YSSD = WS_DTB + 1 * MiB, WS_MIXED = WS_YSSD + 64 * MiB;
constexpr size_t WS_HBUF = WS_SCR, WS_XG = WS_HBUF + 187 * MiB, WS_YSLOT = WS_XG + 136 * MiB;
constexpr size_t WS_WFFN = WS_SCR + 860 * MiB, WS_END = WS_WFFN + 264 * MiB;
static_assert(WS_MIXED + 132 * MiB <= WS_WFFN && WS_YSLOT + 281 * MiB <= WS_WFFN, "scratch inside the map");
static_assert((size_t)PMAX * DFE * 2 <= 187 * MiB && (size_t)PMAX * D * 2 <= 136 * MiB && (size_t)PMAX * FLD * 4 <= 281 * MiB && (size_t)M * FLD * 4 <= 132 * MiB, "moe buffers");
constexpr int CW_CNT = 16;
constexpr int CW_BAR = 4096;
constexpr int MAX_BAR_REGIONS = 48;
static_assert((CW_BAR + MAX_BAR_REGIONS * XCD_BAR_WORDS) * 4 <= (int)CTL_BYTES, "ctl");
constexpr int RING_BYTES = 131072, LDS_BYTES = 147456, MISC_OFF = LDS_BYTES - 256;

struct Params { const float* in[35]; float* out; unsigned char* ws; int ph_lo, ph_hi, bar_idx, pad; };

__device__ __forceinline__ float wave_sum_f(float v) {
#pragma unroll
    for (int o = 32; o >= 1; o >>= 1) v += __shfl_xor(v, o);
    return v;
}

__device__ __forceinline__ void cvt_item(const float* W, int K, int N, bf16_t* WT, int dst_row0, LAS float* scr, int k0, int n0, int lane) {
#pragma unroll 8
    for (int i = 0; i < 32; ++i) { const int kk = 2 * i + (lane >> 5), col = lane & 31;
        scr[kk * 33 + col] = (k0 + kk < K && n0 + col < N) ? W[(size_t)(k0 + kk) * N + n0 + col] : 0.f; }
    asm volatile("s_waitcnt lgkmcnt(0)" ::: "memory");
    const int c = lane & 7;
#pragma unroll
    for (int j = 0; j < 4; ++j) { const int n = (lane >> 3) + 8 * j; const LAS float* s = scr + (8 * c) * 33 + n;
        u32x4 o; o.x = cvt_pk_bf16(s[0 * 33], s[1 * 33]); o.y = cvt_pk_bf16(s[2 * 33], s[3 * 33]); o.z = cvt_pk_bf16(s[4 * 33], s[5 * 33]); o.w = cvt_pk_bf16(s[6 * 33], s[7 * 33]);
        if (n0 + n < N && k0 + 8 * c < K) *(u32x4*)(WT + (size_t)(dst_row0 + n) * K + k0 + 8 * c) = o; }
    asm volatile("s_waitcnt lgkmcnt(0)" ::: "memory");
}
template <int MODE>
__device__ __forceinline__ void cvt_job(const float* W, int K, int N, bf16_t* WT, int row_off, int half, LAS float* scr, int gw, int ngw, int lane) {
    const int nkb = (K + 63) / 64, nnb = (N + 31) / 32, nitems = nkb * nnb;
    for (int it = gw; it < nitems; it += ngw) {
        const int kb = it / nnb, nb = it % nnb, n0 = nb * 32;
        const int dr = MODE == 0 ? row_off + n0 : row_off + 256 * (n0 / 128) + half * 128 + (n0 % 128);
        cvt_item(W, K, N, WT, dr, scr, kb * 64, n0, lane);
    }
}

struct LnOut { float* xf; bf16_t* xb; };
__device__ __forceinline__ void ln_finish(f32x4 (&v)[8], const float* gam, const float* bet, int lane, float* xf_row, bf16_t* xb_row) {
    float s = 0.f;
#pragma unroll
    for (int j = 0; j < 8; ++j) s += (v[j][0] + v[j][1]) + (v[j][2] + v[j][3]);
    const float mean = wave_sum_f(s) * (1.f / D);
    float q = 0.f;
#pragma unroll
    for (int j = 0; j < 8; ++j) { v[j] = v[j] - mean; q += (v[j][0] * v[j][0] + v[j][1] * v[j][1]) + (v[j][2] * v[j][2] + v[j][3] * v[j][3]); }
    const float rstd = rsqrtf(wave_sum_f(q) * (1.f / D) + 1e-5f);
#pragma unroll
    for (int j = 0; j < 8; ++j) { const int c = 4 * lane + 256 * j;
        const f32x4 g = *(const f32x4*)(gam + c), b = *(const f32x4*)(bet + c);
        v[j] = v[j] * rstd * g + b;
        *(f32x4*)(xf_row + c) = v[j];
        if (xb_row) { u32x2 w; w.x = cvt_pk_bf16(v[j][0], v[j][1]); w.y = cvt_pk_bf16(v[j][2], v[j][3]); *(u32x2*)(xb_row + c) = w; } }
}

#define DPP_ROR(z, n) __uint_as_float(__builtin_amdgcn_update_dpp(0u, __float_as_uint(z), 0x120 + (n), 0xf, 0xf, false))
__device__ __forceinline__ float wave_allsum(float x) {
    { auto s = __builtin_amdgcn_permlane32_swap(__float_as_uint(x), __float_as_uint(x), false, false); x = __uint_as_float(s[0]) + __uint_as_float(s[1]); }
    { auto s = __builtin_amdgcn_permlane16_swap(__float_as_uint(x), __float_as_uint(x), false, false); x = __uint_as_float(s[0]) + __uint_as_float(s[1]); }
    x += DPP_ROR(x, 8); x += DPP_ROR(x, 4); x += DPP_ROR(x, 2); x += DPP_ROR(x, 1);
    return x;
}
__device__ __forceinline__ float reduce4(float x0, float x1, float x2, float x3) {
    float y0, y1, z;
    { auto s = __builtin_amdgcn_permlane32_swap(__float_as_uint(x0), __float_as_uint(x2), false, false); y0 = __uint_as_float(s[0]) + __uint_as_float(s[1]); }
    { auto s = __builtin_amdgcn_permlane32_swap(__float_as_uint(x1), __float_as_uint(x3), false, false); y1 = __uint_as_float(s[0]) + __uint_as_float(s[1]); }
    { auto s = __builtin_amdgcn_permlane16_swap(__float_as_uint(y0), __float_as_uint(y1), false, false); z = __uint_as_float(s[0]) + __uint_as_float(s[1]); }
    z += DPP_ROR(z, 8); z += DPP_ROR(z, 4); z += DPP_ROR(z, 2); z += DPP_ROR(z, 1);
    return z;
}
__device__ __forceinline__ float rdlane(float v, int l) { return __int_as_float(__builtin_amdgcn_readlane(__float_as_int(v), l)); }
__device__ __forceinline__ float fast_sigmoid(float x) { return __builtin_amdgcn_rcpf(1.f + __builtin_amdgcn_exp2f(-1.4426950408889634f * x)); }
__device__ __forceinline__ float fast_tanh(float x) { return 1.f - 2.f * __builtin_amdgcn_rcpf(1.f + __builtin_amdgcn_exp2f(2.8853900817779268f * x)); }

constexpr int LORA_PITCH = 328;
__device__ __forceinline__ void lora_phase(LAS unsigned char* lds, const bf16_t* projb, const float* mix, const float* vmix, const bf16_t* Wl_w, const bf16_t* Wl_a, const bf16_t* Wl_g, const bf16_t* Wl_v,
                                           bf16_t* lw, const bool has_v, const int vcu, const int G, const int tid) {
    const int wave = __builtin_amdgcn_readfirstlane(tid >> 6), lane = tid & 63, fr = lane & 15, fq = lane >> 4;
    LAS bf16_t* Aimg = (LAS bf16_t*)lds;
    for (int u = vcu; u < M / 64; u += G) {
        {
            const int tau = tid >> 3, part = tid & 7, m = u * 64 + tau; const bool first = (m % SEQ) == 0;
#pragma unroll
            for (int i = 0; i < 5; ++i) {
                const int j0 = 40 * part + 8 * i;
                const u32x4 cur = *(const u32x4*)(projb + (size_t)m * PROJ_BLD + OFF_WLO + j0);
                u32x4 prv = (u32x4){0u, 0u, 0u, 0u};
                if (!first) prv = *(const u32x4*)(projb + (size_t)(m - 1) * PROJ_BLD + OFF_WLO + j0);
                f32x4 mx0, mx1;
                if (j0 < 288) { mx0 = *(const f32x4*)(mix + (OFF_WLO - OFF_RW) + j0); mx1 = *(const f32x4*)(mix + (OFF_WLO - OFF_RW) + j0 + 4); }
                else if (has_v) { mx0 = *(const f32x4*)(vmix + (j0 - 288)); mx1 = *(const f32x4*)(vmix + (j0 - 288) + 4); }
                else { mx0 = (f32x4){0.f, 0.f, 0.f, 0.f}; mx1 = mx0; }
                float o[8];
#pragma unroll
                for (int e = 0; e < 4; ++e) {
                    const float c0 = bf_lo(cur[e]), c1 = bf_hi(cur[e]), p0 = bf_lo(prv[e]), p1 = bf_hi(prv[e]);
                    const float m0 = (e < 2) ? mx0[2 * e] : mx1[2 * e - 4], m1 = (e < 2) ? mx0[2 * e + 1] : mx1[2 * e - 3];
                    o[2 * e] = c0 + (p0 - c0) * m0; o[2 * e + 1] = c1 + (p1 - c1) * m1;
                }
                if (j0 < 64) {
#pragma unroll
                    for (int e = 0; e < 8; ++e) o[e] = fast_tanh(o[e]);
                } else if (j0 >= 128 && j0 < 288) {
#pragma unroll
                    for (int e = 0; e < 8; ++e) o[e] = fast_sigmoid(o[e]);
                }
                u32x4 w; w.x = cvt_pk_bf16(o[0], o[1]); w.y = cvt_pk_bf16(o[2], o[3]); w.z = cvt_pk_bf16(o[4], o[5]); w.w = cvt_pk_bf16(o[6], o[7]);
                *(LAS u32x4*)(Aimg + tau * LORA_PITCH + j0) = w;
            }
        }
        __syncthreads();
        for (int q = 0; q < 4; ++q) {
            if (q == 3 && !has_v) break;
            const int K = (q == 2) ? 160 : (q == 3 ? 32 : 64), koff = (q == 0) ? 0 : (q == 1 ? 64 : (q == 2 ? 128 : 288));
            const bf16_t* W = (q == 0) ? Wl_w : (q == 1 ? Wl_a : (q == 2 ? Wl_g : Wl_v));
            f32x4 acc[8][4];
#pragma unroll
            for (int ct = 0; ct < 8; ++ct)
#pragma unroll
                for (int tt = 0; tt < 4; ++tt) acc[ct][tt] = (f32x4){0.f, 0.f, 0.f, 0.f};
            for (int ks = 0; ks < K / 32; ++ks) {
                bf16x8 af[8], bfr[4];
#pragma unroll
                for (int ct = 0; ct < 8; ++ct) af[ct] = *(const bf16x8*)(W + (size_t)(128 * wave + 16 * ct + fr) * K + 32 * ks + 8 * fq);
#pragma unroll
                for (int tt = 0; tt < 4; ++tt) bfr[tt] = *(const LAS bf16x8*)(Aimg + (16 * tt + fr) * LORA_PITCH + koff + 32 * ks + 8 * fq);
#pragma unroll
                for (int ct = 0; ct < 8; ++ct)
#pragma unroll
                    for (int tt = 0; tt < 4; ++tt) acc[ct][tt] = __builtin_amdgcn_mfma_f32_16x16x32_bf16(af[ct], bfr[tt], acc[ct][tt], 0, 0, 0);
            }
            bf16_t* out = lw + (size_t)q * M * 1024;
#pragma unroll
            for (int ct = 0; ct < 8; ++ct)
#pragma unroll
                for (int tt = 0; tt < 4; ++tt) { u32x2 w; w.x = cvt_pk_bf16(acc[ct][tt][0], acc[ct][tt][1]); w.y = cvt_pk_bf16(acc[ct][tt][2], acc[ct][tt][3]);
                    *(u32x2*)(out + (size_t)(u * 64 + 16 * tt + fr) * 1024 + 128 * wave + 16 * ct + 4 * fq) = w; }
        }
        __syncthreads();
    }
}

struct RwScan { const bf16_t* proj_; const bf16_t* lw_; const float* mix; const float* w0; const float* a0; const float* v0; const float* k_k; const float* k_a; const float* r_k; float* vf_; float* y_; float* bon_; int layer; int pad; };
constexpr int RWB_A = 0, RWB_DR = 8192, RWB_D = 16384, RWB_B = 24576, RWB_K = 32768, RWB_V = 40960, RWB_SC = 45056, RWB_SIZE = 45568, RW_YST = 3 * RWB_SIZE, RW_YST_SIZE = 4096, RW_TB = 32, RW_NCH = SEQ / RW_TB;
static_assert(RW_YST + 2 * RW_YST_SIZE <= MISC_OFF, "rwkv scan LDS map");
__device__ __forceinline__ float rowsum16(float z) { z += DPP_ROR(z, 8); asm("" : "+v"(z)); z += DPP_ROR(z, 4); asm("" : "+v"(z)); z += DPP_ROR(z, 2); asm("" : "+v"(z)); z += DPP_ROR(z, 1); asm("" : "+v"(z)); return z; }
__device__ __forceinline__ void rwkv_scan_phase(LAS unsigned char* lds, const RwScan& a, const int vcu, const int G, const int tid) {
    const int wave = __builtin_amdgcn_readfirstlane(tid >> 6), lane = tid & 63, jj = lane & 15, rg = lane >> 4;
    for (int u = vcu; u < BATCH * RW_H * 2; u += G) {
        const int b = u >> 5, h = (u >> 1) & 15, half = u & 1;
        if (wave >= 4) {
            const int pw_ = wave - 4, c = h * 64 + lane, ptid = tid - 256;
            const float mix_r = a.mix[c], mix_k = a.mix[1024 + c], mix_v = a.mix[2048 + c];
            const float w0c = a.w0[c], a0c = a.a0[c], v0c = a.layer ? a.v0[c] : 0.f, kkc = a.k_k[c], kac = a.k_a[c], rkc = a.r_k[c];
            const bf16_t* lw_w = a.lw_; const bf16_t* lw_a = a.lw_ + (size_t)M * 1024; const bf16_t* lw_v = a.lw_ + (size_t)3 * M * 1024;
            const int woff = jj * 16 + rg * 4;
            unsigned pr[9], pk[9], pv[9], pw[8], pa[8], pvp[8]; float pvf[8];
#define RW_PREFETCH(t0_) do { const int tb_ = (t0_) + 8 * pw_; \
            _Pragma("unroll") for (int i = 0; i < 9; ++i) { const int t_ = tb_ + i - 1; \
                if (t_ >= 0) { const bf16_t* row_ = a.proj_ + (size_t)(b * SEQ + t_) * PROJ_BLD + h * 64 + lane; pr[i] = row_[OFF_R]; pk[i] = row_[OFF_K]; pv[i] = row_[OFF_V]; } \
                else { pr[i] = 0u; pk[i] = 0u; pv[i] = 0u; } } \
            _Pragma("unroll") for (int i = 0; i < 8; ++i) { const size_t o_ = (size_t)(b * SEQ + tb_ + i) * 1024 + c; pw[i] = lw_w[o_]; pa[i] = lw_a[o_]; \
                if (a.layer) { pvp[i] = lw_v[o_]; pvf[i] = a.vf_[o_]; } else { pvp[i] = 0u; pvf[i] = 0.f; } } } while (0)
#define RW_PREP(ch_) do { const int t0_ = (ch_) * RW_TB; LAS unsigned char* buf_ = lds + ((ch_) % 3) * RWB_SIZE; \
            _Pragma("unroll") for (int i = 0; i < 8; ++i) { \
                const int tau = 8 * pw_ + i; \
                const float rc = __uint_as_float(pr[i + 1] << 16), rp = __uint_as_float(pr[i] << 16), kc = __uint_as_float(pk[i + 1] << 16), kp = __uint_as_float(pk[i] << 16), vc = __uint_as_float(pv[i + 1] << 16), vp = __uint_as_float(pv[i] << 16); \
                const float r = rc + (rp - rc) * mix_r, kraw = kc + (kp - kc) * mix_k, vraw = vc + (vp - vc) * mix_v; \
                const float sg = fast_sigmoid(w0c + __uint_as_float(pw[i] << 16)); \
                const float dec = __builtin_amdgcn_exp2f(-1.4426950408889634f * 0.6065306597126334f * sg);     \
                const float as = fast_sigmoid(a0c + __uint_as_float(pa[i] << 16)); \
                float v = vraw; \
                if (a.layer) v = vraw + (pvf[i] - vraw) * fast_sigmoid(v0c + __uint_as_float(pvp[i] << 16)); \
                const float kkv = kraw * kkc; \
                const float km = kraw * (1.f + (as - 1.f) * kac); \
                const float z = reduce4(kkv * kkv, r * km * rkc, kkv * as * r, km * r);     \
                const float nrm2 = rdlane(z, 0), rks = rdlane(z, 16), bru = rdlane(z, 32), kr = rdlane(z, 48); \
                const float inv = 1.f / fmaxf(sqrtf(nrm2), 1e-12f); \
                const float kkn = kkv * inv; \
                *(LAS float*)(buf_ + RWB_A + tau * 256 + woff) = -kkn; *(LAS float*)(buf_ + RWB_DR + tau * 256 + woff) = dec * r; *(LAS float*)(buf_ + RWB_D + tau * 256 + woff) = dec; \
                *(LAS float*)(buf_ + RWB_B + tau * 256 + woff) = kkn * as; *(LAS float*)(buf_ + RWB_K + tau * 256 + woff) = km; \
                if ((lane >> 5) == half) { ((LAS float*)(buf_ + RWB_V))[tau * 32 + (lane & 31)] = v; \
                    if (a.layer == 0) a.vf_[(size_t)(b * SEQ + t0_ + tau) * 1024 + c] = vraw; } \
                if (lane == 0) { ((LAS float*)(buf_ + RWB_SC))[tau] = bru * inv; ((LAS float*)(buf_ + RWB_SC))[32 + tau] = kr; ((LAS float*)(buf_ + RWB_SC))[64 + tau] = rks; } \
            } } while (0)
#define RW_FLUSH(ch_) do { const int t0_ = (ch_) * RW_TB; const LAS unsigned char* buf_ = lds + ((ch_) % 3) * RWB_SIZE; const LAS float* yst_ = (const LAS float*)(lds + RW_YST + ((ch_) & 1) * RW_YST_SIZE); \
            _Pragma("unroll") for (int q = 0; q < 4; ++q) { const int idx = ptid + 256 * q, tau = idx >> 5, i = idx & 31; \
                const float y = yst_[((((tau >> 4) * 4 + (i >> 3)) * 64 + ((i & 7) >> 1) * 16 + (tau & 15)) << 1) + (i & 1)]; \
                const float bo = ((const LAS float*)(buf_ + RWB_SC))[64 + tau] * ((const LAS float*)(buf_ + RWB_V))[tau * 32 + i]; \
                const size_t o = (size_t)(b * SEQ + t0_ + tau) * 1024 + h * 64 + half * 32 + i; \
                a.y_[o] = y; a.bon_[o] = bo; } } while (0)
            RW_PREFETCH(0);
            RW_PREP(0);
            RW_PREFETCH(RW_TB);
            __syncthreads();
            for (int ch = 0; ch < RW_NCH; ++ch) {
                if (ch > 0) RW_FLUSH(ch - 1);
                if (ch + 1 < RW_NCH) { RW_PREP(ch + 1); if (ch + 2 < RW_NCH) RW_PREFETCH((ch + 2) * RW_TB); }
                __syncthreads();
            }
            RW_FLUSH(RW_NCH - 1);
#undef RW_PREFETCH
#undef RW_PREP
#undef RW_FLUSH
        } else {
            f32x2 S0 = (f32x2){0.f, 0.f}, S1 = S0, S2 = S0, S3 = S0;
            __syncthreads();
            for (int ch = 0; ch < RW_NCH; ++ch) {
                const LAS unsigned char* buf = lds + (ch % 3) * RWB_SIZE;
                const LAS unsigned char* ob = buf + jj * 16;
                const LAS float* Vb = (const LAS float*)(buf + RWB_V) + 8 * wave + 2 * rg; const LAS float* SC = (const LAS float*)(buf + RWB_SC);
                LAS f32x2* Yst = (LAS f32x2*)(lds + RW_YST + (ch & 1) * RW_YST_SIZE);
                f32x4 a4 = *(const LAS f32x4*)(ob + RWB_A), q4 = *(const LAS f32x4*)(ob + RWB_DR), d4 = *(const LAS f32x4*)(ob + RWB_D), b4 = *(const LAS f32x4*)(ob + RWB_B), k4 = *(const LAS f32x4*)(ob + RWB_K);
                f32x2 vi = *(const LAS f32x2*)Vb; float br = SC[0], kr = SC[32];
#pragma unroll
                for (int blk = 0; blk < 2; ++blk) {
                    f32x2 yacc = (f32x2){0.f, 0.f};
#pragma unroll
                    for (int s = 0; s < 16; ++s) {
                        const int tn = blk * 16 + s + 1;
                        const f32x4 na4 = *(const LAS f32x4*)(ob + RWB_A + tn * 256), nq4 = *(const LAS f32x4*)(ob + RWB_DR + tn * 256), nd4 = *(const LAS f32x4*)(ob + RWB_D + tn * 256),
                                    nb4 = *(const LAS f32x4*)(ob + RWB_B + tn * 256), nk4 = *(const LAS f32x4*)(ob + RWB_K + tn * 256);
                        const f32x2 nvi = *(const LAS f32x2*)(Vb + (tn & 31) * 32); const float nbr = SC[tn & 31], nkr = SC[32 + (tn & 31)];
                        const f32x2 pa_ = (S0 * a4[0] + S1 * a4[1]) + (S2 * a4[2] + S3 * a4[3]);
                        const f32x2 pq_ = (S0 * q4[0] + S1 * q4[1]) + (S2 * q4[2] + S3 * q4[3]);
                        f32x2 sa, zq;
                        sa.x = rowsum16(pa_.x); sa.y = rowsum16(pa_.y); zq.x = rowsum16(pq_.x); zq.y = rowsum16(pq_.y);
                        S0 = S0 * d4[0] + sa * b4[0] + vi * k4[0]; S1 = S1 * d4[1] + sa * b4[1] + vi * k4[1]; S2 = S2 * d4[2] + sa * b4[2] + vi * k4[2]; S3 = S3 * d4[3] + sa * b4[3] + vi * k4[3];
                        const f32x2 y = zq + sa * br + vi * kr;
                        yacc.x = (jj == s) ? y.x : yacc.x; yacc.y = (jj == s) ? y.y : yacc.y;
                        a4 = na4; q4 = nq4; d4 = nd4; b4 = nb4; k4 = nk4; vi = nvi; br = nbr; kr = nkr;
                    }
                    Yst[(blk * 4 + wave) * 64 + lane] = yacc;
                }
                __syncthreads();
            }
        }
        __syncthreads();
    }
}

__device__ __forceinline__ void rwkv_post_phase(const float* yrw, const float* bon, const bf16_t* lw_g, const float* ln_w, const float* ln_b, bf16_t* ymixb, const int gw, const int NGW, const int lane) {
    const int c0 = 16 * lane;
    f32x4 lw4[4], lb4[4];
#pragma unroll
    for (int j = 0; j < 4; ++j) { lw4[j] = *(const f32x4*)(ln_w + c0 + 4 * j); lb4[j] = *(const f32x4*)(ln_b + c0 + 4 * j); }
    for (int m = gw; m < M; m += NGW) {
        f32x4 y[4], bo[4];
#pragma unroll
        for (int j = 0; j < 4; ++j) { y[j] = *(const f32x4*)(yrw + (size_t)m * 1024 + c0 + 4 * j); bo[j] = *(const f32x4*)(bon + (size_t)m * 1024 + c0 + 4 * j); }
        const u32x4 g0 = *(const u32x4*)(lw_g + (size_t)m * 1024 + c0), g1 = *(const u32x4*)(lw_g + (size_t)m * 1024 + c0 + 8);
        float s = 0.f;
#pragma unroll
        for (int j = 0; j < 4; ++j) s += (y[j][0] + y[j][1]) + (y[j][2] + y[j][3]);
        s += __shfl_xor(s, 1); s += __shfl_xor(s, 2);
        const float mu = s * (1.f / 64.f);
        float q = 0.f;
#pragma unroll
        for (int j = 0; j < 4; ++j) { y[j] = y[j] - mu; q += (y[j][0] * y[j][0] + y[j][1] * y[j][1]) + (y[j][2] * y[j][2] + y[j][3] * y[j][3]); }
        q += __shfl_xor(q, 1); q += __shfl_xor(q, 2);
        const float rstd = rsqrtf(q * (1.f / 64.f) + 64e-5f);
        float o[16];
#pragma unroll
        for (int j = 0; j < 4; ++j) { const f32x4 t = y[j] * rstd * lw4[j] + lb4[j] + bo[j]; o[4 * j] = t[0]; o[4 * j + 1] = t[1]; o[4 * j + 2] = t[2]; o[4 * j + 3] = t[3]; }
        const unsigned gw_[8] = {g0.x, g0.y, g0.z, g0.w, g1.x, g1.y, g1.z, g1.w};
        u32x4 w0, w1;
        w0.x = cvt_pk_bf16(o[0] * bf_lo(gw_[0]), o[1] * bf_hi(gw_[0])); w0.y = cvt_pk_bf16(o[2] * bf_lo(gw_[1]), o[3] * bf_hi(gw_[1]));
        w0.z = cvt_pk_bf16(o[4] * bf_lo(gw_[2]), o[5] * bf_hi(gw_[2])); w0.w = cvt_pk_bf16(o[6] * bf_lo(gw_[3]), o[7] * bf_hi(gw_[3]));
        w1.x = cvt_pk_bf16(o[8] * bf_lo(gw_[4]), o[9] * bf_hi(gw_[4])); w1.y = cvt_pk_bf16(o[10] * bf_lo(gw_[5]), o[11] * bf_hi(gw_[5]));
        w1.z = cvt_pk_bf16(o[12] * bf_lo(gw_[6]), o[13] * bf_hi(gw_[6])); w1.w = cvt_pk_bf16(o[14] * bf_lo(gw_[7]), o[15] * bf_hi(gw_[7]));
        *(u32x4*)(ymixb + (size_t)m * 2048 + 1024 + c0) = w0; *(u32x4*)(ymixb + (size_t)m * 2048 + 1024 + c0 + 8) = w1;
    }
}

__device__ __forceinline__ void ssd_conv_phase(const bf16_t* projb, const float* cw, const float* cb, const float* dt_bias, bf16_t* xbcc, float* dtb, const int vcu, const int G, const int tid) {
    for (int u = vcu; u < M / 64; u += G) {
        if (tid < 384) {
            const int cg = tid % 192, hf = tid / 192, c0 = 8 * cg, m0 = u * 64 + 32 * hf, t_in_seq = m0 % SEQ;
            float w[4][8], bias[8];
#pragma unroll
            for (int q = 0; q < 4; ++q) { const f32x4 a = *(const f32x4*)(cw + q * CONV_DIM + c0), b = *(const f32x4*)(cw + q * CONV_DIM + c0 + 4);
                w[q][0] = a[0]; w[q][1] = a[1]; w[q][2] = a[2]; w[q][3] = a[3]; w[q][4] = b[0]; w[q][5] = b[1]; w[q][6] = b[2]; w[q][7] = b[3]; }
            { const f32x4 a = *(const f32x4*)(cb + c0), b = *(const f32x4*)(cb + c0 + 4); bias[0] = a[0]; bias[1] = a[1]; bias[2] = a[2]; bias[3] = a[3]; bias[4] = b[0]; bias[5] = b[1]; bias[6] = b[2]; bias[7] = b[3]; }
            float win[3][8];
#pragma unroll
            for (int q = 0; q < 3; ++q) {
                u32x4 r = (u32x4){0u, 0u, 0u, 0u};
                if (t_in_seq - 3 + q >= 0) r = *(const u32x4*)(projb + (size_t)(m0 - 3 + q) * PROJ_BLD + OFF_XBC + c0);
                win[q][0] = bf_lo(r.x); win[q][1] = bf_hi(r.x); win[q][2] = bf_lo(r.y); win[q][3] = bf_hi(r.y); win[q][4] = bf_lo(r.z); win[q][5] = bf_hi(r.z); win[q][6] = bf_lo(r.w); win[q][7] = bf_hi(r.w);
            }
            for (int i = 0; i < 32; ++i) {
                const u32x4 r = *(const u32x4*)(projb + (size_t)(m0 + i) * PROJ_BLD + OFF_XBC + c0);
                float cur[8] = {bf_lo(r.x), bf_hi(r.x), bf_lo(r.y), bf_hi(r.y), bf_lo(r.z), bf_hi(r.z), bf_lo(r.w), bf_hi(r.w)};
                float o[8];
#pragma unroll
                for (int e = 0; e < 8; ++e) { const float acc = bias[e] + w[0][e] * win[0][e] + w[1][e] * win[1][e] + w[2][e] * win[2][e] + w[3][e] * cur[e]; o[e] = fast_silu(acc);
                    win[0][e] = win[1][e]; win[1][e] = win[2][e]; win[2][e] = cur[e]; }
                u32x4 wv; wv.x = cvt_pk_bf16(o[0], o[1]); wv.y = cvt_pk_bf16(o[2], o[3]); wv.z = cvt_pk_bf16(o[4], o[5]); wv.w = cvt_pk_bf16(o[6], o[7]);
                *(u32x4*)(xbcc + (size_t)(m0 + i) * CONV_DIM + c0) = wv;
            }
        }
#pragma unroll
        for (int q = 0; q < 2; ++q) { const int idx = tid + 512 * q, m = u * 64 + (idx >> 4), h = idx & 15;
            const float x = bf2f(projb[(size_t)m * PROJ_BLD + OFF_DT + h]) + dt_bias[h];
            dtb[(size_t)m * SSD_H + h] = fmaxf(x, 0.f) + log1pf(expf(-fabsf(x))); }
    }
}

constexpr int SP = 136;
constexpr int SS_C = 0, SS_B = 34816, SS_BT = 69632, SS_XT = 104448, SS_XW = 113152, SS_HT = 121856, SS_AC = 130560, SS_DT = 131072, SS_END = 131584;
__device__ __forceinline__ void ssd_scan_phase(LAS unsigned char* lds, const bf16_t* xbcc, const float* dtb, const float* a_log, const float* dskip, float* yssd, const int vcu, const int G, const int tid) {
    const int wave = __builtin_amdgcn_readfirstlane(tid >> 6), lane = tid & 63, fr = lane & 15, fq = lane >> 4;
    LAS bf16_t* Cimg = (LAS bf16_t*)(lds + SS_C); LAS bf16_t* Bimg = (LAS bf16_t*)(lds + SS_B); LAS bf16_t* BTimg = (LAS bf16_t*)(lds + SS_BT);
    LAS bf16_t* xT = (LAS bf16_t*)(lds + SS_XT); LAS bf16_t* xwT = (LAS bf16_t*)(lds + SS_XW); LAS bf16_t* hT = (LAS bf16_t*)(lds + SS_HT);
    LAS float* acum = (LAS float*)(lds + SS_AC); LAS float* dtv = (LAS float*)(lds + SS_DT);
    for (int u = vcu; u < BATCH * SSD_H * 2; u += G) {
        const int b = u >> 5, h = (u >> 1) & 15, phalf = u & 1, g = h >> 3;
        const float Ah = -expf(a_log[h]) * 1.4426950408889634f;
        const float dsk = dskip[h];
        f32x4 hs[2] = {(f32x4){0.f, 0.f, 0.f, 0.f}, (f32x4){0.f, 0.f, 0.f, 0.f}};
        for (int i = tid; i < 32 * SP / 2; i += 512) ((LAS unsigned*)hT)[i] = 0u;
        const int row = tid >> 2, part = tid & 3;
        for (int ch = 0; ch < SEQ / 128; ++ch) {
            const int mrow0 = b * SEQ + ch * 128;
            u32x4 xr;
            {
                const bf16_t* src = xbcc + (size_t)(mrow0 + row) * CONV_DIM;
                u32x4 cv[4], bv[4];
#pragma unroll
                for (int j = 0; j < 4; ++j) { cv[j] = *(const u32x4*)(src + 1280 + g * 128 + 32 * part + 8 * j); bv[j] = *(const u32x4*)(src + 1024 + g * 128 + 32 * part + 8 * j); }
                xr = *(const u32x4*)(src + h * 64 + phalf * 32 + 8 * part);
                if (tid < 128) dtv[tid] = dtb[(size_t)(mrow0 + tid) * SSD_H + h];
#pragma unroll
                for (int j = 0; j < 4; ++j) { *(LAS u32x4*)(Cimg + row * SP + 32 * part + 8 * j) = cv[j]; *(LAS u32x4*)(Bimg + row * SP + 32 * part + 8 * j) = bv[j]; }
#pragma unroll
                for (int j = 0; j < 4; ++j) { const unsigned wv[4] = {bv[j].x, bv[j].y, bv[j].z, bv[j].w};
#pragma unroll
                    for (int e = 0; e < 4; ++e) { const int n = 32 * part + 8 * j + 2 * e; BTimg[n * SP + row] = (bf16_t)(wv[e] & 0xffffu); BTimg[(n + 1) * SP + row] = (bf16_t)(wv[e] >> 16); } }
            }
            __syncthreads();
            if (wave == 0) {
                const float v0 = dtv[2 * lane] * Ah, v1 = dtv[2 * lane + 1] * Ah;
                float s = v0 + v1;
#pragma unroll
                for (int o = 1; o < 64; o <<= 1) { const float t = __shfl_up(s, o); if (lane >= o) s += t; }
                acum[2 * lane] = s - v1; acum[2 * lane + 1] = s;
            }
            __syncthreads();
            const float atot = acum[127];
            {
                const float wgt = dtv[row] * __builtin_amdgcn_exp2f(atot - acum[row]);
                const unsigned wv[4] = {xr.x, xr.y, xr.z, xr.w};
#pragma unroll
                for (int e = 0; e < 4; ++e) { const int p = 8 * part + 2 * e; const float x0 = bf_lo(wv[e]), x1 = bf_hi(wv[e]);
                    xT[p * SP + row] = (bf16_t)(wv[e] & 0xffffu); xT[(p + 1) * SP + row] = (bf16_t)(wv[e] >> 16);
                    const unsigned pk = cvt_pk_bf16(x0 * wgt, x1 * wgt); xwT[p * SP + row] = (bf16_t)(pk & 0xffffu); xwT[(p + 1) * SP + row] = (bf16_t)(pk >> 16); }
            }
            f32x4 gacc[8];
#pragma unroll
            for (int st = 0; st < 8; ++st) gacc[st] = (f32x4){0.f, 0.f, 0.f, 0.f};
            {
                bf16x8 cf[4];
#pragma unroll
                for (int ks = 0; ks < 4; ++ks) cf[ks] = *(const LAS bf16x8*)(Cimg + (16 * wave + fr) * SP + 32 * ks + 8 * fq);
#pragma unroll
                for (int st = 0; st < 8; ++st) if (st <= wave) {
#pragma unroll
                    for (int ks = 0; ks < 4; ++ks) { const bf16x8 bfg = *(const LAS bf16x8*)(Bimg + (16 * st + fr) * SP + 32 * ks + 8 * fq);
                        gacc[st] = __builtin_amdgcn_mfma_f32_16x16x32_bf16(bfg, cf[ks], gacc[st], 0, 0, 0); }
                }
            }
            __syncthreads();
            {
                LAS bf16_t* Mimg = Bimg;
                const int l = 16 * wave + fr; const float al = acum[l];
#pragma unroll
                for (int st = 0; st < 8; ++st) if (st <= wave + 1) {
                    u32x2 wv = (u32x2){0u, 0u};
                    if (st <= wave) {
                        const f32x4 as4 = *(const LAS f32x4*)(acum + 16 * st + 4 * fq), dt4 = *(const LAS f32x4*)(dtv + 16 * st + 4 * fq);
                        float mv[4];
#pragma unroll
                        for (int r = 0; r < 4; ++r) { const int s = 16 * st + 4 * fq + r; mv[r] = (s <= l) ? gacc[st][r] * dt4[r] * __builtin_amdgcn_exp2f(al - as4[r]) : 0.f; }
                        wv.x = cvt_pk_bf16(mv[0], mv[1]); wv.y = cvt_pk_bf16(mv[2], mv[3]);
                    }
                    *(LAS u32x2*)(Mimg + l * SP + 16 * st + 4 * fq) = wv;
                }
            }
            __syncthreads();
            {
                const LAS bf16_t* Mimg = Bimg;
                f32x4 yd[2] = {(f32x4){0.f, 0.f, 0.f, 0.f}, (f32x4){0.f, 0.f, 0.f, 0.f}}, yo[2] = {(f32x4){0.f, 0.f, 0.f, 0.f}, (f32x4){0.f, 0.f, 0.f, 0.f}};
#pragma unroll
                for (int ks = 0; ks < 4; ++ks) {
                    const bf16x8 cfr = *(const LAS bf16x8*)(Cimg + (16 * wave + fr) * SP + 32 * ks + 8 * fq);
#pragma unroll
                    for (int pt = 0; pt < 2; ++pt) { const bf16x8 hf = *(const LAS bf16x8*)(hT + (16 * pt + fr) * SP + 32 * ks + 8 * fq);
                        yo[pt] = __builtin_amdgcn_mfma_f32_16x16x32_bf16(hf, cfr, yo[pt], 0, 0, 0); }
                    if (2 * ks <= wave) {
                        const bf16x8 mf = *(const LAS bf16x8*)(Mimg + (16 * wave + fr) * SP + 32 * ks + 8 * fq);
#pragma unroll
                        for (int pt = 0; pt < 2; ++pt) { const bf16x8 xf_ = *(const LAS bf16x8*)(xT + (16 * pt + fr) * SP + 32 * ks + 8 * fq);
                            yd[pt] = __builtin_amdgcn_mfma_f32_16x16x32_bf16(xf_, mf, yd[pt], 0, 0, 0); }
                    }
                }
                const int l = 16 * wave + fr; const float el = __builtin_amdgcn_exp2f(acum[l]);
#pragma unroll
                for (int pt = 0; pt < 2; ++pt) {
                    f32x4 o;
#pragma unroll
                    for (int r = 0; r < 4; ++r) o[r] = yd[pt][r] + el * yo[pt][r] + dsk * bf2f(xT[(16 * pt + 4 * fq + r) * SP + l]);
                    *(f32x4*)(yssd + (size_t)(mrow0 + l) * 1024 + h * 64 + phalf * 32 + 16 * pt + 4 * fq) = o;
                }
            }
            {
                const float ea = __builtin_amdgcn_exp2f(atot);
                hs[0] = hs[0] * ea; hs[1] = hs[1] * ea;
#pragma unroll
                for (int ks = 0; ks < 4; ++ks) {
                    const bf16x8 btf = *(const LAS bf16x8*)(BTimg + (16 * wave + fr) * SP + 32 * ks + 8 * fq);
#pragma unroll
                    for (int pt = 0; pt < 2; ++pt) { const bf16x8 xwf = *(const LAS bf16x8*)(xwT + (16 * pt + fr) * SP + 32 * ks + 8 * fq);
                        hs[pt] = __builtin_amdgcn_mfma_f32_16x16x32_bf16(btf, xwf, hs[pt], 0, 0, 0); }
                }
            }
            __syncthreads();
#pragma unroll
            for (int pt = 0; pt < 2; ++pt) { u32x2 wv; wv.x = cvt_pk_bf16(hs[pt][0], hs[pt][1]); wv.y = cvt_pk_bf16(hs[pt][2], hs[pt][3]);
                *(LAS u32x2*)(hT + (16 * pt + fr) * SP + 16 * wave + 4 * fq) = wv; }
        }
        __syncthreads();
    }
}

__device__ __forceinline__ void ssd_post_phase(const float* yssd, const bf16_t* projb, const float* norm_w, bf16_t* ymixb, const int gw, const int NGW, const int lane) {
    const int c0 = 16 * lane;
    f32x4 nw[4];
#pragma unroll
    for (int j = 0; j < 4; ++j) nw[j] = *(const f32x4*)(norm_w + c0 + 4 * j);
    for (int m = gw; m < M; m += NGW) {
        f32x4 y[4];
#pragma unroll
        for (int j = 0; j < 4; ++j) y[j] = *(const f32x4*)(yssd + (size_t)m * 1024 + c0 + 4 * j);
        const u32x4 z0 = *(const u32x4*)(projb + (size_t)m * PROJ_BLD + OFF_Z + c0), z1 = *(const u32x4*)(projb + (size_t)m * PROJ_BLD + OFF_Z + c0 + 8);
        const unsigned zw[8] = {z0.x, z0.y, z0.z, z0.w, z1.x, z1.y, z1.z, z1.w};
        float uu[16]; float ss = 0.f;
#pragma unroll
        for (int e = 0; e < 8; ++e) { uu[2 * e] = y[e >> 1][(2 * e) & 3] * fast_silu(bf_lo(zw[e])); uu[2 * e + 1] = y[e >> 1][(2 * e + 1) & 3] * fast_silu(bf_hi(zw[e])); ss += uu[2 * e] * uu[2 * e] + uu[2 * e + 1] * uu[2 * e + 1]; }
#pragma unroll
        for (int o = 1; o < 32; o <<= 1) ss += __shfl_xor(ss, o);
        const float rs = rsqrtf(ss * (1.f / 512.f) + 1e-5f);
        u32x4 w0, w1;
        w0.x = cvt_pk_bf16(uu[0] * rs * nw[0][0], uu[1] * rs * nw[0][1]); w0.y = cvt_pk_bf16(uu[2] * rs * nw[0][2], uu[3] * rs * nw[0][3]);
        w0.z = cvt_pk_bf16(uu[4] * rs * nw[1][0], uu[5] * rs * nw[1][1]); w0.w = cvt_pk_bf16(uu[6] * rs * nw[1][2], uu[7] * rs * nw[1][3]);
        w1.x = cvt_pk_bf16(uu[8] * rs * nw[2][0], uu[9] * rs * nw[2][1]); w1.y = cvt_pk_bf16(uu[10] * rs * nw[2][2], uu[11] * rs * nw[2][3]);
        w1.z = cvt_pk_bf16(uu[12] * rs * nw[3][0], uu[13] * rs * nw[3][1]); w1.w = cvt_pk_bf16(uu[14] * rs * nw[3][2], uu[15] * rs * nw[3][3]);
        *(u32x4*)(ymixb + (size_t)m * 2048 + c0) = w0; *(u32x4*)(ymixb + (size_t)m * 2048 + c0 + 8) = w1;
    }
}

#define PH_BEGIN int z_ = 0; asm volatile("" : "+s"(z_)); unsigned char* const wsq = P.ws + z_; int tid = tid0; asm volatile("" : "+v"(tid)); \
    const int G = G0 + z_, bx = bx0 + z_, vcu = vcu0 + z_, lane = tid & 63, wave = __builtin_amdgcn_readfirstlane(tid >> 6), gw = vcu * NWAVES + wave, NGW = G * NWAVES; (void)bx; (void)lane; (void)gw; (void)NGW; (void)wave;
#define INP(i) (P.in[(i) + z_])
#define Win_t ((bf16_t*)(wsq + WS_WIN))
#define Wout_t ((bf16_t*)(wsq + WS_WOUT))
#define Wffn ((bf16_t*)(wsq + WS_WFFN))
#define Wl_w ((bf16_t*)(wsq + WS_WLORA))
#define Wl_a (Wl_w + 1024 * 64)
#define Wl_g (Wl_a + 1024 * 64)
#define Wl_v (Wl_g + 1024 * 160)
#define xf ((float*)(wsq + WS_XF))
#define xb ((bf16_t*)(wsq + WS_XB))
#define projb ((bf16_t*)(wsq + WS_PROJB))
#define ymixb ((bf16_t*)(wsq + WS_YMIXB))
#define mixed ((float*)(wsq + WS_MIXED))
#define hbuf ((bf16_t*)(wsq + WS_HBUF))
#define xg ((bf16_t*)(wsq + WS_XG))
#define yslot ((float*)(wsq + WS_YSLOT))
#define xbcc ((bf16_t*)(wsq + WS_XBCC))
#define dtb ((float*)(wsq + WS_DTB))
#define yssd ((float*)(wsq + WS_YSSD))
#define lw ((bf16_t*)(wsq + WS_LW))
#define yrw ((float*)(wsq + WS_YRW))
#define bon ((float*)(wsq + WS_BON))
#define vfirst ((float*)(wsq + WS_VFIRST))
#define tok_e ((int*)(wsq + WS_TOK))
#define tok_pos (tok_e + 2 * M)
#define tok_g ((float*)(tok_pos + 2 * M))
#define tok_dest ((int*)(tok_g + 2 * M))
#define cnt ((int*)(wsq + WS_CTL) + CW_CNT + 8 * li)
__global__ void __launch_bounds__(NWAVES * 64, 2) fwd(Params P) {
    extern __shared__ __attribute__((aligned(16))) unsigned char lds_raw[];
    LAS unsigned char* lds = (LAS unsigned char*)lds_raw;
    volatile LAS unsigned* MISC = (volatile LAS unsigned*)(lds + MISC_OFF);
    const int tid0 = threadIdx.x;
    const int G0 = gridDim.x, bx0 = blockIdx.x;
    const int vcu0 = (G0 % 8 == 0) ? (bx0 % 8) * (G0 / 8) + bx0 / 8 : bx0;
    unsigned* ctl = (unsigned*)(P.ws + WS_CTL);
    if (tid0 < 64) MISC[tid0] = 0u;
    __syncthreads();
#if MK_LAUNCH_MODE == 1
    constexpr int lo = 0, hi = 64;
#else
    const int lo = P.ph_lo, hi = P.ph_hi;
#endif
    XcdBarrier bar; bar.bar = ctl + CW_BAR + P.bar_idx * XCD_BAR_WORDS; bar.x = 0; bar.st = MISC + 8;
    if (hi - lo > 1) bar = xcd_barrier_post(ctl + CW_BAR + P.bar_idx * XCD_BAR_WORDS, MISC + 8);
#define IN(k) (lo <= (k) && (k) < hi)
#define SEAM(k) do { if ((k) + 1 < hi) xcd_barrier(bar); } while (0)

    for (int l = 0; l < 4; ++l) {
        const int pb = l * 16, li = l >> 1; const bool moe = (l & 1) != 0;
        if (IN(pb + 0)) {
            PH_BEGIN
            LAS float* scr = (LAS float*)(lds + wave * 16384);
            cvt_job<0>(INP(1) + (size_t)l * D * IN_DIM, D, IN_DIM, Win_t, 0, 0, scr, gw, NGW, lane);
            if (l > 0) cvt_job<0>(INP(2) + (size_t)(l - 1) * D * 32, D, 32, Win_t, IN_DIM, 0, scr, gw, NGW, lane);
            { const int r0 = l > 0 ? IN_DIM + 32 : IN_DIM, nz = (PROJ_BLD - r0) * (D / 8);
              for (int i = bx * 512 + tid; i < nz; i += G * 512) *(u32x4*)(Win_t + (size_t)r0 * D + (size_t)i * 8) = (u32x4){0u, 0u, 0u, 0u}; }
            cvt_job<0>(INP(23) + (size_t)l * D * D, D, D, Wout_t, 0, 0, scr, gw, NGW, lane);
            cvt_job<0>(INP(12) + (size_t)l * 64 * 1024, 64, 1024, Wl_w, 0, 0, scr, gw, NGW, lane);
            cvt_job<0>(INP(14) + (size_t)l * 64 * 1024, 64, 1024, Wl_a, 0, 0, scr, gw, NGW, lane);
            cvt_job<0>(INP(17) + (size_t)l * 160 * 1024, 160, 1024, Wl_g, 0, 0, scr, gw, NGW, lane);
            if (l > 0) cvt_job<0>(INP(16) + (size_t)(l - 1) * 32 * 1024, 32, 1024, Wl_v, 0, 0, scr, gw, NGW, lane);
            if (l == 0) {
                const float* x = INP(0);
                for (size_t i = (size_t)bx * 512 + tid; i < (size_t)M * D / 8; i += (size_t)G * 512) {
                    const f32x4 a = *(const f32x4*)(x + i * 8), b = *(const f32x4*)(x + i * 8 + 4);
                    u32x4 w; w.x = cvt_pk_bf16(a[0], a[1]); w.y = cvt_pk_bf16(a[2], a[3]); w.z = cvt_pk_bf16(b[0], b[1]); w.w = cvt_pk_bf16(b[2], b[3]);
                    *(u32x4*)(xb + i * 8) = w; }
            }
            __syncthreads();
            SEAM(pb + 0);
        }
        if (IN(pb + 1)) {
            PH_BEGIN
            pg8::Gemm g{xb, Win_t, D}; pg8::StaticOrder S; S.init(M, PROJ_BLD, G, bx);
            pg8::EpiBf16 E{projb, PROJ_BLD};
            pg8::gemm_phase<pg8::EpiBf16, pg8::StaticOrder>(lds, g, S, E, tid);
#if (MK_DBL >> 1) & 1
            pg8::gemm_phase<pg8::EpiBf16, pg8::StaticOrder>(lds, g, S, E, tid);
#endif
            SEAM(pb + 1);
        }
        if (IN(pb + 2)) {
            PH_BEGIN
            lora_phase(lds, projb, INP(9) + (size_t)l * RW_SHIFT, INP(10) + (size_t)(l > 0 ? l - 1 : 0) * 32, Wl_w, Wl_a, Wl_g, Wl_v, lw, l > 0, vcu, G, tid);
#if (MK_DBL >> 2) & 1
            lora_phase(lds, projb, INP(9) + (size_t)l * RW_SHIFT, INP(10) + (size_t)(l > 0 ? l - 1 : 0) * 32, Wl_w, Wl_a, Wl_g, Wl_v, lw, l > 0, vcu, G, tid);
#endif
            ssd_conv_phase(projb, INP(3) + (size_t)l * 4 * CONV_DIM, INP(4) + (size_t)l * CONV_DIM, INP(5) + l * SSD_H, xbcc, dtb, vcu, G, tid);
#if (MK_DBL >> 11) & 1
            ssd_conv_phase(projb, INP(3) + (size_t)l * 4 * CONV_DIM, INP(4) + (size_t)l * CONV_DIM, INP(5) + l * SSD_H, xbcc, dtb, vcu, G, tid);
#endif
            SEAM(pb + 2);
        }
        if (IN(pb + 3)) {
            PH_BEGIN
            RwScan a; a.proj_ = projb; a.lw_ = lw; a.mix = INP(9) + (size_t)l * RW_SHIFT; a.w0 = INP(11) + l * 1024; a.a0 = INP(13) + l * 1024; a.v0 = INP(15) + (l > 0 ? l - 1 : 0) * 1024;
            a.k_k = INP(18) + l * 1024; a.k_a = INP(19) + l * 1024; a.r_k = INP(20) + l * 1024; a.vf_ = vfirst; a.y_ = yrw; a.bon_ = bon; a.layer = l; a.pad = 0;
            rwkv_scan_phase(lds, a, vcu, G, tid);
#if (MK_DBL >> 3) & 1
            rwkv_scan_phase(lds, a, vcu, G, tid);
#endif
            ssd_scan_phase(lds, xbcc, dtb, INP(6) + l * SSD_H, INP(7) + l * SSD_H, yssd, vcu, G, tid);
#if (MK_DBL >> 10) & 1
            ssd_scan_phase(lds, xbcc, dtb, INP(6) + l * SSD_H, INP(7) + l * SSD_H, yssd, vcu, G, tid);
#endif
            SEAM(pb + 3);
        }
        if (IN(pb + 4)) {
            PH_BEGIN
            rwkv_post_phase(yrw, bon, lw + (size_t)2 * M * 1024, INP(21) + l * 1024, INP(22) + l * 1024, ymixb, gw, NGW, lane);
#if (MK_DBL >> 4) & 1
            rwkv_post_phase(yrw, bon, lw + (size_t)2 * M * 1024, INP(21) + l * 1024, INP(22) + l * 1024, ymixb, gw, NGW, lane);
#endif
            ssd_post_phase(yssd, projb, INP(8) + l * 1024, ymixb, gw, NGW, lane);
#if (MK_DBL >> 4) & 1
            ssd_post_phase(yssd, projb, INP(8) + l * 1024, ymixb, gw, NGW, lane);
#endif
            SEAM(pb + 4);
        }
        if (IN(pb + 5)) {
            PH_BEGIN
            pg8::Gemm g{ymixb, Wout_t, D}; pg8::StaticOrder S; S.init(M, D, G, bx);
            pg8::EpiF32 E{mixed, FLD};
            pg8::gemm_phase<pg8::EpiF32, pg8::StaticOrder>(lds, g, S, E, tid);
#if (MK_DBL >> 5) & 1
            pg8::gemm_phase<pg8::EpiF32, pg8::StaticOrder>(lds, g, S, E, tid);
#endif
            SEAM(pb + 5);
        }
        if (IN(pb + 6)) {
            PH_BEGIN
            const float* xin = (l == 0) ? INP(0) : xf;
            const float* gam = INP(24) + l * D; const float* bet = INP(25) + l * D;
            LAS float* rs = (LAS float*)lds;
            if (moe) { const float* router = INP(31) + (size_t)li * D * NE;
                for (int i = tid; i < D * NE; i += 512) rs[(i & 7) * D + (i >> 3)] = router[i];
                __syncthreads(); }
            for (int m = gw; m < M; m += NGW) {
                f32x4 v[8];
#pragma unroll
                for (int j = 0; j < 8; ++j) { const size_t o = (size_t)m * D + 4 * lane + 256 * j; v[j] = ALPHA * *(const f32x4*)(xin + o) + *(const f32x4*)(mixed + (size_t)m * FLD + 4 * lane + 256 * j); }
                ln_finish(v, gam, bet, lane, xf + (size_t)m * D, xb + (size_t)m * D);
                if (moe) {
                    float lg[8];
#pragma unroll
                    for (int e = 0; e < 8; ++e) { float s = 0.f;
#pragma unroll
                        for (int j = 0; j < 8; ++j) { const f32x4 r = *(const LAS f32x4*)(rs + e * D + 4 * lane + 256 * j); s += (v[j][0] * r[0] + v[j][1] * r[1]) + (v[j][2] * r[2] + v[j][3] * r[3]); }
                        lg[e] = wave_sum_f(s); }
                    if (lane == 0) {
                        int i0 = 0; float v0 = lg[0];
#pragma unroll
                        for (int e = 1; e < 8; ++e) if (lg[e] > v0) { v0 = lg[e]; i0 = e; }
                        int i1 = -1; float v1 = -3.4e38f;
#pragma unroll
                        for (int e = 0; e < 8; ++e) if (e != i0 && lg[e] > v1) { v1 = lg[e]; i1 = e; }
                        const float e1 = expf(v1 - v0);
                        tok_e[2 * m] = i0; tok_e[2 * m + 1] = i1; tok_g[2 * m] = 1.f / (1.f + e1); tok_g[2 * m + 1] = e1 / (1.f + e1);
                        tok_pos[2 * m] = atomicAdd(&cnt[i0], 1); tok_pos[2 * m + 1] = atomicAdd(&cnt[i1], 1);
                    }
                }
            }
            __syncthreads();
            SEAM(pb + 6);
        }
        if (IN(pb + 7)) {
            PH_BEGIN
            LAS float* scr = (LAS float*)(lds + wave * 16384);
            if (!moe) {
                cvt_job<1>(INP(28) + (size_t)li * D * DFF, D, DFF, Wffn, 0, 0, scr, gw, NGW, lane);
                cvt_job<1>(INP(29) + (size_t)li * D * DFF, D, DFF, Wffn, 0, 1, scr, gw, NGW, lane);
                cvt_job<0>(INP(30) + (size_t)li * DFF * D, DFF, D, Wffn + (size_t)2 * DFF * D, 0, 0, scr, gw, NGW, lane);
            } else {
                for (int e = 0; e < NE; ++e) {
                    cvt_job<1>(INP(32) + ((size_t)li * NE + e) * D * DFE, D, DFE, Wffn, e * 2 * DFE, 0, scr, gw, NGW, lane);
                    cvt_job<1>(INP(33) + ((size_t)li * NE + e) * D * DFE, D, DFE, Wffn, e * 2 * DFE, 1, scr, gw, NGW, lane);
                    cvt_job<0>(INP(34) + ((size_t)li * NE + e) * DFE * D, DFE, D, Wffn + (size_t)NE * 2 * DFE * D, e * D, 0, scr, gw, NGW, lane);
                }
                int start[8]; { int acc = 0;
#pragma unroll
                    for (int e = 0; e < 8; ++e) { start[e] = acc; acc += ((cnt[e] + 255) >> 8) << 8; } }
                for (int m = gw; m < M; m += NGW) {
                    u32x4 r[4];
#pragma unroll
                    for (int j = 0; j < 4; ++j) r[j] = *(const u32x4*)(xb + (size_t)m * D + 8 * lane + 512 * j);
#pragma unroll
                    for (int s = 0; s < 2; ++s) {
                        const int e = tok_e[2 * m + s], pos = tok_pos[2 * m + s];
                        int st = 0;
#pragma unroll
                        for (int q = 0; q < 8; ++q) st = (e == q) ? start[q] : st;
                        const int dest = st + pos;
#pragma unroll
                        for (int j = 0; j < 4; ++j) *(u32x4*)(xg + (size_t)dest * D + 8 * lane + 512 * j) = r[j];
                        if (lane == 0) tok_dest[2 * m + s] = dest;
                    }
                }
            }
            __syncthreads();
            SEAM(pb + 7);
        }
        if (IN(pb + 8)) {
            PH_BEGIN
            if (!moe) {
                pg8::Gemm g{xb, Wffn, D}; pg8::StaticOrder S; S.init(M, 2 * DFF, G, bx);
                pg8::EpiSwiglu E{hbuf, DFF};
                pg8::gemm_phase<pg8::EpiSwiglu, pg8::StaticOrder>(lds, g, S, E, tid);
#if (MK_DBL >> 8) & 1
                pg8::gemm_phase<pg8::EpiSwiglu, pg8::StaticOrder>(lds, g, S, E, tid);
#endif
            } else {
                pg8::Gemm g{xg, Wffn, D}; pg8::GroupedOrder S; S.init(cnt, 2 * DFE, G, bx);
                pg8::EpiSwiglu E{hbuf, DFE};
                pg8::gemm_phase<pg8::EpiSwiglu, pg8::GroupedOrder>(lds, g, S, E, tid);
#if (MK_DBL >> 8) & 1
                pg8::gemm_phase<pg8::EpiSwiglu, pg8::GroupedOrder>(lds, g, S, E, tid);
#endif
            }
            SEAM(pb + 8);
        }
        if (IN(pb + 9)) {
            PH_BEGIN
            if (!moe) {
                pg8::Gemm g{hbuf, Wffn + (size_t)2 * DFF * D, DFF}; pg8::StaticOrder S; S.init(M, D, G, bx);
                pg8::EpiF32 E{yslot, FLD};
                pg8::gemm_phase<pg8::EpiF32, pg8::StaticOrder>(lds, g, S, E, tid);
#if (MK_DBL >> 9) & 1
                pg8::gemm_phase<pg8::EpiF32, pg8::StaticOrder>(lds, g, S, E, tid);
#endif
#if (MK_DBL >> 5) & 1
            pg8::gemm_phase<pg8::EpiF32, pg8::StaticOrder>(lds, g, S, E, tid);
#endif
            } else {
                pg8::Gemm g{hbuf, Wffn + (size_t)NE * 2 * DFE * D, DFE}; pg8::GroupedOrder S; S.init(cnt, D, G, bx);
                pg8::EpiF32 E{yslot, FLD};
                pg8::gemm_phase<pg8::EpiF32, pg8::GroupedOrder>(lds, g, S, E, tid);
#if (MK_DBL >> 9) & 1
                pg8::gemm_phase<pg8::EpiF32, pg8::GroupedOrder>(lds, g, S, E, tid);
#endif
            }
            SEAM(pb + 9);
        }
        if (IN(pb + 10)) {
            PH_BEGIN
            const float* gam = INP(26) + l * D; const float* bet = INP(27) + l * D;
            float* dst = (l == 3) ? P.out : xf;
            for (int m = gw; m < M; m += NGW) {
                f32x4 v[8];
                if (!moe) {
#pragma unroll
                    for (int j = 0; j < 8; ++j) { const size_t o = (size_t)m * D + 4 * lane + 256 * j; v[j] = ALPHA * *(const f32x4*)(xf + o) + *(const f32x4*)(yslot + (size_t)m * FLD + 4 * lane + 256 * j); }
                } else {
                    const int d0 = tok_dest[2 * m], d1 = tok_dest[2 * m + 1]; const float g0 = tok_g[2 * m], g1 = tok_g[2 * m + 1];
#pragma unroll
                    for (int j = 0; j < 8; ++j) { const int c = 4 * lane + 256 * j;
                        v[j] = ALPHA * *(const f32x4*)(xf + (size_t)m * D + c) + g0 * *(const f32x4*)(yslot + (size_t)d0 * FLD + c) + g1 * *(const f32x4*)(yslot + (size_t)d1 * FLD + c); }
                }
                ln_finish(v, gam, bet, lane, dst + (size_t)m * D, (l == 3) ? (bf16_t*)nullptr : xb + (size_t)m * D);
            }
            SEAM(pb + 10);
        }
    }
#undef IN
#undef SEAM
}
#undef PH_BEGIN
#undef INP
#undef Win_t
#undef Wout_t
#undef Wffn
#undef Wl_w
#undef Wl_a
#undef Wl_g
#undef Wl_v
#undef xf
#undef xb
#undef projb
#undef ymixb
#undef mixed
#undef hbuf
#undef xg
#undef yslot
#undef xbcc
#undef dtb
#undef yssd
#undef lw
#undef yrw
#undef bon
#undef vfirst
#undef tok_e
#undef tok_pos
#undef tok_g
#undef tok_dest
#undef cnt


}

extern "C" void kernel_launch(void* const* d_in, const int* in_sizes, int n_in, void* d_out, int out_size, void* d_ws, size_t ws_size, hipStream_t stream) {
    (void)in_sizes; (void)out_size;
    static int grid = 0;
    if (grid == 0) {
        if (n_in != 35 || ws_size < WS_END) { fprintf(stderr, "kernel_launch: need 35 inputs and %zu bytes of workspace (got %d, %zu)\n", (size_t)WS_END, n_in, ws_size); grid = -1; return; }
        int dev = 0, cus = 0;
        if (hipGetDevice(&dev) != hipSuccess || hipDeviceGetAttribute(&cus, hipDeviceAttributeMultiprocessorCount, dev) != hipSuccess) { grid = -1; return; }
        if (hipFuncSetAttribute((const void*)fwd, hipFuncAttributeMaxDynamicSharedMemorySize, LDS_BYTES) != hipSuccess) { fprintf(stderr, "kernel_launch: hipFuncSetAttribute failed\n"); grid = -1; return; }
        int per_cu = 0;
        if (hipOccupancyMaxActiveBlocksPerMultiprocessor(&per_cu, (const void*)fwd, NWAVES * 64, LDS_BYTES) != hipSuccess || per_cu < 1) { fprintf(stderr, "kernel_launch: occupancy query says %d blocks per CU\n", per_cu); }
        (void)hipGetLastError();
        grid = cus;
    }
    if (grid < 0) return;
    unsigned char* ws = (unsigned char*)d_ws;
    (void)hipMemsetAsync(ws + WS_CTL, 0, CTL_BYTES, stream);
    Params P{};
    for (int i = 0; i < 35; ++i) P.in[i] = (const float*)d_in[i];
    P.out = (float*)d_out; P.ws = ws; P.pad = 0;
    int nbar = 0;
    auto run = [&](int lo, int hi) {
        P.ph_lo = lo; P.ph_hi = hi; P.bar_idx = (hi - lo > 1) ? nbar++ : 0;
        hipLaunchKernelGGL(fwd, dim3(grid), dim3(NWAVES * 64), LDS_BYTES, stream, P);
    };
    if (MK_LAUNCH_MODE == 1) run(0, 64);
    else if (MK_LAUNCH_MODE == 4) { for (int l = 0; l < 4; ++l) run(l * 16, l * 16 + 16); }
    else { for (int l = 0; l < 4; ++l) for (int k = 0; k <= 10; ++k) run(l * 16 + k, l * 16 + k + 1); }
}
```

```cpp
#define MK_DBL 0
#include <hip/hip_runtime.h>
#include <cstdint>
#include <cstdio>

#ifndef MK_DBL
#define MK_DBL 0
#endif
#ifndef MK_LAUNCH_MODE
#define MK_LAUNCH_MODE 1
#endif
namespace {
constexpr int BATCH = 8, SEQ = 2048, M = BATCH * SEQ, D = 2048;
constexpr int HD = 64, SSD_H = 16, SSD_N = 128, CONV_DIM = 1536;
constexpr int RW_H = 16;
constexpr int IN_DIM = 5936, PROJ_LD = 5968;
constexpr int OFF_Z = 0, OFF_XBC = 1024, OFF_DT = 2560, OFF_RW = 2576, OFF_R = 2576, OFF_K = 3600, OFF_V = 4624, OFF_WLO = 5648, OFF_ALO = 5712, OFF_GLO = 5776, OFF_VLO = 5936;
constexpr int RW_SHIFT = 3360;
constexpr int DFF = 5632, NE = 8, DFE = 2816;
constexpr float ALPHA = 1.681792830507429f;
constexpr int LORA_LD = 320;

__device__ __forceinline__ float sigmoidf_(float x) { return 1.f / (1.f + expf(-x)); }
__device__ __forceinline__ float siluf_(float x) { return x / (1.f + expf(-x)); }
__device__ __forceinline__ float softplusf_(float x) { return fmaxf(x, 0.f) + log1pf(expf(-fabsf(x))); }
__device__ __forceinline__ float wave_sum(float v) {
#pragma unroll
    for (int o = 32; o >= 1; o >>= 1) v += __shfl_xor(v, o);
    return v;
}


#define LAS __attribute__((address_space(3)))
typedef unsigned short bf16_t;
typedef short bf16x8 __attribute__((ext_vector_type(8)));
typedef float f32x4 __attribute__((ext_vector_type(4)));
typedef float f32x2 __attribute__((ext_vector_type(2)));
typedef unsigned u32x4 __attribute__((ext_vector_type(4)));
typedef unsigned u32x2 __attribute__((ext_vector_type(2)));

__device__ __forceinline__ unsigned cvt_pk_bf16(float lo, float hi) { unsigned r; asm volatile("v_cvt_pk_bf16_f32 %0, %1, %2" : "=v"(r) : "v"(lo), "v"(hi)); return r; }
__device__ __forceinline__ float bf_lo(unsigned w) { return __uint_as_float(w << 16); }
__device__ __forceinline__ float bf_hi(unsigned w) { return __uint_as_float(w & 0xffff0000u); }
__device__ __forceinline__ float bf2f(bf16_t b) { return __uint_as_float(((unsigned)b) << 16); }
__device__ __forceinline__ float fast_silu(float x) { return x * __builtin_amdgcn_rcpf(1.f + __builtin_amdgcn_exp2f(-1.4426950408889634f * x)); }

namespace pg8 {
constexpr int BM = 256, BK = 64, HALF = 128, HTB = HALF * BK * 2, STAGE_BYTES = 8 * HTB, NXCD = 8, WGM = 8;
__host__ __device__ __forceinline__ int lds_byte(int r, int c) { const int st = (r >> 4) * 2 + (c >> 5), rr = r & 15, cc = c & 31, ob = rr * 64 + cc * 2; return st * 1024 + (ob ^ (((ob >> 9) & 1) << 5)); }
__host__ __device__ __forceinline__ void stage_rc(int b, int& R, int& C) { const int st = b / 1024, sb = b % 1024, swz = sb ^ (((sb >> 9) & 1) << 5); R = (st >> 1) * 16 + swz / 64; C = (st & 1) * 32 + (swz % 64) / 2; }
__host__ __device__ __forceinline__ int perm32(int rho) { const int n = rho >> 4, i = rho & 15; return 8 * (i >> 2) + 4 * n + (i & 3); }

struct Unit { int pm, pn, pb; };
struct Gemm { const bf16_t* A; const bf16_t* Bt; int K; };

__device__ __forceinline__ void decode_unit(int wgid, int nM, int nN, int& pm, int& pn) {
    const int nwg = nM * nN;
    { const int q = nwg / NXCD, r = nwg % NXCD, xcd = wgid % NXCD, off = wgid / NXCD; wgid = (xcd < r ? xcd * (q + 1) : r * (q + 1) + (xcd - r) * q) + off; }
    const int nig = WGM * nN, gid = wgid / nig, fm = gid * WGM, gsz = (nM - fm) < WGM ? (nM - fm) : WGM;
    pm = fm + ((wgid % nig) % gsz); pn = (wgid % nig) / gsz;
}
struct StaticOrder {
    int nM, nN, nwg, G, c;
    __device__ void init(int Mrows, int N, int G_, int c_) { nM = Mrows / BM; nN = N / BM; nwg = nM * nN; G = G_; c = c_; }
    __device__ __forceinline__ bool next(int i, Unit& u) const {
        const long L = (long)i * G + c; if (L >= nwg) return false;
        decode_unit((int)L, nM, nN, u.pm, u.pn); u.pb = u.pn; return true;
    }
};
struct GroupedOrder {
    int nM, nN, nwg, G, c; int cum[9];
    __device__ void init(const int* cnt, int N, int G_, int c_) {
        int acc = 0;
#pragma unroll
        for (int e = 0; e < 8; ++e) { cum[e] = acc; acc += (cnt[e] + 255) >> 8; }
        cum[8] = acc; nM = acc; nN = N / BM; nwg = nM * nN; G = G_; c = c_;
    }
    __device__ __forceinline__ bool next(int i, Unit& u) const {
        const long L = (long)i * G + c; if (L >= nwg) return false;
        decode_unit((int)L, nM, nN, u.pm, u.pn);
        int e = 0;
#pragma unroll
        for (int q = 1; q < 8; ++q) e += (u.pm >= cum[q]) ? 1 : 0;
        u.pb = e * nN + u.pn; return true;
    }
};

struct EpiF32 {
    static constexpr bool PERM = false;
    float* C; int ldc;
    __device__ __forceinline__ void operator()(const f32x4 (&acc)[2][2][4][2], const Unit& u, int wr, int wc, int fr, int fq) const {
        const int row0 = u.pm * BM + wr * 64 + fr, col0 = u.pn * BM + wc * 32 + 4 * fq;
#pragma unroll
        for (int ai = 0; ai < 2; ++ai)
#pragma unroll
            for (int m = 0; m < 4; ++m) { float* rowp = C + (size_t)(row0 + ai * HALF + m * 16) * ldc + col0;
#pragma unroll
                for (int bj = 0; bj < 2; ++bj)
#pragma unroll
                    for (int n = 0; n < 2; ++n) *(f32x4*)(rowp + bj * HALF + n * 16) = acc[ai][bj][m][n]; }
    }
};
struct EpiBf16 {
    static constexpr bool PERM = true;
    bf16_t* O; int ldc;
    __device__ __forceinline__ void operator()(const f32x4 (&acc)[2][2][4][2], const Unit& u, int wr, int wc, int fr, int fq) const {
        const int row0 = u.pm * BM + wr * 64 + fr, col0 = u.pn * BM + wc * 32 + 8 * fq;
#pragma unroll
        for (int ai = 0; ai < 2; ++ai)
#pragma unroll
            for (int m = 0; m < 4; ++m) { bf16_t* rowp = O + (size_t)(row0 + ai * HALF + m * 16) * ldc + col0;
#pragma unroll
                for (int bj = 0; bj < 2; ++bj) { const f32x4 v0 = acc[ai][bj][m][0], v1 = acc[ai][bj][m][1];
                    u32x4 w; w.x = cvt_pk_bf16(v0[0], v0[1]); w.y = cvt_pk_bf16(v0[2], v0[3]); w.z = cvt_pk_bf16(v1[0], v1[1]); w.w = cvt_pk_bf16(v1[2], v1[3]);
                    *(u32x4*)(rowp + bj * HALF) = w; } }
    }
};
struct EpiSwiglu {
    static constexpr bool PERM = true;
    bf16_t* O; int ldc;
    __device__ __forceinline__ void operator()(const f32x4 (&acc)[2][2][4][2], const Unit& u, int wr, int wc, int fr, int fq) const {
        const int row0 = u.pm * BM + wr * 64 + fr, col0 = u.pn * HALF + wc * 32 + 8 * fq;
#pragma unroll
        for (int ai = 0; ai < 2; ++ai)
#pragma unroll
            for (int m = 0; m < 4; ++m) { bf16_t* rowp = O + (size_t)(row0 + ai * HALF + m * 16) * ldc + col0;
                float o[8];
#pragma unroll
                for (int n = 0; n < 2; ++n)
#pragma unroll
                    for (int i = 0; i < 4; ++i) o[n * 4 + i] = fast_silu(acc[ai][0][m][n][i]) * acc[ai][1][m][n][i];
                u32x4 w; w.x = cvt_pk_bf16(o[0], o[1]); w.y = cvt_pk_bf16(o[2], o[3]); w.z = cvt_pk_bf16(o[4], o[5]); w.w = cvt_pk_bf16(o[6], o[7]);
                *(u32x4*)rowp = w; }
    }
};

template <class Epi, class Sched>
__device__ __forceinline__ void gemm_phase(LAS unsigned char* lds, const Gemm g, const Sched& S, const Epi& E, const int tid) {
    const int wid = __builtin_amdgcn_readfirstlane(tid >> 6), lane = tid & 63, wr = wid >> 2, wc = wid & 3, fr = lane & 15, fq = lane >> 4;
    const int K = g.K, nt = K / BK;
    unsigned voffA[2], voffB[2];
#pragma unroll
    for (int i = 0; i < 2; ++i) { int R, C; stage_rc(tid * 16 + i * 8192, R, C); const int Rb = Epi::PERM ? ((R & ~31) + perm32(R & 31)) : R;
        voffA[i] = (unsigned)(R * K + C) * 2u; voffB[i] = (unsigned)(Rb * K + C) * 2u; }
    const size_t kstep = (size_t)(BK * 2);
    const size_t hstep = (size_t)HALF * K * 2;
    const size_t tstep = 2 * hstep;
    const unsigned ldsw = (unsigned)wid * 1024u;
    const int aoff = lds_byte(wr * 64 + fr, fq * 8), boff = lds_byte(wc * 32 + fr, fq * 8);
#define PG8_SA(b, h) (((b) * 2 + (h)) * HTB)
#define PG8_SB(b, h) ((4 + (b) * 2 + (h)) * HTB)
#define PG8_STAGE(bufoff, gbase, voff) do { _Pragma("unroll") for (int _i = 0; _i < 2; ++_i) \
        __builtin_amdgcn_global_load_lds((const unsigned*)((const char*)(gbase) + (voff)[_i]), (LAS unsigned*)(lds + (bufoff) + ldsw + _i * 8192), 16, 0, 0); } while (0)
#define PG8_LDA(dst, b, h) do { _Pragma("unroll") for (int m = 0; m < 4; ++m) _Pragma("unroll") for (int k = 0; k < 2; ++k) dst[m][k] = *(const LAS bf16x8*)(lds + PG8_SA(b, h) + aoff + m * 2048 + k * 1024); } while (0)
#define PG8_LDB(dst, b, h) do { _Pragma("unroll") for (int n = 0; n < 2; ++n) _Pragma("unroll") for (int k = 0; k < 2; ++k) dst[n][k] = *(const LAS bf16x8*)(lds + PG8_SB(b, h) + boff + n * 2048 + k * 1024); } while (0)
#define PG8_MMA(ai, bj, At, Bt) do { __builtin_amdgcn_s_setprio(1); _Pragma("unroll") for (int m = 0; m < 4; ++m) _Pragma("unroll") for (int n = 0; n < 2; ++n) _Pragma("unroll") for (int k = 0; k < 2; ++k) \
        acc[ai][bj][m][n] = __builtin_amdgcn_mfma_f32_16x16x32_bf16(Bt[n][k], At[m][k], acc[ai][bj][m][n], 0, 0, 0); __builtin_amdgcn_s_setprio(0); } while (0)
#define PG8_WAIT_V(n) asm volatile("s_waitcnt vmcnt(" #n ")" ::: "memory")
#define PG8_WAIT_L(n) asm volatile("s_waitcnt lgkmcnt(" #n ")" ::: "memory")
#define PG8_BAR __builtin_amdgcn_s_barrier()
#define PG8_SCHED __builtin_amdgcn_sched_barrier(0)
    Unit cur, nxt; int ui = 0;
    if (!S.next(0, cur)) return;
    f32x4 acc[2][2][4][2];
#pragma unroll
    for (int a = 0; a < 2; ++a)
#pragma unroll
        for (int b = 0; b < 2; ++b)
#pragma unroll
            for (int m = 0; m < 4; ++m)
#pragma unroll
                for (int n = 0; n < 2; ++n) acc[a][b][m][n] = (f32x4){0.f, 0.f, 0.f, 0.f};
    bf16x8 At[4][2], B0[2][2], B1[2][2];
    const char* cA = (const char*)g.A + (size_t)cur.pm * tstep; const char* cB = (const char*)g.Bt + (size_t)cur.pb * tstep;
    PG8_STAGE(PG8_SB(0, 0), cB, voffB); PG8_STAGE(PG8_SB(0, 1), cB + hstep, voffB); PG8_STAGE(PG8_SA(0, 0), cA, voffA); PG8_STAGE(PG8_SA(0, 1), cA + hstep, voffA);
    if (wr == 1) PG8_BAR;
    PG8_WAIT_V(2); PG8_BAR;
    PG8_STAGE(PG8_SB(1, 0), cB + kstep, voffB); PG8_STAGE(PG8_SA(1, 0), cA + kstep, voffA); PG8_STAGE(PG8_SB(1, 1), cB + hstep + kstep, voffB);
    PG8_WAIT_V(6); PG8_BAR;
    for (;;) {
        const bool has_next = S.next(ui + 1, nxt);
        const char* nA = has_next ? (const char*)g.A + (size_t)nxt.pm * tstep : cA; const char* nB = has_next ? (const char*)g.Bt + (size_t)nxt.pb * tstep : cB;
        for (int t = 0; t < nt; t += 2) {
            const bool last = (t == nt - 2);
            const char* a1 = cA + (size_t)(t + 1) * kstep;
            const char* a2 = last ? nA : cA + (size_t)(t + 2) * kstep; const char* b2 = last ? nB : cB + (size_t)(t + 2) * kstep;
            const char* a3 = a2 + kstep; const char* b3 = b2 + kstep;
            PG8_LDB(B0, 0, 0); PG8_LDB(B1, 0, 1); PG8_SCHED; PG8_LDA(At, 0, 0); PG8_STAGE(PG8_SA(1, 1), a1 + hstep, voffA);
            PG8_WAIT_V(8); PG8_WAIT_L(0); PG8_BAR; PG8_MMA(0, 0, At, B0); PG8_MMA(0, 1, At, B1); PG8_BAR; PG8_SCHED;
            PG8_LDA(At, 0, 1); PG8_STAGE(PG8_SB(0, 0), b2, voffB); PG8_STAGE(PG8_SB(0, 1), b2 + hstep, voffB); PG8_STAGE(PG8_SA(0, 0), a2, voffA);
            PG8_WAIT_V(8); PG8_WAIT_L(0); PG8_BAR; PG8_MMA(1, 0, At, B0); PG8_MMA(1, 1, At, B1); PG8_BAR; PG8_SCHED;
            PG8_LDB(B0, 1, 0); PG8_LDB(B1, 1, 1); PG8_SCHED; PG8_LDA(At, 1, 0); PG8_STAGE(PG8_SA(0, 1), a2 + hstep, voffA);
            PG8_WAIT_V(8); PG8_WAIT_L(0); PG8_BAR; PG8_MMA(0, 0, At, B0); PG8_MMA(0, 1, At, B1); PG8_BAR; PG8_SCHED;
            PG8_LDA(At, 1, 1); PG8_STAGE(PG8_SB(1, 0), b3, voffB); PG8_STAGE(PG8_SB(1, 1), b3 + hstep, voffB); PG8_STAGE(PG8_SA(1, 0), a3, voffA);
            PG8_WAIT_V(8); PG8_WAIT_L(0); PG8_BAR; PG8_MMA(1, 0, At, B0); PG8_MMA(1, 1, At, B1); PG8_BAR; PG8_SCHED;
        }
        if (wr == 0) PG8_BAR;
        E(acc, cur, wr, wc, fr, fq);
        if (!has_next) break;
#pragma unroll
        for (int a = 0; a < 2; ++a)
#pragma unroll
            for (int b = 0; b < 2; ++b)
#pragma unroll
                for (int m = 0; m < 4; ++m)
#pragma unroll
                    for (int n = 0; n < 2; ++n) acc[a][b][m][n] = (f32x4){0.f, 0.f, 0.f, 0.f};
        cur = nxt; cA = nA; cB = nB; ++ui;
        if (wr == 1) PG8_BAR;
    }
    PG8_WAIT_V(0);
    PG8_BAR;
#undef PG8_SA
#undef PG8_SB
#undef PG8_STAGE
#undef PG8_LDA
#undef PG8_LDB
#undef PG8_MMA
#undef PG8_WAIT_V
#undef PG8_WAIT_L
#undef PG8_BAR
#undef PG8_SCHED
}
}

#define XB_TMO      128
#define XB_XCNT(j)  (256  + 64 * (j))
#define XB_XSUB(j)  (1280 + 64 * (j))
#define XB_XGEN(j)  (2304 + 64 * (j))
#define XB_TOP      3328
#define XB_TOPGEN   3392
#define XCD_BAR_WORDS 3456
#define XB_SPIN_CAP (1u << 18)
__device__ __forceinline__ unsigned xb_ld(unsigned* p)              { return __hip_atomic_load(p, __ATOMIC_RELAXED, __HIP_MEMORY_SCOPE_AGENT); }
__device__ __forceinline__ unsigned xb_add(unsigned* p, unsigned v) { return __hip_atomic_fetch_add(p, v, __ATOMIC_RELAXED, __HIP_MEMORY_SCOPE_AGENT); }
__device__ __forceinline__ unsigned xb_xcc_id() { return (unsigned)__builtin_amdgcn_s_getreg((3 << 11) | 20) & 0xFu; }
#define XB_SPIN(cond, bar) do { unsigned _sp = 0; while (cond) { __builtin_amdgcn_s_sleep(1); \
    if ((++_sp & 255u) == 0u) { if (xb_ld(&(bar)[XB_TMO])) break; if (_sp > XB_SPIN_CAP) { atomicAdd(&(bar)[XB_TMO], 1u); break; } } } } while (0)
struct XcdBarrier { unsigned* bar; unsigned x; volatile LAS unsigned* st; };
__device__ __forceinline__ XcdBarrier xcd_barrier_post(unsigned* bar, volatile LAS unsigned* st) {
    XcdBarrier b; b.bar = bar; b.x = xb_xcc_id(); b.st = st;
    if (threadIdx.x == 0) (void)xb_add(&bar[XB_XCNT(b.x)], 1u);
    return b;
}
__device__ __forceinline__ void xcd_barrier_complete(unsigned* bar, unsigned x, unsigned& nloc, unsigned& nx) {
    const unsigned G = gridDim.x * gridDim.y * gridDim.z;
    asm volatile("" : "+s"(x));
    unsigned sum, cnt, mine, sp = 0u;
    for (;;) {
        sum = 0u; cnt = 0u; mine = 0u;
#pragma unroll
        for (unsigned j = 0; j < 16; ++j) { const unsigned c = xb_ld(&bar[XB_XCNT(j)]); sum += c; cnt += (c > 0u) ? 1u : 0u; mine = (j == x) ? c : mine; }
        if (sum == G) break;
        __builtin_amdgcn_s_sleep(1);
        if ((++sp & 255u) == 0u) { if (xb_ld(&bar[XB_TMO])) break; if (sp > XB_SPIN_CAP) { atomicAdd(&bar[XB_TMO], 1u); break; } }
    }
    nloc = mine > 0u ? mine : 1u; nx = cnt > 0u ? cnt : 1u;
}
__device__ __forceinline__ void xcd_barrier(const XcdBarrier& b) {
    asm volatile("s_waitcnt vmcnt(0)" ::: "memory");
    __syncthreads();
    if (threadIdx.x == 0) {
        unsigned* bar = b.bar;
        __builtin_amdgcn_s_waitcnt(0);
        unsigned nloc = b.st[0], nx = b.st[1];
        if (nloc == 0u) { xcd_barrier_complete(bar, b.x, nloc, nx); b.st[0] = nloc; b.st[1] = nx; }
        const unsigned old = xb_add(&bar[XB_XSUB(b.x)], 1u);
        const unsigned gen = old / nloc;
        if (old + 1u == (gen + 1u) * nloc) {
            __builtin_amdgcn_fence(__ATOMIC_RELEASE, "agent");
            asm volatile("s_waitcnt vmcnt(0)" ::: "memory");
            const unsigned og = xb_add(&bar[XB_TOP], 1u);
            const unsigned tg = og / nx;
            if (og + 1u == (tg + 1u) * nx) xb_add(&bar[XB_TOPGEN], 1u);
            else XB_SPIN(xb_ld(&bar[XB_TOPGEN]) == tg, bar);
            __builtin_amdgcn_fence(__ATOMIC_ACQUIRE, "agent");
            xb_add(&bar[XB_XGEN(b.x)], 1u);
            asm volatile("s_waitcnt vmcnt(0)" ::: "memory");
        } else {
            XB_SPIN(xb_ld(&bar[XB_XGEN(b.x)]) == gen, bar);
            __builtin_amdgcn_fence(__ATOMIC_ACQUIRE, "agent");
            asm volatile("s_waitcnt vmcnt(0)" ::: "memory");
        }
    }
    __syncthreads();
}

constexpr size_t MiB = 1u << 20;
constexpr int NWAVES = 8;
constexpr int PROJ_BLD = 6144;
constexpr int PMAX = 34816;
constexpr int FLD = 2048 + 64;
constexpr size_t WS_CTL = 0, CTL_BYTES = 1 * MiB;
constexpr size_t WS_WIN = 1 * MiB, WS_WOUT = 25 * MiB, WS_WLORA = 33 * MiB;
constexpr size_t WS_XF = 34 * MiB, WS_XB = 162 * MiB, WS_VFIRST = 226 * MiB, WS_YMIXB = 290 * MiB, WS_TOK = 354 * MiB, WS_SCR = 356 * MiB;
constexpr size_t WS_PROJB = WS_SCR, WS_LW = WS_PROJB + 192 * MiB, WS_YRW = WS_LW + 128 * MiB, WS_BON = WS_YRW + 64 * MiB, WS_XBCC = WS_BON + 64 * MiB, WS_DTB = WS_XBCC + 48 * MiB, WS_YSSD = WS_DTB + 1 * MiB, WS_MIXED = WS_YSSD + 64 * MiB;
constexpr size_t WS_HBUF = WS_SCR, WS_XG = WS_HBUF + 187 * MiB, WS_YSLOT = WS_XG + 136 * MiB;
constexpr size_t WS_WFFN = WS_SCR + 860 * MiB, WS_END = WS_WFFN + 264 * MiB;
static_assert(WS_MIXED + 132 * MiB <= WS_WFFN && WS_YSLOT + 281 * MiB <= WS_WFFN, "scratch inside the map");
static_assert((size_t)PMAX * DFE * 2 <= 187 * MiB && (size_t)PMAX * D * 2 <= 136 * MiB && (size_t)PMAX * FLD * 4 <= 281 * MiB && (size_t)M * FLD * 4 <= 132 * MiB, "moe buffers");
constexpr int CW_CNT = 16;
constexpr int CW_BAR = 4096;
constexpr int MAX_BAR_REGIONS = 48;
static_assert((CW_BAR + MAX_BAR_REGIONS * XCD_BAR_WORDS) * 4 <= (int)CTL_BYTES, "ctl");
constexpr int RING_BYTES = 131072, LDS_BYTES = 147456, MISC_OFF = LDS_BYTES - 256;

struct Params { const float* in[35]; float* out; unsigned char* ws; int ph_lo, ph_hi, bar_idx, pad; };

__device__ __forceinline__ float wave_sum_f(float v) {
#pragma unroll
    for (int o = 32; o >= 1; o >>= 1) v += __shfl_xor(v, o);
    return v;
}

__device__ __forceinline__ void cvt_item(const float* W, int K, int N, bf16_t* WT, int dst_row0, LAS float* scr, int k0, int n0, int lane) {
#pragma unroll 8
    for (int i = 0; i < 32; ++i) { const int kk = 2 * i + (lane >> 5), col = lane & 31;
        scr[kk * 33 + col] = (k0 + kk < K && n0 + col < N) ? W[(size_t)(k0 + kk) * N + n0 + col] : 0.f; }
    asm volatile("s_waitcnt lgkmcnt(0)" ::: "memory");
    const int c = lane & 7;
#pragma unroll
    for (int j = 0; j < 4; ++j) { const int n = (lane >> 3) + 8 * j; const LAS float* s = scr + (8 * c) * 33 + n;
        u32x4 o; o.x = cvt_pk_bf16(s[0 * 33], s[1 * 33]); o.y = cvt_pk_bf16(s[2 * 33], s[3 * 33]); o.z = cvt_pk_bf16(s[4 * 33], s[5 * 33]); o.w = cvt_pk_bf16(s[6 * 33], s[7 * 33]);
        if (n0 + n < N && k0 + 8 * c < K) *(u32x4*)(WT + (size_t)(dst_row0 + n) * K + k0 + 8 * c) = o; }
    asm volatile("s_waitcnt lgkmcnt(0)" ::: "memory");
}
template <int MODE>
__device__ __forceinline__ void cvt_job(const float* W, int K, int N, bf16_t* WT, int row_off, int half, LAS float* scr, int gw, int ngw, int lane) {
    const int nkb = (K + 63) / 64, nnb = (N + 31) / 32, nitems = nkb * nnb;
    for (int it = gw; it < nitems; it += ngw) {
        const int kb = it / nnb, nb = it % nnb, n0 = nb * 32;
        const int dr = MODE == 0 ? row_off + n0 : row_off + 256 * (n0 / 128) + half * 128 + (n0 % 128);
        cvt_item(W, K, N, WT, dr, scr, kb * 64, n0, lane);
    }
}

struct LnOut { float* xf; bf16_t* xb; };
__device__ __forceinline__ void ln_finish(f32x4 (&v)[8], const float* gam, const float* bet, int lane, float* xf_row, bf16_t* xb_row) {
    float s = 0.f;
#pragma unroll
    for (int j = 0; j < 8; ++j) s += (v[j][0] + v[j][1]) + (v[j][2] + v[j][3]);
    const float mean = wave_sum_f(s) * (1.f / D);
    float q = 0.f;
#pragma unroll
    for (int j = 0; j < 8; ++j) { v[j] = v[j] - mean; q += (v[j][0] * v[j][0] + v[j][1] * v[j][1]) + (v[j][2] * v[j][2] + v[j][3] * v[j][3]); }
    const float rstd = rsqrtf(wave_sum_f(q) * (1.f / D) + 1e-5f);
#pragma unroll
    for (int j = 0; j < 8; ++j) { const int c = 4 * lane + 256 * j;
        const f32x4 g = *(const f32x4*)(gam + c), b = *(const f32x4*)(bet + c);
        v[j] = v[j] * rstd * g + b;
        *(f32x4*)(xf_row + c) = v[j];
        if (xb_row) { u32x2 w; w.x = cvt_pk_bf16(v[j][0], v[j][1]); w.y = cvt_pk_bf16(v[j][2], v[j][3]); *(u32x2*)(xb_row + c) = w; } }
}

#define DPP_ROR(z, n) __uint_as_float(__builtin_amdgcn_update_dpp(0u, __float_as_uint(z), 0x120 + (n), 0xf, 0xf, false))
__device__ __forceinline__ float wave_allsum(float x) {
    { auto s = __builtin_amdgcn_permlane32_swap(__float_as_uint(x), __float_as_uint(x), false, false); x = __uint_as_float(s[0]) + __uint_as_float(s[1]); }
    { auto s = __builtin_amdgcn_permlane16_swap(__float_as_uint(x), __float_as_uint(x), false, false); x = __uint_as_float(s[0]) + __uint_as_float(s[1]); }
    x += DPP_ROR(x, 8); x += DPP_ROR(x, 4); x += DPP_ROR(x, 2); x += DPP_ROR(x, 1);
    return x;
}
__device__ __forceinline__ float reduce4(float x0, float x1, float x2, float x3) {
    float y0, y1, z;
    { auto s = __builtin_amdgcn_permlane32_swap(__float_as_uint(x0), __float_as_uint(x2), false, false); y0 = __uint_as_float(s[0]) + __uint_as_float(s[1]); }
    { auto s = __builtin_amdgcn_permlane32_swap(__float_as_uint(x1), __float_as_uint(x3), false, false); y1 = __uint_as_float(s[0]) + __uint_as_float(s[1]); }
    { auto s = __builtin_amdgcn_permlane16_swap(__float_as_uint(y0), __float_as_uint(y1), false, false); z = __uint_as_float(s[0]) + __uint_as_float(s[1]); }
    z += DPP_ROR(z, 8); z += DPP_ROR(z, 4); z += DPP_ROR(z, 2); z += DPP_ROR(z, 1);
    return z;
}
__device__ __forceinline__ float rdlane(float v, int l) { return __int_as_float(__builtin_amdgcn_readlane(__float_as_int(v), l)); }
__device__ __forceinline__ float fast_sigmoid(float x) { return __builtin_amdgcn_rcpf(1.f + __builtin_amdgcn_exp2f(-1.4426950408889634f * x)); }
__device__ __forceinline__ float fast_tanh(float x) { return 1.f - 2.f * __builtin_amdgcn_rcpf(1.f + __builtin_amdgcn_exp2f(2.8853900817779268f * x)); }

constexpr int LORA_PITCH = 328;
__device__ __forceinline__ void lora_phase(LAS unsigned char* lds, const bf16_t* projb, const float* mix, const float* vmix, const bf16_t* Wl_w, const bf16_t* Wl_a, const bf16_t* Wl_g, const bf16_t* Wl_v,
                                           bf16_t* lw, const bool has_v, const int vcu, const int G, const int tid) {
    const int wave = __builtin_amdgcn_readfirstlane(tid >> 6), lane = tid & 63, fr = lane & 15, fq = lane >> 4;
    LAS bf16_t* Aimg = (LAS bf16_t*)lds;
    for (int u = vcu; u < M / 64; u += G) {
        {
            const int tau = tid >> 3, part = tid & 7, m = u * 64 + tau; const bool first = (m % SEQ) == 0;
#pragma unroll
            for (int i = 0; i < 5; ++i) {
                const int j0 = 40 * part + 8 * i;
                const u32x4 cur = *(const u32x4*)(projb + (size_t)m * PROJ_BLD + OFF_WLO + j0);
                u32x4 prv = (u32x4){0u, 0u, 0u, 0u};
                if (!first) prv = *(const u32x4*)(projb + (size_t)(m - 1) * PROJ_BLD + OFF_WLO + j0);
                f32x4 mx0, mx1;
                if (j0 < 288) { mx0 = *(const f32x4*)(mix + (OFF_WLO - OFF_RW) + j0); mx1 = *(const f32x4*)(mix + (OFF_WLO - OFF_RW) + j0 + 4); }
                else if (has_v) { mx0 = *(const f32x4*)(vmix + (j0 - 288)); mx1 = *(const f32x4*)(vmix + (j0 - 288) + 4); }
                else { mx0 = (f32x4){0.f, 0.f, 0.f, 0.f}; mx1 = mx0; }
                float o[8];
#pragma unroll
                for (int e = 0; e < 4; ++e) {
                    const float c0 = bf_lo(cur[e]), c1 = bf_hi(cur[e]), p0 = bf_lo(prv[e]), p1 = bf_hi(prv[e]);
                    const float m0 = (e < 2) ? mx0[2 * e] : mx1[2 * e - 4], m1 = (e < 2) ? mx0[2 * e + 1] : mx1[2 * e - 3];
                    o[2 * e] = c0 + (p0 - c0) * m0; o[2 * e + 1] = c1 + (p1 - c1) * m1;
                }
                if (j0 < 64) {
#pragma unroll
                    for (int e = 0; e < 8; ++e) o[e] = fast_tanh(o[e]);
                } else if (j0 >= 128 && j0 < 288) {
#pragma unroll
                    for (int e = 0; e < 8; ++e) o[e] = fast_sigmoid(o[e]);
                }
                u32x4 w; w.x = cvt_pk_bf16(o[0], o[1]); w.y = cvt_pk_bf16(o[2], o[3]); w.z = cvt_pk_bf16(o[4], o[5]); w.w = cvt_pk_bf16(o[6], o[7]);
                *(LAS u32x4*)(Aimg + tau * LORA_PITCH + j0) = w;
            }
        }
        __syncthreads();
        for (int q = 0; q < 4; ++q) {
            if (q == 3 && !has_v) break;
            const int K = (q == 2) ? 160 : (q == 3 ? 32 : 64), koff = (q == 0) ? 0 : (q == 1 ? 64 : (q == 2 ? 128 : 288));
            const bf16_t* W = (q == 0) ? Wl_w : (q == 1 ? Wl_a : (q == 2 ? Wl_g : Wl_v));
            f32x4 acc[8][4];
#pragma unroll
            for (int ct = 0; ct < 8; ++ct)
#pragma unroll
                for (int tt = 0; tt < 4; ++tt) acc[ct][tt] = (f32x4){0.f, 0.f, 0.f, 0.f};
            for (int ks = 0; ks < K / 32; ++ks) {
                bf16x8 af[8], bfr[4];
#pragma unroll
                for (int ct = 0; ct < 8; ++ct) af[ct] = *(const bf16x8*)(W + (size_t)(128 * wave + 16 * ct + fr) * K + 32 * ks + 8 * fq);
#pragma unroll
                for (int tt = 0; tt < 4; ++tt) bfr[tt] = *(const LAS bf16x8*)(Aimg + (16 * tt + fr) * LORA_PITCH + koff + 32 * ks + 8 * fq);
#pragma unroll
                for (int ct = 0; ct < 8; ++ct)
#pragma unroll
                    for (int tt = 0; tt < 4; ++tt) acc[ct][tt] = __builtin_amdgcn_mfma_f32_16x16x32_bf16(af[ct], bfr[tt], acc[ct][tt], 0, 0, 0);
            }
            bf16_t* out = lw + (size_t)q * M * 1024;
#pragma unroll
            for (int ct = 0; ct < 8; ++ct)
#pragma unroll
                for (int tt = 0; tt < 4; ++tt) { u32x2 w; w.x = cvt_pk_bf16(acc[ct][tt][0], acc[ct][tt][1]); w.y = cvt_pk_bf16(acc[ct][tt][2], acc[ct][tt][3]);
                    *(u32x2*)(out + (size_t)(u * 64 + 16 * tt + fr) * 1024 + 128 * wave + 16 * ct + 4 * fq) = w; }
        }
        __syncthreads();
    }
}

struct RwScan { const bf16_t* proj_; const bf16_t* lw_; const float* mix; const float* w0; const float* a0; const float* v0; const float* k_k; const float* k_a; const float* r_k; float* vf_; float* y_; float* bon_; int layer; int pad; };
constexpr int RWB_A = 0, RWB_DR = 8192, RWB_D = 16384, RWB_B = 24576, RWB_K = 32768, RWB_V = 40960, RWB_SC = 45056, RWB_SIZE = 45568, RW_YST = 3 * RWB_SIZE, RW_YST_SIZE = 4096, RW_TB = 32, RW_NCH = SEQ / RW_TB;
static_assert(RW_YST + 2 * RW_YST_SIZE <= MISC_OFF, "rwkv scan LDS map");
__device__ __forceinline__ float rowsum16(float z) { z += DPP_ROR(z, 8); asm("" : "+v"(z)); z += DPP_ROR(z, 4); asm("" : "+v"(z)); z += DPP_ROR(z, 2); asm("" : "+v"(z)); z += DPP_ROR(z, 1); asm("" : "+v"(z)); return z; }
__device__ __forceinline__ void rwkv_scan_phase(LAS unsigned char* lds, const RwScan& a, const int vcu, const int G, const int tid) {
    const int wave = __builtin_amdgcn_readfirstlane(tid >> 6), lane = tid & 63, jj = lane & 15, rg = lane >> 4;
    for (int u = vcu; u < BATCH * RW_H * 2; u += G) {
        const int b = u >> 5, h = (u >> 1) & 15, half = u & 1;
        if (wave >= 4) {
            const int pw_ = wave - 4, c = h * 64 + lane, ptid = tid - 256;
            const float mix_r = a.mix[c], mix_k = a.mix[1024 + c], mix_v = a.mix[2048 + c];
            const float w0c = a.w0[c], a0c = a.a0[c], v0c = a.layer ? a.v0[c] : 0.f, kkc = a.k_k[c], kac = a.k_a[c], rkc = a.r_k[c];
            const bf16_t* lw_w = a.lw_; const bf16_t* lw_a = a.lw_ + (size_t)M * 1024; const bf16_t* lw_v = a.lw_ + (size_t)3 * M * 1024;
            const int woff = jj * 16 + rg * 4;
            unsigned pr[9], pk[9], pv[9], pw[8], pa[8], pvp[8]; float pvf[8];
#define RW_PREFETCH(t0_) do { const int tb_ = (t0_) + 8 * pw_; \
            _Pragma("unroll") for (int i = 0; i < 9; ++i) { const int t_ = tb_ + i - 1; \
                if (t_ >= 0) { const bf16_t* row_ = a.proj_ + (size_t)(b * SEQ + t_) * PROJ_BLD + h * 64 + lane; pr[i] = row_[OFF_R]; pk[i] = row_[OFF_K]; pv[i] = row_[OFF_V]; } \
                else { pr[i] = 0u; pk[i] = 0u; pv[i] = 0u; } } \
            _Pragma("unroll") for (int i = 0; i < 8; ++i) { const size_t o_ = (size_t)(b * SEQ + tb_ + i) * 1024 + c; pw[i] = lw_w[o_]; pa[i] = lw_a[o_]; \
                if (a.layer) { pvp[i] = lw_v[o_]; pvf[i] = a.vf_[o_]; } else { pvp[i] = 0u; pvf[i] = 0.f; } } } while (0)
#define RW_PREP(ch_) do { const int t0_ = (ch_) * RW_TB; LAS unsigned char* buf_ = lds + ((ch_) % 3) * RWB_SIZE; \
            _Pragma("unroll") for (int i = 0; i < 8; ++i) { \
                const int tau = 8 * pw_ + i; \
                const float rc = __uint_as_float(pr[i + 1] << 16), rp = __uint_as_float(pr[i] << 16), kc = __uint_as_float(pk[i + 1] << 16), kp = __uint_as_float(pk[i] << 16), vc = __uint_as_float(pv[i + 1] << 16), vp = __uint_as_float(pv[i] << 16); \
                const float r = rc + (rp - rc) * mix_r, kraw = kc + (kp - kc) * mix_k, vraw = vc + (vp - vc) * mix_v; \
                const float sg = fast_sigmoid(w0c + __uint_as_float(pw[i] << 16)); \
                const float dec = __builtin_amdgcn_exp2f(-1.4426950408889634f * 0.6065306597126334f * sg);     \
                const float as = fast_sigmoid(a0c + __uint_as_float(pa[i] << 16)); \
                float v = vraw; \
                if (a.layer) v = vraw + (pvf[i] - vraw) * fast_sigmoid(v0c + __uint_as_float(pvp[i] << 16)); \
                const float kkv = kraw * kkc; \
                const float km = kraw * (1.f + (as - 1.f) * kac); \
                const float z = reduce4(kkv * kkv, r * km * rkc, kkv * as * r, km * r);     \
                const float nrm2 = rdlane(z, 0), rks = rdlane(z, 16), bru = rdlane(z, 32), kr = rdlane(z, 48); \
                const float inv = 1.f / fmaxf(sqrtf(nrm2), 1e-12f); \
                const float kkn = kkv * inv; \
                *(LAS float*)(buf_ + RWB_A + tau * 256 + woff) = -kkn; *(LAS float*)(buf_ + RWB_DR + tau * 256 + woff) = dec * r; *(LAS float*)(buf_ + RWB_D + tau * 256 + woff) = dec; \
                *(LAS float*)(buf_ + RWB_B + tau * 256 + woff) = kkn * as; *(LAS float*)(buf_ + RWB_K + tau * 256 + woff) = km; \
                if ((lane >> 5) == half) { ((LAS float*)(buf_ + RWB_V))[tau * 32 + (lane & 31)] = v; \
                    if (a.layer == 0) a.vf_[(size_t)(b * SEQ + t0_ + tau) * 1024 + c] = vraw; } \
                if (lane == 0) { ((LAS float*)(buf_ + RWB_SC))[tau] = bru * inv; ((LAS float*)(buf_ + RWB_SC))[32 + tau] = kr; ((LAS float*)(buf_ + RWB_SC))[64 + tau] = rks; } \
            } } while (0)
#define RW_FLUSH(ch_) do { const int t0_ = (ch_) * RW_TB; const LAS unsigned char* buf_ = lds + ((ch_) % 3) * RWB_SIZE; const LAS float* yst_ = (const LAS float*)(lds + RW_YST + ((ch_) & 1) * RW_YST_SIZE); \
            _Pragma("unroll") for (int q = 0; q < 4; ++q) { const int idx = ptid + 256 * q, tau = idx >> 5, i = idx & 31; \
                const float y = yst_[((((tau >> 4) * 4 + (i >> 3)) * 64 + ((i & 7) >> 1) * 16 + (tau & 15)) << 1) + (i & 1)]; \
                const float bo = ((const LAS float*)(buf_ + RWB_SC))[64 + tau] * ((const LAS float*)(buf_ + RWB_V))[tau * 32 + i]; \
                const size_t o = (size_t)(b * SEQ + t0_ + tau) * 1024 + h * 64 + half * 32 + i; \
                a.y_[o] = y; a.bon_[o] = bo; } } while (0)
            RW_PREFETCH(0);
            RW_PREP(0);
            RW_PREFETCH(RW_TB);
            __syncthreads();
            for (int ch = 0; ch < RW_NCH; ++ch) {
                if (ch > 0) RW_FLUSH(ch - 1);
                if (ch + 1 < RW_NCH) { RW_PREP(ch + 1); if (ch + 2 < RW_NCH) RW_PREFETCH((ch + 2) * RW_TB); }
                __syncthreads();
            }
            RW_FLUSH(RW_NCH - 1);
#undef RW_PREFETCH
#undef RW_PREP
#undef RW_FLUSH
        } else {
            f32x2 S0 = (f32x2){0.f, 0.f}, S1 = S0, S2 = S0, S3 = S0;
            __syncthreads();
            for (int ch = 0; ch < RW_NCH; ++ch) {
                const LAS unsigned char* buf = lds + (ch % 3) * RWB_SIZE;
                const LAS unsigned char* ob = buf + jj * 16;
                const LAS float* Vb = (const LAS float*)(buf + RWB_V) + 8 * wave + 2 * rg; const LAS float* SC = (const LAS float*)(buf + RWB_SC);
                LAS f32x2* Yst = (LAS f32x2*)(lds + RW_YST + (ch & 1) * RW_YST_SIZE);
                f32x4 a4 = *(const LAS f32x4*)(ob + RWB_A), q4 = *(const LAS f32x4*)(ob + RWB_DR), d4 = *(const LAS f32x4*)(ob + RWB_D), b4 = *(const LAS f32x4*)(ob + RWB_B), k4 = *(const LAS f32x4*)(ob + RWB_K);
                f32x2 vi = *(const LAS f32x2*)Vb; float br = SC[0], kr = SC[32];
#pragma unroll
                for (int blk = 0; blk < 2; ++blk) {
                    f32x2 yacc = (f32x2){0.f, 0.f};
#pragma unroll
                    for (int s = 0; s < 16; ++s) {
                        const int tn = blk * 16 + s + 1;
                        const f32x4 na4 = *(const LAS f32x4*)(ob + RWB_A + tn * 256), nq4 = *(const LAS f32x4*)(ob + RWB_DR + tn * 256), nd4 = *(const LAS f32x4*)(ob + RWB_D + tn * 256),
                                    nb4 = *(const LAS f32x4*)(ob + RWB_B + tn * 256), nk4 = *(const LAS f32x4*)(ob + RWB_K + tn * 256);
                        const f32x2 nvi = *(const LAS f32x2*)(Vb + (tn & 31) * 32); const float nbr = SC[tn & 31], nkr = SC[32 + (tn & 31)];
                        const f32x2 pa_ = (S0 * a4[0] + S1 * a4[1]) + (S2 * a4[2] + S3 * a4[3]);
                        const f32x2 pq_ = (S0 * q4[0] + S1 * q4[1]) + (S2 * q4[2] + S3 * q4[3]);
                        f32x2 sa, zq;
                        sa.x = rowsum16(pa_.x); sa.y = rowsum16(pa_.y); zq.x = rowsum16(pq_.x); zq.y = rowsum16(pq_.y);
                        S0 = S0 * d4[0] + sa * b4[0] + vi * k4[0]; S1 = S1 * d4[1] + sa * b4[1] + vi * k4[1]; S2 = S2 * d4[2] + sa * b4[2] + vi * k4[2]; S3 = S3 * d4[3] + sa * b4[3] + vi * k4[3];
                        const f32x2 y = zq + sa * br + vi * kr;
                        yacc.x = (jj == s) ? y.x : yacc.x; yacc.y = (jj == s) ? y.y : yacc.y;
                        a4 = na4; q4 = nq4; d4 = nd4; b4 = nb4; k4 = nk4; vi = nvi; br = nbr; kr = nkr;
                    }
                    Yst[(blk * 4 + wave) * 64 + lane] = yacc;
                }
                __syncthreads();
            }
        }
        __syncthreads();
    }
}

__device__ __forceinline__ void rwkv_post_phase(const float* yrw, const float* bon, const bf16_t* lw_g, const float* ln_w, const float* ln_b, bf16_t* ymixb, const int gw, const int NGW, const int lane) {
    const int c0 = 16 * lane;
    f32x4 lw4[4], lb4[4];
#pragma unroll
    for (int j = 0; j < 4; ++j) { lw4[j] = *(const f32x4*)(ln_w + c0 + 4 * j); lb4[j] = *(const f32x4*)(ln_b + c0 + 4 * j); }
    for (int m = gw; m < M; m += NGW) {
        f32x4 y[4], bo[4];
#pragma unroll
        for (int j = 0; j < 4; ++j) { y[j] = *(const f32x4*)(yrw + (size_t)m * 1024 + c0 + 4 * j); bo[j] = *(const f32x4*)(bon + (size_t)m * 1024 + c0 + 4 * j); }
        const u32x4 g0 = *(const u32x4*)(lw_g + (size_t)m * 1024 + c0), g1 = *(const u32x4*)(lw_g + (size_t)m * 1024 + c0 + 8);
        float s = 0.f;
#pragma unroll
        for (int j = 0; j < 4; ++j) s += (y[j][0] + y[j][1]) + (y[j][2] + y[j][3]);
        s += __shfl_xor(s, 1); s += __shfl_xor(s, 2);
        const float mu = s * (1.f / 64.f);
        float q = 0.f;
#pragma unroll
        for (int j = 0; j < 4; ++j) { y[j] = y[j] - mu; q += (y[j][0] * y[j][0] + y[j][1] * y[j][1]) + (y[j][2] * y[j][2] + y[j][3] * y[j][3]); }
        q += __shfl_xor(q, 1); q += __shfl_xor(q, 2);
        const float rstd = rsqrtf(q * (1.f / 64.f) + 64e-5f);
        float o[16];
#pragma unroll
        for (int j = 0; j < 4; ++j) { const f32x4 t = y[j] * rstd * lw4[j] + lb4[j] + bo[j]; o[4 * j] = t[0]; o[4 * j + 1] = t[1]; o[4 * j + 2] = t[2]; o[4 * j + 3] = t[3]; }
        const unsigned gw_[8] = {g0.x, g0.y, g0.z, g0.w, g1.x, g1.y, g1.z, g1.w};
        u32x4 w0, w1;
        w0.x = cvt_pk_bf16(o[0] * bf_lo(gw_[0]), o[1] * bf_hi(gw_[0])); w0.y = cvt_pk_bf16(o[2] * bf_lo(gw_[1]), o[3] * bf_hi(gw_[1]));
        w0.z = cvt_pk_bf16(o[4] * bf_lo(gw_[2]), o[5] * bf_hi(gw_[2])); w0.w = cvt_pk_bf16(o[6] * bf_lo(gw_[3]), o[7] * bf_hi(gw_[3]));
        w1.x = cvt_pk_bf16(o[8] * bf_lo(gw_[4]), o[9] * bf_hi(gw_[4])); w1.y = cvt_pk_bf16(o[10] * bf_lo(gw_[5]), o[11] * bf_hi(gw_[5]));
        w1.z = cvt_pk_bf16(o[12] * bf_lo(gw_[6]), o[13] * bf_hi(gw_[6])); w1.w = cvt_pk_bf16(o[14] * bf_lo(gw_[7]), o[15] * bf_hi(gw_[7]));
        *(u32x4*)(ymixb + (size_t)m * 2048 + 1024 + c0) = w0; *(u32x4*)(ymixb + (size_t)m * 2048 + 1024 + c0 + 8) = w1;
    }
}

__device__ __forceinline__ void ssd_conv_phase(const bf16_t* projb, const float* cw, const float* cb, const float* dt_bias, bf16_t* xbcc, float* dtb, const int vcu, const int G, const int tid) {
    for (int u = vcu; u < M / 64; u += G) {
        if (tid < 384) {
            const int cg = tid % 192, hf = tid / 192, c0 = 8 * cg, m0 = u * 64 + 32 * hf, t_in_seq = m0 % SEQ;
            float w[4][8], bias[8];
#pragma unroll
            for (int q = 0; q < 4; ++q) { const f32x4 a = *(const f32x4*)(cw + q * CONV_DIM + c0), b = *(const f32x4*)(cw + q * CONV_DIM + c0 + 4);
                w[q][0] = a[0]; w[q][1] = a[1]; w[q][2] = a[2]; w[q][3] = a[3]; w[q][4] = b[0]; w[q][5] = b[1]; w[q][6] = b[2]; w[q][7] = b[3]; }
            { const f32x4 a = *(const f32x4*)(cb + c0), b = *(const f32x4*)(cb + c0 + 4); bias[0] = a[0]; bias[1] = a[1]; bias[2] = a[2]; bias[3] = a[3]; bias[4] = b[0]; bias[5] = b[1]; bias[6] = b[2]; bias[7] = b[3]; }
            float win[3][8];
#pragma unroll
            for (int q = 0; q < 3; ++q) {
                u32x4 r = (u32x4){0u, 0u, 0u, 0u};
                if (t_in_seq - 3 + q >= 0) r = *(const u32x4*)(projb + (size_t)(m0 - 3 + q) * PROJ_BLD + OFF_XBC + c0);
                win[q][0] = bf_lo(r.x); win[q][1] = bf_hi(r.x); win[q][2] = bf_lo(r.y); win[q][3] = bf_hi(r.y); win[q][4] = bf_lo(r.z); win[q][5] = bf_hi(r.z); win[q][6] = bf_lo(r.w); win[q][7] = bf_hi(r.w);
            }
            for (int i = 0; i < 32; ++i) {
                const u32x4 r = *(const u32x4*)(projb + (size_t)(m0 + i) * PROJ_BLD + OFF_XBC + c0);
                float cur[8] = {bf_lo(r.x), bf_hi(r.x), bf_lo(r.y), bf_hi(r.y), bf_lo(r.z), bf_hi(r.z), bf_lo(r.w), bf_hi(r.w)};
                float o[8];
#pragma unroll
                for (int e = 0; e < 8; ++e) { const float acc = bias[e] + w[0][e] * win[0][e] + w[1][e] * win[1][e] + w[2][e] * win[2][e] + w[3][e] * cur[e]; o[e] = fast_silu(acc);
                    win[0][e] = win[1][e]; win[1][e] = win[2][e]; win[2][e] = cur[e]; }
                u32x4 wv; wv.x = cvt_pk_bf16(o[0], o[1]); wv.y = cvt_pk_bf16(o[2], o[3]); wv.z = cvt_pk_bf16(o[4], o[5]); wv.w = cvt_pk_bf16(o[6], o[7]);
                *(u32x4*)(xbcc + (size_t)(m0 + i) * CONV_DIM + c0) = wv;
            }
        }
#pragma unroll
        for (int q = 0; q < 2; ++q) { const int idx = tid + 512 * q, m = u * 64 + (idx >> 4), h = idx & 15;
            const float x = bf2f(projb[(size_t)m * PROJ_BLD + OFF_DT + h]) + dt_bias[h];
            dtb[(size_t)m * SSD_H + h] = fmaxf(x, 0.f) + log1pf(expf(-fabsf(x))); }
    }
}

constexpr int SP = 136;
constexpr int SS_C = 0, SS_B = 34816, SS_BT = 69632, SS_XT = 104448, SS_XW = 113152, SS_HT = 121856, SS_AC = 130560, SS_DT = 131072, SS_END = 131584;
__device__ __forceinline__ void ssd_scan_phase(LAS unsigned char* lds, const bf16_t* xbcc, const float* dtb, const float* a_log, const float* dskip, float* yssd, const int vcu, const int G, const int tid) {
    const int wave = __builtin_amdgcn_readfirstlane(tid >> 6), lane = tid & 63, fr = lane & 15, fq = lane >> 4;
    LAS bf16_t* Cimg = (LAS bf16_t*)(lds + SS_C); LAS bf16_t* Bimg = (LAS bf16_t*)(lds + SS_B); LAS bf16_t* BTimg = (LAS bf16_t*)(lds + SS_BT);
    LAS bf16_t* xT = (LAS bf16_t*)(lds + SS_XT); LAS bf16_t* xwT = (LAS bf16_t*)(lds + SS_XW); LAS bf16_t* hT = (LAS bf16_t*)(lds + SS_HT);
    LAS float* acum = (LAS float*)(lds + SS_AC); LAS float* dtv = (LAS float*)(lds + SS_DT);
    for (int u = vcu; u < BATCH * SSD_H * 2; u += G) {
        const int b = u >> 5, h = (u >> 1) & 15, phalf = u & 1, g = h >> 3;
        const float Ah = -expf(a_log[h]) * 1.4426950408889634f;
        const float dsk = dskip[h];
        f32x4 hs[2] = {(f32x4){0.f, 0.f, 0.f, 0.f}, (f32x4){0.f, 0.f, 0.f, 0.f}};
        for (int i = tid; i < 32 * SP / 2; i += 512) ((LAS unsigned*)hT)[i] = 0u;
        const int row = tid >> 2, part = tid & 3;
        for (int ch = 0; ch < SEQ / 128; ++ch) {
            const int mrow0 = b * SEQ + ch * 128;
            u32x4 xr;
            {
                const bf16_t* src = xbcc + (size_t)(mrow0 + row) * CONV_DIM;
                u32x4 cv[4], bv[4];
#pragma unroll
                for (int j = 0; j < 4; ++j) { cv[j] = *(const u32x4*)(src + 1280 + g * 128 + 32 * part + 8 * j); bv[j] = *(const u32x4*)(src + 1024 + g * 128 + 32 * part + 8 * j); }
                xr = *(const u32x4*)(src + h * 64 + phalf * 32 + 8 * part);
                if (tid < 128) dtv[tid] = dtb[(size_t)(mrow0 + tid) * SSD_H + h];
#pragma unroll
                for (int j = 0; j < 4; ++j) { *(LAS u32x4*)(Cimg + row * SP + 32 * part + 8 * j) = cv[j]; *(LAS u32x4*)(Bimg + row * SP + 32 * part + 8 * j) = bv[j]; }
#pragma unroll
                for (int j = 0; j < 4; ++j) { const unsigned wv[4] = {bv[j].x, bv[j].y, bv[j].z, bv[j].w};
#pragma unroll
                    for (int e = 0; e < 4; ++e) { const int n = 32 * part + 8 * j + 2 * e; BTimg[n * SP + row] = (bf16_t)(wv[e] & 0xffffu); BTimg[(n + 1) * SP + row] = (bf16_t)(wv[e] >> 16); } }
            }
            __syncthreads();
            if (wave == 0) {
                const float v0 = dtv[2 * lane] * Ah, v1 = dtv[2 * lane + 1] * Ah;
                float s = v0 + v1;
#pragma unroll
                for (int o = 1; o < 64; o <<= 1) { const float t = __shfl_up(s, o); if (lane >= o) s += t; }
                acum[2 * lane] = s - v1; acum[2 * lane + 1] = s;
            }
            __syncthreads();
            const float atot = acum[127];
            {
                const float wgt = dtv[row] * __builtin_amdgcn_exp2f(atot - acum[row]);
                const unsigned wv[4] = {xr.x, xr.y, xr.z, xr.w};
#pragma unroll
                for (int e = 0; e < 4; ++e) { const int p = 8 * part + 2 * e; const float x0 = bf_lo(wv[e]), x1 = bf_hi(wv[e]);
                    xT[p * SP + row] = (bf16_t)(wv[e] & 0xffffu); xT[(p + 1) * SP + row] = (bf16_t)(wv[e] >> 16);
                    const unsigned pk = cvt_pk_bf16(x0 * wgt, x1 * wgt); xwT[p * SP + row] = (bf16_t)(pk & 0xffffu); xwT[(p + 1) * SP + row] = (bf16_t)(pk >> 16); }
            }
            f32x4 gacc[8];
#pragma unroll
            for (int st = 0; st < 8; ++st) gacc[st] = (f32x4){0.f, 0.f, 0.f, 0.f};
            {
                bf16x8 cf[4];
#pragma unroll
                for (int ks = 0; ks < 4; ++ks) cf[ks] = *(const LAS bf16x8*)(Cimg + (16 * wave + fr) * SP + 32 * ks + 8 * fq);
#pragma unroll
                for (int st = 0; st < 8; ++st) if (st <= wave) {
#pragma unroll
                    for (int ks = 0; ks < 4; ++ks) { const bf16x8 bfg = *(const LAS bf16x8*)(Bimg + (16 * st + fr) * SP + 32 * ks + 8 * fq);
                        gacc[st] = __builtin_amdgcn_mfma_f32_16x16x32_bf16(bfg, cf[ks], gacc[st], 0, 0, 0); }
                }
            }
            __syncthreads();
            {
                LAS bf16_t* Mimg = Bimg;
                const int l = 16 * wave + fr; const float al = acum[l];
#pragma unroll
                for (int st = 0; st < 8; ++st) if (st <= wave + 1) {
                    u32x2 wv = (u32x2){0u, 0u};
                    if (st <= wave) {
                        const f32x4 as4 = *(const LAS f32x4*)(acum + 16 * st + 4 * fq), dt4 = *(const LAS f32x4*)(dtv + 16 * st + 4 * fq);
                        float mv[4];
#pragma unroll
                        for (int r = 0; r < 4; ++r) { const int s = 16 * st + 4 * fq + r; mv[r] = (s <= l) ? gacc[st][r] * dt4[r] * __builtin_amdgcn_exp2f(al - as4[r]) : 0.f; }
                        wv.x = cvt_pk_bf16(mv[0], mv[1]); wv.y = cvt_pk_bf16(mv[2], mv[3]);
                    }
                    *(LAS u32x2*)(Mimg + l * SP + 16 * st + 4 * fq) = wv;
                }
            }
            __syncthreads();
            {
                const LAS bf16_t* Mimg = Bimg;
                f32x4 yd[2] = {(f32x4){0.f, 0.f, 0.f, 0.f}, (f32x4){0.f, 0.f, 0.f, 0.f}}, yo[2] = {(f32x4){0.f, 0.f, 0.f, 0.f}, (f32x4){0.f, 0.f, 0.f, 0.f}};
#pragma unroll
                for (int ks = 0; ks < 4; ++ks) {
                    const bf16x8 cfr = *(const LAS bf16x8*)(Cimg + (16 * wave + fr) * SP + 32 * ks + 8 * fq);
#pragma unroll
                    for (int pt = 0; pt < 2; ++pt) { const bf16x8 hf = *(const LAS bf16x8*)(hT + (16 * pt + fr) * SP + 32 * ks + 8 * fq);
                        yo[pt] = __builtin_amdgcn_mfma_f32_16x16x32_bf16(hf, cfr, yo[pt], 0, 0, 0); }
                    if (2 * ks <= wave) {
                        const bf16x8 mf = *(const LAS bf16x8*)(Mimg + (16 * wave + fr) * SP + 32 * ks + 8 * fq);
#pragma unroll
                        for (int pt = 0; pt < 2; ++pt) { const bf16x8 xf_ = *(const LAS bf16x8*)(xT + (16 * pt + fr) * SP + 32 * ks + 8 * fq);
                            yd[pt] = __builtin_amdgcn_mfma_f32_16x16x32_bf16(xf_, mf, yd[pt], 0, 0, 0); }
                    }
                }
                const int l = 16 * wave + fr; const float el = __builtin_amdgcn_exp2f(acum[l]);
#pragma unroll
                for (int pt = 0; pt < 2; ++pt) {
                    f32x4 o;
#pragma unroll
                    for (int r = 0; r < 4; ++r) o[r] = yd[pt][r] + el * yo[pt][r] + dsk * bf2f(xT[(16 * pt + 4 * fq + r) * SP + l]);
                    *(f32x4*)(yssd + (size_t)(mrow0 + l) * 1024 + h * 64 + phalf * 32 + 16 * pt + 4 * fq) = o;
                }
            }
            {
                const float ea = __builtin_amdgcn_exp2f(atot);
                hs[0] = hs[0] * ea; hs[1] = hs[1] * ea;
#pragma unroll
                for (int ks = 0; ks < 4; ++ks) {
                    const bf16x8 btf = *(const LAS bf16x8*)(BTimg + (16 * wave + fr) * SP + 32 * ks + 8 * fq);
#pragma unroll
                    for (int pt = 0; pt < 2; ++pt) { const bf16x8 xwf = *(const LAS bf16x8*)(xwT + (16 * pt + fr) * SP + 32 * ks + 8 * fq);
                        hs[pt] = __builtin_amdgcn_mfma_f32_16x16x32_bf16(btf, xwf, hs[pt], 0, 0, 0); }
                }
            }
            __syncthreads();
#pragma unroll
            for (int pt = 0; pt < 2; ++pt) { u32x2 wv; wv.x = cvt_pk_bf16(hs[pt][0], hs[pt][1]); wv.y = cvt_pk_bf16(hs[pt][2], hs[pt][3]);
                *(LAS u32x2*)(hT + (16 * pt + fr) * SP + 16 * wave + 4 * fq) = wv; }
        }
        __syncthreads();
    }
}

__device__ __forceinline__ void ssd_post_phase(const float* yssd, const bf16_t* projb, const float* norm_w, bf16_t* ymixb, const int gw, const int NGW, const int lane) {
    const int c0 = 16 * lane;
    f32x4 nw[4];
#pragma unroll
    for (int j = 0; j < 4; ++j) nw[j] = *(const f32x4*)(norm_w + c0 + 4 * j);
    for (int m = gw; m < M; m += NGW) {
        f32x4 y[4];
#pragma unroll
        for (int j = 0; j < 4; ++j) y[j] = *(const f32x4*)(yssd + (size_t)m * 1024 + c0 + 4 * j);
        const u32x4 z0 = *(const u32x4*)(projb + (size_t)m * PROJ_BLD + OFF_Z + c0), z1 = *(const u32x4*)(projb + (size_t)m * PROJ_BLD + OFF_Z + c0 + 8);
        const unsigned zw[8] = {z0.x, z0.y, z0.z, z0.w, z1.x, z1.y, z1.z, z1.w};
        float uu[16]; float ss = 0.f;
#pragma unroll
        for (int e = 0; e < 8; ++e) { uu[2 * e] = y[e >> 1][(2 * e) & 3] * fast_silu(bf_lo(zw[e])); uu[2 * e + 1] = y[e >> 1][(2 * e + 1) & 3] * fast_silu(bf_hi(zw[e])); ss += uu[2 * e] * uu[2 * e] + uu[2 * e + 1] * uu[2 * e + 1]; }
#pragma unroll
        for (int o = 1; o < 32; o <<= 1) ss += __shfl_xor(ss, o);
        const float rs = rsqrtf(ss * (1.f / 512.f) + 1e-5f);
        u32x4 w0, w1;
        w0.x = cvt_pk_bf16(uu[0] * rs * nw[0][0], uu[1] * rs * nw[0][1]); w0.y = cvt_pk_bf16(uu[2] * rs * nw[0][2], uu[3] * rs * nw[0][3]);
        w0.z = cvt_pk_bf16(uu[4] * rs * nw[1][0], uu[5] * rs * nw[1][1]); w0.w = cvt_pk_bf16(uu[6] * rs * nw[1][2], uu[7] * rs * nw[1][3]);
        w1.x = cvt_pk_bf16(uu[8] * rs * nw[2][0], uu[9] * rs * nw[2][1]); w1.y = cvt_pk_bf16(uu[10] * rs * nw[2][2], uu[11] * rs * nw[2][3]);
        w1.z = cvt_pk_bf16(uu[12] * rs * nw[3][0], uu[13] * rs * nw[3][1]); w1.w = cvt_pk_bf16(uu[14] * rs * nw[3][2], uu[15] * rs * nw[3][3]);
        *(u32x4*)(ymixb + (size_t)m * 2048 + c0) = w0; *(u32x4*)(ymixb + (size_t)m * 2048 + c0 + 8) = w1;
    }
}

#define PH_BEGIN int z_ = 0; asm volatile("" : "+s"(z_)); unsigned char* const wsq = P.ws + z_; int tid = tid0; asm volatile("" : "+v"(tid)); \
    const int G = G0 + z_, bx = bx0 + z_, vcu = vcu0 + z_, lane = tid & 63, wave = __builtin_amdgcn_readfirstlane(tid >> 6), gw = vcu * NWAVES + wave, NGW = G * NWAVES; (void)bx; (void)lane; (void)gw; (void)NGW; (void)wave;
#define INP(i) (P.in[(i) + z_])
#define Win_t ((bf16_t*)(wsq + WS_WIN))
#define Wout_t ((bf16_t*)(wsq + WS_WOUT))
#define Wffn ((bf16_t*)(wsq + WS_WFFN))
#define Wl_w ((bf16_t*)(wsq + WS_WLORA))
#define Wl_a (Wl_w + 1024 * 64)
#define Wl_g (Wl_a + 1024 * 64)
#define Wl_v (Wl_g + 1024 * 160)
#define xf ((float*)(wsq + WS_XF))
#define xb ((bf16_t*)(wsq + WS_XB))
#define projb ((bf16_t*)(wsq + WS_PROJB))
#define ymixb ((bf16_t*)(wsq + WS_YMIXB))
#define mixed ((float*)(wsq + WS_MIXED))
#define hbuf ((bf16_t*)(wsq + WS_HBUF))
#define xg ((bf16_t*)(wsq + WS_XG))
#define yslot ((float*)(wsq + WS_YSLOT))
#define xbcc ((bf16_t*)(wsq + WS_XBCC))
#define dtb ((float*)(wsq + WS_DTB))
#define yssd ((float*)(wsq + WS_YSSD))
#define lw ((bf16_t*)(wsq + WS_LW))
#define yrw ((float*)(wsq + WS_YRW))
#define bon ((float*)(wsq + WS_BON))
#define vfirst ((float*)(wsq + WS_VFIRST))
#define tok_e ((int*)(wsq + WS_TOK))
#define tok_pos (tok_e + 2 * M)
#define tok_g ((float*)(tok_pos + 2 * M))
#define tok_dest ((int*)(tok_g + 2 * M))
#define cnt ((int*)(wsq + WS_CTL) + CW_CNT + 8 * li)
__global__ void __launch_bounds__(NWAVES * 64, 2) fwd(Params P) {
    extern __shared__ __attribute__((aligned(16))) unsigned char lds_raw[];
    LAS unsigned char* lds = (LAS unsigned char*)lds_raw;
    volatile LAS unsigned* MISC = (volatile LAS unsigned*)(lds + MISC_OFF);
    const int tid0 = threadIdx.x;
    const int G0 = gridDim.x, bx0 = blockIdx.x;
    const int vcu0 = (G0 % 8 == 0) ? (bx0 % 8) * (G0 / 8) + bx0 / 8 : bx0;
    unsigned* ctl = (unsigned*)(P.ws + WS_CTL);
    if (tid0 < 64) MISC[tid0] = 0u;
    __syncthreads();
#if MK_LAUNCH_MODE == 1
    constexpr int lo = 0, hi = 64;
#else
    const int lo = P.ph_lo, hi = P.ph_hi;
#endif
    XcdBarrier bar; bar.bar = ctl + CW_BAR + P.bar_idx * XCD_BAR_WORDS; bar.x = 0; bar.st = MISC + 8;
    if (hi - lo > 1) bar = xcd_barrier_post(ctl + CW_BAR + P.bar_idx * XCD_BAR_WORDS, MISC + 8);
#define IN(k) (lo <= (k) && (k) < hi)
#define SEAM(k) do { if ((k) + 1 < hi) xcd_barrier(bar); } while (0)

    for (int l = 0; l < 4; ++l) {
        const int pb = l * 16, li = l >> 1; const bool moe = (l & 1) != 0;
        if (IN(pb + 0)) {
            PH_BEGIN
            LAS float* scr = (LAS float*)(lds + wave * 16384);
            cvt_job<0>(INP(1) + (size_t)l * D * IN_DIM, D, IN_DIM, Win_t, 0, 0, scr, gw, NGW, lane);
            if (l > 0) cvt_job<0>(INP(2) + (size_t)(l - 1) * D * 32, D, 32, Win_t, IN_DIM, 0, scr, gw, NGW, lane);
            { const int r0 = l > 0 ? IN_DIM + 32 : IN_DIM, nz = (PROJ_BLD - r0) * (D / 8);
              for (int i = bx * 512 + tid; i < nz; i += G * 512) *(u32x4*)(Win_t + (size_t)r0 * D + (size_t)i * 8) = (u32x4){0u, 0u, 0u, 0u}; }
            cvt_job<0>(INP(23) + (size_t)l * D * D, D, D, Wout_t, 0, 0, scr, gw, NGW, lane);
            cvt_job<0>(INP(12) + (size_t)l * 64 * 1024, 64, 1024, Wl_w, 0, 0, scr, gw, NGW, lane);
            cvt_job<0>(INP(14) + (size_t)l * 64 * 1024, 64, 1024, Wl_a, 0, 0, scr, gw, NGW, lane);
            cvt_job<0>(INP(17) + (size_t)l * 160 * 1024, 160, 1024, Wl_g, 0, 0, scr, gw, NGW, lane);
            if (l > 0) cvt_job<0>(INP(16) + (size_t)(l - 1) * 32 * 1024, 32, 1024, Wl_v, 0, 0, scr, gw, NGW, lane);
            if (l == 0) {
                const float* x = INP(0);
                for (size_t i = (size_t)bx * 512 + tid; i < (size_t)M * D / 8; i += (size_t)G * 512) {
                    const f32x4 a = *(const f32x4*)(x + i * 8), b = *(const f32x4*)(x + i * 8 + 4);
                    u32x4 w; w.x = cvt_pk_bf16(a[0], a[1]); w.y = cvt_pk_bf16(a[2], a[3]); w.z = cvt_pk_bf16(b[0], b[1]); w.w = cvt_pk_bf16(b[2], b[3]);
                    *(u32x4*)(xb + i * 8) = w; }
            }
            __syncthreads();
            SEAM(pb + 0);
        }
        if (IN(pb + 1)) {
            PH_BEGIN
            pg8::Gemm g{xb, Win_t, D}; pg8::StaticOrder S; S.init(M, PROJ_BLD, G, bx);
            pg8::EpiBf16 E{projb, PROJ_BLD};
            pg8::gemm_phase<pg8::EpiBf16, pg8::StaticOrder>(lds, g, S, E, tid);
#if (MK_DBL >> 1) & 1
            pg8::gemm_phase<pg8::EpiBf16, pg8::StaticOrder>(lds, g, S, E, tid);
#endif
            SEAM(pb + 1);
        }
        if (IN(pb + 2)) {
            PH_BEGIN
            lora_phase(lds, projb, INP(9) + (size_t)l * RW_SHIFT, INP(10) + (size_t)(l > 0 ? l - 1 : 0) * 32, Wl_w, Wl_a, Wl_g, Wl_v, lw, l > 0, vcu, G, tid);
#if (MK_DBL >> 2) & 1
            lora_phase(lds, projb, INP(9) + (size_t)l * RW_SHIFT, INP(10) + (size_t)(l > 0 ? l - 1 : 0) * 32, Wl_w, Wl_a, Wl_g, Wl_v, lw, l > 0, vcu, G, tid);
#endif
            ssd_conv_phase(projb, INP(3) + (size_t)l * 4 * CONV_DIM, INP(4) + (size_t)l * CONV_DIM, INP(5) + l * SSD_H, xbcc, dtb, vcu, G, tid);
#if (MK_DBL >> 11) & 1
            ssd_conv_phase(projb, INP(3) + (size_t)l * 4 * CONV_DIM, INP(4) + (size_t)l * CONV_DIM, INP(5) + l * SSD_H, xbcc, dtb, vcu, G, tid);
#endif
            SEAM(pb + 2);
        }
        if (IN(pb + 3)) {
            PH_BEGIN
            RwScan a; a.proj_ = projb; a.lw_ = lw; a.mix = INP(9) + (size_t)l * RW_SHIFT; a.w0 = INP(11) + l * 1024; a.a0 = INP(13) + l * 1024; a.v0 = INP(15) + (l > 0 ? l - 1 : 0) * 1024;
            a.k_k = INP(18) + l * 1024; a.k_a = INP(19) + l * 1024; a.r_k = INP(20) + l * 1024; a.vf_ = vfirst; a.y_ = yrw; a.bon_ = bon; a.layer = l; a.pad = 0;
            rwkv_scan_phase(lds, a, vcu, G, tid);
#if (MK_DBL >> 3) & 1
            rwkv_scan_phase(lds, a, vcu, G, tid);
#endif
            ssd_scan_phase(lds, xbcc, dtb, INP(6) + l * SSD_H, INP(7) + l * SSD_H, yssd, vcu, G, tid);
#if (MK_DBL >> 10) & 1
            ssd_scan_phase(lds, xbcc, dtb, INP(6) + l * SSD_H, INP(7) + l * SSD_H, yssd, vcu, G, tid);
#endif
            SEAM(pb + 3);
        }
        if (IN(pb + 4)) {
            PH_BEGIN
            rwkv_post_phase(yrw, bon, lw + (size_t)2 * M * 1024, INP(21) + l * 1024, INP(22) + l * 1024, ymixb, gw, NGW, lane);
#if (MK_DBL >> 4) & 1
            rwkv_post_phase(yrw, bon, lw + (size_t)2 * M * 1024, INP(21) + l * 1024, INP(22) + l * 1024, ymixb, gw, NGW, lane);
#endif
            ssd_post_phase(yssd, projb, INP(8) + l * 1024, ymixb, gw, NGW, lane);
#if (MK_DBL >> 4) & 1
            ssd_post_phase(yssd, projb, INP(8) + l * 1024, ymixb, gw, NGW, lane);
#endif
            SEAM(pb + 4);
        }
        if (IN(pb + 5)) {
            PH_BEGIN
            pg8::Gemm g{ymixb, Wout_t, D}; pg8::StaticOrder S; S.init(M, D, G, bx);
            pg8::EpiBf16 E{(bf16_t*)mixed, FLD};
            pg8::gemm_phase<pg8::EpiBf16, pg8::StaticOrder>(lds, g, S, E, tid);
#if (MK_DBL >> 5) & 1
            pg8::gemm_phase<pg8::EpiBf16, pg8::StaticOrder>(lds, g, S, E, tid);
#endif
            SEAM(pb + 5);
        }
        if (IN(pb + 6)) {
            PH_BEGIN
            const float* xin = (l == 0) ? INP(0) : xf;
            const float* gam = INP(24) + l * D; const float* bet = INP(25) + l * D;
            LAS float* rs = (LAS float*)lds;
            if (moe) { const float* router = INP(31) + (size_t)li * D * NE;
                for (int i = tid; i < D * NE; i += 512) rs[(i & 7) * D + (i >> 3)] = router[i];
                __syncthreads(); }
            for (int m = gw; m < M; m += NGW) {
                f32x4 v[8];
#pragma unroll
                for (int j = 0; j < 8; ++j) { const size_t o = (size_t)m * D + 4 * lane + 256 * j; const u32x2 mw = *(const u32x2*)((const bf16_t*)mixed + (size_t)m * FLD + 4 * lane + 256 * j); v[j] = ALPHA * *(const f32x4*)(xin + o) + (f32x4){bf_lo(mw.x), bf_hi(mw.x), bf_lo(mw.y), bf_hi(mw.y)}; }
                ln_finish(v, gam, bet, lane, xf + (size_t)m * D, xb + (size_t)m * D);
                if (moe) {
                    float lg[8];
#pragma unroll
                    for (int e = 0; e < 8; ++e) { float s = 0.f;
#pragma unroll
                        for (int j = 0; j < 8; ++j) { const f32x4 r = *(const LAS f32x4*)(rs + e * D + 4 * lane + 256 * j); s += (v[j][0] * r[0] + v[j][1] * r[1]) + (v[j][2] * r[2] + v[j][3] * r[3]); }
                        lg[e] = wave_sum_f(s); }
                    if (lane == 0) {
                        int i0 = 0; float v0 = lg[0];
#pragma unroll
                        for (int e = 1; e < 8; ++e) if (lg[e] > v0) { v0 = lg[e]; i0 = e; }
                        int i1 = -1; float v1 = -3.4e38f;
#pragma unroll
                        for (int e = 0; e < 8; ++e) if (e != i0 && lg[e] > v1) { v1 = lg[e]; i1 = e; }
                        const float e1 = expf(v1 - v0);
                        tok_e[2 * m] = i0; tok_e[2 * m + 1] = i1; tok_g[2 * m] = 1.f / (1.f + e1); tok_g[2 * m + 1] = e1 / (1.f + e1);
                        tok_pos[2 * m] = atomicAdd(&cnt[i0], 1); tok_pos[2 * m + 1] = atomicAdd(&cnt[i1], 1);
                    }
                }
            }
            __syncthreads();
            SEAM(pb + 6);
        }
        if (IN(pb + 7)) {
            PH_BEGIN
            LAS float* scr = (LAS float*)(lds + wave * 16384);
            if (!moe) {
                cvt_job<1>(INP(28) + (size_t)li * D * DFF, D, DFF, Wffn, 0, 0, scr, gw, NGW, lane);
                cvt_job<1>(INP(29) + (size_t)li * D * DFF, D, DFF, Wffn, 0, 1, scr, gw, NGW, lane);
                cvt_job<0>(INP(30) + (size_t)li * DFF * D, DFF, D, Wffn + (size_t)2 * DFF * D, 0, 0, scr, gw, NGW, lane);
            } else {
                for (int e = 0; e < NE; ++e) {
                    cvt_job<1>(INP(32) + ((size_t)li * NE + e) * D * DFE, D, DFE, Wffn, e * 2 * DFE, 0, scr, gw, NGW, lane);
                    cvt_job<1>(INP(33) + ((size_t)li * NE + e) * D * DFE, D, DFE, Wffn, e * 2 * DFE, 1, scr, gw, NGW, lane);
                    cvt_job<0>(INP(34) + ((size_t)li * NE + e) * DFE * D, DFE, D, Wffn + (size_t)NE * 2 * DFE * D, e * D, 0, scr, gw, NGW, lane);
                }
                int start[8]; { int acc = 0;
#pragma unroll
                    for (int e = 0; e < 8; ++e) { start[e] = acc; acc += ((cnt[e] + 255) >> 8) << 8; } }
                for (int m = gw; m < M; m += NGW) {
                    u32x4 r[4];
#pragma unroll
                    for (int j = 0; j < 4; ++j) r[j] = *(const u32x4*)(xb + (size_t)m * D + 8 * lane + 512 * j);
#pragma unroll
                    for (int s = 0; s < 2; ++s) {
                        const int e = tok_e[2 * m + s], pos = tok_pos[2 * m + s];
                        int st = 0;
#pragma unroll
                        for (int q = 0; q < 8; ++q) st = (e == q) ? start[q] : st;
                        const int dest = st + pos;
#pragma unroll
                        for (int j = 0; j < 4; ++j) *(u32x4*)(xg + (size_t)dest * D + 8 * lane + 512 * j) = r[j];
                        if (lane == 0) tok_dest[2 * m + s] = dest;
                    }
                }
            }
            __syncthreads();
            SEAM(pb + 7);
        }
        if (IN(pb + 8)) {
            PH_BEGIN
            if (!moe) {
                pg8::Gemm g{xb, Wffn, D}; pg8::StaticOrder S; S.init(M, 2 * DFF, G, bx);
                pg8::EpiSwiglu E{hbuf, DFF};
                pg8::gemm_phase<pg8::EpiSwiglu, pg8::StaticOrder>(lds, g, S, E, tid);
#if (MK_DBL >> 8) & 1
                pg8::gemm_phase<pg8::EpiSwiglu, pg8::StaticOrder>(lds, g, S, E, tid);
#endif
            } else {
                pg8::Gemm g{xg, Wffn, D}; pg8::GroupedOrder S; S.init(cnt, 2 * DFE, G, bx);
                pg8::EpiSwiglu E{hbuf, DFE};
                pg8::gemm_phase<pg8::EpiSwiglu, pg8::GroupedOrder>(lds, g, S, E, tid);
#if (MK_DBL >> 8) & 1
                pg8::gemm_phase<pg8::EpiSwiglu, pg8::GroupedOrder>(lds, g, S, E, tid);
#endif
            }
            SEAM(pb + 8);
        }
        if (IN(pb + 9)) {
            PH_BEGIN
            if (!moe) {
                pg8::Gemm g{hbuf, Wffn + (size_t)2 * DFF * D, DFF}; pg8::StaticOrder S; S.init(M, D, G, bx);
                pg8::EpiF32 E{yslot, FLD};
                pg8::gemm_phase<pg8::EpiF32, pg8::StaticOrder>(lds, g, S, E, tid);
#if (MK_DBL >> 9) & 1
                pg8::gemm_phase<pg8::EpiF32, pg8::StaticOrder>(lds, g, S, E, tid);
#endif
#if (MK_DBL >> 5) & 1
            pg8::gemm_phase<pg8::EpiF32, pg8::StaticOrder>(lds, g, S, E, tid);
#endif
            } else {
                pg8::Gemm g{hbuf, Wffn + (size_t)NE * 2 * DFE * D, DFE}; pg8::GroupedOrder S; S.init(cnt, D, G, bx);
                pg8::EpiF32 E{yslot, FLD};
                pg8::gemm_phase<pg8::EpiF32, pg8::GroupedOrder>(lds, g, S, E, tid);
#if (MK_DBL >> 9) & 1
                pg8::gemm_phase<pg8::EpiF32, pg8::GroupedOrder>(lds, g, S, E, tid);
#endif
            }
            SEAM(pb + 9);
        }
        if (IN(pb + 10)) {
            PH_BEGIN
            const float* gam = INP(26) + l * D; const float* bet = INP(27) + l * D;
            float* dst = (l == 3) ? P.out : xf;
            for (int m = gw; m < M; m += NGW) {
                f32x4 v[8];
                if (!moe) {
#pragma unroll
                    for (int j = 0; j < 8; ++j) { const size_t o = (size_t)m * D + 4 * lane + 256 * j; v[j] = ALPHA * *(const f32x4*)(xf + o) + *(const f32x4*)(yslot + (size_t)m * FLD + 4 * lane + 256 * j); }
                } else {
                    const int d0 = tok_dest[2 * m], d1 = tok_dest[2 * m + 1]; const float g0 = tok_g[2 * m], g1 = tok_g[2 * m + 1];
#pragma unroll
                    for (int j = 0; j < 8; ++j) { const int c = 4 * lane + 256 * j;
                        v[j] = ALPHA * *(const f32x4*)(xf + (size_t)m * D + c) + g0 * *(const f32x4*)(yslot + (size_t)d0 * FLD + c) + g1 * *(const f32x4*)(yslot + (size_t)d1 * FLD + c); }
                }
                ln_finish(v, gam, bet, lane, dst + (size_t)m * D, (l == 3) ? (bf16_t*)nullptr : xb + (size_t)m * D);
            }
            SEAM(pb + 10);
        }
    }
#undef IN
#undef SEAM
}
#undef PH_BEGIN
#undef INP
#undef Win_t
#undef Wout_t
#undef Wffn
#undef Wl_w
#undef Wl_a
#undef Wl_g
#undef Wl_v
#undef xf
#undef xb
#undef projb
#undef ymixb
#undef mixed
#undef hbuf
#undef xg
#undef yslot
#undef xbcc
#undef dtb
#undef yssd
#undef lw
#undef yrw
#undef bon
#undef vfirst
#undef tok_e
#undef tok_pos
#undef tok_g
#undef tok_dest
#undef cnt


}

extern "C" void kernel_launch(void* const* d_in, const int* in_sizes, int n_in, void* d_out, int out_size, void* d_ws, size_t ws_size, hipStream_t stream) {
    (void)in_sizes; (void)out_size;
    static int grid = 0;
    if (grid == 0) {
        if (n_in != 35 || ws_size < WS_END) { fprintf(stderr, "kernel_launch: need 35 inputs and %zu bytes of workspace (got %d, %zu)\n", (size_t)WS_END, n_in, ws_size); grid = -1; return; }
        int dev = 0, cus = 0;
        if (hipGetDevice(&dev) != hipSuccess || hipDeviceGetAttribute(&cus, hipDeviceAttributeMultiprocessorCount, dev) != hipSuccess) { grid = -1; return; }
        if (hipFuncSetAttribute((const void*)fwd, hipFuncAttributeMaxDynamicSharedMemorySize, LDS_BYTES) != hipSuccess) { fprintf(stderr, "kernel_launch: hipFuncSetAttribute failed\n"); grid = -1; return; }
        int per_cu = 0;
        if (hipOccupancyMaxActiveBlocksPerMultiprocessor(&per_cu, (const void*)fwd, NWAVES * 64, LDS_BYTES) != hipSuccess || per_cu < 1) { fprintf(stderr, "kernel_launch: occupancy query says %d blocks per CU\n", per_cu); }
        (void)hipGetLastError();
        grid = cus;
    }
    if (grid < 0) return;
    unsigned char* ws = (unsigned char*)d_ws;
    (void)hipMemsetAsync(ws + WS_CTL, 0, CTL_BYTES, stream);
    Params P{};
    for (int i = 0; i < 35; ++i) P.in[i] = (const float*)d_in[i];
    P.out = (float*)d_out; P.ws = ws; P.pad = 0;
    int nbar = 0;
    auto run = [&](int lo, int hi) {
        P.ph_lo = lo; P.ph_hi = hi; P.bar_idx = (hi - lo > 1) ? nbar++ : 0;
        hipLaunchKernelGGL(fwd, dim3(grid), dim3(NWAVES * 64), LDS_BYTES, stream, P);
    };
    if (MK_LAUNCH_MODE == 1) run(0, 64);
    else if (MK_LAUNCH_MODE == 4) { for (int l = 0; l < 4; ++l) run(l * 16, l * 16 + 16); }
    else { for (int l = 0; l < 4; ++l) for (int k = 0; k <= 10; ++k) run(l * 16 + k, l * 16 + k + 1); }
}
```

```cpp
#define MK_DBL 0
#include <hip/hip_runtime.h>
#include <cstdint>
#include <cstdio>

#ifndef MK_DBL
#define MK_DBL 0
#endif
#ifndef MK_LAUNCH_MODE
#define MK_LAUNCH_MODE 1
#endif
namespace {
constexpr int BATCH = 8, SEQ = 2048, M = BATCH * SEQ, D = 2048;
constexpr int HD = 64, SSD_H = 16, SSD_N = 128, CONV_DIM = 1536;
constexpr int RW_H = 16;
constexpr int IN_DIM = 5936, PROJ_LD = 5968;
constexpr int OFF_Z = 0, OFF_XBC = 1024, OFF_DT = 2560, OFF_RW = 2576, OFF_R = 2576, OFF_K = 3600, OFF_V = 4624, OFF_WLO = 5648, OFF_ALO = 5712, OFF_GLO = 5776, OFF_VLO = 5936;
constexpr int RW_SHIFT = 3360;
constexpr int DFF = 5632, NE = 8, DFE = 2816;
constexpr float ALPHA = 1.681792830507429f;
constexpr int LORA_LD = 320;

__device__ __forceinline__ float sigmoidf_(float x) { return 1.f / (1.f + expf(-x)); }
__device__ __forceinline__ float siluf_(float x) { return x / (1.f + expf(-x)); }
__device__ __forceinline__ float softplusf_(float x) { return fmaxf(x, 0.f) + log1pf(expf(-fabsf(x))); }
__device__ __forceinline__ float wave_sum(float v) {
#pragma unroll
    for (int o = 32; o >= 1; o >>= 1) v += __shfl_xor(v, o);
    return v;
}


#define LAS __attribute__((address_space(3)))
typedef unsigned short bf16_t;
typedef short bf16x8 __attribute__((ext_vector_type(8)));
typedef float f32x4 __attribute__((ext_vector_type(4)));
typedef float f32x2 __attribute__((ext_vector_type(2)));
typedef unsigned u32x4 __attribute__((ext_vector_type(4)));
typedef unsigned u32x2 __attribute__((ext_vector_type(2)));

__device__ __forceinline__ unsigned cvt_pk_bf16(float lo, float hi) { unsigned r; asm volatile("v_cvt_pk_bf16_f32 %0, %1, %2" : "=v"(r) : "v"(lo), "v"(hi)); return r; }
__device__ __forceinline__ float bf_lo(unsigned w) { return __uint_as_float(w << 16); }
__device__ __forceinline__ float bf_hi(unsigned w) { return __uint_as_float(w & 0xffff0000u); }
__device__ __forceinline__ float bf2f(bf16_t b) { return __uint_as_float(((unsigned)b) << 16); }
__device__ __forceinline__ float fast_silu(float x) { return x * __builtin_amdgcn_rcpf(1.f + __builtin_amdgcn_exp2f(-1.4426950408889634f * x)); }

namespace pg8 {
constexpr int BM = 256, BK = 64, HALF = 128, HTB = HALF * BK * 2, STAGE_BYTES = 8 * HTB, NXCD = 8, WGM = 8;
__host__ __device__ __forceinline__ int lds_byte(int r, int c) { const int st = (r >> 4) * 2 + (c >> 5), rr = r & 15, cc = c & 31, ob = rr * 64 + cc * 2; return st * 1024 + (ob ^ (((ob >> 9) & 1) << 5)); }
__host__ __device__ __forceinline__ void stage_rc(int b, int& R, int& C) { const int st = b / 1024, sb = b % 1024, swz = sb ^ (((sb >> 9) & 1) << 5); R = (st >> 1) * 16 + swz / 64; C = (st & 1) * 32 + (swz % 64) / 2; }
__host__ __device__ __forceinline__ int perm32(int rho) { const int n = rho >> 4, i = rho & 15; return 8 * (i >> 2) + 4 * n + (i & 3); }

struct Unit { int pm, pn, pb; };
struct Gemm { const bf16_t* A; const bf16_t* Bt; int K; };

__device__ __forceinline__ void decode_unit(int wgid, int nM, int nN, int& pm, int& pn) {
    const int nwg = nM * nN;
    { const int q = nwg / NXCD, r = nwg % NXCD, xcd = wgid % NXCD, off = wgid / NXCD; wgid = (xcd < r ? xcd * (q + 1) : r * (q + 1) + (xcd - r) * q) + off; }
    const int nig = WGM * nN, gid = wgid / nig, fm = gid * WGM, gsz = (nM - fm) < WGM ? (nM - fm) : WGM;
    pm = fm + ((wgid % nig) % gsz); pn = (wgid % nig) / gsz;
}
struct StaticOrder {
    int nM, nN, nwg, G, c;
    __device__ void init(int Mrows, int N, int G_, int c_) { nM = Mrows / BM; nN = N / BM; nwg = nM * nN; G = G_; c = c_; }
    __device__ __forceinline__ bool next(int i, Unit& u) const {
        const long L = (long)i * G + c; if (L >= nwg) return false;
        decode_unit((int)L, nM, nN, u.pm, u.pn); u.pb = u.pn; return true;
    }
};
struct RepeatOrder : StaticOrder {
    int per, reps;
    __device__ void init2(int Mrows, int N, int G_, int c_, int reps_) { init(Mrows, N, G_, c_); per = (nwg + G - 1) / G; reps = reps_; }
    __device__ __forceinline__ bool next(int i, Unit& u) const { if (i >= per * reps) return false; return StaticOrder::next(i % per, u); }
};
struct GroupedOrder {
    int nM, nN, nwg, G, c; int cum[9];
    __device__ void init(const int* cnt, int N, int G_, int c_) {
        int acc = 0;
#pragma unroll
        for (int e = 0; e < 8; ++e) { cum[e] = acc; acc += (cnt[e] + 255) >> 8; }
        cum[8] = acc; nM = acc; nN = N / BM; nwg = nM * nN; G = G_; c = c_;
    }
    __device__ __forceinline__ bool next(int i, Unit& u) const {
        const long L = (long)i * G + c; if (L >= nwg) return false;
        decode_unit((int)L, nM, nN, u.pm, u.pn);
        int e = 0;
#pragma unroll
        for (int q = 1; q < 8; ++q) e += (u.pm >= cum[q]) ? 1 : 0;
        u.pb = e * nN + u.pn; return true;
    }
};

struct EpiF32 {
    static constexpr bool PERM = false;
    float* C; int ldc;
    __device__ __forceinline__ void operator()(const f32x4 (&acc)[2][2][4][2], const Unit& u, int wr, int wc, int fr, int fq) const {
        const int row0 = u.pm * BM + wr * 64 + fr, col0 = u.pn * BM + wc * 32 + 4 * fq;
#pragma unroll
        for (int ai = 0; ai < 2; ++ai)
#pragma unroll
            for (int m = 0; m < 4; ++m) { float* rowp = C + (size_t)(row0 + ai * HALF + m * 16) * ldc + col0;
#pragma unroll
                for (int bj = 0; bj < 2; ++bj)
#pragma unroll
                    for (int n = 0; n < 2; ++n) *(f32x4*)(rowp + bj * HALF + n * 16) = acc[ai][bj][m][n]; }
    }
};
struct EpiBf16 {
    static constexpr bool PERM = true;
    bf16_t* O; int ldc;
    __device__ __forceinline__ void operator()(const f32x4 (&acc)[2][2][4][2], const Unit& u, int wr, int wc, int fr, int fq) const {
        const int row0 = u.pm * BM + wr * 64 + fr, col0 = u.pn * BM + wc * 32 + 8 * fq;
#pragma unroll
        for (int ai = 0; ai < 2; ++ai)
#pragma unroll
            for (int m = 0; m < 4; ++m) { bf16_t* rowp = O + (size_t)(row0 + ai * HALF + m * 16) * ldc + col0;
#pragma unroll
                for (int bj = 0; bj < 2; ++bj) { const f32x4 v0 = acc[ai][bj][m][0], v1 = acc[ai][bj][m][1];
                    u32x4 w; w.x = cvt_pk_bf16(v0[0], v0[1]); w.y = cvt_pk_bf16(v0[2], v0[3]); w.z = cvt_pk_bf16(v1[0], v1[1]); w.w = cvt_pk_bf16(v1[2], v1[3]);
                    *(u32x4*)(rowp + bj * HALF) = w; } }
    }
};
struct EpiSwiglu {
    static constexpr bool PERM = true;
    bf16_t* O; int ldc;
    __device__ __forceinline__ void operator()(const f32x4 (&acc)[2][2][4][2], const Unit& u, int wr, int wc, int fr, int fq) const {
        const int row0 = u.pm * BM + wr * 64 + fr, col0 = u.pn * HALF + wc * 32 + 8 * fq;
#pragma unroll
        for (int ai = 0; ai < 2; ++ai)
#pragma unroll
            for (int m = 0; m < 4; ++m) { bf16_t* rowp = O + (size_t)(row0 + ai * HALF + m * 16) * ldc + col0;
                float o[8];
#pragma unroll
                for (int n = 0; n < 2; ++n)
#pragma unroll
                    for (int i = 0; i < 4; ++i) o[n * 4 + i] = fast_silu(acc[ai][0][m][n][i]) * acc[ai][1][m][n][i];
                u32x4 w; w.x = cvt_pk_bf16(o[0], o[1]); w.y = cvt_pk_bf16(o[2], o[3]); w.z = cvt_pk_bf16(o[4], o[5]); w.w = cvt_pk_bf16(o[6], o[7]);
                *(u32x4*)rowp = w; }
    }
};

template <class Epi, class Sched>
__device__ __forceinline__ void gemm_phase(LAS unsigned char* lds, const Gemm g, const Sched& S, const Epi& E, const int tid) {
    const int wid = __builtin_amdgcn_readfirstlane(tid >> 6), lane = tid & 63, wr = wid >> 2, wc = wid & 3, fr = lane & 15, fq = lane >> 4;
    const int K = g.K, nt = K / BK;
    unsigned voffA[2], voffB[2];
#pragma unroll
    for (int i = 0; i < 2; ++i) { int R, C; stage_rc(tid * 16 + i * 8192, R, C); const int Rb = Epi::PERM ? ((R & ~31) + perm32(R & 31)) : R;
        voffA[i] = (unsigned)(R * K + C) * 2u; voffB[i] = (unsigned)(Rb * K + C) * 2u; }
    const size_t kstep = (size_t)(BK * 2);
    const size_t hstep = (size_t)HALF * K * 2;
    const size_t tstep = 2 * hstep;
    const unsigned ldsw = (unsigned)wid * 1024u;
    const int aoff = lds_byte(wr * 64 + fr, fq * 8), boff = lds_byte(wc * 32 + fr, fq * 8);
#define PG8_SA(b, h) (((b) * 2 + (h)) * HTB)
#define PG8_SB(b, h) ((4 + (b) * 2 + (h)) * HTB)
#define PG8_STAGE(bufoff, gbase, voff) do { _Pragma("unroll") for (int _i = 0; _i < 2; ++_i) \
        __builtin_amdgcn_global_load_lds((const unsigned*)((const char*)(gbase) + (voff)[_i]), (LAS unsigned*)(lds + (bufoff) + ldsw + _i * 8192), 16, 0, 0); } while (0)
#define PG8_LDA(dst, b, h) do { _Pragma("unroll") for (int m = 0; m < 4; ++m) _Pragma("unroll") for (int k = 0; k < 2; ++k) dst[m][k] = *(const LAS bf16x8*)(lds + PG8_SA(b, h) + aoff + m * 2048 + k * 1024); } while (0)
#define PG8_LDB(dst, b, h) do { _Pragma("unroll") for (int n = 0; n < 2; ++n) _Pragma("unroll") for (int k = 0; k < 2; ++k) dst[n][k] = *(const LAS bf16x8*)(lds + PG8_SB(b, h) + boff + n * 2048 + k * 1024); } while (0)
#define PG8_MMA(ai, bj, At, Bt) do { __builtin_amdgcn_s_setprio(1); _Pragma("unroll") for (int m = 0; m < 4; ++m) _Pragma("unroll") for (int n = 0; n < 2; ++n) _Pragma("unroll") for (int k = 0; k < 2; ++k) \
        acc[ai][bj][m][n] = __builtin_amdgcn_mfma_f32_16x16x32_bf16(Bt[n][k], At[m][k], acc[ai][bj][m][n], 0, 0, 0); __builtin_amdgcn_s_setprio(0); } while (0)
#define PG8_WAIT_V(n) asm volatile("s_waitcnt vmcnt(" #n ")" ::: "memory")
#define PG8_WAIT_L(n) asm volatile("s_waitcnt lgkmcnt(" #n ")" ::: "memory")
#define PG8_BAR __builtin_amdgcn_s_barrier()
#define PG8_SCHED __builtin_amdgcn_sched_barrier(0)
    Unit cur, nxt; int ui = 0;
    if (!S.next(0, cur)) return;
    f32x4 acc[2][2][4][2];
#pragma unroll
    for (int a = 0; a < 2; ++a)
#pragma unroll
        for (int b = 0; b < 2; ++b)
#pragma unroll
            for (int m = 0; m < 4; ++m)
#pragma unroll
                for (int n = 0; n < 2; ++n) acc[a][b][m][n] = (f32x4){0.f, 0.f, 0.f, 0.f};
    bf16x8 At[4][2], B0[2][2], B1[2][2];
    const char* cA = (const char*)g.A + (size_t)cur.pm * tstep; const char* cB = (const char*)g.Bt + (size_t)cur.pb * tstep;
    PG8_STAGE(PG8_SB(0, 0), cB, voffB); PG8_STAGE(PG8_SB(0, 1), cB + hstep, voffB); PG8_STAGE(PG8_SA(0, 0), cA, voffA); PG8_STAGE(PG8_SA(0, 1), cA + hstep, voffA);
    if (wr == 1) PG8_BAR;
    PG8_WAIT_V(2); PG8_BAR;
    PG8_STAGE(PG8_SB(1, 0), cB + kstep, voffB); PG8_STAGE(PG8_SA(1, 0), cA + kstep, voffA); PG8_STAGE(PG8_SB(1, 1), cB + hstep + kstep, voffB);
    PG8_WAIT_V(6); PG8_BAR;
    for (;;) {
        const bool has_next = S.next(ui + 1, nxt);
        const char* nA = has_next ? (const char*)g.A + (size_t)nxt.pm * tstep : cA; const char* nB = has_next ? (const char*)g.Bt + (size_t)nxt.pb * tstep : cB;
        for (int t = 0; t < nt; t += 2) {
            const bool last = (t == nt - 2);
            const char* a1 = cA + (size_t)(t + 1) * kstep;
            const char* a2 = last ? nA : cA + (size_t)(t + 2) * kstep; const char* b2 = last ? nB : cB + (size_t)(t + 2) * kstep;
            const char* a3 = a2 + kstep; const char* b3 = b2 + kstep;
            PG8_LDB(B0, 0, 0); PG8_LDB(B1, 0, 1); PG8_SCHED; PG8_LDA(At, 0, 0); PG8_STAGE(PG8_SA(1, 1), a1 + hstep, voffA);
            PG8_WAIT_V(8); PG8_WAIT_L(0); PG8_BAR; PG8_MMA(0, 0, At, B0); PG8_MMA(0, 1, At, B1); PG8_BAR; PG8_SCHED;
            PG8_LDA(At, 0, 1); PG8_STAGE(PG8_SB(0, 0), b2, voffB); PG8_STAGE(PG8_SB(0, 1), b2 + hstep, voffB); PG8_STAGE(PG8_SA(0, 0), a2, voffA);
            PG8_WAIT_V(8); PG8_WAIT_L(0); PG8_BAR; PG8_MMA(1, 0, At, B0); PG8_MMA(1, 1, At, B1); PG8_BAR; PG8_SCHED;
            PG8_LDB(B0, 1, 0); PG8_LDB(B1, 1, 1); PG8_SCHED; PG8_LDA(At, 1, 0); PG8_STAGE(PG8_SA(0, 1), a2 + hstep, voffA);
            PG8_WAIT_V(8); PG8_WAIT_L(0); PG8_BAR; PG8_MMA(0, 0, At, B0); PG8_MMA(0, 1, At, B1); PG8_BAR; PG8_SCHED;
            PG8_LDA(At, 1, 1); PG8_STAGE(PG8_SB(1, 0), b3, voffB); PG8_STAGE(PG8_SB(1, 1), b3 + hstep, voffB); PG8_STAGE(PG8_SA(1, 0), a3, voffA);
            PG8_WAIT_V(8); PG8_WAIT_L(0); PG8_BAR; PG8_MMA(1, 0, At, B0); PG8_MMA(1, 1, At, B1); PG8_BAR; PG8_SCHED;
        }
        if (wr == 0) PG8_BAR;
        E(acc, cur, wr, wc, fr, fq);
        if (!has_next) break;
#pragma unroll
        for (int a = 0; a < 2; ++a)
#pragma unroll
            for (int b = 0; b < 2; ++b)
#pragma unroll
                for (int m = 0; m < 4; ++m)
#pragma unroll
                    for (int n = 0; n < 2; ++n) acc[a][b][m][n] = (f32x4){0.f, 0.f, 0.f, 0.f};
        cur = nxt; cA = nA; cB = nB; ++ui;
        if (wr == 1) PG8_BAR;
    }
    PG8_WAIT_V(0);
    PG8_BAR;
#undef PG8_SA
#undef PG8_SB
#undef PG8_STAGE
#undef PG8_LDA
#undef PG8_LDB
#undef PG8_MMA
#undef PG8_WAIT_V
#undef PG8_WAIT_L
#undef PG8_BAR
#undef PG8_SCHED
}
}

#define XB_TMO      128
#define XB_XCNT(j)  (256  + 64 * (j))
#define XB_XSUB(j)  (1280 + 64 * (j))
#define XB_XGEN(j)  (2304 + 64 * (j))
#define XB_TOP      3328
#define XB_TOPGEN   3392
#define XCD_BAR_WORDS 3456
#define XB_SPIN_CAP (1u << 18)
__device__ __forceinline__ unsigned xb_ld(unsigned* p)              { return __hip_atomic_load(p, __ATOMIC_RELAXED, __HIP_MEMORY_SCOPE_AGENT); }
__device__ __forceinline__ unsigned xb_add(unsigned* p, unsigned v) { return __hip_atomic_fetch_add(p, v, __ATOMIC_RELAXED, __HIP_MEMORY_SCOPE_AGENT); }
__device__ __forceinline__ unsigned xb_xcc_id() { return (unsigned)__builtin_amdgcn_s_getreg((3 << 11) | 20) & 0xFu; }
#define XB_SPIN(cond, bar) do { unsigned _sp = 0; while (cond) { __builtin_amdgcn_s_sleep(1); \
    if ((++_sp & 255u) == 0u) { if (xb_ld(&(bar)[XB_TMO])) break; if (_sp > XB_SPIN_CAP) { atomicAdd(&(bar)[XB_TMO], 1u); break; } } } } while (0)
struct XcdBarrier { unsigned* bar; unsigned x; volatile LAS unsigned* st; };
__device__ __forceinline__ XcdBarrier xcd_barrier_post(unsigned* bar, volatile LAS unsigned* st) {
    XcdBarrier b; b.bar = bar; b.x = xb_xcc_id(); b.st = st;
    if (threadIdx.x == 0) (void)xb_add(&bar[XB_XCNT(b.x)], 1u);
    return b;
}
__device__ __forceinline__ void xcd_barrier_complete(unsigned* bar, unsigned x, unsigned& nloc, unsigned& nx) {
    const unsigned G = gridDim.x * gridDim.y * gridDim.z;
    asm volatile("" : "+s"(x));
    unsigned sum, cnt, mine, sp = 0u;
    for (;;) {
        sum = 0u; cnt = 0u; mine = 0u;
#pragma unroll
        for (unsigned j = 0; j < 16; ++j) { const unsigned c = xb_ld(&bar[XB_XCNT(j)]); sum += c; cnt += (c > 0u) ? 1u : 0u; mine = (j == x) ? c : mine; }
        if (sum == G) break;
        __builtin_amdgcn_s_sleep(1);
        if ((++sp & 255u) == 0u) { if (xb_ld(&bar[XB_TMO])) break; if (sp > XB_SPIN_CAP) { atomicAdd(&bar[XB_TMO], 1u); break; } }
    }
    nloc = mine > 0u ? mine : 1u; nx = cnt > 0u ? cnt : 1u;
}
__device__ __forceinline__ void xcd_barrier(const XcdBarrier& b) {
    asm volatile("s_waitcnt vmcnt(0)" ::: "memory");
    __syncthreads();
    if (threadIdx.x == 0) {
        unsigned* bar = b.bar;
        __builtin_amdgcn_s_waitcnt(0);
        unsigned nloc = b.st[0], nx = b.st[1];
        if (nloc == 0u) { xcd_barrier_complete(bar, b.x, nloc, nx); b.st[0] = nloc; b.st[1] = nx; }
        const unsigned old = xb_add(&bar[XB_XSUB(b.x)], 1u);
        const unsigned gen = old / nloc;
        if (old + 1u == (gen + 1u) * nloc) {
            __builtin_amdgcn_fence(__ATOMIC_RELEASE, "agent");
            asm volatile("s_waitcnt vmcnt(0)" ::: "memory");
            const unsigned og = xb_add(&bar[XB_TOP], 1u);
            const unsigned tg = og / nx;
            if (og + 1u == (tg + 1u) * nx) xb_add(&bar[XB_TOPGEN], 1u);
            else XB_SPIN(xb_ld(&bar[XB_TOPGEN]) == tg, bar);
            __builtin_amdgcn_fence(__ATOMIC_ACQUIRE, "agent");
            xb_add(&bar[XB_XGEN(b.x)], 1u);
            asm volatile("s_waitcnt vmcnt(0)" ::: "memory");
        } else {
            XB_SPIN(xb_ld(&bar[XB_XGEN(b.x)]) == gen, bar);
            __builtin_amdgcn_fence(__ATOMIC_ACQUIRE, "agent");
            asm volatile("s_waitcnt vmcnt(0)" ::: "memory");
        }
    }
    __syncthreads();
}

constexpr size_t MiB = 1u << 20;
constexpr int NWAVES = 8;
constexpr int PROJ_BLD = 6144;
constexpr int PMAX = 34816;
constexpr int FLD = 2048 + 64;
constexpr size_t WS_CTL = 0, CTL_BYTES = 1 * MiB;
constexpr size_t WS_WIN = 1 * MiB, WS_WOUT = 25 * MiB, WS_WLORA = 33 * MiB;
constexpr size_t WS_XF = 34 * MiB, WS_XB = 162 * MiB, WS_VFIRST = 226 * MiB, WS_YMIXB = 290 * MiB, WS_TOK = 354 * MiB, WS_SCR = 356 * MiB;
constexpr size_t WS_PROJB = WS_SCR, WS_LW = WS_PROJB + 192 * MiB, WS_YRW = WS_LW + 128 * MiB, WS_BON = WS_YRW + 64 * MiB, WS_XBCC = WS_BON + 64 * MiB, WS_DTB = WS_XBCC + 48 * MiB, WS_YSSD = WS_DTB + 1 * MiB, WS_MIXED = WS_YSSD + 64 * MiB;
constexpr size_t WS_HBUF = WS_SCR, WS_XG = WS_HBUF + 187 * MiB, WS_YSLOT = WS_XG + 136 * MiB;
constexpr size_t WS_WFFN = WS_SCR + 860 * MiB, WS_END = WS_WFFN + 264 * MiB;
static_assert(WS_MIXED + 132 * MiB <= WS_WFFN && WS_YSLOT + 281 * MiB <= WS_WFFN, "scratch inside the map");
static_assert((size_t)PMAX * DFE * 2 <= 187 * MiB && (size_t)PMAX * D * 2 <= 136 * MiB && (size_t)PMAX * FLD * 4 <= 281 * MiB && (size_t)M * FLD * 4 <= 132 * MiB, "moe buffers");
constexpr int CW_CNT = 16;
constexpr int CW_BAR = 4096;
constexpr int MAX_BAR_REGIONS = 48;
static_assert((CW_BAR + MAX_BAR_REGIONS * XCD_BAR_WORDS) * 4 <= (int)CTL_BYTES, "ctl");
constexpr int RING_BYTES = 131072, LDS_BYTES = 147456, MISC_OFF = LDS_BYTES - 256;

struct Params { const float* in[35]; float* out; unsigned char* ws; int ph_lo, ph_hi, bar_idx, pad; };

__device__ __forceinline__ float wave_sum_f(float v) {
#pragma unroll
    for (int o = 32; o >= 1; o >>= 1) v += __shfl_xor(v, o);
    return v;
}

__device__ __forceinline__ void cvt_item(const float* W, int K, int N, bf16_t* WT, int dst_row0, LAS float* scr, int k0, int n0, int lane) {
    const int kr = lane >> 3, c4 = (lane & 7) * 4;
    f32x4 v[8];
    if (n0 + 32 <= N && k0 + 64 <= K) {
#pragma unroll
        for (int i = 0; i < 8; ++i) v[i] = *(const f32x4*)(W + (size_t)(k0 + 8 * i + kr) * N + n0 + c4);
    } else {
#pragma unroll
        for (int i = 0; i < 8; ++i) { const int kk = k0 + 8 * i + kr;
#pragma unroll
            for (int e = 0; e < 4; ++e) v[i][e] = (kk < K && n0 + c4 + e < N) ? W[(size_t)kk * N + n0 + c4 + e] : 0.f; }
    }
#pragma unroll
    for (int i = 0; i < 8; ++i) { LAS float* d = scr + (8 * i + kr) * 33 + c4; d[0] = v[i][0]; d[1] = v[i][1]; d[2] = v[i][2]; d[3] = v[i][3]; }
    asm volatile("s_waitcnt lgkmcnt(0)" ::: "memory");
    const int c = lane & 7;
#pragma unroll
    for (int j = 0; j < 4; ++j) { const int n = (lane >> 3) + 8 * j; const LAS float* s = scr + (8 * c) * 33 + n;
        u32x4 o; o.x = cvt_pk_bf16(s[0 * 33], s[1 * 33]); o.y = cvt_pk_bf16(s[2 * 33], s[3 * 33]); o.z = cvt_pk_bf16(s[4 * 33], s[5 * 33]); o.w = cvt_pk_bf16(s[6 * 33], s[7 * 33]);
        if (n0 + n < N && k0 + 8 * c < K) *(u32x4*)(WT + (size_t)(dst_row0 + n) * K + k0 + 8 * c) = o; }
    asm volatile("s_waitcnt lgkmcnt(0)" ::: "memory");
}
template <int MODE>
__device__ __forceinline__ void cvt_job(const float* W, int K, int N, bf16_t* WT, int row_off, int half, LAS float* scr, int gw, int ngw, int lane) {
    const int nkb = (K + 63) / 64, nnb = (N + 31) / 32, nitems = nkb * nnb;
    for (int it = gw; it < nitems; it += ngw) {
        const int kb = it / nnb, nb = it % nnb, n0 = nb * 32;
        const int dr = MODE == 0 ? row_off + n0 : row_off + 256 * (n0 / 128) + half * 128 + (n0 % 128);
        cvt_item(W, K, N, WT, dr, scr, kb * 64, n0, lane);
    }
}

struct LnOut { float* xf; bf16_t* xb; };
__device__ __forceinline__ void ln_finish(f32x4 (&v)[8], const float* gam, const float* bet, int lane, float* xf_row, bf16_t* xb_row) {
    float s = 0.f;
#pragma unroll
    for (int j = 0; j < 8; ++j) s += (v[j][0] + v[j][1]) + (v[j][2] + v[j][3]);
    const float mean = wave_sum_f(s) * (1.f / D);
    float q = 0.f;
#pragma unroll
    for (int j = 0; j < 8; ++j) { v[j] = v[j] - mean; q += (v[j][0] * v[j][0] + v[j][1] * v[j][1]) + (v[j][2] * v[j][2] + v[j][3] * v[j][3]); }
    const float rstd = rsqrtf(wave_sum_f(q) * (1.f / D) + 1e-5f);
#pragma unroll
    for (int j = 0; j < 8; ++j) { const int c = 4 * lane + 256 * j;
        const f32x4 g = *(const f32x4*)(gam + c), b = *(const f32x4*)(bet + c);
        v[j] = v[j] * rstd * g + b;
        *(f32x4*)(xf_row + c) = v[j];
        if (xb_row) { u32x2 w; w.x = cvt_pk_bf16(v[j][0], v[j][1]); w.y = cvt_pk_bf16(v[j][2], v[j][3]); *(u32x2*)(xb_row + c) = w; } }
}

#define DPP_ROR(z, n) __uint_as_float(__builtin_amdgcn_update_dpp(0u, __float_as_uint(z), 0x120 + (n), 0xf, 0xf, false))
__device__ __forceinline__ float wave_allsum(float x) {
    { auto s = __builtin_amdgcn_permlane32_swap(__float_as_uint(x), __float_as_uint(x), false, false); x = __uint_as_float(s[0]) + __uint_as_float(s[1]); }
    { auto s = __builtin_amdgcn_permlane16_swap(__float_as_uint(x), __float_as_uint(x), false, false); x = __uint_as_float(s[0]) + __uint_as_float(s[1]); }
    x += DPP_ROR(x, 8); x += DPP_ROR(x, 4); x += DPP_ROR(x, 2); x += DPP_ROR(x, 1);
    return x;
}
__device__ __forceinline__ float reduce4(float x0, float x1, float x2, float x3) {
    float y0, y1, z;
    { auto s = __builtin_amdgcn_permlane32_swap(__float_as_uint(x0), __float_as_uint(x2), false, false); y0 = __uint_as_float(s[0]) + __uint_as_float(s[1]); }
    { auto s = __builtin_amdgcn_permlane32_swap(__float_as_uint(x1), __float_as_uint(x3), false, false); y1 = __uint_as_float(s[0]) + __uint_as_float(s[1]); }
    { auto s = __builtin_amdgcn_permlane16_swap(__float_as_uint(y0), __float_as_uint(y1), false, false); z = __uint_as_float(s[0]) + __uint_as_float(s[1]); }
    z += DPP_ROR(z, 8); z += DPP_ROR(z, 4); z += DPP_ROR(z, 2); z += DPP_ROR(z, 1);
    return z;
}
__device__ __forceinline__ float rdlane(float v, int l) { return __int_as_float(__builtin_amdgcn_readlane(__float_as_int(v), l)); }
__device__ __forceinline__ float fast_sigmoid(float x) { return __builtin_amdgcn_rcpf(1.f + __builtin_amdgcn_exp2f(-1.4426950408889634f * x)); }
__device__ __forceinline__ float fast_tanh(float x) { return 1.f - 2.f * __builtin_amdgcn_rcpf(1.f + __builtin_amdgcn_exp2f(2.8853900817779268f * x)); }

constexpr int LORA_PITCH = 328;
__device__ __forceinline__ void lora_phase(LAS unsigned char* lds, const bf16_t* projb, const float* mix, const float* vmix, const bf16_t* Wl_w, const bf16_t* Wl_a, const bf16_t* Wl_g, const bf16_t* Wl_v,
                                           bf16_t* lw, const bool has_v, const int vcu, const int G, const int tid) {
    const int wave = __builtin_amdgcn_readfirstlane(tid >> 6), lane = tid & 63, fr = lane & 15, fq = lane >> 4;
    LAS bf16_t* Aimg = (LAS bf16_t*)lds;
    for (int u = vcu; u < M / 64; u += G) {
        {
            const int tau = tid >> 3, part = tid & 7, m = u * 64 + tau; const bool first = (m % SEQ) == 0;
#pragma unroll
            for (int i = 0; i < 5; ++i) {
                const int j0 = 40 * part + 8 * i;
                const u32x4 cur = *(const u32x4*)(projb + (size_t)m * PROJ_BLD + OFF_WLO + j0);
                u32x4 prv = (u32x4){0u, 0u, 0u, 0u};
                if (!first) prv = *(const u32x4*)(projb + (size_t)(m - 1) * PROJ_BLD + OFF_WLO + j0);
                f32x4 mx0, mx1;
                if (j0 < 288) { mx0 = *(const f32x4*)(mix + (OFF_WLO - OFF_RW) + j0); mx1 = *(const f32x4*)(mix + (OFF_WLO - OFF_RW) + j0 + 4); }
                else if (has_v) { mx0 = *(const f32x4*)(vmix + (j0 - 288)); mx1 = *(const f32x4*)(vmix + (j0 - 288) + 4); }
                else { mx0 = (f32x4){0.f, 0.f, 0.f, 0.f}; mx1 = mx0; }
                float o[8];
#pragma unroll
                for (int e = 0; e < 4; ++e) {
                    const float c0 = bf_lo(cur[e]), c1 = bf_hi(cur[e]), p0 = bf_lo(prv[e]), p1 = bf_hi(prv[e]);
                    const float m0 = (e < 2) ? mx0[2 * e] : mx1[2 * e - 4], m1 = (e < 2) ? mx0[2 * e + 1] : mx1[2 * e - 3];
                    o[2 * e] = c0 + (p0 - c0) * m0; o[2 * e + 1] = c1 + (p1 - c1) * m1;
                }
                if (j0 < 64) {
#pragma unroll
                    for (int e = 0; e < 8; ++e) o[e] = fast_tanh(o[e]);
                } else if (j0 >= 128 && j0 < 288) {
#pragma unroll
                    for (int e = 0; e < 8; ++e) o[e] = fast_sigmoid(o[e]);
                }
                u32x4 w; w.x = cvt_pk_bf16(o[0], o[1]); w.y = cvt_pk_bf16(o[2], o[3]); w.z = cvt_pk_bf16(o[4], o[5]); w.w = cvt_pk_bf16(o[6], o[7]);
                *(LAS u32x4*)(Aimg + tau * LORA_PITCH + j0) = w;
            }
        }
        __syncthreads();
        for (int q = 0; q < 4; ++q) {
            if (q == 3 && !has_v) break;
            const int K = (q == 2) ? 160 : (q == 3 ? 32 : 64), koff = (q == 0) ? 0 : (q == 1 ? 64 : (q == 2 ? 128 : 288));
            const bf16_t* W = (q == 0) ? Wl_w : (q == 1 ? Wl_a : (q == 2 ? Wl_g : Wl_v));
            f32x4 acc[8][4];
#pragma unroll
            for (int ct = 0; ct < 8; ++ct)
#pragma unroll
                for (int tt = 0; tt < 4; ++tt) acc[ct][tt] = (f32x4){0.f, 0.f, 0.f, 0.f};
            for (int ks = 0; ks < K / 32; ++ks) {
                bf16x8 af[8], bfr[4];
#pragma unroll
                for (int ct = 0; ct < 8; ++ct) af[ct] = *(const bf16x8*)(W + (size_t)(128 * wave + 16 * ct + fr) * K + 32 * ks + 8 * fq);
#pragma unroll
                for (int tt = 0; tt < 4; ++tt) bfr[tt] = *(const LAS bf16x8*)(Aimg + (16 * tt + fr) * LORA_PITCH + koff + 32 * ks + 8 * fq);
#pragma unroll
                for (int ct = 0; ct < 8; ++ct)
#pragma unroll
                    for (int tt = 0; tt < 4; ++tt) acc[ct][tt] = __builtin_amdgcn_mfma_f32_16x16x32_bf16(af[ct], bfr[tt], acc[ct][tt], 0, 0, 0);
            }
            bf16_t* out = lw + (size_t)q * M * 1024;
#pragma unroll
            for (int ct = 0; ct < 8; ++ct)
#pragma unroll
                for (int tt = 0; tt < 4; ++tt) { u32x2 w; w.x = cvt_pk_bf16(acc[ct][tt][0], acc[ct][tt][1]); w.y = cvt_pk_bf16(acc[ct][tt][2], acc[ct][tt][3]);
                    *(u32x2*)(out + (size_t)(u * 64 + 16 * tt + fr) * 1024 + 128 * wave + 16 * ct + 4 * fq) = w; }
        }
        __syncthreads();
    }
}

struct RwScan { const bf16_t* proj_; const bf16_t* lw_; const float* mix; const float* w0; const float* a0; const float* v0; const float* k_k; const float* k_a; const float* r_k; float* vf_; float* y_; float* bon_; int layer; int pad; };
constexpr int RWB_A = 0, RWB_DR = 8192, RWB_D = 16384, RWB_B = 24576, RWB_K = 32768, RWB_V = 40960, RWB_SC = 45056, RWB_SIZE = 45568, RW_YST = 3 * RWB_SIZE, RW_YST_SIZE = 4096, RW_TB = 32, RW_NCH = SEQ / RW_TB;
static_assert(RW_YST + 2 * RW_YST_SIZE <= MISC_OFF, "rwkv scan LDS map");
__device__ __forceinline__ float rowsum16(float z) { z += DPP_ROR(z, 8); asm("" : "+v"(z)); z += DPP_ROR(z, 4); asm("" : "+v"(z)); z += DPP_ROR(z, 2); asm("" : "+v"(z)); z += DPP_ROR(z, 1); asm("" : "+v"(z)); return z; }
__device__ __forceinline__ void rwkv_scan_phase(LAS unsigned char* lds, const RwScan& a, const int vcu, const int G, const int tid) {
    const int wave = __builtin_amdgcn_readfirstlane(tid >> 6), lane = tid & 63, jj = lane & 15, rg = lane >> 4;
    for (int u = vcu; u < BATCH * RW_H * 2; u += G) {
        const int b = u >> 5, h = (u >> 1) & 15, half = u & 1;
        if (wave >= 4) {
            const int pw_ = wave - 4, c = h * 64 + lane, ptid = tid - 256;
            const float mix_r = a.mix[c], mix_k = a.mix[1024 + c], mix_v = a.mix[2048 + c];
            const float w0c = a.w0[c], a0c = a.a0[c], v0c = a.layer ? a.v0[c] : 0.f, kkc = a.k_k[c], kac = a.k_a[c], rkc = a.r_k[c];
            const bf16_t* lw_w = a.lw_; const bf16_t* lw_a = a.lw_ + (size_t)M * 1024; const bf16_t* lw_v = a.lw_ + (size_t)3 * M * 1024;
            const int woff = jj * 16 + rg * 4;
            unsigned pr[9], pk[9], pv[9], pw[8], pa[8], pvp[8]; float pvf[8];
#define RW_PREFETCH(t0_) do { const int tb_ = (t0_) + 8 * pw_; \
            _Pragma("unroll") for (int i = 0; i < 9; ++i) { const int t_ = tb_ + i - 1; \
                if (t_ >= 0) { const bf16_t* row_ = a.proj_ + (size_t)(b * SEQ + t_) * PROJ_BLD + h * 64 + lane; pr[i] = row_[OFF_R]; pk[i] = row_[OFF_K]; pv[i] = row_[OFF_V]; } \
                else { pr[i] = 0u; pk[i] = 0u; pv[i] = 0u; } } \
            _Pragma("unroll") for (int i = 0; i < 8; ++i) { const size_t o_ = (size_t)(b * SEQ + tb_ + i) * 1024 + c; pw[i] = lw_w[o_]; pa[i] = lw_a[o_]; \
                if (a.layer) { pvp[i] = lw_v[o_]; pvf[i] = a.vf_[o_]; } else { pvp[i] = 0u; pvf[i] = 0.f; } } } while (0)
#define RW_PREP(ch_) do { const int t0_ = (ch_) * RW_TB; LAS unsigned char* buf_ = lds + ((ch_) % 3) * RWB_SIZE; \
            _Pragma("unroll") for (int i = 0; i < 8; ++i) { \
                const int tau = 8 * pw_ + i; \
                const float rc = __uint_as_float(pr[i + 1] << 16), rp = __uint_as_float(pr[i] << 16), kc = __uint_as_float(pk[i + 1] << 16), kp = __uint_as_float(pk[i] << 16), vc = __uint_as_float(pv[i + 1] << 16), vp = __uint_as_float(pv[i] << 16); \
                const float r = rc + (rp - rc) * mix_r, kraw = kc + (kp - kc) * mix_k, vraw = vc + (vp - vc) * mix_v; \
                const float sg = fast_sigmoid(w0c + __uint_as_float(pw[i] << 16)); \
                const float dec = __builtin_amdgcn_exp2f(-1.4426950408889634f * 0.6065306597126334f * sg);     \
                const float as = fast_sigmoid(a0c + __uint_as_float(pa[i] << 16)); \
                float v = vraw; \
                if (a.layer) v = vraw + (pvf[i] - vraw) * fast_sigmoid(v0c + __uint_as_float(pvp[i] << 16)); \
                const float kkv = kraw * kkc; \
                const float km = kraw * (1.f + (as - 1.f) * kac); \
                const float z = reduce4(kkv * kkv, r * km * rkc, kkv * as * r, km * r);     \
                const float nrm2 = rdlane(z, 0), rks = rdlane(z, 16), bru = rdlane(z, 32), kr = rdlane(z, 48); \
                const float inv = 1.f / fmaxf(sqrtf(nrm2), 1e-12f); \
                const float kkn = kkv * inv; \
                *(LAS float*)(buf_ + RWB_A + tau * 256 + woff) = -kkn; *(LAS float*)(buf_ + RWB_DR + tau * 256 + woff) = dec * r; *(LAS float*)(buf_ + RWB_D + tau * 256 + woff) = dec; \
                *(LAS float*)(buf_ + RWB_B + tau * 256 + woff) = kkn * as; *(LAS float*)(buf_ + RWB_K + tau * 256 + woff) = km; \
                if ((lane >> 5) == half) { ((LAS float*)(buf_ + RWB_V))[tau * 32 + (lane & 31)] = v; \
                    if (a.layer == 0) a.vf_[(size_t)(b * SEQ + t0_ + tau) * 1024 + c] = vraw; } \
                if (lane == 0) { ((LAS float*)(buf_ + RWB_SC))[tau] = bru * inv; ((LAS float*)(buf_ + RWB_SC))[32 + tau] = kr; ((LAS float*)(buf_ + RWB_SC))[64 + tau] = rks; } \
            } } while (0)
#define RW_FLUSH(ch_) do { const int t0_ = (ch_) * RW_TB; const LAS unsigned char* buf_ = lds + ((ch_) % 3) * RWB_SIZE; const LAS float* yst_ = (const LAS float*)(lds + RW_YST + ((ch_) & 1) * RW_YST_SIZE); \
            _Pragma("unroll") for (int q = 0; q < 4; ++q) { const int idx = ptid + 256 * q, tau = idx >> 5, i = idx & 31; \
                const float y = yst_[((((tau >> 4) * 4 + (i >> 3)) * 64 + ((i & 7) >> 1) * 16 + (tau & 15)) << 1) + (i & 1)]; \
                const float bo = ((const LAS float*)(buf_ + RWB_SC))[64 + tau] * ((const LAS float*)(buf_ + RWB_V))[tau * 32 + i]; \
                const size_t o = (size_t)(b * SEQ + t0_ + tau) * 1024 + h * 64 + half * 32 + i; \
                a.y_[o] = y; a.bon_[o] = bo; } } while (0)
            RW_PREFETCH(0);
            RW_PREP(0);
            RW_PREFETCH(RW_TB);
            __syncthreads();
            for (int ch = 0; ch < RW_NCH; ++ch) {
                if (ch > 0) RW_FLUSH(ch - 1);
                if (ch + 1 < RW_NCH) { RW_PREP(ch + 1); if (ch + 2 < RW_NCH) RW_PREFETCH((ch + 2) * RW_TB); }
                __syncthreads();
            }
            RW_FLUSH(RW_NCH - 1);
#undef RW_PREFETCH
#undef RW_PREP
#undef RW_FLUSH
        } else {
            f32x2 S0 = (f32x2){0.f, 0.f}, S1 = S0, S2 = S0, S3 = S0;
            __syncthreads();
            for (int ch = 0; ch < RW_NCH; ++ch) {
                const LAS unsigned char* buf = lds + (ch % 3) * RWB_SIZE;
                const LAS unsigned char* ob = buf + jj * 16;
                const LAS float* Vb = (const LAS float*)(buf + RWB_V) + 8 * wave + 2 * rg; const LAS float* SC = (const LAS float*)(buf + RWB_SC);
                LAS f32x2* Yst = (LAS f32x2*)(lds + RW_YST + (ch & 1) * RW_YST_SIZE);
                f32x4 a4 = *(const LAS f32x4*)(ob + RWB_A), q4 = *(const LAS f32x4*)(ob + RWB_DR), d4 = *(const LAS f32x4*)(ob + RWB_D), b4 = *(const LAS f32x4*)(ob + RWB_B), k4 = *(const LAS f32x4*)(ob + RWB_K);
                f32x2 vi = *(const LAS f32x2*)Vb; float br = SC[0], kr = SC[32];
#pragma unroll
                for (int blk = 0; blk < 2; ++blk) {
                    f32x2 yacc = (f32x2){0.f, 0.f};
#pragma unroll
                    for (int s = 0; s < 16; ++s) {
                        const int tn = blk * 16 + s + 1;
                        const f32x4 na4 = *(const LAS f32x4*)(ob + RWB_A + tn * 256), nq4 = *(const LAS f32x4*)(ob + RWB_DR + tn * 256), nd4 = *(const LAS f32x4*)(ob + RWB_D + tn * 256),
                                    nb4 = *(const LAS f32x4*)(ob + RWB_B + tn * 256), nk4 = *(const LAS f32x4*)(ob + RWB_K + tn * 256);
                        const f32x2 nvi = *(const LAS f32x2*)(Vb + (tn & 31) * 32); const float nbr = SC[tn & 31], nkr = SC[32 + (tn & 31)];
                        const f32x2 pa_ = (S0 * a4[0] + S1 * a4[1]) + (S2 * a4[2] + S3 * a4[3]);
                        const f32x2 pq_ = (S0 * q4[0] + S1 * q4[1]) + (S2 * q4[2] + S3 * q4[3]);
                        f32x2 sa, zq;
                        sa.x = rowsum16(pa_.x); sa.y = rowsum16(pa_.y); zq.x = rowsum16(pq_.x); zq.y = rowsum16(pq_.y);
                        S0 = S0 * d4[0] + sa * b4[0] + vi * k4[0]; S1 = S1 * d4[1] + sa * b4[1] + vi * k4[1]; S2 = S2 * d4[2] + sa * b4[2] + vi * k4[2]; S3 = S3 * d4[3] + sa * b4[3] + vi * k4[3];
                        const f32x2 y = zq + sa * br + vi * kr;
                        yacc.x = (jj == s) ? y.x : yacc.x; yacc.y = (jj == s) ? y.y : yacc.y;
                        a4 = na4; q4 = nq4; d4 = nd4; b4 = nb4; k4 = nk4; vi = nvi; br = nbr; kr = nkr;
                    }
                    Yst[(blk * 4 + wave) * 64 + lane] = yacc;
                }
                __syncthreads();
            }
        }
        __syncthreads();
    }
}

__device__ __forceinline__ void rwkv_post_phase(const float* yrw, const float* bon, const bf16_t* lw_g, const float* ln_w, const float* ln_b, bf16_t* ymixb, const int gw, const int NGW, const int lane) {
    const int c0 = 16 * lane;
    f32x4 lw4[4], lb4[4];
#pragma unroll
    for (int j = 0; j < 4; ++j) { lw4[j] = *(const f32x4*)(ln_w + c0 + 4 * j); lb4[j] = *(const f32x4*)(ln_b + c0 + 4 * j); }
    for (int m = gw; m < M; m += NGW) {
        f32x4 y[4], bo[4];
#pragma unroll
        for (int j = 0; j < 4; ++j) { y[j] = *(const f32x4*)(yrw + (size_t)m * 1024 + c0 + 4 * j); bo[j] = *(const f32x4*)(bon + (size_t)m * 1024 + c0 + 4 * j); }
        const u32x4 g0 = *(const u32x4*)(lw_g + (size_t)m * 1024 + c0), g1 = *(const u32x4*)(lw_g + (size_t)m * 1024 + c0 + 8);
        float s = 0.f;
#pragma unroll
        for (int j = 0; j < 4; ++j) s += (y[j][0] + y[j][1]) + (y[j][2] + y[j][3]);
        s += __shfl_xor(s, 1); s += __shfl_xor(s, 2);
        const float mu = s * (1.f / 64.f);
        float q = 0.f;
#pragma unroll
        for (int j = 0; j < 4; ++j) { y[j] = y[j] - mu; q += (y[j][0] * y[j][0] + y[j][1] * y[j][1]) + (y[j][2] * y[j][2] + y[j][3] * y[j][3]); }
        q += __shfl_xor(q, 1); q += __shfl_xor(q, 2);
        const float rstd = rsqrtf(q * (1.f / 64.f) + 64e-5f);
        float o[16];
#pragma unroll
        for (int j = 0; j < 4; ++j) { const f32x4 t = y[j] * rstd * lw4[j] + lb4[j] + bo[j]; o[4 * j] = t[0]; o[4 * j + 1] = t[1]; o[4 * j + 2] = t[2]; o[4 * j + 3] = t[3]; }
        const unsigned gw_[8] = {g0.x, g0.y, g0.z, g0.w, g1.x, g1.y, g1.z, g1.w};
        u32x4 w0, w1;
        w0.x = cvt_pk_bf16(o[0] * bf_lo(gw_[0]), o[1] * bf_hi(gw_[0])); w0.y = cvt_pk_bf16(o[2] * bf_lo(gw_[1]), o[3] * bf_hi(gw_[1]));
        w0.z = cvt_pk_bf16(o[4] * bf_lo(gw_[2]), o[5] * bf_hi(gw_[2])); w0.w = cvt_pk_bf16(o[6] * bf_lo(gw_[3]), o[7] * bf_hi(gw_[3]));
        w1.x = cvt_pk_bf16(o[8] * bf_lo(gw_[4]), o[9] * bf_hi(gw_[4])); w1.y = cvt_pk_bf16(o[10] * bf_lo(gw_[5]), o[11] * bf_hi(gw_[5]));
        w1.z = cvt_pk_bf16(o[12] * bf_lo(gw_[6]), o[13] * bf_hi(gw_[6])); w1.w = cvt_pk_bf16(o[14] * bf_lo(gw_[7]), o[15] * bf_hi(gw_[7]));
        *(u32x4*)(ymixb + (size_t)m * 2048 + 1024 + c0) = w0; *(u32x4*)(ymixb + (size_t)m * 2048 + 1024 + c0 + 8) = w1;
    }
}

__device__ __forceinline__ void ssd_conv_phase(const bf16_t* projb, const float* cw, const float* cb, const float* dt_bias, bf16_t* xbcc, float* dtb, const int vcu, const int G, const int tid) {
    for (int u = vcu; u < M / 64; u += G) {
        if (tid < 384) {
            const int cg = tid % 192, hf = tid / 192, c0 = 8 * cg, m0 = u * 64 + 32 * hf, t_in_seq = m0 % SEQ;
            float w[4][8], bias[8];
#pragma unroll
            for (int q = 0; q < 4; ++q) { const f32x4 a = *(const f32x4*)(cw + q * CONV_DIM + c0), b = *(const f32x4*)(cw + q * CONV_DIM + c0 + 4);
                w[q][0] = a[0]; w[q][1] = a[1]; w[q][2] = a[2]; w[q][3] = a[3]; w[q][4] = b[0]; w[q][5] = b[1]; w[q][6] = b[2]; w[q][7] = b[3]; }
            { const f32x4 a = *(const f32x4*)(cb + c0), b = *(const f32x4*)(cb + c0 + 4); bias[0] = a[0]; bias[1] = a[1]; bias[2] = a[2]; bias[3] = a[3]; bias[4] = b[0]; bias[5] = b[1]; bias[6] = b[2]; bias[7] = b[3]; }
            float win[3][8];
#pragma unroll
            for (int q = 0; q < 3; ++q) {
                u32x4 r = (u32x4){0u, 0u, 0u, 0u};
                if (t_in_seq - 3 + q >= 0) r = *(const u32x4*)(projb + (size_t)(m0 - 3 + q) * PROJ_BLD + OFF_XBC + c0);
                win[q][0] = bf_lo(r.x); win[q][1] = bf_hi(r.x); win[q][2] = bf_lo(r.y); win[q][3] = bf_hi(r.y); win[q][4] = bf_lo(r.z); win[q][5] = bf_hi(r.z); win[q][6] = bf_lo(r.w); win[q][7] = bf_hi(r.w);
            }
            for (int i = 0; i < 32; ++i) {
                const u32x4 r = *(const u32x4*)(projb + (size_t)(m0 + i) * PROJ_BLD + OFF_XBC + c0);
                float cur[8] = {bf_lo(r.x), bf_hi(r.x), bf_lo(r.y), bf_hi(r.y), bf_lo(r.z), bf_hi(r.z), bf_lo(r.w), bf_hi(r.w)};
                float o[8];
#pragma unroll
                for (int e = 0; e < 8; ++e) { const float acc = bias[e] + w[0][e] * win[0][e] + w[1][e] * win[1][e] + w[2][e] * win[2][e] + w[3][e] * cur[e]; o[e] = fast_silu(acc);
                    win[0][e] = win[1][e]; win[1][e] = win[2][e]; win[2][e] = cur[e]; }
                u32x4 wv; wv.x = cvt_pk_bf16(o[0], o[1]); wv.y = cvt_pk_bf16(o[2], o[3]); wv.z = cvt_pk_bf16(o[4], o[5]); wv.w = cvt_pk_bf16(o[6], o[7]);
                *(u32x4*)(xbcc + (size_t)(m0 + i) * CONV_DIM + c0) = wv;
            }
        }
#pragma unroll
        for (int q = 0; q < 2; ++q) { const int idx = tid + 512 * q, m = u * 64 + (idx >> 4), h = idx & 15;
            const float x = bf2f(projb[(size_t)m * PROJ_BLD + OFF_DT + h]) + dt_bias[h];
            dtb[(size_t)m * SSD_H + h] = fmaxf(x, 0.f) + log1pf(expf(-fabsf(x))); }
    }
}

constexpr int SP = 136;
constexpr int SS_C = 0, SS_B = 34816, SS_BT = 69632, SS_XT = 104448, SS_XW = 113152, SS_HT = 121856, SS_AC = 130560, SS_DT = 131072, SS_END = 131584;
__device__ __forceinline__ void ssd_scan_phase(LAS unsigned char* lds, const bf16_t* xbcc, const float* dtb, const float* a_log, const float* dskip, float* yssd, const int vcu, const int G, const int tid) {
    const int wave = __builtin_amdgcn_readfirstlane(tid >> 6), lane = tid & 63, fr = lane & 15, fq = lane >> 4;
    LAS bf16_t* Cimg = (LAS bf16_t*)(lds + SS_C); LAS bf16_t* Bimg = (LAS bf16_t*)(lds + SS_B); LAS bf16_t* BTimg = (LAS bf16_t*)(lds + SS_BT);
    LAS bf16_t* xT = (LAS bf16_t*)(lds + SS_XT); LAS bf16_t* xwT = (LAS bf16_t*)(lds + SS_XW); LAS bf16_t* hT = (LAS bf16_t*)(lds + SS_HT);
    LAS float* acum = (LAS float*)(lds + SS_AC); LAS float* dtv = (LAS float*)(lds + SS_DT);
    for (int u = vcu; u < BATCH * SSD_H * 2; u += G) {
        const int b = u >> 5, h = (u >> 1) & 15, phalf = u & 1, g = h >> 3;
        const float Ah = -expf(a_log[h]) * 1.4426950408889634f;
        const float dsk = dskip[h];
        f32x4 hs[2] = {(f32x4){0.f, 0.f, 0.f, 0.f}, (f32x4){0.f, 0.f, 0.f, 0.f}};
        for (int i = tid; i < 32 * SP / 2; i += 512) ((LAS unsigned*)hT)[i] = 0u;
        const int row = tid >> 2, part = tid & 3;
        for (int ch = 0; ch < SEQ / 128; ++ch) {
            const int mrow0 = b * SEQ + ch * 128;
            u32x4 xr;
            {
                const bf16_t* src = xbcc + (size_t)(mrow0 + row) * CONV_DIM;
                u32x4 cv[4], bv[4];
#pragma unroll
                for (int j = 0; j < 4; ++j) { cv[j] = *(const u32x4*)(src + 1280 + g * 128 + 32 * part + 8 * j); bv[j] = *(const u32x4*)(src + 1024 + g * 128 + 32 * part + 8 * j); }
                xr = *(const u32x4*)(src + h * 64 + phalf * 32 + 8 * part);
                if (tid < 128) dtv[tid] = dtb[(size_t)(mrow0 + tid) * SSD_H + h];
#pragma unroll
                for (int j = 0; j < 4; ++j) { *(LAS u32x4*)(Cimg + row * SP + 32 * part + 8 * j) = cv[j]; *(LAS u32x4*)(Bimg + row * SP + 32 * part + 8 * j) = bv[j]; }
#pragma unroll
                for (int j = 0; j < 4; ++j) { const unsigned wv[4] = {bv[j].x, bv[j].y, bv[j].z, bv[j].w};
#pragma unroll
                    for (int e = 0; e < 4; ++e) { const int n = 32 * part + 8 * j + 2 * e; BTimg[n * SP + row] = (bf16_t)(wv[e] & 0xffffu); BTimg[(n + 1) * SP + row] = (bf16_t)(wv[e] >> 16); } }
            }
            __syncthreads();
            if (wave == 0) {
                const float v0 = dtv[2 * lane] * Ah, v1 = dtv[2 * lane + 1] * Ah;
                float s = v0 + v1;
#pragma unroll
                for (int o = 1; o < 64; o <<= 1) { const float t = __shfl_up(s, o); if (lane >= o) s += t; }
                acum[2 * lane] = s - v1; acum[2 * lane + 1] = s;
            }
            __syncthreads();
            const float atot = acum[127];
            {
                const float wgt = dtv[row] * __builtin_amdgcn_exp2f(atot - acum[row]);
                const unsigned wv[4] = {xr.x, xr.y, xr.z, xr.w};
#pragma unroll
                for (int e = 0; e < 4; ++e) { const int p = 8 * part + 2 * e; const float x0 = bf_lo(wv[e]), x1 = bf_hi(wv[e]);
                    xT[p * SP + row] = (bf16_t)(wv[e] & 0xffffu); xT[(p + 1) * SP + row] = (bf16_t)(wv[e] >> 16);
                    const unsigned pk = cvt_pk_bf16(x0 * wgt, x1 * wgt); xwT[p * SP + row] = (bf16_t)(pk & 0xffffu); xwT[(p + 1) * SP + row] = (bf16_t)(pk >> 16); }
            }
            f32x4 gacc[8];
#pragma unroll
            for (int st = 0; st < 8; ++st) gacc[st] = (f32x4){0.f, 0.f, 0.f, 0.f};
            {
                bf16x8 cf[4];
#pragma unroll
                for (int ks = 0; ks < 4; ++ks) cf[ks] = *(const LAS bf16x8*)(Cimg + (16 * wave + fr) * SP + 32 * ks + 8 * fq);
#pragma unroll
                for (int st = 0; st < 8; ++st) if (st <= wave) {
#pragma unroll
                    for (int ks = 0; ks < 4; ++ks) { const bf16x8 bfg = *(const LAS bf16x8*)(Bimg + (16 * st + fr) * SP + 32 * ks + 8 * fq);
                        gacc[st] = __builtin_amdgcn_mfma_f32_16x16x32_bf16(bfg, cf[ks], gacc[st], 0, 0, 0); }
                }
            }
            __syncthreads();
            {
                LAS bf16_t* Mimg = Bimg;
                const int l = 16 * wave + fr; const float al = acum[l];
#pragma unroll
                for (int st = 0; st < 8; ++st) if (st <= wave + 1) {
                    u32x2 wv = (u32x2){0u, 0u};
                    if (st <= wave) {
                        const f32x4 as4 = *(const LAS f32x4*)(acum + 16 * st + 4 * fq), dt4 = *(const LAS f32x4*)(dtv + 16 * st + 4 * fq);
                        float mv[4];
#pragma unroll
                        for (int r = 0; r < 4; ++r) { const int s = 16 * st + 4 * fq + r; mv[r] = (s <= l) ? gacc[st][r] * dt4[r] * __builtin_amdgcn_exp2f(al - as4[r]) : 0.f; }
                        wv.x = cvt_pk_bf16(mv[0], mv[1]); wv.y = cvt_pk_bf16(mv[2], mv[3]);
                    }
                    *(LAS u32x2*)(Mimg + l * SP + 16 * st + 4 * fq) = wv;
                }
            }
            __syncthreads();
            {
                const LAS bf16_t* Mimg = Bimg;
                f32x4 yd[2] = {(f32x4){0.f, 0.f, 0.f, 0.f}, (f32x4){0.f, 0.f, 0.f, 0.f}}, yo[2] = {(f32x4){0.f, 0.f, 0.f, 0.f}, (f32x4){0.f, 0.f, 0.f, 0.f}};
#pragma unroll
                for (int ks = 0; ks < 4; ++ks) {
                    const bf16x8 cfr = *(const LAS bf16x8*)(Cimg + (16 * wave + fr) * SP + 32 * ks + 8 * fq);
#pragma unroll
                    for (int pt = 0; pt < 2; ++pt) { const bf16x8 hf = *(const LAS bf16x8*)(hT + (16 * pt + fr) * SP + 32 * ks + 8 * fq);
                        yo[pt] = __builtin_amdgcn_mfma_f32_16x16x32_bf16(hf, cfr, yo[pt], 0, 0, 0); }
                    if (2 * ks <= wave) {
                        const bf16x8 mf = *(const LAS bf16x8*)(Mimg + (16 * wave + fr) * SP + 32 * ks + 8 * fq);
#pragma unroll
                        for (int pt = 0; pt < 2; ++pt) { const bf16x8 xf_ = *(const LAS bf16x8*)(xT + (16 * pt + fr) * SP + 32 * ks + 8 * fq);
                            yd[pt] = __builtin_amdgcn_mfma_f32_16x16x32_bf16(xf_, mf, yd[pt], 0, 0, 0); }
                    }
                }
                const int l = 16 * wave + fr; const float el = __builtin_amdgcn_exp2f(acum[l]);
#pragma unroll
                for (int pt = 0; pt < 2; ++pt) {
                    f32x4 o;
#pragma unroll
                    for (int r = 0; r < 4; ++r) o[r] = yd[pt][r] + el * yo[pt][r] + dsk * bf2f(xT[(16 * pt + 4 * fq + r) * SP + l]);
                    *(f32x4*)(yssd + (size_t)(mrow0 + l) * 1024 + h * 64 + phalf * 32 + 16 * pt + 4 * fq) = o;
                }
            }
            {
                const float ea = __builtin_amdgcn_exp2f(atot);
                hs[0] = hs[0] * ea; hs[1] = hs[1] * ea;
#pragma unroll
                for (int ks = 0; ks < 4; ++ks) {
                    const bf16x8 btf = *(const LAS bf16x8*)(BTimg + (16 * wave + fr) * SP + 32 * ks + 8 * fq);
#pragma unroll
                    for (int pt = 0; pt < 2; ++pt) { const bf16x8 xwf = *(const LAS bf16x8*)(xwT + (16 * pt + fr) * SP + 32 * ks + 8 * fq);
                        hs[pt] = __builtin_amdgcn_mfma_f32_16x16x32_bf16(btf, xwf, hs[pt], 0, 0, 0); }
                }
            }
            __syncthreads();
#pragma unroll
            for (int pt = 0; pt < 2; ++pt) { u32x2 wv; wv.x = cvt_pk_bf16(hs[pt][0], hs[pt][1]); wv.y = cvt_pk_bf16(hs[pt][2], hs[pt][3]);
                *(LAS u32x2*)(hT + (16 * pt + fr) * SP + 16 * wave + 4 * fq) = wv; }
        }
        __syncthreads();
    }
}

__device__ __forceinline__ void ssd_post_phase(const float* yssd, const bf16_t* projb, const float* norm_w, bf16_t* ymixb, const int gw, const int NGW, const int lane) {
    const int c0 = 16 * lane;
    f32x4 nw[4];
#pragma unroll
    for (int j = 0; j < 4; ++j) nw[j] = *(const f32x4*)(norm_w + c0 + 4 * j);
    for (int m = gw; m < M; m += NGW) {
        f32x4 y[4];
#pragma unroll
        for (int j = 0; j < 4; ++j) y[j] = *(const f32x4*)(yssd + (size_t)m * 1024 + c0 + 4 * j);
        const u32x4 z0 = *(const u32x4*)(projb + (size_t)m * PROJ_BLD + OFF_Z + c0), z1 = *(const u32x4*)(projb + (size_t)m * PROJ_BLD + OFF_Z + c0 + 8);
        const unsigned zw[8] = {z0.x, z0.y, z0.z, z0.w, z1.x, z1.y, z1.z, z1.w};
        float uu[16]; float ss = 0.f;
#pragma unroll
        for (int e = 0; e < 8; ++e) { uu[2 * e] = y[e >> 1][(2 * e) & 3] * fast_silu(bf_lo(zw[e])); uu[2 * e + 1] = y[e >> 1][(2 * e + 1) & 3] * fast_silu(bf_hi(zw[e])); ss += uu[2 * e] * uu[2 * e] + uu[2 * e + 1] * uu[2 * e + 1]; }
#pragma unroll
        for (int o = 1; o < 32; o <<= 1) ss += __shfl_xor(ss, o);
        const float rs = rsqrtf(ss * (1.f / 512.f) + 1e-5f);
        u32x4 w0, w1;
        w0.x = cvt_pk_bf16(uu[0] * rs * nw[0][0], uu[1] * rs * nw[0][1]); w0.y = cvt_pk_bf16(uu[2] * rs * nw[0][2], uu[3] * rs * nw[0][3]);
        w0.z = cvt_pk_bf16(uu[4] * rs * nw[1][0], uu[5] * rs * nw[1][1]); w0.w = cvt_pk_bf16(uu[6] * rs * nw[1][2], uu[7] * rs * nw[1][3]);
        w1.x = cvt_pk_bf16(uu[8] * rs * nw[2][0], uu[9] * rs * nw[2][1]); w1.y = cvt_pk_bf16(uu[10] * rs * nw[2][2], uu[11] * rs * nw[2][3]);
        w1.z = cvt_pk_bf16(uu[12] * rs * nw[3][0], uu[13] * rs * nw[3][1]); w1.w = cvt_pk_bf16(uu[14] * rs * nw[3][2], uu[15] * rs * nw[3][3]);
        *(u32x4*)(ymixb + (size_t)m * 2048 + c0) = w0; *(u32x4*)(ymixb + (size_t)m * 2048 + c0 + 8) = w1;
    }
}

#define PH_BEGIN int z_ = 0; asm volatile("" : "+s"(z_)); unsigned char* const wsq = P.ws + z_; int tid = tid0; asm volatile("" : "+v"(tid)); \
    const int G = G0 + z_, bx = bx0 + z_, vcu = vcu0 + z_, lane = tid & 63, wave = __builtin_amdgcn_readfirstlane(tid >> 6), gw = vcu * NWAVES + wave, NGW = G * NWAVES; (void)bx; (void)lane; (void)gw; (void)NGW; (void)wave;
#define INP(i) (P.in[(i) + z_])
#define Win_t ((bf16_t*)(wsq + WS_WIN))
#define Wout_t ((bf16_t*)(wsq + WS_WOUT))
#define Wffn ((bf16_t*)(wsq + WS_WFFN))
#define Wl_w ((bf16_t*)(wsq + WS_WLORA))
#define Wl_a (Wl_w + 1024 * 64)
#define Wl_g (Wl_a + 1024 * 64)
#define Wl_v (Wl_g + 1024 * 160)
#define xf ((float*)(wsq + WS_XF))
#define xb ((bf16_t*)(wsq + WS_XB))
#define projb ((bf16_t*)(wsq + WS_PROJB))
#define ymixb ((bf16_t*)(wsq + WS_YMIXB))
#define mixed ((float*)(wsq + WS_MIXED))
#define hbuf ((bf16_t*)(wsq + WS_HBUF))
#define xg ((bf16_t*)(wsq + WS_XG))
#define yslot ((float*)(wsq + WS_YSLOT))
#define xbcc ((bf16_t*)(wsq + WS_XBCC))
#define dtb ((float*)(wsq + WS_DTB))
#define yssd ((float*)(wsq + WS_YSSD))
#define lw ((bf16_t*)(wsq + WS_LW))
#define yrw ((float*)(wsq + WS_YRW))
#define bon ((float*)(wsq + WS_BON))
#define vfirst ((float*)(wsq + WS_VFIRST))
#define tok_e ((int*)(wsq + WS_TOK))
#define tok_pos (tok_e + 2 * M)
#define tok_g ((float*)(tok_pos + 2 * M))
#define tok_dest ((int*)(tok_g + 2 * M))
#define cnt ((int*)(wsq + WS_CTL) + CW_CNT + 8 * li)
__global__ void __launch_bounds__(NWAVES * 64, 2) fwd(Params P) {
    extern __shared__ __attribute__((aligned(16))) unsigned char lds_raw[];
    LAS unsigned char* lds = (LAS unsigned char*)lds_raw;
    volatile LAS unsigned* MISC = (volatile LAS unsigned*)(lds + MISC_OFF);
    const int tid0 = threadIdx.x;
    const int G0 = gridDim.x, bx0 = blockIdx.x;
    const int vcu0 = (G0 % 8 == 0) ? (bx0 % 8) * (G0 / 8) + bx0 / 8 : bx0;
    unsigned* ctl = (unsigned*)(P.ws + WS_CTL);
    if (tid0 < 64) MISC[tid0] = 0u;
    __syncthreads();
#if MK_LAUNCH_MODE == 1
    constexpr int lo = 0, hi = 64;
#else
    const int lo = P.ph_lo, hi = P.ph_hi;
#endif
    XcdBarrier bar; bar.bar = ctl + CW_BAR + P.bar_idx * XCD_BAR_WORDS; bar.x = 0; bar.st = MISC + 8;
    if (hi - lo > 1) bar = xcd_barrier_post(ctl + CW_BAR + P.bar_idx * XCD_BAR_WORDS, MISC + 8);
#define IN(k) (lo <= (k) && (k) < hi)
#define SEAM(k) do { if ((k) + 1 < hi) xcd_barrier(bar); } while (0)

    for (int l = 0; l < 4; ++l) {
        const int pb = l * 16, li = l >> 1; const bool moe = (l & 1) != 0;
        if (IN(pb + 0)) {
            PH_BEGIN
            for (int rep_ = 0; rep_ < 1 + ((MK_DBL >> 0) & 1); ++rep_) {
            LAS float* scr = (LAS float*)(lds + wave * 16384);
            cvt_job<0>(INP(1) + (size_t)l * D * IN_DIM, D, IN_DIM, Win_t, 0, 0, scr, gw, NGW, lane);
            if (l > 0) cvt_job<0>(INP(2) + (size_t)(l - 1) * D * 32, D, 32, Win_t, IN_DIM, 0, scr, gw, NGW, lane);
            { const int r0 = l > 0 ? IN_DIM + 32 : IN_DIM, nz = (PROJ_BLD - r0) * (D / 8);
              for (int i = bx * 512 + tid; i < nz; i += G * 512) *(u32x4*)(Win_t + (size_t)r0 * D + (size_t)i * 8) = (u32x4){0u, 0u, 0u, 0u}; }
            cvt_job<0>(INP(23) + (size_t)l * D * D, D, D, Wout_t, 0, 0, scr, gw, NGW, lane);
            cvt_job<0>(INP(12) + (size_t)l * 64 * 1024, 64, 1024, Wl_w, 0, 0, scr, gw, NGW, lane);
            cvt_job<0>(INP(14) + (size_t)l * 64 * 1024, 64, 1024, Wl_a, 0, 0, scr, gw, NGW, lane);
            cvt_job<0>(INP(17) + (size_t)l * 160 * 1024, 160, 1024, Wl_g, 0, 0, scr, gw, NGW, lane);
            if (l > 0) cvt_job<0>(INP(16) + (size_t)(l - 1) * 32 * 1024, 32, 1024, Wl_v, 0, 0, scr, gw, NGW, lane);
            if (l == 0) {
                const float* x = INP(0);
                const size_t stride = (size_t)G * 512, total = (size_t)M * D / 8;
                size_t i = (size_t)bx * 512 + tid;
                for (; i + 3 * stride < total; i += 4 * stride) {
                    f32x4 a[4], b[4];
#pragma unroll
                    for (int q = 0; q < 4; ++q) { a[q] = *(const f32x4*)(x + (i + q * stride) * 8); b[q] = *(const f32x4*)(x + (i + q * stride) * 8 + 4); }
#pragma unroll
                    for (int q = 0; q < 4; ++q) { u32x4 w; w.x = cvt_pk_bf16(a[q][0], a[q][1]); w.y = cvt_pk_bf16(a[q][2], a[q][3]); w.z = cvt_pk_bf16(b[q][0], b[q][1]); w.w = cvt_pk_bf16(b[q][2], b[q][3]);
                        *(u32x4*)(xb + (i + q * stride) * 8) = w; }
                }
                for (; i < total; i += stride) {
                    const f32x4 a = *(const f32x4*)(x + i * 8), b = *(const f32x4*)(x + i * 8 + 4);
                    u32x4 w; w.x = cvt_pk_bf16(a[0], a[1]); w.y = cvt_pk_bf16(a[2], a[3]); w.z = cvt_pk_bf16(b[0], b[1]); w.w = cvt_pk_bf16(b[2], b[3]);
                    *(u32x4*)(xb + i * 8) = w; }
            }
            }
            __syncthreads();
            SEAM(pb + 0);
        }
        if (IN(pb + 1)) {
            PH_BEGIN
            pg8::Gemm g{xb, Win_t, D}; pg8::StaticOrder S; S.init(M, PROJ_BLD, G, bx);
            pg8::EpiBf16 E{projb, PROJ_BLD};
            pg8::gemm_phase<pg8::EpiBf16, pg8::StaticOrder>(lds, g, S, E, tid);
#if (MK_DBL >> 1) & 1
            pg8::gemm_phase<pg8::EpiBf16, pg8::StaticOrder>(lds, g, S, E, tid);
#endif
            SEAM(pb + 1);
        }
        if (IN(pb + 2)) {
            PH_BEGIN
            lora_phase(lds, projb, INP(9) + (size_t)l * RW_SHIFT, INP(10) + (size_t)(l > 0 ? l - 1 : 0) * 32, Wl_w, Wl_a, Wl_g, Wl_v, lw, l > 0, vcu, G, tid);
#if (MK_DBL >> 2) & 1
            lora_phase(lds, projb, INP(9) + (size_t)l * RW_SHIFT, INP(10) + (size_t)(l > 0 ? l - 1 : 0) * 32, Wl_w, Wl_a, Wl_g, Wl_v, lw, l > 0, vcu, G, tid);
#endif
            ssd_conv_phase(projb, INP(3) + (size_t)l * 4 * CONV_DIM, INP(4) + (size_t)l * CONV_DIM, INP(5) + l * SSD_H, xbcc, dtb, vcu, G, tid);
#if (MK_DBL >> 11) & 1
            ssd_conv_phase(projb, INP(3) + (size_t)l * 4 * CONV_DIM, INP(4) + (size_t)l * CONV_DIM, INP(5) + l * SSD_H, xbcc, dtb, vcu, G, tid);
#endif
            SEAM(pb + 2);
        }
        if (IN(pb + 3)) {
            PH_BEGIN
            RwScan a; a.proj_ = projb; a.lw_ = lw; a.mix = INP(9) + (size_t)l * RW_SHIFT; a.w0 = INP(11) + l * 1024; a.a0 = INP(13) + l * 1024; a.v0 = INP(15) + (l > 0 ? l - 1 : 0) * 1024;
            a.k_k = INP(18) + l * 1024; a.k_a = INP(19) + l * 1024; a.r_k = INP(20) + l * 1024; a.vf_ = vfirst; a.y_ = yrw; a.bon_ = bon; a.layer = l; a.pad = 0;
            rwkv_scan_phase(lds, a, vcu, G, tid);
#if (MK_DBL >> 3) & 1
            rwkv_scan_phase(lds, a, vcu, G, tid);
#endif
            ssd_scan_phase(lds, xbcc, dtb, INP(6) + l * SSD_H, INP(7) + l * SSD_H, yssd, vcu, G, tid);
#if (MK_DBL >> 10) & 1
            ssd_scan_phase(lds, xbcc, dtb, INP(6) + l * SSD_H, INP(7) + l * SSD_H, yssd, vcu, G, tid);
#endif
            SEAM(pb + 3);
        }
        if (IN(pb + 4)) {
            PH_BEGIN
            rwkv_post_phase(yrw, bon, lw + (size_t)2 * M * 1024, INP(21) + l * 1024, INP(22) + l * 1024, ymixb, gw, NGW, lane);
#if (MK_DBL >> 4) & 1
            rwkv_post_phase(yrw, bon, lw + (size_t)2 * M * 1024, INP(21) + l * 1024, INP(22) + l * 1024, ymixb, gw, NGW, lane);
#endif
            ssd_post_phase(yssd, projb, INP(8) + l * 1024, ymixb, gw, NGW, lane);
#if (MK_DBL >> 4) & 1
            ssd_post_phase(yssd, projb, INP(8) + l * 1024, ymixb, gw, NGW, lane);
#endif
            SEAM(pb + 4);
        }
        if (IN(pb + 5)) {
            PH_BEGIN
            pg8::Gemm g{ymixb, Wout_t, D}; pg8::StaticOrder S; S.init(M, D, G, bx);
            pg8::EpiBf16 E{(bf16_t*)mixed, FLD};
#if (MK_DBL >> 14) & 1
            { pg8::RepeatOrder R; R.init2(M, D, G, bx, 2); pg8::gemm_phase<pg8::EpiBf16, pg8::RepeatOrder>(lds, g, R, E, tid); }
#else
            pg8::gemm_phase<pg8::EpiBf16, pg8::StaticOrder>(lds, g, S, E, tid);
#endif
#if (MK_DBL >> 5) & 1
            pg8::gemm_phase<pg8::EpiBf16, pg8::StaticOrder>(lds, g, S, E, tid);
#endif
            SEAM(pb + 5);
        }
        if (IN(pb + 6)) {
            PH_BEGIN
            const float* xin = (l == 0) ? INP(0) : xf;
            const float* gam = INP(24) + l * D; const float* bet = INP(25) + l * D;
            LAS float* rs = (LAS float*)lds;
            if (moe) { const float* router = INP(31) + (size_t)li * D * NE;
                for (int i = tid; i < D * NE; i += 512) rs[(i & 7) * D + (i >> 3)] = router[i];
                __syncthreads(); }
            for (int m = gw; m < M; m += NGW) {
                f32x4 v[8];
#pragma unroll
                for (int j = 0; j < 8; ++j) { const size_t o = (size_t)m * D + 4 * lane + 256 * j; const u32x2 mw = *(const u32x2*)((const bf16_t*)mixed + (size_t)m * FLD + 4 * lane + 256 * j); v[j] = ALPHA * *(const f32x4*)(xin + o) + (f32x4){bf_lo(mw.x), bf_hi(mw.x), bf_lo(mw.y), bf_hi(mw.y)}; }
                ln_finish(v, gam, bet, lane, xf + (size_t)m * D, xb + (size_t)m * D);
                if (moe) {
                    float lg[8];
#pragma unroll
                    for (int e = 0; e < 8; ++e) { float s = 0.f;
#pragma unroll
                        for (int j = 0; j < 8; ++j) { const f32x4 r = *(const LAS f32x4*)(rs + e * D + 4 * lane + 256 * j); s += (v[j][0] * r[0] + v[j][1] * r[1]) + (v[j][2] * r[2] + v[j][3] * r[3]); }
                        lg[e] = wave_sum_f(s); }
                    if (lane == 0) {
                        int i0 = 0; float v0 = lg[0];
#pragma unroll
                        for (int e = 1; e < 8; ++e) if (lg[e] > v0) { v0 = lg[e]; i0 = e; }
                        int i1 = -1; float v1 = -3.4e38f;
#pragma unroll
                        for (int e = 0; e < 8; ++e) if (e != i0 && lg[e] > v1) { v1 = lg[e]; i1 = e; }
                        const float e1 = expf(v1 - v0);
                        tok_e[2 * m] = i0; tok_e[2 * m + 1] = i1; tok_g[2 * m] = 1.f / (1.f + e1); tok_g[2 * m + 1] = e1 / (1.f + e1);
                        tok_pos[2 * m] = atomicAdd(&cnt[i0], 1); tok_pos[2 * m + 1] = atomicAdd(&cnt[i1], 1);
                    }
                }
            }
            __syncthreads();
            SEAM(pb + 6);
        }
        if (IN(pb + 7)) {
            PH_BEGIN
            LAS float* scr = (LAS float*)(lds + wave * 16384);
            for (int rep_ = 0; rep_ < 1 + ((MK_DBL >> 7) & 1); ++rep_) {
            if (!moe) {
                cvt_job<1>(INP(28) + (size_t)li * D * DFF, D, DFF, Wffn, 0, 0, scr, gw, NGW, lane);
                cvt_job<1>(INP(29) + (size_t)li * D * DFF, D, DFF, Wffn, 0, 1, scr, gw, NGW, lane);
                cvt_job<0>(INP(30) + (size_t)li * DFF * D, DFF, D, Wffn + (size_t)2 * DFF * D, 0, 0, scr, gw, NGW, lane);
            } else {
                for (int e = 0; e < NE; ++e) {
                    cvt_job<1>(INP(32) + ((size_t)li * NE + e) * D * DFE, D, DFE, Wffn, e * 2 * DFE, 0, scr, gw, NGW, lane);
                    cvt_job<1>(INP(33) + ((size_t)li * NE + e) * D * DFE, D, DFE, Wffn, e * 2 * DFE, 1, scr, gw, NGW, lane);
                    cvt_job<0>(INP(34) + ((size_t)li * NE + e) * DFE * D, DFE, D, Wffn + (size_t)NE * 2 * DFE * D, e * D, 0, scr, gw, NGW, lane);
                }
            }
            }
            if (moe) {
                int start[8]; { int acc = 0;
#pragma unroll
                    for (int e = 0; e < 8; ++e) { start[e] = acc; acc += ((cnt[e] + 255) >> 8) << 8; } }
                for (int m = gw; m < M; m += NGW) {
                    u32x4 r[4];
#pragma unroll
                    for (int j = 0; j < 4; ++j) r[j] = *(const u32x4*)(xb + (size_t)m * D + 8 * lane + 512 * j);
#pragma unroll
                    for (int s = 0; s < 2; ++s) {
                        const int e = tok_e[2 * m + s], pos = tok_pos[2 * m + s];
                        int st = 0;
#pragma unroll
                        for (int q = 0; q < 8; ++q) st = (e == q) ? start[q] : st;
                        const int dest = st + pos;
#pragma unroll
                        for (int j = 0; j < 4; ++j) *(u32x4*)(xg + (size_t)dest * D + 8 * lane + 512 * j) = r[j];
                        if (lane == 0) tok_dest[2 * m + s] = dest;
                    }
                }
            }
            __syncthreads();
            SEAM(pb + 7);
        }
        if (IN(pb + 8)) {
            PH_BEGIN
            if (!moe) {
                pg8::Gemm g{xb, Wffn, D}; pg8::StaticOrder S; S.init(M, 2 * DFF, G, bx);
                pg8::EpiSwiglu E{hbuf, DFF};
                pg8::gemm_phase<pg8::EpiSwiglu, pg8::StaticOrder>(lds, g, S, E, tid);
#if (MK_DBL >> 15) & 1
                pg8::gemm_phase<pg8::EpiSwiglu, pg8::StaticOrder>(lds, g, S, E, tid);
#endif
            } else {
                pg8::Gemm g{xg, Wffn, D}; pg8::GroupedOrder S; S.init(cnt, 2 * DFE, G, bx);
                pg8::EpiSwiglu E{hbuf, DFE};
                pg8::gemm_phase<pg8::EpiSwiglu, pg8::GroupedOrder>(lds, g, S, E, tid);
#if (MK_DBL >> 16) & 1
                pg8::gemm_phase<pg8::EpiSwiglu, pg8::GroupedOrder>(lds, g, S, E, tid);
#endif
            }
            SEAM(pb + 8);
        }
        if (IN(pb + 9)) {
            PH_BEGIN
            if (!moe) {
                pg8::Gemm g{hbuf, Wffn + (size_t)2 * DFF * D, DFF}; pg8::StaticOrder S; S.init(M, D, G, bx);
                pg8::EpiF32 E{yslot, FLD};
                pg8::gemm_phase<pg8::EpiF32, pg8::StaticOrder>(lds, g, S, E, tid);
#if (MK_DBL >> 17) & 1
                pg8::gemm_phase<pg8::EpiF32, pg8::StaticOrder>(lds, g, S, E, tid);
#endif
#if (MK_DBL >> 5) & 1
            pg8::gemm_phase<pg8::EpiF32, pg8::StaticOrder>(lds, g, S, E, tid);
#endif
            } else {
                pg8::Gemm g{hbuf, Wffn + (size_t)NE * 2 * DFE * D, DFE}; pg8::GroupedOrder S; S.init(cnt, D, G, bx);
                pg8::EpiF32 E{yslot, FLD};
                pg8::gemm_phase<pg8::EpiF32, pg8::GroupedOrder>(lds, g, S, E, tid);
#if (MK_DBL >> 18) & 1
                pg8::gemm_phase<pg8::EpiF32, pg8::GroupedOrder>(lds, g, S, E, tid);
#endif
            }
            SEAM(pb + 9);
        }
        if (IN(pb + 10)) {
            PH_BEGIN
            const float* gam = INP(26) + l * D; const float* bet = INP(27) + l * D;
            float* dst = (l == 3) ? P.out : xf;
            for (int m = gw; m < M; m += NGW) {
                f32x4 v[8];
                if (!moe) {
#pragma unroll
                    for (int j = 0; j < 8; ++j) { const size_t o = (size_t)m * D + 4 * lane + 256 * j; v[j] = ALPHA * *(const f32x4*)(xf + o) + *(const f32x4*)(yslot + (size_t)m * FLD + 4 * lane + 256 * j); }
                } else {
                    const int d0 = tok_dest[2 * m], d1 = tok_dest[2 * m + 1]; const float g0 = tok_g[2 * m], g1 = tok_g[2 * m + 1];
#pragma unroll
                    for (int j = 0; j < 8; ++j) { const int c = 4 * lane + 256 * j;
                        v[j] = ALPHA * *(const f32x4*)(xf + (size_t)m * D + c) + g0 * *(const f32x4*)(yslot + (size_t)d0 * FLD + c) + g1 * *(const f32x4*)(yslot + (size_t)d1 * FLD + c); }
                }
                ln_finish(v, gam, bet, lane, dst + (size_t)m * D, (l == 3) ? (bf16_t*)nullptr : xb + (size_t)m * D);
            }
            SEAM(pb + 10);
        }
    }
#undef IN
#undef SEAM
}
#undef PH_BEGIN
#undef INP
#undef Win_t
#undef Wout_t
#undef Wffn
#undef Wl_w
#undef Wl_a
#undef Wl_g
#undef Wl_v
#undef xf
#undef xb
#undef projb
#undef ymixb
#undef mixed
#undef hbuf
#undef xg
#undef yslot
#undef xbcc
#undef dtb
#undef yssd
#undef lw
#undef yrw
#undef bon
#undef vfirst
#undef tok_e
#undef tok_pos
#undef tok_g
#undef tok_dest
#undef cnt


}

extern "C" void kernel_launch(void* const* d_in, const int* in_sizes, int n_in, void* d_out, int out_size, void* d_ws, size_t ws_size, hipStream_t stream) {
    (void)in_sizes; (void)out_size;
    static int grid = 0;
    if (grid == 0) {
        if (n_in != 35 || ws_size < WS_END) { fprintf(stderr, "kernel_launch: need 35 inputs and %zu bytes of workspace (got %d, %zu)\n", (size_t)WS_END, n_in, ws_size); grid = -1; return; }
        int dev = 0, cus = 0;
        if (hipGetDevice(&dev) != hipSuccess || hipDeviceGetAttribute(&cus, hipDeviceAttributeMultiprocessorCount, dev) != hipSuccess) { grid = -1; return; }
        if (hipFuncSetAttribute((const void*)fwd, hipFuncAttributeMaxDynamicSharedMemorySize, LDS_BYTES) != hipSuccess) { fprintf(stderr, "kernel_launch: hipFuncSetAttribute failed\n"); grid = -1; return; }
        int per_cu = 0;
        if (hipOccupancyMaxActiveBlocksPerMultiprocessor(&per_cu, (const void*)fwd, NWAVES * 64, LDS_BYTES) != hipSuccess || per_cu < 1) { fprintf(stderr, "kernel_launch: occupancy query says %d blocks per CU\n", per_cu); }
        (void)hipGetLastError();
        grid = cus;
    }
    if (grid < 0) return;
    unsigned char* ws = (unsigned char*)d_ws;
    (void)hipMemsetAsync(ws + WS_CTL, 0, CTL_BYTES, stream);
    Params P{};
    for (int i = 0; i < 35; ++i) P.in[i] = (const float*)d_in[i];
    P.out = (float*)d_out; P.ws = ws; P.pad = 0;
    int nbar = 0;
    auto run = [&](int lo, int hi) {
        P.ph_lo = lo; P.ph_hi = hi; P.bar_idx = (hi - lo > 1) ? nbar++ : 0;
        hipLaunchKernelGGL(fwd, dim3(grid), dim3(NWAVES * 64), LDS_BYTES, stream, P);
    };
    if (MK_LAUNCH_MODE == 1) run(0, 64);
    else if (MK_LAUNCH_MODE == 4) { for (int l = 0; l < 4; ++l) run(l * 16, l * 16 + 16); }
    else { for (int l = 0; l < 4; ++l) for (int k = 0; k <= 10; ++k) run(l * 16 + k, l * 16 + k + 1); }
}
```

```cpp
#define MK_TS_MASK 0
#include <hip/hip_runtime.h>
#include <cstdint>
#include <cstdio>

#ifndef MK_DBL
#define MK_DBL 0
#endif
#ifndef MK_CV_CUT_MOE
#define MK_CV_CUT_MOE 16896
#endif
#ifndef MK_CV_CUT_DENSE
#define MK_CV_CUT_DENSE 16896
#endif
#ifndef MK_RWKV_CHUNKED
#define MK_RWKV_CHUNKED 2
#endif
#ifndef MK_GEMM_8PH
#define MK_GEMM_8PH 0
#endif
#ifndef MK_LAUNCH_MODE
#define MK_LAUNCH_MODE 1
#endif
namespace {
constexpr int BATCH = 8, SEQ = 2048, M = BATCH * SEQ, D = 2048;
constexpr int HD = 64, SSD_H = 16, SSD_N = 128, CONV_DIM = 1536;
constexpr int RW_H = 16;
constexpr int IN_DIM = 5936, PROJ_LD = 5968;
constexpr int OFF_Z = 0, OFF_XBC = 1024, OFF_DT = 2560, OFF_RW = 2576, OFF_R = 2576, OFF_K = 3600, OFF_V = 4624, OFF_WLO = 5648, OFF_ALO = 5712, OFF_GLO = 5776, OFF_VLO = 5936;
constexpr int RW_SHIFT = 3360;
constexpr int DFF = 5632, NE = 8, DFE = 2816;
constexpr float ALPHA = 1.681792830507429f;
constexpr int LORA_LD = 320;

__device__ __forceinline__ float sigmoidf_(float x) { return 1.f / (1.f + expf(-x)); }
__device__ __forceinline__ float siluf_(float x) { return x / (1.f + expf(-x)); }
__device__ __forceinline__ float softplusf_(float x) { return fmaxf(x, 0.f) + log1pf(expf(-fabsf(x))); }
__device__ __forceinline__ float wave_sum(float v) {
#pragma unroll
    for (int o = 32; o >= 1; o >>= 1) v += __shfl_xor(v, o);
    return v;
}


#define LAS __attribute__((address_space(3)))
typedef unsigned short bf16_t;
typedef short bf16x8 __attribute__((ext_vector_type(8)));
typedef float f32x4 __attribute__((ext_vector_type(4)));
typedef float f32x2 __attribute__((ext_vector_type(2)));
typedef unsigned u32x4 __attribute__((ext_vector_type(4)));
typedef unsigned u32x2 __attribute__((ext_vector_type(2)));

typedef __bf16 bf16x2_t __attribute__((ext_vector_type(2)));
__device__ __forceinline__ unsigned cvt_pk_bf16(float lo, float hi) { const f32x2 v = {lo, hi}; const bf16x2_t b = __builtin_convertvector(v, bf16x2_t); return __builtin_bit_cast(unsigned, b); }
__device__ __forceinline__ float bf_lo(unsigned w) { return __uint_as_float(w << 16); }
__device__ __forceinline__ float bf_hi(unsigned w) { return __uint_as_float(w & 0xffff0000u); }
__device__ __forceinline__ float bf2f(bf16_t b) { return __uint_as_float(((unsigned)b) << 16); }
__device__ __forceinline__ float opaque0() { float z = 0.f; asm volatile("" : "+v"(z)); return z; }
#define ZERO4() ((f32x4){opaque0(), 0.f, 0.f, 0.f} * 0.f)
__device__ __forceinline__ float fast_silu(float x) { return x * __builtin_amdgcn_rcpf(1.f + __builtin_amdgcn_exp2f(-1.4426950408889634f * x)); }

namespace pg8 {
constexpr int BM = 256, BK = 64, HALF = 128, HTB = HALF * BK * 2, STAGE_BYTES = 8 * HTB, NXCD = 8, WGM = 8;
__host__ __device__ __forceinline__ int lds_byte(int r, int c) { const int st = (r >> 4) * 2 + (c >> 5), rr = r & 15, cc = c & 31, ob = rr * 64 + cc * 2; return st * 1024 + (ob ^ (((ob >> 9) & 1) << 5)); }
__host__ __device__ __forceinline__ void stage_rc(int b, int& R, int& C) { const int st = b / 1024, sb = b % 1024, swz = sb ^ (((sb >> 9) & 1) << 5); R = (st >> 1) * 16 + swz / 64; C = (st & 1) * 32 + (swz % 64) / 2; }
__host__ __device__ __forceinline__ int perm32(int rho) { const int n = rho >> 4, i = rho & 15; return 8 * (i >> 2) + 4 * n + (i & 3); }

struct Unit { int pm, pn, pb; };
struct Gemm { const bf16_t* A; const bf16_t* Bt; int K; const int* rowmap = nullptr; };

__device__ __forceinline__ void decode_unit(int wgid, int nM, int nN, int& pm, int& pn) {
    const int nwg = nM * nN;
    { const int q = nwg / NXCD, r = nwg % NXCD, xcd = wgid % NXCD, off = wgid / NXCD; wgid = (xcd < r ? xcd * (q + 1) : r * (q + 1) + (xcd - r) * q) + off; }
    const int nig = WGM * nN, gid = wgid / nig, fm = gid * WGM, gsz = (nM - fm) < WGM ? (nM - fm) : WGM;
    pm = fm + ((wgid % nig) % gsz); pn = (wgid % nig) / gsz;
}
struct StaticOrder {
    int nM, nN, nwg, G, c;
    __device__ void init(int Mrows, int N, int G_, int c_) { nM = Mrows / BM; nN = N / BM; nwg = nM * nN; G = G_; c = c_; }
    __device__ __forceinline__ bool next(int i, Unit& u) const {
        const long L = (long)i * G + c; if (L >= nwg) return false;
        decode_unit((int)L, nM, nN, u.pm, u.pn); u.pb = u.pn; return true;
    }
};
struct RepeatOrder : StaticOrder {
    int per, reps;
    __device__ void init2(int Mrows, int N, int G_, int c_, int reps_) { init(Mrows, N, G_, c_); per = (nwg + G - 1) / G; reps = reps_; }
    __device__ __forceinline__ bool next(int i, Unit& u) const { if (i >= per * reps) return false; return StaticOrder::next(i % per, u); }
};
struct GroupedOrder {
    int nM, nN, nwg, G, c; int cum[9];
    __device__ void init(const int* cnt, int N, int G_, int c_) {
        int acc = 0;
#pragma unroll
        for (int e = 0; e < 8; ++e) { cum[e] = acc; acc += (cnt[e] + 255) >> 8; }
        cum[8] = acc; nM = acc; nN = N / BM; nwg = nM * nN; G = G_; c = c_;
    }
    __device__ __forceinline__ bool next(int i, Unit& u) const {
        const long L = (long)i * G + c; if (L >= nwg) return false;
        decode_unit((int)L, nM, nN, u.pm, u.pn);
        int e = 0;
#pragma unroll
        for (int q = 1; q < 8; ++q) e += (u.pm >= cum[q]) ? 1 : 0;
        u.pb = e * nN + u.pn; return true;
    }
};

struct EpiF32 {
    static constexpr bool PERM = false;
    float* C; int ldc;
    __device__ __forceinline__ void operator()(const f32x4 (&acc)[2][2][4][2], const Unit& u, int wr, int wc, int fr, int fq) const {
        const int row0 = u.pm * BM + wr * 64 + fr, col0 = u.pn * BM + wc * 32 + 4 * fq;
#pragma unroll
        for (int ai = 0; ai < 2; ++ai)
#pragma unroll
            for (int m = 0; m < 4; ++m) { float* rowp = C + (size_t)(row0 + ai * HALF + m * 16) * ldc + col0;
#pragma unroll
                for (int bj = 0; bj < 2; ++bj)
#pragma unroll
                    for (int n = 0; n < 2; ++n) *(f32x4*)(rowp + bj * HALF + n * 16) = acc[ai][bj][m][n]; }
    }
};
struct EpiBf16 {
    static constexpr bool PERM = true;
    bf16_t* O; int ldc;
    __device__ __forceinline__ void operator()(const f32x4 (&acc)[2][2][4][2], const Unit& u, int wr, int wc, int fr, int fq) const {
        const int row0 = u.pm * BM + wr * 64 + fr, col0 = u.pn * BM + wc * 32 + 8 * fq;
#pragma unroll
        for (int ai = 0; ai < 2; ++ai)
#pragma unroll
            for (int m = 0; m < 4; ++m) { bf16_t* rowp = O + (size_t)(row0 + ai * HALF + m * 16) * ldc + col0;
#pragma unroll
                for (int bj = 0; bj < 2; ++bj) { const f32x4 v0 = acc[ai][bj][m][0], v1 = acc[ai][bj][m][1];
                    u32x4 w; w.x = cvt_pk_bf16(v0[0], v0[1]); w.y = cvt_pk_bf16(v0[2], v0[3]); w.z = cvt_pk_bf16(v1[0], v1[1]); w.w = cvt_pk_bf16(v1[2], v1[3]);
                    *(u32x4*)(rowp + bj * HALF) = w; } }
    }
};
struct EpiSwiglu {
    static constexpr bool PERM = true;
    bf16_t* O; int ldc;
    __device__ __forceinline__ void operator()(const f32x4 (&acc)[2][2][4][2], const Unit& u, int wr, int wc, int fr, int fq) const {
        const int row0 = u.pm * BM + wr * 64 + fr, col0 = u.pn * HALF + wc * 32 + 8 * fq;
#pragma unroll
        for (int ai = 0; ai < 2; ++ai)
#pragma unroll
            for (int m = 0; m < 4; ++m) { bf16_t* rowp = O + (size_t)(row0 + ai * HALF + m * 16) * ldc + col0;
                float o[8];
#pragma unroll
                for (int n = 0; n < 2; ++n)
#pragma unroll
                    for (int i = 0; i < 4; ++i) o[n * 4 + i] = fast_silu(acc[ai][0][m][n][i]) * acc[ai][1][m][n][i];
                u32x4 w; w.x = cvt_pk_bf16(o[0], o[1]); w.y = cvt_pk_bf16(o[2], o[3]); w.z = cvt_pk_bf16(o[4], o[5]); w.w = cvt_pk_bf16(o[6], o[7]);
                *(u32x4*)rowp = w; }
    }
};

template <class Epi, class Sched, bool GATHER = false>
__device__ __forceinline__ void gemm_phase(LAS unsigned char* lds, const Gemm g, const Sched& S, const Epi& E, const int tid) {
    const int wid = __builtin_amdgcn_readfirstlane(tid >> 6), lane = tid & 63, wr = wid >> 2, wc = wid & 3, fr = lane & 15, fq = lane >> 4;
    const int K = g.K, nt = K / BK;
    unsigned voffA[2], voffB[2];
#pragma unroll
    for (int i = 0; i < 2; ++i) { int R, C; stage_rc(tid * 16 + i * 8192, R, C); const int Rb = Epi::PERM ? ((R & ~31) + perm32(R & 31)) : R;
        voffA[i] = (unsigned)(R * K + C) * 2u; voffB[i] = (unsigned)(Rb * K + C) * 2u; }
    unsigned goC[2][2], goN[2][2];
#define PG8_GLOOK(dst, unit_) do { _Pragma("unroll") for (int h_ = 0; h_ < 2; ++h_) _Pragma("unroll") for (int i_ = 0; i_ < 2; ++i_) { int R_, C_; stage_rc(tid * 16 + i_ * 8192, R_, C_); \
        dst[h_][i_] = (unsigned)(g.rowmap[(unit_).pm * BM + h_ * HALF + R_] * K + C_) * 2u; } } while (0)
#define PG8_STAGE_G(bufoff, kb_, go_, h_) do { _Pragma("unroll") for (int _i = 0; _i < 2; ++_i) \
        __builtin_amdgcn_global_load_lds((const unsigned*)((const char*)g.A + (kb_) + (go_)[h_][_i]), (LAS unsigned*)(lds + (bufoff) + ldsw + _i * 8192), 16, 0, 0); } while (0)
#define PG8_STAGE_A(bufoff, base_, nx_, kb_, h_) do { if (GATHER) { if (nx_) PG8_STAGE_G(bufoff, kb_, goN, h_); else PG8_STAGE_G(bufoff, kb_, goC, h_); } \
        else PG8_STAGE(bufoff, (base_) + (kb_) + (h_) * hstep, voffA); } while (0)
    const size_t kstep = (size_t)(BK * 2);
    const size_t hstep = (size_t)HALF * K * 2;
    const size_t tstep = 2 * hstep;
    const unsigned ldsw = (unsigned)wid * 1024u;
    const int aoff = lds_byte(wr * 64 + fr, fq * 8), boff = lds_byte(wc * 32 + fr, fq * 8);
#define PG8_SA(b, h) (((b) * 2 + (h)) * HTB)
#define PG8_SB(b, h) ((4 + (b) * 2 + (h)) * HTB)
#define PG8_STAGE(bufoff, gbase, voff) do { _Pragma("unroll") for (int _i = 0; _i < 2; ++_i) \
        __builtin_amdgcn_global_load_lds((const unsigned*)((const char*)(gbase) + (voff)[_i]), (LAS unsigned*)(lds + (bufoff) + ldsw + _i * 8192), 16, 0, 0); } while (0)
#define PG8_LDA(dst, b, h) do { _Pragma("unroll") for (int m = 0; m < 4; ++m) _Pragma("unroll") for (int k = 0; k < 2; ++k) dst[m][k] = *(const LAS bf16x8*)(lds + PG8_SA(b, h) + aoff + m * 2048 + k * 1024); } while (0)
#define PG8_LDB(dst, b, h) do { _Pragma("unroll") for (int n = 0; n < 2; ++n) _Pragma("unroll") for (int k = 0; k < 2; ++k) dst[n][k] = *(const LAS bf16x8*)(lds + PG8_SB(b, h) + boff + n * 2048 + k * 1024); } while (0)
#define PG8_MMA(ai, bj, At, Bt) do { __builtin_amdgcn_s_setprio(1); _Pragma("unroll") for (int m = 0; m < 4; ++m) _Pragma("unroll") for (int n = 0; n < 2; ++n) _Pragma("unroll") for (int k = 0; k < 2; ++k) \
        acc[ai][bj][m][n] = __builtin_amdgcn_mfma_f32_16x16x32_bf16(Bt[n][k], At[m][k], acc[ai][bj][m][n], 0, 0, 0); __builtin_amdgcn_s_setprio(0); } while (0)
#define PG8_WAIT_V(n) asm volatile("s_waitcnt vmcnt(" #n ")" ::: "memory")
#define PG8_WAIT_L(n) asm volatile("s_waitcnt lgkmcnt(" #n ")" ::: "memory")
#define PG8_BAR __builtin_amdgcn_s_barrier()
#define PG8_SCHED __builtin_amdgcn_sched_barrier(0)
    Unit cur, nxt; int ui = 0;
    if (!S.next(0, cur)) return;
    f32x4 acc[2][2][4][2];
#pragma unroll
    for (int a = 0; a < 2; ++a)
#pragma unroll
        for (int b = 0; b < 2; ++b)
#pragma unroll
            for (int m = 0; m < 4; ++m)
#pragma unroll
                for (int n = 0; n < 2; ++n) acc[a][b][m][n] = ZERO4();
    bf16x8 At[4][2], B0[2][2], B1[2][2];
    const char* cA = (const char*)g.A + (size_t)cur.pm * tstep; const char* cB = (const char*)g.Bt + (size_t)cur.pb * tstep;
#if MK_GEMM_8PH
    PG8_STAGE(PG8_SB(0, 0), cB, voffB); PG8_STAGE(PG8_SA(0, 0), cA, voffA); PG8_STAGE(PG8_SB(0, 1), cB + hstep, voffB); PG8_STAGE(PG8_SA(0, 1), cA + hstep, voffA);
    if (wr == 1) PG8_BAR;
    PG8_WAIT_V(4); PG8_BAR;
    PG8_STAGE(PG8_SB(1, 0), cB + kstep, voffB); PG8_STAGE(PG8_SA(1, 0), cA + kstep, voffA); PG8_STAGE(PG8_SB(1, 1), cB + hstep + kstep, voffB);
    PG8_WAIT_V(6); PG8_BAR;
#else
    if (GATHER) { PG8_GLOOK(goC, cur); PG8_GLOOK(goN, cur); }
    PG8_STAGE(PG8_SB(0, 0), cB, voffB); PG8_STAGE(PG8_SB(0, 1), cB + hstep, voffB); PG8_STAGE_A(PG8_SA(0, 0), cA, false, 0, 0); PG8_STAGE_A(PG8_SA(0, 1), cA, false, 0, 1);
    if (wr == 1) PG8_BAR;
    PG8_WAIT_V(2); PG8_BAR;
    PG8_STAGE(PG8_SB(1, 0), cB + kstep, voffB); PG8_STAGE_A(PG8_SA(1, 0), cA, false, kstep, 0); PG8_STAGE(PG8_SB(1, 1), cB + hstep + kstep, voffB);
    PG8_WAIT_V(6); PG8_BAR;
#endif
    for (;;) {
        const bool has_next = S.next(ui + 1, nxt);
        const char* nA = has_next ? (const char*)g.A + (size_t)nxt.pm * tstep : cA; const char* nB = has_next ? (const char*)g.Bt + (size_t)nxt.pb * tstep : cB;
        if (GATHER && has_next && wid < 4) __builtin_amdgcn_global_load_lds((const unsigned*)(g.rowmap + nxt.pm * BM + tid), (LAS unsigned*)(lds + STAGE_BYTES + ((ui + 1) & 1) * 1024 + wid * 256), 4, 0, 0);
        for (int t = 0; t < nt; t += 2) {
            const bool last = (t == nt - 2);
            const char* a1 = cA + (size_t)(t + 1) * kstep;
            const char* a2 = last ? nA : cA + (size_t)(t + 2) * kstep; const char* b2 = last ? nB : cB + (size_t)(t + 2) * kstep;
            const char* a3 = a2 + kstep; const char* b3 = b2 + kstep;
#if MK_GEMM_8PH
            PG8_LDB(B0, 0, 0); PG8_SCHED; PG8_LDA(At, 0, 0); PG8_STAGE(PG8_SA(1, 1), a1 + hstep, voffA);
            PG8_WAIT_L(8); PG8_BAR; PG8_WAIT_L(0); PG8_MMA(0, 0, At, B0); PG8_BAR; PG8_SCHED;
            PG8_LDB(B1, 0, 1); PG8_STAGE(PG8_SB(0, 0), b2, voffB);
            PG8_BAR; PG8_WAIT_L(0); PG8_MMA(0, 1, At, B1); PG8_BAR;
            PG8_LDA(At, 0, 1); PG8_STAGE(PG8_SA(0, 0), a2, voffA);
            PG8_BAR; PG8_WAIT_L(0); PG8_MMA(1, 0, At, B0); PG8_BAR; PG8_SCHED;
            PG8_STAGE(PG8_SB(0, 1), b2 + hstep, voffB);
            PG8_WAIT_V(6); PG8_BAR; PG8_MMA(1, 1, At, B1); PG8_BAR;
            PG8_LDB(B0, 1, 0); PG8_SCHED; PG8_LDA(At, 1, 0); PG8_STAGE(PG8_SA(0, 1), a2 + hstep, voffA);
            PG8_WAIT_L(8); PG8_BAR; PG8_WAIT_L(0); PG8_MMA(0, 0, At, B0); PG8_BAR; PG8_SCHED;
            PG8_LDB(B1, 1, 1); PG8_STAGE(PG8_SB(1, 0), b3, voffB);
            PG8_BAR; PG8_WAIT_L(0); PG8_MMA(0, 1, At, B1); PG8_BAR;
            PG8_LDA(At, 1, 1); PG8_STAGE(PG8_SA(1, 0), a3, voffA);
            PG8_BAR; PG8_WAIT_L(0); PG8_MMA(1, 0, At, B0); PG8_BAR; PG8_SCHED;
            PG8_STAGE(PG8_SB(1, 1), b3 + hstep, voffB);
            PG8_WAIT_V(6); PG8_BAR; PG8_MMA(1, 1, At, B1); PG8_BAR;
#else
            if (GATHER && last && has_next) {
                const LAS int* ib_ = (const LAS int*)(lds + STAGE_BYTES + ((ui + 1) & 1) * 1024);
#pragma unroll
                for (int h_ = 0; h_ < 2; ++h_)
#pragma unroll
                    for (int i_ = 0; i_ < 2; ++i_) { int R_, C_; stage_rc(tid * 16 + i_ * 8192, R_, C_); goN[h_][i_] = (unsigned)(ib_[h_ * HALF + R_] * K + C_) * 2u; }
            }
            const size_t kb1 = (size_t)(t + 1) * kstep, kb2 = last ? (size_t)0 : (size_t)(t + 2) * kstep, kb3 = kb2 + kstep;
            PG8_LDB(B0, 0, 0); PG8_LDB(B1, 0, 1); PG8_SCHED; PG8_LDA(At, 0, 0); PG8_STAGE_A(PG8_SA(1, 1), cA, false, kb1, 1);
            PG8_WAIT_V(8); PG8_WAIT_L(0); PG8_BAR; PG8_MMA(0, 0, At, B0); PG8_MMA(0, 1, At, B1); PG8_BAR; PG8_SCHED;
            PG8_LDA(At, 0, 1); PG8_STAGE(PG8_SB(0, 0), b2, voffB); PG8_STAGE(PG8_SB(0, 1), b2 + hstep, voffB); PG8_STAGE_A(PG8_SA(0, 0), (last ? nA : cA), last, kb2, 0);
            PG8_WAIT_V(8); PG8_WAIT_L(0); PG8_BAR; PG8_MMA(1, 0, At, B0); PG8_MMA(1, 1, At, B1); PG8_BAR; PG8_SCHED;
            PG8_LDB(B0, 1, 0); PG8_LDB(B1, 1, 1); PG8_SCHED; PG8_LDA(At, 1, 0); PG8_STAGE_A(PG8_SA(0, 1), (last ? nA : cA), last, kb2, 1);
            PG8_WAIT_V(8); PG8_WAIT_L(0); PG8_BAR; PG8_MMA(0, 0, At, B0); PG8_MMA(0, 1, At, B1); PG8_BAR; PG8_SCHED;
            PG8_LDA(At, 1, 1); PG8_STAGE(PG8_SB(1, 0), b3, voffB); PG8_STAGE(PG8_SB(1, 1), b3 + hstep, voffB); PG8_STAGE_A(PG8_SA(1, 0), (last ? nA : cA), last, kb3, 0);
            PG8_WAIT_V(8); PG8_WAIT_L(0); PG8_BAR; PG8_MMA(1, 0, At, B0); PG8_MMA(1, 1, At, B1); PG8_BAR; PG8_SCHED;
#endif
        }
        if (wr == 0) PG8_BAR;
        E(acc, cur, wr, wc, fr, fq);
        if (!has_next) break;
#pragma unroll
        for (int a = 0; a < 2; ++a)
#pragma unroll
            for (int b = 0; b < 2; ++b)
#pragma unroll
                for (int m = 0; m < 4; ++m)
#pragma unroll
                    for (int n = 0; n < 2; ++n) acc[a][b][m][n] = ZERO4();
        cur = nxt; cA = nA; cB = nB; ++ui;
        if (GATHER) {
#pragma unroll
            for (int h_ = 0; h_ < 2; ++h_) { goC[h_][0] = goN[h_][0]; goC[h_][1] = goN[h_][1]; } }
        if (wr == 1) PG8_BAR;
    }
    PG8_WAIT_V(0);
    PG8_BAR;
#undef PG8_SA
#undef PG8_SB
#undef PG8_STAGE
#undef PG8_STAGE_A
#undef PG8_STAGE_G
#undef PG8_GLOOK
#undef PG8_LDA
#undef PG8_LDB
#undef PG8_MMA
#undef PG8_WAIT_V
#undef PG8_WAIT_L
#undef PG8_BAR
#undef PG8_SCHED
}
}

#define XB_TMO      128
#define XB_XCNT(j)  (256  + 64 * (j))
#define XB_XSUB(j)  (1280 + 64 * (j))
#define XB_XGEN(j)  (2304 + 64 * (j))
#define XB_TOP      3328
#define XB_TOPGEN   3392
#define XCD_BAR_WORDS 3456
#define XB_SPIN_CAP (1u << 18)
__device__ __forceinline__ unsigned xb_ld(unsigned* p)              { return __hip_atomic_load(p, __ATOMIC_RELAXED, __HIP_MEMORY_SCOPE_AGENT); }
__device__ __forceinline__ unsigned xb_add(unsigned* p, unsigned v) { return __hip_atomic_fetch_add(p, v, __ATOMIC_RELAXED, __HIP_MEMORY_SCOPE_AGENT); }
__device__ __forceinline__ unsigned xb_xcc_id() { return (unsigned)__builtin_amdgcn_s_getreg((3 << 11) | 20) & 0xFu; }
#define XB_SPIN(cond, bar) do { unsigned _sp = 0; while (cond) { __builtin_amdgcn_s_sleep(1); \
    if ((++_sp & 255u) == 0u) { if (xb_ld(&(bar)[XB_TMO])) break; if (_sp > XB_SPIN_CAP) { atomicAdd(&(bar)[XB_TMO], 1u); break; } } } } while (0)
struct XcdBarrier { unsigned* bar; unsigned x; volatile LAS unsigned* st; };
__device__ __forceinline__ XcdBarrier xcd_barrier_post(unsigned* bar, volatile LAS unsigned* st) {
    XcdBarrier b; b.bar = bar; b.x = xb_xcc_id(); b.st = st;
    if (threadIdx.x == 0) (void)xb_add(&bar[XB_XCNT(b.x)], 1u);
    return b;
}
__device__ __forceinline__ void xcd_barrier_complete(unsigned* bar, unsigned x, unsigned& nloc, unsigned& nx) {
    const unsigned G = gridDim.x * gridDim.y * gridDim.z;
    asm volatile("" : "+s"(x));
    unsigned sum, cnt, mine, sp = 0u;
    for (;;) {
        sum = 0u; cnt = 0u; mine = 0u;
#pragma unroll
        for (unsigned j = 0; j < 16; ++j) { const unsigned c = xb_ld(&bar[XB_XCNT(j)]); sum += c; cnt += (c > 0u) ? 1u : 0u; mine = (j == x) ? c : mine; }
        if (sum == G) break;
        __builtin_amdgcn_s_sleep(1);
        if ((++sp & 255u) == 0u) { if (xb_ld(&bar[XB_TMO])) break; if (sp > XB_SPIN_CAP) { atomicAdd(&bar[XB_TMO], 1u); break; } }
    }
    nloc = mine > 0u ? mine : 1u; nx = cnt > 0u ? cnt : 1u;
}
__device__ __forceinline__ void xcd_barrier(const XcdBarrier& b) {
    asm volatile("s_waitcnt vmcnt(0)" ::: "memory");
    __syncthreads();
    if (threadIdx.x == 0) {
        unsigned* bar = b.bar;
        __builtin_amdgcn_s_waitcnt(0);
        unsigned nloc = b.st[0], nx = b.st[1];
        if (nloc == 0u) { xcd_barrier_complete(bar, b.x, nloc, nx); b.st[0] = nloc; b.st[1] = nx; }
        const unsigned old = xb_add(&bar[XB_XSUB(b.x)], 1u);
        const unsigned gen = old / nloc;
        if (old + 1u == (gen + 1u) * nloc) {
            __builtin_amdgcn_fence(__ATOMIC_RELEASE, "agent");
            asm volatile("s_waitcnt vmcnt(0)" ::: "memory");
            const unsigned og = xb_add(&bar[XB_TOP], 1u);
            const unsigned tg = og / nx;
            if (og + 1u == (tg + 1u) * nx) xb_add(&bar[XB_TOPGEN], 1u);
            else XB_SPIN(xb_ld(&bar[XB_TOPGEN]) == tg, bar);
            __builtin_amdgcn_fence(__ATOMIC_ACQUIRE, "agent");
            xb_add(&bar[XB_XGEN(b.x)], 1u);
            asm volatile("s_waitcnt vmcnt(0)" ::: "memory");
        } else {
            XB_SPIN(xb_ld(&bar[XB_XGEN(b.x)]) == gen, bar);
            __builtin_amdgcn_fence(__ATOMIC_ACQUIRE, "agent");
            asm volatile("s_waitcnt vmcnt(0)" ::: "memory");
        }
    }
    __syncthreads();
}

constexpr size_t MiB = 1u << 20;
constexpr int NWAVES = 8;
constexpr int PROJ_BLD = 6144;
constexpr int PMAX = 34816;
constexpr int FLD = 2048 + 64;
constexpr size_t WS_CTL = 0, CTL_BYTES = 1 * MiB;
constexpr size_t WS_WIN = 1 * MiB, WS_WOUT = 25 * MiB, WS_WLORA = 33 * MiB;
constexpr size_t WS_XF = 34 * MiB, WS_XB = 162 * MiB, WS_VFIRST = 226 * MiB, WS_YMIXB = 290 * MiB, WS_TOK = 354 * MiB, WS_SCR = 356 * MiB;
constexpr size_t WS_PROJB = WS_SCR, WS_LW = WS_PROJB + 192 * MiB, WS_YRW = WS_LW + 128 * MiB, WS_BON = WS_YRW + 64 * MiB, WS_XBCC = WS_BON + 64 * MiB, WS_DTB = WS_XBCC + 48 * MiB, WS_YSSD = WS_DTB + 1 * MiB, WS_MIXED = WS_YSSD + 64 * MiB;
constexpr size_t WS_HBUF = WS_SCR, WS_XG = WS_HBUF + 187 * MiB, WS_YSLOT = WS_XG + 136 * MiB;
constexpr size_t WS_WFFN = WS_SCR + 860 * MiB, WS_END = WS_WFFN + 264 * MiB;
constexpr size_t WS_IMG = WS_MIXED;
static_assert(WS_MIXED + 132 * MiB <= WS_WFFN && WS_YSLOT + 281 * MiB <= WS_WFFN, "scratch inside the map");
static_assert((size_t)PMAX * DFE * 2 <= 187 * MiB && (size_t)PMAX * D * 2 <= 136 * MiB && (size_t)PMAX * FLD * 4 <= 281 * MiB && (size_t)M * FLD * 4 <= 132 * MiB, "moe buffers");
constexpr int CW_CNT = 16;
constexpr int CW_BAR = 4096;
constexpr int MAX_BAR_REGIONS = 48;
static_assert((CW_BAR + MAX_BAR_REGIONS * XCD_BAR_WORDS) * 4 <= (int)CTL_BYTES, "ctl");
constexpr int RING_BYTES = 131072, LDS_BYTES = 147456, MISC_OFF = LDS_BYTES - 256;

struct Params { const float* in[35]; float* out; unsigned char* ws; int ph_lo, ph_hi, bar_idx, pad; };

__device__ __forceinline__ float wave_sum_f(float v) {
#pragma unroll
    for (int o = 32; o >= 1; o >>= 1) v += __shfl_xor(v, o);
    return v;
}

__device__ __forceinline__ void cvt_item(const float* W, int K, int N, bf16_t* WT, int dst_row0, LAS float* scr, int k0, int n0, int lane) {
    const int kr = lane >> 3, c4 = (lane & 7) * 4;
    f32x4 v[8];
    if (n0 + 32 <= N && k0 + 64 <= K) {
#pragma unroll
        for (int i = 0; i < 8; ++i) v[i] = *(const f32x4*)(W + (size_t)(k0 + 8 * i + kr) * N + n0 + c4);
    } else {
#pragma unroll
        for (int i = 0; i < 8; ++i) { const int kk = k0 + 8 * i + kr;
#pragma unroll
            for (int e = 0; e < 4; ++e) v[i][e] = (kk < K && n0 + c4 + e < N) ? W[(size_t)kk * N + n0 + c4 + e] : 0.f; }
    }
#pragma unroll
    for (int i = 0; i < 8; ++i) { LAS float* d = scr + (8 * i + kr) * 33 + c4; d[0] = v[i][0]; d[1] = v[i][1]; d[2] = v[i][2]; d[3] = v[i][3]; }
    asm volatile("s_waitcnt lgkmcnt(0)" ::: "memory");
    const int c = lane & 7;
#pragma unroll
    for (int j = 0; j < 4; ++j) { const int n = (lane >> 3) + 8 * j; const LAS float* s = scr + (8 * c) * 33 + n;
        u32x4 o; o.x = cvt_pk_bf16(s[0 * 33], s[1 * 33]); o.y = cvt_pk_bf16(s[2 * 33], s[3 * 33]); o.z = cvt_pk_bf16(s[4 * 33], s[5 * 33]); o.w = cvt_pk_bf16(s[6 * 33], s[7 * 33]);
        if (n0 + n < N && k0 + 8 * c < K) *(u32x4*)(WT + (size_t)(dst_row0 + n) * K + k0 + 8 * c) = o; }
    asm volatile("s_waitcnt lgkmcnt(0)" ::: "memory");
}
template <int MODE>
__device__ __forceinline__ void cvt_job(const float* W, int K, int N, bf16_t* WT, int row_off, int half, LAS float* scr, int gw, int ngw, int lane) {
    const int nkb = (K + 63) / 64, nnb = (N + 31) / 32, nitems = nkb * nnb;
    for (int it = gw; it < nitems; it += ngw) {
        const int kb = it / nnb, nb = it % nnb, n0 = nb * 32;
        const int dr = MODE == 0 ? row_off + n0 : row_off + 256 * (n0 / 128) + half * 128 + (n0 % 128);
        cvt_item(W, K, N, WT, dr, scr, kb * 64, n0, lane);
    }
}

#define DPP_ROR(z, n) __uint_as_float(__builtin_amdgcn_update_dpp(0u, __float_as_uint(z), 0x120 + (n), 0xf, 0xf, false))
__device__ __forceinline__ float wave_allsum(float x) {
    { auto s = __builtin_amdgcn_permlane32_swap(__float_as_uint(x), __float_as_uint(x), false, false); x = __uint_as_float(s[0]) + __uint_as_float(s[1]); }
    { auto s = __builtin_amdgcn_permlane16_swap(__float_as_uint(x), __float_as_uint(x), false, false); x = __uint_as_float(s[0]) + __uint_as_float(s[1]); }
    x += DPP_ROR(x, 8); x += DPP_ROR(x, 4); x += DPP_ROR(x, 2); x += DPP_ROR(x, 1);
    return x;
}
__device__ __forceinline__ float reduce4(float x0, float x1, float x2, float x3) {
    float y0, y1, z;
    { auto s = __builtin_amdgcn_permlane32_swap(__float_as_uint(x0), __float_as_uint(x2), false, false); y0 = __uint_as_float(s[0]) + __uint_as_float(s[1]); }
    { auto s = __builtin_amdgcn_permlane32_swap(__float_as_uint(x1), __float_as_uint(x3), false, false); y1 = __uint_as_float(s[0]) + __uint_as_float(s[1]); }
    { auto s = __builtin_amdgcn_permlane16_swap(__float_as_uint(y0), __float_as_uint(y1), false, false); z = __uint_as_float(s[0]) + __uint_as_float(s[1]); }
    z += DPP_ROR(z, 8); z += DPP_ROR(z, 4); z += DPP_ROR(z, 2); z += DPP_ROR(z, 1);
    return z;
}
__device__ __forceinline__ float rdlane(float v, int l) { return __int_as_float(__builtin_amdgcn_readlane(__float_as_int(v), l)); }
__device__ __forceinline__ f32x4 ld_bf4(const bf16_t* p) { const u32x2 w = *(const u32x2*)p; return (f32x4){bf_lo(w.x), bf_hi(w.x), bf_lo(w.y), bf_hi(w.y)}; }
__device__ __forceinline__ void ln_finish(f32x4 (&v)[8], const f32x4 (&g8)[8], const f32x4 (&b8)[8], int lane, float* xf_row, bf16_t* xb_row) {
    float s = 0.f;
#pragma unroll
    for (int j = 0; j < 8; ++j) s += (v[j][0] + v[j][1]) + (v[j][2] + v[j][3]);
    const float mean = wave_allsum(s) * (1.f / D);
    float q = 0.f;
#pragma unroll
    for (int j = 0; j < 8; ++j) { v[j] = v[j] - mean; q += (v[j][0] * v[j][0] + v[j][1] * v[j][1]) + (v[j][2] * v[j][2] + v[j][3] * v[j][3]); }
    const float rstd = rsqrtf(wave_allsum(q) * (1.f / D) + 1e-5f);
#pragma unroll
    for (int j = 0; j < 8; ++j) { const int c = 4 * lane + 256 * j;
        v[j] = v[j] * rstd * g8[j] + b8[j];
        if (xf_row) *(f32x4*)(xf_row + c) = v[j];
        if (xb_row) { u32x2 w; w.x = cvt_pk_bf16(v[j][0], v[j][1]); w.y = cvt_pk_bf16(v[j][2], v[j][3]); *(u32x2*)(xb_row + c) = w; } }
}

__device__ __forceinline__ float fast_sigmoid(float x) { return __builtin_amdgcn_rcpf(1.f + __builtin_amdgcn_exp2f(-1.4426950408889634f * x)); }
__device__ __forceinline__ float fast_tanh(float x) { return 1.f - 2.f * __builtin_amdgcn_rcpf(1.f + __builtin_amdgcn_exp2f(2.8853900817779268f * x)); }

constexpr int LORA_PITCH = 328;
__device__ __forceinline__ void lora_phase(LAS unsigned char* lds, const bf16_t* projb, const float* mix, const float* vmix, const bf16_t* Wl_w, const bf16_t* Wl_a, const bf16_t* Wl_g, const bf16_t* Wl_v,
                                           bf16_t* lw, const bool has_v, const int vcu, const int G, const int tid) {
    const int wave = __builtin_amdgcn_readfirstlane(tid >> 6), lane = tid & 63, fr = lane & 15, fq = lane >> 4;
    LAS bf16_t* Aimg = (LAS bf16_t*)lds;
    for (int u = vcu; u < M / 64; u += G) {
        {
            const int tau = tid >> 3, part = tid & 7, m = u * 64 + tau; const bool first = (m % SEQ) == 0;
#pragma unroll
            for (int i = 0; i < 5; ++i) {
                const int j0 = 40 * part + 8 * i;
                const u32x4 cur = *(const u32x4*)(projb + (size_t)m * PROJ_BLD + OFF_WLO + j0);
                u32x4 prv = (u32x4){0u, 0u, 0u, 0u};
                if (!first) prv = *(const u32x4*)(projb + (size_t)(m - 1) * PROJ_BLD + OFF_WLO + j0);
                f32x4 mx0, mx1;
                if (j0 < 288) { mx0 = *(const f32x4*)(mix + (OFF_WLO - OFF_RW) + j0); mx1 = *(const f32x4*)(mix + (OFF_WLO - OFF_RW) + j0 + 4); }
                else if (has_v) { mx0 = *(const f32x4*)(vmix + (j0 - 288)); mx1 = *(const f32x4*)(vmix + (j0 - 288) + 4); }
                else { mx0 = (f32x4){0.f, 0.f, 0.f, 0.f}; mx1 = mx0; }
                float o[8];
#pragma unroll
                for (int e = 0; e < 4; ++e) {
                    const float c0 = bf_lo(cur[e]), c1 = bf_hi(cur[e]), p0 = bf_lo(prv[e]), p1 = bf_hi(prv[e]);
                    const float m0 = (e < 2) ? mx0[2 * e] : mx1[2 * e - 4], m1 = (e < 2) ? mx0[2 * e + 1] : mx1[2 * e - 3];
                    o[2 * e] = c0 + (p0 - c0) * m0; o[2 * e + 1] = c1 + (p1 - c1) * m1;
                }
                if (j0 < 64) {
#pragma unroll
                    for (int e = 0; e < 8; ++e) o[e] = fast_tanh(o[e]);
                } else if (j0 >= 128 && j0 < 288) {
#pragma unroll
                    for (int e = 0; e < 8; ++e) o[e] = fast_sigmoid(o[e]);
                }
                u32x4 w; w.x = cvt_pk_bf16(o[0], o[1]); w.y = cvt_pk_bf16(o[2], o[3]); w.z = cvt_pk_bf16(o[4], o[5]); w.w = cvt_pk_bf16(o[6], o[7]);
                *(LAS u32x4*)(Aimg + tau * LORA_PITCH + j0) = w;
            }
        }
        __syncthreads();
        for (int q = 0; q < 4; ++q) {
            if (q == 3 && !has_v) break;
            const int K = (q == 2) ? 160 : (q == 3 ? 32 : 64), koff = (q == 0) ? 0 : (q == 1 ? 64 : (q == 2 ? 128 : 288));
            const bf16_t* W = (q == 0) ? Wl_w : (q == 1 ? Wl_a : (q == 2 ? Wl_g : Wl_v));
            f32x4 acc[8][4];
#pragma unroll
            for (int ct = 0; ct < 8; ++ct)
#pragma unroll
                for (int tt = 0; tt < 4; ++tt) acc[ct][tt] = (f32x4){0.f, 0.f, 0.f, 0.f};
            for (int ks = 0; ks < K / 32; ++ks) {
                bf16x8 af[8], bfr[4];
#pragma unroll
                for (int ct = 0; ct < 8; ++ct) af[ct] = *(const bf16x8*)(W + (size_t)(128 * wave + 32 * (ct >> 1) + 8 * (fr >> 2) + 4 * (ct & 1) + (fr & 3)) * K + 32 * ks + 8 * fq);
#pragma unroll
                for (int tt = 0; tt < 4; ++tt) bfr[tt] = *(const LAS bf16x8*)(Aimg + (16 * tt + fr) * LORA_PITCH + koff + 32 * ks + 8 * fq);
#pragma unroll
                for (int ct = 0; ct < 8; ++ct)
#pragma unroll
                    for (int tt = 0; tt < 4; ++tt) acc[ct][tt] = __builtin_amdgcn_mfma_f32_16x16x32_bf16(af[ct], bfr[tt], acc[ct][tt], 0, 0, 0);
            }
            bf16_t* out = lw + (size_t)q * M * 1024;
#pragma unroll
            for (int cp = 0; cp < 4; ++cp)
#pragma unroll
                for (int tt = 0; tt < 4; ++tt) { u32x4 w; w.x = cvt_pk_bf16(acc[2 * cp][tt][0], acc[2 * cp][tt][1]); w.y = cvt_pk_bf16(acc[2 * cp][tt][2], acc[2 * cp][tt][3]);
                    w.z = cvt_pk_bf16(acc[2 * cp + 1][tt][0], acc[2 * cp + 1][tt][1]); w.w = cvt_pk_bf16(acc[2 * cp + 1][tt][2], acc[2 * cp + 1][tt][3]);
                    *(u32x4*)(out + (size_t)(u * 64 + 16 * tt + fr) * 1024 + 128 * wave + 32 * cp + 8 * fq) = w; }
        }
        __syncthreads();
    }
}

struct RwScan { const bf16_t* proj_; const bf16_t* lw_; const float* mix; const float* w0; const float* a0; const float* v0; const float* k_k; const float* k_a; const float* r_k; float* vf_; bf16_t* y_; bf16_t* bon_; int layer; int pad;
                const float* cw1; const float* cw3; const float* cw2; bf16_t* cwt; int cmoe; int pad2; };
constexpr int RWB_A = 0, RWB_DR = 8192, RWB_D = 16384, RWB_B = 24576, RWB_K = 32768, RWB_BIG = 40960, RWS_V = 0, RWS_SC = 4096, RWS_SIZE = 4608, RW_SMALL = 2 * RWB_BIG, RW_YST = RW_SMALL + 3 * RWS_SIZE, RW_YST_SIZE = 4096, RW_CVT = RW_YST + 2 * RW_YST_SIZE, RW_TB = 32, RW_NCH = SEQ / RW_TB;
static_assert(RW_CVT + 4 * 8448 <= MISC_OFF, "rwkv scan LDS map");
__device__ __forceinline__ float rowsum16(float z) { z += DPP_ROR(z, 8); asm("" : "+v"(z)); z += DPP_ROR(z, 4); asm("" : "+v"(z)); z += DPP_ROR(z, 2); asm("" : "+v"(z)); z += DPP_ROR(z, 1); asm("" : "+v"(z)); return z; }
__device__ __forceinline__ void rwkv_scan_phase(LAS unsigned char* lds, const RwScan& a, const int vcu, const int G, const int tid) {
    const int wave = __builtin_amdgcn_readfirstlane(tid >> 6), lane = tid & 63, jj = lane & 15, rg = lane >> 4;
    for (int u = vcu; u < BATCH * RW_H * 2; u += G) {
        const int b = u >> 5, h = (u >> 1) & 15, half = u & 1;
        if (wave >= 4) {
            const int pw_ = wave - 4, c = h * 64 + lane, ptid = tid - 256;
            const float mix_r = a.mix[c], mix_k = a.mix[1024 + c], mix_v = a.mix[2048 + c];
            const float w0c = a.w0[c], a0c = a.a0[c], v0c = a.layer ? a.v0[c] : 0.f, kkc = a.k_k[c], kac = a.k_a[c], rkc = a.r_k[c];
            const bf16_t* lw_w = a.lw_; const bf16_t* lw_a = a.lw_ + (size_t)M * 1024; const bf16_t* lw_v = a.lw_ + (size_t)3 * M * 1024;
            const int woff = (lane & 7) * 32 + (lane >> 3) * 4;
            unsigned pr[9], pk[9], pv[9], pw[8], pa[8], pvp[8]; float pvf[8];
#define RW_PREFETCH(t0_) do { const int tb_ = (t0_) + 8 * pw_; \
            _Pragma("unroll") for (int i = 0; i < 9; ++i) { const int t_ = tb_ + i - 1; \
                if (t_ >= 0) { const bf16_t* row_ = a.proj_ + (size_t)(b * SEQ + t_) * PROJ_BLD + h * 64 + lane; pr[i] = row_[OFF_R]; pk[i] = row_[OFF_K]; pv[i] = row_[OFF_V]; } \
                else { pr[i] = 0u; pk[i] = 0u; pv[i] = 0u; } } \
            _Pragma("unroll") for (int i = 0; i < 8; ++i) { const size_t o_ = (size_t)(b * SEQ + tb_ + i) * 1024 + c; pw[i] = lw_w[o_]; pa[i] = lw_a[o_]; \
                if (a.layer) { pvp[i] = lw_v[o_]; pvf[i] = a.vf_[o_]; } else { pvp[i] = 0u; pvf[i] = 0.f; } } } while (0)
#define RW_PREP(ch_) do { const int t0_ = (ch_) * RW_TB; LAS unsigned char* buf_ = lds + ((ch_) & 1) * RWB_BIG; LAS unsigned char* sm_ = lds + RW_SMALL + ((ch_) % 3) * RWS_SIZE; \
            _Pragma("unroll") for (int i = 0; i < 8; ++i) { \
                const int tau = 8 * pw_ + i; \
                const float rc = __uint_as_float(pr[i + 1] << 16), rp = __uint_as_float(pr[i] << 16), kc = __uint_as_float(pk[i + 1] << 16), kp = __uint_as_float(pk[i] << 16), vc = __uint_as_float(pv[i + 1] << 16), vp = __uint_as_float(pv[i] << 16); \
                const float r = rc + (rp - rc) * mix_r, kraw = kc + (kp - kc) * mix_k, vraw = vc + (vp - vc) * mix_v; \
                const float sg = fast_sigmoid(w0c + __uint_as_float(pw[i] << 16)); \
                const float dec = __builtin_amdgcn_exp2f(-1.4426950408889634f * 0.6065306597126334f * sg);     \
                const float as = fast_sigmoid(a0c + __uint_as_float(pa[i] << 16)); \
                float v = vraw; \
                if (a.layer) v = vraw + (pvf[i] - vraw) * fast_sigmoid(v0c + __uint_as_float(pvp[i] << 16)); \
                const float kkv = kraw * kkc; \
                const float km = kraw * (1.f + (as - 1.f) * kac); \
                const float z = reduce4(kkv * kkv, r * km * rkc, kkv * as * r, km * r);     \
                const float nrm2 = rdlane(z, 0), rks = rdlane(z, 16), bru = rdlane(z, 32), kr = rdlane(z, 48); \
                const float inv = __builtin_amdgcn_rsqf(fmaxf(nrm2, 1e-24f));     \
                const float kkn = kkv * inv; \
                *(LAS float*)(buf_ + RWB_A + tau * 256 + woff) = -kkn; *(LAS float*)(buf_ + RWB_DR + tau * 256 + woff) = dec * r; *(LAS float*)(buf_ + RWB_D + tau * 256 + woff) = dec; \
                *(LAS float*)(buf_ + RWB_B + tau * 256 + woff) = kkn * as; *(LAS float*)(buf_ + RWB_K + tau * 256 + woff) = km; \
                if ((lane >> 5) == half) { ((LAS float*)(sm_ + RWS_V))[tau * 32 + (lane & 31)] = v; \
                    if (a.layer == 0) a.vf_[(size_t)(b * SEQ + t0_ + tau) * 1024 + c] = vraw; } \
                if (lane == 0) { ((LAS float*)(sm_ + RWS_SC))[tau] = bru * inv; ((LAS float*)(sm_ + RWS_SC))[32 + tau] = kr; ((LAS float*)(sm_ + RWS_SC))[64 + tau] = rks; } \
            } } while (0)
#define RW_FLUSH(ch_) do { const int t0_ = (ch_) * RW_TB; const LAS unsigned char* sm_ = lds + RW_SMALL + ((ch_) % 3) * RWS_SIZE; const LAS float* yst_ = (const LAS float*)(lds + RW_YST + ((ch_) & 1) * RW_YST_SIZE); \
            _Pragma("unroll") for (int q = 0; q < 2; ++q) { const int idx = ptid + 256 * q, tau = idx >> 4, i = (idx & 15) * 2;     \
                const float y0 = yst_[(((tau >> 3) * 4 + (i >> 3)) * 64) + (i & 7) * 8 + (tau & 7)], y1 = yst_[(((tau >> 3) * 4 + (i >> 3)) * 64) + ((i & 7) + 1) * 8 + (tau & 7)]; \
                const float rk_ = ((const LAS float*)(sm_ + RWS_SC))[64 + tau]; const f32x2 v2_ = *(const LAS f32x2*)((const LAS float*)(sm_ + RWS_V) + tau * 32 + i); \
                const size_t o = (size_t)(b * SEQ + t0_ + tau) * 1024 + h * 64 + half * 32 + i; \
                *(unsigned*)(a.y_ + o) = cvt_pk_bf16(y0, y1); *(unsigned*)(a.bon_ + o) = cvt_pk_bf16(rk_ * v2_.x, rk_ * v2_.y); } } while (0)
            const int cv_total = a.cmoe ? NE * 3 * 2816 : 3 * 5632, cv_stride = G * 4;
            int cv_it = vcu * 4 + pw_; float cvv[32]; bool cv_pend = false;
#define CV_DECODE(it_) const int e_ = a.cmoe ? (it_) / 8448 : 0, rr_ = a.cmoe ? (it_) % 8448 : (it_), per_ = a.cmoe ? 2816 : 5632, j_ = rr_ / per_, r_ = rr_ % per_, dfe_ = a.cmoe ? DFE : DFF; \
            const int K_ = (j_ == 2) ? dfe_ : D, N_ = (j_ == 2) ? D : dfe_, nnb_ = N_ / 32, k0_ = (r_ / nnb_) * 64, n0_ = (r_ % nnb_) * 32; \
            const float* W_ = (j_ == 0 ? a.cw1 : (j_ == 1 ? a.cw3 : a.cw2)) + (size_t)e_ * D * dfe_;
#define CV_LOAD() do { if (cv_it < cv_total) { CV_DECODE(cv_it) \
                const float* src_ = W_ + (size_t)(k0_ + 32 * (lane >> 5)) * N_ + n0_ + (lane & 31);     \
                _Pragma("unroll") for (int i = 0; i < 32; ++i) cvv[i] = src_[(size_t)i * N_]; cv_pend = true; } } while (0)
#define CV_STORE() do { if (cv_pend) { CV_DECODE(cv_it) (void)W_; \
                const int drow_ = (j_ == 2) ? (a.cmoe ? e_ * D + n0_ : n0_) : (a.cmoe ? e_ * 2 * DFE : 0) + 256 * (n0_ / 128) + j_ * 128 + (n0_ % 128); \
                bf16_t* WT_ = a.cwt + ((j_ == 2) ? (size_t)(a.cmoe ? NE * 2 * DFE : 2 * DFF) * D : (size_t)0) + (size_t)(drow_ + (lane & 31)) * K_ + k0_ + 32 * (lane >> 5); \
                _Pragma("unroll") for (int q = 0; q < 4; ++q) { u32x4 o; o.x = cvt_pk_bf16(cvv[8 * q], cvv[8 * q + 1]); o.y = cvt_pk_bf16(cvv[8 * q + 2], cvv[8 * q + 3]); o.z = cvt_pk_bf16(cvv[8 * q + 4], cvv[8 * q + 5]); o.w = cvt_pk_bf16(cvv[8 * q + 6], cvv[8 * q + 7]); \
                    *(u32x4*)(WT_ + 8 * q) = o; } \
                cv_pend = false; cv_it += cv_stride; } } while (0)
            RW_PREFETCH(0);
            RW_PREP(0);
            RW_PREFETCH(RW_TB);
            CV_LOAD();
            __syncthreads();
            for (int ch = 0; ch < RW_NCH; ++ch) {
                if (ch > 0) RW_FLUSH(ch - 1);
                if (ch + 1 < RW_NCH) { RW_PREP(ch + 1);
#if (MK_DBL >> 12) & 1
                    RW_PREP(ch + 1);
#endif
                    if (ch + 2 < RW_NCH) RW_PREFETCH((ch + 2) * RW_TB); }
                CV_STORE(); CV_LOAD();
                __syncthreads();
            }
            RW_FLUSH(RW_NCH - 1);
            while (cv_pend) { CV_STORE(); CV_LOAD(); }
#undef CV_DECODE
#undef CV_LOAD
#undef CV_STORE
#undef RW_PREFETCH
#undef RW_PREP
#undef RW_FLUSH
        } else {
            const int jl = lane & 7, rr = lane >> 3;
            __builtin_amdgcn_s_setprio(3);
            f32x2 S01 = (f32x2){0.f, 0.f}, S23 = S01, S45 = S01, S67 = S01;
#define DPP_Q(z, ctrl) __uint_as_float(__builtin_amdgcn_update_dpp(0u, __float_as_uint(z), (ctrl), 0xf, 0xf, false))
#define SUM8(z) do { z += DPP_Q(z, 0xB1); asm("" : "+v"(z)); z += DPP_Q(z, 0x4E); asm("" : "+v"(z)); z += DPP_Q(z, 0x141); asm("" : "+v"(z)); } while (0)
            __syncthreads();
            for (int ch = 0; ch < RW_NCH; ++ch) {
                const LAS unsigned char* buf = lds + (ch & 1) * RWB_BIG; const LAS unsigned char* sm = lds + RW_SMALL + (ch % 3) * RWS_SIZE;
                const LAS unsigned char* ob = buf + jl * 32;
                const LAS float* Vb = (const LAS float*)(sm + RWS_V) + 8 * wave + rr; const LAS float* SC = (const LAS float*)(sm + RWS_SC);
                LAS float* Yst = (LAS float*)(lds + RW_YST + (ch & 1) * RW_YST_SIZE);
#define LD8(dst0, dst1, off) do { dst0 = *(const LAS f32x4*)(ob + (off)); dst1 = *(const LAS f32x4*)(ob + (off) + 16); } while (0)
                f32x4 a0, a1, q0, q1, d0, d1, b0, b1, k0, k1, na0, na1, nq0, nq1, nd0, nd1, nb0, nb1, nk0, nk1;
                LD8(a0, a1, RWB_A); LD8(q0, q1, RWB_DR); LD8(d0, d1, RWB_D); LD8(b0, b1, RWB_B); LD8(k0, k1, RWB_K);
                float vi = Vb[0], br = SC[0], kr = SC[32];
                LD8(na0, na1, RWB_A + 256); LD8(nq0, nq1, RWB_DR + 256); LD8(nd0, nd1, RWB_D + 256); LD8(nb0, nb1, RWB_B + 256); LD8(nk0, nk1, RWB_K + 256);
                float nvi = Vb[32], nbr = SC[1], nkr = SC[33];
#pragma unroll
                for (int blk = 0; blk < 4; ++blk) {
                    float yacc = 0.f;
#pragma unroll
                    for (int s = 0; s < 8; ++s) {
                        const int tn = blk * 8 + s + 2;
                        f32x4 ma0, ma1, mq0, mq1, md0, md1, mb0, mb1, mk0, mk1;
                        LD8(ma0, ma1, RWB_A + tn * 256); LD8(mq0, mq1, RWB_DR + tn * 256); LD8(md0, md1, RWB_D + tn * 256); LD8(mb0, mb1, RWB_B + tn * 256); LD8(mk0, mk1, RWB_K + tn * 256);
                        const float mvi = Vb[(tn & 31) * 32], mbr = SC[tn & 31], mkr = SC[32 + (tn & 31)];
                        const f32x2 pa2 = (S01 * (f32x2){a0[0], a0[1]} + S23 * (f32x2){a0[2], a0[3]}) + (S45 * (f32x2){a1[0], a1[1]} + S67 * (f32x2){a1[2], a1[3]});
                        const f32x2 pq2 = (S01 * (f32x2){q0[0], q0[1]} + S23 * (f32x2){q0[2], q0[3]}) + (S45 * (f32x2){q1[0], q1[1]} + S67 * (f32x2){q1[2], q1[3]});
                        float sa = pa2.x + pa2.y, zq = pq2.x + pq2.y;
                        SUM8(sa); SUM8(zq);
                        S01 = (S01 * (f32x2){d0[0], d0[1]} + vi * (f32x2){k0[0], k0[1]}) + sa * (f32x2){b0[0], b0[1]};
                        S23 = (S23 * (f32x2){d0[2], d0[3]} + vi * (f32x2){k0[2], k0[3]}) + sa * (f32x2){b0[2], b0[3]};
                        S45 = (S45 * (f32x2){d1[0], d1[1]} + vi * (f32x2){k1[0], k1[1]}) + sa * (f32x2){b1[0], b1[1]};
                        S67 = (S67 * (f32x2){d1[2], d1[3]} + vi * (f32x2){k1[2], k1[3]}) + sa * (f32x2){b1[2], b1[3]};
                        const float y = zq + sa * br + vi * kr;
                        yacc = (jl == s) ? y : yacc;
                        a0 = na0; a1 = na1; q0 = nq0; q1 = nq1; d0 = nd0; d1 = nd1; b0 = nb0; b1 = nb1; k0 = nk0; k1 = nk1; vi = nvi; br = nbr; kr = nkr;
                        na0 = ma0; na1 = ma1; nq0 = mq0; nq1 = mq1; nd0 = md0; nd1 = md1; nb0 = mb0; nb1 = mb1; nk0 = mk0; nk1 = mk1; nvi = mvi; nbr = mbr; nkr = mkr;
                    }
                    Yst[(blk * 4 + wave) * 64 + lane] = yacc;
                }
#undef LD8
                __syncthreads();
            }
#undef SUM8
#undef DPP_Q
            __builtin_amdgcn_s_setprio(0);
        }
        __syncthreads();
    }
}

constexpr int RP = 68, VP = 34;
constexpr int CK_RA = 0, CK_RB = 8704, CK_RK = 17408, CK_RR = 26112, CK_LD = 34816, CK_RV = 43520, CK_RRK = 47872, CK_CUM = 48000, CK_PL = 56976, CK_NAB = 57232,
              CK_AT = 61840, CK_RT = 66448, CK_BH = 71056, CK_KH = 75664, CK_S0 = 80272, CK_NAK = 84880, CK_MBR = 87440, CK_MKR = 90000, CK_TT = 92560, CK_VI = 95120, CK_WI = 97680, CK_UI = 100240,
              CK_BC = 102800, CK_KC = 107920, CK_CUM2 = 113040, CK_END = 122016;
constexpr int P64 = 72, P32 = 40;
static_assert(CK_END <= MISC_OFF, "chunked rwkv LDS map");
__device__ __forceinline__ bf16x8 ldfrag(const LAS bf16_t* img, int pitch, int row, int k0) { return *(const LAS bf16x8*)(img + row * pitch + k0); }
__device__ __forceinline__ void rwkv_chunk_phase(LAS unsigned char* lds, const RwScan& a, const int vcu, const int G, const int tid0_) {
    const int tid = tid0_, wave = __builtin_amdgcn_readfirstlane(tid >> 6), lane = tid & 63;
    LAS float* RA = (LAS float*)(lds + CK_RA); LAS float* RB = (LAS float*)(lds + CK_RB); LAS float* RKm = (LAS float*)(lds + CK_RK); LAS float* RR = (LAS float*)(lds + CK_RR);
    LAS float* RLD = (LAS float*)(lds + CK_LD); LAS float* RV = (LAS float*)(lds + CK_RV); LAS float* RRK = (LAS float*)(lds + CK_RRK); LAS float* CUM = (LAS float*)(lds + CK_CUM);
    LAS float* PL = (LAS float*)(lds + CK_PL); LAS float* NabT = (LAS float*)(lds + CK_NAB); LAS float* CUMB = (LAS float*)(lds + CK_CUM2);
#define CK_CUMSUM(buf_) do { LAS float* cu_ = (buf_) ? CUMB : CUM; float ldv[32]; \
        _Pragma("unroll") for (int t = 0; t < 32; ++t) ldv[t] = RLD[t * RP + lane]; \
        float cs = 0.f; cu_[lane] = 0.f; \
        _Pragma("unroll") for (int t = 0; t < 32; ++t) { cs += ldv[t]; cu_[(t + 1) * RP + lane] = cs; } } while (0)
    LAS bf16_t* AT = (LAS bf16_t*)(lds + CK_AT); LAS bf16_t* RT = (LAS bf16_t*)(lds + CK_RT); LAS bf16_t* BH = (LAS bf16_t*)(lds + CK_BH); LAS bf16_t* KH = (LAS bf16_t*)(lds + CK_KH); LAS bf16_t* S0 = (LAS bf16_t*)(lds + CK_S0);
    LAS bf16_t* NakT = (LAS bf16_t*)(lds + CK_NAK); LAS bf16_t* MbrT = (LAS bf16_t*)(lds + CK_MBR); LAS bf16_t* MkrT = (LAS bf16_t*)(lds + CK_MKR); LAS bf16_t* TT = (LAS bf16_t*)(lds + CK_TT);
    LAS bf16_t* Vi = (LAS bf16_t*)(lds + CK_VI); LAS bf16_t* Wi = (LAS bf16_t*)(lds + CK_WI); LAS bf16_t* Ui = (LAS bf16_t*)(lds + CK_UI); LAS bf16_t* BcT = (LAS bf16_t*)(lds + CK_BC); LAS bf16_t* KcT = (LAS bf16_t*)(lds + CK_KC);
    for (int u = vcu; u < BATCH * RW_H * 2; u += G) {
        const int b = u >> 5, h = (u >> 1) & 15, half = u & 1, c = h * 64 + lane;
        const float mix_r = a.mix[c], mix_k = a.mix[1024 + c], mix_v = a.mix[2048 + c];
        const float w0c = a.w0[c], a0c = a.a0[c], v0c = a.layer ? a.v0[c] : 0.f, kkc = a.k_k[c], kac = a.k_a[c], rkc = a.r_k[c];
        const bf16_t* lw_w = a.lw_; const bf16_t* lw_a = a.lw_ + (size_t)M * 1024; const bf16_t* lw_v = a.lw_ + (size_t)3 * M * 1024;
        const int ptok0 = (wave < 4) ? 4 * (wave - 1) : 12 + 5 * (wave - 4), pntok = (wave == 0) ? 0 : ((wave < 4) ? 4 : 5);
        unsigned pr[6], pk[6], pv[6], pw[5], pa[5], pvp[5]; float pvf[5];
#define CK_PREFETCH(t0_) do { if (pntok) { const int tb_ = (t0_) + ptok0; \
        _Pragma("unroll") for (int i = 0; i < 6; ++i) { const int t_ = tb_ + i - 1; \
            if (t_ >= 0 && i <= pntok) { const bf16_t* row_ = a.proj_ + (size_t)(b * SEQ + t_) * PROJ_BLD + h * 64 + lane; pr[i] = row_[OFF_R]; pk[i] = row_[OFF_K]; pv[i] = row_[OFF_V]; } \
            else { pr[i] = 0u; pk[i] = 0u; pv[i] = 0u; } } \
        _Pragma("unroll") for (int i = 0; i < 5; ++i) { if (i < pntok) { const size_t o_ = (size_t)(b * SEQ + tb_ + i) * 1024 + c; pw[i] = lw_w[o_]; pa[i] = lw_a[o_]; \
            if (a.layer) { pvp[i] = lw_v[o_]; pvf[i] = a.vf_[o_]; } else { pvp[i] = 0u; pvf[i] = 0.f; } } else { pw[i] = 0u; pa[i] = 0u; pvp[i] = 0u; pvf[i] = 0.f; } } } } while (0)
#define CK_PREP(t0_) do { \
            _Pragma("unroll") for (int i = 0; i < 5; ++i) if (i < pntok) { \
                const int tau = ptok0 + i; \
                const float rc = __uint_as_float(pr[i + 1] << 16), rp = __uint_as_float(pr[i] << 16), kc = __uint_as_float(pk[i + 1] << 16), kp = __uint_as_float(pk[i] << 16), vc = __uint_as_float(pv[i + 1] << 16), vp = __uint_as_float(pv[i] << 16); \
                const float r = rc + (rp - rc) * mix_r, kraw = kc + (kp - kc) * mix_k, vraw = vc + (vp - vc) * mix_v; \
                const float sg = fast_sigmoid(w0c + __uint_as_float(pw[i] << 16)); \
                const float ld = -1.4426950408889634f * 0.6065306597126334f * sg;       \
                const float as = fast_sigmoid(a0c + __uint_as_float(pa[i] << 16)); \
                float v = vraw; \
                if (a.layer) v = vraw + (pvf[i] - vraw) * fast_sigmoid(v0c + __uint_as_float(pvp[i] << 16)); \
                const float kkv = kraw * kkc; \
                const float km = kraw * (1.f + (as - 1.f) * kac); \
                const float z = reduce4(kkv * kkv, r * km * rkc, 0.f, 0.f); \
                const float nrm2 = rdlane(z, 0), rks = rdlane(z, 16); \
                const float kkn = kkv * __builtin_amdgcn_rsqf(fmaxf(nrm2, 1e-24f)); \
                RA[tau * RP + lane] = -kkn; RB[tau * RP + lane] = kkn * as; RKm[tau * RP + lane] = km; RR[tau * RP + lane] = r; RLD[tau * RP + lane] = ld; \
                if ((lane >> 5) == half) { RV[tau * VP + (lane & 31)] = v; \
                    if (a.layer == 0) a.vf_[(size_t)(b * SEQ + (t0_) + tau) * 1024 + c] = vraw; } \
                if (lane == 0) RRK[tau] = rks; \
            } } while (0)
        const int cv_total = a.cmoe ? NE * 3 * 2816 : 3 * 5632, cv_stride = G * 4;
        int cv_it = vcu * 4 + (wave & 3); bool cv_pend = false;
#define CV_DECODE(it_) const int e_ = a.cmoe ? (it_) / 8448 : 0, rr_ = a.cmoe ? (it_) % 8448 : (it_), per_ = a.cmoe ? 2816 : 5632, j_ = rr_ / per_, r_ = rr_ % per_, dfe_ = a.cmoe ? DFE : DFF; \
        const int K_ = (j_ == 2) ? dfe_ : D, N_ = (j_ == 2) ? D : dfe_, nnb_ = N_ / 32, k0_ = (r_ / nnb_) * 64, n0_ = (r_ % nnb_) * 32; \
        const float* W_ = (j_ == 0 ? a.cw1 : (j_ == 1 ? a.cw3 : a.cw2)) + (size_t)e_ * D * dfe_;
#define CV_LOAD() do { if (cv_it < cv_total) { CV_DECODE(cv_it) \
            const float* src_ = W_ + (size_t)(k0_ + 32 * (lane >> 5)) * N_ + n0_ + (lane & 31); \
            _Pragma("unroll") for (int i = 0; i < 32; ++i) cvv[i] = src_[(size_t)i * N_]; cv_pend = true; } } while (0)
#define CV_STORE() do { if (cv_pend) { CV_DECODE(cv_it) (void)W_; \
            const int drow_ = (j_ == 2) ? (a.cmoe ? e_ * D + n0_ : n0_) : (a.cmoe ? e_ * 2 * DFE : 0) + 256 * (n0_ / 128) + j_ * 128 + (n0_ % 128); \
            bf16_t* WT_ = a.cwt + ((j_ == 2) ? (size_t)(a.cmoe ? NE * 2 * DFE : 2 * DFF) * D : (size_t)0) + (size_t)(drow_ + (lane & 31)) * K_ + k0_ + 32 * (lane >> 5); \
            _Pragma("unroll") for (int q = 0; q < 4; ++q) { u32x4 o; o.x = cvt_pk_bf16(cvv[8 * q], cvv[8 * q + 1]); o.y = cvt_pk_bf16(cvv[8 * q + 2], cvv[8 * q + 3]); o.z = cvt_pk_bf16(cvv[8 * q + 4], cvv[8 * q + 5]); o.w = cvt_pk_bf16(cvv[8 * q + 6], cvv[8 * q + 7]); \
                *(u32x4*)(WT_ + 8 * q) = o; } \
            cv_pend = false; cv_it += cv_stride; } } while (0)
        f32x4 Sacc = ZERO4();
        for (int i = tid; i < 32 * P64 / 2; i += 512) ((LAS unsigned*)S0)[i] = 0u;
        CK_PREFETCH(0);
        CK_PREP(0);
        CK_PREFETCH(32);
        __syncthreads();
        if (wave == 4) CK_CUMSUM(0);
        __syncthreads();
        for (int ch = 0; ch < SEQ / 32; ++ch) {
            const int t0 = ch * 32;
            int tid_c = tid0_; asm volatile("" : "+v"(tid_c));
            const int tid = tid_c, lane = tid & 63, fr = lane & 15, fq = lane >> 4;
            const LAS float* CUMc = (ch & 1) ? CUMB : CUM;
            {
                const int t = tid & 31, j0 = 4 * (tid >> 5);
                const f32x4 ct = *(const LAS f32x4*)(CUMc + (t + 1) * RP + j0), cp = *(const LAS f32x4*)(CUMc + t * RP + j0), cL = *(const LAS f32x4*)(CUMc + 32 * RP + j0);
                const f32x4 ra = *(const LAS f32x4*)(RA + t * RP + j0), rb = *(const LAS f32x4*)(RB + t * RP + j0), rk = *(const LAS f32x4*)(RKm + t * RP + j0), rr = *(const LAS f32x4*)(RR + t * RP + j0);
                float at[4], rt[4], bh[4], kh[4], bc[4], kc_[4];
#pragma unroll
                for (int e = 0; e < 4; ++e) { const float ea = __builtin_amdgcn_exp2f(cp[e]), er = __builtin_amdgcn_exp2f(ct[e]), ei = __builtin_amdgcn_exp2f(-ct[e]), ec = __builtin_amdgcn_exp2f(cL[e] - ct[e]);
                    at[e] = ra[e] * ea; rt[e] = rr[e] * er; bh[e] = rb[e] * ei; kh[e] = rk[e] * ei; bc[e] = rb[e] * ec; kc_[e] = rk[e] * ec; }
                { u32x2 w; w.x = cvt_pk_bf16(at[0], at[1]); w.y = cvt_pk_bf16(at[2], at[3]); *(LAS u32x2*)(AT + t * P64 + j0) = w; }
                { u32x2 w; w.x = cvt_pk_bf16(rt[0], rt[1]); w.y = cvt_pk_bf16(rt[2], rt[3]); *(LAS u32x2*)(RT + t * P64 + j0) = w; }
                { u32x2 w; w.x = cvt_pk_bf16(bh[0], bh[1]); w.y = cvt_pk_bf16(bh[2], bh[3]); *(LAS u32x2*)(BH + t * P64 + j0) = w; }
                { u32x2 w; w.x = cvt_pk_bf16(kh[0], kh[1]); w.y = cvt_pk_bf16(kh[2], kh[3]); *(LAS u32x2*)(KH + t * P64 + j0) = w; }
                { const unsigned w0 = cvt_pk_bf16(bc[0], bc[1]), w1 = cvt_pk_bf16(bc[2], bc[3]), x0 = cvt_pk_bf16(kc_[0], kc_[1]), x1 = cvt_pk_bf16(kc_[2], kc_[3]);
                  BcT[(j0 + 0) * P32 + t] = (bf16_t)(w0 & 0xffffu); BcT[(j0 + 1) * P32 + t] = (bf16_t)(w0 >> 16); BcT[(j0 + 2) * P32 + t] = (bf16_t)(w1 & 0xffffu); BcT[(j0 + 3) * P32 + t] = (bf16_t)(w1 >> 16);
                  KcT[(j0 + 0) * P32 + t] = (bf16_t)(x0 & 0xffffu); KcT[(j0 + 1) * P32 + t] = (bf16_t)(x0 >> 16); KcT[(j0 + 2) * P32 + t] = (bf16_t)(x1 & 0xffffu); KcT[(j0 + 3) * P32 + t] = (bf16_t)(x1 >> 16); }
                if (t == 31) { f32x4 pl; pl[0] = __builtin_amdgcn_exp2f(cL[0]); pl[1] = __builtin_amdgcn_exp2f(cL[1]); pl[2] = __builtin_amdgcn_exp2f(cL[2]); pl[3] = __builtin_amdgcn_exp2f(cL[3]); *(LAS f32x4*)(PL + j0) = pl; }
                { const int i0 = 2 * (tid >> 5); const f32x2 vv = *(const LAS f32x2*)(RV + t * VP + i0); const unsigned w = cvt_pk_bf16(vv.x, vv.y);
                  Vi[i0 * P32 + t] = (bf16_t)(w & 0xffffu); Vi[(i0 + 1) * P32 + t] = (bf16_t)(w >> 16); }
                { const int tb = tid >> 4, ib = 2 * (tid & 15); const float rk_ = RRK[tb]; const f32x2 vb = *(const LAS f32x2*)(RV + tb * VP + ib);
                  *(unsigned*)(a.bon_ + (size_t)(b * SEQ + t0 + tb) * 1024 + h * 64 + half * 32 + ib) = cvt_pk_bf16(rk_ * vb.x, rk_ * vb.y); }
            }
            __syncthreads();
#pragma unroll
            for (int q = 0; q < 2; ++q) {
                const int id = 2 * wave + q, mat = id >> 2, mt = (id >> 1) & 1, nt = id & 1;
                const LAS bf16_t* Ai = (mat & 1) ? KH : BH; const LAS bf16_t* Bi = (mat & 2) ? RT : AT;
                f32x4 g = ZERO4();
#pragma unroll
                for (int ks = 0; ks < 2; ++ks) g = __builtin_amdgcn_mfma_f32_16x16x32_bf16(ldfrag(Ai, P64, 16 * mt + fr, 32 * ks + 8 * fq), ldfrag(Bi, P64, 16 * nt + fr, 32 * ks + 8 * fq), g, 0, 0, 0);
                const int t = 16 * nt + fr, s0 = 16 * mt + 4 * fq;
#pragma unroll
                for (int r = 0; r < 4; ++r) { const int s = s0 + r; const bool keep = (mat < 2) ? (s < t) : (s <= t); g[r] = keep ? g[r] : 0.f; }
                if (mat == 0) *(LAS f32x4*)(NabT + t * 36 + s0) = g;
                else { LAS bf16_t* Xo = (mat == 1) ? NakT : ((mat == 2) ? MbrT : MkrT); u32x2 w; w.x = cvt_pk_bf16(g[0], g[1]); w.y = cvt_pk_bf16(g[2], g[3]); *(LAS u32x2*)(Xo + t * P32 + s0) = w; }
            }
            __syncthreads();
            if (wave == 0) {
                int ln = lane; asm volatile("" : "+v"(ln));
                float Tr[32];
                f32x4 rowb[2][8];
#pragma unroll
                for (int t = 0; t < 32; ++t) {
                    if (t + 1 < 32) {
#pragma unroll
                        for (int q = 0; q < 8; ++q) if (4 * q < t + 1) rowb[(t + 1) & 1][q] = *(const LAS f32x4*)(NabT + (t + 1) * 36 + 4 * q);
                    }
                    float acc4[4] = {(ln == t) ? 1.f : 0.f, 0.f, 0.f, 0.f};
#pragma unroll
                    for (int q = 0; q < 8; ++q)
#pragma unroll
                        for (int e = 0; e < 4; ++e) if (4 * q + e < t) acc4[e] += Tr[4 * q + e] * rowb[t & 1][q][e];
                    const float acc = (acc4[0] + acc4[1]) + (acc4[2] + acc4[3]);
                    Tr[t] = acc;
                    if (ln < 32) TT[t * P32 + ln] = (bf16_t)(cvt_pk_bf16(acc, 0.f) & 0xffffu);
                }
            } else {
                if (wave >= 4) {
                    const int mt = (wave - 4) >> 1, nt = (wave - 4) & 1;
                    f32x4 w = ZERO4();
#pragma unroll
                    for (int ks = 0; ks < 2; ++ks) w = __builtin_amdgcn_mfma_f32_16x16x32_bf16(ldfrag(AT, P64, 16 * mt + fr, 32 * ks + 8 * fq), ldfrag(S0, P64, 16 * nt + fr, 32 * ks + 8 * fq), w, 0, 0, 0);
                    w = __builtin_amdgcn_mfma_f32_16x16x32_bf16(ldfrag(NakT, P32, 16 * mt + fr, 8 * fq), ldfrag(Vi, P32, 16 * nt + fr, 8 * fq), w, 0, 0, 0);
                    u32x2 o; o.x = cvt_pk_bf16(w[0], w[1]); o.y = cvt_pk_bf16(w[2], w[3]); *(LAS u32x2*)(Wi + (16 * nt + fr) * P32 + 16 * mt + 4 * fq) = o;
                }
                if (ch + 1 < SEQ / 32) { CK_PREP(t0 + 32); if (ch + 2 < SEQ / 32) CK_PREFETCH(t0 + 64); }
            }
            __syncthreads();
            float cvv[32];
            if (wave >= 4) CV_LOAD();
            if (wave == 4 && ch + 1 < SEQ / 32) CK_CUMSUM((ch + 1) & 1);
            if (wave < 4) {
                const int mt = wave >> 1, nt = wave & 1;
                f32x4 uu = ZERO4();
                uu = __builtin_amdgcn_mfma_f32_16x16x32_bf16(ldfrag(TT, P32, 16 * mt + fr, 8 * fq), ldfrag(Wi, P32, 16 * nt + fr, 8 * fq), uu, 0, 0, 0);
                u32x2 o; o.x = cvt_pk_bf16(uu[0], uu[1]); o.y = cvt_pk_bf16(uu[2], uu[3]); *(LAS u32x2*)(Ui + (16 * nt + fr) * P32 + 16 * mt + 4 * fq) = o;
            }
            __syncthreads();
            if (wave >= 4) CV_STORE();
            if (wave < 4) {
                const int mt = wave >> 1, nt = wave & 1;
                f32x4 y = ZERO4();
#pragma unroll
                for (int ks = 0; ks < 2; ++ks) y = __builtin_amdgcn_mfma_f32_16x16x32_bf16(ldfrag(S0, P64, 16 * mt + fr, 32 * ks + 8 * fq), ldfrag(RT, P64, 16 * nt + fr, 32 * ks + 8 * fq), y, 0, 0, 0);
                y = __builtin_amdgcn_mfma_f32_16x16x32_bf16(ldfrag(Ui, P32, 16 * mt + fr, 8 * fq), ldfrag(MbrT, P32, 16 * nt + fr, 8 * fq), y, 0, 0, 0);
                y = __builtin_amdgcn_mfma_f32_16x16x32_bf16(ldfrag(Vi, P32, 16 * mt + fr, 8 * fq), ldfrag(MkrT, P32, 16 * nt + fr, 8 * fq), y, 0, 0, 0);
                u32x2 o; o.x = cvt_pk_bf16(y[0], y[1]); o.y = cvt_pk_bf16(y[2], y[3]);
                *(u32x2*)(a.y_ + (size_t)(b * SEQ + t0 + 16 * nt + fr) * 1024 + h * 64 + half * 32 + 16 * mt + 4 * fq) = o;
            }
            {
                const int mt = wave >> 1, nt = wave & 1;
                const f32x4 pl = *(const LAS f32x4*)(PL + 16 * mt + 4 * fq);
                Sacc = Sacc * pl;
                Sacc = __builtin_amdgcn_mfma_f32_16x16x32_bf16(ldfrag(BcT, P32, 16 * mt + fr, 8 * fq), ldfrag(Ui, P32, 16 * nt + fr, 8 * fq), Sacc, 0, 0, 0);
                Sacc = __builtin_amdgcn_mfma_f32_16x16x32_bf16(ldfrag(KcT, P32, 16 * mt + fr, 8 * fq), ldfrag(Vi, P32, 16 * nt + fr, 8 * fq), Sacc, 0, 0, 0);
            }
            __syncthreads();
            { const int mt = wave >> 1, nt = wave & 1; u32x2 o; o.x = cvt_pk_bf16(Sacc[0], Sacc[1]); o.y = cvt_pk_bf16(Sacc[2], Sacc[3]);
              *(LAS u32x2*)(S0 + (16 * nt + fr) * P64 + 16 * mt + 4 * fq) = o; }
        }
        if (wave >= 4) { float cvv[32]; CV_LOAD(); while (cv_pend) { CV_STORE(); CV_LOAD(); } }
#undef CK_PREFETCH
#undef CK_CUMSUM
#undef CK_PREP
#undef CV_DECODE
#undef CV_LOAD
#undef CV_STORE
        __syncthreads();
    }
}

constexpr int IMG_AT = 0, IMG_RT = 4096, IMG_BH = 8192, IMG_KH = 12288, IMG_VI = 16384, IMG_NAK = 20480, IMG_MBR = 22528, IMG_MKR = 24576, IMG_TT = 26624, IMG_PL = 28672, IMG_UNIT = 28928;
constexpr int PW_AT = 0, PW_RT = 4608, PW_BH = 9216, PW_KH = 13824, PW_NAB = PW_BH, PW_SIZE = 18432, PW_NW = 7;
static_assert(PW_NW * PW_SIZE <= MISC_OFF, "rwkv pre-phase LDS map");
static_assert((size_t)BATCH * RW_H * (SEQ / 32) * IMG_UNIT <= (size_t)299 * MiB, "rwkv chunk images fit between yssd and the FFN weights");
template <bool MOE> __device__ __forceinline__ void cv_decode(const int it, int& e, int& j, int& k0, int& n0) {
    constexpr int per = MOE ? 2816 : 5632, nnb = MOE ? 88 : 176;
    e = MOE ? it / 8448 : 0; const int rr = MOE ? it - e * 8448 : it; j = rr / per; const int r = rr - j * per;
    if (j == 2) { k0 = (r >> 6) * 64; n0 = (r & 63) * 32; } else { const int q = r / nnb; k0 = q * 64; n0 = (r - q * nnb) * 32; }
}
__device__ __forceinline__ void rwkv_pre_phase(LAS unsigned char* lds, const RwScan& a_, unsigned char* img, const int vcu, const int G, const int tid0_, const bool do_cv, const bool do_work) {
    const int wave = __builtin_amdgcn_readfirstlane(tid0_ >> 6);
    const bf16_t* const a_proj = a_.proj_; const bf16_t* const a_lw = a_.lw_; const float* const a_mix = a_.mix; const float* const a_w0 = a_.w0; const float* const a_a0 = a_.a0; const float* const a_v0 = a_.v0;
    const float* const a_kk = a_.k_k; const float* const a_ka = a_.k_a; const float* const a_rk = a_.r_k; float* const a_vf = a_.vf_; bf16_t* const a_bon = a_.bon_; const int a_layer = a_.layer;
    const float* const a_cw1 = a_.cw1; const float* const a_cw3 = a_.cw3; const float* const a_cw2 = a_.cw2; bf16_t* const a_cwt = a_.cwt; const int a_cmoe = a_.cmoe;
    if (wave >= PW_NW) {
        const int lane = tid0_ & 63;
        const int cv_total = a_cmoe ? MK_CV_CUT_MOE : MK_CV_CUT_DENSE, cv_stride = G * (NWAVES - PW_NW);
        int cv_it = do_cv ? vcu * (NWAVES - PW_NW) + (wave - PW_NW) : cv_total;
        float va[32], vb[32];
#define CV_DECODE(it_) int e_, j_, k0_, n0_; if (a_cmoe) cv_decode<true>((it_), e_, j_, k0_, n0_); else cv_decode<false>((it_), e_, j_, k0_, n0_); \
        const int dfe_ = a_cmoe ? DFE : DFF, K_ = (j_ == 2) ? dfe_ : D, N_ = (j_ == 2) ? D : dfe_; \
        const float* W_ = (j_ == 0 ? a_cw1 : (j_ == 1 ? a_cw3 : a_cw2)) + (size_t)e_ * D * dfe_;
#define CV_LD(buf_, it_) do { CV_DECODE(it_) \
            const float* src_ = W_ + (size_t)(k0_ + 32 * (lane >> 5)) * N_ + n0_ + (lane & 31); \
            _Pragma("unroll") for (int i = 0; i < 32; ++i) { buf_[i] = *src_; src_ += N_; asm volatile("" : "+v"(src_)); } } while (0)
#define CV_ST(buf_, it_) do { CV_DECODE(it_) (void)W_; \
            const int drow_ = (j_ == 2) ? (a_cmoe ? e_ * D + n0_ : n0_) : (a_cmoe ? e_ * 2 * DFE : 0) + 256 * (n0_ / 128) + j_ * 128 + (n0_ % 128); \
            bf16_t* WT_ = a_cwt + ((j_ == 2) ? (size_t)(a_cmoe ? NE * 2 * DFE : 2 * DFF) * D : (size_t)0) + (size_t)(drow_ + (lane & 31)) * K_ + k0_ + 32 * (lane >> 5); \
            _Pragma("unroll") for (int q = 0; q < 4; ++q) { u32x4 o; o.x = cvt_pk_bf16(buf_[8 * q], buf_[8 * q + 1]); o.y = cvt_pk_bf16(buf_[8 * q + 2], buf_[8 * q + 3]); o.z = cvt_pk_bf16(buf_[8 * q + 4], buf_[8 * q + 5]); o.w = cvt_pk_bf16(buf_[8 * q + 6], buf_[8 * q + 7]); \
                *(u32x4*)(WT_ + 8 * q) = o; } } while (0)
#ifndef MK_X_NOCV
        if (cv_it < cv_total) CV_LD(va, cv_it);
        while (cv_it < cv_total) {
            const int n1 = cv_it + cv_stride;
            if (n1 < cv_total) CV_LD(vb, n1);
            CV_ST(va, cv_it);
            if (n1 >= cv_total) break;
            const int n2 = n1 + cv_stride;
            if (n2 < cv_total) CV_LD(va, n2);
            CV_ST(vb, n1);
            cv_it = n2;
        }
#endif
#undef CV_DECODE
#undef CV_LD
#undef CV_ST
        return;
    }
    LAS unsigned char* my = lds + wave * PW_SIZE;
    LAS bf16_t* AT = (LAS bf16_t*)(my + PW_AT); LAS bf16_t* RT = (LAS bf16_t*)(my + PW_RT); LAS bf16_t* BH = (LAS bf16_t*)(my + PW_BH); LAS bf16_t* KH = (LAS bf16_t*)(my + PW_KH); LAS float* NabT = (LAS float*)(my + PW_NAB);
    const bf16_t* lw_w = a_lw; const bf16_t* lw_a = a_lw + (size_t)M * 1024; const bf16_t* lw_v = a_lw + (size_t)3 * M * 1024;
    const __amdgpu_buffer_rsrc_t rs_proj = __builtin_amdgcn_make_buffer_rsrc((void*)a_proj, 0, 0x7fffffff, 0x00020000), rs_lw = __builtin_amdgcn_make_buffer_rsrc((void*)a_lw, 0, 0x7fffffff, 0x00020000),
                                 rs_vf = __builtin_amdgcn_make_buffer_rsrc((void*)a_vf, 0, 0x7fffffff, 0x00020000), rs_bon = __builtin_amdgcn_make_buffer_rsrc((void*)a_bon, 0, 0x7fffffff, 0x00020000),
                                 rs_img = __builtin_amdgcn_make_buffer_rsrc((void*)img, 0, 0x7fffffff, 0x00020000);
    if (do_work) for (int u = vcu; u < M / 64; u += G) {
        const int b = u >> 5, tbase = (u & 31) * 64;
        for (int id = wave; id < 32; id += PW_NW) {
            int ln = tid0_ & 63; asm volatile("" : "+v"(ln));
            const int lane = ln, fr = lane & 15, fq = lane >> 4;
            const int h = id >> 1, t0 = tbase + 32 * (id & 1), c = h * 64 + lane;
            const float mix_r = a_mix[c], mix_k = a_mix[1024 + c], mix_v = a_mix[2048 + c];
            const float w0c = a_w0[c], a0c = a_a0[c], v0c = a_layer ? a_v0[c] : 0.f, kkc = a_kk[c], kac = a_ka[c], rkc = a_rk[c];
            unsigned char* ug = img + (size_t)((b * RW_H + h) * (SEQ / 32) + (t0 >> 5)) * IMG_UNIT;
            float cum = 0.f, er = 1.f;
            const bool hasv = a_layer != 0;
            unsigned prA[5], pkA[5], pvA[5], pwA[4], paA[4], pvpA[4], prB[5], pkB[5], pvB[5], pwB[4], paB[4], pvpB[4]; float pvfA[4], pvfB[4];
            const unsigned vo2 = (unsigned)lane * 2u, vo4 = (unsigned)lane * 4u, vo2d = (unsigned)(lane >> 1) * 4u; const bool odd_lane = (lane & 1) != 0;
            const unsigned so_proj = (unsigned)((b * SEQ + t0) * PROJ_BLD + h * 64) * 2u, so_tok = (unsigned)((b * SEQ + t0) * 1024 + h * 64);
            const unsigned so_img = (unsigned)((b * RW_H + h) * (SEQ / 32) + (t0 >> 5)) * (unsigned)IMG_UNIT + IMG_VI;
#define PRE_FETCH(tb_, X) do { \
            _Pragma("unroll") for (int i = 0; i < 4; ++i) { const unsigned t_ = (unsigned)((tb_) + i); \
                pr##X[i + 1] = __builtin_amdgcn_raw_buffer_load_b32(rs_proj, vo2d, so_proj + t_ * (PROJ_BLD * 2u) + OFF_R * 2u, 0); \
                pk##X[i + 1] = __builtin_amdgcn_raw_buffer_load_b32(rs_proj, vo2d, so_proj + t_ * (PROJ_BLD * 2u) + OFF_K * 2u, 0); \
                pv##X[i + 1] = __builtin_amdgcn_raw_buffer_load_b32(rs_proj, vo2d, so_proj + t_ * (PROJ_BLD * 2u) + OFF_V * 2u, 0); \
                pw##X[i] = __builtin_amdgcn_raw_buffer_load_b32(rs_lw, vo2d, (so_tok + t_ * 1024u) * 2u, 0); \
                pa##X[i] = __builtin_amdgcn_raw_buffer_load_b32(rs_lw, vo2d, (so_tok + t_ * 1024u) * 2u + (unsigned)M * 2048u, 0); \
                if (hasv) { pvp##X[i] = __builtin_amdgcn_raw_buffer_load_b32(rs_lw, vo2d, (so_tok + t_ * 1024u) * 2u + (unsigned)M * 6144u, 0); \
                            pvf##X[i] = __uint_as_float(__builtin_amdgcn_raw_buffer_load_b32(rs_vf, vo2d, (so_tok + t_ * 1024u) * 2u, 0)); }   \
                else { pvp##X[i] = 0u; pvf##X[i] = 0.f; } } } while (0)
#define BFSEL(x_) __uint_as_float(odd_lane ? ((x_) & 0xffff0000u) : ((x_) << 16))
#define PRE_TOK8(tb_, X) do { \
            _Pragma("unroll") for (int i = 0; i < 4; ++i) { const int tau = (tb_) + i; \
                const float rc = BFSEL(pr##X[i + 1]), rp = BFSEL(pr##X[i]), kc = BFSEL(pk##X[i + 1]), kp = BFSEL(pk##X[i]), \
                            vc = BFSEL(pv##X[i + 1]), vp = BFSEL(pv##X[i]); \
                const float r = rc + (rp - rc) * mix_r, kraw = kc + (kp - kc) * mix_k, vraw = vc + (vp - vc) * mix_v; \
                const float sg = fast_sigmoid(w0c + BFSEL(pw##X[i])); \
                const float ld = -1.4426950408889634f * 0.6065306597126334f * sg;       \
                const float as = fast_sigmoid(a0c + BFSEL(pa##X[i])); \
                float v = vraw; \
                if (hasv) v = vraw + (BFSEL(__float_as_uint(pvf##X[i])) - vraw) * fast_sigmoid(v0c + BFSEL(pvp##X[i])); \
                const float kkv = kraw * kkc; \
                const float km = kraw * (1.f + (as - 1.f) * kac); \
                const float z = reduce4(kkv * kkv, r * km * rkc, 0.f, 0.f); \
                const float nrm2 = rdlane(z, 0), rks = rdlane(z, 16); \
                const float kkn = kkv * __builtin_amdgcn_rsqf(fmaxf(nrm2, 1e-24f)); \
                const float er_prev = er;                                          \
                cum += ld; er = __builtin_amdgcn_exp2f(cum); \
                const float ei = __builtin_amdgcn_exp2f(-cum); \
                const float at = -kkn * er_prev, rt = r * er, bh = kkn * as * ei, kh = km * ei; \
                const unsigned w0 = cvt_pk_bf16(at, rt), w1 = cvt_pk_bf16(bh, kh), w2 = cvt_pk_bf16(v, rks * v); \
                AT[tau * P64 + lane] = (bf16_t)(w0 & 0xffffu); RT[tau * P64 + lane] = (bf16_t)(w0 >> 16); BH[tau * P64 + lane] = (bf16_t)(w1 & 0xffffu); KH[tau * P64 + lane] = (bf16_t)(w1 >> 16); \
                __builtin_amdgcn_raw_buffer_store_b16((unsigned short)(w2 & 0xffffu), rs_img, vo2, so_img + (unsigned)tau * 128u, 0);        \
                __builtin_amdgcn_raw_buffer_store_b16((unsigned short)(w2 >> 16), rs_bon, vo2, (so_tok + (unsigned)tau * 1024u) * 2u, 0); \
                if (!hasv) __builtin_amdgcn_raw_buffer_store_b16((unsigned short)(cvt_pk_bf16(vraw, 0.f) & 0xffffu), rs_vf, vo2, (so_tok + (unsigned)tau * 1024u) * 2u, 0); \
            } } while (0)
            PRE_FETCH(0, A);
            if (t0 > 0) { prA[0] = __builtin_amdgcn_raw_buffer_load_b32(rs_proj, vo2d, so_proj - PROJ_BLD * 2u + OFF_R * 2u, 0); pkA[0] = __builtin_amdgcn_raw_buffer_load_b32(rs_proj, vo2d, so_proj - PROJ_BLD * 2u + OFF_K * 2u, 0);
                          pvA[0] = __builtin_amdgcn_raw_buffer_load_b32(rs_proj, vo2d, so_proj - PROJ_BLD * 2u + OFF_V * 2u, 0); }
            else { prA[0] = 0u; pkA[0] = 0u; pvA[0] = 0u; }
            for (int gg = 0; gg < 4; ++gg) {
                PRE_FETCH(8 * gg + 4, B);
                prB[0] = prA[4]; pkB[0] = pkA[4]; pvB[0] = pvA[4];
                PRE_TOK8(8 * gg, A);
                if (gg < 3) PRE_FETCH(8 * gg + 8, A);
                prA[0] = prB[4]; pkA[0] = pkB[4]; pvA[0] = pvB[4];
                PRE_TOK8(8 * gg + 4, B);
            }
#undef PRE_FETCH
#undef PRE_TOK8
#undef BFSEL
            *(float*)(ug + IMG_PL + lane * 4) = er;
            asm volatile("s_waitcnt lgkmcnt(0)" ::: "memory");
#pragma unroll
            for (int arr = 1; arr < 3; ++arr) {
                const LAS bf16_t* X = (arr == 1) ? BH : KH;
                unsigned pkd[16];
#pragma unroll
                for (int k = 0; k < 16; ++k) pkd[k] = (unsigned)X[(2 * k) * P64 + lane] | ((unsigned)X[(2 * k + 1) * P64 + lane] << 16);
                unsigned char* dst = ug + ((arr == 1) ? IMG_BH : IMG_KH) + lane * 64;
#pragma unroll
                for (int q = 0; q < 4; ++q) *(u32x4*)(dst + q * 16) = (u32x4){pkd[4 * q], pkd[4 * q + 1], pkd[4 * q + 2], pkd[4 * q + 3]};
            }
            asm volatile("s_waitcnt lgkmcnt(0)" ::: "memory");
#ifndef MK_X_NOGRAM
            {
                bf16x8 fB[2][2], fK[2][2], fA[2][2], fR[2][2];
#pragma unroll
                for (int m = 0; m < 2; ++m)
#pragma unroll
                    for (int ks = 0; ks < 2; ++ks) { fB[m][ks] = ldfrag(BH, P64, 16 * m + fr, 32 * ks + 8 * fq); fK[m][ks] = ldfrag(KH, P64, 16 * m + fr, 32 * ks + 8 * fq);
                                                     fA[m][ks] = ldfrag(AT, P64, 16 * m + fr, 32 * ks + 8 * fq); fR[m][ks] = ldfrag(RT, P64, 16 * m + fr, 32 * ks + 8 * fq); }
                asm volatile("s_waitcnt lgkmcnt(0)" ::: "memory");
#pragma unroll
                for (int mat = 0; mat < 4; ++mat)
#pragma unroll
                    for (int mt = 0; mt < 2; ++mt)
#pragma unroll
                        for (int nt = 0; nt < 2; ++nt) {
                            f32x4 g = ZERO4();
                            if (!(mt == 1 && nt == 0)) {
#pragma unroll
                                for (int ks = 0; ks < 2; ++ks) g = __builtin_amdgcn_mfma_f32_16x16x32_bf16((mat & 1) ? fK[mt][ks] : fB[mt][ks], (mat & 2) ? fR[nt][ks] : fA[nt][ks], g, 0, 0, 0);
                            }
                            const int t = 16 * nt + fr, s0 = 16 * mt + 4 * fq;
                            if (mt == nt) {
#pragma unroll
                                for (int r = 0; r < 4; ++r) { const int s = s0 + r; const bool keep = (mat < 2) ? (s < t) : (s <= t); g[r] = keep ? g[r] : 0.f; }
                            }
                            if (mat == 0) *(LAS f32x4*)(NabT + t * 36 + s0) = g;
                            else { u32x2 w; w.x = cvt_pk_bf16(g[0], g[1]); w.y = cvt_pk_bf16(g[2], g[3]); *(u32x2*)(ug + IMG_NAK + (mat - 1) * 2048 + (t * 32 + s0) * 2) = w; }
                        }
            }
#endif
            asm volatile("s_waitcnt lgkmcnt(0)" ::: "memory");
#ifndef MK_X_NOSOLVE
            {
                float Tr[32];
                f32x4 rowb[2][8];
#pragma unroll
                for (int t = 0; t < 32; ++t) {
                    if (t + 1 < 32) {
#pragma unroll
                        for (int q = 0; q < 8; ++q) if (4 * q < t + 1) rowb[(t + 1) & 1][q] = *(const LAS f32x4*)(NabT + (t + 1) * 36 + 4 * q);
                    }
                    float acc4[4] = {(ln == t) ? 1.f : 0.f, 0.f, 0.f, 0.f};
#pragma unroll
                    for (int q = 0; q < 8; ++q)
#pragma unroll
                        for (int e = 0; e < 4; ++e) if (4 * q + e < t) acc4[e] += Tr[4 * q + e] * rowb[t & 1][q][e];
                    const float acc = (acc4[0] + acc4[1]) + (acc4[2] + acc4[3]);
                    Tr[t] = acc;
                    if (ln < 32) *(bf16_t*)(ug + IMG_TT + (t * 32 + ln) * 2) = (bf16_t)(cvt_pk_bf16(acc, 0.f) & 0xffffu);
                }
            }
#endif
            {
                const int row = lane >> 1, hf = lane & 1;
#pragma unroll
                for (int q = 0; q < 4; ++q) {
                    *(u32x4*)(ug + IMG_AT + row * 128 + hf * 64 + q * 16) = *(const LAS u32x4*)(AT + row * P64 + hf * 32 + 8 * q);
                    *(u32x4*)(ug + IMG_RT + row * 128 + hf * 64 + q * 16) = *(const LAS u32x4*)(RT + row * P64 + hf * 32 + 8 * q);
                }
            }
            asm volatile("s_waitcnt lgkmcnt(0)" ::: "memory");
        }
    }
}

constexpr int SK_AT = 0, SK_RT = 4608, SK_S0 = 9216, SK_NAK = 13824, SK_MBR = 16384, SK_MKR = 18944, SK_TT = 21504, SK_VI = 24064, SK_WI = 26624, SK_UI = 29184, SK_BH = 31744, SK_KH = 36864, SK_PL = 41984, SK_END = 42240, SK_BUF = SK_END;
static_assert(2 * SK_BUF <= MISC_OFF, "rwkv state phase LDS map");
__device__ __forceinline__ void rwkv_state_phase(LAS unsigned char* lds, const unsigned char* img, bf16_t* y_, const RwScan& a_, const int vcu, const int G, const int tid0_) {
    const int wave = __builtin_amdgcn_readfirstlane(tid0_ >> 6);
    const float* const a_cw1 = a_.cw1; const float* const a_cw3 = a_.cw3; const float* const a_cw2 = a_.cw2; bf16_t* const a_cwt = a_.cwt; const int a_cmoe = a_.cmoe;
    const int cv_total = a_cmoe ? NE * 3 * 2816 : 3 * 5632, cv_stride = G * 4, cv_cut = a_cmoe ? MK_CV_CUT_MOE : MK_CV_CUT_DENSE;
#define CV_DECODE(it_) int e_, j_, k0_, n0_; if (a_cmoe) cv_decode<true>((it_), e_, j_, k0_, n0_); else cv_decode<false>((it_), e_, j_, k0_, n0_); \
        const int dfe_ = a_cmoe ? DFE : DFF, K_ = (j_ == 2) ? dfe_ : D, N_ = (j_ == 2) ? D : dfe_; \
        const float* W_ = (j_ == 0 ? a_cw1 : (j_ == 1 ? a_cw3 : a_cw2)) + (size_t)e_ * D * dfe_;
#define CV_LOAD(cvv, cv_it, cv_pend) do { if (cv_it < cv_total) { CV_DECODE(cv_it) const int cl_ = tid0_ & 63; \
            const float* src_ = W_ + (size_t)(k0_ + 32 * (cl_ >> 5)) * N_ + n0_ + (cl_ & 31); \
            _Pragma("unroll") for (int i = 0; i < 32; ++i) cvv[i] = src_[(size_t)i * N_]; cv_pend = true; } } while (0)
#define CV_STORE(cvv, cv_it, cv_pend) do { if (cv_pend) { CV_DECODE(cv_it) (void)W_; const int cl_ = tid0_ & 63; \
            const int drow_ = (j_ == 2) ? (a_cmoe ? e_ * D + n0_ : n0_) : (a_cmoe ? e_ * 2 * DFE : 0) + 256 * (n0_ / 128) + j_ * 128 + (n0_ % 128); \
            bf16_t* WT_ = a_cwt + ((j_ == 2) ? (size_t)(a_cmoe ? NE * 2 * DFE : 2 * DFF) * D : (size_t)0) + (size_t)(drow_ + (cl_ & 31)) * K_ + k0_ + 32 * (cl_ >> 5); \
            _Pragma("unroll") for (int q = 0; q < 4; ++q) { u32x4 o; o.x = cvt_pk_bf16(cvv[8 * q], cvv[8 * q + 1]); o.y = cvt_pk_bf16(cvv[8 * q + 2], cvv[8 * q + 3]); o.z = cvt_pk_bf16(cvv[8 * q + 4], cvv[8 * q + 5]); o.w = cvt_pk_bf16(cvv[8 * q + 6], cvv[8 * q + 7]); \
                *(u32x4*)(WT_ + 8 * q) = o; } \
            cv_pend = false; cv_it += cv_stride; } } while (0)
    LAS bf16_t* Wi = (LAS bf16_t*)(lds + SK_WI); LAS bf16_t* Ui = (LAS bf16_t*)(lds + SK_UI);
    for (int u = vcu; u < BATCH * RW_H * 2; u += G) {
        const int b = u >> 5, h = (u >> 1) & 15, half = u & 1;
        const unsigned char* ub = img + (size_t)((b * RW_H + h) * (SEQ / 32)) * IMG_UNIT;
        f32x4 Sacc = ZERO4();
        u32x4 q0a, q0b, q1a, q1b, q2a, q2b, q3;
        int cv_itA = cv_cut + vcu * 4 + (wave & 3); bool cv_pendA = false; float cvA[32];
#pragma unroll
        for (int i = 0; i < 32; ++i) cvA[i] = 0.f;
#define ST_FETCH(ch_) do { if (wave < 4) { const unsigned char* ug_ = ub + (size_t)(ch_) * IMG_UNIT; const int tf_ = tid0_; \
            q0a = *(const u32x4*)(ug_ + IMG_AT + tf_ * 16); q0b = *(const u32x4*)(ug_ + IMG_RT + tf_ * 16); q1a = *(const u32x4*)(ug_ + IMG_NAK + tf_ * 16); q1b = *(const u32x4*)(ug_ + IMG_MKR + tf_ * 16); \
            q2a = *(const u32x4*)(ug_ + IMG_BH + tf_ * 16); q2b = *(const u32x4*)(ug_ + IMG_KH + tf_ * 16); \
            if (tf_ < 128) q3 = *(const u32x4*)(ug_ + IMG_VI + (tf_ >> 2) * 128 + half * 64 + (tf_ & 3) * 16); else if (tf_ < 144) q3 = *(const u32x4*)(ug_ + IMG_PL + (tf_ - 128) * 16); } } while (0)
        q0a = q0b = q1a = q1b = q2a = q2b = q3 = (u32x4){0u, 0u, 0u, 0u};
        ST_FETCH(0);
        for (int ch = 0; ch < SEQ / 32; ++ch) {
            const int t0 = ch * 32;
            int tid_c = tid0_; asm volatile("" : "+v"(tid_c));
            const int tid = tid_c, lane = tid & 63, fr = lane & 15, fq = lane >> 4;
            LAS unsigned char* lb = lds + (ch & 1) * SK_BUF;
            LAS bf16_t* AT = (LAS bf16_t*)(lb + SK_AT); LAS bf16_t* RT = (LAS bf16_t*)(lb + SK_RT); LAS bf16_t* S0 = (LAS bf16_t*)(lb + SK_S0);
            LAS bf16_t* NakT = (LAS bf16_t*)(lb + SK_NAK); LAS bf16_t* MbrT = (LAS bf16_t*)(lb + SK_MBR); LAS bf16_t* MkrT = (LAS bf16_t*)(lb + SK_MKR); LAS bf16_t* TT = (LAS bf16_t*)(lb + SK_TT);
            LAS bf16_t* Vi = (LAS bf16_t*)(lb + SK_VI); LAS bf16_t* BhT = (LAS bf16_t*)(lb + SK_BH); LAS bf16_t* KhT = (LAS bf16_t*)(lb + SK_KH); LAS float* PL = (LAS float*)(lb + SK_PL);
            if (wave < 4) {
                { const int o_ = (tid >> 3) * 144 + (tid & 7) * 16; *(LAS u32x4*)(lb + SK_AT + o_) = q0a; *(LAS u32x4*)(lb + SK_RT + o_) = q0b; }
                { const int idx = tid & 127, o_ = (tid >> 7) * 2560 + (idx >> 2) * 80 + (idx & 3) * 16; *(LAS u32x4*)(lb + SK_NAK + o_) = q1a; *(LAS u32x4*)(lb + SK_MKR + o_) = q1b; }
                { const int o_ = (tid >> 2) * 80 + (tid & 3) * 16; *(LAS u32x4*)(lb + SK_BH + o_) = q2a; *(LAS u32x4*)(lb + SK_KH + o_) = q2b; }
                if (tid < 128) { const int t_ = tid >> 2, i0_ = 8 * (tid & 3); const unsigned wv_[4] = {q3.x, q3.y, q3.z, q3.w};
#pragma unroll
                    for (int e = 0; e < 4; ++e) { Vi[(i0_ + 2 * e) * P32 + t_] = (bf16_t)(wv_[e] & 0xffffu); Vi[(i0_ + 2 * e + 1) * P32 + t_] = (bf16_t)(wv_[e] >> 16); } }
                else if (tid < 144) *(LAS u32x4*)(lb + SK_PL + (tid - 128) * 16) = q3;
            }
            { const int mt = wave >> 1, nt = wave & 1; u32x2 o; o.x = cvt_pk_bf16(Sacc[0], Sacc[1]); o.y = cvt_pk_bf16(Sacc[2], Sacc[3]);
              *(LAS u32x2*)(S0 + (16 * nt + fr) * P64 + 16 * mt + 4 * fq) = o; }
            __syncthreads();
            if (ch + 1 < SEQ / 32) ST_FETCH(ch + 1);
            if (wave >= 4) {
                const int mt = (wave - 4) >> 1, nt = (wave - 4) & 1;
                f32x4 w = ZERO4();
#pragma unroll
                for (int ks = 0; ks < 2; ++ks) w = __builtin_amdgcn_mfma_f32_16x16x32_bf16(ldfrag(AT, P64, 16 * mt + fr, 32 * ks + 8 * fq), ldfrag(S0, P64, 16 * nt + fr, 32 * ks + 8 * fq), w, 0, 0, 0);
                w = __builtin_amdgcn_mfma_f32_16x16x32_bf16(ldfrag(NakT, P32, 16 * mt + fr, 8 * fq), ldfrag(Vi, P32, 16 * nt + fr, 8 * fq), w, 0, 0, 0);
                u32x2 o; o.x = cvt_pk_bf16(w[0], w[1]); o.y = cvt_pk_bf16(w[2], w[3]); *(LAS u32x2*)(Wi + (16 * nt + fr) * P32 + 16 * mt + 4 * fq) = o;
            }
            __syncthreads();
            if (wave < 4) {
                const int mt = wave >> 1, nt = wave & 1;
                f32x4 uu = ZERO4();
                uu = __builtin_amdgcn_mfma_f32_16x16x32_bf16(ldfrag(TT, P32, 16 * mt + fr, 8 * fq), ldfrag(Wi, P32, 16 * nt + fr, 8 * fq), uu, 0, 0, 0);
                u32x2 o; o.x = cvt_pk_bf16(uu[0], uu[1]); o.y = cvt_pk_bf16(uu[2], uu[3]); *(LAS u32x2*)(Ui + (16 * nt + fr) * P32 + 16 * mt + 4 * fq) = o;
            }
            if (wave >= 4) { CV_STORE(cvA, cv_itA, cv_pendA); CV_LOAD(cvA, cv_itA, cv_pendA); }
            __syncthreads();
            if (wave < 4) {
                const int mt = wave >> 1, nt = wave & 1;
                f32x4 y = ZERO4();
#pragma unroll
                for (int ks = 0; ks < 2; ++ks) y = __builtin_amdgcn_mfma_f32_16x16x32_bf16(ldfrag(S0, P64, 16 * mt + fr, 32 * ks + 8 * fq), ldfrag(RT, P64, 16 * nt + fr, 32 * ks + 8 * fq), y, 0, 0, 0);
                y = __builtin_amdgcn_mfma_f32_16x16x32_bf16(ldfrag(Ui, P32, 16 * mt + fr, 8 * fq), ldfrag(MbrT, P32, 16 * nt + fr, 8 * fq), y, 0, 0, 0);
                y = __builtin_amdgcn_mfma_f32_16x16x32_bf16(ldfrag(Vi, P32, 16 * mt + fr, 8 * fq), ldfrag(MkrT, P32, 16 * nt + fr, 8 * fq), y, 0, 0, 0);
                u32x2 o; o.x = cvt_pk_bf16(y[0], y[1]); o.y = cvt_pk_bf16(y[2], y[3]);
                *(u32x2*)(y_ + (size_t)(b * SEQ + t0 + 16 * nt + fr) * 1024 + h * 64 + half * 32 + 16 * mt + 4 * fq) = o;
            }
            {
                const int mt = wave >> 1, nt = wave & 1;
                const f32x4 pl = *(const LAS f32x4*)(PL + 16 * mt + 4 * fq);
                Sacc = __builtin_amdgcn_mfma_f32_16x16x32_bf16(ldfrag(BhT, P32, 16 * mt + fr, 8 * fq), ldfrag(Ui, P32, 16 * nt + fr, 8 * fq), Sacc, 0, 0, 0);
                Sacc = __builtin_amdgcn_mfma_f32_16x16x32_bf16(ldfrag(KhT, P32, 16 * mt + fr, 8 * fq), ldfrag(Vi, P32, 16 * nt + fr, 8 * fq), Sacc, 0, 0, 0);
                Sacc = Sacc * pl;
            }
        }
        if (wave >= 4) { do { CV_STORE(cvA, cv_itA, cv_pendA); CV_LOAD(cvA, cv_itA, cv_pendA); } while (cv_pendA); }
        __syncthreads();
#undef CV_DECODE
#undef CV_LOAD
#undef CV_STORE
#undef ST_FETCH
    }
}

__device__ __forceinline__ void ld_bf16x16(const bf16_t* p, f32x4 (&o)[4]) { const u32x4 a = *(const u32x4*)p, b = *(const u32x4*)(p + 8);
    o[0] = (f32x4){bf_lo(a.x), bf_hi(a.x), bf_lo(a.y), bf_hi(a.y)}; o[1] = (f32x4){bf_lo(a.z), bf_hi(a.z), bf_lo(a.w), bf_hi(a.w)};
    o[2] = (f32x4){bf_lo(b.x), bf_hi(b.x), bf_lo(b.y), bf_hi(b.y)}; o[3] = (f32x4){bf_lo(b.z), bf_hi(b.z), bf_lo(b.w), bf_hi(b.w)}; }
__device__ __forceinline__ void rwkv_post_phase(const bf16_t* __restrict__ yrw, const bf16_t* __restrict__ bon, const bf16_t* __restrict__ lw_g, const float* __restrict__ ln_w, const float* __restrict__ ln_b, bf16_t* __restrict__ ymixb, const int gw, const int NGW, const int lane) {
    const int c0 = 16 * lane;
    f32x4 lw4[4], lb4[4];
#pragma unroll
    for (int j = 0; j < 4; ++j) { lw4[j] = *(const f32x4*)(ln_w + c0 + 4 * j); lb4[j] = *(const f32x4*)(ln_b + c0 + 4 * j); }
#pragma unroll 2
    for (int m = gw; m < M; m += NGW) {
        f32x4 y[4], bo[4];
        ld_bf16x16(yrw + (size_t)m * 1024 + c0, y); ld_bf16x16(bon + (size_t)m * 1024 + c0, bo);
        const u32x4 g0 = *(const u32x4*)(lw_g + (size_t)m * 1024 + c0), g1 = *(const u32x4*)(lw_g + (size_t)m * 1024 + c0 + 8);
        float s = 0.f;
#pragma unroll
        for (int j = 0; j < 4; ++j) s += (y[j][0] + y[j][1]) + (y[j][2] + y[j][3]);
        s += __shfl_xor(s, 1); s += __shfl_xor(s, 2);
        const float mu = s * (1.f / 64.f);
        float q = 0.f;
#pragma unroll
        for (int j = 0; j < 4; ++j) { y[j] = y[j] - mu; q += (y[j][0] * y[j][0] + y[j][1] * y[j][1]) + (y[j][2] * y[j][2] + y[j][3] * y[j][3]); }
        q += __shfl_xor(q, 1); q += __shfl_xor(q, 2);
        const float rstd = rsqrtf(q * (1.f / 64.f) + 64e-5f);
        float o[16];
#pragma unroll
        for (int j = 0; j < 4; ++j) { const f32x4 t = y[j] * rstd * lw4[j] + lb4[j] + bo[j]; o[4 * j] = t[0]; o[4 * j + 1] = t[1]; o[4 * j + 2] = t[2]; o[4 * j + 3] = t[3]; }
        const unsigned gw_[8] = {g0.x, g0.y, g0.z, g0.w, g1.x, g1.y, g1.z, g1.w};
        u32x4 w0, w1;
        w0.x = cvt_pk_bf16(o[0] * bf_lo(gw_[0]), o[1] * bf_hi(gw_[0])); w0.y = cvt_pk_bf16(o[2] * bf_lo(gw_[1]), o[3] * bf_hi(gw_[1]));
        w0.z = cvt_pk_bf16(o[4] * bf_lo(gw_[2]), o[5] * bf_hi(gw_[2])); w0.w = cvt_pk_bf16(o[6] * bf_lo(gw_[3]), o[7] * bf_hi(gw_[3]));
        w1.x = cvt_pk_bf16(o[8] * bf_lo(gw_[4]), o[9] * bf_hi(gw_[4])); w1.y = cvt_pk_bf16(o[10] * bf_lo(gw_[5]), o[11] * bf_hi(gw_[5]));
        w1.z = cvt_pk_bf16(o[12] * bf_lo(gw_[6]), o[13] * bf_hi(gw_[6])); w1.w = cvt_pk_bf16(o[14] * bf_lo(gw_[7]), o[15] * bf_hi(gw_[7]));
        *(u32x4*)(ymixb + (size_t)m * 2048 + 1024 + c0) = w0; *(u32x4*)(ymixb + (size_t)m * 2048 + 1024 + c0 + 8) = w1;
    }
}

__device__ __forceinline__ void ssd_conv_phase(const bf16_t* projb, const float* cw, const float* cb, const float* dt_bias, bf16_t* xbcc, float* dtb, const int vcu, const int G, const int tid) {
    for (int u = vcu; u < M / 64; u += G) {
        if (tid < 384) {
            const int cg = tid % 192, hf = tid / 192, c0 = 8 * cg, m0 = u * 64 + 32 * hf, t_in_seq = m0 % SEQ;
            float w[4][8], bias[8];
#pragma unroll
            for (int q = 0; q < 4; ++q) { const f32x4 a = *(const f32x4*)(cw + q * CONV_DIM + c0), b = *(const f32x4*)(cw + q * CONV_DIM + c0 + 4);
                w[q][0] = a[0]; w[q][1] = a[1]; w[q][2] = a[2]; w[q][3] = a[3]; w[q][4] = b[0]; w[q][5] = b[1]; w[q][6] = b[2]; w[q][7] = b[3]; }
            { const f32x4 a = *(const f32x4*)(cb + c0), b = *(const f32x4*)(cb + c0 + 4); bias[0] = a[0]; bias[1] = a[1]; bias[2] = a[2]; bias[3] = a[3]; bias[4] = b[0]; bias[5] = b[1]; bias[6] = b[2]; bias[7] = b[3]; }
            float win[3][8];
#pragma unroll
            for (int q = 0; q < 3; ++q) {
                u32x4 r = (u32x4){0u, 0u, 0u, 0u};
                if (t_in_seq - 3 + q >= 0) r = *(const u32x4*)(projb + (size_t)(m0 - 3 + q) * PROJ_BLD + OFF_XBC + c0);
                win[q][0] = bf_lo(r.x); win[q][1] = bf_hi(r.x); win[q][2] = bf_lo(r.y); win[q][3] = bf_hi(r.y); win[q][4] = bf_lo(r.z); win[q][5] = bf_hi(r.z); win[q][6] = bf_lo(r.w); win[q][7] = bf_hi(r.w);
            }
            for (int i0 = 0; i0 < 32; i0 += 8) {
                u32x4 rr[8];
#pragma unroll
                for (int q = 0; q < 8; ++q) rr[q] = *(const u32x4*)(projb + (size_t)(m0 + i0 + q) * PROJ_BLD + OFF_XBC + c0);
#pragma unroll
                for (int q = 0; q < 8; ++q) {
                    const u32x4 r = rr[q];
                    float cur[8] = {bf_lo(r.x), bf_hi(r.x), bf_lo(r.y), bf_hi(r.y), bf_lo(r.z), bf_hi(r.z), bf_lo(r.w), bf_hi(r.w)};
                    float o[8];
#pragma unroll
                    for (int e = 0; e < 8; ++e) { const float acc = bias[e] + w[0][e] * win[0][e] + w[1][e] * win[1][e] + w[2][e] * win[2][e] + w[3][e] * cur[e]; o[e] = fast_silu(acc);
                        win[0][e] = win[1][e]; win[1][e] = win[2][e]; win[2][e] = cur[e]; }
                    u32x4 wv; wv.x = cvt_pk_bf16(o[0], o[1]); wv.y = cvt_pk_bf16(o[2], o[3]); wv.z = cvt_pk_bf16(o[4], o[5]); wv.w = cvt_pk_bf16(o[6], o[7]);
                    *(u32x4*)(xbcc + (size_t)(m0 + i0 + q) * CONV_DIM + c0) = wv;
                }
            }
        }
#pragma unroll
        for (int q = 0; q < 2; ++q) { const int idx = tid + 512 * q, m = u * 64 + (idx >> 4), h = idx & 15;
            const float x = bf2f(projb[(size_t)m * PROJ_BLD + OFF_DT + h]) + dt_bias[h];
            dtb[(size_t)m * SSD_H + h] = fmaxf(x, 0.f) + log1pf(expf(-fabsf(x))); }
    }
}

constexpr int SP = 136;
constexpr int SS_C = 0, SS_B = 34816, SS_BT = 69632, SS_XT = 104448, SS_XW = 113152, SS_HT = 121856, SS_AC = 130560, SS_DT = 131072, SS_END = 131584;
__device__ __forceinline__ void ssd_scan_phase(LAS unsigned char* lds, const bf16_t* xbcc, const float* dtb, const float* a_log, const float* dskip, bf16_t* yssd, const int vcu, const int G, const int tid) {
    const int wave = __builtin_amdgcn_readfirstlane(tid >> 6), lane = tid & 63, fr = lane & 15, fq = lane >> 4;
    const int lt = (wave < 4) ? 2 * wave : 15 - 2 * wave;
    LAS bf16_t* Cimg = (LAS bf16_t*)(lds + SS_C); LAS bf16_t* Bimg = (LAS bf16_t*)(lds + SS_B); LAS bf16_t* BTimg = (LAS bf16_t*)(lds + SS_BT);
    LAS bf16_t* xT = (LAS bf16_t*)(lds + SS_XT); LAS bf16_t* xwT = (LAS bf16_t*)(lds + SS_XW); LAS bf16_t* hT = (LAS bf16_t*)(lds + SS_HT);
    LAS float* acum = (LAS float*)(lds + SS_AC); LAS float* dtv = (LAS float*)(lds + SS_DT);
    for (int u = vcu; u < BATCH * SSD_H * 2; u += G) {
        const int b = u >> 5, h = (u >> 1) & 15, phalf = u & 1, g = h >> 3;
        const float Ah = -expf(a_log[h]) * 1.4426950408889634f;
        const float dsk = dskip[h];
        f32x4 hs[2] = {(f32x4){0.f, 0.f, 0.f, 0.f}, (f32x4){0.f, 0.f, 0.f, 0.f}};
        for (int i = tid; i < 32 * SP / 2; i += 512) ((LAS unsigned*)hT)[i] = 0u;
        const int row = tid >> 2, part = tid & 3;
        u32x4 cvn[4], bvn[4], xrn; float dtn = 0.f, dtn1 = 0.f;
#define SS_FETCH(ch_) do { const bf16_t* src_ = xbcc + (size_t)(b * SEQ + (ch_) * 128 + row) * CONV_DIM; \
        _Pragma("unroll") for (int j = 0; j < 4; ++j) { cvn[j] = *(const u32x4*)(src_ + 1280 + g * 128 + 32 * part + 8 * j); bvn[j] = *(const u32x4*)(src_ + 1024 + g * 128 + 32 * part + 8 * j); } \
        xrn = *(const u32x4*)(src_ + h * 64 + phalf * 32 + 8 * part); \
        if (tid < 64) { const float* dp_ = dtb + (size_t)(b * SEQ + (ch_) * 128 + 2 * tid) * SSD_H + h; dtn = dp_[0]; dtn1 = dp_[SSD_H]; } } while (0)
        SS_FETCH(0);
        for (int ch = 0; ch < SEQ / 128; ++ch) {
            const int mrow0 = b * SEQ + ch * 128;
            u32x4 xr;
            {
                u32x4 cv[4], bv[4];
#pragma unroll
                for (int j = 0; j < 4; ++j) { cv[j] = cvn[j]; bv[j] = bvn[j]; }
                xr = xrn;
                if (wave == 0) {
                    const float d0 = dtn, d1 = dtn1;
                    *(LAS f32x2*)(dtv + 2 * lane) = (f32x2){d0, d1};
                    const float v0 = d0 * Ah, v1 = d1 * Ah;
                    float s = v0 + v1;
#define SS_DPPF(x_, ctrl_, rm_, bc_) __int_as_float(__builtin_amdgcn_update_dpp(0, __float_as_int(x_), (ctrl_), (rm_), 0xF, (bc_)))
                    s += SS_DPPF(s, 0x111, 0xF, true); asm("" : "+v"(s));
                    s += SS_DPPF(s, 0x112, 0xF, true); asm("" : "+v"(s));
                    s += SS_DPPF(s, 0x114, 0xF, true); asm("" : "+v"(s));
                    s += SS_DPPF(s, 0x118, 0xF, true); asm("" : "+v"(s));
                    s += SS_DPPF(s, 0x142, 0xA, false); asm("" : "+v"(s));
                    s += SS_DPPF(s, 0x143, 0xC, false); asm("" : "+v"(s));
#undef SS_DPPF
                    *(LAS f32x2*)(acum + 2 * lane) = (f32x2){s - v1, s};
                }
                if (ch + 1 < SEQ / 128) SS_FETCH(ch + 1);
#pragma unroll
                for (int j = 0; j < 4; ++j) { *(LAS u32x4*)(Cimg + row * SP + 32 * part + 8 * j) = cv[j]; *(LAS u32x4*)(Bimg + row * SP + 32 * part + 8 * j) = bv[j]; }
#pragma unroll
                for (int j = 0; j < 4; ++j) { const unsigned wv[4] = {bv[j].x, bv[j].y, bv[j].z, bv[j].w};
#pragma unroll
                    for (int e = 0; e < 4; ++e) { const int n = 32 * part + 8 * j + 2 * e; BTimg[n * SP + row] = (bf16_t)(wv[e] & 0xffffu); BTimg[(n + 1) * SP + row] = (bf16_t)(wv[e] >> 16); } }
            }
            __syncthreads();
            const float atot = acum[127];
            {
                const float wgt = dtv[row] * __builtin_amdgcn_exp2f(atot - acum[row]);
                const unsigned wv[4] = {xr.x, xr.y, xr.z, xr.w};
#pragma unroll
                for (int e = 0; e < 4; ++e) { const int p = 8 * part + 2 * e; const float x0 = bf_lo(wv[e]), x1 = bf_hi(wv[e]);
                    xT[p * SP + row] = (bf16_t)(wv[e] & 0xffffu); xT[(p + 1) * SP + row] = (bf16_t)(wv[e] >> 16);
                    const unsigned pk = cvt_pk_bf16(x0 * wgt, x1 * wgt); xwT[p * SP + row] = (bf16_t)(pk & 0xffffu); xwT[(p + 1) * SP + row] = (bf16_t)(pk >> 16); }
            }
            f32x4 gacc[8];
#pragma unroll
            for (int st = 0; st < 8; ++st) gacc[st] = (f32x4){0.f, 0.f, 0.f, 0.f};
            {
                bf16x8 cf[4];
#pragma unroll
                for (int ks = 0; ks < 4; ++ks) cf[ks] = *(const LAS bf16x8*)(Cimg + (16 * lt + fr) * SP + 32 * ks + 8 * fq);
#pragma unroll
                for (int st = 0; st < 8; ++st) if (st <= lt) {
#pragma unroll
                    for (int ks = 0; ks < 4; ++ks) { const bf16x8 bfg = *(const LAS bf16x8*)(Bimg + (16 * st + fr) * SP + 32 * ks + 8 * fq);
                        gacc[st] = __builtin_amdgcn_mfma_f32_16x16x32_bf16(bfg, cf[ks], gacc[st], 0, 0, 0); }
                }
            }
            __syncthreads();
            {
                LAS bf16_t* Mimg = Bimg;
                const int l = 16 * lt + fr; const float al = acum[l];
#pragma unroll
                for (int st = 0; st < 8; ++st) if (st <= lt + 1) {
                    u32x2 wv = (u32x2){0u, 0u};
                    if (st <= lt) {
                        const f32x4 as4 = *(const LAS f32x4*)(acum + 16 * st + 4 * fq), dt4 = *(const LAS f32x4*)(dtv + 16 * st + 4 * fq);
                        float mv[4];
#pragma unroll
                        for (int r = 0; r < 4; ++r) { const int s = 16 * st + 4 * fq + r; mv[r] = (s <= l) ? gacc[st][r] * dt4[r] * __builtin_amdgcn_exp2f(al - as4[r]) : 0.f; }
                        wv.x = cvt_pk_bf16(mv[0], mv[1]); wv.y = cvt_pk_bf16(mv[2], mv[3]);
                    }
                    *(LAS u32x2*)(Mimg + l * SP + 16 * st + 4 * fq) = wv;
                }
            }
            __syncthreads();
            {
                const LAS bf16_t* Mimg = Bimg;
                f32x4 yd[2] = {(f32x4){0.f, 0.f, 0.f, 0.f}, (f32x4){0.f, 0.f, 0.f, 0.f}}, yo[2] = {(f32x4){0.f, 0.f, 0.f, 0.f}, (f32x4){0.f, 0.f, 0.f, 0.f}};
#pragma unroll
                for (int ks = 0; ks < 4; ++ks) {
                    const bf16x8 cfr = *(const LAS bf16x8*)(Cimg + (16 * lt + fr) * SP + 32 * ks + 8 * fq);
#pragma unroll
                    for (int pt = 0; pt < 2; ++pt) { const bf16x8 hf = *(const LAS bf16x8*)(hT + (16 * pt + fr) * SP + 32 * ks + 8 * fq);
                        yo[pt] = __builtin_amdgcn_mfma_f32_16x16x32_bf16(hf, cfr, yo[pt], 0, 0, 0); }
                    if (2 * ks <= lt) {
                        const bf16x8 mf = *(const LAS bf16x8*)(Mimg + (16 * lt + fr) * SP + 32 * ks + 8 * fq);
#pragma unroll
                        for (int pt = 0; pt < 2; ++pt) { const bf16x8 xf_ = *(const LAS bf16x8*)(xT + (16 * pt + fr) * SP + 32 * ks + 8 * fq);
                            yd[pt] = __builtin_amdgcn_mfma_f32_16x16x32_bf16(xf_, mf, yd[pt], 0, 0, 0); }
                    }
                }
                const int l = 16 * lt + fr; const float el = __builtin_amdgcn_exp2f(acum[l]);
#pragma unroll
                for (int pt = 0; pt < 2; ++pt) {
                    f32x4 o;
#pragma unroll
                    for (int r = 0; r < 4; ++r) o[r] = yd[pt][r] + el * yo[pt][r] + dsk * bf2f(xT[(16 * pt + 4 * fq + r) * SP + l]);
                    { u32x2 w2; w2.x = cvt_pk_bf16(o[0], o[1]); w2.y = cvt_pk_bf16(o[2], o[3]); *(u32x2*)(yssd + (size_t)(mrow0 + l) * 1024 + h * 64 + phalf * 32 + 16 * pt + 4 * fq) = w2; }
                }
            }
            {
                const float ea = __builtin_amdgcn_exp2f(atot);
                hs[0] = hs[0] * ea; hs[1] = hs[1] * ea;
#pragma unroll
                for (int ks = 0; ks < 4; ++ks) {
                    const bf16x8 btf = *(const LAS bf16x8*)(BTimg + (16 * wave + fr) * SP + 32 * ks + 8 * fq);
#pragma unroll
                    for (int pt = 0; pt < 2; ++pt) { const bf16x8 xwf = *(const LAS bf16x8*)(xwT + (16 * pt + fr) * SP + 32 * ks + 8 * fq);
                        hs[pt] = __builtin_amdgcn_mfma_f32_16x16x32_bf16(btf, xwf, hs[pt], 0, 0, 0); }
                }
            }
            __syncthreads();
#pragma unroll
            for (int pt = 0; pt < 2; ++pt) { u32x2 wv; wv.x = cvt_pk_bf16(hs[pt][0], hs[pt][1]); wv.y = cvt_pk_bf16(hs[pt][2], hs[pt][3]);
                *(LAS u32x2*)(hT + (16 * pt + fr) * SP + 16 * wave + 4 * fq) = wv; }
        }
#undef SS_FETCH
        __syncthreads();
    }
}

__device__ __forceinline__ void ssd_post_phase(const bf16_t* __restrict__ yssd, const bf16_t* __restrict__ projb, const float* __restrict__ norm_w, bf16_t* __restrict__ ymixb, const int gw, const int NGW, const int lane) {
    const int c0 = 16 * lane;
    f32x4 nw[4];
#pragma unroll
    for (int j = 0; j < 4; ++j) nw[j] = *(const f32x4*)(norm_w + c0 + 4 * j);
#pragma unroll 2
    for (int m = gw; m < M; m += NGW) {
        f32x4 y[4];
        ld_bf16x16(yssd + (size_t)m * 1024 + c0, y);
        const u32x4 z0 = *(const u32x4*)(projb + (size_t)m * PROJ_BLD + OFF_Z + c0), z1 = *(const u32x4*)(projb + (size_t)m * PROJ_BLD + OFF_Z + c0 + 8);
        const unsigned zw[8] = {z0.x, z0.y, z0.z, z0.w, z1.x, z1.y, z1.z, z1.w};
        float uu[16]; float ss = 0.f;
#pragma unroll
        for (int e = 0; e < 8; ++e) { uu[2 * e] = y[e >> 1][(2 * e) & 3] * fast_silu(bf_lo(zw[e])); uu[2 * e + 1] = y[e >> 1][(2 * e + 1) & 3] * fast_silu(bf_hi(zw[e])); ss += uu[2 * e] * uu[2 * e] + uu[2 * e + 1] * uu[2 * e + 1]; }
#pragma unroll
        for (int o = 1; o < 32; o <<= 1) ss += __shfl_xor(ss, o);
        const float rs = rsqrtf(ss * (1.f / 512.f) + 1e-5f);
        u32x4 w0, w1;
        w0.x = cvt_pk_bf16(uu[0] * rs * nw[0][0], uu[1] * rs * nw[0][1]); w0.y = cvt_pk_bf16(uu[2] * rs * nw[0][2], uu[3] * rs * nw[0][3]);
        w0.z = cvt_pk_bf16(uu[4] * rs * nw[1][0], uu[5] * rs * nw[1][1]); w0.w = cvt_pk_bf16(uu[6] * rs * nw[1][2], uu[7] * rs * nw[1][3]);
        w1.x = cvt_pk_bf16(uu[8] * rs * nw[2][0], uu[9] * rs * nw[2][1]); w1.y = cvt_pk_bf16(uu[10] * rs * nw[2][2], uu[11] * rs * nw[2][3]);
        w1.z = cvt_pk_bf16(uu[12] * rs * nw[3][0], uu[13] * rs * nw[3][1]); w1.w = cvt_pk_bf16(uu[14] * rs * nw[3][2], uu[15] * rs * nw[3][3]);
        *(u32x4*)(ymixb + (size_t)m * 2048 + c0) = w0; *(u32x4*)(ymixb + (size_t)m * 2048 + c0 + 8) = w1;
    }
}

#define PH_BEGIN int z_ = 0; asm volatile("" : "+s"(z_)); unsigned char* const wsq = P.ws + z_; int tid = tid0; asm volatile("" : "+v"(tid)); \
    const int G = G0 + z_, bx = bx0 + z_, vcu = vcu0 + z_, lane = tid & 63, wave = __builtin_amdgcn_readfirstlane(tid >> 6), gw = vcu * NWAVES + wave, NGW = G * NWAVES; (void)bx; (void)lane; (void)gw; (void)NGW; (void)wave;
#define CVT_MIXER_WEIGHTS(L_, gw, NGW, tix, tnum) do { const int L = (L_); \
            cvt_job<0>(INP(1) + (size_t)L * D * IN_DIM, D, IN_DIM, Win_t, 0, 0, scr, gw, NGW, lane); \
            if (L > 0) cvt_job<0>(INP(2) + (size_t)(L - 1) * D * 32, D, 32, Win_t, IN_DIM, 0, scr, gw, NGW, lane); \
            { const int r0 = L > 0 ? IN_DIM + 32 : IN_DIM, nz = (PROJ_BLD - r0) * (D / 8);       \
              const unsigned oz = __float_as_uint(opaque0()); for (int i = (tix); i < nz; i += (tnum)) *(u32x4*)(Win_t + (size_t)r0 * D + (size_t)i * 8) = (u32x4){oz, oz, oz, oz}; } \
            cvt_job<0>(INP(23) + (size_t)L * D * D, D, D, Wout_t, 0, 0, scr, gw, NGW, lane); \
            cvt_job<0>(INP(12) + (size_t)L * 64 * 1024, 64, 1024, Wl_w, 0, 0, scr, gw, NGW, lane); \
            cvt_job<0>(INP(14) + (size_t)L * 64 * 1024, 64, 1024, Wl_a, 0, 0, scr, gw, NGW, lane); \
            cvt_job<0>(INP(17) + (size_t)L * 160 * 1024, 160, 1024, Wl_g, 0, 0, scr, gw, NGW, lane); \
            if (L > 0) cvt_job<0>(INP(16) + (size_t)(L - 1) * 32 * 1024, 32, 1024, Wl_v, 0, 0, scr, gw, NGW, lane); } while (0)
#define INP(i) (P.in[(i) + z_])
#define RW_ARGS(a) RwScan a; a.proj_ = projb; a.lw_ = lw; a.mix = INP(9) + (size_t)l * RW_SHIFT; a.w0 = INP(11) + l * 1024; a.a0 = INP(13) + l * 1024; a.v0 = INP(15) + (l > 0 ? l - 1 : 0) * 1024; \
            a.k_k = INP(18) + l * 1024; a.k_a = INP(19) + l * 1024; a.r_k = INP(20) + l * 1024; a.vf_ = vfirst; a.y_ = (bf16_t*)yrw; a.bon_ = (bf16_t*)bon; a.layer = l; a.pad = 0; \
            a.cw1 = moe ? INP(32) + (size_t)li * NE * D * DFE : INP(28) + (size_t)li * D * DFF; a.cw3 = moe ? INP(33) + (size_t)li * NE * D * DFE : INP(29) + (size_t)li * D * DFF; a.cw2 = moe ? INP(34) + (size_t)li * NE * DFE * D : INP(30) + (size_t)li * DFF * D; a.cwt = Wffn; a.cmoe = moe ? 1 : 0; a.pad2 = 0;

#define Win_t ((bf16_t*)(wsq + WS_WIN))
#define Wout_t ((bf16_t*)(wsq + WS_WOUT))
#define Wffn ((bf16_t*)(wsq + WS_WFFN))
#define Wl_w ((bf16_t*)(wsq + WS_WLORA))
#define Wl_a (Wl_w + 1024 * 64)
#define Wl_g (Wl_a + 1024 * 64)
#define Wl_v (Wl_g + 1024 * 160)
#define xf ((float*)(wsq + WS_XF))
#define xb ((bf16_t*)(wsq + WS_XB))
#define projb ((bf16_t*)(wsq + WS_PROJB))
#define ymixb ((bf16_t*)(wsq + WS_YMIXB))
#define mixed ((float*)(wsq + WS_MIXED))
#define hbuf ((bf16_t*)(wsq + WS_HBUF))
#define xg ((bf16_t*)(wsq + WS_XG))
#define yslot ((float*)(wsq + WS_YSLOT))
#define xbcc ((bf16_t*)(wsq + WS_XBCC))
#define dtb ((float*)(wsq + WS_DTB))
#define yssd ((float*)(wsq + WS_YSSD))
#define lw ((bf16_t*)(wsq + WS_LW))
#define yrw ((float*)(wsq + WS_YRW))
#define bon ((float*)(wsq + WS_BON))
#define vfirst ((float*)(wsq + WS_VFIRST))
#define tok_e ((int*)(wsq + WS_TOK))
#define tok_pos (tok_e + 2 * M)
#define tok_g ((float*)(tok_pos + 2 * M))
#define tok_dest ((int*)(tok_g + 2 * M))
#define src_row (tok_dest + 2 * M)
#define cnt ((int*)(wsq + WS_CTL) + CW_CNT + 8 * li)
__global__ void __launch_bounds__(NWAVES * 64, 2) fwd(Params P) {
    extern __shared__ __attribute__((aligned(16))) unsigned char lds_raw[];
    LAS unsigned char* lds = (LAS unsigned char*)lds_raw;
    volatile LAS unsigned* MISC = (volatile LAS unsigned*)(lds + MISC_OFF);
    const int tid0 = threadIdx.x;
    const int G0 = gridDim.x, bx0 = blockIdx.x;
    const int vcu0 = (G0 % 8 == 0) ? (bx0 % 8) * (G0 / 8) + bx0 / 8 : bx0;
    unsigned* ctl = (unsigned*)(P.ws + WS_CTL);
    if (tid0 < 64) MISC[tid0] = 0u;
    __syncthreads();
#if MK_LAUNCH_MODE == 1
    constexpr int lo = 0, hi = 64;
#else
    const int lo = P.ph_lo, hi = P.ph_hi;
#endif
    XcdBarrier bar; bar.bar = ctl + CW_BAR + P.bar_idx * XCD_BAR_WORDS; bar.x = 0; bar.st = MISC + 8;
    if (hi - lo > 1) bar = xcd_barrier_post(ctl + CW_BAR + P.bar_idx * XCD_BAR_WORDS, MISC + 8);
#define IN(k) (lo <= (k) && (k) < hi)
#ifndef MK_TS_MASK
#define MK_TS_MASK 0
#endif
#ifndef MK_TS_MULT
#define MK_TS_MULT 8
#endif
    unsigned long long ts_acc = 0ull, ts_t0 = 0ull; (void)ts_acc; (void)ts_t0;
#ifndef MK_TS_LAYERS
#define MK_TS_LAYERS 0xF
#endif
#define TS_ON(k) (MK_TS_MASK != 0 && ((MK_TS_MASK >> (k)) & 1) && ((MK_TS_LAYERS >> l) & 1))
#define TS_BEGIN(k) do { if (TS_ON(k)) ts_t0 = __builtin_amdgcn_s_memrealtime(); } while (0)
#define TS_END(k) do { if (TS_ON(k)) { __syncthreads(); ts_acc += __builtin_amdgcn_s_memrealtime() - ts_t0; } } while (0)
#define SEAM(k) do { if (((k) & 15) == 3 && TS_ON(21)) { TS_END(21); } if ((k) + 1 < hi) { TS_END((k) & 15); TS_BEGIN(20); xcd_barrier(bar); if ((MK_DBL >> 19) & 1) xcd_barrier(bar); TS_END(20); } else { TS_END((k) & 15); } } while (0)

    for (int l = 0; l < 4; ++l) {
        const int pb = l * 16, li = l >> 1; const bool moe = (l & 1) != 0;
        if (IN(pb + 0) && l == 0) {
            PH_BEGIN
            TS_BEGIN(0);
            for (int rep_ = 0; rep_ < 1 + ((MK_DBL >> 0) & 1); ++rep_) {
            LAS float* scr = (LAS float*)(lds + wave * 16384);
            CVT_MIXER_WEIGHTS(0, gw, NGW, bx * 512 + tid, G * 512);
            if (l == 0) {
                const float* x = INP(0);
                const size_t stride = (size_t)G * 512, total = (size_t)M * D / 8;
                size_t i = (size_t)bx * 512 + tid;
                for (; i + 3 * stride < total; i += 4 * stride) {
                    f32x4 a[4], b[4];
#pragma unroll
                    for (int q = 0; q < 4; ++q) { a[q] = *(const f32x4*)(x + (i + q * stride) * 8); b[q] = *(const f32x4*)(x + (i + q * stride) * 8 + 4); }
#pragma unroll
                    for (int q = 0; q < 4; ++q) { u32x4 w; w.x = cvt_pk_bf16(a[q][0], a[q][1]); w.y = cvt_pk_bf16(a[q][2], a[q][3]); w.z = cvt_pk_bf16(b[q][0], b[q][1]); w.w = cvt_pk_bf16(b[q][2], b[q][3]);
                        *(u32x4*)(xb + (i + q * stride) * 8) = w; }
                }
                for (; i < total; i += stride) {
                    const f32x4 a = *(const f32x4*)(x + i * 8), b = *(const f32x4*)(x + i * 8 + 4);
                    u32x4 w; w.x = cvt_pk_bf16(a[0], a[1]); w.y = cvt_pk_bf16(a[2], a[3]); w.z = cvt_pk_bf16(b[0], b[1]); w.w = cvt_pk_bf16(b[2], b[3]);
                    *(u32x4*)(xb + i * 8) = w; }
            }
            }
            __syncthreads();
            SEAM(pb + 0);
        }
        if (IN(pb + 1)) {
            PH_BEGIN
            TS_BEGIN(1);
            pg8::Gemm g{xb, Win_t, D}; pg8::StaticOrder S; S.init(M, PROJ_BLD, G, bx);
            pg8::EpiBf16 E{projb, PROJ_BLD};
            pg8::gemm_phase<pg8::EpiBf16, pg8::StaticOrder>(lds, g, S, E, tid);
#if (MK_DBL >> 1) & 1
            pg8::gemm_phase<pg8::EpiBf16, pg8::StaticOrder>(lds, g, S, E, tid);
#endif
            SEAM(pb + 1);
        }
        if (IN(pb + 2)) {
            PH_BEGIN
            TS_BEGIN(2);
            lora_phase(lds, projb, INP(9) + (size_t)l * RW_SHIFT, INP(10) + (size_t)(l > 0 ? l - 1 : 0) * 32, Wl_w, Wl_a, Wl_g, Wl_v, lw, l > 0, vcu, G, tid);
#if (MK_DBL >> 2) & 1
            lora_phase(lds, projb, INP(9) + (size_t)l * RW_SHIFT, INP(10) + (size_t)(l > 0 ? l - 1 : 0) * 32, Wl_w, Wl_a, Wl_g, Wl_v, lw, l > 0, vcu, G, tid);
#endif
            ssd_conv_phase(projb, INP(3) + (size_t)l * 4 * CONV_DIM, INP(4) + (size_t)l * CONV_DIM, INP(5) + l * SSD_H, xbcc, dtb, vcu, G, tid);
#if (MK_DBL >> 11) & 1
            ssd_conv_phase(projb, INP(3) + (size_t)l * 4 * CONV_DIM, INP(4) + (size_t)l * CONV_DIM, INP(5) + l * SSD_H, xbcc, dtb, vcu, G, tid);
#endif
#if MK_RWKV_CHUNKED == 2
            __syncthreads();
            {
                RW_ARGS(a);
                int tid3 = tid; asm volatile("" : "+v"(tid3));
                rwkv_pre_phase(lds, a, wsq + WS_IMG, vcu, G, tid3, true, true);
#if (MK_DBL >> 12) & 1
                __syncthreads();
                rwkv_pre_phase(lds, a, wsq + WS_IMG, vcu, G, tid3, false, true);
#endif
#if (MK_DBL >> 13) & 1
                __syncthreads();
                rwkv_pre_phase(lds, a, wsq + WS_IMG, vcu, G, tid3, true, false);
#endif
            }
#endif
            SEAM(pb + 2);
        }
        if (IN(pb + 3)) {
            PH_BEGIN
            TS_BEGIN(3);
#if MK_RWKV_CHUNKED == 2
            RW_ARGS(a);
            const bool ssd_first = ((vcu >> 1) & 1) != 0;
            if (ssd_first) { int tid4 = tid; asm volatile("" : "+v"(tid4)); ssd_scan_phase(lds, xbcc, dtb, INP(6) + l * SSD_H, INP(7) + l * SSD_H, (bf16_t*)yssd, vcu, G, tid4); }
            rwkv_state_phase(lds, wsq + WS_IMG, (bf16_t*)yrw, a, vcu, G, tid);
#if (MK_DBL >> 3) & 1
            rwkv_state_phase(lds, wsq + WS_IMG, (bf16_t*)yrw, a, vcu, G, tid);
#endif
#elif MK_RWKV_CHUNKED
            RW_ARGS(a);
            rwkv_chunk_phase(lds, a, vcu, G, tid);
#else
            RW_ARGS(a);
            rwkv_scan_phase(lds, a, vcu, G, tid);
#endif
            if (TS_ON(21)) { TS_END(3); TS_BEGIN(21); }
#if ((MK_DBL >> 3) & 1) && MK_RWKV_CHUNKED == 0
            rwkv_scan_phase(lds, a, vcu, G, tid);
#endif
            int tid2 = tid; asm volatile("" : "+v"(tid2));
#if MK_RWKV_CHUNKED == 2
            if (!ssd_first)
#endif
            ssd_scan_phase(lds, xbcc, dtb, INP(6) + l * SSD_H, INP(7) + l * SSD_H, (bf16_t*)yssd, vcu, G, tid2);
#if (MK_DBL >> 10) & 1
            ssd_scan_phase(lds, xbcc, dtb, INP(6) + l * SSD_H, INP(7) + l * SSD_H, (bf16_t*)yssd, vcu, G, tid);
#endif
            SEAM(pb + 3);
        }
        if (IN(pb + 4)) {
            PH_BEGIN
            TS_BEGIN(4);
            rwkv_post_phase((const bf16_t*)yrw, (const bf16_t*)bon, lw + (size_t)2 * M * 1024, INP(21) + l * 1024, INP(22) + l * 1024, ymixb, gw, NGW, lane);
#if (MK_DBL >> 4) & 1
            rwkv_post_phase((const bf16_t*)yrw, (const bf16_t*)bon, lw + (size_t)2 * M * 1024, INP(21) + l * 1024, INP(22) + l * 1024, ymixb, gw, NGW, lane);
#endif
            ssd_post_phase((const bf16_t*)yssd, projb, INP(8) + l * 1024, ymixb, gw, NGW, lane);
#if (MK_DBL >> 4) & 1
            ssd_post_phase((const bf16_t*)yssd, projb, INP(8) + l * 1024, ymixb, gw, NGW, lane);
#endif
            SEAM(pb + 4);
        }
        if (IN(pb + 5)) {
            PH_BEGIN
            TS_BEGIN(5);
            pg8::Gemm g{ymixb, Wout_t, D}; pg8::StaticOrder S; S.init(M, D, G, bx);
            pg8::EpiBf16 E{(bf16_t*)mixed, FLD};
#if (MK_DBL >> 14) & 1
            { pg8::RepeatOrder R; R.init2(M, D, G, bx, 2); pg8::gemm_phase<pg8::EpiBf16, pg8::RepeatOrder>(lds, g, R, E, tid); }
#else
            pg8::gemm_phase<pg8::EpiBf16, pg8::StaticOrder>(lds, g, S, E, tid);
#endif
#if (MK_DBL >> 5) & 1
            pg8::gemm_phase<pg8::EpiBf16, pg8::StaticOrder>(lds, g, S, E, tid);
#endif
            SEAM(pb + 5);
        }
        if (IN(pb + 6)) {
            PH_BEGIN
            TS_BEGIN(6);
            const float* xin = INP(0);
            f32x4 g8[8], b8[8];
#pragma unroll
            for (int j = 0; j < 8; ++j) { g8[j] = *(const f32x4*)(INP(24) + l * D + 4 * lane + 256 * j); b8[j] = *(const f32x4*)(INP(25) + l * D + 4 * lane + 256 * j); }
            LAS float* rs = (LAS float*)lds;
            LAS int* wgcnt = (LAS int*)(lds + 65536); LAS int* wgbase = wgcnt + 8; LAS int* rec = wgcnt + 16;
            if (moe) { const float* router = INP(31) + (size_t)li * D * NE;
                for (int i = tid; i < D * NE; i += 512) rs[(i & 7) * D + (i >> 3)] = router[i];
                if (tid < 16) wgcnt[tid] = 0;
                __syncthreads(); }
            int nrec = 0;
            for (int m0 = gw; m0 < M; m0 += 2 * NGW) {
                const int m1 = m0 + NGW; const bool has1 = m1 < M; const int m1c = has1 ? m1 : m0;
                f32x4 va[8], vb[8];
#pragma unroll
                for (int j = 0; j < 8; ++j) { const int c = 4 * lane + 256 * j;
                    const u32x2 ma = *(const u32x2*)((const bf16_t*)mixed + (size_t)m0 * FLD + c), mb = *(const u32x2*)((const bf16_t*)mixed + (size_t)m1c * FLD + c);
                    const f32x4 xa = (l == 0) ? *(const f32x4*)(xin + (size_t)m0 * D + c) : ld_bf4(xb + (size_t)m0 * D + c), xbv = (l == 0) ? *(const f32x4*)(xin + (size_t)m1c * D + c) : ld_bf4(xb + (size_t)m1c * D + c);
                    va[j] = ALPHA * xa + (f32x4){bf_lo(ma.x), bf_hi(ma.x), bf_lo(ma.y), bf_hi(ma.y)};
                    vb[j] = ALPHA * xbv + (f32x4){bf_lo(mb.x), bf_hi(mb.x), bf_lo(mb.y), bf_hi(mb.y)}; }
                ln_finish(va, g8, b8, lane, (float*)nullptr, xb + (size_t)m0 * D);
                if (has1) ln_finish(vb, g8, b8, lane, (float*)nullptr, xb + (size_t)m1 * D);
                if (moe) {
#pragma unroll
                    for (int r = 0; r < 2; ++r) {
                        if (r == 1 && !has1) break;
                        const int m = r ? m1 : m0;
                        float sl[8];
#pragma unroll
                        for (int e = 0; e < 8; ++e) { float s = 0.f;
#pragma unroll
                            for (int j = 0; j < 8; ++j) { const f32x4 rr = *(const LAS f32x4*)(rs + e * D + 4 * lane + 256 * j); const f32x4 vv = r ? vb[j] : va[j]; s += (vv[0] * rr[0] + vv[1] * rr[1]) + (vv[2] * rr[2] + vv[3] * rr[3]); }
                            sl[e] = s; }
                        const float z0 = reduce4(sl[0], sl[1], sl[2], sl[3]), z1 = reduce4(sl[4], sl[5], sl[6], sl[7]);
                        const float lg[8] = {rdlane(z0, 0), rdlane(z0, 16), rdlane(z0, 32), rdlane(z0, 48), rdlane(z1, 0), rdlane(z1, 16), rdlane(z1, 32), rdlane(z1, 48)};
                        if (lane == 0) {
                            int i0 = 0; float v0 = lg[0];
#pragma unroll
                            for (int e = 1; e < 8; ++e) if (lg[e] > v0) { v0 = lg[e]; i0 = e; }
                            int i1 = -1; float v1 = -3.4e38f;
#pragma unroll
                            for (int e = 0; e < 8; ++e) if (e != i0 && lg[e] > v1) { v1 = lg[e]; i1 = e; }
                            const float e1 = expf(v1 - v0);
                            tok_e[2 * m] = i0; tok_e[2 * m + 1] = i1; tok_g[2 * m] = 1.f / (1.f + e1); tok_g[2 * m + 1] = e1 / (1.f + e1);
                            const int lp0 = __hip_atomic_fetch_add(&wgcnt[i0], 1, __ATOMIC_RELAXED, __HIP_MEMORY_SCOPE_WORKGROUP), lp1 = __hip_atomic_fetch_add(&wgcnt[i1], 1, __ATOMIC_RELAXED, __HIP_MEMORY_SCOPE_WORKGROUP);
                            LAS int* rc = rec + ((nrec + r) * NWAVES + wave) * 5;
                            rc[0] = m; rc[1] = i0; rc[2] = i1; rc[3] = lp0; rc[4] = lp1;
                        }
                    }
                    nrec += has1 ? 2 : 1;
                }
            }
            if (moe) {
                __syncthreads();
                if (tid < 8) wgbase[tid] = atomicAdd(&cnt[tid], wgcnt[tid]);
                __syncthreads();
                for (int i = tid; i < nrec * NWAVES; i += 512) { const LAS int* rc = rec + i * 5; const int m = rc[0];
                    tok_pos[2 * m] = wgbase[rc[1]] + rc[3]; tok_pos[2 * m + 1] = wgbase[rc[2]] + rc[4]; }
            }
            __syncthreads();
            SEAM(pb + 6);
        }
        if (IN(pb + 7) && moe) {
            PH_BEGIN
            TS_BEGIN(7);
            LAS float* scr = (LAS float*)(lds + wave * 16384);
            if (moe) {
                int start[8]; { int acc = 0;
#pragma unroll
                    for (int e = 0; e < 8; ++e) { start[e] = acc; acc += ((cnt[e] + 255) >> 8) << 8; } }
                for (int i = bx * 512 + tid; i < 2 * M; i += G * 512) {
                    const int e = tok_e[i], pos = tok_pos[i];
                    int st = 0;
#pragma unroll
                    for (int q = 0; q < 8; ++q) st = (e == q) ? start[q] : st;
                    const int dest = st + pos;
                    tok_dest[i] = dest; src_row[dest] = i >> 1;
                }
                for (int p = bx * 512 + tid; p < PMAX; p += G * 512) {
                    int e = 0;
#pragma unroll
                    for (int q = 1; q < 8; ++q) e += (p >= start[q]) ? 1 : 0;
                    if (p - start[e] >= cnt[e]) src_row[p] = 0;
                }
            }
            __syncthreads();
            SEAM(pb + 7);
        }
        if (IN(pb + 8)) {
            PH_BEGIN
            TS_BEGIN(8);
            if (!moe) {
                pg8::Gemm g{xb, Wffn, D}; pg8::StaticOrder S; S.init(M, 2 * DFF, G, bx);
                pg8::EpiSwiglu E{hbuf, DFF};
                pg8::gemm_phase<pg8::EpiSwiglu, pg8::StaticOrder>(lds, g, S, E, tid);
#if (MK_DBL >> 15) & 1
                pg8::gemm_phase<pg8::EpiSwiglu, pg8::StaticOrder>(lds, g, S, E, tid);
#endif
            } else {
                pg8::Gemm g{xb, Wffn, D, src_row}; pg8::GroupedOrder S; S.init(cnt, 2 * DFE, G, bx);
                pg8::EpiSwiglu E{hbuf, DFE};
                pg8::gemm_phase<pg8::EpiSwiglu, pg8::GroupedOrder, true>(lds, g, S, E, tid);
#if (MK_DBL >> 16) & 1
                pg8::gemm_phase<pg8::EpiSwiglu, pg8::GroupedOrder>(lds, g, S, E, tid);
#endif
            }
            SEAM(pb + 8);
        }
        if (IN(pb + 9)) {
            PH_BEGIN
            TS_BEGIN(9);
            if (!moe) {
                pg8::Gemm g{hbuf, Wffn + (size_t)2 * DFF * D, DFF}; pg8::StaticOrder S; S.init(M, D, G, bx);
                pg8::EpiBf16 E{(bf16_t*)yslot, FLD};
                pg8::gemm_phase<pg8::EpiBf16, pg8::StaticOrder>(lds, g, S, E, tid);
            } else {
                pg8::Gemm g{hbuf, Wffn + (size_t)NE * 2 * DFE * D, DFE}; pg8::GroupedOrder S; S.init(cnt, D, G, bx);
                pg8::EpiBf16 E{(bf16_t*)yslot, FLD};
                pg8::gemm_phase<pg8::EpiBf16, pg8::GroupedOrder>(lds, g, S, E, tid);
            }
            if (l < 3) {
                int tail = 0;
                if (moe) { int np = 0;
#pragma unroll
                    for (int e = 0; e < 8; ++e) np += (cnt[e] + 255) >> 8;
                    tail = (np * (D / 256)) % G; }
                if (bx >= tail) {
                    LAS float* scr = (LAS float*)(lds + wave * 16384);
                    const int fwg = bx - tail, nf = G - tail;
                    CVT_MIXER_WEIGHTS(l + 1, fwg * NWAVES + wave, nf * NWAVES, fwg * 512 + tid, nf * 512);
                }
            }
            SEAM(pb + 9);
        }
        if (IN(pb + 10)) {
            PH_BEGIN
            TS_BEGIN(10);
            f32x4 g8[8], b8[8];
#pragma unroll
            for (int j = 0; j < 8; ++j) { g8[j] = *(const f32x4*)(INP(26) + l * D + 4 * lane + 256 * j); b8[j] = *(const f32x4*)(INP(27) + l * D + 4 * lane + 256 * j); }
            float* dst = (l == 3) ? P.out : (float*)nullptr; const bf16_t* ysb = (const bf16_t*)yslot;
            for (int m0 = gw; m0 < M; m0 += 2 * NGW) {
                const int m1 = m0 + NGW; const bool has1 = m1 < M; const int m1c = has1 ? m1 : m0;
                f32x4 va[8], vb[8];
                if (!moe) {
#pragma unroll
                    for (int j = 0; j < 8; ++j) { const int c = 4 * lane + 256 * j;
                        va[j] = ALPHA * ld_bf4(xb + (size_t)m0 * D + c) + ld_bf4(ysb + (size_t)m0 * FLD + c);
                        vb[j] = ALPHA * ld_bf4(xb + (size_t)m1c * D + c) + ld_bf4(ysb + (size_t)m1c * FLD + c); }
                } else {
                    const int a0 = tok_dest[2 * m0], a1 = tok_dest[2 * m0 + 1], c0 = tok_dest[2 * m1c], c1 = tok_dest[2 * m1c + 1];
                    const float ga0 = tok_g[2 * m0], ga1 = tok_g[2 * m0 + 1], gc0 = tok_g[2 * m1c], gc1 = tok_g[2 * m1c + 1];
#pragma unroll
                    for (int j = 0; j < 8; ++j) { const int c = 4 * lane + 256 * j;
                        va[j] = ALPHA * ld_bf4(xb + (size_t)m0 * D + c) + ga0 * ld_bf4(ysb + (size_t)a0 * FLD + c) + ga1 * ld_bf4(ysb + (size_t)a1 * FLD + c);
                        vb[j] = ALPHA * ld_bf4(xb + (size_t)m1c * D + c) + gc0 * ld_bf4(ysb + (size_t)c0 * FLD + c) + gc1 * ld_bf4(ysb + (size_t)c1 * FLD + c); }
                }
                ln_finish(va, g8, b8, lane, dst ? dst + (size_t)m0 * D : (float*)nullptr, (l == 3) ? (bf16_t*)nullptr : xb + (size_t)m0 * D);
                if (has1) ln_finish(vb, g8, b8, lane, dst ? dst + (size_t)m1 * D : (float*)nullptr, (l == 3) ? (bf16_t*)nullptr : xb + (size_t)m1 * D);
            }
            SEAM(pb + 10);
        }
    }
    if (MK_TS_MASK != 0 && bx0 == 0 && tid0 < 64) {
        const unsigned long long t_end = __builtin_amdgcn_s_memrealtime() + (unsigned long long)MK_TS_MULT * ts_acc;
        while (__builtin_amdgcn_s_memrealtime() < t_end) __builtin_amdgcn_s_sleep(32);
    }
#undef IN
#undef SEAM
}
#undef PH_BEGIN
#undef CVT_MIXER_WEIGHTS
#undef INP
#undef Win_t
#undef Wout_t
#undef Wffn
#undef Wl_w
#undef Wl_a
#undef Wl_g
#undef Wl_v
#undef xf
#undef xb
#undef projb
#undef ymixb
#undef mixed
#undef hbuf
#undef xg
#undef yslot
#undef xbcc
#undef dtb
#undef yssd
#undef lw
#undef yrw
#undef bon
#undef vfirst
#undef tok_e
#undef tok_pos
#undef tok_g
#undef tok_dest
#undef src_row
#undef cnt


}

extern "C" void kernel_launch(void* const* d_in, const int* in_sizes, int n_in, void* d_out, int out_size, void* d_ws, size_t ws_size, hipStream_t stream) {
    (void)in_sizes; (void)out_size;
    static int grid = 0;
    if (grid == 0) {
        if (n_in != 35 || ws_size < WS_END) { fprintf(stderr, "kernel_launch: need 35 inputs and %zu bytes of workspace (got %d, %zu)\n", (size_t)WS_END, n_in, ws_size); grid = -1; return; }
        int dev = 0, cus = 0;
        if (hipGetDevice(&dev) != hipSuccess || hipDeviceGetAttribute(&cus, hipDeviceAttributeMultiprocessorCount, dev) != hipSuccess) { grid = -1; return; }
        if (hipFuncSetAttribute((const void*)fwd, hipFuncAttributeMaxDynamicSharedMemorySize, LDS_BYTES) != hipSuccess) { fprintf(stderr, "kernel_launch: hipFuncSetAttribute failed\n"); grid = -1; return; }
        int per_cu = 0;
        if (hipOccupancyMaxActiveBlocksPerMultiprocessor(&per_cu, (const void*)fwd, NWAVES * 64, LDS_BYTES) != hipSuccess || per_cu < 1) { fprintf(stderr, "kernel_launch: occupancy query says %d blocks per CU\n", per_cu); }
        (void)hipGetLastError();
        grid = cus;
    }
    if (grid < 0) return;
    unsigned char* ws = (unsigned char*)d_ws;
    (void)hipMemsetAsync(ws + WS_CTL, 0, CTL_BYTES, stream);
    Params P{};
    for (int i = 0; i < 35; ++i) P.in[i] = (const float*)d_in[i];
    P.out = (float*)d_out; P.ws = ws; P.pad = 0;
    int nbar = 0;
    auto run = [&](int lo, int hi) {
        P.ph_lo = lo; P.ph_hi = hi; P.bar_idx = (hi - lo > 1) ? nbar++ : 0;
        hipLaunchKernelGGL(fwd, dim3(grid), dim3(NWAVES * 64), LDS_BYTES, stream, P);
    };
    if (MK_LAUNCH_MODE == 1) run(0, 64);
    else if (MK_LAUNCH_MODE == 4) { for (int l = 0; l < 4; ++l) run(l * 16, l * 16 + 16); }
    else { for (int l = 0; l < 4; ++l) for (int k = 0; k <= 10; ++k) run(l * 16 + k, l * 16 + k + 1); }
}
```

```cpp
#include <hip/hip_runtime.h>
#include <cstdint>
#include <cstdio>

#ifndef MK_DBL
#define MK_DBL 0
#endif
#ifndef MK_CV_CUT_MOE
#define MK_CV_CUT_MOE 16896
#endif
#ifndef MK_CV_CUT_DENSE
#define MK_CV_CUT_DENSE 16896
#endif
#ifndef MK_RWKV_CHUNKED
#define MK_RWKV_CHUNKED 2
#endif
#ifndef MK_GEMM_8PH
#define MK_GEMM_8PH 0
#endif
#ifndef MK_LAUNCH_MODE
#define MK_LAUNCH_MODE 1
#endif
namespace {
constexpr int BATCH = 8, SEQ = 2048, M = BATCH * SEQ, D = 2048;
constexpr int HD = 64, SSD_H = 16, SSD_N = 128, CONV_DIM = 1536;
constexpr int RW_H = 16;
constexpr int IN_DIM = 5936, PROJ_LD = 5968;
constexpr int OFF_Z = 0, OFF_XBC = 1024, OFF_DT = 2560, OFF_RW = 2576, OFF_R = 2576, OFF_K = 3600, OFF_V = 4624, OFF_WLO = 5648, OFF_ALO = 5712, OFF_GLO = 5776, OFF_VLO = 5936;
constexpr int RW_SHIFT = 3360;
constexpr int DFF = 5632, NE = 8, DFE = 2816;
constexpr float ALPHA = 1.681792830507429f;
constexpr int LORA_LD = 320;

__device__ __forceinline__ float sigmoidf_(float x) { return 1.f / (1.f + expf(-x)); }
__device__ __forceinline__ float siluf_(float x) { return x / (1.f + expf(-x)); }
__device__ __forceinline__ float softplusf_(float x) { return fmaxf(x, 0.f) + log1pf(expf(-fabsf(x))); }
__device__ __forceinline__ float wave_sum(float v) {
#pragma unroll
    for (int o = 32; o >= 1; o >>= 1) v += __shfl_xor(v, o);
    return v;
}


#define LAS __attribute__((address_space(3)))
typedef unsigned short bf16_t;
typedef short bf16x8 __attribute__((ext_vector_type(8)));
typedef float f32x4 __attribute__((ext_vector_type(4)));
typedef float f32x2 __attribute__((ext_vector_type(2)));
typedef unsigned u32x4 __attribute__((ext_vector_type(4)));
typedef unsigned u32x2 __attribute__((ext_vector_type(2)));

typedef __bf16 bf16x2_t __attribute__((ext_vector_type(2)));
__device__ __forceinline__ unsigned cvt_pk_bf16(float lo, float hi) { const f32x2 v = {lo, hi}; const bf16x2_t b = __builtin_convertvector(v, bf16x2_t); return __builtin_bit_cast(unsigned, b); }
__device__ __forceinline__ float bf_lo(unsigned w) { return __uint_as_float(w << 16); }
__device__ __forceinline__ float bf_hi(unsigned w) { return __uint_as_float(w & 0xffff0000u); }
__device__ __forceinline__ float bf2f(bf16_t b) { return __uint_as_float(((unsigned)b) << 16); }
__device__ __forceinline__ float opaque0() { float z = 0.f; asm volatile("" : "+v"(z)); return z; }
#define ZERO4() ((f32x4){opaque0(), 0.f, 0.f, 0.f} * 0.f)
__device__ __forceinline__ float fast_silu(float x) { return x * __builtin_amdgcn_rcpf(1.f + __builtin_amdgcn_exp2f(-1.4426950408889634f * x)); }

namespace pg8 {
constexpr int BM = 256, BK = 64, HALF = 128, HTB = HALF * BK * 2, STAGE_BYTES = 8 * HTB, NXCD = 8, WGM = 8;
__host__ __device__ __forceinline__ int lds_byte(int r, int c) { const int st = (r >> 4) * 2 + (c >> 5), rr = r & 15, cc = c & 31, ob = rr * 64 + cc * 2; return st * 1024 + (ob ^ (((ob >> 9) & 1) << 5)); }
__host__ __device__ __forceinline__ void stage_rc(int b, int& R, int& C) { const int st = b / 1024, sb = b % 1024, swz = sb ^ (((sb >> 9) & 1) << 5); R = (st >> 1) * 16 + swz / 64; C = (st & 1) * 32 + (swz % 64) / 2; }
__host__ __device__ __forceinline__ int perm32(int rho) { const int n = rho >> 4, i = rho & 15; return 8 * (i >> 2) + 4 * n + (i & 3); }

struct Unit { int pm, pn, pb; };
struct Gemm { const bf16_t* A; const bf16_t* Bt; int K; const int* rowmap = nullptr; };

__device__ __forceinline__ void decode_unit(int wgid, int nM, int nN, int& pm, int& pn) {
    const int nwg = nM * nN;
    { const int q = nwg / NXCD, r = nwg % NXCD, xcd = wgid % NXCD, off = wgid / NXCD; wgid = (xcd < r ? xcd * (q + 1) : r * (q + 1) + (xcd - r) * q) + off; }
    const int nig = WGM * nN, gid = wgid / nig, fm = gid * WGM, gsz = (nM - fm) < WGM ? (nM - fm) : WGM;
    pm = fm + ((wgid % nig) % gsz); pn = (wgid % nig) / gsz;
}
struct StaticOrder {
    int nM, nN, nwg, G, c;
    __device__ void init(int Mrows, int N, int G_, int c_) { nM = Mrows / BM; nN = N / BM; nwg = nM * nN; G = G_; c = c_; }
    __device__ __forceinline__ bool next(int i, Unit& u) const {
        const long L = (long)i * G + c; if (L >= nwg) return false;
        decode_unit((int)L, nM, nN, u.pm, u.pn); u.pb = u.pn; return true;
    }
};
struct RepeatOrder : StaticOrder {
    int per, reps;
    __device__ void init2(int Mrows, int N, int G_, int c_, int reps_) { init(Mrows, N, G_, c_); per = (nwg + G - 1) / G; reps = reps_; }
    __device__ __forceinline__ bool next(int i, Unit& u) const { if (i >= per * reps) return false; return StaticOrder::next(i % per, u); }
};
struct GroupedOrder {
    int nM, nN, nwg, G, c; int cum[9];
    __device__ void init(const int* cnt, int N, int G_, int c_) {
        int acc = 0;
#pragma unroll
        for (int e = 0; e < 8; ++e) { cum[e] = acc; acc += (cnt[e] + 255) >> 8; }
        cum[8] = acc; nM = acc; nN = N / BM; nwg = nM * nN; G = G_; c = c_;
    }
    __device__ __forceinline__ bool next(int i, Unit& u) const {
        const long L = (long)i * G + c; if (L >= nwg) return false;
        decode_unit((int)L, nM, nN, u.pm, u.pn);
        int e = 0;
#pragma unroll
        for (int q = 1; q < 8; ++q) e += (u.pm >= cum[q]) ? 1 : 0;
        u.pb = e * nN + u.pn; return true;
    }
};

struct EpiF32 {
    static constexpr bool PERM = false;
    float* C; int ldc;
    __device__ __forceinline__ void operator()(const f32x4 (&acc)[2][2][4][2], const Unit& u, int wr, int wc, int fr, int fq) const {
        const int row0 = u.pm * BM + wr * 64 + fr, col0 = u.pn * BM + wc * 32 + 4 * fq;
#pragma unroll
        for (int ai = 0; ai < 2; ++ai)
#pragma unroll
            for (int m = 0; m < 4; ++m) { float* rowp = C + (size_t)(row0 + ai * HALF + m * 16) * ldc + col0;
#pragma unroll
                for (int bj = 0; bj < 2; ++bj)
#pragma unroll
                    for (int n = 0; n < 2; ++n) *(f32x4*)(rowp + bj * HALF + n * 16) = acc[ai][bj][m][n]; }
    }
};
struct EpiBf16 {
    static constexpr bool PERM = true;
    bf16_t* O; int ldc;
    __device__ __forceinline__ void operator()(const f32x4 (&acc)[2][2][4][2], const Unit& u, int wr, int wc, int fr, int fq) const {
        const int row0 = u.pm * BM + wr * 64 + fr, col0 = u.pn * BM + wc * 32 + 8 * fq;
#pragma unroll
        for (int ai = 0; ai < 2; ++ai)
#pragma unroll
            for (int m = 0; m < 4; ++m) { bf16_t* rowp = O + (size_t)(row0 + ai * HALF + m * 16) * ldc + col0;
#pragma unroll
                for (int bj = 0; bj < 2; ++bj) { const f32x4 v0 = acc[ai][bj][m][0], v1 = acc[ai][bj][m][1];
                    u32x4 w; w.x = cvt_pk_bf16(v0[0], v0[1]); w.y = cvt_pk_bf16(v0[2], v0[3]); w.z = cvt_pk_bf16(v1[0], v1[1]); w.w = cvt_pk_bf16(v1[2], v1[3]);
                    *(u32x4*)(rowp + bj * HALF) = w; } }
    }
};
struct EpiSwiglu {
    static constexpr bool PERM = true;
    bf16_t* O; int ldc;
    __device__ __forceinline__ void operator()(const f32x4 (&acc)[2][2][4][2], const Unit& u, int wr, int wc, int fr, int fq) const {
        const int row0 = u.pm * BM + wr * 64 + fr, col0 = u.pn * HALF + wc * 32 + 8 * fq;
#pragma unroll
        for (int ai = 0; ai < 2; ++ai)
#pragma unroll
            for (int m = 0; m < 4; ++m) { bf16_t* rowp = O + (size_t)(row0 + ai * HALF + m * 16) * ldc + col0;
                float o[8];
#pragma unroll
                for (int n = 0; n < 2; ++n)
#pragma unroll
                    for (int i = 0; i < 4; ++i) o[n * 4 + i] = fast_silu(acc[ai][0][m][n][i]) * acc[ai][1][m][n][i];
                u32x4 w; w.x = cvt_pk_bf16(o[0], o[1]); w.y = cvt_pk_bf16(o[2], o[3]); w.z = cvt_pk_bf16(o[4], o[5]); w.w = cvt_pk_bf16(o[6], o[7]);
                *(u32x4*)rowp = w; }
    }
};

template <class Epi, class Sched, bool GATHER = false>
__device__ __forceinline__ void gemm_phase(LAS unsigned char* lds, const Gemm g, const Sched& S, const Epi& E, const int tid) {
    const int wid = __builtin_amdgcn_readfirstlane(tid >> 6), lane = tid & 63, wr = wid >> 2, wc = wid & 3, fr = lane & 15, fq = lane >> 4;
    const int K = g.K, nt = K / BK;
    unsigned voffA[2], voffB[2];
#pragma unroll
    for (int i = 0; i < 2; ++i) { int R, C; stage_rc(tid * 16 + i * 8192, R, C); const int Rb = Epi::PERM ? ((R & ~31) + perm32(R & 31)) : R;
        voffA[i] = (unsigned)(R * K + C) * 2u; voffB[i] = (unsigned)(Rb * K + C) * 2u; }
    unsigned goC[2][2], goN[2][2];
#define PG8_GLOOK(dst, unit_) do { _Pragma("unroll") for (int h_ = 0; h_ < 2; ++h_) _Pragma("unroll") for (int i_ = 0; i_ < 2; ++i_) { int R_, C_; stage_rc(tid * 16 + i_ * 8192, R_, C_); \
        dst[h_][i_] = (unsigned)(g.rowmap[(unit_).pm * BM + h_ * HALF + R_] * K + C_) * 2u; } } while (0)
#define PG8_STAGE_G(bufoff, kb_, go_, h_) do { _Pragma("unroll") for (int _i = 0; _i < 2; ++_i) \
        __builtin_amdgcn_global_load_lds((const unsigned*)((const char*)g.A + (kb_) + (go_)[h_][_i]), (LAS unsigned*)(lds + (bufoff) + ldsw + _i * 8192), 16, 0, 0); } while (0)
#define PG8_STAGE_A(bufoff, base_, nx_, kb_, h_) do { if (GATHER) { if (nx_) PG8_STAGE_G(bufoff, kb_, goN, h_); else PG8_STAGE_G(bufoff, kb_, goC, h_); } \
        else PG8_STAGE(bufoff, (base_) + (kb_) + (h_) * hstep, voffA); } while (0)
    const size_t kstep = (size_t)(BK * 2);
    const size_t hstep = (size_t)HALF * K * 2;
    const size_t tstep = 2 * hstep;
    const unsigned ldsw = (unsigned)wid * 1024u;
    const int aoff = lds_byte(wr * 64 + fr, fq * 8), boff = lds_byte(wc * 32 + fr, fq * 8);
#define PG8_SA(b, h) (((b) * 2 + (h)) * HTB)
#define PG8_SB(b, h) ((4 + (b) * 2 + (h)) * HTB)
#define PG8_STAGE(bufoff, gbase, voff) do { _Pragma("unroll") for (int _i = 0; _i < 2; ++_i) \
        __builtin_amdgcn_global_load_lds((const unsigned*)((const char*)(gbase) + (voff)[_i]), (LAS unsigned*)(lds + (bufoff) + ldsw + _i * 8192), 16, 0, 0); } while (0)
#define PG8_LDA(dst, b, h) do { _Pragma("unroll") for (int m = 0; m < 4; ++m) _Pragma("unroll") for (int k = 0; k < 2; ++k) dst[m][k] = *(const LAS bf16x8*)(lds + PG8_SA(b, h) + aoff + m * 2048 + k * 1024); } while (0)
#define PG8_LDB(dst, b, h) do { _Pragma("unroll") for (int n = 0; n < 2; ++n) _Pragma("unroll") for (int k = 0; k < 2; ++k) dst[n][k] = *(const LAS bf16x8*)(lds + PG8_SB(b, h) + boff + n * 2048 + k * 1024); } while (0)
#define PG8_MMA(ai, bj, At, Bt) do { __builtin_amdgcn_s_setprio(1); _Pragma("unroll") for (int m = 0; m < 4; ++m) _Pragma("unroll") for (int n = 0; n < 2; ++n) _Pragma("unroll") for (int k = 0; k < 2; ++k) \
        acc[ai][bj][m][n] = __builtin_amdgcn_mfma_f32_16x16x32_bf16(Bt[n][k], At[m][k], acc[ai][bj][m][n], 0, 0, 0); __builtin_amdgcn_s_setprio(0); } while (0)
#define PG8_WAIT_V(n) asm volatile("s_waitcnt vmcnt(" #n ")" ::: "memory")
#define PG8_WAIT_L(n) asm volatile("s_waitcnt lgkmcnt(" #n ")" ::: "memory")
#define PG8_BAR __builtin_amdgcn_s_barrier()
#define PG8_SCHED __builtin_amdgcn_sched_barrier(0)
    Unit cur, nxt; int ui = 0;
    if (!S.next(0, cur)) return;
    f32x4 acc[2][2][4][2];
#pragma unroll
    for (int a = 0; a < 2; ++a)
#pragma unroll
        for (int b = 0; b < 2; ++b)
#pragma unroll
            for (int m = 0; m < 4; ++m)
#pragma unroll
                for (int n = 0; n < 2; ++n) acc[a][b][m][n] = ZERO4();
    bf16x8 At[4][2], B0[2][2], B1[2][2];
    const char* cA = (const char*)g.A + (size_t)cur.pm * tstep; const char* cB = (const char*)g.Bt + (size_t)cur.pb * tstep;
#if MK_GEMM_8PH
    PG8_STAGE(PG8_SB(0, 0), cB, voffB); PG8_STAGE(PG8_SA(0, 0), cA, voffA); PG8_STAGE(PG8_SB(0, 1), cB + hstep, voffB); PG8_STAGE(PG8_SA(0, 1), cA + hstep, voffA);
    if (wr == 1) PG8_BAR;
    PG8_WAIT_V(4); PG8_BAR;
    PG8_STAGE(PG8_SB(1, 0), cB + kstep, voffB); PG8_STAGE(PG8_SA(1, 0), cA + kstep, voffA); PG8_STAGE(PG8_SB(1, 1), cB + hstep + kstep, voffB);
    PG8_WAIT_V(6); PG8_BAR;
#else
    if (GATHER) { PG8_GLOOK(goC, cur); PG8_GLOOK(goN, cur); }
    PG8_STAGE(PG8_SB(0, 0), cB, voffB); PG8_STAGE(PG8_SB(0, 1), cB + hstep, voffB); PG8_STAGE_A(PG8_SA(0, 0), cA, false, 0, 0); PG8_STAGE_A(PG8_SA(0, 1), cA, false, 0, 1);
    if (wr == 1) PG8_BAR;
    PG8_WAIT_V(2); PG8_BAR;
    PG8_STAGE(PG8_SB(1, 0), cB + kstep, voffB); PG8_STAGE_A(PG8_SA(1, 0), cA, false, kstep, 0); PG8_STAGE(PG8_SB(1, 1), cB + hstep + kstep, voffB);
    PG8_WAIT_V(6); PG8_BAR;
#endif
    for (;;) {
        const bool has_next = S.next(ui + 1, nxt);
        const char* nA = has_next ? (const char*)g.A + (size_t)nxt.pm * tstep : cA; const char* nB = has_next ? (const char*)g.Bt + (size_t)nxt.pb * tstep : cB;
        if (GATHER && has_next && wid < 4) __builtin_amdgcn_global_load_lds((const unsigned*)(g.rowmap + nxt.pm * BM + tid), (LAS unsigned*)(lds + STAGE_BYTES + ((ui + 1) & 1) * 1024 + wid * 256), 4, 0, 0);
        for (int t = 0; t < nt; t += 2) {
            const bool last = (t == nt - 2);
            const char* a1 = cA + (size_t)(t + 1) * kstep;
            const char* a2 = last ? nA : cA + (size_t)(t + 2) * kstep; const char* b2 = last ? nB : cB + (size_t)(t + 2) * kstep;
            const char* a3 = a2 + kstep; const char* b3 = b2 + kstep;
#if MK_GEMM_8PH
            PG8_LDB(B0, 0, 0); PG8_SCHED; PG8_LDA(At, 0, 0); PG8_STAGE(PG8_SA(1, 1), a1 + hstep, voffA);
            PG8_WAIT_L(8); PG8_BAR; PG8_WAIT_L(0); PG8_MMA(0, 0, At, B0); PG8_BAR; PG8_SCHED;
            PG8_LDB(B1, 0, 1); PG8_STAGE(PG8_SB(0, 0), b2, voffB);
            PG8_BAR; PG8_WAIT_L(0); PG8_MMA(0, 1, At, B1); PG8_BAR;
            PG8_LDA(At, 0, 1); PG8_STAGE(PG8_SA(0, 0), a2, voffA);
            PG8_BAR; PG8_WAIT_L(0); PG8_MMA(1, 0, At, B0); PG8_BAR; PG8_SCHED;
            PG8_STAGE(PG8_SB(0, 1), b2 + hstep, voffB);
            PG8_WAIT_V(6); PG8_BAR; PG8_MMA(1, 1, At, B1); PG8_BAR;
            PG8_LDB(B0, 1, 0); PG8_SCHED; PG8_LDA(At, 1, 0); PG8_STAGE(PG8_SA(0, 1), a2 + hstep, voffA);
            PG8_WAIT_L(8); PG8_BAR; PG8_WAIT_L(0); PG8_MMA(0, 0, At, B0); PG8_BAR; PG8_SCHED;
            PG8_LDB(B1, 1, 1); PG8_STAGE(PG8_SB(1, 0), b3, voffB);
            PG8_BAR; PG8_WAIT_L(0); PG8_MMA(0, 1, At, B1); PG8_BAR;
            PG8_LDA(At, 1, 1); PG8_STAGE(PG8_SA(1, 0), a3, voffA);
            PG8_BAR; PG8_WAIT_L(0); PG8_MMA(1, 0, At, B0); PG8_BAR; PG8_SCHED;
            PG8_STAGE(PG8_SB(1, 1), b3 + hstep, voffB);
            PG8_WAIT_V(6); PG8_BAR; PG8_MMA(1, 1, At, B1); PG8_BAR;
#else
            if (GATHER && last && has_next) {
                const LAS int* ib_ = (const LAS int*)(lds + STAGE_BYTES + ((ui + 1) & 1) * 1024);
#pragma unroll
                for (int h_ = 0; h_ < 2; ++h_)
#pragma unroll
                    for (int i_ = 0; i_ < 2; ++i_) { int R_, C_; stage_rc(tid * 16 + i_ * 8192, R_, C_); goN[h_][i_] = (unsigned)(ib_[h_ * HALF + R_] * K + C_) * 2u; }
            }
            const size_t kb1 = (size_t)(t + 1) * kstep, kb2 = last ? (size_t)0 : (size_t)(t + 2) * kstep, kb3 = kb2 + kstep;
            PG8_LDB(B0, 0, 0); PG8_LDB(B1, 0, 1); PG8_SCHED; PG8_LDA(At, 0, 0); PG8_STAGE_A(PG8_SA(1, 1), cA, false, kb1, 1);
            PG8_WAIT_V(8); PG8_WAIT_L(0); PG8_BAR; PG8_MMA(0, 0, At, B0); PG8_MMA(0, 1, At, B1); PG8_BAR; PG8_SCHED;
            PG8_LDA(At, 0, 1); PG8_STAGE(PG8_SB(0, 0), b2, voffB); PG8_STAGE(PG8_SB(0, 1), b2 + hstep, voffB); PG8_STAGE_A(PG8_SA(0, 0), (last ? nA : cA), last, kb2, 0);
            PG8_WAIT_V(8); PG8_WAIT_L(0); PG8_BAR; PG8_MMA(1, 0, At, B0); PG8_MMA(1, 1, At, B1); PG8_BAR; PG8_SCHED;
            PG8_LDB(B0, 1, 0); PG8_LDB(B1, 1, 1); PG8_SCHED; PG8_LDA(At, 1, 0); PG8_STAGE_A(PG8_SA(0, 1), (last ? nA : cA), last, kb2, 1);
            PG8_WAIT_V(8); PG8_WAIT_L(0); PG8_BAR; PG8_MMA(0, 0, At, B0); PG8_MMA(0, 1, At, B1); PG8_BAR; PG8_SCHED;
            PG8_LDA(At, 1, 1); PG8_STAGE(PG8_SB(1, 0), b3, voffB); PG8_STAGE(PG8_SB(1, 1), b3 + hstep, voffB); PG8_STAGE_A(PG8_SA(1, 0), (last ? nA : cA), last, kb3, 0);
            PG8_WAIT_V(8); PG8_WAIT_L(0); PG8_BAR; PG8_MMA(1, 0, At, B0); PG8_MMA(1, 1, At, B1); PG8_BAR; PG8_SCHED;
#endif
        }
        if (wr == 0) PG8_BAR;
        E(acc, cur, wr, wc, fr, fq);
        if (!has_next) break;
#pragma unroll
        for (int a = 0; a < 2; ++a)
#pragma unroll
            for (int b = 0; b < 2; ++b)
#pragma unroll
                for (int m = 0; m < 4; ++m)
#pragma unroll
                    for (int n = 0; n < 2; ++n) acc[a][b][m][n] = ZERO4();
        cur = nxt; cA = nA; cB = nB; ++ui;
        if (GATHER) {
#pragma unroll
            for (int h_ = 0; h_ < 2; ++h_) { goC[h_][0] = goN[h_][0]; goC[h_][1] = goN[h_][1]; } }
        if (wr == 1) PG8_BAR;
    }
    PG8_WAIT_V(0);
    PG8_BAR;
#undef PG8_SA
#undef PG8_SB
#undef PG8_STAGE
#undef PG8_STAGE_A
#undef PG8_STAGE_G
#undef PG8_GLOOK
#undef PG8_LDA
#undef PG8_LDB
#undef PG8_MMA
#undef PG8_WAIT_V
#undef PG8_WAIT_L
#undef PG8_BAR
#undef PG8_SCHED
}
}

#define XB_TMO      128
#define XB_XCNT(j)  (256  + 64 * (j))
#define XB_XSUB(j)  (1280 + 64 * (j))
#define XB_XGEN(j)  (2304 + 64 * (j))
#define XB_TOP      3328
#define XB_TOPGEN   3392
#define XCD_BAR_WORDS 3456
#define XB_SPIN_CAP (1u << 18)
__device__ __forceinline__ unsigned xb_ld(unsigned* p)              { return __hip_atomic_load(p, __ATOMIC_RELAXED, __HIP_MEMORY_SCOPE_AGENT); }
__device__ __forceinline__ unsigned xb_add(unsigned* p, unsigned v) { return __hip_atomic_fetch_add(p, v, __ATOMIC_RELAXED, __HIP_MEMORY_SCOPE_AGENT); }
__device__ __forceinline__ unsigned xb_xcc_id() { return (unsigned)__builtin_amdgcn_s_getreg((3 << 11) | 20) & 0xFu; }
#define XB_SPIN(cond, bar) do { unsigned _sp = 0; while (cond) { __builtin_amdgcn_s_sleep(1); \
    if ((++_sp & 255u) == 0u) { if (xb_ld(&(bar)[XB_TMO])) break; if (_sp > XB_SPIN_CAP) { atomicAdd(&(bar)[XB_TMO], 1u); break; } } } } while (0)
struct XcdBarrier { unsigned* bar; unsigned x; volatile LAS unsigned* st; };
__device__ __forceinline__ XcdBarrier xcd_barrier_post(unsigned* bar, volatile LAS unsigned* st) {
    XcdBarrier b; b.bar = bar; b.x = xb_xcc_id(); b.st = st;
    if (threadIdx.x == 0) (void)xb_add(&bar[XB_XCNT(b.x)], 1u);
    return b;
}
__device__ __forceinline__ void xcd_barrier_complete(unsigned* bar, unsigned x, unsigned& nloc, unsigned& nx) {
    const unsigned G = gridDim.x * gridDim.y * gridDim.z;
    asm volatile("" : "+s"(x));
    unsigned sum, cnt, mine, sp = 0u;
    for (;;) {
        sum = 0u; cnt = 0u; mine = 0u;
#pragma unroll
        for (unsigned j = 0; j < 16; ++j) { const unsigned c = xb_ld(&bar[XB_XCNT(j)]); sum += c; cnt += (c > 0u) ? 1u : 0u; mine = (j == x) ? c : mine; }
        if (sum == G) break;
        __builtin_amdgcn_s_sleep(1);
        if ((++sp & 255u) == 0u) { if (xb_ld(&bar[XB_TMO])) break; if (sp > XB_SPIN_CAP) { atomicAdd(&bar[XB_TMO], 1u); break; } }
    }
    nloc = mine > 0u ? mine : 1u; nx = cnt > 0u ? cnt : 1u;
}
__device__ __forceinline__ void xcd_barrier(const XcdBarrier& b) {
    asm volatile("s_waitcnt vmcnt(0)" ::: "memory");
    __syncthreads();
    if (threadIdx.x == 0) {
        unsigned* bar = b.bar;
        __builtin_amdgcn_s_waitcnt(0);
        unsigned nloc = b.st[0], nx = b.st[1];
        if (nloc == 0u) { xcd_barrier_complete(bar, b.x, nloc, nx); b.st[0] = nloc; b.st[1] = nx; }
        const unsigned old = xb_add(&bar[XB_XSUB(b.x)], 1u);
        const unsigned gen = old / nloc;
        if (old + 1u == (gen + 1u) * nloc) {
            __builtin_amdgcn_fence(__ATOMIC_RELEASE, "agent");
            asm volatile("s_waitcnt vmcnt(0)" ::: "memory");
            const unsigned og = xb_add(&bar[XB_TOP], 1u);
            const unsigned tg = og / nx;
            if (og + 1u == (tg + 1u) * nx) xb_add(&bar[XB_TOPGEN], 1u);
            else XB_SPIN(xb_ld(&bar[XB_TOPGEN]) == tg, bar);
            __builtin_amdgcn_fence(__ATOMIC_ACQUIRE, "agent");
            xb_add(&bar[XB_XGEN(b.x)], 1u);
            asm volatile("s_waitcnt vmcnt(0)" ::: "memory");
        } else {
            XB_SPIN(xb_ld(&bar[XB_XGEN(b.x)]) == gen, bar);
            __builtin_amdgcn_fence(__ATOMIC_ACQUIRE, "agent");
            asm volatile("s_waitcnt vmcnt(0)" ::: "memory");
        }
    }
    __syncthreads();
}

constexpr size_t MiB = 1u << 20;
constexpr int NWAVES = 8;
constexpr int PROJ_BLD = 6144;
constexpr int PMAX = 34816;
constexpr int FLD = 2048 + 64;
constexpr size_t WS_CTL = 0, CTL_BYTES = 1 * MiB;
constexpr size_t WS_WIN = 1 * MiB, WS_WOUT = 25 * MiB, WS_WLORA = 33 * MiB;
constexpr size_t WS_XF = 34 * MiB, WS_XB = 162 * MiB, WS_VFIRST = 226 * MiB, WS_YMIXB = 290 * MiB, WS_TOK = 354 * MiB, WS_SCR = 356 * MiB;
constexpr size_t WS_PROJB = WS_SCR, WS_LW = WS_PROJB + 192 * MiB, WS_YRW = WS_LW + 128 * MiB, WS_BON = WS_YRW + 64 * MiB, WS_XBCC = WS_BON + 64 * MiB, WS_DTB = WS_XBCC + 48 * MiB, WS_YSSD = WS_DTB + 1 * MiB, WS_MIXED = WS_YSSD + 64 * MiB;
constexpr size_t WS_HBUF = WS_SCR, WS_XG = WS_HBUF + 187 * MiB, WS_YSLOT = WS_XG + 136 * MiB;
constexpr size_t WS_WFFN = WS_SCR + 860 * MiB, WS_END = WS_WFFN + 264 * MiB;
constexpr size_t WS_IMG = WS_MIXED;
static_assert(WS_MIXED + 132 * MiB <= WS_WFFN && WS_YSLOT + 281 * MiB <= WS_WFFN, "scratch inside the map");
static_assert((size_t)PMAX * DFE * 2 <= 187 * MiB && (size_t)PMAX * D * 2 <= 136 * MiB && (size_t)PMAX * FLD * 4 <= 281 * MiB && (size_t)M * FLD * 4 <= 132 * MiB, "moe buffers");
constexpr int CW_CNT = 16;
constexpr int CW_BAR = 4096;
constexpr int MAX_BAR_REGIONS = 48;
static_assert((CW_BAR + MAX_BAR_REGIONS * XCD_BAR_WORDS) * 4 <= (int)CTL_BYTES, "ctl");
constexpr int RING_BYTES = 131072, LDS_BYTES = 147456, MISC_OFF = LDS_BYTES - 256;

struct Params { const float* in[35]; float* out; unsigned char* ws; int ph_lo, ph_hi, bar_idx, pad; };

__device__ __forceinline__ float wave_sum_f(float v) {
#pragma unroll
    for (int o = 32; o >= 1; o >>= 1) v += __shfl_xor(v, o);
    return v;
}

__device__ __forceinline__ void cvt_item(const float* W, int K, int N, bf16_t* WT, int dst_row0, LAS float* scr, int k0, int n0, int lane) {
    const int kr = lane >> 3, c4 = (lane & 7) * 4;
    f32x4 v[8];
    if (n0 + 32 <= N && k0 + 64 <= K) {
#pragma unroll
        for (int i = 0; i < 8; ++i) v[i] = *(const f32x4*)(W + (size_t)(k0 + 8 * i + kr) * N + n0 + c4);
    } else {
#pragma unroll
        for (int i = 0; i < 8; ++i) { const int kk = k0 + 8 * i + kr;
#pragma unroll
            for (int e = 0; e < 4; ++e) v[i][e] = (kk < K && n0 + c4 + e < N) ? W[(size_t)kk * N + n0 + c4 + e] : 0.f; }
    }
#pragma unroll
    for (int i = 0; i < 8; ++i) { LAS float* d = scr + (8 * i + kr) * 33 + c4; d[0] = v[i][0]; d[1] = v[i][1]; d[2] = v[i][2]; d[3] = v[i][3]; }
    asm volatile("s_waitcnt lgkmcnt(0)" ::: "memory");
    const int c = lane & 7;
#pragma unroll
    for (int j = 0; j < 4; ++j) { const int n = (lane >> 3) + 8 * j; const LAS float* s = scr + (8 * c) * 33 + n;
        u32x4 o; o.x = cvt_pk_bf16(s[0 * 33], s[1 * 33]); o.y = cvt_pk_bf16(s[2 * 33], s[3 * 33]); o.z = cvt_pk_bf16(s[4 * 33], s[5 * 33]); o.w = cvt_pk_bf16(s[6 * 33], s[7 * 33]);
        if (n0 + n < N && k0 + 8 * c < K) *(u32x4*)(WT + (size_t)(dst_row0 + n) * K + k0 + 8 * c) = o; }
    asm volatile("s_waitcnt lgkmcnt(0)" ::: "memory");
}
template <int MODE>
__device__ __forceinline__ void cvt_job(const float* W, int K, int N, bf16_t* WT, int row_off, int half, LAS float* scr, int gw, int ngw, int lane) {
    const int nkb = (K + 63) / 64, nnb = (N + 31) / 32, nitems = nkb * nnb;
    for (int it = gw; it < nitems; it += ngw) {
        const int kb = it / nnb, nb = it % nnb, n0 = nb * 32;
        const int dr = MODE == 0 ? row_off + n0 : row_off + 256 * (n0 / 128) + half * 128 + (n0 % 128);
        cvt_item(W, K, N, WT, dr, scr, kb * 64, n0, lane);
    }
}

#define DPP_ROR(z, n) __uint_as_float(__builtin_amdgcn_update_dpp(0u, __float_as_uint(z), 0x120 + (n), 0xf, 0xf, false))
__device__ __forceinline__ float wave_allsum(float x) {
    { auto s = __builtin_amdgcn_permlane32_swap(__float_as_uint(x), __float_as_uint(x), false, false); x = __uint_as_float(s[0]) + __uint_as_float(s[1]); }
    { auto s = __builtin_amdgcn_permlane16_swap(__float_as_uint(x), __float_as_uint(x), false, false); x = __uint_as_float(s[0]) + __uint_as_float(s[1]); }
    x += DPP_ROR(x, 8); x += DPP_ROR(x, 4); x += DPP_ROR(x, 2); x += DPP_ROR(x, 1);
    return x;
}
__device__ __forceinline__ float reduce4(float x0, float x1, float x2, float x3) {
    float y0, y1, z;
    { auto s = __builtin_amdgcn_permlane32_swap(__float_as_uint(x0), __float_as_uint(x2), false, false); y0 = __uint_as_float(s[0]) + __uint_as_float(s[1]); }
    { auto s = __builtin_amdgcn_permlane32_swap(__float_as_uint(x1), __float_as_uint(x3), false, false); y1 = __uint_as_float(s[0]) + __uint_as_float(s[1]); }
    { auto s = __builtin_amdgcn_permlane16_swap(__float_as_uint(y0), __float_as_uint(y1), false, false); z = __uint_as_float(s[0]) + __uint_as_float(s[1]); }
    z += DPP_ROR(z, 8); z += DPP_ROR(z, 4); z += DPP_ROR(z, 2); z += DPP_ROR(z, 1);
    return z;
}
__device__ __forceinline__ float rdlane(float v, int l) { return __int_as_float(__builtin_amdgcn_readlane(__float_as_int(v), l)); }
__device__ __forceinline__ f32x4 ld_bf4(const bf16_t* p) { const u32x2 w = *(const u32x2*)p; return (f32x4){bf_lo(w.x), bf_hi(w.x), bf_lo(w.y), bf_hi(w.y)}; }
__device__ __forceinline__ void ln_finish(f32x4 (&v)[8], const f32x4 (&g8)[8], const f32x4 (&b8)[8], int lane, float* xf_row, bf16_t* xb_row) {
    float s = 0.f;
#pragma unroll
    for (int j = 0; j < 8; ++j) s += (v[j][0] + v[j][1]) + (v[j][2] + v[j][3]);
    const float mean = wave_allsum(s) * (1.f / D);
    float q = 0.f;
#pragma unroll
    for (int j = 0; j < 8; ++j) { v[j] = v[j] - mean; q += (v[j][0] * v[j][0] + v[j][1] * v[j][1]) + (v[j][2] * v[j][2] + v[j][3] * v[j][3]); }
    const float rstd = rsqrtf(wave_allsum(q) * (1.f / D) + 1e-5f);
#pragma unroll
    for (int j = 0; j < 8; ++j) { const int c = 4 * lane + 256 * j;
        v[j] = v[j] * rstd * g8[j] + b8[j];
        if (xf_row) *(f32x4*)(xf_row + c) = v[j];
        if (xb_row) { u32x2 w; w.x = cvt_pk_bf16(v[j][0], v[j][1]); w.y = cvt_pk_bf16(v[j][2], v[j][3]); *(u32x2*)(xb_row + c) = w; } }
}

__device__ __forceinline__ float fast_sigmoid(float x) { return __builtin_amdgcn_rcpf(1.f + __builtin_amdgcn_exp2f(-1.4426950408889634f * x)); }
__device__ __forceinline__ float fast_tanh(float x) { return 1.f - 2.f * __builtin_amdgcn_rcpf(1.f + __builtin_amdgcn_exp2f(2.8853900817779268f * x)); }

constexpr int LORA_PITCH = 328;
__device__ __forceinline__ void lora_phase(LAS unsigned char* lds, const bf16_t* projb, const float* mix, const float* vmix, const bf16_t* Wl_w, const bf16_t* Wl_a, const bf16_t* Wl_g, const bf16_t* Wl_v,
                                           bf16_t* lw, const bool has_v, const int vcu, const int G, const int tid) {
    const int wave = __builtin_amdgcn_readfirstlane(tid >> 6), lane = tid & 63, fr = lane & 15, fq = lane >> 4;
    LAS bf16_t* Aimg = (LAS bf16_t*)lds;
    for (int u = vcu; u < M / 64; u += G) {
        {
            const int tau = tid >> 3, part = tid & 7, m = u * 64 + tau; const bool first = (m % SEQ) == 0;
#pragma unroll
            for (int i = 0; i < 5; ++i) {
                const int j0 = 40 * part + 8 * i;
                const u32x4 cur = *(const u32x4*)(projb + (size_t)m * PROJ_BLD + OFF_WLO + j0);
                u32x4 prv = (u32x4){0u, 0u, 0u, 0u};
                if (!first) prv = *(const u32x4*)(projb + (size_t)(m - 1) * PROJ_BLD + OFF_WLO + j0);
                f32x4 mx0, mx1;
                if (j0 < 288) { mx0 = *(const f32x4*)(mix + (OFF_WLO - OFF_RW) + j0); mx1 = *(const f32x4*)(mix + (OFF_WLO - OFF_RW) + j0 + 4); }
                else if (has_v) { mx0 = *(const f32x4*)(vmix + (j0 - 288)); mx1 = *(const f32x4*)(vmix + (j0 - 288) + 4); }
                else { mx0 = (f32x4){0.f, 0.f, 0.f, 0.f}; mx1 = mx0; }
                float o[8];
#pragma unroll
                for (int e = 0; e < 4; ++e) {
                    const float c0 = bf_lo(cur[e]), c1 = bf_hi(cur[e]), p0 = bf_lo(prv[e]), p1 = bf_hi(prv[e]);
                    const float m0 = (e < 2) ? mx0[2 * e] : mx1[2 * e - 4], m1 = (e < 2) ? mx0[2 * e + 1] : mx1[2 * e - 3];
                    o[2 * e] = c0 + (p0 - c0) * m0; o[2 * e + 1] = c1 + (p1 - c1) * m1;
                }
                if (j0 < 64) {
#pragma unroll
                    for (int e = 0; e < 8; ++e) o[e] = fast_tanh(o[e]);
                } else if (j0 >= 128 && j0 < 288) {
#pragma unroll
                    for (int e = 0; e < 8; ++e) o[e] = fast_sigmoid(o[e]);
                }
                u32x4 w; w.x = cvt_pk_bf16(o[0], o[1]); w.y = cvt_pk_bf16(o[2], o[3]); w.z = cvt_pk_bf16(o[4], o[5]); w.w = cvt_pk_bf16(o[6], o[7]);
                *(LAS u32x4*)(Aimg + tau * LORA_PITCH + j0) = w;
            }
        }
        __syncthreads();
        for (int q = 0; q < 4; ++q) {
            if (q == 3 && !has_v) break;
            const int K = (q == 2) ? 160 : (q == 3 ? 32 : 64), koff = (q == 0) ? 0 : (q == 1 ? 64 : (q == 2 ? 128 : 288));
            const bf16_t* W = (q == 0) ? Wl_w : (q == 1 ? Wl_a : (q == 2 ? Wl_g : Wl_v));
            f32x4 acc[8][4];
#pragma unroll
            for (int ct = 0; ct < 8; ++ct)
#pragma unroll
                for (int tt = 0; tt < 4; ++tt) acc[ct][tt] = (f32x4){0.f, 0.f, 0.f, 0.f};
            for (int ks = 0; ks < K / 32; ++ks) {
                bf16x8 af[8], bfr[4];
#pragma unroll
                for (int ct = 0; ct < 8; ++ct) af[ct] = *(const bf16x8*)(W + (size_t)(128 * wave + 32 * (ct >> 1) + 8 * (fr >> 2) + 4 * (ct & 1) + (fr & 3)) * K + 32 * ks + 8 * fq);
#pragma unroll
                for (int tt = 0; tt < 4; ++tt) bfr[tt] = *(const LAS bf16x8*)(Aimg + (16 * tt + fr) * LORA_PITCH + koff + 32 * ks + 8 * fq);
#pragma unroll
                for (int ct = 0; ct < 8; ++ct)
#pragma unroll
                    for (int tt = 0; tt < 4; ++tt) acc[ct][tt] = __builtin_amdgcn_mfma_f32_16x16x32_bf16(af[ct], bfr[tt], acc[ct][tt], 0, 0, 0);
            }
            bf16_t* out = lw + (size_t)q * M * 1024;
#pragma unroll
            for (int cp = 0; cp < 4; ++cp)
#pragma unroll
                for (int tt = 0; tt < 4; ++tt) { u32x4 w; w.x = cvt_pk_bf16(acc[2 * cp][tt][0], acc[2 * cp][tt][1]); w.y = cvt_pk_bf16(acc[2 * cp][tt][2], acc[2 * cp][tt][3]);
                    w.z = cvt_pk_bf16(acc[2 * cp + 1][tt][0], acc[2 * cp + 1][tt][1]); w.w = cvt_pk_bf16(acc[2 * cp + 1][tt][2], acc[2 * cp + 1][tt][3]);
                    *(u32x4*)(out + (size_t)(u * 64 + 16 * tt + fr) * 1024 + 128 * wave + 32 * cp + 8 * fq) = w; }
        }
        __syncthreads();
    }
}

struct RwScan { const bf16_t* proj_; const bf16_t* lw_; const float* mix; const float* w0; const float* a0; const float* v0; const float* k_k; const float* k_a; const float* r_k; float* vf_; bf16_t* y_; bf16_t* bon_; int layer; int pad;
                const float* cw1; const float* cw3; const float* cw2; bf16_t* cwt; int cmoe; int pad2; };
constexpr int RWB_A = 0, RWB_DR = 8192, RWB_D = 16384, RWB_B = 24576, RWB_K = 32768, RWB_BIG = 40960, RWS_V = 0, RWS_SC = 4096, RWS_SIZE = 4608, RW_SMALL = 2 * RWB_BIG, RW_YST = RW_SMALL + 3 * RWS_SIZE, RW_YST_SIZE = 4096, RW_CVT = RW_YST + 2 * RW_YST_SIZE, RW_TB = 32, RW_NCH = SEQ / RW_TB;
static_assert(RW_CVT + 4 * 8448 <= MISC_OFF, "rwkv scan LDS map");
__device__ __forceinline__ float rowsum16(float z) { z += DPP_ROR(z, 8); asm("" : "+v"(z)); z += DPP_ROR(z, 4); asm("" : "+v"(z)); z += DPP_ROR(z, 2); asm("" : "+v"(z)); z += DPP_ROR(z, 1); asm("" : "+v"(z)); return z; }
__device__ __forceinline__ void rwkv_scan_phase(LAS unsigned char* lds, const RwScan& a, const int vcu, const int G, const int tid) {
    const int wave = __builtin_amdgcn_readfirstlane(tid >> 6), lane = tid & 63, jj = lane & 15, rg = lane >> 4;
    for (int u = vcu; u < BATCH * RW_H * 2; u += G) {
        const int b = u >> 5, h = (u >> 1) & 15, half = u & 1;
        if (wave >= 4) {
            const int pw_ = wave - 4, c = h * 64 + lane, ptid = tid - 256;
            const float mix_r = a.mix[c], mix_k = a.mix[1024 + c], mix_v = a.mix[2048 + c];
            const float w0c = a.w0[c], a0c = a.a0[c], v0c = a.layer ? a.v0[c] : 0.f, kkc = a.k_k[c], kac = a.k_a[c], rkc = a.r_k[c];
            const bf16_t* lw_w = a.lw_; const bf16_t* lw_a = a.lw_ + (size_t)M * 1024; const bf16_t* lw_v = a.lw_ + (size_t)3 * M * 1024;
            const int woff = (lane & 7) * 32 + (lane >> 3) * 4;
            unsigned pr[9], pk[9], pv[9], pw[8], pa[8], pvp[8]; float pvf[8];
#define RW_PREFETCH(t0_) do { const int tb_ = (t0_) + 8 * pw_; \
            _Pragma("unroll") for (int i = 0; i < 9; ++i) { const int t_ = tb_ + i - 1; \
                if (t_ >= 0) { const bf16_t* row_ = a.proj_ + (size_t)(b * SEQ + t_) * PROJ_BLD + h * 64 + lane; pr[i] = row_[OFF_R]; pk[i] = row_[OFF_K]; pv[i] = row_[OFF_V]; } \
                else { pr[i] = 0u; pk[i] = 0u; pv[i] = 0u; } } \
            _Pragma("unroll") for (int i = 0; i < 8; ++i) { const size_t o_ = (size_t)(b * SEQ + tb_ + i) * 1024 + c; pw[i] = lw_w[o_]; pa[i] = lw_a[o_]; \
                if (a.layer) { pvp[i] = lw_v[o_]; pvf[i] = a.vf_[o_]; } else { pvp[i] = 0u; pvf[i] = 0.f; } } } while (0)
#define RW_PREP(ch_) do { const int t0_ = (ch_) * RW_TB; LAS unsigned char* buf_ = lds + ((ch_) & 1) * RWB_BIG; LAS unsigned char* sm_ = lds + RW_SMALL + ((ch_) % 3) * RWS_SIZE; \
            _Pragma("unroll") for (int i = 0; i < 8; ++i) { \
                const int tau = 8 * pw_ + i; \
                const float rc = __uint_as_float(pr[i + 1] << 16), rp = __uint_as_float(pr[i] << 16), kc = __uint_as_float(pk[i + 1] << 16), kp = __uint_as_float(pk[i] << 16), vc = __uint_as_float(pv[i + 1] << 16), vp = __uint_as_float(pv[i] << 16); \
                const float r = rc + (rp - rc) * mix_r, kraw = kc + (kp - kc) * mix_k, vraw = vc + (vp - vc) * mix_v; \
                const float sg = fast_sigmoid(w0c + __uint_as_float(pw[i] << 16)); \
                const float dec = __builtin_amdgcn_exp2f(-1.4426950408889634f * 0.6065306597126334f * sg);     \
                const float as = fast_sigmoid(a0c + __uint_as_float(pa[i] << 16)); \
                float v = vraw; \
                if (a.layer) v = vraw + (pvf[i] - vraw) * fast_sigmoid(v0c + __uint_as_float(pvp[i] << 16)); \
                const float kkv = kraw * kkc; \
                const float km = kraw * (1.f + (as - 1.f) * kac); \
                const float z = reduce4(kkv * kkv, r * km * rkc, kkv * as * r, km * r);     \
                const float nrm2 = rdlane(z, 0), rks = rdlane(z, 16), bru = rdlane(z, 32), kr = rdlane(z, 48); \
                const float inv = __builtin_amdgcn_rsqf(fmaxf(nrm2, 1e-24f));     \
                const float kkn = kkv * inv; \
                *(LAS float*)(buf_ + RWB_A + tau * 256 + woff) = -kkn; *(LAS float*)(buf_ + RWB_DR + tau * 256 + woff) = dec * r; *(LAS float*)(buf_ + RWB_D + tau * 256 + woff) = dec; \
                *(LAS float*)(buf_ + RWB_B + tau * 256 + woff) = kkn * as; *(LAS float*)(buf_ + RWB_K + tau * 256 + woff) = km; \
                if ((lane >> 5) == half) { ((LAS float*)(sm_ + RWS_V))[tau * 32 + (lane & 31)] = v; \
                    if (a.layer == 0) a.vf_[(size_t)(b * SEQ + t0_ + tau) * 1024 + c] = vraw; } \
                if (lane == 0) { ((LAS float*)(sm_ + RWS_SC))[tau] = bru * inv; ((LAS float*)(sm_ + RWS_SC))[32 + tau] = kr; ((LAS float*)(sm_ + RWS_SC))[64 + tau] = rks; } \
            } } while (0)
#define RW_FLUSH(ch_) do { const int t0_ = (ch_) * RW_TB; const LAS unsigned char* sm_ = lds + RW_SMALL + ((ch_) % 3) * RWS_SIZE; const LAS float* yst_ = (const LAS float*)(lds + RW_YST + ((ch_) & 1) * RW_YST_SIZE); \
            _Pragma("unroll") for (int q = 0; q < 2; ++q) { const int idx = ptid + 256 * q, tau = idx >> 4, i = (idx & 15) * 2;     \
                const float y0 = yst_[(((tau >> 3) * 4 + (i >> 3)) * 64) + (i & 7) * 8 + (tau & 7)], y1 = yst_[(((tau >> 3) * 4 + (i >> 3)) * 64) + ((i & 7) + 1) * 8 + (tau & 7)]; \
                const float rk_ = ((const LAS float*)(sm_ + RWS_SC))[64 + tau]; const f32x2 v2_ = *(const LAS f32x2*)((const LAS float*)(sm_ + RWS_V) + tau * 32 + i); \
                const size_t o = (size_t)(b * SEQ + t0_ + tau) * 1024 + h * 64 + half * 32 + i; \
                *(unsigned*)(a.y_ + o) = cvt_pk_bf16(y0, y1); *(unsigned*)(a.bon_ + o) = cvt_pk_bf16(rk_ * v2_.x, rk_ * v2_.y); } } while (0)
            const int cv_total = a.cmoe ? NE * 3 * 2816 : 3 * 5632, cv_stride = G * 4;
            int cv_it = vcu * 4 + pw_; float cvv[32]; bool cv_pend = false;
#define CV_DECODE(it_) const int e_ = a.cmoe ? (it_) / 8448 : 0, rr_ = a.cmoe ? (it_) % 8448 : (it_), per_ = a.cmoe ? 2816 : 5632, j_ = rr_ / per_, r_ = rr_ % per_, dfe_ = a.cmoe ? DFE : DFF; \
            const int K_ = (j_ == 2) ? dfe_ : D, N_ = (j_ == 2) ? D : dfe_, nnb_ = N_ / 32, k0_ = (r_ / nnb_) * 64, n0_ = (r_ % nnb_) * 32; \
            const float* W_ = (j_ == 0 ? a.cw1 : (j_ == 1 ? a.cw3 : a.cw2)) + (size_t)e_ * D * dfe_;
#define CV_LOAD() do { if (cv_it < cv_total) { CV_DECODE(cv_it) \
                const float* src_ = W_ + (size_t)(k0_ + 32 * (lane >> 5)) * N_ + n0_ + (lane & 31);     \
                _Pragma("unroll") for (int i = 0; i < 32; ++i) cvv[i] = src_[(size_t)i * N_]; cv_pend = true; } } while (0)
#define CV_STORE() do { if (cv_pend) { CV_DECODE(cv_it) (void)W_; \
                const int drow_ = (j_ == 2) ? (a.cmoe ? e_ * D + n0_ : n0_) : (a.cmoe ? e_ * 2 * DFE : 0) + 256 * (n0_ / 128) + j_ * 128 + (n0_ % 128); \
                bf16_t* WT_ = a.cwt + ((j_ == 2) ? (size_t)(a.cmoe ? NE * 2 * DFE : 2 * DFF) * D : (size_t)0) + (size_t)(drow_ + (lane & 31)) * K_ + k0_ + 32 * (lane >> 5); \
                _Pragma("unroll") for (int q = 0; q < 4; ++q) { u32x4 o; o.x = cvt_pk_bf16(cvv[8 * q], cvv[8 * q + 1]); o.y = cvt_pk_bf16(cvv[8 * q + 2], cvv[8 * q + 3]); o.z = cvt_pk_bf16(cvv[8 * q + 4], cvv[8 * q + 5]); o.w = cvt_pk_bf16(cvv[8 * q + 6], cvv[8 * q + 7]); \
                    *(u32x4*)(WT_ + 8 * q) = o; } \
                cv_pend = false; cv_it += cv_stride; } } while (0)
            RW_PREFETCH(0);
            RW_PREP(0);
            RW_PREFETCH(RW_TB);
            CV_LOAD();
            __syncthreads();
            for (int ch = 0; ch < RW_NCH; ++ch) {
                if (ch > 0) RW_FLUSH(ch - 1);
                if (ch + 1 < RW_NCH) { RW_PREP(ch + 1);
#if (MK_DBL >> 12) & 1
                    RW_PREP(ch + 1);
#endif
                    if (ch + 2 < RW_NCH) RW_PREFETCH((ch + 2) * RW_TB); }
                CV_STORE(); CV_LOAD();
                __syncthreads();
            }
            RW_FLUSH(RW_NCH - 1);
            while (cv_pend) { CV_STORE(); CV_LOAD(); }
#undef CV_DECODE
#undef CV_LOAD
#undef CV_STORE
#undef RW_PREFETCH
#undef RW_PREP
#undef RW_FLUSH
        } else {
            const int jl = lane & 7, rr = lane >> 3;
            __builtin_amdgcn_s_setprio(3);
            f32x2 S01 = (f32x2){0.f, 0.f}, S23 = S01, S45 = S01, S67 = S01;
#define DPP_Q(z, ctrl) __uint_as_float(__builtin_amdgcn_update_dpp(0u, __float_as_uint(z), (ctrl), 0xf, 0xf, false))
#define SUM8(z) do { z += DPP_Q(z, 0xB1); asm("" : "+v"(z)); z += DPP_Q(z, 0x4E); asm("" : "+v"(z)); z += DPP_Q(z, 0x141); asm("" : "+v"(z)); } while (0)
            __syncthreads();
            for (int ch = 0; ch < RW_NCH; ++ch) {
                const LAS unsigned char* buf = lds + (ch & 1) * RWB_BIG; const LAS unsigned char* sm = lds + RW_SMALL + (ch % 3) * RWS_SIZE;
                const LAS unsigned char* ob = buf + jl * 32;
                const LAS float* Vb = (const LAS float*)(sm + RWS_V) + 8 * wave + rr; const LAS float* SC = (const LAS float*)(sm + RWS_SC);
                LAS float* Yst = (LAS float*)(lds + RW_YST + (ch & 1) * RW_YST_SIZE);
#define LD8(dst0, dst1, off) do { dst0 = *(const LAS f32x4*)(ob + (off)); dst1 = *(const LAS f32x4*)(ob + (off) + 16); } while (0)
                f32x4 a0, a1, q0, q1, d0, d1, b0, b1, k0, k1, na0, na1, nq0, nq1, nd0, nd1, nb0, nb1, nk0, nk1;
                LD8(a0, a1, RWB_A); LD8(q0, q1, RWB_DR); LD8(d0, d1, RWB_D); LD8(b0, b1, RWB_B); LD8(k0, k1, RWB_K);
                float vi = Vb[0], br = SC[0], kr = SC[32];
                LD8(na0, na1, RWB_A + 256); LD8(nq0, nq1, RWB_DR + 256); LD8(nd0, nd1, RWB_D + 256); LD8(nb0, nb1, RWB_B + 256); LD8(nk0, nk1, RWB_K + 256);
                float nvi = Vb[32], nbr = SC[1], nkr = SC[33];
#pragma unroll
                for (int blk = 0; blk < 4; ++blk) {
                    float yacc = 0.f;
#pragma unroll
                    for (int s = 0; s < 8; ++s) {
                        const int tn = blk * 8 + s + 2;
                        f32x4 ma0, ma1, mq0, mq1, md0, md1, mb0, mb1, mk0, mk1;
                        LD8(ma0, ma1, RWB_A + tn * 256); LD8(mq0, mq1, RWB_DR + tn * 256); LD8(md0, md1, RWB_D + tn * 256); LD8(mb0, mb1, RWB_B + tn * 256); LD8(mk0, mk1, RWB_K + tn * 256);
                        const float mvi = Vb[(tn & 31) * 32], mbr = SC[tn & 31], mkr = SC[32 + (tn & 31)];
                        const f32x2 pa2 = (S01 * (f32x2){a0[0], a0[1]} + S23 * (f32x2){a0[2], a0[3]}) + (S45 * (f32x2){a1[0], a1[1]} + S67 * (f32x2){a1[2], a1[3]});
                        const f32x2 pq2 = (S01 * (f32x2){q0[0], q0[1]} + S23 * (f32x2){q0[2], q0[3]}) + (S45 * (f32x2){q1[0], q1[1]} + S67 * (f32x2){q1[2], q1[3]});
                        float sa = pa2.x + pa2.y, zq = pq2.x + pq2.y;
                        SUM8(sa); SUM8(zq);
                        S01 = (S01 * (f32x2){d0[0], d0[1]} + vi * (f32x2){k0[0], k0[1]}) + sa * (f32x2){b0[0], b0[1]};
                        S23 = (S23 * (f32x2){d0[2], d0[3]} + vi * (f32x2){k0[2], k0[3]}) + sa * (f32x2){b0[2], b0[3]};
                        S45 = (S45 * (f32x2){d1[0], d1[1]} + vi * (f32x2){k1[0], k1[1]}) + sa * (f32x2){b1[0], b1[1]};
                        S67 = (S67 * (f32x2){d1[2], d1[3]} + vi * (f32x2){k1[2], k1[3]}) + sa * (f32x2){b1[2], b1[3]};
                        const float y = zq + sa * br + vi * kr;
                        yacc = (jl == s) ? y : yacc;
                        a0 = na0; a1 = na1; q0 = nq0; q1 = nq1; d0 = nd0; d1 = nd1; b0 = nb0; b1 = nb1; k0 = nk0; k1 = nk1; vi = nvi; br = nbr; kr = nkr;
                        na0 = ma0; na1 = ma1; nq0 = mq0; nq1 = mq1; nd0 = md0; nd1 = md1; nb0 = mb0; nb1 = mb1; nk0 = mk0; nk1 = mk1; nvi = mvi; nbr = mbr; nkr = mkr;
                    }
                    Yst[(blk * 4 + wave) * 64 + lane] = yacc;
                }
#undef LD8
                __syncthreads();
            }
#undef SUM8
#undef DPP_Q
            __builtin_amdgcn_s_setprio(0);
        }
        __syncthreads();
    }
}

constexpr int RP = 68, VP = 34;
constexpr int CK_RA = 0, CK_RB = 8704, CK_RK = 17408, CK_RR = 26112, CK_LD = 34816, CK_RV = 43520, CK_RRK = 47872, CK_CUM = 48000, CK_PL = 56976, CK_NAB = 57232,
              CK_AT = 61840, CK_RT = 66448, CK_BH = 71056, CK_KH = 75664, CK_S0 = 80272, CK_NAK = 84880, CK_MBR = 87440, CK_MKR = 90000, CK_TT = 92560, CK_VI = 95120, CK_WI = 97680, CK_UI = 100240,
              CK_BC = 102800, CK_KC = 107920, CK_CUM2 = 113040, CK_END = 122016;
constexpr int P64 = 72, P32 = 40;
static_assert(CK_END <= MISC_OFF, "chunked rwkv LDS map");
__device__ __forceinline__ bf16x8 ldfrag(const LAS bf16_t* img, int pitch, int row, int k0) { return *(const LAS bf16x8*)(img + row * pitch + k0); }
__device__ __forceinline__ void rwkv_chunk_phase(LAS unsigned char* lds, const RwScan& a, const int vcu, const int G, const int tid0_) {
    const int tid = tid0_, wave = __builtin_amdgcn_readfirstlane(tid >> 6), lane = tid & 63;
    LAS float* RA = (LAS float*)(lds + CK_RA); LAS float* RB = (LAS float*)(lds + CK_RB); LAS float* RKm = (LAS float*)(lds + CK_RK); LAS float* RR = (LAS float*)(lds + CK_RR);
    LAS float* RLD = (LAS float*)(lds + CK_LD); LAS float* RV = (LAS float*)(lds + CK_RV); LAS float* RRK = (LAS float*)(lds + CK_RRK); LAS float* CUM = (LAS float*)(lds + CK_CUM);
    LAS float* PL = (LAS float*)(lds + CK_PL); LAS float* NabT = (LAS float*)(lds + CK_NAB); LAS float* CUMB = (LAS float*)(lds + CK_CUM2);
#define CK_CUMSUM(buf_) do { LAS float* cu_ = (buf_) ? CUMB : CUM; float ldv[32]; \
        _Pragma("unroll") for (int t = 0; t < 32; ++t) ldv[t] = RLD[t * RP + lane]; \
        float cs = 0.f; cu_[lane] = 0.f; \
        _Pragma("unroll") for (int t = 0; t < 32; ++t) { cs += ldv[t]; cu_[(t + 1) * RP + lane] = cs; } } while (0)
    LAS bf16_t* AT = (LAS bf16_t*)(lds + CK_AT); LAS bf16_t* RT = (LAS bf16_t*)(lds + CK_RT); LAS bf16_t* BH = (LAS bf16_t*)(lds + CK_BH); LAS bf16_t* KH = (LAS bf16_t*)(lds + CK_KH); LAS bf16_t* S0 = (LAS bf16_t*)(lds + CK_S0);
    LAS bf16_t* NakT = (LAS bf16_t*)(lds + CK_NAK); LAS bf16_t* MbrT = (LAS bf16_t*)(lds + CK_MBR); LAS bf16_t* MkrT = (LAS bf16_t*)(lds + CK_MKR); LAS bf16_t* TT = (LAS bf16_t*)(lds + CK_TT);
    LAS bf16_t* Vi = (LAS bf16_t*)(lds + CK_VI); LAS bf16_t* Wi = (LAS bf16_t*)(lds + CK_WI); LAS bf16_t* Ui = (LAS bf16_t*)(lds + CK_UI); LAS bf16_t* BcT = (LAS bf16_t*)(lds + CK_BC); LAS bf16_t* KcT = (LAS bf16_t*)(lds + CK_KC);
    for (int u = vcu; u < BATCH * RW_H * 2; u += G) {
        const int b = u >> 5, h = (u >> 1) & 15, half = u & 1, c = h * 64 + lane;
        const float mix_r = a.mix[c], mix_k = a.mix[1024 + c], mix_v = a.mix[2048 + c];
        const float w0c = a.w0[c], a0c = a.a0[c], v0c = a.layer ? a.v0[c] : 0.f, kkc = a.k_k[c], kac = a.k_a[c], rkc = a.r_k[c];
        const bf16_t* lw_w = a.lw_; const bf16_t* lw_a = a.lw_ + (size_t)M * 1024; const bf16_t* lw_v = a.lw_ + (size_t)3 * M * 1024;
        const int ptok0 = (wave < 4) ? 4 * (wave - 1) : 12 + 5 * (wave - 4), pntok = (wave == 0) ? 0 : ((wave < 4) ? 4 : 5);
        unsigned pr[6], pk[6], pv[6], pw[5], pa[5], pvp[5]; float pvf[5];
#define CK_PREFETCH(t0_) do { if (pntok) { const int tb_ = (t0_) + ptok0; \
        _Pragma("unroll") for (int i = 0; i < 6; ++i) { const int t_ = tb_ + i - 1; \
            if (t_ >= 0 && i <= pntok) { const bf16_t* row_ = a.proj_ + (size_t)(b * SEQ + t_) * PROJ_BLD + h * 64 + lane; pr[i] = row_[OFF_R]; pk[i] = row_[OFF_K]; pv[i] = row_[OFF_V]; } \
            else { pr[i] = 0u; pk[i] = 0u; pv[i] = 0u; } } \
        _Pragma("unroll") for (int i = 0; i < 5; ++i) { if (i < pntok) { const size_t o_ = (size_t)(b * SEQ + tb_ + i) * 1024 + c; pw[i] = lw_w[o_]; pa[i] = lw_a[o_]; \
            if (a.layer) { pvp[i] = lw_v[o_]; pvf[i] = a.vf_[o_]; } else { pvp[i] = 0u; pvf[i] = 0.f; } } else { pw[i] = 0u; pa[i] = 0u; pvp[i] = 0u; pvf[i] = 0.f; } } } } while (0)
#define CK_PREP(t0_) do { \
            _Pragma("unroll") for (int i = 0; i < 5; ++i) if (i < pntok) { \
                const int tau = ptok0 + i; \
                const float rc = __uint_as_float(pr[i + 1] << 16), rp = __uint_as_float(pr[i] << 16), kc = __uint_as_float(pk[i + 1] << 16), kp = __uint_as_float(pk[i] << 16), vc = __uint_as_float(pv[i + 1] << 16), vp = __uint_as_float(pv[i] << 16); \
                const float r = rc + (rp - rc) * mix_r, kraw = kc + (kp - kc) * mix_k, vraw = vc + (vp - vc) * mix_v; \
                const float sg = fast_sigmoid(w0c + __uint_as_float(pw[i] << 16)); \
                const float ld = -1.4426950408889634f * 0.6065306597126334f * sg;       \
                const float as = fast_sigmoid(a0c + __uint_as_float(pa[i] << 16)); \
                float v = vraw; \
                if (a.layer) v = vraw + (pvf[i] - vraw) * fast_sigmoid(v0c + __uint_as_float(pvp[i] << 16)); \
                const float kkv = kraw * kkc; \
                const float km = kraw * (1.f + (as - 1.f) * kac); \
                const float z = reduce4(kkv * kkv, r * km * rkc, 0.f, 0.f); \
                const float nrm2 = rdlane(z, 0), rks = rdlane(z, 16); \
                const float kkn = kkv * __builtin_amdgcn_rsqf(fmaxf(nrm2, 1e-24f)); \
                RA[tau * RP + lane] = -kkn; RB[tau * RP + lane] = kkn * as; RKm[tau * RP + lane] = km; RR[tau * RP + lane] = r; RLD[tau * RP + lane] = ld; \
                if ((lane >> 5) == half) { RV[tau * VP + (lane & 31)] = v; \
                    if (a.layer == 0) a.vf_[(size_t)(b * SEQ + (t0_) + tau) * 1024 + c] = vraw; } \
                if (lane == 0) RRK[tau] = rks; \
            } } while (0)
        const int cv_total = a.cmoe ? NE * 3 * 2816 : 3 * 5632, cv_stride = G * 4;
        int cv_it = vcu * 4 + (wave & 3); bool cv_pend = false;
#define CV_DECODE(it_) const int e_ = a.cmoe ? (it_) / 8448 : 0, rr_ = a.cmoe ? (it_) % 8448 : (it_), per_ = a.cmoe ? 2816 : 5632, j_ = rr_ / per_, r_ = rr_ % per_, dfe_ = a.cmoe ? DFE : DFF; \
        const int K_ = (j_ == 2) ? dfe_ : D, N_ = (j_ == 2) ? D : dfe_, nnb_ = N_ / 32, k0_ = (r_ / nnb_) * 64, n0_ = (r_ % nnb_) * 32; \
        const float* W_ = (j_ == 0 ? a.cw1 : (j_ == 1 ? a.cw3 : a.cw2)) + (size_t)e_ * D * dfe_;
#define CV_LOAD() do { if (cv_it < cv_total) { CV_DECODE(cv_it) \
            const float* src_ = W_ + (size_t)(k0_ + 32 * (lane >> 5)) * N_ + n0_ + (lane & 31); \
            _Pragma("unroll") for (int i = 0; i < 32; ++i) cvv[i] = src_[(size_t)i * N_]; cv_pend = true; } } while (0)
#define CV_STORE() do { if (cv_pend) { CV_DECODE(cv_it) (void)W_; \
            const int drow_ = (j_ == 2) ? (a.cmoe ? e_ * D + n0_ : n0_) : (a.cmoe ? e_ * 2 * DFE : 0) + 256 * (n0_ / 128) + j_ * 128 + (n0_ % 128); \
            bf16_t* WT_ = a.cwt + ((j_ == 2) ? (size_t)(a.cmoe ? NE * 2 * DFE : 2 * DFF) * D : (size_t)0) + (size_t)(drow_ + (lane & 31)) * K_ + k0_ + 32 * (lane >> 5); \
            _Pragma("unroll") for (int q = 0; q < 4; ++q) { u32x4 o; o.x = cvt_pk_bf16(cvv[8 * q], cvv[8 * q + 1]); o.y = cvt_pk_bf16(cvv[8 * q + 2], cvv[8 * q + 3]); o.z = cvt_pk_bf16(cvv[8 * q + 4], cvv[8 * q + 5]); o.w = cvt_pk_bf16(cvv[8 * q + 6], cvv[8 * q + 7]); \
                *(u32x4*)(WT_ + 8 * q) = o; } \
            cv_pend = false; cv_it += cv_stride; } } while (0)
        f32x4 Sacc = ZERO4();
        for (int i = tid; i < 32 * P64 / 2; i += 512) ((LAS unsigned*)S0)[i] = 0u;
        CK_PREFETCH(0);
        CK_PREP(0);
        CK_PREFETCH(32);
        __syncthreads();
        if (wave == 4) CK_CUMSUM(0);
        __syncthreads();
        for (int ch = 0; ch < SEQ / 32; ++ch) {
            const int t0 = ch * 32;
            int tid_c = tid0_; asm volatile("" : "+v"(tid_c));
            const int tid = tid_c, lane = tid & 63, fr = lane & 15, fq = lane >> 4;
            const LAS float* CUMc = (ch & 1) ? CUMB : CUM;
            {
                const int t = tid & 31, j0 = 4 * (tid >> 5);
                const f32x4 ct = *(const LAS f32x4*)(CUMc + (t + 1) * RP + j0), cp = *(const LAS f32x4*)(CUMc + t * RP + j0), cL = *(const LAS f32x4*)(CUMc + 32 * RP + j0);
                const f32x4 ra = *(const LAS f32x4*)(RA + t * RP + j0), rb = *(const LAS f32x4*)(RB + t * RP + j0), rk = *(const LAS f32x4*)(RKm + t * RP + j0), rr = *(const LAS f32x4*)(RR + t * RP + j0);
                float at[4], rt[4], bh[4], kh[4], bc[4], kc_[4];
#pragma unroll
                for (int e = 0; e < 4; ++e) { const float ea = __builtin_amdgcn_exp2f(cp[e]), er = __builtin_amdgcn_exp2f(ct[e]), ei = __builtin_amdgcn_exp2f(-ct[e]), ec = __builtin_amdgcn_exp2f(cL[e] - ct[e]);
                    at[e] = ra[e] * ea; rt[e] = rr[e] * er; bh[e] = rb[e] * ei; kh[e] = rk[e] * ei; bc[e] = rb[e] * ec; kc_[e] = rk[e] * ec; }
                { u32x2 w; w.x = cvt_pk_bf16(at[0], at[1]); w.y = cvt_pk_bf16(at[2], at[3]); *(LAS u32x2*)(AT + t * P64 + j0) = w; }
                { u32x2 w; w.x = cvt_pk_bf16(rt[0], rt[1]); w.y = cvt_pk_bf16(rt[2], rt[3]); *(LAS u32x2*)(RT + t * P64 + j0) = w; }
                { u32x2 w; w.x = cvt_pk_bf16(bh[0], bh[1]); w.y = cvt_pk_bf16(bh[2], bh[3]); *(LAS u32x2*)(BH + t * P64 + j0) = w; }
                { u32x2 w; w.x = cvt_pk_bf16(kh[0], kh[1]); w.y = cvt_pk_bf16(kh[2], kh[3]); *(LAS u32x2*)(KH + t * P64 + j0) = w; }
                { const unsigned w0 = cvt_pk_bf16(bc[0], bc[1]), w1 = cvt_pk_bf16(bc[2], bc[3]), x0 = cvt_pk_bf16(kc_[0], kc_[1]), x1 = cvt_pk_bf16(kc_[2], kc_[3]);
                  BcT[(j0 + 0) * P32 + t] = (bf16_t)(w0 & 0xffffu); BcT[(j0 + 1) * P32 + t] = (bf16_t)(w0 >> 16); BcT[(j0 + 2) * P32 + t] = (bf16_t)(w1 & 0xffffu); BcT[(j0 + 3) * P32 + t] = (bf16_t)(w1 >> 16);
                  KcT[(j0 + 0) * P32 + t] = (bf16_t)(x0 & 0xffffu); KcT[(j0 + 1) * P32 + t] = (bf16_t)(x0 >> 16); KcT[(j0 + 2) * P32 + t] = (bf16_t)(x1 & 0xffffu); KcT[(j0 + 3) * P32 + t] = (bf16_t)(x1 >> 16); }
                if (t == 31) { f32x4 pl; pl[0] = __builtin_amdgcn_exp2f(cL[0]); pl[1] = __builtin_amdgcn_exp2f(cL[1]); pl[2] = __builtin_amdgcn_exp2f(cL[2]); pl[3] = __builtin_amdgcn_exp2f(cL[3]); *(LAS f32x4*)(PL + j0) = pl; }
                { const int i0 = 2 * (tid >> 5); const f32x2 vv = *(const LAS f32x2*)(RV + t * VP + i0); const unsigned w = cvt_pk_bf16(vv.x, vv.y);
                  Vi[i0 * P32 + t] = (bf16_t)(w & 0xffffu); Vi[(i0 + 1) * P32 + t] = (bf16_t)(w >> 16); }
                { const int tb = tid >> 4, ib = 2 * (tid & 15); const float rk_ = RRK[tb]; const f32x2 vb = *(const LAS f32x2*)(RV + tb * VP + ib);
                  *(unsigned*)(a.bon_ + (size_t)(b * SEQ + t0 + tb) * 1024 + h * 64 + half * 32 + ib) = cvt_pk_bf16(rk_ * vb.x, rk_ * vb.y); }
            }
            __syncthreads();
#pragma unroll
            for (int q = 0; q < 2; ++q) {
                const int id = 2 * wave + q, mat = id >> 2, mt = (id >> 1) & 1, nt = id & 1;
                const LAS bf16_t* Ai = (mat & 1) ? KH : BH; const LAS bf16_t* Bi = (mat & 2) ? RT : AT;
                f32x4 g = ZERO4();
#pragma unroll
                for (int ks = 0; ks < 2; ++ks) g = __builtin_amdgcn_mfma_f32_16x16x32_bf16(ldfrag(Ai, P64, 16 * mt + fr, 32 * ks + 8 * fq), ldfrag(Bi, P64, 16 * nt + fr, 32 * ks + 8 * fq), g, 0, 0, 0);
                const int t = 16 * nt + fr, s0 = 16 * mt + 4 * fq;
#pragma unroll
                for (int r = 0; r < 4; ++r) { const int s = s0 + r; const bool keep = (mat < 2) ? (s < t) : (s <= t); g[r] = keep ? g[r] : 0.f; }
                if (mat == 0) *(LAS f32x4*)(NabT + t * 36 + s0) = g;
                else { LAS bf16_t* Xo = (mat == 1) ? NakT : ((mat == 2) ? MbrT : MkrT); u32x2 w; w.x = cvt_pk_bf16(g[0], g[1]); w.y = cvt_pk_bf16(g[2], g[3]); *(LAS u32x2*)(Xo + t * P32 + s0) = w; }
            }
            __syncthreads();
            if (wave == 0) {
                int ln = lane; asm volatile("" : "+v"(ln));
                float Tr[32];
                f32x4 rowb[2][8];
#pragma unroll
                for (int t = 0; t < 32; ++t) {
                    if (t + 1 < 32) {
#pragma unroll
                        for (int q = 0; q < 8; ++q) if (4 * q < t + 1) rowb[(t + 1) & 1][q] = *(const LAS f32x4*)(NabT + (t + 1) * 36 + 4 * q);
                    }
                    float acc4[4] = {(ln == t) ? 1.f : 0.f, 0.f, 0.f, 0.f};
#pragma unroll
                    for (int q = 0; q < 8; ++q)
#pragma unroll
                        for (int e = 0; e < 4; ++e) if (4 * q + e < t) acc4[e] += Tr[4 * q + e] * rowb[t & 1][q][e];
                    const float acc = (acc4[0] + acc4[1]) + (acc4[2] + acc4[3]);
                    Tr[t] = acc;
                    if (ln < 32) TT[t * P32 + ln] = (bf16_t)(cvt_pk_bf16(acc, 0.f) & 0xffffu);
                }
            } else {
                if (wave >= 4) {
                    const int mt = (wave - 4) >> 1, nt = (wave - 4) & 1;
                    f32x4 w = ZERO4();
#pragma unroll
                    for (int ks = 0; ks < 2; ++ks) w = __builtin_amdgcn_mfma_f32_16x16x32_bf16(ldfrag(AT, P64, 16 * mt + fr, 32 * ks + 8 * fq), ldfrag(S0, P64, 16 * nt + fr, 32 * ks + 8 * fq), w, 0, 0, 0);
                    w = __builtin_amdgcn_mfma_f32_16x16x32_bf16(ldfrag(NakT, P32, 16 * mt + fr, 8 * fq), ldfrag(Vi, P32, 16 * nt + fr, 8 * fq), w, 0, 0, 0);
                    u32x2 o; o.x = cvt_pk_bf16(w[0], w[1]); o.y = cvt_pk_bf16(w[2], w[3]); *(LAS u32x2*)(Wi + (16 * nt + fr) * P32 + 16 * mt + 4 * fq) = o;
                }
                if (ch + 1 < SEQ / 32) { CK_PREP(t0 + 32); if (ch + 2 < SEQ / 32) CK_PREFETCH(t0 + 64); }
            }
            __syncthreads();
            float cvv[32];
            if (wave >= 4) CV_LOAD();
            if (wave == 4 && ch + 1 < SEQ / 32) CK_CUMSUM((ch + 1) & 1);
            if (wave < 4) {
                const int mt = wave >> 1, nt = wave & 1;
                f32x4 uu = ZERO4();
                uu = __builtin_amdgcn_mfma_f32_16x16x32_bf16(ldfrag(TT, P32, 16 * mt + fr, 8 * fq), ldfrag(Wi, P32, 16 * nt + fr, 8 * fq), uu, 0, 0, 0);
                u32x2 o; o.x = cvt_pk_bf16(uu[0], uu[1]); o.y = cvt_pk_bf16(uu[2], uu[3]); *(LAS u32x2*)(Ui + (16 * nt + fr) * P32 + 16 * mt + 4 * fq) = o;
            }
            __syncthreads();
            if (wave >= 4) CV_STORE();
            if (wave < 4) {
                const int mt = wave >> 1, nt = wave & 1;
                f32x4 y = ZERO4();
#pragma unroll
                for (int ks = 0; ks < 2; ++ks) y = __builtin_amdgcn_mfma_f32_16x16x32_bf16(ldfrag(S0, P64, 16 * mt + fr, 32 * ks + 8 * fq), ldfrag(RT, P64, 16 * nt + fr, 32 * ks + 8 * fq), y, 0, 0, 0);
                y = __builtin_amdgcn_mfma_f32_16x16x32_bf16(ldfrag(Ui, P32, 16 * mt + fr, 8 * fq), ldfrag(MbrT, P32, 16 * nt + fr, 8 * fq), y, 0, 0, 0);
                y = __builtin_amdgcn_mfma_f32_16x16x32_bf16(ldfrag(Vi, P32, 16 * mt + fr, 8 * fq), ldfrag(MkrT, P32, 16 * nt + fr, 8 * fq), y, 0, 0, 0);
                u32x2 o; o.x = cvt_pk_bf16(y[0], y[1]); o.y = cvt_pk_bf16(y[2], y[3]);
                *(u32x2*)(a.y_ + (size_t)(b * SEQ + t0 + 16 * nt + fr) * 1024 + h * 64 + half * 32 + 16 * mt + 4 * fq) = o;
            }
            {
                const int mt = wave >> 1, nt = wave & 1;
                const f32x4 pl = *(const LAS f32x4*)(PL + 16 * mt + 4 * fq);
                Sacc = Sacc * pl;
                Sacc = __builtin_amdgcn_mfma_f32_16x16x32_bf16(ldfrag(BcT, P32, 16 * mt + fr, 8 * fq), ldfrag(Ui, P32, 16 * nt + fr, 8 * fq), Sacc, 0, 0, 0);
                Sacc = __builtin_amdgcn_mfma_f32_16x16x32_bf16(ldfrag(KcT, P32, 16 * mt + fr, 8 * fq), ldfrag(Vi, P32, 16 * nt + fr, 8 * fq), Sacc, 0, 0, 0);
            }
            __syncthreads();
            { const int mt = wave >> 1, nt = wave & 1; u32x2 o; o.x = cvt_pk_bf16(Sacc[0], Sacc[1]); o.y = cvt_pk_bf16(Sacc[2], Sacc[3]);
              *(LAS u32x2*)(S0 + (16 * nt + fr) * P64 + 16 * mt + 4 * fq) = o; }
        }
        if (wave >= 4) { float cvv[32]; CV_LOAD(); while (cv_pend) { CV_STORE(); CV_LOAD(); } }
#undef CK_PREFETCH
#undef CK_CUMSUM
#undef CK_PREP
#undef CV_DECODE
#undef CV_LOAD
#undef CV_STORE
        __syncthreads();
    }
}

constexpr int IMG_AT = 0, IMG_RT = 4096, IMG_BH = 8192, IMG_KH = 12288, IMG_VI = 16384, IMG_NAK = 20480, IMG_MBR = 22528, IMG_MKR = 24576, IMG_TT = 26624, IMG_PL = 28672, IMG_UNIT = 28928;
constexpr int PW_AT = 0, PW_RT = 4608, PW_BH = 9216, PW_KH = 13824, PW_NAB = PW_BH, PW_SIZE = 18432, PW_NW = 7;
static_assert(PW_NW * PW_SIZE <= MISC_OFF, "rwkv pre-phase LDS map");
static_assert((size_t)BATCH * RW_H * (SEQ / 32) * IMG_UNIT <= (size_t)299 * MiB, "rwkv chunk images fit between yssd and the FFN weights");
template <bool MOE> __device__ __forceinline__ void cv_decode(const int it, int& e, int& j, int& k0, int& n0) {
    constexpr int per = MOE ? 2816 : 5632, nnb = MOE ? 88 : 176;
    e = MOE ? it / 8448 : 0; const int rr = MOE ? it - e * 8448 : it; j = rr / per; const int r = rr - j * per;
    if (j == 2) { k0 = (r >> 6) * 64; n0 = (r & 63) * 32; } else { const int q = r / nnb; k0 = q * 64; n0 = (r - q * nnb) * 32; }
}
__device__ __forceinline__ void rwkv_pre_phase(LAS unsigned char* lds, const RwScan& a_, unsigned char* img, const int vcu, const int G, const int tid0_, const bool do_cv, const bool do_work) {
    const int wave = __builtin_amdgcn_readfirstlane(tid0_ >> 6);
    const bf16_t* const a_proj = a_.proj_; const bf16_t* const a_lw = a_.lw_; const float* const a_mix = a_.mix; const float* const a_w0 = a_.w0; const float* const a_a0 = a_.a0; const float* const a_v0 = a_.v0;
    const float* const a_kk = a_.k_k; const float* const a_ka = a_.k_a; const float* const a_rk = a_.r_k; float* const a_vf = a_.vf_; bf16_t* const a_bon = a_.bon_; const int a_layer = a_.layer;
    const float* const a_cw1 = a_.cw1; const float* const a_cw3 = a_.cw3; const float* const a_cw2 = a_.cw2; bf16_t* const a_cwt = a_.cwt; const int a_cmoe = a_.cmoe;
    if (wave >= PW_NW) {
        const int lane = tid0_ & 63;
        const int cv_total = a_cmoe ? MK_CV_CUT_MOE : MK_CV_CUT_DENSE, cv_stride = G * (NWAVES - PW_NW);
        int cv_it = do_cv ? vcu * (NWAVES - PW_NW) + (wave - PW_NW) : cv_total;
        float va[32], vb[32];
#define CV_DECODE(it_) int e_, j_, k0_, n0_; if (a_cmoe) cv_decode<true>((it_), e_, j_, k0_, n0_); else cv_decode<false>((it_), e_, j_, k0_, n0_); \
        const int dfe_ = a_cmoe ? DFE : DFF, K_ = (j_ == 2) ? dfe_ : D, N_ = (j_ == 2) ? D : dfe_; \
        const float* W_ = (j_ == 0 ? a_cw1 : (j_ == 1 ? a_cw3 : a_cw2)) + (size_t)e_ * D * dfe_;
#define CV_LD(buf_, it_) do { CV_DECODE(it_) \
            const float* src_ = W_ + (size_t)(k0_ + 32 * (lane >> 5)) * N_ + n0_ + (lane & 31); \
            _Pragma("unroll") for (int i = 0; i < 32; ++i) { buf_[i] = *src_; src_ += N_; asm volatile("" : "+v"(src_)); } } while (0)
#define CV_ST(buf_, it_) do { CV_DECODE(it_) (void)W_; \
            const int drow_ = (j_ == 2) ? (a_cmoe ? e_ * D + n0_ : n0_) : (a_cmoe ? e_ * 2 * DFE : 0) + 256 * (n0_ / 128) + j_ * 128 + (n0_ % 128); \
            bf16_t* WT_ = a_cwt + ((j_ == 2) ? (size_t)(a_cmoe ? NE * 2 * DFE : 2 * DFF) * D : (size_t)0) + (size_t)(drow_ + (lane & 31)) * K_ + k0_ + 32 * (lane >> 5); \
            _Pragma("unroll") for (int q = 0; q < 4; ++q) { u32x4 o; o.x = cvt_pk_bf16(buf_[8 * q], buf_[8 * q + 1]); o.y = cvt_pk_bf16(buf_[8 * q + 2], buf_[8 * q + 3]); o.z = cvt_pk_bf16(buf_[8 * q + 4], buf_[8 * q + 5]); o.w = cvt_pk_bf16(buf_[8 * q + 6], buf_[8 * q + 7]); \
                *(u32x4*)(WT_ + 8 * q) = o; } } while (0)
#ifndef MK_X_NOCV
        if (cv_it < cv_total) CV_LD(va, cv_it);
        while (cv_it < cv_total) {
            const int n1 = cv_it + cv_stride;
            if (n1 < cv_total) CV_LD(vb, n1);
            CV_ST(va, cv_it);
            if (n1 >= cv_total) break;
            const int n2 = n1 + cv_stride;
            if (n2 < cv_total) CV_LD(va, n2);
            CV_ST(vb, n1);
            cv_it = n2;
        }
#endif
#undef CV_DECODE
#undef CV_LD
#undef CV_ST
        return;
    }
    LAS unsigned char* my = lds + wave * PW_SIZE;
    LAS bf16_t* AT = (LAS bf16_t*)(my + PW_AT); LAS bf16_t* RT = (LAS bf16_t*)(my + PW_RT); LAS bf16_t* BH = (LAS bf16_t*)(my + PW_BH); LAS bf16_t* KH = (LAS bf16_t*)(my + PW_KH); LAS float* NabT = (LAS float*)(my + PW_NAB);
    const bf16_t* lw_w = a_lw; const bf16_t* lw_a = a_lw + (size_t)M * 1024; const bf16_t* lw_v = a_lw + (size_t)3 * M * 1024;
    const __amdgpu_buffer_rsrc_t rs_proj = __builtin_amdgcn_make_buffer_rsrc((void*)a_proj, 0, 0x7fffffff, 0x00020000), rs_lw = __builtin_amdgcn_make_buffer_rsrc((void*)a_lw, 0, 0x7fffffff, 0x00020000),
                                 rs_vf = __builtin_amdgcn_make_buffer_rsrc((void*)a_vf, 0, 0x7fffffff, 0x00020000), rs_bon = __builtin_amdgcn_make_buffer_rsrc((void*)a_bon, 0, 0x7fffffff, 0x00020000),
                                 rs_img = __builtin_amdgcn_make_buffer_rsrc((void*)img, 0, 0x7fffffff, 0x00020000);
    if (do_work) for (int u = vcu; u < M / 64; u += G) {
        const int b = u >> 5, tbase = (u & 31) * 64;
        for (int id = wave; id < 32; id += PW_NW) {
            int ln = tid0_ & 63; asm volatile("" : "+v"(ln));
            const int lane = ln, fr = lane & 15, fq = lane >> 4;
            const int h = id >> 1, t0 = tbase + 32 * (id & 1), c = h * 64 + lane;
            const float mix_r = a_mix[c], mix_k = a_mix[1024 + c], mix_v = a_mix[2048 + c];
            const float w0c = a_w0[c], a0c = a_a0[c], v0c = a_layer ? a_v0[c] : 0.f, kkc = a_kk[c], kac = a_ka[c], rkc = a_rk[c];
            unsigned char* ug = img + (size_t)((b * RW_H + h) * (SEQ / 32) + (t0 >> 5)) * IMG_UNIT;
            float cum = 0.f, er = 1.f;
            const bool hasv = a_layer != 0;
            unsigned prA[5], pkA[5], pvA[5], pwA[4], paA[4], pvpA[4], prB[5], pkB[5], pvB[5], pwB[4], paB[4], pvpB[4]; float pvfA[4], pvfB[4];
            const unsigned vo2 = (unsigned)lane * 2u, vo4 = (unsigned)lane * 4u, vo2d = (unsigned)(lane >> 1) * 4u; const bool odd_lane = (lane & 1) != 0;
            const unsigned so_proj = (unsigned)((b * SEQ + t0) * PROJ_BLD + h * 64) * 2u, so_tok = (unsigned)((b * SEQ + t0) * 1024 + h * 64);
            const unsigned so_img = (unsigned)((b * RW_H + h) * (SEQ / 32) + (t0 >> 5)) * (unsigned)IMG_UNIT + IMG_VI;
#define PRE_FETCH(tb_, X) do { \
            _Pragma("unroll") for (int i = 0; i < 4; ++i) { const unsigned t_ = (unsigned)((tb_) + i); \
                pr##X[i + 1] = __builtin_amdgcn_raw_buffer_load_b32(rs_proj, vo2d, so_proj + t_ * (PROJ_BLD * 2u) + OFF_R * 2u, 0); \
                pk##X[i + 1] = __builtin_amdgcn_raw_buffer_load_b32(rs_proj, vo2d, so_proj + t_ * (PROJ_BLD * 2u) + OFF_K * 2u, 0); \
                pv##X[i + 1] = __builtin_amdgcn_raw_buffer_load_b32(rs_proj, vo2d, so_proj + t_ * (PROJ_BLD * 2u) + OFF_V * 2u, 0); \
                pw##X[i] = __builtin_amdgcn_raw_buffer_load_b32(rs_lw, vo2d, (so_tok + t_ * 1024u) * 2u, 0); \
                pa##X[i] = __builtin_amdgcn_raw_buffer_load_b32(rs_lw, vo2d, (so_tok + t_ * 1024u) * 2u + (unsigned)M * 2048u, 0); \
                if (hasv) { pvp##X[i] = __builtin_amdgcn_raw_buffer_load_b32(rs_lw, vo2d, (so_tok + t_ * 1024u) * 2u + (unsigned)M * 6144u, 0); \
                            pvf##X[i] = __uint_as_float(__builtin_amdgcn_raw_buffer_load_b32(rs_vf, vo2d, (so_tok + t_ * 1024u) * 2u, 0)); }   \
                else { pvp##X[i] = 0u; pvf##X[i] = 0.f; } } } while (0)
#define BFSEL(x_) __uint_as_float(odd_lane ? ((x_) & 0xffff0000u) : ((x_) << 16))
#define PRE_TOK8(tb_, X) do { \
            _Pragma("unroll") for (int i = 0; i < 4; ++i) { const int tau = (tb_) + i; \
                const float rc = BFSEL(pr##X[i + 1]), rp = BFSEL(pr##X[i]), kc = BFSEL(pk##X[i + 1]), kp = BFSEL(pk##X[i]), \
                            vc = BFSEL(pv##X[i + 1]), vp = BFSEL(pv##X[i]); \
                const float r = rc + (rp - rc) * mix_r, kraw = kc + (kp - kc) * mix_k, vraw = vc + (vp - vc) * mix_v; \
                const float sg = fast_sigmoid(w0c + BFSEL(pw##X[i])); \
                const float ld = -1.4426950408889634f * 0.6065306597126334f * sg;       \
                const float as = fast_sigmoid(a0c + BFSEL(pa##X[i])); \
                float v = vraw; \
                if (hasv) v = vraw + (BFSEL(__float_as_uint(pvf##X[i])) - vraw) * fast_sigmoid(v0c + BFSEL(pvp##X[i])); \
                const float kkv = kraw * kkc; \
                const float km = kraw * (1.f + (as - 1.f) * kac); \
                const float z = reduce4(kkv * kkv, r * km * rkc, 0.f, 0.f); \
                const float nrm2 = rdlane(z, 0), rks = rdlane(z, 16); \
                const float kkn = kkv * __builtin_amdgcn_rsqf(fmaxf(nrm2, 1e-24f)); \
                const float er_prev = er;                                          \
                cum += ld; er = __builtin_amdgcn_exp2f(cum); \
                const float ei = __builtin_amdgcn_exp2f(-cum); \
                const float at = -kkn * er_prev, rt = r * er, bh = kkn * as * ei, kh = km * ei; \
                const unsigned w0 = cvt_pk_bf16(at, rt), w1 = cvt_pk_bf16(bh, kh), w2 = cvt_pk_bf16(v, rks * v); \
                AT[tau * P64 + lane] = (bf16_t)(w0 & 0xffffu); RT[tau * P64 + lane] = (bf16_t)(w0 >> 16); BH[tau * P64 + lane] = (bf16_t)(w1 & 0xffffu); KH[tau * P64 + lane] = (bf16_t)(w1 >> 16); \
                __builtin_amdgcn_raw_buffer_store_b16((unsigned short)(w2 & 0xffffu), rs_img, vo2, so_img + (unsigned)tau * 128u, 0);        \
                __builtin_amdgcn_raw_buffer_store_b16((unsigned short)(w2 >> 16), rs_bon, vo2, (so_tok + (unsigned)tau * 1024u) * 2u, 0); \
                if (!hasv) __builtin_amdgcn_raw_buffer_store_b16((unsigned short)(cvt_pk_bf16(vraw, 0.f) & 0xffffu), rs_vf, vo2, (so_tok + (unsigned)tau * 1024u) * 2u, 0); \
            } } while (0)
            PRE_FETCH(0, A);
            if (t0 > 0) { prA[0] = __builtin_amdgcn_raw_buffer_load_b32(rs_proj, vo2d, so_proj - PROJ_BLD * 2u + OFF_R * 2u, 0); pkA[0] = __builtin_amdgcn_raw_buffer_load_b32(rs_proj, vo2d, so_proj - PROJ_BLD * 2u + OFF_K * 2u, 0);
                          pvA[0] = __builtin_amdgcn_raw_buffer_load_b32(rs_proj, vo2d, so_proj - PROJ_BLD * 2u + OFF_V * 2u, 0); }
            else { prA[0] = 0u; pkA[0] = 0u; pvA[0] = 0u; }
            for (int gg = 0; gg < 4; ++gg) {
                PRE_FETCH(8 * gg + 4, B);
                prB[0] = prA[4]; pkB[0] = pkA[4]; pvB[0] = pvA[4];
                PRE_TOK8(8 * gg, A);
                if (gg < 3) PRE_FETCH(8 * gg + 8, A);
                prA[0] = prB[4]; pkA[0] = pkB[4]; pvA[0] = pvB[4];
                PRE_TOK8(8 * gg + 4, B);
            }
#undef PRE_FETCH
#undef PRE_TOK8
#undef BFSEL
            *(float*)(ug + IMG_PL + lane * 4) = er;
            asm volatile("s_waitcnt lgkmcnt(0)" ::: "memory");
#pragma unroll
            for (int arr = 1; arr < 3; ++arr) {
                const LAS bf16_t* X = (arr == 1) ? BH : KH;
                unsigned pkd[16];
#pragma unroll
                for (int k = 0; k < 16; ++k) pkd[k] = (unsigned)X[(2 * k) * P64 + lane] | ((unsigned)X[(2 * k + 1) * P64 + lane] << 16);
                unsigned char* dst = ug + ((arr == 1) ? IMG_BH : IMG_KH) + lane * 64;
#pragma unroll
                for (int q = 0; q < 4; ++q) *(u32x4*)(dst + q * 16) = (u32x4){pkd[4 * q], pkd[4 * q + 1], pkd[4 * q + 2], pkd[4 * q + 3]};
            }
            asm volatile("s_waitcnt lgkmcnt(0)" ::: "memory");
#ifndef MK_X_NOGRAM
            {
                bf16x8 fB[2][2], fK[2][2], fA[2][2], fR[2][2];
#pragma unroll
                for (int m = 0; m < 2; ++m)
#pragma unroll
                    for (int ks = 0; ks < 2; ++ks) { fB[m][ks] = ldfrag(BH, P64, 16 * m + fr, 32 * ks + 8 * fq); fK[m][ks] = ldfrag(KH, P64, 16 * m + fr, 32 * ks + 8 * fq);
                                                     fA[m][ks] = ldfrag(AT, P64, 16 * m + fr, 32 * ks + 8 * fq); fR[m][ks] = ldfrag(RT, P64, 16 * m + fr, 32 * ks + 8 * fq); }
                asm volatile("s_waitcnt lgkmcnt(0)" ::: "memory");
#pragma unroll
                for (int mat = 0; mat < 4; ++mat)
#pragma unroll
                    for (int mt = 0; mt < 2; ++mt)
#pragma unroll
                        for (int nt = 0; nt < 2; ++nt) {
                            f32x4 g = ZERO4();
                            if (!(mt == 1 && nt == 0)) {
#pragma unroll
                                for (int ks = 0; ks < 2; ++ks) g = __builtin_amdgcn_mfma_f32_16x16x32_bf16((mat & 1) ? fK[mt][ks] : fB[mt][ks], (mat & 2) ? fR[nt][ks] : fA[nt][ks], g, 0, 0, 0);
                            }
                            const int t = 16 * nt + fr, s0 = 16 * mt + 4 * fq;
                            if (mt == nt) {
#pragma unroll
                                for (int r = 0; r < 4; ++r) { const int s = s0 + r; const bool keep = (mat < 2) ? (s < t) : (s <= t); g[r] = keep ? g[r] : 0.f; }
                            }
                            if (mat == 0) *(LAS f32x4*)(NabT + t * 36 + s0) = g;
                            else { u32x2 w; w.x = cvt_pk_bf16(g[0], g[1]); w.y = cvt_pk_bf16(g[2], g[3]); *(u32x2*)(ug + IMG_NAK + (mat - 1) * 2048 + (t * 32 + s0) * 2) = w; }
                        }
            }
#endif
            asm volatile("s_waitcnt lgkmcnt(0)" ::: "memory");
#ifndef MK_X_NOSOLVE
            {
                float Tr[32];
                f32x4 rowb[2][8];
#pragma unroll
                for (int t = 0; t < 32; ++t) {
                    if (t + 1 < 32) {
#pragma unroll
                        for (int q = 0; q < 8; ++q) if (4 * q < t + 1) rowb[(t + 1) & 1][q] = *(const LAS f32x4*)(NabT + (t + 1) * 36 + 4 * q);
                    }
                    float acc4[4] = {(ln == t) ? 1.f : 0.f, 0.f, 0.f, 0.f};
#pragma unroll
                    for (int q = 0; q < 8; ++q)
#pragma unroll
                        for (int e = 0; e < 4; ++e) if (4 * q + e < t) acc4[e] += Tr[4 * q + e] * rowb[t & 1][q][e];
                    const float acc = (acc4[0] + acc4[1]) + (acc4[2] + acc4[3]);
                    Tr[t] = acc;
                    if (ln < 32) *(bf16_t*)(ug + IMG_TT + (t * 32 + ln) * 2) = (bf16_t)(cvt_pk_bf16(acc, 0.f) & 0xffffu);
                }
            }
#endif
            {
                const int row = lane >> 1, hf = lane & 1;
#pragma unroll
                for (int q = 0; q < 4; ++q) {
                    *(u32x4*)(ug + IMG_AT + row * 128 + hf * 64 + q * 16) = *(const LAS u32x4*)(AT + row * P64 + hf * 32 + 8 * q);
                    *(u32x4*)(ug + IMG_RT + row * 128 + hf * 64 + q * 16) = *(const LAS u32x4*)(RT + row * P64 + hf * 32 + 8 * q);
                }
            }
            asm volatile("s_waitcnt lgkmcnt(0)" ::: "memory");
        }
    }
}

constexpr int SK_AT = 0, SK_RT = 4608, SK_S0 = 9216, SK_NAK = 13824, SK_MBR = 16384, SK_MKR = 18944, SK_TT = 21504, SK_VI = 24064, SK_WI = 26624, SK_UI = 29184, SK_BH = 31744, SK_KH = 36864, SK_PL = 41984, SK_END = 42240, SK_BUF = SK_END;
static_assert(2 * SK_BUF <= MISC_OFF, "rwkv state phase LDS map");
__device__ __forceinline__ void rwkv_state_phase(LAS unsigned char* lds, const unsigned char* img, bf16_t* y_, const RwScan& a_, const int vcu, const int G, const int tid0_) {
    const int wave = __builtin_amdgcn_readfirstlane(tid0_ >> 6);
    const float* const a_cw1 = a_.cw1; const float* const a_cw3 = a_.cw3; const float* const a_cw2 = a_.cw2; bf16_t* const a_cwt = a_.cwt; const int a_cmoe = a_.cmoe;
    const int cv_total = a_cmoe ? NE * 3 * 2816 : 3 * 5632, cv_stride = G * 4, cv_cut = a_cmoe ? MK_CV_CUT_MOE : MK_CV_CUT_DENSE;
#define CV_DECODE(it_) int e_, j_, k0_, n0_; if (a_cmoe) cv_decode<true>((it_), e_, j_, k0_, n0_); else cv_decode<false>((it_), e_, j_, k0_, n0_); \
        const int dfe_ = a_cmoe ? DFE : DFF, K_ = (j_ == 2) ? dfe_ : D, N_ = (j_ == 2) ? D : dfe_; \
        const float* W_ = (j_ == 0 ? a_cw1 : (j_ == 1 ? a_cw3 : a_cw2)) + (size_t)e_ * D * dfe_;
#define CV_LOAD(cvv, cv_it, cv_pend) do { if (cv_it < cv_total) { CV_DECODE(cv_it) const int cl_ = tid0_ & 63; \
            const float* src_ = W_ + (size_t)(k0_ + 32 * (cl_ >> 5)) * N_ + n0_ + (cl_ & 31); \
            _Pragma("unroll") for (int i = 0; i < 32; ++i) cvv[i] = src_[(size_t)i * N_]; cv_pend = true; } } while (0)
#define CV_STORE(cvv, cv_it, cv_pend) do { if (cv_pend) { CV_DECODE(cv_it) (void)W_; const int cl_ = tid0_ & 63; \
            const int drow_ = (j_ == 2) ? (a_cmoe ? e_ * D + n0_ : n0_) : (a_cmoe ? e_ * 2 * DFE : 0) + 256 * (n0_ / 128) + j_ * 128 + (n0_ % 128); \
            bf16_t* WT_ = a_cwt + ((j_ == 2) ? (size_t)(a_cmoe ? NE * 2 * DFE : 2 * DFF) * D : (size_t)0) + (size_t)(drow_ + (cl_ & 31)) * K_ + k0_ + 32 * (cl_ >> 5); \
            _Pragma("unroll") for (int q = 0; q < 4; ++q) { u32x4 o; o.x = cvt_pk_bf16(cvv[8 * q], cvv[8 * q + 1]); o.y = cvt_pk_bf16(cvv[8 * q + 2], cvv[8 * q + 3]); o.z = cvt_pk_bf16(cvv[8 * q + 4], cvv[8 * q + 5]); o.w = cvt_pk_bf16(cvv[8 * q + 6], cvv[8 * q + 7]); \
                *(u32x4*)(WT_ + 8 * q) = o; } \
            cv_pend = false; cv_it += cv_stride; } } while (0)
    LAS bf16_t* Wi = (LAS bf16_t*)(lds + SK_WI); LAS bf16_t* Ui = (LAS bf16_t*)(lds + SK_UI);
    for (int u = vcu; u < BATCH * RW_H * 2; u += G) {
        const int b = u >> 5, h = (u >> 1) & 15, half = u & 1;
        const unsigned char* ub = img + (size_t)((b * RW_H + h) * (SEQ / 32)) * IMG_UNIT;
        f32x4 Sacc = ZERO4();
        u32x4 q0a, q0b, q1a, q1b, q2a, q2b, q3;
        int cv_itA = cv_cut + vcu * 4 + (wave & 3); bool cv_pendA = false; float cvA[32];
#pragma unroll
        for (int i = 0; i < 32; ++i) cvA[i] = 0.f;
#define ST_FETCH(ch_) do { if (wave < 4) { const unsigned char* ug_ = ub + (size_t)(ch_) * IMG_UNIT; const int tf_ = tid0_; \
            q0a = *(const u32x4*)(ug_ + IMG_AT + tf_ * 16); q0b = *(const u32x4*)(ug_ + IMG_RT + tf_ * 16); q1a = *(const u32x4*)(ug_ + IMG_NAK + tf_ * 16); q1b = *(const u32x4*)(ug_ + IMG_MKR + tf_ * 16); \
            q2a = *(const u32x4*)(ug_ + IMG_BH + tf_ * 16); q2b = *(const u32x4*)(ug_ + IMG_KH + tf_ * 16); \
            if (tf_ < 128) q3 = *(const u32x4*)(ug_ + IMG_VI + (tf_ >> 2) * 128 + half * 64 + (tf_ & 3) * 16); else if (tf_ < 144) q3 = *(const u32x4*)(ug_ + IMG_PL + (tf_ - 128) * 16); } } while (0)
        q0a = q0b = q1a = q1b = q2a = q2b = q3 = (u32x4){0u, 0u, 0u, 0u};
        ST_FETCH(0);
        for (int ch = 0; ch < SEQ / 32; ++ch) {
            const int t0 = ch * 32;
            int tid_c = tid0_; asm volatile("" : "+v"(tid_c));
            const int tid = tid_c, lane = tid & 63, fr = lane & 15, fq = lane >> 4;
            LAS unsigned char* lb = lds + (ch & 1) * SK_BUF;
            LAS bf16_t* AT = (LAS bf16_t*)(lb + SK_AT); LAS bf16_t* RT = (LAS bf16_t*)(lb + SK_RT); LAS bf16_t* S0 = (LAS bf16_t*)(lb + SK_S0);
            LAS bf16_t* NakT = (LAS bf16_t*)(lb + SK_NAK); LAS bf16_t* MbrT = (LAS bf16_t*)(lb + SK_MBR); LAS bf16_t* MkrT = (LAS bf16_t*)(lb + SK_MKR); LAS bf16_t* TT = (LAS bf16_t*)(lb + SK_TT);
            LAS bf16_t* Vi = (LAS bf16_t*)(lb + SK_VI); LAS bf16_t* BhT = (LAS bf16_t*)(lb + SK_BH); LAS bf16_t* KhT = (LAS bf16_t*)(lb + SK_KH); LAS float* PL = (LAS float*)(lb + SK_PL);
            if (wave < 4) {
                { const int o_ = (tid >> 3) * 144 + (tid & 7) * 16; *(LAS u32x4*)(lb + SK_AT + o_) = q0a; *(LAS u32x4*)(lb + SK_RT + o_) = q0b; }
                { const int idx = tid & 127, o_ = (tid >> 7) * 2560 + (idx >> 2) * 80 + (idx & 3) * 16; *(LAS u32x4*)(lb + SK_NAK + o_) = q1a; *(LAS u32x4*)(lb + SK_MKR + o_) = q1b; }
                { const int o_ = (tid >> 2) * 80 + (tid & 3) * 16; *(LAS u32x4*)(lb + SK_BH + o_) = q2a; *(LAS u32x4*)(lb + SK_KH + o_) = q2b; }
                if (tid < 128) { const int t_ = tid >> 2, i0_ = 8 * (tid & 3); const unsigned wv_[4] = {q3.x, q3.y, q3.z, q3.w};
#pragma unroll
                    for (int e = 0; e < 4; ++e) { Vi[(i0_ + 2 * e) * P32 + t_] = (bf16_t)(wv_[e] & 0xffffu); Vi[(i0_ + 2 * e + 1) * P32 + t_] = (bf16_t)(wv_[e] >> 16); } }
                else if (tid < 144) *(LAS u32x4*)(lb + SK_PL + (tid - 128) * 16) = q3;
            }
            { const int mt = wave >> 1, nt = wave & 1; u32x2 o; o.x = cvt_pk_bf16(Sacc[0], Sacc[1]); o.y = cvt_pk_bf16(Sacc[2], Sacc[3]);
              *(LAS u32x2*)(S0 + (16 * nt + fr) * P64 + 16 * mt + 4 * fq) = o; }
            __syncthreads();
            if (ch + 1 < SEQ / 32) ST_FETCH(ch + 1);
            if (wave >= 4) {
                const int mt = (wave - 4) >> 1, nt = (wave - 4) & 1;
                f32x4 w = ZERO4();
#pragma unroll
                for (int ks = 0; ks < 2; ++ks) w = __builtin_amdgcn_mfma_f32_16x16x32_bf16(ldfrag(AT, P64, 16 * mt + fr, 32 * ks + 8 * fq), ldfrag(S0, P64, 16 * nt + fr, 32 * ks + 8 * fq), w, 0, 0, 0);
                w = __builtin_amdgcn_mfma_f32_16x16x32_bf16(ldfrag(NakT, P32, 16 * mt + fr, 8 * fq), ldfrag(Vi, P32, 16 * nt + fr, 8 * fq), w, 0, 0, 0);
                u32x2 o; o.x = cvt_pk_bf16(w[0], w[1]); o.y = cvt_pk_bf16(w[2], w[3]); *(LAS u32x2*)(Wi + (16 * nt + fr) * P32 + 16 * mt + 4 * fq) = o;
            }
            __syncthreads();
            if (wave < 4) {
                const int mt = wave >> 1, nt = wave & 1;
                f32x4 uu = ZERO4();
                uu = __builtin_amdgcn_mfma_f32_16x16x32_bf16(ldfrag(TT, P32, 16 * mt + fr, 8 * fq), ldfrag(Wi, P32, 16 * nt + fr, 8 * fq), uu, 0, 0, 0);
                u32x2 o; o.x = cvt_pk_bf16(uu[0], uu[1]); o.y = cvt_pk_bf16(uu[2], uu[3]); *(LAS u32x2*)(Ui + (16 * nt + fr) * P32 + 16 * mt + 4 * fq) = o;
            }
            if (wave >= 4) { CV_STORE(cvA, cv_itA, cv_pendA); CV_LOAD(cvA, cv_itA, cv_pendA); }
            __syncthreads();
            if (wave < 4) {
                const int mt = wave >> 1, nt = wave & 1;
                f32x4 y = ZERO4();
#pragma unroll
                for (int ks = 0; ks < 2; ++ks) y = __builtin_amdgcn_mfma_f32_16x16x32_bf16(ldfrag(S0, P64, 16 * mt + fr, 32 * ks + 8 * fq), ldfrag(RT, P64, 16 * nt + fr, 32 * ks + 8 * fq), y, 0, 0, 0);
                y = __builtin_amdgcn_mfma_f32_16x16x32_bf16(ldfrag(Ui, P32, 16 * mt + fr, 8 * fq), ldfrag(MbrT, P32, 16 * nt + fr, 8 * fq), y, 0, 0, 0);
                y = __builtin_amdgcn_mfma_f32_16x16x32_bf16(ldfrag(Vi, P32, 16 * mt + fr, 8 * fq), ldfrag(MkrT, P32, 16 * nt + fr, 8 * fq), y, 0, 0, 0);
                u32x2 o; o.x = cvt_pk_bf16(y[0], y[1]); o.y = cvt_pk_bf16(y[2], y[3]);
                *(u32x2*)(y_ + (size_t)(b * SEQ + t0 + 16 * nt + fr) * 1024 + h * 64 + half * 32 + 16 * mt + 4 * fq) = o;
            }
            {
                const int mt = wave >> 1, nt = wave & 1;
                const f32x4 pl = *(const LAS f32x4*)(PL + 16 * mt + 4 * fq);
                Sacc = __builtin_amdgcn_mfma_f32_16x16x32_bf16(ldfrag(BhT, P32, 16 * mt + fr, 8 * fq), ldfrag(Ui, P32, 16 * nt + fr, 8 * fq), Sacc, 0, 0, 0);
                Sacc = __builtin_amdgcn_mfma_f32_16x16x32_bf16(ldfrag(KhT, P32, 16 * mt + fr, 8 * fq), ldfrag(Vi, P32, 16 * nt + fr, 8 * fq), Sacc, 0, 0, 0);
                Sacc = Sacc * pl;
            }
        }
        if (wave >= 4) { do { CV_STORE(cvA, cv_itA, cv_pendA); CV_LOAD(cvA, cv_itA, cv_pendA); } while (cv_pendA); }
        __syncthreads();
#undef CV_DECODE
#undef CV_LOAD
#undef CV_STORE
#undef ST_FETCH
    }
}

__device__ __forceinline__ void ld_bf16x16(const bf16_t* p, f32x4 (&o)[4]) { const u32x4 a = *(const u32x4*)p, b = *(const u32x4*)(p + 8);
    o[0] = (f32x4){bf_lo(a.x), bf_hi(a.x), bf_lo(a.y), bf_hi(a.y)}; o[1] = (f32x4){bf_lo(a.z), bf_hi(a.z), bf_lo(a.w), bf_hi(a.w)};
    o[2] = (f32x4){bf_lo(b.x), bf_hi(b.x), bf_lo(b.y), bf_hi(b.y)}; o[3] = (f32x4){bf_lo(b.z), bf_hi(b.z), bf_lo(b.w), bf_hi(b.w)}; }
__device__ __forceinline__ void rwkv_post_phase(const bf16_t* __restrict__ yrw, const bf16_t* __restrict__ bon, const bf16_t* __restrict__ lw_g, const float* __restrict__ ln_w, const float* __restrict__ ln_b, bf16_t* __restrict__ ymixb, const int gw, const int NGW, const int lane) {
    const int c0 = 16 * lane;
    f32x4 lw4[4], lb4[4];
#pragma unroll
    for (int j = 0; j < 4; ++j) { lw4[j] = *(const f32x4*)(ln_w + c0 + 4 * j); lb4[j] = *(const f32x4*)(ln_b + c0 + 4 * j); }
#pragma unroll 2
    for (int m = gw; m < M; m += NGW) {
        f32x4 y[4], bo[4];
        ld_bf16x16(yrw + (size_t)m * 1024 + c0, y); ld_bf16x16(bon + (size_t)m * 1024 + c0, bo);
        const u32x4 g0 = *(const u32x4*)(lw_g + (size_t)m * 1024 + c0), g1 = *(const u32x4*)(lw_g + (size_t)m * 1024 + c0 + 8);
        float s = 0.f;
#pragma unroll
        for (int j = 0; j < 4; ++j) s += (y[j][0] + y[j][1]) + (y[j][2] + y[j][3]);
        s += __shfl_xor(s, 1); s += __shfl_xor(s, 2);
        const float mu = s * (1.f / 64.f);
        float q = 0.f;
#pragma unroll
        for (int j = 0; j < 4; ++j) { y[j] = y[j] - mu; q += (y[j][0] * y[j][0] + y[j][1] * y[j][1]) + (y[j][2] * y[j][2] + y[j][3] * y[j][3]); }
        q += __shfl_xor(q, 1); q += __shfl_xor(q, 2);
        const float rstd = rsqrtf(q * (1.f / 64.f) + 64e-5f);
        float o[16];
#pragma unroll
        for (int j = 0; j < 4; ++j) { const f32x4 t = y[j] * rstd * lw4[j] + lb4[j] + bo[j]; o[4 * j] = t[0]; o[4 * j + 1] = t[1]; o[4 * j + 2] = t[2]; o[4 * j + 3] = t[3]; }
        const unsigned gw_[8] = {g0.x, g0.y, g0.z, g0.w, g1.x, g1.y, g1.z, g1.w};
        u32x4 w0, w1;
        w0.x = cvt_pk_bf16(o[0] * bf_lo(gw_[0]), o[1] * bf_hi(gw_[0])); w0.y = cvt_pk_bf16(o[2] * bf_lo(gw_[1]), o[3] * bf_hi(gw_[1]));
        w0.z = cvt_pk_bf16(o[4] * bf_lo(gw_[2]), o[5] * bf_hi(gw_[2])); w0.w = cvt_pk_bf16(o[6] * bf_lo(gw_[3]), o[7] * bf_hi(gw_[3]));
        w1.x = cvt_pk_bf16(o[8] * bf_lo(gw_[4]), o[9] * bf_hi(gw_[4])); w1.y = cvt_pk_bf16(o[10] * bf_lo(gw_[5]), o[11] * bf_hi(gw_[5]));
        w1.z = cvt_pk_bf16(o[12] * bf_lo(gw_[6]), o[13] * bf_hi(gw_[6])); w1.w = cvt_pk_bf16(o[14] * bf_lo(gw_[7]), o[15] * bf_hi(gw_[7]));
        *(u32x4*)(ymixb + (size_t)m * 2048 + 1024 + c0) = w0; *(u32x4*)(ymixb + (size_t)m * 2048 + 1024 + c0 + 8) = w1;
    }
}

__device__ __forceinline__ void ssd_conv_phase(const bf16_t* projb, const float* cw, const float* cb, const float* dt_bias, bf16_t* xbcc, float* dtb, const int vcu, const int G, const int tid) {
    for (int u = vcu; u < M / 64; u += G) {
        if (tid < 384) {
            const int cg = tid % 192, hf = tid / 192, c0 = 8 * cg, m0 = u * 64 + 32 * hf, t_in_seq = m0 % SEQ;
            float w[4][8], bias[8];
#pragma unroll
            for (int q = 0; q < 4; ++q) { const f32x4 a = *(const f32x4*)(cw + q * CONV_DIM + c0), b = *(const f32x4*)(cw + q * CONV_DIM + c0 + 4);
                w[q][0] = a[0]; w[q][1] = a[1]; w[q][2] = a[2]; w[q][3] = a[3]; w[q][4] = b[0]; w[q][5] = b[1]; w[q][6] = b[2]; w[q][7] = b[3]; }
            { const f32x4 a = *(const f32x4*)(cb + c0), b = *(const f32x4*)(cb + c0 + 4); bias[0] = a[0]; bias[1] = a[1]; bias[2] = a[2]; bias[3] = a[3]; bias[4] = b[0]; bias[5] = b[1]; bias[6] = b[2]; bias[7] = b[3]; }
            float win[3][8];
#pragma unroll
            for (int q = 0; q < 3; ++q) {
                u32x4 r = (u32x4){0u, 0u, 0u, 0u};
                if (t_in_seq - 3 + q >= 0) r = *(const u32x4*)(projb + (size_t)(m0 - 3 + q) * PROJ_BLD + OFF_XBC + c0);
                win[q][0] = bf_lo(r.x); win[q][1] = bf_hi(r.x); win[q][2] = bf_lo(r.y); win[q][3] = bf_hi(r.y); win[q][4] = bf_lo(r.z); win[q][5] = bf_hi(r.z); win[q][6] = bf_lo(r.w); win[q][7] = bf_hi(r.w);
            }
            for (int i0 = 0; i0 < 32; i0 += 8) {
                u32x4 rr[8];
#pragma unroll
                for (int q = 0; q < 8; ++q) rr[q] = *(const u32x4*)(projb + (size_t)(m0 + i0 + q) * PROJ_BLD + OFF_XBC + c0);
#pragma unroll
                for (int q = 0; q < 8; ++q) {
                    const u32x4 r = rr[q];
                    float cur[8] = {bf_lo(r.x), bf_hi(r.x), bf_lo(r.y), bf_hi(r.y), bf_lo(r.z), bf_hi(r.z), bf_lo(r.w), bf_hi(r.w)};
                    float o[8];
#pragma unroll
                    for (int e = 0; e < 8; ++e) { const float acc = bias[e] + w[0][e] * win[0][e] + w[1][e] * win[1][e] + w[2][e] * win[2][e] + w[3][e] * cur[e]; o[e] = fast_silu(acc);
                        win[0][e] = win[1][e]; win[1][e] = win[2][e]; win[2][e] = cur[e]; }
                    u32x4 wv; wv.x = cvt_pk_bf16(o[0], o[1]); wv.y = cvt_pk_bf16(o[2], o[3]); wv.z = cvt_pk_bf16(o[4], o[5]); wv.w = cvt_pk_bf16(o[6], o[7]);
                    *(u32x4*)(xbcc + (size_t)(m0 + i0 + q) * CONV_DIM + c0) = wv;
                }
            }
        }
#pragma unroll
        for (int q = 0; q < 2; ++q) { const int idx = tid + 512 * q, m = u * 64 + (idx >> 4), h = idx & 15;
            const float x = bf2f(projb[(size_t)m * PROJ_BLD + OFF_DT + h]) + dt_bias[h];
            dtb[(size_t)m * SSD_H + h] = fmaxf(x, 0.f) + log1pf(expf(-fabsf(x))); }
    }
}

constexpr int SP = 136;
constexpr int SS_C = 0, SS_B = 34816, SS_BT = 69632, SS_XT = 104448, SS_XW = 113152, SS_HT = 121856, SS_AC = 130560, SS_DT = 131072, SS_END = 131584;
__device__ __forceinline__ void ssd_scan_phase(LAS unsigned char* lds, const bf16_t* xbcc, const float* dtb, const float* a_log, const float* dskip, bf16_t* yssd, const int vcu, const int G, const int tid) {
    const int wave = __builtin_amdgcn_readfirstlane(tid >> 6), lane = tid & 63, fr = lane & 15, fq = lane >> 4;
    const int lt = (wave < 4) ? 2 * wave : 15 - 2 * wave;
    LAS bf16_t* Cimg = (LAS bf16_t*)(lds + SS_C); LAS bf16_t* Bimg = (LAS bf16_t*)(lds + SS_B); LAS bf16_t* BTimg = (LAS bf16_t*)(lds + SS_BT);
    LAS bf16_t* xT = (LAS bf16_t*)(lds + SS_XT); LAS bf16_t* xwT = (LAS bf16_t*)(lds + SS_XW); LAS bf16_t* hT = (LAS bf16_t*)(lds + SS_HT);
    LAS float* acum = (LAS float*)(lds + SS_AC); LAS float* dtv = (LAS float*)(lds + SS_DT);
    for (int u = vcu; u < BATCH * SSD_H * 2; u += G) {
        const int b = u >> 5, h = (u >> 1) & 15, phalf = u & 1, g = h >> 3;
        const float Ah = -expf(a_log[h]) * 1.4426950408889634f;
        const float dsk = dskip[h];
        f32x4 hs[2] = {(f32x4){0.f, 0.f, 0.f, 0.f}, (f32x4){0.f, 0.f, 0.f, 0.f}};
        for (int i = tid; i < 32 * SP / 2; i += 512) ((LAS unsigned*)hT)[i] = 0u;
        const int row = tid >> 2, part = tid & 3;
        u32x4 cvn[4], bvn[4], xrn; float dtn = 0.f, dtn1 = 0.f;
#define SS_FETCH(ch_) do { const bf16_t* src_ = xbcc + (size_t)(b * SEQ + (ch_) * 128 + row) * CONV_DIM; \
        _Pragma("unroll") for (int j = 0; j < 4; ++j) { cvn[j] = *(const u32x4*)(src_ + 1280 + g * 128 + 32 * part + 8 * j); bvn[j] = *(const u32x4*)(src_ + 1024 + g * 128 + 32 * part + 8 * j); } \
        xrn = *(const u32x4*)(src_ + h * 64 + phalf * 32 + 8 * part); \
        if (tid < 64) { const float* dp_ = dtb + (size_t)(b * SEQ + (ch_) * 128 + 2 * tid) * SSD_H + h; dtn = dp_[0]; dtn1 = dp_[SSD_H]; } } while (0)
        SS_FETCH(0);
        for (int ch = 0; ch < SEQ / 128; ++ch) {
            const int mrow0 = b * SEQ + ch * 128;
            u32x4 xr;
            {
                u32x4 cv[4], bv[4];
#pragma unroll
                for (int j = 0; j < 4; ++j) { cv[j] = cvn[j]; bv[j] = bvn[j]; }
                xr = xrn;
                if (wave == 0) {
                    const float d0 = dtn, d1 = dtn1;
                    *(LAS f32x2*)(dtv + 2 * lane) = (f32x2){d0, d1};
                    const float v0 = d0 * Ah, v1 = d1 * Ah;
                    float s = v0 + v1;
#define SS_DPPF(x_, ctrl_, rm_, bc_) __int_as_float(__builtin_amdgcn_update_dpp(0, __float_as_int(x_), (ctrl_), (rm_), 0xF, (bc_)))
                    s += SS_DPPF(s, 0x111, 0xF, true); asm("" : "+v"(s));
                    s += SS_DPPF(s, 0x112, 0xF, true); asm("" : "+v"(s));
                    s += SS_DPPF(s, 0x114, 0xF, true); asm("" : "+v"(s));
                    s += SS_DPPF(s, 0x118, 0xF, true); asm("" : "+v"(s));
                    s += SS_DPPF(s, 0x142, 0xA, false); asm("" : "+v"(s));
                    s += SS_DPPF(s, 0x143, 0xC, false); asm("" : "+v"(s));
#undef SS_DPPF
                    *(LAS f32x2*)(acum + 2 * lane) = (f32x2){s - v1, s};
                }
                if (ch + 1 < SEQ / 128) SS_FETCH(ch + 1);
#pragma unroll
                for (int j = 0; j < 4; ++j) { *(LAS u32x4*)(Cimg + row * SP + 32 * part + 8 * j) = cv[j]; *(LAS u32x4*)(Bimg + row * SP + 32 * part + 8 * j) = bv[j]; }
#pragma unroll
                for (int j = 0; j < 4; ++j) { const unsigned wv[4] = {bv[j].x, bv[j].y, bv[j].z, bv[j].w};
#pragma unroll
                    for (int e = 0; e < 4; ++e) { const int n = 32 * part + 8 * j + 2 * e; BTimg[n * SP + row] = (bf16_t)(wv[e] & 0xffffu); BTimg[(n + 1) * SP + row] = (bf16_t)(wv[e] >> 16); } }
            }
            __syncthreads();
            const float atot = acum[127];
            {
                const float wgt = dtv[row] * __builtin_amdgcn_exp2f(atot - acum[row]);
                const unsigned wv[4] = {xr.x, xr.y, xr.z, xr.w};
#pragma unroll
                for (int e = 0; e < 4; ++e) { const int p = 8 * part + 2 * e; const float x0 = bf_lo(wv[e]), x1 = bf_hi(wv[e]);
                    xT[p * SP + row] = (bf16_t)(wv[e] & 0xffffu); xT[(p + 1) * SP + row] = (bf16_t)(wv[e] >> 16);
                    const unsigned pk = cvt_pk_bf16(x0 * wgt, x1 * wgt); xwT[p * SP + row] = (bf16_t)(pk & 0xffffu); xwT[(p + 1) * SP + row] = (bf16_t)(pk >> 16); }
            }
            f32x4 gacc[8];
#pragma unroll
            for (int st = 0; st < 8; ++st) gacc[st] = (f32x4){0.f, 0.f, 0.f, 0.f};
            {
                bf16x8 cf[4];
#pragma unroll
                for (int ks = 0; ks < 4; ++ks) cf[ks] = *(const LAS bf16x8*)(Cimg + (16 * lt + fr) * SP + 32 * ks + 8 * fq);
#pragma unroll
                for (int st = 0; st < 8; ++st) if (st <= lt) {
#pragma unroll
                    for (int ks = 0; ks < 4; ++ks) { const bf16x8 bfg = *(const LAS bf16x8*)(Bimg + (16 * st + fr) * SP + 32 * ks + 8 * fq);
                        gacc[st] = __builtin_amdgcn_mfma_f32_16x16x32_bf16(bfg, cf[ks], gacc[st], 0, 0, 0); }
                }
            }
            __syncthreads();
            {
                LAS bf16_t* Mimg = Bimg;
                const int l = 16 * lt + fr; const float al = acum[l];
#pragma unroll
                for (int st = 0; st < 8; ++st) if (st <= lt + 1) {
                    u32x2 wv = (u32x2){0u, 0u};
                    if (st <= lt) {
                        const f32x4 as4 = *(const LAS f32x4*)(acum + 16 * st + 4 * fq), dt4 = *(const LAS f32x4*)(dtv + 16 * st + 4 * fq);
                        float mv[4];
#pragma unroll
                        for (int r = 0; r < 4; ++r) { const int s = 16 * st + 4 * fq + r; mv[r] = (s <= l) ? gacc[st][r] * dt4[r] * __builtin_amdgcn_exp2f(al - as4[r]) : 0.f; }
                        wv.x = cvt_pk_bf16(mv[0], mv[1]); wv.y = cvt_pk_bf16(mv[2], mv[3]);
                    }
                    *(LAS u32x2*)(Mimg + l * SP + 16 * st + 4 * fq) = wv;
                }
            }
            __syncthreads();
            {
                const LAS bf16_t* Mimg = Bimg;
                f32x4 yd[2] = {(f32x4){0.f, 0.f, 0.f, 0.f}, (f32x4){0.f, 0.f, 0.f, 0.f}}, yo[2] = {(f32x4){0.f, 0.f, 0.f, 0.f}, (f32x4){0.f, 0.f, 0.f, 0.f}};
#pragma unroll
                for (int ks = 0; ks < 4; ++ks) {
                    const bf16x8 cfr = *(const LAS bf16x8*)(Cimg + (16 * lt + fr) * SP + 32 * ks + 8 * fq);
#pragma unroll
                    for (int pt = 0; pt < 2; ++pt) { const bf16x8 hf = *(const LAS bf16x8*)(hT + (16 * pt + fr) * SP + 32 * ks + 8 * fq);
                        yo[pt] = __builtin_amdgcn_mfma_f32_16x16x32_bf16(hf, cfr, yo[pt], 0, 0, 0); }
                    if (2 * ks <= lt) {
                        const bf16x8 mf = *(const LAS bf16x8*)(Mimg + (16 * lt + fr) * SP + 32 * ks + 8 * fq);
#pragma unroll
                        for (int pt = 0; pt < 2; ++pt) { const bf16x8 xf_ = *(const LAS bf16x8*)(xT + (16 * pt + fr) * SP + 32 * ks + 8 * fq);
                            yd[pt] = __builtin_amdgcn_mfma_f32_16x16x32_bf16(xf_, mf, yd[pt], 0, 0, 0); }
                    }
                }
                const int l = 16 * lt + fr; const float el = __builtin_amdgcn_exp2f(acum[l]);
#pragma unroll
                for (int pt = 0; pt < 2; ++pt) {
                    f32x4 o;
#pragma unroll
                    for (int r = 0; r < 4; ++r) o[r] = yd[pt][r] + el * yo[pt][r] + dsk * bf2f(xT[(16 * pt + 4 * fq + r) * SP + l]);
                    { u32x2 w2; w2.x = cvt_pk_bf16(o[0], o[1]); w2.y = cvt_pk_bf16(o[2], o[3]); *(u32x2*)(yssd + (size_t)(mrow0 + l) * 1024 + h * 64 + phalf * 32 + 16 * pt + 4 * fq) = w2; }
                }
            }
            {
                const float ea = __builtin_amdgcn_exp2f(atot);
                hs[0] = hs[0] * ea; hs[1] = hs[1] * ea;
#pragma unroll
                for (int ks = 0; ks < 4; ++ks) {
                    const bf16x8 btf = *(const LAS bf16x8*)(BTimg + (16 * wave + fr) * SP + 32 * ks + 8 * fq);
#pragma unroll
                    for (int pt = 0; pt < 2; ++pt) { const bf16x8 xwf = *(const LAS bf16x8*)(xwT + (16 * pt + fr) * SP + 32 * ks + 8 * fq);
                        hs[pt] = __builtin_amdgcn_mfma_f32_16x16x32_bf16(btf, xwf, hs[pt], 0, 0, 0); }
                }
            }
            __syncthreads();
#pragma unroll
            for (int pt = 0; pt < 2; ++pt) { u32x2 wv; wv.x = cvt_pk_bf16(hs[pt][0], hs[pt][1]); wv.y = cvt_pk_bf16(hs[pt][2], hs[pt][3]);
                *(LAS u32x2*)(hT + (16 * pt + fr) * SP + 16 * wave + 4 * fq) = wv; }
        }
#undef SS_FETCH
        __syncthreads();
    }
}

__device__ __forceinline__ void ssd_post_phase(const bf16_t* __restrict__ yssd, const bf16_t* __restrict__ projb, const float* __restrict__ norm_w, bf16_t* __restrict__ ymixb, const int gw, const int NGW, const int lane) {
    const int c0 = 16 * lane;
    f32x4 nw[4];
#pragma unroll
    for (int j = 0; j < 4; ++j) nw[j] = *(const f32x4*)(norm_w + c0 + 4 * j);
#pragma unroll 2
    for (int m = gw; m < M; m += NGW) {
        f32x4 y[4];
        ld_bf16x16(yssd + (size_t)m * 1024 + c0, y);
        const u32x4 z0 = *(const u32x4*)(projb + (size_t)m * PROJ_BLD + OFF_Z + c0), z1 = *(const u32x4*)(projb + (size_t)m * PROJ_BLD + OFF_Z + c0 + 8);
        const unsigned zw[8] = {z0.x, z0.y, z0.z, z0.w, z1.x, z1.y, z1.z, z1.w};
        float uu[16]; float ss = 0.f;
#pragma unroll
        for (int e = 0; e < 8; ++e) { uu[2 * e] = y[e >> 1][(2 * e) & 3] * fast_silu(bf_lo(zw[e])); uu[2 * e + 1] = y[e >> 1][(2 * e + 1) & 3] * fast_silu(bf_hi(zw[e])); ss += uu[2 * e] * uu[2 * e] + uu[2 * e + 1] * uu[2 * e + 1]; }
#pragma unroll
        for (int o = 1; o < 32; o <<= 1) ss += __shfl_xor(ss, o);
        const float rs = rsqrtf(ss * (1.f / 512.f) + 1e-5f);
        u32x4 w0, w1;
        w0.x = cvt_pk_bf16(uu[0] * rs * nw[0][0], uu[1] * rs * nw[0][1]); w0.y = cvt_pk_bf16(uu[2] * rs * nw[0][2], uu[3] * rs * nw[0][3]);
        w0.z = cvt_pk_bf16(uu[4] * rs * nw[1][0], uu[5] * rs * nw[1][1]); w0.w = cvt_pk_bf16(uu[6] * rs * nw[1][2], uu[7] * rs * nw[1][3]);
        w1.x = cvt_pk_bf16(uu[8] * rs * nw[2][0], uu[9] * rs * nw[2][1]); w1.y = cvt_pk_bf16(uu[10] * rs * nw[2][2], uu[11] * rs * nw[2][3]);
        w1.z = cvt_pk_bf16(uu[12] * rs * nw[3][0], uu[13] * rs * nw[3][1]); w1.w = cvt_pk_bf16(uu[14] * rs * nw[3][2], uu[15] * rs * nw[3][3]);
        *(u32x4*)(ymixb + (size_t)m * 2048 + c0) = w0; *(u32x4*)(ymixb + (size_t)m * 2048 + c0 + 8) = w1;
    }
}

#define PH_BEGIN int z_ = 0; asm volatile("" : "+s"(z_)); unsigned char* const wsq = P.ws + z_; int tid = tid0; asm volatile("" : "+v"(tid)); \
    const int G = G0 + z_, bx = bx0 + z_, vcu = vcu0 + z_, lane = tid & 63, wave = __builtin_amdgcn_readfirstlane(tid >> 6), gw = vcu * NWAVES + wave, NGW = G * NWAVES; (void)bx; (void)lane; (void)gw; (void)NGW; (void)wave;
#define CVT_MIXER_WEIGHTS(L_, gw, NGW, tix, tnum) do { const int L = (L_); \
            cvt_job<0>(INP(1) + (size_t)L * D * IN_DIM, D, IN_DIM, Win_t, 0, 0, scr, gw, NGW, lane); \
            if (L > 0) cvt_job<0>(INP(2) + (size_t)(L - 1) * D * 32, D, 32, Win_t, IN_DIM, 0, scr, gw, NGW, lane); \
            { const int r0 = L > 0 ? IN_DIM + 32 : IN_DIM, nz = (PROJ_BLD - r0) * (D / 8);       \
              const unsigned oz = __float_as_uint(opaque0()); for (int i = (tix); i < nz; i += (tnum)) *(u32x4*)(Win_t + (size_t)r0 * D + (size_t)i * 8) = (u32x4){oz, oz, oz, oz}; } \
            cvt_job<0>(INP(23) + (size_t)L * D * D, D, D, Wout_t, 0, 0, scr, gw, NGW, lane); \
            cvt_job<0>(INP(12) + (size_t)L * 64 * 1024, 64, 1024, Wl_w, 0, 0, scr, gw, NGW, lane); \
            cvt_job<0>(INP(14) + (size_t)L * 64 * 1024, 64, 1024, Wl_a, 0, 0, scr, gw, NGW, lane); \
            cvt_job<0>(INP(17) + (size_t)L * 160 * 1024, 160, 1024, Wl_g, 0, 0, scr, gw, NGW, lane); \
            if (L > 0) cvt_job<0>(INP(16) + (size_t)(L - 1) * 32 * 1024, 32, 1024, Wl_v, 0, 0, scr, gw, NGW, lane); } while (0)
#define INP(i) (P.in[(i) + z_])
#define RW_ARGS(a) RwScan a; a.proj_ = projb; a.lw_ = lw; a.mix = INP(9) + (size_t)l * RW_SHIFT; a.w0 = INP(11) + l * 1024; a.a0 = INP(13) + l * 1024; a.v0 = INP(15) + (l > 0 ? l - 1 : 0) * 1024; \
            a.k_k = INP(18) + l * 1024; a.k_a = INP(19) + l * 1024; a.r_k = INP(20) + l * 1024; a.vf_ = vfirst; a.y_ = (bf16_t*)yrw; a.bon_ = (bf16_t*)bon; a.layer = l; a.pad = 0; \
            a.cw1 = moe ? INP(32) + (size_t)li * NE * D * DFE : INP(28) + (size_t)li * D * DFF; a.cw3 = moe ? INP(33) + (size_t)li * NE * D * DFE : INP(29) + (size_t)li * D * DFF; a.cw2 = moe ? INP(34) + (size_t)li * NE * DFE * D : INP(30) + (size_t)li * DFF * D; a.cwt = Wffn; a.cmoe = moe ? 1 : 0; a.pad2 = 0;

#define Win_t ((bf16_t*)(wsq + WS_WIN))
#define Wout_t ((bf16_t*)(wsq + WS_WOUT))
#define Wffn ((bf16_t*)(wsq + WS_WFFN))
#define Wl_w ((bf16_t*)(wsq + WS_WLORA))
#define Wl_a (Wl_w + 1024 * 64)
#define Wl_g (Wl_a + 1024 * 64)
#define Wl_v (Wl_g + 1024 * 160)
#define xf ((float*)(wsq + WS_XF))
#define xb ((bf16_t*)(wsq + WS_XB))
#define projb ((bf16_t*)(wsq + WS_PROJB))
#define ymixb ((bf16_t*)(wsq + WS_YMIXB))
#define mixed ((float*)(wsq + WS_MIXED))
#define hbuf ((bf16_t*)(wsq + WS_HBUF))
#define xg ((bf16_t*)(wsq + WS_XG))
#define yslot ((float*)(wsq + WS_YSLOT))
#define xbcc ((bf16_t*)(wsq + WS_XBCC))
#define dtb ((float*)(wsq + WS_DTB))
#define yssd ((float*)(wsq + WS_YSSD))
#define lw ((bf16_t*)(wsq + WS_LW))
#define yrw ((float*)(wsq + WS_YRW))
#define bon ((float*)(wsq + WS_BON))
#define vfirst ((float*)(wsq + WS_VFIRST))
#define tok_e ((int*)(wsq + WS_TOK))
#define tok_pos (tok_e + 2 * M)
#define tok_g ((float*)(tok_pos + 2 * M))
#define tok_dest ((int*)(tok_g + 2 * M))
#define src_row (tok_dest + 2 * M)
#define cnt ((int*)(wsq + WS_CTL) + CW_CNT + 8 * li)
__global__ void __launch_bounds__(NWAVES * 64, 2) fwd(Params P) {
    extern __shared__ __attribute__((aligned(16))) unsigned char lds_raw[];
    LAS unsigned char* lds = (LAS unsigned char*)lds_raw;
    volatile LAS unsigned* MISC = (volatile LAS unsigned*)(lds + MISC_OFF);
    const int tid0 = threadIdx.x;
    const int G0 = gridDim.x, bx0 = blockIdx.x;
    const int vcu0 = (G0 % 8 == 0) ? (bx0 % 8) * (G0 / 8) + bx0 / 8 : bx0;
    unsigned* ctl = (unsigned*)(P.ws + WS_CTL);
    if (tid0 < 64) MISC[tid0] = 0u;
    __syncthreads();
#if MK_LAUNCH_MODE == 1
    constexpr int lo = 0, hi = 64;
#else
    const int lo = P.ph_lo, hi = P.ph_hi;
#endif
    XcdBarrier bar; bar.bar = ctl + CW_BAR + P.bar_idx * XCD_BAR_WORDS; bar.x = 0; bar.st = MISC + 8;
    if (hi - lo > 1) bar = xcd_barrier_post(ctl + CW_BAR + P.bar_idx * XCD_BAR_WORDS, MISC + 8);
#define IN(k) (lo <= (k) && (k) < hi)
#ifndef MK_TS_MASK
#define MK_TS_MASK 0
#endif
#ifndef MK_TS_MULT
#define MK_TS_MULT 8
#endif
    unsigned long long ts_acc = 0ull, ts_t0 = 0ull; (void)ts_acc; (void)ts_t0;
#ifndef MK_TS_LAYERS
#define MK_TS_LAYERS 0xF
#endif
#define TS_ON(k) (MK_TS_MASK != 0 && ((MK_TS_MASK >> (k)) & 1) && ((MK_TS_LAYERS >> l) & 1))
#define TS_BEGIN(k) do { if (TS_ON(k)) ts_t0 = __builtin_amdgcn_s_memrealtime(); } while (0)
#define TS_END(k) do { if (TS_ON(k)) { __syncthreads(); ts_acc += __builtin_amdgcn_s_memrealtime() - ts_t0; } } while (0)
#define SEAM(k) do { if (((k) & 15) == 3 && TS_ON(21)) { TS_END(21); } if ((k) + 1 < hi) { TS_END((k) & 15); TS_BEGIN(20); xcd_barrier(bar); if ((MK_DBL >> 19) & 1) xcd_barrier(bar); TS_END(20); } else { TS_END((k) & 15); } } while (0)

    for (int l = 0; l < 4; ++l) {
        const int pb = l * 16, li = l >> 1; const bool moe = (l & 1) != 0;
        if (IN(pb + 0) && l == 0) {
            PH_BEGIN
            TS_BEGIN(0);
            for (int rep_ = 0; rep_ < 1 + ((MK_DBL >> 0) & 1); ++rep_) {
            LAS float* scr = (LAS float*)(lds + wave * 16384);
            CVT_MIXER_WEIGHTS(0, gw, NGW, bx * 512 + tid, G * 512);
            if (l == 0) {
                const float* x = INP(0);
                const size_t stride = (size_t)G * 512, total = (size_t)M * D / 8;
                size_t i = (size_t)bx * 512 + tid;
                for (; i + 3 * stride < total; i += 4 * stride) {
                    f32x4 a[4], b[4];
#pragma unroll
                    for (int q = 0; q < 4; ++q) { a[q] = *(const f32x4*)(x + (i + q * stride) * 8); b[q] = *(const f32x4*)(x + (i + q * stride) * 8 + 4); }
#pragma unroll
                    for (int q = 0; q < 4; ++q) { u32x4 w; w.x = cvt_pk_bf16(a[q][0], a[q][1]); w.y = cvt_pk_bf16(a[q][2], a[q][3]); w.z = cvt_pk_bf16(b[q][0], b[q][1]); w.w = cvt_pk_bf16(b[q][2], b[q][3]);
                        *(u32x4*)(xb + (i + q * stride) * 8) = w; }
                }
                for (; i < total; i += stride) {
                    const f32x4 a = *(const f32x4*)(x + i * 8), b = *(const f32x4*)(x + i * 8 + 4);
                    u32x4 w; w.x = cvt_pk_bf16(a[0], a[1]); w.y = cvt_pk_bf16(a[2], a[3]); w.z = cvt_pk_bf16(b[0], b[1]); w.w = cvt_pk_bf16(b[2], b[3]);
                    *(u32x4*)(xb + i * 8) = w; }
            }
            }
            __syncthreads();
            SEAM(pb + 0);
        }
        if (IN(pb + 1)) {
            PH_BEGIN
            TS_BEGIN(1);
            pg8::Gemm g{xb, Win_t, D}; pg8::StaticOrder S; S.init(M, PROJ_BLD, G, bx);
            pg8::EpiBf16 E{projb, PROJ_BLD};
            pg8::gemm_phase<pg8::EpiBf16, pg8::StaticOrder>(lds, g, S, E, tid);
#if (MK_DBL >> 1) & 1
            pg8::gemm_phase<pg8::EpiBf16, pg8::StaticOrder>(lds, g, S, E, tid);
#endif
            SEAM(pb + 1);
        }
        if (IN(pb + 2)) {
            PH_BEGIN
            TS_BEGIN(2);
            lora_phase(lds, projb, INP(9) + (size_t)l * RW_SHIFT, INP(10) + (size_t)(l > 0 ? l - 1 : 0) * 32, Wl_w, Wl_a, Wl_g, Wl_v, lw, l > 0, vcu, G, tid);
#if (MK_DBL >> 2) & 1
            lora_phase(lds, projb, INP(9) + (size_t)l * RW_SHIFT, INP(10) + (size_t)(l > 0 ? l - 1 : 0) * 32, Wl_w, Wl_a, Wl_g, Wl_v, lw, l > 0, vcu, G, tid);
#endif
            ssd_conv_phase(projb, INP(3) + (size_t)l * 4 * CONV_DIM, INP(4) + (size_t)l * CONV_DIM, INP(5) + l * SSD_H, xbcc, dtb, vcu, G, tid);
#if (MK_DBL >> 11) & 1
            ssd_conv_phase(projb, INP(3) + (size_t)l * 4 * CONV_DIM, INP(4) + (size_t)l * CONV_DIM, INP(5) + l * SSD_H, xbcc, dtb, vcu, G, tid);
#endif
#if MK_RWKV_CHUNKED == 2
            __syncthreads();
            {
                RW_ARGS(a);
                int tid3 = tid; asm volatile("" : "+v"(tid3));
                rwkv_pre_phase(lds, a, wsq + WS_IMG, vcu, G, tid3, true, true);
#if (MK_DBL >> 12) & 1
                __syncthreads();
                rwkv_pre_phase(lds, a, wsq + WS_IMG, vcu, G, tid3, false, true);
#endif
#if (MK_DBL >> 13) & 1
                __syncthreads();
                rwkv_pre_phase(lds, a, wsq + WS_IMG, vcu, G, tid3, true, false);
#endif
            }
#endif
            SEAM(pb + 2);
        }
        if (IN(pb + 3)) {
            PH_BEGIN
            TS_BEGIN(3);
#if MK_RWKV_CHUNKED == 2
            RW_ARGS(a);
            const bool ssd_first = ((vcu >> 1) & 1) != 0;
            if (ssd_first) { int tid4 = tid; asm volatile("" : "+v"(tid4)); ssd_scan_phase(lds, xbcc, dtb, INP(6) + l * SSD_H, INP(7) + l * SSD_H, (bf16_t*)yssd, vcu, G, tid4); }
            rwkv_state_phase(lds, wsq + WS_IMG, (bf16_t*)yrw, a, vcu, G, tid);
#if (MK_DBL >> 3) & 1
            rwkv_state_phase(lds, wsq + WS_IMG, (bf16_t*)yrw, a, vcu, G, tid);
#endif
#elif MK_RWKV_CHUNKED
            RW_ARGS(a);
            rwkv_chunk_phase(lds, a, vcu, G, tid);
#else
            RW_ARGS(a);
            rwkv_scan_phase(lds, a, vcu, G, tid);
#endif
            if (TS_ON(21)) { TS_END(3); TS_BEGIN(21); }
#if ((MK_DBL >> 3) & 1) && MK_RWKV_CHUNKED == 0
            rwkv_scan_phase(lds, a, vcu, G, tid);
#endif
            int tid2 = tid; asm volatile("" : "+v"(tid2));
#if MK_RWKV_CHUNKED == 2
            if (!ssd_first)
#endif
            ssd_scan_phase(lds, xbcc, dtb, INP(6) + l * SSD_H, INP(7) + l * SSD_H, (bf16_t*)yssd, vcu, G, tid2);
#if (MK_DBL >> 10) & 1
            ssd_scan_phase(lds, xbcc, dtb, INP(6) + l * SSD_H, INP(7) + l * SSD_H, (bf16_t*)yssd, vcu, G, tid);
#endif
            SEAM(pb + 3);
        }
        if (IN(pb + 4)) {
            PH_BEGIN
            TS_BEGIN(4);
            rwkv_post_phase((const bf16_t*)yrw, (const bf16_t*)bon, lw + (size_t)2 * M * 1024, INP(21) + l * 1024, INP(22) + l * 1024, ymixb, gw, NGW, lane);
#if (MK_DBL >> 4) & 1
            rwkv_post_phase((const bf16_t*)yrw, (const bf16_t*)bon, lw + (size_t)2 * M * 1024, INP(21) + l * 1024, INP(22) + l * 1024, ymixb, gw, NGW, lane);
#endif
            ssd_post_phase((const bf16_t*)yssd, projb, INP(8) + l * 1024, ymixb, gw, NGW, lane);
#if (MK_DBL >> 4) & 1
            ssd_post_phase((const bf16_t*)yssd, projb, INP(8) + l * 1024, ymixb, gw, NGW, lane);
#endif
            SEAM(pb + 4);
        }
        if (IN(pb + 5)) {
            PH_BEGIN
            TS_BEGIN(5);
            pg8::Gemm g{ymixb, Wout_t, D}; pg8::StaticOrder S; S.init(M, D, G, bx);
            pg8::EpiBf16 E{(bf16_t*)mixed, FLD};
#if (MK_DBL >> 14) & 1
            { pg8::RepeatOrder R; R.init2(M, D, G, bx, 2); pg8::gemm_phase<pg8::EpiBf16, pg8::RepeatOrder>(lds, g, R, E, tid); }
#else
            pg8::gemm_phase<pg8::EpiBf16, pg8::StaticOrder>(lds, g, S, E, tid);
#endif
#if (MK_DBL >> 5) & 1
            pg8::gemm_phase<pg8::EpiBf16, pg8::StaticOrder>(lds, g, S, E, tid);
#endif
            SEAM(pb + 5);
        }
        if (IN(pb + 6)) {
            PH_BEGIN
            TS_BEGIN(6);
            const float* xin = INP(0);
            f32x4 g8[8], b8[8];
#pragma unroll
            for (int j = 0; j < 8; ++j) { g8[j] = *(const f32x4*)(INP(24) + l * D + 4 * lane + 256 * j); b8[j] = *(const f32x4*)(INP(25) + l * D + 4 * lane + 256 * j); }
            LAS float* rs = (LAS float*)lds;
            LAS int* wgcnt = (LAS int*)(lds + 65536); LAS int* wgbase = wgcnt + 8; LAS int* rec = wgcnt + 16;
            if (moe) { const float* router = INP(31) + (size_t)li * D * NE;
                for (int i = tid; i < D * NE; i += 512) rs[(i & 7) * D + (i >> 3)] = router[i];
                if (tid < 16) wgcnt[tid] = 0;
                __syncthreads(); }
            int nrec = 0;
            for (int m0 = gw; m0 < M; m0 += 2 * NGW) {
                const int m1 = m0 + NGW; const bool has1 = m1 < M; const int m1c = has1 ? m1 : m0;
                f32x4 va[8], vb[8];
#pragma unroll
                for (int j = 0; j < 8; ++j) { const int c = 4 * lane + 256 * j;
                    const u32x2 ma = *(const u32x2*)((const bf16_t*)mixed + (size_t)m0 * FLD + c), mb = *(const u32x2*)((const bf16_t*)mixed + (size_t)m1c * FLD + c);
                    const f32x4 xa = (l == 0) ? *(const f32x4*)(xin + (size_t)m0 * D + c) : ld_bf4(xb + (size_t)m0 * D + c), xbv = (l == 0) ? *(const f32x4*)(xin + (size_t)m1c * D + c) : ld_bf4(xb + (size_t)m1c * D + c);
                    va[j] = ALPHA * xa + (f32x4){bf_lo(ma.x), bf_hi(ma.x), bf_lo(ma.y), bf_hi(ma.y)};
                    vb[j] = ALPHA * xbv + (f32x4){bf_lo(mb.x), bf_hi(mb.x), bf_lo(mb.y), bf_hi(mb.y)}; }
                ln_finish(va, g8, b8, lane, (float*)nullptr, xb + (size_t)m0 * D);
                if (has1) ln_finish(vb, g8, b8, lane, (float*)nullptr, xb + (size_t)m1 * D);
                if (moe) {
#pragma unroll
                    for (int r = 0; r < 2; ++r) {
                        if (r == 1 && !has1) break;
                        const int m = r ? m1 : m0;
                        float sl[8];
#pragma unroll
                        for (int e = 0; e < 8; ++e) { float s = 0.f;
#pragma unroll
                            for (int j = 0; j < 8; ++j) { const f32x4 rr = *(const LAS f32x4*)(rs + e * D + 4 * lane + 256 * j); const f32x4 vv = r ? vb[j] : va[j]; s += (vv[0] * rr[0] + vv[1] * rr[1]) + (vv[2] * rr[2] + vv[3] * rr[3]); }
                            sl[e] = s; }
                        const float z0 = reduce4(sl[0], sl[1], sl[2], sl[3]), z1 = reduce4(sl[4], sl[5], sl[6], sl[7]);
                        const float lg[8] = {rdlane(z0, 0), rdlane(z0, 16), rdlane(z0, 32), rdlane(z0, 48), rdlane(z1, 0), rdlane(z1, 16), rdlane(z1, 32), rdlane(z1, 48)};
                        if (lane == 0) {
                            int i0 = 0; float v0 = lg[0];
#pragma unroll
                            for (int e = 1; e < 8; ++e) if (lg[e] > v0) { v0 = lg[e]; i0 = e; }
                            int i1 = -1; float v1 = -3.4e38f;
#pragma unroll
                            for (int e = 0; e < 8; ++e) if (e != i0 && lg[e] > v1) { v1 = lg[e]; i1 = e; }
                            const float e1 = expf(v1 - v0);
                            tok_e[2 * m] = i0; tok_e[2 * m + 1] = i1; tok_g[2 * m] = 1.f / (1.f + e1); tok_g[2 * m + 1] = e1 / (1.f + e1);
                            const int lp0 = __hip_atomic_fetch_add(&wgcnt[i0], 1, __ATOMIC_RELAXED, __HIP_MEMORY_SCOPE_WORKGROUP), lp1 = __hip_atomic_fetch_add(&wgcnt[i1], 1, __ATOMIC_RELAXED, __HIP_MEMORY_SCOPE_WORKGROUP);
                            LAS int* rc = rec + ((nrec + r) * NWAVES + wave) * 5;
                            rc[0] = m; rc[1] = i0; rc[2] = i1; rc[3] = lp0; rc[4] = lp1;
                        }
                    }
                    nrec += has1 ? 2 : 1;
                }
            }
            if (moe) {
                __syncthreads();
                if (tid < 8) wgbase[tid] = atomicAdd(&cnt[tid], wgcnt[tid]);
                __syncthreads();
                for (int i = tid; i < nrec * NWAVES; i += 512) { const LAS int* rc = rec + i * 5; const int m = rc[0];
                    tok_pos[2 * m] = wgbase[rc[1]] + rc[3]; tok_pos[2 * m + 1] = wgbase[rc[2]] + rc[4]; }
            }
            __syncthreads();
            SEAM(pb + 6);
        }
        if (IN(pb + 7) && moe) {
            PH_BEGIN
            TS_BEGIN(7);
            LAS float* scr = (LAS float*)(lds + wave * 16384);
            if (moe) {
                int start[8]; { int acc = 0;
#pragma unroll
                    for (int e = 0; e < 8; ++e) { start[e] = acc; acc += ((cnt[e] + 255) >> 8) << 8; } }
                for (int i = bx * 512 + tid; i < 2 * M; i += G * 512) {
                    const int e = tok_e[i], pos = tok_pos[i];
                    int st = 0;
#pragma unroll
                    for (int q = 0; q < 8; ++q) st = (e == q) ? start[q] : st;
                    const int dest = st + pos;
                    tok_dest[i] = dest; src_row[dest] = i >> 1;
                }
                for (int p = bx * 512 + tid; p < PMAX; p += G * 512) {
                    int e = 0;
#pragma unroll
                    for (int q = 1; q < 8; ++q) e += (p >= start[q]) ? 1 : 0;
                    if (p - start[e] >= cnt[e]) src_row[p] = 0;
                }
            }
            __syncthreads();
            SEAM(pb + 7);
        }
        if (IN(pb + 8)) {
            PH_BEGIN
            TS_BEGIN(8);
            if (!moe) {
                pg8::Gemm g{xb, Wffn, D}; pg8::StaticOrder S; S.init(M, 2 * DFF, G, bx);
                pg8::EpiSwiglu E{hbuf, DFF};
                pg8::gemm_phase<pg8::EpiSwiglu, pg8::StaticOrder>(lds, g, S, E, tid);
#if (MK_DBL >> 15) & 1
                pg8::gemm_phase<pg8::EpiSwiglu, pg8::StaticOrder>(lds, g, S, E, tid);
#endif
            } else {
                pg8::Gemm g{xb, Wffn, D, src_row}; pg8::GroupedOrder S; S.init(cnt, 2 * DFE, G, bx);
                pg8::EpiSwiglu E{hbuf, DFE};
                pg8::gemm_phase<pg8::EpiSwiglu, pg8::GroupedOrder, true>(lds, g, S, E, tid);
#if (MK_DBL >> 16) & 1
                pg8::gemm_phase<pg8::EpiSwiglu, pg8::GroupedOrder>(lds, g, S, E, tid);
#endif
            }
            SEAM(pb + 8);
        }
        if (IN(pb + 9)) {
            PH_BEGIN
            TS_BEGIN(9);
            if (!moe) {
                pg8::Gemm g{hbuf, Wffn + (size_t)2 * DFF * D, DFF}; pg8::StaticOrder S; S.init(M, D, G, bx);
                pg8::EpiBf16 E{(bf16_t*)yslot, FLD};
                pg8::gemm_phase<pg8::EpiBf16, pg8::StaticOrder>(lds, g, S, E, tid);
            } else {
                pg8::Gemm g{hbuf, Wffn + (size_t)NE * 2 * DFE * D, DFE}; pg8::GroupedOrder S; S.init(cnt, D, G, bx);
                pg8::EpiBf16 E{(bf16_t*)yslot, FLD};
                pg8::gemm_phase<pg8::EpiBf16, pg8::GroupedOrder>(lds, g, S, E, tid);
            }
            if (l < 3) {
                int tail = 0;
                if (moe) { int np = 0;
#pragma unroll
                    for (int e = 0; e < 8; ++e) np += (cnt[e] + 255) >> 8;
                    tail = (np * (D / 256)) % G; }
                if (bx >= tail) {
                    LAS float* scr = (LAS float*)(lds + wave * 16384);
                    const int fwg = bx - tail, nf = G - tail;
                    CVT_MIXER_WEIGHTS(l + 1, fwg * NWAVES + wave, nf * NWAVES, fwg * 512 + tid, nf * 512);
                }
            }
            SEAM(pb + 9);
        }
        if (IN(pb + 10)) {
            PH_BEGIN
            TS_BEGIN(10);
            f32x4 g8[8], b8[8];
#pragma unroll
            for (int j = 0; j < 8; ++j) { g8[j] = *(const f32x4*)(INP(26) + l * D + 4 * lane + 256 * j); b8[j] = *(const f32x4*)(INP(27) + l * D + 4 * lane + 256 * j); }
            float* dst = (l == 3) ? P.out : (float*)nullptr; const bf16_t* ysb = (const bf16_t*)yslot;
            for (int m0 = gw; m0 < M; m0 += 2 * NGW) {
                const int m1 = m0 + NGW; const bool has1 = m1 < M; const int m1c = has1 ? m1 : m0;
                f32x4 va[8], vb[8];
                if (!moe) {
#pragma unroll
                    for (int j = 0; j < 8; ++j) { const int c = 4 * lane + 256 * j;
                        va[j] = ALPHA * ld_bf4(xb + (size_t)m0 * D + c) + ld_bf4(ysb + (size_t)m0 * FLD + c);
                        vb[j] = ALPHA * ld_bf4(xb + (size_t)m1c * D + c) + ld_bf4(ysb + (size_t)m1c * FLD + c); }
                } else {
                    const int a0 = tok_dest[2 * m0], a1 = tok_dest[2 * m0 + 1], c0 = tok_dest[2 * m1c], c1 = tok_dest[2 * m1c + 1];
                    const float ga0 = tok_g[2 * m0], ga1 = tok_g[2 * m0 + 1], gc0 = tok_g[2 * m1c], gc1 = tok_g[2 * m1c + 1];
#pragma unroll
                    for (int j = 0; j < 8; ++j) { const int c = 4 * lane + 256 * j;
                        va[j] = ALPHA * ld_bf4(xb + (size_t)m0 * D + c) + ga0 * ld_bf4(ysb + (size_t)a0 * FLD + c) + ga1 * ld_bf4(ysb + (size_t)a1 * FLD + c);
                        vb[j] = ALPHA * ld_bf4(xb + (size_t)m1c * D + c) + gc0 * ld_bf4(ysb + (size_t)c0 * FLD + c) + gc1 * ld_bf4(ysb + (size_t)c1 * FLD + c); }
                }
                ln_finish(va, g8, b8, lane, dst ? dst + (size_t)m0 * D : (float*)nullptr, (l == 3) ? (bf16_t*)nullptr : xb + (size_t)m0 * D);
                if (has1) ln_finish(vb, g8, b8, lane, dst ? dst + (size_t)m1 * D : (float*)nullptr, (l == 3) ? (bf16_t*)nullptr : xb + (size_t)m1 * D);
            }
            SEAM(pb + 10);
        }
    }
    if (MK_TS_MASK != 0 && bx0 == 0 && tid0 < 64) {
        const unsigned long long t_end = __builtin_amdgcn_s_memrealtime() + (unsigned long long)MK_TS_MULT * ts_acc;
        while (__builtin_amdgcn_s_memrealtime() < t_end) __builtin_amdgcn_s_sleep(32);
    }
#undef IN
#undef SEAM
}
#undef PH_BEGIN
#undef CVT_MIXER_WEIGHTS
#undef INP
#undef Win_t
#undef Wout_t
#undef Wffn
#undef Wl_w
#undef Wl_a
#undef Wl_g
#undef Wl_v
#undef xf
#undef xb
#undef projb
#undef ymixb
#undef mixed
#undef hbuf
#undef xg
#undef yslot
#undef xbcc
#undef dtb
#undef yssd
#undef lw
#undef yrw
#undef bon
#undef vfirst
#undef tok_e
#undef tok_pos
#undef tok_g
#undef tok_dest
#undef src_row
#undef cnt


}

extern "C" void kernel_launch(void* const* d_in, const int* in_sizes, int n_in, void* d_out, int out_size, void* d_ws, size_t ws_size, hipStream_t stream) {
    (void)in_sizes; (void)out_size;
    static int grid = 0;
    if (grid == 0) {
        if (n_in != 35 || ws_size < WS_END) { fprintf(stderr, "kernel_launch: need 35 inputs and %zu bytes of workspace (got %d, %zu)\n", (size_t)WS_END, n_in, ws_size); grid = -1; return; }
        int dev = 0, cus = 0;
        if (hipGetDevice(&dev) != hipSuccess || hipDeviceGetAttribute(&cus, hipDeviceAttributeMultiprocessorCount, dev) != hipSuccess) { grid = -1; return; }
        if (hipFuncSetAttribute((const void*)fwd, hipFuncAttributeMaxDynamicSharedMemorySize, LDS_BYTES) != hipSuccess) { fprintf(stderr, "kernel_launch: hipFuncSetAttribute failed\n"); grid = -1; return; }
        int per_cu = 0;
        if (hipOccupancyMaxActiveBlocksPerMultiprocessor(&per_cu, (const void*)fwd, NWAVES * 64, LDS_BYTES) != hipSuccess || per_cu < 1) { fprintf(stderr, "kernel_launch: occupancy query says %d blocks per CU\n", per_cu); }
        (void)hipGetLastError();
        grid = cus;
    }
    if (grid < 0) return;
    unsigned char* ws = (unsigned char*)d_ws;
    (void)hipMemsetAsync(ws + WS_CTL, 0, CTL_BYTES, stream);
    Params P{};
    for (int i = 0; i < 35; ++i) P.in[i] = (const float*)d_in[i];
    P.out = (float*)d_out; P.ws = ws; P.pad = 0;
    int nbar = 0;
    auto run = [&](int lo, int hi) {
        P.ph_lo = lo; P.ph_hi = hi; P.bar_idx = (hi - lo > 1) ? nbar++ : 0;
        hipLaunchKernelGGL(fwd, dim3(grid), dim3(NWAVES * 64), LDS_BYTES, stream, P);
    };
    if (MK_LAUNCH_MODE == 1) run(0, 64);
    else if (MK_LAUNCH_MODE == 4) { for (int l = 0; l < 4; ++l) run(l * 16, l * 16 + 16); }
    else { for (int l = 0; l < 4; ++l) for (int k = 0; k <= 10; ++k) run(l * 16 + k, l * 16 + k + 1); }
}
```

```cpp
#define MK_TS_MASK 0
#include <hip/hip_runtime.h>
#include <cstdint>
#include <cstdio>

#ifndef MK_DBL
#define MK_DBL 0
#endif
#ifndef MK_CV_CUT_MOE
#define MK_CV_CUT_MOE 16896
#endif
#ifndef MK_CV_CUT_DENSE
#define MK_CV_CUT_DENSE 16896
#endif
#ifndef MK_RWKV_CHUNKED
#define MK_RWKV_CHUNKED 2
#endif
#ifndef MK_GEMM_8PH
#define MK_GEMM_8PH 0
#endif
#ifndef MK_LAUNCH_MODE
#define MK_LAUNCH_MODE 1
#endif
namespace {
constexpr int BATCH = 8, SEQ = 2048, M = BATCH * SEQ, D = 2048;
constexpr int HD = 64, SSD_H = 16, SSD_N = 128, CONV_DIM = 1536;
constexpr int RW_H = 16;
constexpr int IN_DIM = 5936, PROJ_LD = 5968;
constexpr int OFF_Z = 0, OFF_XBC = 1024, OFF_DT = 2560, OFF_RW = 2576, OFF_R = 2576, OFF_K = 3600, OFF_V = 4624, OFF_WLO = 5648, OFF_ALO = 5712, OFF_GLO = 5776, OFF_VLO = 5936;
constexpr int RW_SHIFT = 3360;
constexpr int DFF = 5632, NE = 8, DFE = 2816;
constexpr float ALPHA = 1.681792830507429f;
constexpr int LORA_LD = 320;

__device__ __forceinline__ float sigmoidf_(float x) { return 1.f / (1.f + expf(-x)); }
__device__ __forceinline__ float siluf_(float x) { return x / (1.f + expf(-x)); }
__device__ __forceinline__ float softplusf_(float x) { return fmaxf(x, 0.f) + log1pf(expf(-fabsf(x))); }
__device__ __forceinline__ float wave_sum(float v) {
#pragma unroll
    for (int o = 32; o >= 1; o >>= 1) v += __shfl_xor(v, o);
    return v;
}


#define LAS __attribute__((address_space(3)))
typedef unsigned short bf16_t;
typedef short bf16x8 __attribute__((ext_vector_type(8)));
typedef float f32x4 __attribute__((ext_vector_type(4)));
typedef float f32x2 __attribute__((ext_vector_type(2)));
typedef unsigned u32x4 __attribute__((ext_vector_type(4)));
typedef unsigned u32x2 __attribute__((ext_vector_type(2)));

typedef __bf16 bf16x2_t __attribute__((ext_vector_type(2)));
__device__ __forceinline__ unsigned cvt_pk_bf16(float lo, float hi) { const f32x2 v = {lo, hi}; const bf16x2_t b = __builtin_convertvector(v, bf16x2_t); return __builtin_bit_cast(unsigned, b); }
__device__ __forceinline__ float bf_lo(unsigned w) { return __uint_as_float(w << 16); }
__device__ __forceinline__ float bf_hi(unsigned w) { return __uint_as_float(w & 0xffff0000u); }
__device__ __forceinline__ float bf2f(bf16_t b) { return __uint_as_float(((unsigned)b) << 16); }
__device__ __forceinline__ float opaque0() { float z = 0.f; asm volatile("" : "+v"(z)); return z; }
#define ZERO4() ((f32x4){opaque0(), 0.f, 0.f, 0.f} * 0.f)
__device__ __forceinline__ float fast_silu(float x) { return x * __builtin_amdgcn_rcpf(1.f + __builtin_amdgcn_exp2f(-1.4426950408889634f * x)); }

namespace pg8 {
constexpr int BM = 256, BK = 64, HALF = 128, HTB = HALF * BK * 2, STAGE_BYTES = 8 * HTB, NXCD = 8, WGM = 8;
__host__ __device__ __forceinline__ int lds_byte(int r, int c) { const int st = (r >> 4) * 2 + (c >> 5), rr = r & 15, cc = c & 31, ob = rr * 64 + cc * 2; return st * 1024 + (ob ^ (((ob >> 9) & 1) << 5)); }
__host__ __device__ __forceinline__ void stage_rc(int b, int& R, int& C) { const int st = b / 1024, sb = b % 1024, swz = sb ^ (((sb >> 9) & 1) << 5); R = (st >> 1) * 16 + swz / 64; C = (st & 1) * 32 + (swz % 64) / 2; }
__host__ __device__ __forceinline__ int perm32(int rho) { const int n = rho >> 4, i = rho & 15; return 8 * (i >> 2) + 4 * n + (i & 3); }

struct Unit { int pm, pn, pb, rb, rv; };
constexpr int INVCAP = 16384;
struct Gemm { const bf16_t* A; const bf16_t* Bt; int K; const int* rowmap = nullptr; int nrows = 0; };

__device__ __forceinline__ void decode_unit(int wgid, int nM, int nN, int& pm, int& pn) {
    const int nwg = nM * nN;
    { const int q = nwg / NXCD, r = nwg % NXCD, xcd = wgid % NXCD, off = wgid / NXCD; wgid = (xcd < r ? xcd * (q + 1) : r * (q + 1) + (xcd - r) * q) + off; }
    const int nig = WGM * nN, gid = wgid / nig, fm = gid * WGM, gsz = (nM - fm) < WGM ? (nM - fm) : WGM;
    pm = fm + ((wgid % nig) % gsz); pn = (wgid % nig) / gsz;
}
struct StaticOrder {
    int nM, nN, nwg, G, c;
    __device__ void init(int Mrows, int N, int G_, int c_) { nM = Mrows / BM; nN = N / BM; nwg = nM * nN; G = G_; c = c_; }
    __device__ __forceinline__ bool next(int i, Unit& u) const {
        const long L = (long)i * G + c; if (L >= nwg) return false;
        decode_unit((int)L, nM, nN, u.pm, u.pn); u.pb = u.pn; return true;
    }
};
struct RepeatOrder : StaticOrder {
    int per, reps;
    __device__ void init2(int Mrows, int N, int G_, int c_, int reps_) { init(Mrows, N, G_, c_); per = (nwg + G - 1) / G; reps = reps_; }
    __device__ __forceinline__ bool next(int i, Unit& u) const { if (i >= per * reps) return false; return StaticOrder::next(i % per, u); }
};
struct GroupedOrder {
    int nM, nN, nwg, G, c; int cum[9];
    __device__ void init(const int* cnt, int N, int G_, int c_) {
        int acc = 0;
#pragma unroll
        for (int e = 0; e < 8; ++e) { cum[e] = acc; acc += (cnt[e] + 255) >> 8; }
        cum[8] = acc; nM = acc; nN = N / BM; nwg = nM * nN; G = G_; c = c_;
    }
    __device__ __forceinline__ bool next(int i, Unit& u) const {
        const long L = (long)i * G + c; if (L >= nwg) return false;
        decode_unit((int)L, nM, nN, u.pm, u.pn);
        int e = 0, lt = u.pm;
#pragma unroll
        for (int q = 1; q < 8; ++q) { const int d = u.pm - cum[q]; e += (d >= 0) ? 1 : 0; lt = (d >= 0) ? d : lt; }
        u.pb = e * nN + u.pn; u.rb = e * INVCAP + lt * BM; u.rv = 0; return true;
    }
};

struct EpiF32 {
    static constexpr bool PERM = false;
    float* C; int ldc;
    __device__ __forceinline__ void operator()(const f32x4 (&acc)[2][2][4][2], const Unit& u, int wr, int wc, int fr, int fq) const {
        const int row0 = u.pm * BM + wr * 64 + fr, col0 = u.pn * BM + wc * 32 + 4 * fq;
#pragma unroll
        for (int ai = 0; ai < 2; ++ai)
#pragma unroll
            for (int m = 0; m < 4; ++m) { float* rowp = C + (size_t)(row0 + ai * HALF + m * 16) * ldc + col0;
#pragma unroll
                for (int bj = 0; bj < 2; ++bj)
#pragma unroll
                    for (int n = 0; n < 2; ++n) *(f32x4*)(rowp + bj * HALF + n * 16) = acc[ai][bj][m][n]; }
    }
};
struct EpiBf16 {
    static constexpr bool PERM = true;
    bf16_t* O; int ldc;
    __device__ __forceinline__ void operator()(const f32x4 (&acc)[2][2][4][2], const Unit& u, int wr, int wc, int fr, int fq) const {
        const int row0 = u.pm * BM + wr * 64 + fr, col0 = u.pn * BM + wc * 32 + 8 * fq;
#pragma unroll
        for (int ai = 0; ai < 2; ++ai)
#pragma unroll
            for (int m = 0; m < 4; ++m) { bf16_t* rowp = O + (size_t)(row0 + ai * HALF + m * 16) * ldc + col0;
#pragma unroll
                for (int bj = 0; bj < 2; ++bj) { const f32x4 v0 = acc[ai][bj][m][0], v1 = acc[ai][bj][m][1];
                    u32x4 w; w.x = cvt_pk_bf16(v0[0], v0[1]); w.y = cvt_pk_bf16(v0[2], v0[3]); w.z = cvt_pk_bf16(v1[0], v1[1]); w.w = cvt_pk_bf16(v1[2], v1[3]);
                    *(u32x4*)(rowp + bj * HALF) = w; } }
    }
};
struct EpiSwiglu {
    static constexpr bool PERM = true;
    bf16_t* O; int ldc;
    __device__ __forceinline__ void operator()(const f32x4 (&acc)[2][2][4][2], const Unit& u, int wr, int wc, int fr, int fq) const {
        const int row0 = u.pm * BM + wr * 64 + fr, col0 = u.pn * HALF + wc * 32 + 8 * fq;
#pragma unroll
        for (int ai = 0; ai < 2; ++ai)
#pragma unroll
            for (int m = 0; m < 4; ++m) { bf16_t* rowp = O + (size_t)(row0 + ai * HALF + m * 16) * ldc + col0;
                float o[8];
#pragma unroll
                for (int n = 0; n < 2; ++n)
#pragma unroll
                    for (int i = 0; i < 4; ++i) o[n * 4 + i] = fast_silu(acc[ai][0][m][n][i]) * acc[ai][1][m][n][i];
                u32x4 w; w.x = cvt_pk_bf16(o[0], o[1]); w.y = cvt_pk_bf16(o[2], o[3]); w.z = cvt_pk_bf16(o[4], o[5]); w.w = cvt_pk_bf16(o[6], o[7]);
                *(u32x4*)rowp = w; }
    }
};

template <class Epi, class Sched, bool GATHER = false>
__device__ __forceinline__ void gemm_phase(LAS unsigned char* lds, const Gemm g, const Sched& S, const Epi& E, const int tid) {
    const int wid = __builtin_amdgcn_readfirstlane(tid >> 6), lane = tid & 63, wr = wid >> 2, wc = wid & 3, fr = lane & 15, fq = lane >> 4;
    const int K = g.K, nt = K / BK;
    unsigned voffA[2], voffB[2];
#pragma unroll
    for (int i = 0; i < 2; ++i) { int R, C; stage_rc(tid * 16 + i * 8192, R, C); const int Rb = Epi::PERM ? ((R & ~31) + perm32(R & 31)) : R;
        voffA[i] = (unsigned)(R * K + C) * 2u; voffB[i] = (unsigned)(Rb * K + C) * 2u; }
    unsigned goC[2][2], goN[2][2];
#define PG8_GLOOK(dst, unit_) do { _Pragma("unroll") for (int h_ = 0; h_ < 2; ++h_) _Pragma("unroll") for (int i_ = 0; i_ < 2; ++i_) { int R_, C_; stage_rc(tid * 16 + i_ * 8192, R_, C_); \
        const int r_ = h_ * HALF + R_; int ix_ = g.rowmap[(unit_).rb + r_]; ix_ = ((unsigned)ix_ < (unsigned)g.nrows) ? ix_ : 0;     dst[h_][i_] = (unsigned)(ix_ * K + C_) * 2u; } } while (0)
#define PG8_STAGE_G(bufoff, kb_, go_, h_) do { _Pragma("unroll") for (int _i = 0; _i < 2; ++_i) \
        __builtin_amdgcn_global_load_lds((const unsigned*)((const char*)g.A + (kb_) + (go_)[h_][_i]), (LAS unsigned*)(lds + (bufoff) + ldsw + _i * 8192), 16, 0, 0); } while (0)
#define PG8_STAGE_A(bufoff, base_, nx_, kb_, h_) do { if (GATHER) { if (nx_) PG8_STAGE_G(bufoff, kb_, goN, h_); else PG8_STAGE_G(bufoff, kb_, goC, h_); } \
        else PG8_STAGE(bufoff, (base_) + (kb_) + (h_) * hstep, voffA); } while (0)
    const size_t kstep = (size_t)(BK * 2);
    const size_t hstep = (size_t)HALF * K * 2;
    const size_t tstep = 2 * hstep;
    const unsigned ldsw = (unsigned)wid * 1024u;
    const int aoff = lds_byte(wr * 64 + fr, fq * 8), boff = lds_byte(wc * 32 + fr, fq * 8);
#define PG8_SA(b, h) (((b) * 2 + (h)) * HTB)
#define PG8_SB(b, h) ((4 + (b) * 2 + (h)) * HTB)
#define PG8_STAGE(bufoff, gbase, voff) do { _Pragma("unroll") for (int _i = 0; _i < 2; ++_i) \
        __builtin_amdgcn_global_load_lds((const unsigned*)((const char*)(gbase) + (voff)[_i]), (LAS unsigned*)(lds + (bufoff) + ldsw + _i * 8192), 16, 0, 0); } while (0)
#define PG8_LDA(dst, b, h) do { _Pragma("unroll") for (int m = 0; m < 4; ++m) _Pragma("unroll") for (int k = 0; k < 2; ++k) dst[m][k] = *(const LAS bf16x8*)(lds + PG8_SA(b, h) + aoff + m * 2048 + k * 1024); } while (0)
#define PG8_LDB(dst, b, h) do { _Pragma("unroll") for (int n = 0; n < 2; ++n) _Pragma("unroll") for (int k = 0; k < 2; ++k) dst[n][k] = *(const LAS bf16x8*)(lds + PG8_SB(b, h) + boff + n * 2048 + k * 1024); } while (0)
#define PG8_MMA(ai, bj, At, Bt) do { __builtin_amdgcn_s_setprio(1); _Pragma("unroll") for (int m = 0; m < 4; ++m) _Pragma("unroll") for (int n = 0; n < 2; ++n) _Pragma("unroll") for (int k = 0; k < 2; ++k) \
        acc[ai][bj][m][n] = __builtin_amdgcn_mfma_f32_16x16x32_bf16(Bt[n][k], At[m][k], acc[ai][bj][m][n], 0, 0, 0); __builtin_amdgcn_s_setprio(0); } while (0)
#define PG8_WAIT_V(n) asm volatile("s_waitcnt vmcnt(" #n ")" ::: "memory")
#define PG8_WAIT_L(n) asm volatile("s_waitcnt lgkmcnt(" #n ")" ::: "memory")
#define PG8_BAR __builtin_amdgcn_s_barrier()
#define PG8_SCHED __builtin_amdgcn_sched_barrier(0)
    Unit cur, nxt; int ui = 0;
    if (!S.next(0, cur)) return;
    f32x4 acc[2][2][4][2];
#pragma unroll
    for (int a = 0; a < 2; ++a)
#pragma unroll
        for (int b = 0; b < 2; ++b)
#pragma unroll
            for (int m = 0; m < 4; ++m)
#pragma unroll
                for (int n = 0; n < 2; ++n) acc[a][b][m][n] = ZERO4();
    bf16x8 At[4][2], B0[2][2], B1[2][2];
    const char* cA = (const char*)g.A + (size_t)cur.pm * tstep; const char* cB = (const char*)g.Bt + (size_t)cur.pb * tstep;
#if MK_GEMM_8PH
    PG8_STAGE(PG8_SB(0, 0), cB, voffB); PG8_STAGE(PG8_SA(0, 0), cA, voffA); PG8_STAGE(PG8_SB(0, 1), cB + hstep, voffB); PG8_STAGE(PG8_SA(0, 1), cA + hstep, voffA);
    if (wr == 1) PG8_BAR;
    PG8_WAIT_V(4); PG8_BAR;
    PG8_STAGE(PG8_SB(1, 0), cB + kstep, voffB); PG8_STAGE(PG8_SA(1, 0), cA + kstep, voffA); PG8_STAGE(PG8_SB(1, 1), cB + hstep + kstep, voffB);
    PG8_WAIT_V(6); PG8_BAR;
#else
    if (GATHER) { PG8_GLOOK(goC, cur); PG8_GLOOK(goN, cur); }
    PG8_STAGE(PG8_SB(0, 0), cB, voffB); PG8_STAGE(PG8_SB(0, 1), cB + hstep, voffB); PG8_STAGE_A(PG8_SA(0, 0), cA, false, 0, 0); PG8_STAGE_A(PG8_SA(0, 1), cA, false, 0, 1);
    if (wr == 1) PG8_BAR;
    PG8_WAIT_V(2); PG8_BAR;
    PG8_STAGE(PG8_SB(1, 0), cB + kstep, voffB); PG8_STAGE_A(PG8_SA(1, 0), cA, false, kstep, 0); PG8_STAGE(PG8_SB(1, 1), cB + hstep + kstep, voffB);
    PG8_WAIT_V(6); PG8_BAR;
#endif
    for (;;) {
        const bool has_next = S.next(ui + 1, nxt);
        const char* nA = has_next ? (const char*)g.A + (size_t)nxt.pm * tstep : cA; const char* nB = has_next ? (const char*)g.Bt + (size_t)nxt.pb * tstep : cB;
        if (GATHER && has_next && wid < 4) __builtin_amdgcn_global_load_lds((const unsigned*)(g.rowmap + nxt.rb + tid), (LAS unsigned*)(lds + STAGE_BYTES + ((ui + 1) & 1) * 1024 + wid * 256), 4, 0, 0);
        for (int t = 0; t < nt; t += 2) {
            const bool last = (t == nt - 2);
            const char* a1 = cA + (size_t)(t + 1) * kstep;
            const char* a2 = last ? nA : cA + (size_t)(t + 2) * kstep; const char* b2 = last ? nB : cB + (size_t)(t + 2) * kstep;
            const char* a3 = a2 + kstep; const char* b3 = b2 + kstep;
#if MK_GEMM_8PH
            PG8_LDB(B0, 0, 0); PG8_SCHED; PG8_LDA(At, 0, 0); PG8_STAGE(PG8_SA(1, 1), a1 + hstep, voffA);
            PG8_WAIT_L(8); PG8_BAR; PG8_WAIT_L(0); PG8_MMA(0, 0, At, B0); PG8_BAR; PG8_SCHED;
            PG8_LDB(B1, 0, 1); PG8_STAGE(PG8_SB(0, 0), b2, voffB);
            PG8_BAR; PG8_WAIT_L(0); PG8_MMA(0, 1, At, B1); PG8_BAR;
            PG8_LDA(At, 0, 1); PG8_STAGE(PG8_SA(0, 0), a2, voffA);
            PG8_BAR; PG8_WAIT_L(0); PG8_MMA(1, 0, At, B0); PG8_BAR; PG8_SCHED;
            PG8_STAGE(PG8_SB(0, 1), b2 + hstep, voffB);
            PG8_WAIT_V(6); PG8_BAR; PG8_MMA(1, 1, At, B1); PG8_BAR;
            PG8_LDB(B0, 1, 0); PG8_SCHED; PG8_LDA(At, 1, 0); PG8_STAGE(PG8_SA(0, 1), a2 + hstep, voffA);
            PG8_WAIT_L(8); PG8_BAR; PG8_WAIT_L(0); PG8_MMA(0, 0, At, B0); PG8_BAR; PG8_SCHED;
            PG8_LDB(B1, 1, 1); PG8_STAGE(PG8_SB(1, 0), b3, voffB);
            PG8_BAR; PG8_WAIT_L(0); PG8_MMA(0, 1, At, B1); PG8_BAR;
            PG8_LDA(At, 1, 1); PG8_STAGE(PG8_SA(1, 0), a3, voffA);
            PG8_BAR; PG8_WAIT_L(0); PG8_MMA(1, 0, At, B0); PG8_BAR; PG8_SCHED;
            PG8_STAGE(PG8_SB(1, 1), b3 + hstep, voffB);
            PG8_WAIT_V(6); PG8_BAR; PG8_MMA(1, 1, At, B1); PG8_BAR;
#else
            if (GATHER && last && has_next) {
                const LAS int* ib_ = (const LAS int*)(lds + STAGE_BYTES + ((ui + 1) & 1) * 1024);
#pragma unroll
                for (int h_ = 0; h_ < 2; ++h_)
#pragma unroll
                    for (int i_ = 0; i_ < 2; ++i_) { int R_, C_; stage_rc(tid * 16 + i_ * 8192, R_, C_); const int r_ = h_ * HALF + R_; int ix_ = ib_[r_]; ix_ = ((unsigned)ix_ < (unsigned)g.nrows) ? ix_ : 0; goN[h_][i_] = (unsigned)(ix_ * K + C_) * 2u; }
            }
            const size_t kb1 = (size_t)(t + 1) * kstep, kb2 = last ? (size_t)0 : (size_t)(t + 2) * kstep, kb3 = kb2 + kstep;
            PG8_LDB(B0, 0, 0); PG8_LDB(B1, 0, 1); PG8_SCHED; PG8_LDA(At, 0, 0); PG8_STAGE_A(PG8_SA(1, 1), cA, false, kb1, 1);
            PG8_WAIT_V(8); PG8_WAIT_L(0); PG8_BAR; PG8_MMA(0, 0, At, B0); PG8_MMA(0, 1, At, B1); PG8_BAR; PG8_SCHED;
            PG8_LDA(At, 0, 1); PG8_STAGE(PG8_SB(0, 0), b2, voffB); PG8_STAGE(PG8_SB(0, 1), b2 + hstep, voffB); PG8_STAGE_A(PG8_SA(0, 0), (last ? nA : cA), last, kb2, 0);
            PG8_WAIT_V(8); PG8_WAIT_L(0); PG8_BAR; PG8_MMA(1, 0, At, B0); PG8_MMA(1, 1, At, B1); PG8_BAR; PG8_SCHED;
            PG8_LDB(B0, 1, 0); PG8_LDB(B1, 1, 1); PG8_SCHED; PG8_LDA(At, 1, 0); PG8_STAGE_A(PG8_SA(0, 1), (last ? nA : cA), last, kb2, 1);
            PG8_WAIT_V(8); PG8_WAIT_L(0); PG8_BAR; PG8_MMA(0, 0, At, B0); PG8_MMA(0, 1, At, B1); PG8_BAR; PG8_SCHED;
            PG8_LDA(At, 1, 1); PG8_STAGE(PG8_SB(1, 0), b3, voffB); PG8_STAGE(PG8_SB(1, 1), b3 + hstep, voffB); PG8_STAGE_A(PG8_SA(1, 0), (last ? nA : cA), last, kb3, 0);
            PG8_WAIT_V(8); PG8_WAIT_L(0); PG8_BAR; PG8_MMA(1, 0, At, B0); PG8_MMA(1, 1, At, B1); PG8_BAR; PG8_SCHED;
#endif
        }
        if (wr == 0) PG8_BAR;
        E(acc, cur, wr, wc, fr, fq);
        if (!has_next) break;
#pragma unroll
        for (int a = 0; a < 2; ++a)
#pragma unroll
            for (int b = 0; b < 2; ++b)
#pragma unroll
                for (int m = 0; m < 4; ++m)
#pragma unroll
                    for (int n = 0; n < 2; ++n) acc[a][b][m][n] = ZERO4();
        cur = nxt; cA = nA; cB = nB; ++ui;
        if (GATHER) {
#pragma unroll
            for (int h_ = 0; h_ < 2; ++h_) { goC[h_][0] = goN[h_][0]; goC[h_][1] = goN[h_][1]; } }
        if (wr == 1) PG8_BAR;
    }
    PG8_WAIT_V(0);
    PG8_BAR;
#undef PG8_SA
#undef PG8_SB
#undef PG8_STAGE
#undef PG8_STAGE_A
#undef PG8_STAGE_G
#undef PG8_GLOOK
#undef PG8_LDA
#undef PG8_LDB
#undef PG8_MMA
#undef PG8_WAIT_V
#undef PG8_WAIT_L
#undef PG8_BAR
#undef PG8_SCHED
}
}

#define XB_TMO      128
#define XB_XCNT(j)  (256  + 64 * (j))
#define XB_XSUB(j)  (1280 + 64 * (j))
#define XB_XGEN(j)  (2304 + 64 * (j))
#define XB_TOP      3328
#define XB_TOPGEN   3392
#define XCD_BAR_WORDS 3456
#define XB_SPIN_CAP (1u << 18)
__device__ __forceinline__ unsigned xb_ld(unsigned* p)              { return __hip_atomic_load(p, __ATOMIC_RELAXED, __HIP_MEMORY_SCOPE_AGENT); }
__device__ __forceinline__ unsigned xb_add(unsigned* p, unsigned v) { return __hip_atomic_fetch_add(p, v, __ATOMIC_RELAXED, __HIP_MEMORY_SCOPE_AGENT); }
__device__ __forceinline__ unsigned xb_xcc_id() { return (unsigned)__builtin_amdgcn_s_getreg((3 << 11) | 20) & 0xFu; }
#define XB_SPIN(cond, bar) do { unsigned _sp = 0; while (cond) { __builtin_amdgcn_s_sleep(1); \
    if ((++_sp & 255u) == 0u) { if (xb_ld(&(bar)[XB_TMO])) break; if (_sp > XB_SPIN_CAP) { atomicAdd(&(bar)[XB_TMO], 1u); break; } } } } while (0)
struct XcdBarrier { unsigned* bar; unsigned x; volatile LAS unsigned* st; };
__device__ __forceinline__ XcdBarrier xcd_barrier_post(unsigned* bar, volatile LAS unsigned* st) {
    XcdBarrier b; b.bar = bar; b.x = xb_xcc_id(); b.st = st;
    if (threadIdx.x == 0) (void)xb_add(&bar[XB_XCNT(b.x)], 1u);
    return b;
}
__device__ __forceinline__ void xcd_barrier_complete(unsigned* bar, unsigned x, unsigned& nloc, unsigned& nx) {
    const unsigned G = gridDim.x * gridDim.y * gridDim.z;
    asm volatile("" : "+s"(x));
    unsigned sum, cnt, mine, sp = 0u;
    for (;;) {
        sum = 0u; cnt = 0u; mine = 0u;
#pragma unroll
        for (unsigned j = 0; j < 16; ++j) { const unsigned c = xb_ld(&bar[XB_XCNT(j)]); sum += c; cnt += (c > 0u) ? 1u : 0u; mine = (j == x) ? c : mine; }
        if (sum == G) break;
        __builtin_amdgcn_s_sleep(1);
        if ((++sp & 255u) == 0u) { if (xb_ld(&bar[XB_TMO])) break; if (sp > XB_SPIN_CAP) { atomicAdd(&bar[XB_TMO], 1u); break; } }
    }
    nloc = mine > 0u ? mine : 1u; nx = cnt > 0u ? cnt : 1u;
}
__device__ __forceinline__ void xcd_barrier(const XcdBarrier& b) {
    asm volatile("s_waitcnt vmcnt(0)" ::: "memory");
    __syncthreads();
    if (threadIdx.x == 0) {
        unsigned* bar = b.bar;
        __builtin_amdgcn_s_waitcnt(0);
        unsigned nloc = b.st[0], nx = b.st[1];
        if (nloc == 0u) { xcd_barrier_complete(bar, b.x, nloc, nx); b.st[0] = nloc; b.st[1] = nx; }
        const unsigned old = xb_add(&bar[XB_XSUB(b.x)], 1u);
        const unsigned gen = old / nloc;
        if (old + 1u == (gen + 1u) * nloc) {
            __builtin_amdgcn_fence(__ATOMIC_RELEASE, "agent");
            asm volatile("s_waitcnt vmcnt(0)" ::: "memory");
            const unsigned og = xb_add(&bar[XB_TOP], 1u);
            const unsigned tg = og / nx;
            if (og + 1u == (tg + 1u) * nx) xb_add(&bar[XB_TOPGEN], 1u);
            else XB_SPIN(xb_ld(&bar[XB_TOPGEN]) == tg, bar);
            __builtin_amdgcn_fence(__ATOMIC_ACQUIRE, "agent");
            xb_add(&bar[XB_XGEN(b.x)], 1u);
            asm volatile("s_waitcnt vmcnt(0)" ::: "memory");
        } else {
            XB_SPIN(xb_ld(&bar[XB_XGEN(b.x)]) == gen, bar);
            __builtin_amdgcn_fence(__ATOMIC_ACQUIRE, "agent");
            asm volatile("s_waitcnt vmcnt(0)" ::: "memory");
        }
    }
    __syncthreads();
}

constexpr size_t MiB = 1u << 20;
constexpr int NWAVES = 8;
constexpr int PROJ_BLD = 6144;
constexpr int PMAX = 34816;
constexpr int FLD = 2048 + 64;
constexpr size_t WS_CTL = 0, CTL_BYTES = 1 * MiB;
constexpr size_t WS_WIN = 1 * MiB, WS_WOUT = 25 * MiB, WS_WLORA = 33 * MiB;
constexpr size_t WS_XF = 34 * MiB, WS_XB = 162 * MiB, WS_VFIRST = 226 * MiB, WS_YMIXB = 290 * MiB, WS_TOK = 354 * MiB, WS_SCR = 356 * MiB;
constexpr size_t WS_PROJB = WS_SCR, WS_LW = WS_PROJB + 192 * MiB, WS_YRW = WS_LW + 128 * MiB, WS_BON = WS_YRW + 64 * MiB, WS_XBCC = WS_BON + 64 * MiB, WS_DTB = WS_XBCC + 48 * MiB, WS_YSSD = WS_DTB + 1 * MiB, WS_MIXED = WS_YSSD + 64 * MiB;
constexpr size_t WS_HBUF = WS_SCR, WS_XG = WS_HBUF + 187 * MiB, WS_YSLOT = WS_XG + 136 * MiB;
constexpr size_t WS_WFFN = WS_SCR + 860 * MiB, WS_END = WS_WFFN + 264 * MiB;
constexpr size_t WS_IMG = WS_MIXED;
static_assert(WS_MIXED + 132 * MiB <= WS_WFFN && WS_YSLOT + 281 * MiB <= WS_WFFN, "scratch inside the map");
static_assert((size_t)PMAX * DFE * 2 <= 187 * MiB && (size_t)PMAX * D * 2 <= 136 * MiB && (size_t)PMAX * FLD * 4 <= 281 * MiB && (size_t)M * FLD * 4 <= 132 * MiB, "moe buffers");
constexpr int CW_CNT = 16;
constexpr int CW_BAR = 4096;
constexpr int MAX_BAR_REGIONS = 48;
static_assert((CW_BAR + MAX_BAR_REGIONS * XCD_BAR_WORDS) * 4 <= (int)CTL_BYTES, "ctl");
constexpr int RING_BYTES = 131072, LDS_BYTES = 147456, MISC_OFF = LDS_BYTES - 256;

struct Params { const float* in[35]; float* out; unsigned char* ws; int ph_lo, ph_hi, bar_idx, pad; };

__device__ __forceinline__ float wave_sum_f(float v) {
#pragma unroll
    for (int o = 32; o >= 1; o >>= 1) v += __shfl_xor(v, o);
    return v;
}

__device__ __forceinline__ void cvt_item(const float* W, int K, int N, bf16_t* WT, int dst_row0, LAS float* scr, int k0, int n0, int lane) {
    const int kr = lane >> 3, c4 = (lane & 7) * 4;
    f32x4 v[8];
    if (n0 + 32 <= N && k0 + 64 <= K) {
#pragma unroll
        for (int i = 0; i < 8; ++i) v[i] = *(const f32x4*)(W + (size_t)(k0 + 8 * i + kr) * N + n0 + c4);
    } else {
#pragma unroll
        for (int i = 0; i < 8; ++i) { const int kk = k0 + 8 * i + kr;
#pragma unroll
            for (int e = 0; e < 4; ++e) v[i][e] = (kk < K && n0 + c4 + e < N) ? W[(size_t)kk * N + n0 + c4 + e] : 0.f; }
    }
#pragma unroll
    for (int i = 0; i < 8; ++i) { LAS float* d = scr + (8 * i + kr) * 33 + c4; d[0] = v[i][0]; d[1] = v[i][1]; d[2] = v[i][2]; d[3] = v[i][3]; }
    asm volatile("s_waitcnt lgkmcnt(0)" ::: "memory");
    const int c = lane & 7;
#pragma unroll
    for (int j = 0; j < 4; ++j) { const int n = (lane >> 3) + 8 * j; const LAS float* s = scr + (8 * c) * 33 + n;
        u32x4 o; o.x = cvt_pk_bf16(s[0 * 33], s[1 * 33]); o.y = cvt_pk_bf16(s[2 * 33], s[3 * 33]); o.z = cvt_pk_bf16(s[4 * 33], s[5 * 33]); o.w = cvt_pk_bf16(s[6 * 33], s[7 * 33]);
        if (n0 + n < N && k0 + 8 * c < K) *(u32x4*)(WT + (size_t)(dst_row0 + n) * K + k0 + 8 * c) = o; }
    asm volatile("s_waitcnt lgkmcnt(0)" ::: "memory");
}
template <int MODE>
__device__ __forceinline__ void cvt_job(const float* W, int K, int N, bf16_t* WT, int row_off, int half, LAS float* scr, int gw, int ngw, int lane) {
    const int nkb = (K + 63) / 64, nnb = (N + 31) / 32, nitems = nkb * nnb;
    for (int it = gw; it < nitems; it += ngw) {
        const int kb = it / nnb, nb = it % nnb, n0 = nb * 32;
        const int dr = MODE == 0 ? row_off + n0 : row_off + 256 * (n0 / 128) + half * 128 + (n0 % 128);
        cvt_item(W, K, N, WT, dr, scr, kb * 64, n0, lane);
    }
}

#define DPP_ROR(z, n) __uint_as_float(__builtin_amdgcn_update_dpp(0u, __float_as_uint(z), 0x120 + (n), 0xf, 0xf, false))
__device__ __forceinline__ float wave_allsum(float x) {
    { auto s = __builtin_amdgcn_permlane32_swap(__float_as_uint(x), __float_as_uint(x), false, false); x = __uint_as_float(s[0]) + __uint_as_float(s[1]); }
    { auto s = __builtin_amdgcn_permlane16_swap(__float_as_uint(x), __float_as_uint(x), false, false); x = __uint_as_float(s[0]) + __uint_as_float(s[1]); }
    x += DPP_ROR(x, 8); x += DPP_ROR(x, 4); x += DPP_ROR(x, 2); x += DPP_ROR(x, 1);
    return x;
}
__device__ __forceinline__ float reduce4(float x0, float x1, float x2, float x3) {
    float y0, y1, z;
    { auto s = __builtin_amdgcn_permlane32_swap(__float_as_uint(x0), __float_as_uint(x2), false, false); y0 = __uint_as_float(s[0]) + __uint_as_float(s[1]); }
    { auto s = __builtin_amdgcn_permlane32_swap(__float_as_uint(x1), __float_as_uint(x3), false, false); y1 = __uint_as_float(s[0]) + __uint_as_float(s[1]); }
    { auto s = __builtin_amdgcn_permlane16_swap(__float_as_uint(y0), __float_as_uint(y1), false, false); z = __uint_as_float(s[0]) + __uint_as_float(s[1]); }
    z += DPP_ROR(z, 8); z += DPP_ROR(z, 4); z += DPP_ROR(z, 2); z += DPP_ROR(z, 1);
    return z;
}
__device__ __forceinline__ float rdlane(float v, int l) { return __int_as_float(__builtin_amdgcn_readlane(__float_as_int(v), l)); }
__device__ __forceinline__ f32x4 ld_bf4(const bf16_t* p) { const u32x2 w = *(const u32x2*)p; return (f32x4){bf_lo(w.x), bf_hi(w.x), bf_lo(w.y), bf_hi(w.y)}; }
__device__ __forceinline__ void ln_finish(f32x4 (&v)[8], const f32x4 (&g8)[8], const f32x4 (&b8)[8], int lane, float* xf_row, bf16_t* xb_row) {
    float s = 0.f;
#pragma unroll
    for (int j = 0; j < 8; ++j) s += (v[j][0] + v[j][1]) + (v[j][2] + v[j][3]);
    const float mean = wave_allsum(s) * (1.f / D);
    float q = 0.f;
#pragma unroll
    for (int j = 0; j < 8; ++j) { v[j] = v[j] - mean; q += (v[j][0] * v[j][0] + v[j][1] * v[j][1]) + (v[j][2] * v[j][2] + v[j][3] * v[j][3]); }
    const float rstd = rsqrtf(wave_allsum(q) * (1.f / D) + 1e-5f);
#pragma unroll
    for (int j = 0; j < 8; ++j) { const int c = 4 * lane + 256 * j;
        v[j] = v[j] * rstd * g8[j] + b8[j];
        if (xf_row) *(f32x4*)(xf_row + c) = v[j];
        if (xb_row) { u32x2 w; w.x = cvt_pk_bf16(v[j][0], v[j][1]); w.y = cvt_pk_bf16(v[j][2], v[j][3]); *(u32x2*)(xb_row + c) = w; } }
}

__device__ __forceinline__ float fast_sigmoid(float x) { return __builtin_amdgcn_rcpf(1.f + __builtin_amdgcn_exp2f(-1.4426950408889634f * x)); }
__device__ __forceinline__ float fast_tanh(float x) { return 1.f - 2.f * __builtin_amdgcn_rcpf(1.f + __builtin_amdgcn_exp2f(2.8853900817779268f * x)); }

constexpr int LORA_PITCH = 328;
__device__ __forceinline__ void lora_phase(LAS unsigned char* lds, const bf16_t* projb, const float* mix, const float* vmix, const bf16_t* Wl_w, const bf16_t* Wl_a, const bf16_t* Wl_g, const bf16_t* Wl_v,
                                           bf16_t* lw, const bool has_v, const int vcu, const int G, const int tid) {
    const int wave = __builtin_amdgcn_readfirstlane(tid >> 6), lane = tid & 63, fr = lane & 15, fq = lane >> 4;
    LAS bf16_t* Aimg = (LAS bf16_t*)lds;
    for (int u = vcu; u < M / 64; u += G) {
        {
            const int tau = tid >> 3, part = tid & 7, m = u * 64 + tau; const bool first = (m % SEQ) == 0;
#pragma unroll
            for (int i = 0; i < 5; ++i) {
                const int j0 = 40 * part + 8 * i;
                const u32x4 cur = *(const u32x4*)(projb + (size_t)m * PROJ_BLD + OFF_WLO + j0);
                u32x4 prv = (u32x4){0u, 0u, 0u, 0u};
                if (!first) prv = *(const u32x4*)(projb + (size_t)(m - 1) * PROJ_BLD + OFF_WLO + j0);
                f32x4 mx0, mx1;
                if (j0 < 288) { mx0 = *(const f32x4*)(mix + (OFF_WLO - OFF_RW) + j0); mx1 = *(const f32x4*)(mix + (OFF_WLO - OFF_RW) + j0 + 4); }
                else if (has_v) { mx0 = *(const f32x4*)(vmix + (j0 - 288)); mx1 = *(const f32x4*)(vmix + (j0 - 288) + 4); }
                else { mx0 = (f32x4){0.f, 0.f, 0.f, 0.f}; mx1 = mx0; }
                float o[8];
#pragma unroll
                for (int e = 0; e < 4; ++e) {
                    const float c0 = bf_lo(cur[e]), c1 = bf_hi(cur[e]), p0 = bf_lo(prv[e]), p1 = bf_hi(prv[e]);
                    const float m0 = (e < 2) ? mx0[2 * e] : mx1[2 * e - 4], m1 = (e < 2) ? mx0[2 * e + 1] : mx1[2 * e - 3];
                    o[2 * e] = c0 + (p0 - c0) * m0; o[2 * e + 1] = c1 + (p1 - c1) * m1;
                }
                if (j0 < 64) {
#pragma unroll
                    for (int e = 0; e < 8; ++e) o[e] = fast_tanh(o[e]);
                } else if (j0 >= 128 && j0 < 288) {
#pragma unroll
                    for (int e = 0; e < 8; ++e) o[e] = fast_sigmoid(o[e]);
                }
                u32x4 w; w.x = cvt_pk_bf16(o[0], o[1]); w.y = cvt_pk_bf16(o[2], o[3]); w.z = cvt_pk_bf16(o[4], o[5]); w.w = cvt_pk_bf16(o[6], o[7]);
                *(LAS u32x4*)(Aimg + tau * LORA_PITCH + j0) = w;
            }
        }
        __syncthreads();
        for (int q = 0; q < 4; ++q) {
            if (q == 3 && !has_v) break;
            const int K = (q == 2) ? 160 : (q == 3 ? 32 : 64), koff = (q == 0) ? 0 : (q == 1 ? 64 : (q == 2 ? 128 : 288));
            const bf16_t* W = (q == 0) ? Wl_w : (q == 1 ? Wl_a : (q == 2 ? Wl_g : Wl_v));
            f32x4 acc[8][4];
#pragma unroll
            for (int ct = 0; ct < 8; ++ct)
#pragma unroll
                for (int tt = 0; tt < 4; ++tt) acc[ct][tt] = (f32x4){0.f, 0.f, 0.f, 0.f};
            for (int ks = 0; ks < K / 32; ++ks) {
                bf16x8 af[8], bfr[4];
#pragma unroll
                for (int ct = 0; ct < 8; ++ct) af[ct] = *(const bf16x8*)(W + (size_t)(128 * wave + 32 * (ct >> 1) + 8 * (fr >> 2) + 4 * (ct & 1) + (fr & 3)) * K + 32 * ks + 8 * fq);
#pragma unroll
                for (int tt = 0; tt < 4; ++tt) bfr[tt] = *(const LAS bf16x8*)(Aimg + (16 * tt + fr) * LORA_PITCH + koff + 32 * ks + 8 * fq);
#pragma unroll
                for (int ct = 0; ct < 8; ++ct)
#pragma unroll
                    for (int tt = 0; tt < 4; ++tt) acc[ct][tt] = __builtin_amdgcn_mfma_f32_16x16x32_bf16(af[ct], bfr[tt], acc[ct][tt], 0, 0, 0);
            }
            bf16_t* out = lw + (size_t)q * M * 1024;
#pragma unroll
            for (int cp = 0; cp < 4; ++cp)
#pragma unroll
                for (int tt = 0; tt < 4; ++tt) { u32x4 w; w.x = cvt_pk_bf16(acc[2 * cp][tt][0], acc[2 * cp][tt][1]); w.y = cvt_pk_bf16(acc[2 * cp][tt][2], acc[2 * cp][tt][3]);
                    w.z = cvt_pk_bf16(acc[2 * cp + 1][tt][0], acc[2 * cp + 1][tt][1]); w.w = cvt_pk_bf16(acc[2 * cp + 1][tt][2], acc[2 * cp + 1][tt][3]);
                    *(u32x4*)(out + (size_t)(u * 64 + 16 * tt + fr) * 1024 + 128 * wave + 32 * cp + 8 * fq) = w; }
        }
        __syncthreads();
    }
}

struct RwScan { const bf16_t* proj_; const bf16_t* lw_; const float* mix; const float* w0; const float* a0; const float* v0; const float* k_k; const float* k_a; const float* r_k; float* vf_; bf16_t* y_; bf16_t* bon_; int layer; int pad;
                const float* cw1; const float* cw3; const float* cw2; bf16_t* cwt; int cmoe; int pad2; };
constexpr int RWB_A = 0, RWB_DR = 8192, RWB_D = 16384, RWB_B = 24576, RWB_K = 32768, RWB_BIG = 40960, RWS_V = 0, RWS_SC = 4096, RWS_SIZE = 4608, RW_SMALL = 2 * RWB_BIG, RW_YST = RW_SMALL + 3 * RWS_SIZE, RW_YST_SIZE = 4096, RW_CVT = RW_YST + 2 * RW_YST_SIZE, RW_TB = 32, RW_NCH = SEQ / RW_TB;
static_assert(RW_CVT + 4 * 8448 <= MISC_OFF, "rwkv scan LDS map");
__device__ __forceinline__ float rowsum16(float z) { z += DPP_ROR(z, 8); asm("" : "+v"(z)); z += DPP_ROR(z, 4); asm("" : "+v"(z)); z += DPP_ROR(z, 2); asm("" : "+v"(z)); z += DPP_ROR(z, 1); asm("" : "+v"(z)); return z; }
__device__ __forceinline__ void rwkv_scan_phase(LAS unsigned char* lds, const RwScan& a, const int vcu, const int G, const int tid) {
    const int wave = __builtin_amdgcn_readfirstlane(tid >> 6), lane = tid & 63, jj = lane & 15, rg = lane >> 4;
    for (int u = vcu; u < BATCH * RW_H * 2; u += G) {
        const int b = u >> 5, h = (u >> 1) & 15, half = u & 1;
        if (wave >= 4) {
            const int pw_ = wave - 4, c = h * 64 + lane, ptid = tid - 256;
            const float mix_r = a.mix[c], mix_k = a.mix[1024 + c], mix_v = a.mix[2048 + c];
            const float w0c = a.w0[c], a0c = a.a0[c], v0c = a.layer ? a.v0[c] : 0.f, kkc = a.k_k[c], kac = a.k_a[c], rkc = a.r_k[c];
            const bf16_t* lw_w = a.lw_; const bf16_t* lw_a = a.lw_ + (size_t)M * 1024; const bf16_t* lw_v = a.lw_ + (size_t)3 * M * 1024;
            const int woff = (lane & 7) * 32 + (lane >> 3) * 4;
            unsigned pr[9], pk[9], pv[9], pw[8], pa[8], pvp[8]; float pvf[8];
#define RW_PREFETCH(t0_) do { const int tb_ = (t0_) + 8 * pw_; \
            _Pragma("unroll") for (int i = 0; i < 9; ++i) { const int t_ = tb_ + i - 1; \
                if (t_ >= 0) { const bf16_t* row_ = a.proj_ + (size_t)(b * SEQ + t_) * PROJ_BLD + h * 64 + lane; pr[i] = row_[OFF_R]; pk[i] = row_[OFF_K]; pv[i] = row_[OFF_V]; } \
                else { pr[i] = 0u; pk[i] = 0u; pv[i] = 0u; } } \
            _Pragma("unroll") for (int i = 0; i < 8; ++i) { const size_t o_ = (size_t)(b * SEQ + tb_ + i) * 1024 + c; pw[i] = lw_w[o_]; pa[i] = lw_a[o_]; \
                if (a.layer) { pvp[i] = lw_v[o_]; pvf[i] = a.vf_[o_]; } else { pvp[i] = 0u; pvf[i] = 0.f; } } } while (0)
#define RW_PREP(ch_) do { const int t0_ = (ch_) * RW_TB; LAS unsigned char* buf_ = lds + ((ch_) & 1) * RWB_BIG; LAS unsigned char* sm_ = lds + RW_SMALL + ((ch_) % 3) * RWS_SIZE; \
            _Pragma("unroll") for (int i = 0; i < 8; ++i) { \
                const int tau = 8 * pw_ + i; \
                const float rc = __uint_as_float(pr[i + 1] << 16), rp = __uint_as_float(pr[i] << 16), kc = __uint_as_float(pk[i + 1] << 16), kp = __uint_as_float(pk[i] << 16), vc = __uint_as_float(pv[i + 1] << 16), vp = __uint_as_float(pv[i] << 16); \
                const float r = rc + (rp - rc) * mix_r, kraw = kc + (kp - kc) * mix_k, vraw = vc + (vp - vc) * mix_v; \
                const float sg = fast_sigmoid(w0c + __uint_as_float(pw[i] << 16)); \
                const float dec = __builtin_amdgcn_exp2f(-1.4426950408889634f * 0.6065306597126334f * sg);     \
                const float as = fast_sigmoid(a0c + __uint_as_float(pa[i] << 16)); \
                float v = vraw; \
                if (a.layer) v = vraw + (pvf[i] - vraw) * fast_sigmoid(v0c + __uint_as_float(pvp[i] << 16)); \
                const float kkv = kraw * kkc; \
                const float km = kraw * (1.f + (as - 1.f) * kac); \
                const float z = reduce4(kkv * kkv, r * km * rkc, kkv * as * r, km * r);     \
                const float nrm2 = rdlane(z, 0), rks = rdlane(z, 16), bru = rdlane(z, 32), kr = rdlane(z, 48); \
                const float inv = __builtin_amdgcn_rsqf(fmaxf(nrm2, 1e-24f));     \
                const float kkn = kkv * inv; \
                *(LAS float*)(buf_ + RWB_A + tau * 256 + woff) = -kkn; *(LAS float*)(buf_ + RWB_DR + tau * 256 + woff) = dec * r; *(LAS float*)(buf_ + RWB_D + tau * 256 + woff) = dec; \
                *(LAS float*)(buf_ + RWB_B + tau * 256 + woff) = kkn * as; *(LAS float*)(buf_ + RWB_K + tau * 256 + woff) = km; \
                if ((lane >> 5) == half) { ((LAS float*)(sm_ + RWS_V))[tau * 32 + (lane & 31)] = v; \
                    if (a.layer == 0) a.vf_[(size_t)(b * SEQ + t0_ + tau) * 1024 + c] = vraw; } \
                if (lane == 0) { ((LAS float*)(sm_ + RWS_SC))[tau] = bru * inv; ((LAS float*)(sm_ + RWS_SC))[32 + tau] = kr; ((LAS float*)(sm_ + RWS_SC))[64 + tau] = rks; } \
            } } while (0)
#define RW_FLUSH(ch_) do { const int t0_ = (ch_) * RW_TB; const LAS unsigned char* sm_ = lds + RW_SMALL + ((ch_) % 3) * RWS_SIZE; const LAS float* yst_ = (const LAS float*)(lds + RW_YST + ((ch_) & 1) * RW_YST_SIZE); \
            _Pragma("unroll") for (int q = 0; q < 2; ++q) { const int idx = ptid + 256 * q, tau = idx >> 4, i = (idx & 15) * 2;     \
                const float y0 = yst_[(((tau >> 3) * 4 + (i >> 3)) * 64) + (i & 7) * 8 + (tau & 7)], y1 = yst_[(((tau >> 3) * 4 + (i >> 3)) * 64) + ((i & 7) + 1) * 8 + (tau & 7)]; \
                const float rk_ = ((const LAS float*)(sm_ + RWS_SC))[64 + tau]; const f32x2 v2_ = *(const LAS f32x2*)((const LAS float*)(sm_ + RWS_V) + tau * 32 + i); \
                const size_t o = (size_t)(b * SEQ + t0_ + tau) * 1024 + h * 64 + half * 32 + i; \
                *(unsigned*)(a.y_ + o) = cvt_pk_bf16(y0, y1); *(unsigned*)(a.bon_ + o) = cvt_pk_bf16(rk_ * v2_.x, rk_ * v2_.y); } } while (0)
            const int cv_total = a.cmoe ? NE * 3 * 2816 : 3 * 5632, cv_stride = G * 4;
            int cv_it = vcu * 4 + pw_; float cvv[32]; bool cv_pend = false;
#define CV_DECODE(it_) const int e_ = a.cmoe ? (it_) / 8448 : 0, rr_ = a.cmoe ? (it_) % 8448 : (it_), per_ = a.cmoe ? 2816 : 5632, j_ = rr_ / per_, r_ = rr_ % per_, dfe_ = a.cmoe ? DFE : DFF; \
            const int K_ = (j_ == 2) ? dfe_ : D, N_ = (j_ == 2) ? D : dfe_, nnb_ = N_ / 32, k0_ = (r_ / nnb_) * 64, n0_ = (r_ % nnb_) * 32; \
            const float* W_ = (j_ == 0 ? a.cw1 : (j_ == 1 ? a.cw3 : a.cw2)) + (size_t)e_ * D * dfe_;
#define CV_LOAD() do { if (cv_it < cv_total) { CV_DECODE(cv_it) \
                const float* src_ = W_ + (size_t)(k0_ + 32 * (lane >> 5)) * N_ + n0_ + (lane & 31);     \
                _Pragma("unroll") for (int i = 0; i < 32; ++i) cvv[i] = src_[(size_t)i * N_]; cv_pend = true; } } while (0)
#define CV_STORE() do { if (cv_pend) { CV_DECODE(cv_it) (void)W_; \
                const int drow_ = (j_ == 2) ? (a.cmoe ? e_ * D + n0_ : n0_) : (a.cmoe ? e_ * 2 * DFE : 0) + 256 * (n0_ / 128) + j_ * 128 + (n0_ % 128); \
                bf16_t* WT_ = a.cwt + ((j_ == 2) ? (size_t)(a.cmoe ? NE * 2 * DFE : 2 * DFF) * D : (size_t)0) + (size_t)(drow_ + (lane & 31)) * K_ + k0_ + 32 * (lane >> 5); \
                _Pragma("unroll") for (int q = 0; q < 4; ++q) { u32x4 o; o.x = cvt_pk_bf16(cvv[8 * q], cvv[8 * q + 1]); o.y = cvt_pk_bf16(cvv[8 * q + 2], cvv[8 * q + 3]); o.z = cvt_pk_bf16(cvv[8 * q + 4], cvv[8 * q + 5]); o.w = cvt_pk_bf16(cvv[8 * q + 6], cvv[8 * q + 7]); \
                    *(u32x4*)(WT_ + 8 * q) = o; } \
                cv_pend = false; cv_it += cv_stride; } } while (0)
            RW_PREFETCH(0);
            RW_PREP(0);
            RW_PREFETCH(RW_TB);
            CV_LOAD();
            __syncthreads();
            for (int ch = 0; ch < RW_NCH; ++ch) {
                if (ch > 0) RW_FLUSH(ch - 1);
                if (ch + 1 < RW_NCH) { RW_PREP(ch + 1);
#if (MK_DBL >> 12) & 1
                    RW_PREP(ch + 1);
#endif
                    if (ch + 2 < RW_NCH) RW_PREFETCH((ch + 2) * RW_TB); }
                CV_STORE(); CV_LOAD();
                __syncthreads();
            }
            RW_FLUSH(RW_NCH - 1);
            while (cv_pend) { CV_STORE(); CV_LOAD(); }
#undef CV_DECODE
#undef CV_LOAD
#undef CV_STORE
#undef RW_PREFETCH
#undef RW_PREP
#undef RW_FLUSH
        } else {
            const int jl = lane & 7, rr = lane >> 3;
            __builtin_amdgcn_s_setprio(3);
            f32x2 S01 = (f32x2){0.f, 0.f}, S23 = S01, S45 = S01, S67 = S01;
#define DPP_Q(z, ctrl) __uint_as_float(__builtin_amdgcn_update_dpp(0u, __float_as_uint(z), (ctrl), 0xf, 0xf, false))
#define SUM8(z) do { z += DPP_Q(z, 0xB1); asm("" : "+v"(z)); z += DPP_Q(z, 0x4E); asm("" : "+v"(z)); z += DPP_Q(z, 0x141); asm("" : "+v"(z)); } while (0)
            __syncthreads();
            for (int ch = 0; ch < RW_NCH; ++ch) {
                const LAS unsigned char* buf = lds + (ch & 1) * RWB_BIG; const LAS unsigned char* sm = lds + RW_SMALL + (ch % 3) * RWS_SIZE;
                const LAS unsigned char* ob = buf + jl * 32;
                const LAS float* Vb = (const LAS float*)(sm + RWS_V) + 8 * wave + rr; const LAS float* SC = (const LAS float*)(sm + RWS_SC);
                LAS float* Yst = (LAS float*)(lds + RW_YST + (ch & 1) * RW_YST_SIZE);
#define LD8(dst0, dst1, off) do { dst0 = *(const LAS f32x4*)(ob + (off)); dst1 = *(const LAS f32x4*)(ob + (off) + 16); } while (0)
                f32x4 a0, a1, q0, q1, d0, d1, b0, b1, k0, k1, na0, na1, nq0, nq1, nd0, nd1, nb0, nb1, nk0, nk1;
                LD8(a0, a1, RWB_A); LD8(q0, q1, RWB_DR); LD8(d0, d1, RWB_D); LD8(b0, b1, RWB_B); LD8(k0, k1, RWB_K);
                float vi = Vb[0], br = SC[0], kr = SC[32];
                LD8(na0, na1, RWB_A + 256); LD8(nq0, nq1, RWB_DR + 256); LD8(nd0, nd1, RWB_D + 256); LD8(nb0, nb1, RWB_B + 256); LD8(nk0, nk1, RWB_K + 256);
                float nvi = Vb[32], nbr = SC[1], nkr = SC[33];
#pragma unroll
                for (int blk = 0; blk < 4; ++blk) {
                    float yacc = 0.f;
#pragma unroll
                    for (int s = 0; s < 8; ++s) {
                        const int tn = blk * 8 + s + 2;
                        f32x4 ma0, ma1, mq0, mq1, md0, md1, mb0, mb1, mk0, mk1;
                        LD8(ma0, ma1, RWB_A + tn * 256); LD8(mq0, mq1, RWB_DR + tn * 256); LD8(md0, md1, RWB_D + tn * 256); LD8(mb0, mb1, RWB_B + tn * 256); LD8(mk0, mk1, RWB_K + tn * 256);
                        const float mvi = Vb[(tn & 31) * 32], mbr = SC[tn & 31], mkr = SC[32 + (tn & 31)];
                        const f32x2 pa2 = (S01 * (f32x2){a0[0], a0[1]} + S23 * (f32x2){a0[2], a0[3]}) + (S45 * (f32x2){a1[0], a1[1]} + S67 * (f32x2){a1[2], a1[3]});
                        const f32x2 pq2 = (S01 * (f32x2){q0[0], q0[1]} + S23 * (f32x2){q0[2], q0[3]}) + (S45 * (f32x2){q1[0], q1[1]} + S67 * (f32x2){q1[2], q1[3]});
                        float sa = pa2.x + pa2.y, zq = pq2.x + pq2.y;
                        SUM8(sa); SUM8(zq);
                        S01 = (S01 * (f32x2){d0[0], d0[1]} + vi * (f32x2){k0[0], k0[1]}) + sa * (f32x2){b0[0], b0[1]};
                        S23 = (S23 * (f32x2){d0[2], d0[3]} + vi * (f32x2){k0[2], k0[3]}) + sa * (f32x2){b0[2], b0[3]};
                        S45 = (S45 * (f32x2){d1[0], d1[1]} + vi * (f32x2){k1[0], k1[1]}) + sa * (f32x2){b1[0], b1[1]};
                        S67 = (S67 * (f32x2){d1[2], d1[3]} + vi * (f32x2){k1[2], k1[3]}) + sa * (f32x2){b1[2], b1[3]};
                        const float y = zq + sa * br + vi * kr;
                        yacc = (jl == s) ? y : yacc;
                        a0 = na0; a1 = na1; q0 = nq0; q1 = nq1; d0 = nd0; d1 = nd1; b0 = nb0; b1 = nb1; k0 = nk0; k1 = nk1; vi = nvi; br = nbr; kr = nkr;
                        na0 = ma0; na1 = ma1; nq0 = mq0; nq1 = mq1; nd0 = md0; nd1 = md1; nb0 = mb0; nb1 = mb1; nk0 = mk0; nk1 = mk1; nvi = mvi; nbr = mbr; nkr = mkr;
                    }
                    Yst[(blk * 4 + wave) * 64 + lane] = yacc;
                }
#undef LD8
                __syncthreads();
            }
#undef SUM8
#undef DPP_Q
            __builtin_amdgcn_s_setprio(0);
        }
        __syncthreads();
    }
}

constexpr int RP = 68, VP = 34;
constexpr int CK_RA = 0, CK_RB = 8704, CK_RK = 17408, CK_RR = 26112, CK_LD = 34816, CK_RV = 43520, CK_RRK = 47872, CK_CUM = 48000, CK_PL = 56976, CK_NAB = 57232,
              CK_AT = 61840, CK_RT = 66448, CK_BH = 71056, CK_KH = 75664, CK_S0 = 80272, CK_NAK = 84880, CK_MBR = 87440, CK_MKR = 90000, CK_TT = 92560, CK_VI = 95120, CK_WI = 97680, CK_UI = 100240,
              CK_BC = 102800, CK_KC = 107920, CK_CUM2 = 113040, CK_END = 122016;
constexpr int P64 = 72, P32 = 40;
static_assert(CK_END <= MISC_OFF, "chunked rwkv LDS map");
__device__ __forceinline__ bf16x8 ldfrag(const LAS bf16_t* img, int pitch, int row, int k0) { return *(const LAS bf16x8*)(img + row * pitch + k0); }
__device__ __forceinline__ void rwkv_chunk_phase(LAS unsigned char* lds, const RwScan& a, const int vcu, const int G, const int tid0_) {
    const int tid = tid0_, wave = __builtin_amdgcn_readfirstlane(tid >> 6), lane = tid & 63;
    LAS float* RA = (LAS float*)(lds + CK_RA); LAS float* RB = (LAS float*)(lds + CK_RB); LAS float* RKm = (LAS float*)(lds + CK_RK); LAS float* RR = (LAS float*)(lds + CK_RR);
    LAS float* RLD = (LAS float*)(lds + CK_LD); LAS float* RV = (LAS float*)(lds + CK_RV); LAS float* RRK = (LAS float*)(lds + CK_RRK); LAS float* CUM = (LAS float*)(lds + CK_CUM);
    LAS float* PL = (LAS float*)(lds + CK_PL); LAS float* NabT = (LAS float*)(lds + CK_NAB); LAS float* CUMB = (LAS float*)(lds + CK_CUM2);
#define CK_CUMSUM(buf_) do { LAS float* cu_ = (buf_) ? CUMB : CUM; float ldv[32]; \
        _Pragma("unroll") for (int t = 0; t < 32; ++t) ldv[t] = RLD[t * RP + lane]; \
        float cs = 0.f; cu_[lane] = 0.f; \
        _Pragma("unroll") for (int t = 0; t < 32; ++t) { cs += ldv[t]; cu_[(t + 1) * RP + lane] = cs; } } while (0)
    LAS bf16_t* AT = (LAS bf16_t*)(lds + CK_AT); LAS bf16_t* RT = (LAS bf16_t*)(lds + CK_RT); LAS bf16_t* BH = (LAS bf16_t*)(lds + CK_BH); LAS bf16_t* KH = (LAS bf16_t*)(lds + CK_KH); LAS bf16_t* S0 = (LAS bf16_t*)(lds + CK_S0);
    LAS bf16_t* NakT = (LAS bf16_t*)(lds + CK_NAK); LAS bf16_t* MbrT = (LAS bf16_t*)(lds + CK_MBR); LAS bf16_t* MkrT = (LAS bf16_t*)(lds + CK_MKR); LAS bf16_t* TT = (LAS bf16_t*)(lds + CK_TT);
    LAS bf16_t* Vi = (LAS bf16_t*)(lds + CK_VI); LAS bf16_t* Wi = (LAS bf16_t*)(lds + CK_WI); LAS bf16_t* Ui = (LAS bf16_t*)(lds + CK_UI); LAS bf16_t* BcT = (LAS bf16_t*)(lds + CK_BC); LAS bf16_t* KcT = (LAS bf16_t*)(lds + CK_KC);
    for (int u = vcu; u < BATCH * RW_H * 2; u += G) {
        const int b = u >> 5, h = (u >> 1) & 15, half = u & 1, c = h * 64 + lane;
        const float mix_r = a.mix[c], mix_k = a.mix[1024 + c], mix_v = a.mix[2048 + c];
        const float w0c = a.w0[c], a0c = a.a0[c], v0c = a.layer ? a.v0[c] : 0.f, kkc = a.k_k[c], kac = a.k_a[c], rkc = a.r_k[c];
        const bf16_t* lw_w = a.lw_; const bf16_t* lw_a = a.lw_ + (size_t)M * 1024; const bf16_t* lw_v = a.lw_ + (size_t)3 * M * 1024;
        const int ptok0 = (wave < 4) ? 4 * (wave - 1) : 12 + 5 * (wave - 4), pntok = (wave == 0) ? 0 : ((wave < 4) ? 4 : 5);
        unsigned pr[6], pk[6], pv[6], pw[5], pa[5], pvp[5]; float pvf[5];
#define CK_PREFETCH(t0_) do { if (pntok) { const int tb_ = (t0_) + ptok0; \
        _Pragma("unroll") for (int i = 0; i < 6; ++i) { const int t_ = tb_ + i - 1; \
            if (t_ >= 0 && i <= pntok) { const bf16_t* row_ = a.proj_ + (size_t)(b * SEQ + t_) * PROJ_BLD + h * 64 + lane; pr[i] = row_[OFF_R]; pk[i] = row_[OFF_K]; pv[i] = row_[OFF_V]; } \
            else { pr[i] = 0u; pk[i] = 0u; pv[i] = 0u; } } \
        _Pragma("unroll") for (int i = 0; i < 5; ++i) { if (i < pntok) { const size_t o_ = (size_t)(b * SEQ + tb_ + i) * 1024 + c; pw[i] = lw_w[o_]; pa[i] = lw_a[o_]; \
            if (a.layer) { pvp[i] = lw_v[o_]; pvf[i] = a.vf_[o_]; } else { pvp[i] = 0u; pvf[i] = 0.f; } } else { pw[i] = 0u; pa[i] = 0u; pvp[i] = 0u; pvf[i] = 0.f; } } } } while (0)
#define CK_PREP(t0_) do { \
            _Pragma("unroll") for (int i = 0; i < 5; ++i) if (i < pntok) { \
                const int tau = ptok0 + i; \
                const float rc = __uint_as_float(pr[i + 1] << 16), rp = __uint_as_float(pr[i] << 16), kc = __uint_as_float(pk[i + 1] << 16), kp = __uint_as_float(pk[i] << 16), vc = __uint_as_float(pv[i + 1] << 16), vp = __uint_as_float(pv[i] << 16); \
                const float r = rc + (rp - rc) * mix_r, kraw = kc + (kp - kc) * mix_k, vraw = vc + (vp - vc) * mix_v; \
                const float sg = fast_sigmoid(w0c + __uint_as_float(pw[i] << 16)); \
                const float ld = -1.4426950408889634f * 0.6065306597126334f * sg;       \
                const float as = fast_sigmoid(a0c + __uint_as_float(pa[i] << 16)); \
                float v = vraw; \
                if (a.layer) v = vraw + (pvf[i] - vraw) * fast_sigmoid(v0c + __uint_as_float(pvp[i] << 16)); \
                const float kkv = kraw * kkc; \
                const float km = kraw * (1.f + (as - 1.f) * kac); \
                const float z = reduce4(kkv * kkv, r * km * rkc, 0.f, 0.f); \
                const float nrm2 = rdlane(z, 0), rks = rdlane(z, 16); \
                const float kkn = kkv * __builtin_amdgcn_rsqf(fmaxf(nrm2, 1e-24f)); \
                RA[tau * RP + lane] = -kkn; RB[tau * RP + lane] = kkn * as; RKm[tau * RP + lane] = km; RR[tau * RP + lane] = r; RLD[tau * RP + lane] = ld; \
                if ((lane >> 5) == half) { RV[tau * VP + (lane & 31)] = v; \
                    if (a.layer == 0) a.vf_[(size_t)(b * SEQ + (t0_) + tau) * 1024 + c] = vraw; } \
                if (lane == 0) RRK[tau] = rks; \
            } } while (0)
        const int cv_total = a.cmoe ? NE * 3 * 2816 : 3 * 5632, cv_stride = G * 4;
        int cv_it = vcu * 4 + (wave & 3); bool cv_pend = false;
#define CV_DECODE(it_) const int e_ = a.cmoe ? (it_) / 8448 : 0, rr_ = a.cmoe ? (it_) % 8448 : (it_), per_ = a.cmoe ? 2816 : 5632, j_ = rr_ / per_, r_ = rr_ % per_, dfe_ = a.cmoe ? DFE : DFF; \
        const int K_ = (j_ == 2) ? dfe_ : D, N_ = (j_ == 2) ? D : dfe_, nnb_ = N_ / 32, k0_ = (r_ / nnb_) * 64, n0_ = (r_ % nnb_) * 32; \
        const float* W_ = (j_ == 0 ? a.cw1 : (j_ == 1 ? a.cw3 : a.cw2)) + (size_t)e_ * D * dfe_;
#define CV_LOAD() do { if (cv_it < cv_total) { CV_DECODE(cv_it) \
            const float* src_ = W_ + (size_t)(k0_ + 32 * (lane >> 5)) * N_ + n0_ + (lane & 31); \
            _Pragma("unroll") for (int i = 0; i < 32; ++i) cvv[i] = src_[(size_t)i * N_]; cv_pend = true; } } while (0)
#define CV_STORE() do { if (cv_pend) { CV_DECODE(cv_it) (void)W_; \
            const int drow_ = (j_ == 2) ? (a.cmoe ? e_ * D + n0_ : n0_) : (a.cmoe ? e_ * 2 * DFE : 0) + 256 * (n0_ / 128) + j_ * 128 + (n0_ % 128); \
            bf16_t* WT_ = a.cwt + ((j_ == 2) ? (size_t)(a.cmoe ? NE * 2 * DFE : 2 * DFF) * D : (size_t)0) + (size_t)(drow_ + (lane & 31)) * K_ + k0_ + 32 * (lane >> 5); \
            _Pragma("unroll") for (int q = 0; q < 4; ++q) { u32x4 o; o.x = cvt_pk_bf16(cvv[8 * q], cvv[8 * q + 1]); o.y = cvt_pk_bf16(cvv[8 * q + 2], cvv[8 * q + 3]); o.z = cvt_pk_bf16(cvv[8 * q + 4], cvv[8 * q + 5]); o.w = cvt_pk_bf16(cvv[8 * q + 6], cvv[8 * q + 7]); \
                *(u32x4*)(WT_ + 8 * q) = o; } \
            cv_pend = false; cv_it += cv_stride; } } while (0)
        f32x4 Sacc = ZERO4();
        for (int i = tid; i < 32 * P64 / 2; i += 512) ((LAS unsigned*)S0)[i] = 0u;
        CK_PREFETCH(0);
        CK_PREP(0);
        CK_PREFETCH(32);
        __syncthreads();
        if (wave == 4) CK_CUMSUM(0);
        __syncthreads();
        for (int ch = 0; ch < SEQ / 32; ++ch) {
            const int t0 = ch * 32;
            int tid_c = tid0_; asm volatile("" : "+v"(tid_c));
            const int tid = tid_c, lane = tid & 63, fr = lane & 15, fq = lane >> 4;
            const LAS float* CUMc = (ch & 1) ? CUMB : CUM;
            {
                const int t = tid & 31, j0 = 4 * (tid >> 5);
                const f32x4 ct = *(const LAS f32x4*)(CUMc + (t + 1) * RP + j0), cp = *(const LAS f32x4*)(CUMc + t * RP + j0), cL = *(const LAS f32x4*)(CUMc + 32 * RP + j0);
                const f32x4 ra = *(const LAS f32x4*)(RA + t * RP + j0), rb = *(const LAS f32x4*)(RB + t * RP + j0), rk = *(const LAS f32x4*)(RKm + t * RP + j0), rr = *(const LAS f32x4*)(RR + t * RP + j0);
                float at[4], rt[4], bh[4], kh[4], bc[4], kc_[4];
#pragma unroll
                for (int e = 0; e < 4; ++e) { const float ea = __builtin_amdgcn_exp2f(cp[e]), er = __builtin_amdgcn_exp2f(ct[e]), ei = __builtin_amdgcn_exp2f(-ct[e]), ec = __builtin_amdgcn_exp2f(cL[e] - ct[e]);
                    at[e] = ra[e] * ea; rt[e] = rr[e] * er; bh[e] = rb[e] * ei; kh[e] = rk[e] * ei; bc[e] = rb[e] * ec; kc_[e] = rk[e] * ec; }
                { u32x2 w; w.x = cvt_pk_bf16(at[0], at[1]); w.y = cvt_pk_bf16(at[2], at[3]); *(LAS u32x2*)(AT + t * P64 + j0) = w; }
                { u32x2 w; w.x = cvt_pk_bf16(rt[0], rt[1]); w.y = cvt_pk_bf16(rt[2], rt[3]); *(LAS u32x2*)(RT + t * P64 + j0) = w; }
                { u32x2 w; w.x = cvt_pk_bf16(bh[0], bh[1]); w.y = cvt_pk_bf16(bh[2], bh[3]); *(LAS u32x2*)(BH + t * P64 + j0) = w; }
                { u32x2 w; w.x = cvt_pk_bf16(kh[0], kh[1]); w.y = cvt_pk_bf16(kh[2], kh[3]); *(LAS u32x2*)(KH + t * P64 + j0) = w; }
                { const unsigned w0 = cvt_pk_bf16(bc[0], bc[1]), w1 = cvt_pk_bf16(bc[2], bc[3]), x0 = cvt_pk_bf16(kc_[0], kc_[1]), x1 = cvt_pk_bf16(kc_[2], kc_[3]);
                  BcT[(j0 + 0) * P32 + t] = (bf16_t)(w0 & 0xffffu); BcT[(j0 + 1) * P32 + t] = (bf16_t)(w0 >> 16); BcT[(j0 + 2) * P32 + t] = (bf16_t)(w1 & 0xffffu); BcT[(j0 + 3) * P32 + t] = (bf16_t)(w1 >> 16);
                  KcT[(j0 + 0) * P32 + t] = (bf16_t)(x0 & 0xffffu); KcT[(j0 + 1) * P32 + t] = (bf16_t)(x0 >> 16); KcT[(j0 + 2) * P32 + t] = (bf16_t)(x1 & 0xffffu); KcT[(j0 + 3) * P32 + t] = (bf16_t)(x1 >> 16); }
                if (t == 31) { f32x4 pl; pl[0] = __builtin_amdgcn_exp2f(cL[0]); pl[1] = __builtin_amdgcn_exp2f(cL[1]); pl[2] = __builtin_amdgcn_exp2f(cL[2]); pl[3] = __builtin_amdgcn_exp2f(cL[3]); *(LAS f32x4*)(PL + j0) = pl; }
                { const int i0 = 2 * (tid >> 5); const f32x2 vv = *(const LAS f32x2*)(RV + t * VP + i0); const unsigned w = cvt_pk_bf16(vv.x, vv.y);
                  Vi[i0 * P32 + t] = (bf16_t)(w & 0xffffu); Vi[(i0 + 1) * P32 + t] = (bf16_t)(w >> 16); }
                { const int tb = tid >> 4, ib = 2 * (tid & 15); const float rk_ = RRK[tb]; const f32x2 vb = *(const LAS f32x2*)(RV + tb * VP + ib);
                  *(unsigned*)(a.bon_ + (size_t)(b * SEQ + t0 + tb) * 1024 + h * 64 + half * 32 + ib) = cvt_pk_bf16(rk_ * vb.x, rk_ * vb.y); }
            }
            __syncthreads();
#pragma unroll
            for (int q = 0; q < 2; ++q) {
                const int id = 2 * wave + q, mat = id >> 2, mt = (id >> 1) & 1, nt = id & 1;
                const LAS bf16_t* Ai = (mat & 1) ? KH : BH; const LAS bf16_t* Bi = (mat & 2) ? RT : AT;
                f32x4 g = ZERO4();
#pragma unroll
                for (int ks = 0; ks < 2; ++ks) g = __builtin_amdgcn_mfma_f32_16x16x32_bf16(ldfrag(Ai, P64, 16 * mt + fr, 32 * ks + 8 * fq), ldfrag(Bi, P64, 16 * nt + fr, 32 * ks + 8 * fq), g, 0, 0, 0);
                const int t = 16 * nt + fr, s0 = 16 * mt + 4 * fq;
#pragma unroll
                for (int r = 0; r < 4; ++r) { const int s = s0 + r; const bool keep = (mat < 2) ? (s < t) : (s <= t); g[r] = keep ? g[r] : 0.f; }
                if (mat == 0) *(LAS f32x4*)(NabT + t * 36 + s0) = g;
                else { LAS bf16_t* Xo = (mat == 1) ? NakT : ((mat == 2) ? MbrT : MkrT); u32x2 w; w.x = cvt_pk_bf16(g[0], g[1]); w.y = cvt_pk_bf16(g[2], g[3]); *(LAS u32x2*)(Xo + t * P32 + s0) = w; }
            }
            __syncthreads();
            if (wave == 0) {
                int ln = lane; asm volatile("" : "+v"(ln));
                float Tr[32];
                f32x4 rowb[2][8];
#pragma unroll
                for (int t = 0; t < 32; ++t) {
                    if (t + 1 < 32) {
#pragma unroll
                        for (int q = 0; q < 8; ++q) if (4 * q < t + 1) rowb[(t + 1) & 1][q] = *(const LAS f32x4*)(NabT + (t + 1) * 36 + 4 * q);
                    }
                    float acc4[4] = {(ln == t) ? 1.f : 0.f, 0.f, 0.f, 0.f};
#pragma unroll
                    for (int q = 0; q < 8; ++q)
#pragma unroll
                        for (int e = 0; e < 4; ++e) if (4 * q + e < t) acc4[e] += Tr[4 * q + e] * rowb[t & 1][q][e];
                    const float acc = (acc4[0] + acc4[1]) + (acc4[2] + acc4[3]);
                    Tr[t] = acc;
                    if (ln < 32) TT[t * P32 + ln] = (bf16_t)(cvt_pk_bf16(acc, 0.f) & 0xffffu);
                }
            } else {
                if (wave >= 4) {
                    const int mt = (wave - 4) >> 1, nt = (wave - 4) & 1;
                    f32x4 w = ZERO4();
#pragma unroll
                    for (int ks = 0; ks < 2; ++ks) w = __builtin_amdgcn_mfma_f32_16x16x32_bf16(ldfrag(AT, P64, 16 * mt + fr, 32 * ks + 8 * fq), ldfrag(S0, P64, 16 * nt + fr, 32 * ks + 8 * fq), w, 0, 0, 0);
                    w = __builtin_amdgcn_mfma_f32_16x16x32_bf16(ldfrag(NakT, P32, 16 * mt + fr, 8 * fq), ldfrag(Vi, P32, 16 * nt + fr, 8 * fq), w, 0, 0, 0);
                    u32x2 o; o.x = cvt_pk_bf16(w[0], w[1]); o.y = cvt_pk_bf16(w[2], w[3]); *(LAS u32x2*)(Wi + (16 * nt + fr) * P32 + 16 * mt + 4 * fq) = o;
                }
                if (ch + 1 < SEQ / 32) { CK_PREP(t0 + 32); if (ch + 2 < SEQ / 32) CK_PREFETCH(t0 + 64); }
            }
            __syncthreads();
            float cvv[32];
            if (wave >= 4) CV_LOAD();
            if (wave == 4 && ch + 1 < SEQ / 32) CK_CUMSUM((ch + 1) & 1);
            if (wave < 4) {
                const int mt = wave >> 1, nt = wave & 1;
                f32x4 uu = ZERO4();
                uu = __builtin_amdgcn_mfma_f32_16x16x32_bf16(ldfrag(TT, P32, 16 * mt + fr, 8 * fq), ldfrag(Wi, P32, 16 * nt + fr, 8 * fq), uu, 0, 0, 0);
                u32x2 o; o.x = cvt_pk_bf16(uu[0], uu[1]); o.y = cvt_pk_bf16(uu[2], uu[3]); *(LAS u32x2*)(Ui + (16 * nt + fr) * P32 + 16 * mt + 4 * fq) = o;
            }
            __syncthreads();
            if (wave >= 4) CV_STORE();
            if (wave < 4) {
                const int mt = wave >> 1, nt = wave & 1;
                f32x4 y = ZERO4();
#pragma unroll
                for (int ks = 0; ks < 2; ++ks) y = __builtin_amdgcn_mfma_f32_16x16x32_bf16(ldfrag(S0, P64, 16 * mt + fr, 32 * ks + 8 * fq), ldfrag(RT, P64, 16 * nt + fr, 32 * ks + 8 * fq), y, 0, 0, 0);
                y = __builtin_amdgcn_mfma_f32_16x16x32_bf16(ldfrag(Ui, P32, 16 * mt + fr, 8 * fq), ldfrag(MbrT, P32, 16 * nt + fr, 8 * fq), y, 0, 0, 0);
                y = __builtin_amdgcn_mfma_f32_16x16x32_bf16(ldfrag(Vi, P32, 16 * mt + fr, 8 * fq), ldfrag(MkrT, P32, 16 * nt + fr, 8 * fq), y, 0, 0, 0);
                u32x2 o; o.x = cvt_pk_bf16(y[0], y[1]); o.y = cvt_pk_bf16(y[2], y[3]);
                *(u32x2*)(a.y_ + (size_t)(b * SEQ + t0 + 16 * nt + fr) * 1024 + h * 64 + half * 32 + 16 * mt + 4 * fq) = o;
            }
            {
                const int mt = wave >> 1, nt = wave & 1;
                const f32x4 pl = *(const LAS f32x4*)(PL + 16 * mt + 4 * fq);
                Sacc = Sacc * pl;
                Sacc = __builtin_amdgcn_mfma_f32_16x16x32_bf16(ldfrag(BcT, P32, 16 * mt + fr, 8 * fq), ldfrag(Ui, P32, 16 * nt + fr, 8 * fq), Sacc, 0, 0, 0);
                Sacc = __builtin_amdgcn_mfma_f32_16x16x32_bf16(ldfrag(KcT, P32, 16 * mt + fr, 8 * fq), ldfrag(Vi, P32, 16 * nt + fr, 8 * fq), Sacc, 0, 0, 0);
            }
            __syncthreads();
            { const int mt = wave >> 1, nt = wave & 1; u32x2 o; o.x = cvt_pk_bf16(Sacc[0], Sacc[1]); o.y = cvt_pk_bf16(Sacc[2], Sacc[3]);
              *(LAS u32x2*)(S0 + (16 * nt + fr) * P64 + 16 * mt + 4 * fq) = o; }
        }
        if (wave >= 4) { float cvv[32]; CV_LOAD(); while (cv_pend) { CV_STORE(); CV_LOAD(); } }
#undef CK_PREFETCH
#undef CK_CUMSUM
#undef CK_PREP
#undef CV_DECODE
#undef CV_LOAD
#undef CV_STORE
        __syncthreads();
    }
}

constexpr int IMG_AT = 0, IMG_RT = 4096, IMG_BH = 8192, IMG_KH = 12288, IMG_VI = 16384, IMG_NAK = 20480, IMG_MBR = 22528, IMG_MKR = 24576, IMG_TT = 26624, IMG_PL = 28672, IMG_UNIT = 28928;
constexpr int PW_AT = 0, PW_RT = 4608, PW_BH = 9216, PW_KH = 13824, PW_NAB = PW_BH, PW_SIZE = 18432, PW_NW = 7;
static_assert(PW_NW * PW_SIZE <= MISC_OFF, "rwkv pre-phase LDS map");
static_assert((size_t)BATCH * RW_H * (SEQ / 32) * IMG_UNIT <= (size_t)299 * MiB, "rwkv chunk images fit between yssd and the FFN weights");
template <bool MOE> __device__ __forceinline__ void cv_decode(const int it, int& e, int& j, int& k0, int& n0) {
    constexpr int per = MOE ? 2816 : 5632, nnb = MOE ? 88 : 176;
    e = MOE ? it / 8448 : 0; const int rr = MOE ? it - e * 8448 : it; j = rr / per; const int r = rr - j * per;
    if (j == 2) { k0 = (r >> 6) * 64; n0 = (r & 63) * 32; } else { const int q = r / nnb; k0 = q * 64; n0 = (r - q * nnb) * 32; }
}
__device__ __forceinline__ void rwkv_pre_phase(LAS unsigned char* lds, const RwScan& a_, unsigned char* img, const int vcu, const int G, const int tid0_, const bool do_cv, const bool do_work) {
    const int wave = __builtin_amdgcn_readfirstlane(tid0_ >> 6);
    const bf16_t* const a_proj = a_.proj_; const bf16_t* const a_lw = a_.lw_; const float* const a_mix = a_.mix; const float* const a_w0 = a_.w0; const float* const a_a0 = a_.a0; const float* const a_v0 = a_.v0;
    const float* const a_kk = a_.k_k; const float* const a_ka = a_.k_a; const float* const a_rk = a_.r_k; float* const a_vf = a_.vf_; bf16_t* const a_bon = a_.bon_; const int a_layer = a_.layer;
    const float* const a_cw1 = a_.cw1; const float* const a_cw3 = a_.cw3; const float* const a_cw2 = a_.cw2; bf16_t* const a_cwt = a_.cwt; const int a_cmoe = a_.cmoe;
    if (wave >= PW_NW) {
        const int lane = tid0_ & 63;
        const int cv_total = a_cmoe ? MK_CV_CUT_MOE : MK_CV_CUT_DENSE, cv_stride = G * (NWAVES - PW_NW);
        int cv_it = do_cv ? vcu * (NWAVES - PW_NW) + (wave - PW_NW) : cv_total;
        float va[32], vb[32];
#define CV_DECODE(it_) int e_, j_, k0_, n0_; if (a_cmoe) cv_decode<true>((it_), e_, j_, k0_, n0_); else cv_decode<false>((it_), e_, j_, k0_, n0_); \
        const int dfe_ = a_cmoe ? DFE : DFF, K_ = (j_ == 2) ? dfe_ : D, N_ = (j_ == 2) ? D : dfe_; \
        const float* W_ = (j_ == 0 ? a_cw1 : (j_ == 1 ? a_cw3 : a_cw2)) + (size_t)e_ * D * dfe_;
#define CV_LD(buf_, it_) do { CV_DECODE(it_) \
            const float* src_ = W_ + (size_t)(k0_ + 32 * (lane >> 5)) * N_ + n0_ + (lane & 31); \
            _Pragma("unroll") for (int i = 0; i < 32; ++i) { buf_[i] = *src_; src_ += N_; asm volatile("" : "+v"(src_)); } } while (0)
#define CV_ST(buf_, it_) do { CV_DECODE(it_) (void)W_; \
            const int drow_ = (j_ == 2) ? (a_cmoe ? e_ * D + n0_ : n0_) : (a_cmoe ? e_ * 2 * DFE : 0) + 256 * (n0_ / 128) + j_ * 128 + (n0_ % 128); \
            bf16_t* WT_ = a_cwt + ((j_ == 2) ? (size_t)(a_cmoe ? NE * 2 * DFE : 2 * DFF) * D : (size_t)0) + (size_t)(drow_ + (lane & 31)) * K_ + k0_ + 32 * (lane >> 5); \
            _Pragma("unroll") for (int q = 0; q < 4; ++q) { u32x4 o; o.x = cvt_pk_bf16(buf_[8 * q], buf_[8 * q + 1]); o.y = cvt_pk_bf16(buf_[8 * q + 2], buf_[8 * q + 3]); o.z = cvt_pk_bf16(buf_[8 * q + 4], buf_[8 * q + 5]); o.w = cvt_pk_bf16(buf_[8 * q + 6], buf_[8 * q + 7]); \
                *(u32x4*)(WT_ + 8 * q) = o; } } while (0)
#ifndef MK_X_NOCV
        if (cv_it < cv_total) CV_LD(va, cv_it);
        while (cv_it < cv_total) {
            const int n1 = cv_it + cv_stride;
            if (n1 < cv_total) CV_LD(vb, n1);
            CV_ST(va, cv_it);
            if (n1 >= cv_total) break;
            const int n2 = n1 + cv_stride;
            if (n2 < cv_total) CV_LD(va, n2);
            CV_ST(vb, n1);
            cv_it = n2;
        }
#endif
#undef CV_DECODE
#undef CV_LD
#undef CV_ST
        return;
    }
    LAS unsigned char* my = lds + wave * PW_SIZE;
    LAS bf16_t* AT = (LAS bf16_t*)(my + PW_AT); LAS bf16_t* RT = (LAS bf16_t*)(my + PW_RT); LAS bf16_t* BH = (LAS bf16_t*)(my + PW_BH); LAS bf16_t* KH = (LAS bf16_t*)(my + PW_KH); LAS float* NabT = (LAS float*)(my + PW_NAB);
    const bf16_t* lw_w = a_lw; const bf16_t* lw_a = a_lw + (size_t)M * 1024; const bf16_t* lw_v = a_lw + (size_t)3 * M * 1024;
    const __amdgpu_buffer_rsrc_t rs_proj = __builtin_amdgcn_make_buffer_rsrc((void*)a_proj, 0, 0x7fffffff, 0x00020000), rs_lw = __builtin_amdgcn_make_buffer_rsrc((void*)a_lw, 0, 0x7fffffff, 0x00020000),
                                 rs_vf = __builtin_amdgcn_make_buffer_rsrc((void*)a_vf, 0, 0x7fffffff, 0x00020000), rs_bon = __builtin_amdgcn_make_buffer_rsrc((void*)a_bon, 0, 0x7fffffff, 0x00020000),
                                 rs_img = __builtin_amdgcn_make_buffer_rsrc((void*)img, 0, 0x7fffffff, 0x00020000);
    if (do_work) for (int u = vcu; u < M / 64; u += G) {
        const int b = u >> 5, tbase = (u & 31) * 64;
        for (int id = wave; id < 32; id += PW_NW) {
            int ln = tid0_ & 63; asm volatile("" : "+v"(ln));
            const int lane = ln, fr = lane & 15, fq = lane >> 4;
            const int h = id >> 1, t0 = tbase + 32 * (id & 1), c = h * 64 + lane;
            const float mix_r = a_mix[c], mix_k = a_mix[1024 + c], mix_v = a_mix[2048 + c];
            const float w0c = a_w0[c], a0c = a_a0[c], v0c = a_layer ? a_v0[c] : 0.f, kkc = a_kk[c], kac = a_ka[c], rkc = a_rk[c];
            unsigned char* ug = img + (size_t)((b * RW_H + h) * (SEQ / 32) + (t0 >> 5)) * IMG_UNIT;
            float cum = 0.f, er = 1.f;
            const bool hasv = a_layer != 0;
            unsigned prA[5], pkA[5], pvA[5], pwA[4], paA[4], pvpA[4], prB[5], pkB[5], pvB[5], pwB[4], paB[4], pvpB[4]; float pvfA[4], pvfB[4];
            const unsigned vo2 = (unsigned)lane * 2u, vo4 = (unsigned)lane * 4u, vo2d = (unsigned)(lane >> 1) * 4u; const bool odd_lane = (lane & 1) != 0;
            const unsigned so_proj = (unsigned)((b * SEQ + t0) * PROJ_BLD + h * 64) * 2u, so_tok = (unsigned)((b * SEQ + t0) * 1024 + h * 64);
            const unsigned so_img = (unsigned)((b * RW_H + h) * (SEQ / 32) + (t0 >> 5)) * (unsigned)IMG_UNIT + IMG_VI;
#define PRE_FETCH(tb_, X) do { \
            _Pragma("unroll") for (int i = 0; i < 4; ++i) { const unsigned t_ = (unsigned)((tb_) + i); \
                pr##X[i + 1] = __builtin_amdgcn_raw_buffer_load_b32(rs_proj, vo2d, so_proj + t_ * (PROJ_BLD * 2u) + OFF_R * 2u, 0); \
                pk##X[i + 1] = __builtin_amdgcn_raw_buffer_load_b32(rs_proj, vo2d, so_proj + t_ * (PROJ_BLD * 2u) + OFF_K * 2u, 0); \
                pv##X[i + 1] = __builtin_amdgcn_raw_buffer_load_b32(rs_proj, vo2d, so_proj + t_ * (PROJ_BLD * 2u) + OFF_V * 2u, 0); \
                pw##X[i] = __builtin_amdgcn_raw_buffer_load_b32(rs_lw, vo2d, (so_tok + t_ * 1024u) * 2u, 0); \
                pa##X[i] = __builtin_amdgcn_raw_buffer_load_b32(rs_lw, vo2d, (so_tok + t_ * 1024u) * 2u + (unsigned)M * 2048u, 0); \
                if (hasv) { pvp##X[i] = __builtin_amdgcn_raw_buffer_load_b32(rs_lw, vo2d, (so_tok + t_ * 1024u) * 2u + (unsigned)M * 6144u, 0); \
                            pvf##X[i] = __uint_as_float(__builtin_amdgcn_raw_buffer_load_b32(rs_vf, vo2d, (so_tok + t_ * 1024u) * 2u, 0)); }   \
                else { pvp##X[i] = 0u; pvf##X[i] = 0.f; } } } while (0)
#define BFSEL(x_) __uint_as_float(odd_lane ? ((x_) & 0xffff0000u) : ((x_) << 16))
#define PRE_TOK8(tb_, X) do { \
            _Pragma("unroll") for (int i = 0; i < 4; ++i) { const int tau = (tb_) + i; \
                const float rc = BFSEL(pr##X[i + 1]), rp = BFSEL(pr##X[i]), kc = BFSEL(pk##X[i + 1]), kp = BFSEL(pk##X[i]), \
                            vc = BFSEL(pv##X[i + 1]), vp = BFSEL(pv##X[i]); \
                const float r = rc + (rp - rc) * mix_r, kraw = kc + (kp - kc) * mix_k, vraw = vc + (vp - vc) * mix_v; \
                const float sg = fast_sigmoid(w0c + BFSEL(pw##X[i])); \
                const float ld = -1.4426950408889634f * 0.6065306597126334f * sg;       \
                const float as = fast_sigmoid(a0c + BFSEL(pa##X[i])); \
                float v = vraw; \
                if (hasv) v = vraw + (BFSEL(__float_as_uint(pvf##X[i])) - vraw) * fast_sigmoid(v0c + BFSEL(pvp##X[i])); \
                const float kkv = kraw * kkc; \
                const float km = kraw * (1.f + (as - 1.f) * kac); \
                const float z = reduce4(kkv * kkv, r * km * rkc, 0.f, 0.f); \
                const float nrm2 = rdlane(z, 0), rks = rdlane(z, 16); \
                const float kkn = kkv * __builtin_amdgcn_rsqf(fmaxf(nrm2, 1e-24f)); \
                const float er_prev = er;                                          \
                cum += ld; er = __builtin_amdgcn_exp2f(cum); \
                const float ei = __builtin_amdgcn_exp2f(-cum); \
                const float at = -kkn * er_prev, rt = r * er, bh = kkn * as * ei, kh = km * ei; \
                const unsigned w0 = cvt_pk_bf16(at, rt), w1 = cvt_pk_bf16(bh, kh), w2 = cvt_pk_bf16(v, rks * v); \
                AT[tau * P64 + lane] = (bf16_t)(w0 & 0xffffu); RT[tau * P64 + lane] = (bf16_t)(w0 >> 16); BH[tau * P64 + lane] = (bf16_t)(w1 & 0xffffu); KH[tau * P64 + lane] = (bf16_t)(w1 >> 16); \
                __builtin_amdgcn_raw_buffer_store_b16((unsigned short)(w2 & 0xffffu), rs_img, vo2, so_img + (unsigned)tau * 128u, 0);        \
                __builtin_amdgcn_raw_buffer_store_b16((unsigned short)(w2 >> 16), rs_bon, vo2, (so_tok + (unsigned)tau * 1024u) * 2u, 0); \
                if (!hasv) __builtin_amdgcn_raw_buffer_store_b16((unsigned short)(cvt_pk_bf16(vraw, 0.f) & 0xffffu), rs_vf, vo2, (so_tok + (unsigned)tau * 1024u) * 2u, 0); \
            } } while (0)
            PRE_FETCH(0, A);
            if (t0 > 0) { prA[0] = __builtin_amdgcn_raw_buffer_load_b32(rs_proj, vo2d, so_proj - PROJ_BLD * 2u + OFF_R * 2u, 0); pkA[0] = __builtin_amdgcn_raw_buffer_load_b32(rs_proj, vo2d, so_proj - PROJ_BLD * 2u + OFF_K * 2u, 0);
                          pvA[0] = __builtin_amdgcn_raw_buffer_load_b32(rs_proj, vo2d, so_proj - PROJ_BLD * 2u + OFF_V * 2u, 0); }
            else { prA[0] = 0u; pkA[0] = 0u; pvA[0] = 0u; }
            for (int gg = 0; gg < 4; ++gg) {
                PRE_FETCH(8 * gg + 4, B);
                prB[0] = prA[4]; pkB[0] = pkA[4]; pvB[0] = pvA[4];
                PRE_TOK8(8 * gg, A);
                if (gg < 3) PRE_FETCH(8 * gg + 8, A);
                prA[0] = prB[4]; pkA[0] = pkB[4]; pvA[0] = pvB[4];
                PRE_TOK8(8 * gg + 4, B);
            }
#undef PRE_FETCH
#undef PRE_TOK8
#undef BFSEL
            *(float*)(ug + IMG_PL + lane * 4) = er;
            asm volatile("s_waitcnt lgkmcnt(0)" ::: "memory");
#pragma unroll
            for (int arr = 1; arr < 3; ++arr) {
                const LAS bf16_t* X = (arr == 1) ? BH : KH;
                unsigned pkd[16];
#pragma unroll
                for (int k = 0; k < 16; ++k) pkd[k] = (unsigned)X[(2 * k) * P64 + lane] | ((unsigned)X[(2 * k + 1) * P64 + lane] << 16);
                unsigned char* dst = ug + ((arr == 1) ? IMG_BH : IMG_KH) + lane * 64;
#pragma unroll
                for (int q = 0; q < 4; ++q) *(u32x4*)(dst + q * 16) = (u32x4){pkd[4 * q], pkd[4 * q + 1], pkd[4 * q + 2], pkd[4 * q + 3]};
            }
            asm volatile("s_waitcnt lgkmcnt(0)" ::: "memory");
#ifndef MK_X_NOGRAM
            {
                bf16x8 fB[2][2], fK[2][2], fA[2][2], fR[2][2];
#pragma unroll
                for (int m = 0; m < 2; ++m)
#pragma unroll
                    for (int ks = 0; ks < 2; ++ks) { fB[m][ks] = ldfrag(BH, P64, 16 * m + fr, 32 * ks + 8 * fq); fK[m][ks] = ldfrag(KH, P64, 16 * m + fr, 32 * ks + 8 * fq);
                                                     fA[m][ks] = ldfrag(AT, P64, 16 * m + fr, 32 * ks + 8 * fq); fR[m][ks] = ldfrag(RT, P64, 16 * m + fr, 32 * ks + 8 * fq); }
                asm volatile("s_waitcnt lgkmcnt(0)" ::: "memory");
#pragma unroll
                for (int mat = 0; mat < 4; ++mat)
#pragma unroll
                    for (int mt = 0; mt < 2; ++mt)
#pragma unroll
                        for (int nt = 0; nt < 2; ++nt) {
                            f32x4 g = ZERO4();
                            if (!(mt == 1 && nt == 0)) {
#pragma unroll
                                for (int ks = 0; ks < 2; ++ks) g = __builtin_amdgcn_mfma_f32_16x16x32_bf16((mat & 1) ? fK[mt][ks] : fB[mt][ks], (mat & 2) ? fR[nt][ks] : fA[nt][ks], g, 0, 0, 0);
                            }
                            const int t = 16 * nt + fr, s0 = 16 * mt + 4 * fq;
                            if (mt == nt) {
#pragma unroll
                                for (int r = 0; r < 4; ++r) { const int s = s0 + r; const bool keep = (mat < 2) ? (s < t) : (s <= t); g[r] = keep ? g[r] : 0.f; }
                            }
                            if (mat == 0) *(LAS f32x4*)(NabT + t * 36 + s0) = g;
                            else { u32x2 w; w.x = cvt_pk_bf16(g[0], g[1]); w.y = cvt_pk_bf16(g[2], g[3]); *(u32x2*)(ug + IMG_NAK + (mat - 1) * 2048 + (t * 32 + s0) * 2) = w; }
                        }
            }
#endif
            asm volatile("s_waitcnt lgkmcnt(0)" ::: "memory");
#ifndef MK_X_NOSOLVE
            {
                float Tr[32];
                f32x4 rowb[2][8];
#pragma unroll
                for (int t = 0; t < 32; ++t) {
                    if (t + 1 < 32) {
#pragma unroll
                        for (int q = 0; q < 8; ++q) if (4 * q < t + 1) rowb[(t + 1) & 1][q] = *(const LAS f32x4*)(NabT + (t + 1) * 36 + 4 * q);
                    }
                    float acc4[4] = {(ln == t) ? 1.f : 0.f, 0.f, 0.f, 0.f};
#pragma unroll
                    for (int q = 0; q < 8; ++q)
#pragma unroll
                        for (int e = 0; e < 4; ++e) if (4 * q + e < t) acc4[e] += Tr[4 * q + e] * rowb[t & 1][q][e];
                    const float acc = (acc4[0] + acc4[1]) + (acc4[2] + acc4[3]);
                    Tr[t] = acc;
                    if (ln < 32) *(bf16_t*)(ug + IMG_TT + (t * 32 + ln) * 2) = (bf16_t)(cvt_pk_bf16(acc, 0.f) & 0xffffu);
                }
            }
#endif
            {
                const int row = lane >> 1, hf = lane & 1;
#pragma unroll
                for (int q = 0; q < 4; ++q) {
                    *(u32x4*)(ug + IMG_AT + row * 128 + hf * 64 + q * 16) = *(const LAS u32x4*)(AT + row * P64 + hf * 32 + 8 * q);
                    *(u32x4*)(ug + IMG_RT + row * 128 + hf * 64 + q * 16) = *(const LAS u32x4*)(RT + row * P64 + hf * 32 + 8 * q);
                }
            }
            asm volatile("s_waitcnt lgkmcnt(0)" ::: "memory");
        }
    }
}

constexpr int SK_AT = 0, SK_RT = 4608, SK_S0 = 9216, SK_NAK = 13824, SK_MBR = 16384, SK_MKR = 18944, SK_TT = 21504, SK_VI = 24064, SK_WI = 26624, SK_UI = 29184, SK_BH = 31744, SK_KH = 36864, SK_PL = 41984, SK_END = 42240, SK_BUF = SK_END;
static_assert(2 * SK_BUF <= MISC_OFF, "rwkv state phase LDS map");
__device__ __forceinline__ void rwkv_state_phase(LAS unsigned char* lds, const unsigned char* img, bf16_t* y_, const RwScan& a_, const int vcu, const int G, const int tid0_) {
    const int wave = __builtin_amdgcn_readfirstlane(tid0_ >> 6);
    const float* const a_cw1 = a_.cw1; const float* const a_cw3 = a_.cw3; const float* const a_cw2 = a_.cw2; bf16_t* const a_cwt = a_.cwt; const int a_cmoe = a_.cmoe;
    const int cv_total = a_cmoe ? NE * 3 * 2816 : 3 * 5632, cv_stride = G * 4, cv_cut = a_cmoe ? MK_CV_CUT_MOE : MK_CV_CUT_DENSE;
#define CV_DECODE(it_) int e_, j_, k0_, n0_; if (a_cmoe) cv_decode<true>((it_), e_, j_, k0_, n0_); else cv_decode<false>((it_), e_, j_, k0_, n0_); \
        const int dfe_ = a_cmoe ? DFE : DFF, K_ = (j_ == 2) ? dfe_ : D, N_ = (j_ == 2) ? D : dfe_; \
        const float* W_ = (j_ == 0 ? a_cw1 : (j_ == 1 ? a_cw3 : a_cw2)) + (size_t)e_ * D * dfe_;
#define CV_LOAD(cvv, cv_it, cv_pend) do { if (cv_it < cv_total) { CV_DECODE(cv_it) const int cl_ = tid0_ & 63; \
            const float* src_ = W_ + (size_t)(k0_ + 32 * (cl_ >> 5)) * N_ + n0_ + (cl_ & 31); \
            _Pragma("unroll") for (int i = 0; i < 32; ++i) cvv[i] = src_[(size_t)i * N_]; cv_pend = true; } } while (0)
#define CV_STORE(cvv, cv_it, cv_pend) do { if (cv_pend) { CV_DECODE(cv_it) (void)W_; const int cl_ = tid0_ & 63; \
            const int drow_ = (j_ == 2) ? (a_cmoe ? e_ * D + n0_ : n0_) : (a_cmoe ? e_ * 2 * DFE : 0) + 256 * (n0_ / 128) + j_ * 128 + (n0_ % 128); \
            bf16_t* WT_ = a_cwt + ((j_ == 2) ? (size_t)(a_cmoe ? NE * 2 * DFE : 2 * DFF) * D : (size_t)0) + (size_t)(drow_ + (cl_ & 31)) * K_ + k0_ + 32 * (cl_ >> 5); \
            _Pragma("unroll") for (int q = 0; q < 4; ++q) { u32x4 o; o.x = cvt_pk_bf16(cvv[8 * q], cvv[8 * q + 1]); o.y = cvt_pk_bf16(cvv[8 * q + 2], cvv[8 * q + 3]); o.z = cvt_pk_bf16(cvv[8 * q + 4], cvv[8 * q + 5]); o.w = cvt_pk_bf16(cvv[8 * q + 6], cvv[8 * q + 7]); \
                *(u32x4*)(WT_ + 8 * q) = o; } \
            cv_pend = false; cv_it += cv_stride; } } while (0)
    LAS bf16_t* Wi = (LAS bf16_t*)(lds + SK_WI); LAS bf16_t* Ui = (LAS bf16_t*)(lds + SK_UI);
    for (int u = vcu; u < BATCH * RW_H * 2; u += G) {
        const int b = u >> 5, h = (u >> 1) & 15, half = u & 1;
        const unsigned char* ub = img + (size_t)((b * RW_H + h) * (SEQ / 32)) * IMG_UNIT;
        f32x4 Sacc = ZERO4();
        u32x4 q0a, q0b, q1a, q1b, q2a, q2b, q3;
        int cv_itA = cv_cut + vcu * 4 + (wave & 3); bool cv_pendA = false; float cvA[32];
#pragma unroll
        for (int i = 0; i < 32; ++i) cvA[i] = 0.f;
#define ST_FETCH(ch_) do { if (wave < 4) { const unsigned char* ug_ = ub + (size_t)(ch_) * IMG_UNIT; const int tf_ = tid0_; \
            q0a = *(const u32x4*)(ug_ + IMG_AT + tf_ * 16); q0b = *(const u32x4*)(ug_ + IMG_RT + tf_ * 16); q1a = *(const u32x4*)(ug_ + IMG_NAK + tf_ * 16); q1b = *(const u32x4*)(ug_ + IMG_MKR + tf_ * 16); \
            q2a = *(const u32x4*)(ug_ + IMG_BH + tf_ * 16); q2b = *(const u32x4*)(ug_ + IMG_KH + tf_ * 16); \
            if (tf_ < 128) q3 = *(const u32x4*)(ug_ + IMG_VI + (tf_ >> 2) * 128 + half * 64 + (tf_ & 3) * 16); else if (tf_ < 144) q3 = *(const u32x4*)(ug_ + IMG_PL + (tf_ - 128) * 16); } } while (0)
        q0a = q0b = q1a = q1b = q2a = q2b = q3 = (u32x4){0u, 0u, 0u, 0u};
        ST_FETCH(0);
        for (int ch = 0; ch < SEQ / 32; ++ch) {
            const int t0 = ch * 32;
            int tid_c = tid0_; asm volatile("" : "+v"(tid_c));
            const int tid = tid_c, lane = tid & 63, fr = lane & 15, fq = lane >> 4;
            LAS unsigned char* lb = lds + (ch & 1) * SK_BUF;
            LAS bf16_t* AT = (LAS bf16_t*)(lb + SK_AT); LAS bf16_t* RT = (LAS bf16_t*)(lb + SK_RT); LAS bf16_t* S0 = (LAS bf16_t*)(lb + SK_S0);
            LAS bf16_t* NakT = (LAS bf16_t*)(lb + SK_NAK); LAS bf16_t* MbrT = (LAS bf16_t*)(lb + SK_MBR); LAS bf16_t* MkrT = (LAS bf16_t*)(lb + SK_MKR); LAS bf16_t* TT = (LAS bf16_t*)(lb + SK_TT);
            LAS bf16_t* Vi = (LAS bf16_t*)(lb + SK_VI); LAS bf16_t* BhT = (LAS bf16_t*)(lb + SK_BH); LAS bf16_t* KhT = (LAS bf16_t*)(lb + SK_KH); LAS float* PL = (LAS float*)(lb + SK_PL);
            if (wave < 4) {
                { const int o_ = (tid >> 3) * 144 + (tid & 7) * 16; *(LAS u32x4*)(lb + SK_AT + o_) = q0a; *(LAS u32x4*)(lb + SK_RT + o_) = q0b; }
                { const int idx = tid & 127, o_ = (tid >> 7) * 2560 + (idx >> 2) * 80 + (idx & 3) * 16; *(LAS u32x4*)(lb + SK_NAK + o_) = q1a; *(LAS u32x4*)(lb + SK_MKR + o_) = q1b; }
                { const int o_ = (tid >> 2) * 80 + (tid & 3) * 16; *(LAS u32x4*)(lb + SK_BH + o_) = q2a; *(LAS u32x4*)(lb + SK_KH + o_) = q2b; }
                if (tid < 128) { const int t_ = tid >> 2, i0_ = 8 * (tid & 3); const unsigned wv_[4] = {q3.x, q3.y, q3.z, q3.w};
#pragma unroll
                    for (int e = 0; e < 4; ++e) { Vi[(i0_ + 2 * e) * P32 + t_] = (bf16_t)(wv_[e] & 0xffffu); Vi[(i0_ + 2 * e + 1) * P32 + t_] = (bf16_t)(wv_[e] >> 16); } }
                else if (tid < 144) *(LAS u32x4*)(lb + SK_PL + (tid - 128) * 16) = q3;
            }
            { const int mt = wave >> 1, nt = wave & 1; u32x2 o; o.x = cvt_pk_bf16(Sacc[0], Sacc[1]); o.y = cvt_pk_bf16(Sacc[2], Sacc[3]);
              *(LAS u32x2*)(S0 + (16 * nt + fr) * P64 + 16 * mt + 4 * fq) = o; }
            __syncthreads();
            if (ch + 1 < SEQ / 32) ST_FETCH(ch + 1);
            if (wave >= 4) {
                const int mt = (wave - 4) >> 1, nt = (wave - 4) & 1;
                f32x4 w = ZERO4();
#pragma unroll
                for (int ks = 0; ks < 2; ++ks) w = __builtin_amdgcn_mfma_f32_16x16x32_bf16(ldfrag(AT, P64, 16 * mt + fr, 32 * ks + 8 * fq), ldfrag(S0, P64, 16 * nt + fr, 32 * ks + 8 * fq), w, 0, 0, 0);
                w = __builtin_amdgcn_mfma_f32_16x16x32_bf16(ldfrag(NakT, P32, 16 * mt + fr, 8 * fq), ldfrag(Vi, P32, 16 * nt + fr, 8 * fq), w, 0, 0, 0);
                u32x2 o; o.x = cvt_pk_bf16(w[0], w[1]); o.y = cvt_pk_bf16(w[2], w[3]); *(LAS u32x2*)(Wi + (16 * nt + fr) * P32 + 16 * mt + 4 * fq) = o;
            }
            __syncthreads();
            if (wave < 4) {
                const int mt = wave >> 1, nt = wave & 1;
                f32x4 uu = ZERO4();
                uu = __builtin_amdgcn_mfma_f32_16x16x32_bf16(ldfrag(TT, P32, 16 * mt + fr, 8 * fq), ldfrag(Wi, P32, 16 * nt + fr, 8 * fq), uu, 0, 0, 0);
                u32x2 o; o.x = cvt_pk_bf16(uu[0], uu[1]); o.y = cvt_pk_bf16(uu[2], uu[3]); *(LAS u32x2*)(Ui + (16 * nt + fr) * P32 + 16 * mt + 4 * fq) = o;
            }
            if (wave >= 4) { CV_STORE(cvA, cv_itA, cv_pendA); CV_LOAD(cvA, cv_itA, cv_pendA); }
            __syncthreads();
            if (wave < 4) {
                const int mt = wave >> 1, nt = wave & 1;
                f32x4 y = ZERO4();
#pragma unroll
                for (int ks = 0; ks < 2; ++ks) y = __builtin_amdgcn_mfma_f32_16x16x32_bf16(ldfrag(S0, P64, 16 * mt + fr, 32 * ks + 8 * fq), ldfrag(RT, P64, 16 * nt + fr, 32 * ks + 8 * fq), y, 0, 0, 0);
                y = __builtin_amdgcn_mfma_f32_16x16x32_bf16(ldfrag(Ui, P32, 16 * mt + fr, 8 * fq), ldfrag(MbrT, P32, 16 * nt + fr, 8 * fq), y, 0, 0, 0);
                y = __builtin_amdgcn_mfma_f32_16x16x32_bf16(ldfrag(Vi, P32, 16 * mt + fr, 8 * fq), ldfrag(MkrT, P32, 16 * nt + fr, 8 * fq), y, 0, 0, 0);
                u32x2 o; o.x = cvt_pk_bf16(y[0], y[1]); o.y = cvt_pk_bf16(y[2], y[3]);
                *(u32x2*)(y_ + (size_t)(b * SEQ + t0 + 16 * nt + fr) * 1024 + h * 64 + half * 32 + 16 * mt + 4 * fq) = o;
            }
            {
                const int mt = wave >> 1, nt = wave & 1;
                const f32x4 pl = *(const LAS f32x4*)(PL + 16 * mt + 4 * fq);
                Sacc = __builtin_amdgcn_mfma_f32_16x16x32_bf16(ldfrag(BhT, P32, 16 * mt + fr, 8 * fq), ldfrag(Ui, P32, 16 * nt + fr, 8 * fq), Sacc, 0, 0, 0);
                Sacc = __builtin_amdgcn_mfma_f32_16x16x32_bf16(ldfrag(KhT, P32, 16 * mt + fr, 8 * fq), ldfrag(Vi, P32, 16 * nt + fr, 8 * fq), Sacc, 0, 0, 0);
                Sacc = Sacc * pl;
            }
        }
        if (wave >= 4) { do { CV_STORE(cvA, cv_itA, cv_pendA); CV_LOAD(cvA, cv_itA, cv_pendA); } while (cv_pendA); }
        __syncthreads();
#undef CV_DECODE
#undef CV_LOAD
#undef CV_STORE
#undef ST_FETCH
    }
}

__device__ __forceinline__ void ld_bf16x16(const bf16_t* p, f32x4 (&o)[4]) { const u32x4 a = *(const u32x4*)p, b = *(const u32x4*)(p + 8);
    o[0] = (f32x4){bf_lo(a.x), bf_hi(a.x), bf_lo(a.y), bf_hi(a.y)}; o[1] = (f32x4){bf_lo(a.z), bf_hi(a.z), bf_lo(a.w), bf_hi(a.w)};
    o[2] = (f32x4){bf_lo(b.x), bf_hi(b.x), bf_lo(b.y), bf_hi(b.y)}; o[3] = (f32x4){bf_lo(b.z), bf_hi(b.z), bf_lo(b.w), bf_hi(b.w)}; }
__device__ __forceinline__ void rwkv_post_phase(const bf16_t* __restrict__ yrw, const bf16_t* __restrict__ bon, const bf16_t* __restrict__ lw_g, const float* __restrict__ ln_w, const float* __restrict__ ln_b, bf16_t* __restrict__ ymixb, const int gw, const int NGW, const int lane) {
    const int c0 = 16 * lane;
    f32x4 lw4[4], lb4[4];
#pragma unroll
    for (int j = 0; j < 4; ++j) { lw4[j] = *(const f32x4*)(ln_w + c0 + 4 * j); lb4[j] = *(const f32x4*)(ln_b + c0 + 4 * j); }
#pragma unroll 2
    for (int m = gw; m < M; m += NGW) {
        f32x4 y[4], bo[4];
        ld_bf16x16(yrw + (size_t)m * 1024 + c0, y); ld_bf16x16(bon + (size_t)m * 1024 + c0, bo);
        const u32x4 g0 = *(const u32x4*)(lw_g + (size_t)m * 1024 + c0), g1 = *(const u32x4*)(lw_g + (size_t)m * 1024 + c0 + 8);
        float s = 0.f;
#pragma unroll
        for (int j = 0; j < 4; ++j) s += (y[j][0] + y[j][1]) + (y[j][2] + y[j][3]);
        s += __shfl_xor(s, 1); s += __shfl_xor(s, 2);
        const float mu = s * (1.f / 64.f);
        float q = 0.f;
#pragma unroll
        for (int j = 0; j < 4; ++j) { y[j] = y[j] - mu; q += (y[j][0] * y[j][0] + y[j][1] * y[j][1]) + (y[j][2] * y[j][2] + y[j][3] * y[j][3]); }
        q += __shfl_xor(q, 1); q += __shfl_xor(q, 2);
        const float rstd = rsqrtf(q * (1.f / 64.f) + 64e-5f);
        float o[16];
#pragma unroll
        for (int j = 0; j < 4; ++j) { const f32x4 t = y[j] * rstd * lw4[j] + lb4[j] + bo[j]; o[4 * j] = t[0]; o[4 * j + 1] = t[1]; o[4 * j + 2] = t[2]; o[4 * j + 3] = t[3]; }
        const unsigned gw_[8] = {g0.x, g0.y, g0.z, g0.w, g1.x, g1.y, g1.z, g1.w};
        u32x4 w0, w1;
        w0.x = cvt_pk_bf16(o[0] * bf_lo(gw_[0]), o[1] * bf_hi(gw_[0])); w0.y = cvt_pk_bf16(o[2] * bf_lo(gw_[1]), o[3] * bf_hi(gw_[1]));
        w0.z = cvt_pk_bf16(o[4] * bf_lo(gw_[2]), o[5] * bf_hi(gw_[2])); w0.w = cvt_pk_bf16(o[6] * bf_lo(gw_[3]), o[7] * bf_hi(gw_[3]));
        w1.x = cvt_pk_bf16(o[8] * bf_lo(gw_[4]), o[9] * bf_hi(gw_[4])); w1.y = cvt_pk_bf16(o[10] * bf_lo(gw_[5]), o[11] * bf_hi(gw_[5]));
        w1.z = cvt_pk_bf16(o[12] * bf_lo(gw_[6]), o[13] * bf_hi(gw_[6])); w1.w = cvt_pk_bf16(o[14] * bf_lo(gw_[7]), o[15] * bf_hi(gw_[7]));
        *(u32x4*)(ymixb + (size_t)m * 2048 + 1024 + c0) = w0; *(u32x4*)(ymixb + (size_t)m * 2048 + 1024 + c0 + 8) = w1;
    }
}

__device__ __forceinline__ void ssd_conv_phase(const bf16_t* projb, const float* cw, const float* cb, const float* dt_bias, bf16_t* xbcc, float* dtb, const int vcu, const int G, const int tid) {
    for (int u = vcu; u < M / 64; u += G) {
        if (tid < 384) {
            const int cg = tid % 192, hf = tid / 192, c0 = 8 * cg, m0 = u * 64 + 32 * hf, t_in_seq = m0 % SEQ;
            float w[4][8], bias[8];
#pragma unroll
            for (int q = 0; q < 4; ++q) { const f32x4 a = *(const f32x4*)(cw + q * CONV_DIM + c0), b = *(const f32x4*)(cw + q * CONV_DIM + c0 + 4);
                w[q][0] = a[0]; w[q][1] = a[1]; w[q][2] = a[2]; w[q][3] = a[3]; w[q][4] = b[0]; w[q][5] = b[1]; w[q][6] = b[2]; w[q][7] = b[3]; }
            { const f32x4 a = *(const f32x4*)(cb + c0), b = *(const f32x4*)(cb + c0 + 4); bias[0] = a[0]; bias[1] = a[1]; bias[2] = a[2]; bias[3] = a[3]; bias[4] = b[0]; bias[5] = b[1]; bias[6] = b[2]; bias[7] = b[3]; }
            float win[3][8];
#pragma unroll
            for (int q = 0; q < 3; ++q) {
                u32x4 r = (u32x4){0u, 0u, 0u, 0u};
                if (t_in_seq - 3 + q >= 0) r = *(const u32x4*)(projb + (size_t)(m0 - 3 + q) * PROJ_BLD + OFF_XBC + c0);
                win[q][0] = bf_lo(r.x); win[q][1] = bf_hi(r.x); win[q][2] = bf_lo(r.y); win[q][3] = bf_hi(r.y); win[q][4] = bf_lo(r.z); win[q][5] = bf_hi(r.z); win[q][6] = bf_lo(r.w); win[q][7] = bf_hi(r.w);
            }
            for (int i0 = 0; i0 < 32; i0 += 8) {
                u32x4 rr[8];
#pragma unroll
                for (int q = 0; q < 8; ++q) rr[q] = *(const u32x4*)(projb + (size_t)(m0 + i0 + q) * PROJ_BLD + OFF_XBC + c0);
#pragma unroll
                for (int q = 0; q < 8; ++q) {
                    const u32x4 r = rr[q];
                    float cur[8] = {bf_lo(r.x), bf_hi(r.x), bf_lo(r.y), bf_hi(r.y), bf_lo(r.z), bf_hi(r.z), bf_lo(r.w), bf_hi(r.w)};
                    float o[8];
#pragma unroll
                    for (int e = 0; e < 8; ++e) { const float acc = bias[e] + w[0][e] * win[0][e] + w[1][e] * win[1][e] + w[2][e] * win[2][e] + w[3][e] * cur[e]; o[e] = fast_silu(acc);
                        win[0][e] = win[1][e]; win[1][e] = win[2][e]; win[2][e] = cur[e]; }
                    u32x4 wv; wv.x = cvt_pk_bf16(o[0], o[1]); wv.y = cvt_pk_bf16(o[2], o[3]); wv.z = cvt_pk_bf16(o[4], o[5]); wv.w = cvt_pk_bf16(o[6], o[7]);
                    *(u32x4*)(xbcc + (size_t)(m0 + i0 + q) * CONV_DIM + c0) = wv;
                }
            }
        }
#pragma unroll
        for (int q = 0; q < 2; ++q) { const int idx = tid + 512 * q, m = u * 64 + (idx >> 4), h = idx & 15;
            const float x = bf2f(projb[(size_t)m * PROJ_BLD + OFF_DT + h]) + dt_bias[h];
            dtb[(size_t)m * SSD_H + h] = fmaxf(x, 0.f) + log1pf(expf(-fabsf(x))); }
    }
}

constexpr int SP = 136;
constexpr int SS_C = 0, SS_B = 34816, SS_BT = 69632, SS_XT = 104448, SS_XW = 113152, SS_HT = 121856, SS_AC = 130560, SS_DT = 131072, SS_END = 131584;
__device__ __forceinline__ void ssd_scan_phase(LAS unsigned char* lds, const bf16_t* xbcc, const float* dtb, const float* a_log, const float* dskip, bf16_t* yssd, const int vcu, const int G, const int tid) {
    const int wave = __builtin_amdgcn_readfirstlane(tid >> 6), lane = tid & 63, fr = lane & 15, fq = lane >> 4;
    const int lt = (wave < 4) ? 2 * wave : 15 - 2 * wave;
    LAS bf16_t* Cimg = (LAS bf16_t*)(lds + SS_C); LAS bf16_t* Bimg = (LAS bf16_t*)(lds + SS_B); LAS bf16_t* BTimg = (LAS bf16_t*)(lds + SS_BT);
    LAS bf16_t* xT = (LAS bf16_t*)(lds + SS_XT); LAS bf16_t* xwT = (LAS bf16_t*)(lds + SS_XW); LAS bf16_t* hT = (LAS bf16_t*)(lds + SS_HT);
    LAS float* acum = (LAS float*)(lds + SS_AC); LAS float* dtv = (LAS float*)(lds + SS_DT);
    for (int u = vcu; u < BATCH * SSD_H * 2; u += G) {
        const int b = u >> 5, h = (u >> 1) & 15, phalf = u & 1, g = h >> 3;
        const float Ah = -expf(a_log[h]) * 1.4426950408889634f;
        const float dsk = dskip[h];
        f32x4 hs[2] = {(f32x4){0.f, 0.f, 0.f, 0.f}, (f32x4){0.f, 0.f, 0.f, 0.f}};
        for (int i = tid; i < 32 * SP / 2; i += 512) ((LAS unsigned*)hT)[i] = 0u;
        const int row = tid >> 2, part = tid & 3;
        u32x4 cvn[4], bvn[4], xrn; float dtn = 0.f, dtn1 = 0.f;
#define SS_FETCH(ch_) do { const bf16_t* src_ = xbcc + (size_t)(b * SEQ + (ch_) * 128 + row) * CONV_DIM; \
        _Pragma("unroll") for (int j = 0; j < 4; ++j) { cvn[j] = *(const u32x4*)(src_ + 1280 + g * 128 + 32 * part + 8 * j); bvn[j] = *(const u32x4*)(src_ + 1024 + g * 128 + 32 * part + 8 * j); } \
        xrn = *(const u32x4*)(src_ + h * 64 + phalf * 32 + 8 * part); \
        if (tid < 64) { const float* dp_ = dtb + (size_t)(b * SEQ + (ch_) * 128 + 2 * tid) * SSD_H + h; dtn = dp_[0]; dtn1 = dp_[SSD_H]; } } while (0)
        SS_FETCH(0);
        for (int ch = 0; ch < SEQ / 128; ++ch) {
            const int mrow0 = b * SEQ + ch * 128;
            u32x4 xr;
            {
                u32x4 cv[4], bv[4];
#pragma unroll
                for (int j = 0; j < 4; ++j) { cv[j] = cvn[j]; bv[j] = bvn[j]; }
                xr = xrn;
                if (wave == 0) {
                    const float d0 = dtn, d1 = dtn1;
                    *(LAS f32x2*)(dtv + 2 * lane) = (f32x2){d0, d1};
                    const float v0 = d0 * Ah, v1 = d1 * Ah;
                    float s = v0 + v1;
#define SS_DPPF(x_, ctrl_, rm_, bc_) __int_as_float(__builtin_amdgcn_update_dpp(0, __float_as_int(x_), (ctrl_), (rm_), 0xF, (bc_)))
                    s += SS_DPPF(s, 0x111, 0xF, true); asm("" : "+v"(s));
                    s += SS_DPPF(s, 0x112, 0xF, true); asm("" : "+v"(s));
                    s += SS_DPPF(s, 0x114, 0xF, true); asm("" : "+v"(s));
                    s += SS_DPPF(s, 0x118, 0xF, true); asm("" : "+v"(s));
                    s += SS_DPPF(s, 0x142, 0xA, false); asm("" : "+v"(s));
                    s += SS_DPPF(s, 0x143, 0xC, false); asm("" : "+v"(s));
#undef SS_DPPF
                    *(LAS f32x2*)(acum + 2 * lane) = (f32x2){s - v1, s};
                }
                if (ch + 1 < SEQ / 128) SS_FETCH(ch + 1);
#pragma unroll
                for (int j = 0; j < 4; ++j) { *(LAS u32x4*)(Cimg + row * SP + 32 * part + 8 * j) = cv[j]; *(LAS u32x4*)(Bimg + row * SP + 32 * part + 8 * j) = bv[j]; }
#pragma unroll
                for (int j = 0; j < 4; ++j) { const unsigned wv[4] = {bv[j].x, bv[j].y, bv[j].z, bv[j].w};
#pragma unroll
                    for (int e = 0; e < 4; ++e) { const int n = 32 * part + 8 * j + 2 * e; BTimg[n * SP + row] = (bf16_t)(wv[e] & 0xffffu); BTimg[(n + 1) * SP + row] = (bf16_t)(wv[e] >> 16); } }
            }
            __syncthreads();
            const float atot = acum[127];
            {
                const float wgt = dtv[row] * __builtin_amdgcn_exp2f(atot - acum[row]);
                const unsigned wv[4] = {xr.x, xr.y, xr.z, xr.w};
#pragma unroll
                for (int e = 0; e < 4; ++e) { const int p = 8 * part + 2 * e; const float x0 = bf_lo(wv[e]), x1 = bf_hi(wv[e]);
                    xT[p * SP + row] = (bf16_t)(wv[e] & 0xffffu); xT[(p + 1) * SP + row] = (bf16_t)(wv[e] >> 16);
                    const unsigned pk = cvt_pk_bf16(x0 * wgt, x1 * wgt); xwT[p * SP + row] = (bf16_t)(pk & 0xffffu); xwT[(p + 1) * SP + row] = (bf16_t)(pk >> 16); }
            }
            f32x4 gacc[8];
#pragma unroll
            for (int st = 0; st < 8; ++st) gacc[st] = (f32x4){0.f, 0.f, 0.f, 0.f};
            {
                bf16x8 cf[4];
#pragma unroll
                for (int ks = 0; ks < 4; ++ks) cf[ks] = *(const LAS bf16x8*)(Cimg + (16 * lt + fr) * SP + 32 * ks + 8 * fq);
#pragma unroll
                for (int st = 0; st < 8; ++st) if (st <= lt) {
#pragma unroll
                    for (int ks = 0; ks < 4; ++ks) { const bf16x8 bfg = *(const LAS bf16x8*)(Bimg + (16 * st + fr) * SP + 32 * ks + 8 * fq);
                        gacc[st] = __builtin_amdgcn_mfma_f32_16x16x32_bf16(bfg, cf[ks], gacc[st], 0, 0, 0); }
                }
            }
            __syncthreads();
            {
                LAS bf16_t* Mimg = Bimg;
                const int l = 16 * lt + fr; const float al = acum[l];
#pragma unroll
                for (int st = 0; st < 8; ++st) if (st <= lt + 1) {
                    u32x2 wv = (u32x2){0u, 0u};
                    if (st <= lt) {
                        const f32x4 as4 = *(const LAS f32x4*)(acum + 16 * st + 4 * fq), dt4 = *(const LAS f32x4*)(dtv + 16 * st + 4 * fq);
                        float mv[4];
#pragma unroll
                        for (int r = 0; r < 4; ++r) { const int s = 16 * st + 4 * fq + r; mv[r] = (s <= l) ? gacc[st][r] * dt4[r] * __builtin_amdgcn_exp2f(al - as4[r]) : 0.f; }
                        wv.x = cvt_pk_bf16(mv[0], mv[1]); wv.y = cvt_pk_bf16(mv[2], mv[3]);
                    }
                    *(LAS u32x2*)(Mimg + l * SP + 16 * st + 4 * fq) = wv;
                }
            }
            __syncthreads();
            {
                const LAS bf16_t* Mimg = Bimg;
                f32x4 yd[2] = {(f32x4){0.f, 0.f, 0.f, 0.f}, (f32x4){0.f, 0.f, 0.f, 0.f}}, yo[2] = {(f32x4){0.f, 0.f, 0.f, 0.f}, (f32x4){0.f, 0.f, 0.f, 0.f}};
#pragma unroll
                for (int ks = 0; ks < 4; ++ks) {
                    const bf16x8 cfr = *(const LAS bf16x8*)(Cimg + (16 * lt + fr) * SP + 32 * ks + 8 * fq);
#pragma unroll
                    for (int pt = 0; pt < 2; ++pt) { const bf16x8 hf = *(const LAS bf16x8*)(hT + (16 * pt + fr) * SP + 32 * ks + 8 * fq);
                        yo[pt] = __builtin_amdgcn_mfma_f32_16x16x32_bf16(hf, cfr, yo[pt], 0, 0, 0); }
                    if (2 * ks <= lt) {
                        const bf16x8 mf = *(const LAS bf16x8*)(Mimg + (16 * lt + fr) * SP + 32 * ks + 8 * fq);
#pragma unroll
                        for (int pt = 0; pt < 2; ++pt) { const bf16x8 xf_ = *(const LAS bf16x8*)(xT + (16 * pt + fr) * SP + 32 * ks + 8 * fq);
                            yd[pt] = __builtin_amdgcn_mfma_f32_16x16x32_bf16(xf_, mf, yd[pt], 0, 0, 0); }
                    }
                }
                const int l = 16 * lt + fr; const float el = __builtin_amdgcn_exp2f(acum[l]);
#pragma unroll
                for (int pt = 0; pt < 2; ++pt) {
                    f32x4 o;
#pragma unroll
                    for (int r = 0; r < 4; ++r) o[r] = yd[pt][r] + el * yo[pt][r] + dsk * bf2f(xT[(16 * pt + 4 * fq + r) * SP + l]);
                    { u32x2 w2; w2.x = cvt_pk_bf16(o[0], o[1]); w2.y = cvt_pk_bf16(o[2], o[3]); *(u32x2*)(yssd + (size_t)(mrow0 + l) * 1024 + h * 64 + phalf * 32 + 16 * pt + 4 * fq) = w2; }
                }
            }
            {
                const float ea = __builtin_amdgcn_exp2f(atot);
                hs[0] = hs[0] * ea; hs[1] = hs[1] * ea;
#pragma unroll
                for (int ks = 0; ks < 4; ++ks) {
                    const bf16x8 btf = *(const LAS bf16x8*)(BTimg + (16 * wave + fr) * SP + 32 * ks + 8 * fq);
#pragma unroll
                    for (int pt = 0; pt < 2; ++pt) { const bf16x8 xwf = *(const LAS bf16x8*)(xwT + (16 * pt + fr) * SP + 32 * ks + 8 * fq);
                        hs[pt] = __builtin_amdgcn_mfma_f32_16x16x32_bf16(btf, xwf, hs[pt], 0, 0, 0); }
                }
            }
            __syncthreads();
#pragma unroll
            for (int pt = 0; pt < 2; ++pt) { u32x2 wv; wv.x = cvt_pk_bf16(hs[pt][0], hs[pt][1]); wv.y = cvt_pk_bf16(hs[pt][2], hs[pt][3]);
                *(LAS u32x2*)(hT + (16 * pt + fr) * SP + 16 * wave + 4 * fq) = wv; }
        }
#undef SS_FETCH
        __syncthreads();
    }
}

__device__ __forceinline__ void ssd_post_phase(const bf16_t* __restrict__ yssd, const bf16_t* __restrict__ projb, const float* __restrict__ norm_w, bf16_t* __restrict__ ymixb, const int gw, const int NGW, const int lane) {
    const int c0 = 16 * lane;
    f32x4 nw[4];
#pragma unroll
    for (int j = 0; j < 4; ++j) nw[j] = *(const f32x4*)(norm_w + c0 + 4 * j);
#pragma unroll 2
    for (int m = gw; m < M; m += NGW) {
        f32x4 y[4];
        ld_bf16x16(yssd + (size_t)m * 1024 + c0, y);
        const u32x4 z0 = *(const u32x4*)(projb + (size_t)m * PROJ_BLD + OFF_Z + c0), z1 = *(const u32x4*)(projb + (size_t)m * PROJ_BLD + OFF_Z + c0 + 8);
        const unsigned zw[8] = {z0.x, z0.y, z0.z, z0.w, z1.x, z1.y, z1.z, z1.w};
        float uu[16]; float ss = 0.f;
#pragma unroll
        for (int e = 0; e < 8; ++e) { uu[2 * e] = y[e >> 1][(2 * e) & 3] * fast_silu(bf_lo(zw[e])); uu[2 * e + 1] = y[e >> 1][(2 * e + 1) & 3] * fast_silu(bf_hi(zw[e])); ss += uu[2 * e] * uu[2 * e] + uu[2 * e + 1] * uu[2 * e + 1]; }
#pragma unroll
        for (int o = 1; o < 32; o <<= 1) ss += __shfl_xor(ss, o);
        const float rs = rsqrtf(ss * (1.f / 512.f) + 1e-5f);
        u32x4 w0, w1;
        w0.x = cvt_pk_bf16(uu[0] * rs * nw[0][0], uu[1] * rs * nw[0][1]); w0.y = cvt_pk_bf16(uu[2] * rs * nw[0][2], uu[3] * rs * nw[0][3]);
        w0.z = cvt_pk_bf16(uu[4] * rs * nw[1][0], uu[5] * rs * nw[1][1]); w0.w = cvt_pk_bf16(uu[6] * rs * nw[1][2], uu[7] * rs * nw[1][3]);
        w1.x = cvt_pk_bf16(uu[8] * rs * nw[2][0], uu[9] * rs * nw[2][1]); w1.y = cvt_pk_bf16(uu[10] * rs * nw[2][2], uu[11] * rs * nw[2][3]);
        w1.z = cvt_pk_bf16(uu[12] * rs * nw[3][0], uu[13] * rs * nw[3][1]); w1.w = cvt_pk_bf16(uu[14] * rs * nw[3][2], uu[15] * rs * nw[3][3]);
        *(u32x4*)(ymixb + (size_t)m * 2048 + c0) = w0; *(u32x4*)(ymixb + (size_t)m * 2048 + c0 + 8) = w1;
    }
}

#define PH_BEGIN int z_ = 0; asm volatile("" : "+s"(z_)); unsigned char* const wsq = P.ws + z_; int tid = tid0; asm volatile("" : "+v"(tid)); \
    const int G = G0 + z_, bx = bx0 + z_, vcu = vcu0 + z_, lane = tid & 63, wave = __builtin_amdgcn_readfirstlane(tid >> 6), gw = vcu * NWAVES + wave, NGW = G * NWAVES; (void)bx; (void)lane; (void)gw; (void)NGW; (void)wave;
#define CVT_MIXER_WEIGHTS(L_, gw, NGW, tix, tnum) do { const int L = (L_); \
            cvt_job<0>(INP(1) + (size_t)L * D * IN_DIM, D, IN_DIM, Win_t, 0, 0, scr, gw, NGW, lane); \
            if (L > 0) cvt_job<0>(INP(2) + (size_t)(L - 1) * D * 32, D, 32, Win_t, IN_DIM, 0, scr, gw, NGW, lane); \
            { const int r0 = L > 0 ? IN_DIM + 32 : IN_DIM, nz = (PROJ_BLD - r0) * (D / 8);       \
              const unsigned oz = __float_as_uint(opaque0()); for (int i = (tix); i < nz; i += (tnum)) *(u32x4*)(Win_t + (size_t)r0 * D + (size_t)i * 8) = (u32x4){oz, oz, oz, oz}; } \
            cvt_job<0>(INP(23) + (size_t)L * D * D, D, D, Wout_t, 0, 0, scr, gw, NGW, lane); \
            cvt_job<0>(INP(12) + (size_t)L * 64 * 1024, 64, 1024, Wl_w, 0, 0, scr, gw, NGW, lane); \
            cvt_job<0>(INP(14) + (size_t)L * 64 * 1024, 64, 1024, Wl_a, 0, 0, scr, gw, NGW, lane); \
            cvt_job<0>(INP(17) + (size_t)L * 160 * 1024, 160, 1024, Wl_g, 0, 0, scr, gw, NGW, lane); \
            if (L > 0) cvt_job<0>(INP(16) + (size_t)(L - 1) * 32 * 1024, 32, 1024, Wl_v, 0, 0, scr, gw, NGW, lane); } while (0)
#define INP(i) (P.in[(i) + z_])
#define RW_ARGS(a) RwScan a; a.proj_ = projb; a.lw_ = lw; a.mix = INP(9) + (size_t)l * RW_SHIFT; a.w0 = INP(11) + l * 1024; a.a0 = INP(13) + l * 1024; a.v0 = INP(15) + (l > 0 ? l - 1 : 0) * 1024; \
            a.k_k = INP(18) + l * 1024; a.k_a = INP(19) + l * 1024; a.r_k = INP(20) + l * 1024; a.vf_ = vfirst; a.y_ = (bf16_t*)yrw; a.bon_ = (bf16_t*)bon; a.layer = l; a.pad = 0; \
            a.cw1 = moe ? INP(32) + (size_t)li * NE * D * DFE : INP(28) + (size_t)li * D * DFF; a.cw3 = moe ? INP(33) + (size_t)li * NE * D * DFE : INP(29) + (size_t)li * D * DFF; a.cw2 = moe ? INP(34) + (size_t)li * NE * DFE * D : INP(30) + (size_t)li * DFF * D; a.cwt = Wffn; a.cmoe = moe ? 1 : 0; a.pad2 = 0;

#define Win_t ((bf16_t*)(wsq + WS_WIN))
#define Wout_t ((bf16_t*)(wsq + WS_WOUT))
#define Wffn ((bf16_t*)(wsq + WS_WFFN))
#define Wl_w ((bf16_t*)(wsq + WS_WLORA))
#define Wl_a (Wl_w + 1024 * 64)
#define Wl_g (Wl_a + 1024 * 64)
#define Wl_v (Wl_g + 1024 * 160)
#define xf ((float*)(wsq + WS_XF))
#define xb ((bf16_t*)(wsq + WS_XB))
#define projb ((bf16_t*)(wsq + WS_PROJB))
#define ymixb ((bf16_t*)(wsq + WS_YMIXB))
#define mixed ((float*)(wsq + WS_MIXED))
#define hbuf ((bf16_t*)(wsq + WS_HBUF))
#define xg ((bf16_t*)(wsq + WS_XG))
#define yslot ((float*)(wsq + WS_YSLOT))
#define xbcc ((bf16_t*)(wsq + WS_XBCC))
#define dtb ((float*)(wsq + WS_DTB))
#define yssd ((float*)(wsq + WS_YSSD))
#define lw ((bf16_t*)(wsq + WS_LW))
#define yrw ((float*)(wsq + WS_YRW))
#define bon ((float*)(wsq + WS_BON))
#define vfirst ((float*)(wsq + WS_VFIRST))
#define tok_e ((int*)(wsq + WS_TOK))
#define tok_pos (tok_e + 2 * M)
#define tok_g ((float*)(tok_pos + 2 * M))
#define tok_dest ((int*)(tok_g + 2 * M))
#define src_row (tok_dest + 2 * M)
#define inv_row (src_row + PMAX)
#define cnt ((int*)(wsq + WS_CTL) + CW_CNT + 8 * li)
__global__ void __launch_bounds__(NWAVES * 64, 2) fwd(Params P) {
    extern __shared__ __attribute__((aligned(16))) unsigned char lds_raw[];
    LAS unsigned char* lds = (LAS unsigned char*)lds_raw;
    volatile LAS unsigned* MISC = (volatile LAS unsigned*)(lds + MISC_OFF);
    const int tid0 = threadIdx.x;
    const int G0 = gridDim.x, bx0 = blockIdx.x;
    const int vcu0 = (G0 % 8 == 0) ? (bx0 % 8) * (G0 / 8) + bx0 / 8 : bx0;
    unsigned* ctl = (unsigned*)(P.ws + WS_CTL);
    if (tid0 < 64) MISC[tid0] = 0u;
    __syncthreads();
#if MK_LAUNCH_MODE == 1
    constexpr int lo = 0, hi = 64;
#else
    const int lo = P.ph_lo, hi = P.ph_hi;
#endif
    XcdBarrier bar; bar.bar = ctl + CW_BAR + P.bar_idx * XCD_BAR_WORDS; bar.x = 0; bar.st = MISC + 8;
    if (hi - lo > 1) bar = xcd_barrier_post(ctl + CW_BAR + P.bar_idx * XCD_BAR_WORDS, MISC + 8);
#define IN(k) (lo <= (k) && (k) < hi)
#ifndef MK_TS_MASK
#define MK_TS_MASK 0
#endif
#ifndef MK_TS_MULT
#define MK_TS_MULT 8
#endif
    unsigned long long ts_acc = 0ull, ts_t0 = 0ull; (void)ts_acc; (void)ts_t0;
#ifndef MK_TS_LAYERS
#define MK_TS_LAYERS 0xF
#endif
#define TS_ON(k) (MK_TS_MASK != 0 && ((MK_TS_MASK >> (k)) & 1) && ((MK_TS_LAYERS >> l) & 1))
#define TS_BEGIN(k) do { if (TS_ON(k)) ts_t0 = __builtin_amdgcn_s_memrealtime(); } while (0)
#define TS_END(k) do { if (TS_ON(k)) { __syncthreads(); ts_acc += __builtin_amdgcn_s_memrealtime() - ts_t0; } } while (0)
#define SEAM(k) do { if (((k) & 15) == 3 && TS_ON(21)) { TS_END(21); } if ((k) + 1 < hi) { TS_END((k) & 15); TS_BEGIN(20); xcd_barrier(bar); if ((MK_DBL >> 19) & 1) xcd_barrier(bar); TS_END(20); } else { TS_END((k) & 15); } } while (0)

    for (int l = 0; l < 4; ++l) {
        const int pb = l * 16, li = l >> 1; const bool moe = (l & 1) != 0;
        if (IN(pb + 0) && l == 0) {
            PH_BEGIN
            TS_BEGIN(0);
            for (int rep_ = 0; rep_ < 1 + ((MK_DBL >> 0) & 1); ++rep_) {
            LAS float* scr = (LAS float*)(lds + wave * 16384);
            CVT_MIXER_WEIGHTS(0, gw, NGW, bx * 512 + tid, G * 512);
            if (l == 0) {
                const float* x = INP(0);
                const size_t stride = (size_t)G * 512, total = (size_t)M * D / 8;
                size_t i = (size_t)bx * 512 + tid;
                for (; i + 3 * stride < total; i += 4 * stride) {
                    f32x4 a[4], b[4];
#pragma unroll
                    for (int q = 0; q < 4; ++q) { a[q] = *(const f32x4*)(x + (i + q * stride) * 8); b[q] = *(const f32x4*)(x + (i + q * stride) * 8 + 4); }
#pragma unroll
                    for (int q = 0; q < 4; ++q) { u32x4 w; w.x = cvt_pk_bf16(a[q][0], a[q][1]); w.y = cvt_pk_bf16(a[q][2], a[q][3]); w.z = cvt_pk_bf16(b[q][0], b[q][1]); w.w = cvt_pk_bf16(b[q][2], b[q][3]);
                        *(u32x4*)(xb + (i + q * stride) * 8) = w; }
                }
                for (; i < total; i += stride) {
                    const f32x4 a = *(const f32x4*)(x + i * 8), b = *(const f32x4*)(x + i * 8 + 4);
                    u32x4 w; w.x = cvt_pk_bf16(a[0], a[1]); w.y = cvt_pk_bf16(a[2], a[3]); w.z = cvt_pk_bf16(b[0], b[1]); w.w = cvt_pk_bf16(b[2], b[3]);
                    *(u32x4*)(xb + i * 8) = w; }
            }
            }
            __syncthreads();
            SEAM(pb + 0);
        }
        if (IN(pb + 1)) {
            PH_BEGIN
            TS_BEGIN(1);
            pg8::Gemm g{xb, Win_t, D}; pg8::StaticOrder S; S.init(M, PROJ_BLD, G, bx);
            pg8::EpiBf16 E{projb, PROJ_BLD};
            pg8::gemm_phase<pg8::EpiBf16, pg8::StaticOrder>(lds, g, S, E, tid);
#if (MK_DBL >> 1) & 1
            pg8::gemm_phase<pg8::EpiBf16, pg8::StaticOrder>(lds, g, S, E, tid);
#endif
            SEAM(pb + 1);
        }
        if (IN(pb + 2)) {
            PH_BEGIN
            TS_BEGIN(2);
            lora_phase(lds, projb, INP(9) + (size_t)l * RW_SHIFT, INP(10) + (size_t)(l > 0 ? l - 1 : 0) * 32, Wl_w, Wl_a, Wl_g, Wl_v, lw, l > 0, vcu, G, tid);
#if (MK_DBL >> 2) & 1
            lora_phase(lds, projb, INP(9) + (size_t)l * RW_SHIFT, INP(10) + (size_t)(l > 0 ? l - 1 : 0) * 32, Wl_w, Wl_a, Wl_g, Wl_v, lw, l > 0, vcu, G, tid);
#endif
            ssd_conv_phase(projb, INP(3) + (size_t)l * 4 * CONV_DIM, INP(4) + (size_t)l * CONV_DIM, INP(5) + l * SSD_H, xbcc, dtb, vcu, G, tid);
#if (MK_DBL >> 11) & 1
            ssd_conv_phase(projb, INP(3) + (size_t)l * 4 * CONV_DIM, INP(4) + (size_t)l * CONV_DIM, INP(5) + l * SSD_H, xbcc, dtb, vcu, G, tid);
#endif
#if MK_RWKV_CHUNKED == 2
            __syncthreads();
            {
                RW_ARGS(a);
                int tid3 = tid; asm volatile("" : "+v"(tid3));
                rwkv_pre_phase(lds, a, wsq + WS_IMG, vcu, G, tid3, true, true);
#if (MK_DBL >> 12) & 1
                __syncthreads();
                rwkv_pre_phase(lds, a, wsq + WS_IMG, vcu, G, tid3, false, true);
#endif
#if (MK_DBL >> 13) & 1
                __syncthreads();
                rwkv_pre_phase(lds, a, wsq + WS_IMG, vcu, G, tid3, true, false);
#endif
            }
#endif
            SEAM(pb + 2);
        }
        if (IN(pb + 3)) {
            PH_BEGIN
            TS_BEGIN(3);
#if MK_RWKV_CHUNKED == 2
            RW_ARGS(a);
            const bool ssd_first = ((vcu >> 1) & 1) != 0;
            if (ssd_first) { int tid4 = tid; asm volatile("" : "+v"(tid4)); ssd_scan_phase(lds, xbcc, dtb, INP(6) + l * SSD_H, INP(7) + l * SSD_H, (bf16_t*)yssd, vcu, G, tid4); }
            rwkv_state_phase(lds, wsq + WS_IMG, (bf16_t*)yrw, a, vcu, G, tid);
#if (MK_DBL >> 3) & 1
            rwkv_state_phase(lds, wsq + WS_IMG, (bf16_t*)yrw, a, vcu, G, tid);
#endif
#elif MK_RWKV_CHUNKED
            RW_ARGS(a);
            rwkv_chunk_phase(lds, a, vcu, G, tid);
#else
            RW_ARGS(a);
            rwkv_scan_phase(lds, a, vcu, G, tid);
#endif
            if (TS_ON(21)) { TS_END(3); TS_BEGIN(21); }
#if ((MK_DBL >> 3) & 1) && MK_RWKV_CHUNKED == 0
            rwkv_scan_phase(lds, a, vcu, G, tid);
#endif
            int tid2 = tid; asm volatile("" : "+v"(tid2));
#if MK_RWKV_CHUNKED == 2
            if (!ssd_first)
#endif
            ssd_scan_phase(lds, xbcc, dtb, INP(6) + l * SSD_H, INP(7) + l * SSD_H, (bf16_t*)yssd, vcu, G, tid2);
#if (MK_DBL >> 10) & 1
            ssd_scan_phase(lds, xbcc, dtb, INP(6) + l * SSD_H, INP(7) + l * SSD_H, (bf16_t*)yssd, vcu, G, tid);
#endif
            SEAM(pb + 3);
        }
        if (IN(pb + 4)) {
            PH_BEGIN
            TS_BEGIN(4);
            rwkv_post_phase((const bf16_t*)yrw, (const bf16_t*)bon, lw + (size_t)2 * M * 1024, INP(21) + l * 1024, INP(22) + l * 1024, ymixb, gw, NGW, lane);
#if (MK_DBL >> 4) & 1
            rwkv_post_phase((const bf16_t*)yrw, (const bf16_t*)bon, lw + (size_t)2 * M * 1024, INP(21) + l * 1024, INP(22) + l * 1024, ymixb, gw, NGW, lane);
#endif
            ssd_post_phase((const bf16_t*)yssd, projb, INP(8) + l * 1024, ymixb, gw, NGW, lane);
#if (MK_DBL >> 4) & 1
            ssd_post_phase((const bf16_t*)yssd, projb, INP(8) + l * 1024, ymixb, gw, NGW, lane);
#endif
            SEAM(pb + 4);
        }
        if (IN(pb + 5)) {
            PH_BEGIN
            TS_BEGIN(5);
            pg8::Gemm g{ymixb, Wout_t, D}; pg8::StaticOrder S; S.init(M, D, G, bx);
            pg8::EpiBf16 E{(bf16_t*)mixed, FLD};
#if (MK_DBL >> 14) & 1
            { pg8::RepeatOrder R; R.init2(M, D, G, bx, 2); pg8::gemm_phase<pg8::EpiBf16, pg8::RepeatOrder>(lds, g, R, E, tid); }
#else
            pg8::gemm_phase<pg8::EpiBf16, pg8::StaticOrder>(lds, g, S, E, tid);
#endif
#if (MK_DBL >> 5) & 1
            pg8::gemm_phase<pg8::EpiBf16, pg8::StaticOrder>(lds, g, S, E, tid);
#endif
            SEAM(pb + 5);
        }
        if (IN(pb + 6)) {
            PH_BEGIN
            TS_BEGIN(6);
            const float* xin = INP(0);
            f32x4 g8[8], b8[8];
#pragma unroll
            for (int j = 0; j < 8; ++j) { g8[j] = *(const f32x4*)(INP(24) + l * D + 4 * lane + 256 * j); b8[j] = *(const f32x4*)(INP(25) + l * D + 4 * lane + 256 * j); }
            LAS float* rs = (LAS float*)lds;
            LAS int* wgcnt = (LAS int*)(lds + 65536); LAS int* wgbase = wgcnt + 8; LAS int* rec = wgcnt + 16;
            if (moe) { const float* router = INP(31) + (size_t)li * D * NE;
                for (int i = tid; i < D * NE; i += 512) rs[(i & 7) * D + (i >> 3)] = router[i];
                if (tid < 16) wgcnt[tid] = 0;
                __syncthreads(); }
            int nrec = 0;
            for (int m0 = gw; m0 < M; m0 += 2 * NGW) {
                const int m1 = m0 + NGW; const bool has1 = m1 < M; const int m1c = has1 ? m1 : m0;
                f32x4 va[8], vb[8];
#pragma unroll
                for (int j = 0; j < 8; ++j) { const int c = 4 * lane + 256 * j;
                    const u32x2 ma = *(const u32x2*)((const bf16_t*)mixed + (size_t)m0 * FLD + c), mb = *(const u32x2*)((const bf16_t*)mixed + (size_t)m1c * FLD + c);
                    const f32x4 xa = (l == 0) ? *(const f32x4*)(xin + (size_t)m0 * D + c) : ld_bf4(xb + (size_t)m0 * D + c), xbv = (l == 0) ? *(const f32x4*)(xin + (size_t)m1c * D + c) : ld_bf4(xb + (size_t)m1c * D + c);
                    va[j] = ALPHA * xa + (f32x4){bf_lo(ma.x), bf_hi(ma.x), bf_lo(ma.y), bf_hi(ma.y)};
                    vb[j] = ALPHA * xbv + (f32x4){bf_lo(mb.x), bf_hi(mb.x), bf_lo(mb.y), bf_hi(mb.y)}; }
                ln_finish(va, g8, b8, lane, (float*)nullptr, xb + (size_t)m0 * D);
                if (has1) ln_finish(vb, g8, b8, lane, (float*)nullptr, xb + (size_t)m1 * D);
                if (moe) {
#pragma unroll
                    for (int r = 0; r < 2; ++r) {
                        if (r == 1 && !has1) break;
                        const int m = r ? m1 : m0;
                        float sl[8];
#pragma unroll
                        for (int e = 0; e < 8; ++e) { float s = 0.f;
#pragma unroll
                            for (int j = 0; j < 8; ++j) { const f32x4 rr = *(const LAS f32x4*)(rs + e * D + 4 * lane + 256 * j); const f32x4 vv = r ? vb[j] : va[j]; s += (vv[0] * rr[0] + vv[1] * rr[1]) + (vv[2] * rr[2] + vv[3] * rr[3]); }
                            sl[e] = s; }
                        const float z0 = reduce4(sl[0], sl[1], sl[2], sl[3]), z1 = reduce4(sl[4], sl[5], sl[6], sl[7]);
                        const float lg[8] = {rdlane(z0, 0), rdlane(z0, 16), rdlane(z0, 32), rdlane(z0, 48), rdlane(z1, 0), rdlane(z1, 16), rdlane(z1, 32), rdlane(z1, 48)};
                        if (lane == 0) {
                            int i0 = 0; float v0 = lg[0];
#pragma unroll
                            for (int e = 1; e < 8; ++e) if (lg[e] > v0) { v0 = lg[e]; i0 = e; }
                            int i1 = -1; float v1 = -3.4e38f;
#pragma unroll
                            for (int e = 0; e < 8; ++e) if (e != i0 && lg[e] > v1) { v1 = lg[e]; i1 = e; }
                            const float e1 = expf(v1 - v0);
                            tok_e[2 * m] = i0; tok_e[2 * m + 1] = i1; tok_g[2 * m] = 1.f / (1.f + e1); tok_g[2 * m + 1] = e1 / (1.f + e1);
                            const int lp0 = __hip_atomic_fetch_add(&wgcnt[i0], 1, __ATOMIC_RELAXED, __HIP_MEMORY_SCOPE_WORKGROUP), lp1 = __hip_atomic_fetch_add(&wgcnt[i1], 1, __ATOMIC_RELAXED, __HIP_MEMORY_SCOPE_WORKGROUP);
                            LAS int* rc = rec + ((nrec + r) * NWAVES + wave) * 5;
                            rc[0] = m; rc[1] = i0; rc[2] = i1; rc[3] = lp0; rc[4] = lp1;
                        }
                    }
                    nrec += has1 ? 2 : 1;
                }
            }
            if (moe) {
                __syncthreads();
                if (tid < 8) wgbase[tid] = atomicAdd(&cnt[tid], wgcnt[tid]);
                __syncthreads();
                for (int i = tid; i < nrec * NWAVES; i += 512) { const LAS int* rc = rec + i * 5; const int m = rc[0];
                    const int p0_ = wgbase[rc[1]] + rc[3], p1_ = wgbase[rc[2]] + rc[4];
                    tok_pos[2 * m] = p0_; tok_pos[2 * m + 1] = p1_;
                    inv_row[rc[1] * pg8::INVCAP + p0_] = m; inv_row[rc[2] * pg8::INVCAP + p1_] = m; }
            }
            __syncthreads();
            SEAM(pb + 6);
        }
        if (IN(pb + 8)) {
            PH_BEGIN
            TS_BEGIN(8);
            if (!moe) {
                pg8::Gemm g{xb, Wffn, D}; pg8::StaticOrder S; S.init(M, 2 * DFF, G, bx);
                pg8::EpiSwiglu E{hbuf, DFF};
                pg8::gemm_phase<pg8::EpiSwiglu, pg8::StaticOrder>(lds, g, S, E, tid);
#if (MK_DBL >> 15) & 1
                pg8::gemm_phase<pg8::EpiSwiglu, pg8::StaticOrder>(lds, g, S, E, tid);
#endif
            } else {
                pg8::Gemm g{xb, Wffn, D, inv_row, M}; pg8::GroupedOrder S; S.init(cnt, 2 * DFE, G, bx);
                pg8::EpiSwiglu E{hbuf, DFE};
                pg8::gemm_phase<pg8::EpiSwiglu, pg8::GroupedOrder, true>(lds, g, S, E, tid);
#if (MK_DBL >> 16) & 1
                pg8::gemm_phase<pg8::EpiSwiglu, pg8::GroupedOrder>(lds, g, S, E, tid);
#endif
            }
            SEAM(pb + 8);
        }
        if (IN(pb + 9)) {
            PH_BEGIN
            TS_BEGIN(9);
            if (!moe) {
                pg8::Gemm g{hbuf, Wffn + (size_t)2 * DFF * D, DFF}; pg8::StaticOrder S; S.init(M, D, G, bx);
                pg8::EpiBf16 E{(bf16_t*)yslot, FLD};
                pg8::gemm_phase<pg8::EpiBf16, pg8::StaticOrder>(lds, g, S, E, tid);
            } else {
                pg8::Gemm g{hbuf, Wffn + (size_t)NE * 2 * DFE * D, DFE}; pg8::GroupedOrder S; S.init(cnt, D, G, bx);
                pg8::EpiBf16 E{(bf16_t*)yslot, FLD};
                pg8::gemm_phase<pg8::EpiBf16, pg8::GroupedOrder>(lds, g, S, E, tid);
            }
            if (l < 3) {
                int tail = 0;
                if (moe) { int np = 0;
#pragma unroll
                    for (int e = 0; e < 8; ++e) np += (cnt[e] + 255) >> 8;
                    tail = (np * (D / 256)) % G; }
                if (bx >= tail) {
                    LAS float* scr = (LAS float*)(lds + wave * 16384);
                    const int fwg = bx - tail, nf = G - tail;
                    CVT_MIXER_WEIGHTS(l + 1, fwg * NWAVES + wave, nf * NWAVES, fwg * 512 + tid, nf * 512);
                }
            }
            SEAM(pb + 9);
        }
        if (IN(pb + 10)) {
            PH_BEGIN
            TS_BEGIN(10);
            f32x4 g8[8], b8[8];
#pragma unroll
            for (int j = 0; j < 8; ++j) { g8[j] = *(const f32x4*)(INP(26) + l * D + 4 * lane + 256 * j); b8[j] = *(const f32x4*)(INP(27) + l * D + 4 * lane + 256 * j); }
            float* dst = (l == 3) ? P.out : (float*)nullptr; const bf16_t* ysb = (const bf16_t*)yslot;
            int pstart[8]; { int acc_ = 0;
#pragma unroll
                for (int e = 0; e < 8; ++e) { pstart[e] = acc_; acc_ += moe ? (((cnt[e] + 255) >> 8) << 8) : 0; } }
            for (int m0 = gw; m0 < M; m0 += 2 * NGW) {
                const int m1 = m0 + NGW; const bool has1 = m1 < M; const int m1c = has1 ? m1 : m0;
                f32x4 va[8], vb[8];
                if (!moe) {
#pragma unroll
                    for (int j = 0; j < 8; ++j) { const int c = 4 * lane + 256 * j;
                        va[j] = ALPHA * ld_bf4(xb + (size_t)m0 * D + c) + ld_bf4(ysb + (size_t)m0 * FLD + c);
                        vb[j] = ALPHA * ld_bf4(xb + (size_t)m1c * D + c) + ld_bf4(ysb + (size_t)m1c * FLD + c); }
                } else {
#define MK_DEST(i_, o_) do { const int e_ = tok_e[(i_)]; int st_ = 0; _Pragma("unroll") for (int q = 0; q < 8; ++q) st_ = (e_ == q) ? pstart[q] : st_; o_ = st_ + tok_pos[(i_)]; } while (0)
                    int a0, a1, c0, c1; MK_DEST(2 * m0, a0); MK_DEST(2 * m0 + 1, a1); MK_DEST(2 * m1c, c0); MK_DEST(2 * m1c + 1, c1);
#undef MK_DEST
                    const float ga0 = tok_g[2 * m0], ga1 = tok_g[2 * m0 + 1], gc0 = tok_g[2 * m1c], gc1 = tok_g[2 * m1c + 1];
#pragma unroll
                    for (int j = 0; j < 8; ++j) { const int c = 4 * lane + 256 * j;
                        va[j] = ALPHA * ld_bf4(xb + (size_t)m0 * D + c) + ga0 * ld_bf4(ysb + (size_t)a0 * FLD + c) + ga1 * ld_bf4(ysb + (size_t)a1 * FLD + c);
                        vb[j] = ALPHA * ld_bf4(xb + (size_t)m1c * D + c) + gc0 * ld_bf4(ysb + (size_t)c0 * FLD + c) + gc1 * ld_bf4(ysb + (size_t)c1 * FLD + c); }
                }
                ln_finish(va, g8, b8, lane, dst ? dst + (size_t)m0 * D : (float*)nullptr, (l == 3) ? (bf16_t*)nullptr : xb + (size_t)m0 * D);
                if (has1) ln_finish(vb, g8, b8, lane, dst ? dst + (size_t)m1 * D : (float*)nullptr, (l == 3) ? (bf16_t*)nullptr : xb + (size_t)m1 * D);
            }
            SEAM(pb + 10);
        }
    }
    if (MK_TS_MASK != 0 && bx0 == 0 && tid0 < 64) {
        const unsigned long long t_end = __builtin_amdgcn_s_memrealtime() + (unsigned long long)MK_TS_MULT * ts_acc;
        while (__builtin_amdgcn_s_memrealtime() < t_end) __builtin_amdgcn_s_sleep(32);
    }
#undef IN
#undef SEAM
}
#undef PH_BEGIN
#undef CVT_MIXER_WEIGHTS
#undef INP
#undef Win_t
#undef Wout_t
#undef Wffn
#undef Wl_w
#undef Wl_a
#undef Wl_g
#undef Wl_v
#undef xf
#undef xb
#undef projb
#undef ymixb
#undef mixed
#undef hbuf
#undef xg
#undef yslot
#undef xbcc
#undef dtb
#undef yssd
#undef lw
#undef yrw
#undef bon
#undef vfirst
#undef tok_e
#undef tok_pos
#undef tok_g
#undef tok_dest
#undef src_row
#undef inv_row
#undef cnt


}

extern "C" void kernel_launch(void* const* d_in, const int* in_sizes, int n_in, void* d_out, int out_size, void* d_ws, size_t ws_size, hipStream_t stream) {
    (void)in_sizes; (void)out_size;
    static int grid = 0;
    if (grid == 0) {
        if (n_in != 35 || ws_size < WS_END) { fprintf(stderr, "kernel_launch: need 35 inputs and %zu bytes of workspace (got %d, %zu)\n", (size_t)WS_END, n_in, ws_size); grid = -1; return; }
        int dev = 0, cus = 0;
        if (hipGetDevice(&dev) != hipSuccess || hipDeviceGetAttribute(&cus, hipDeviceAttributeMultiprocessorCount, dev) != hipSuccess) { grid = -1; return; }
        if (hipFuncSetAttribute((const void*)fwd, hipFuncAttributeMaxDynamicSharedMemorySize, LDS_BYTES) != hipSuccess) { fprintf(stderr, "kernel_launch: hipFuncSetAttribute failed\n"); grid = -1; return; }
        int per_cu = 0;
        if (hipOccupancyMaxActiveBlocksPerMultiprocessor(&per_cu, (const void*)fwd, NWAVES * 64, LDS_BYTES) != hipSuccess || per_cu < 1) { fprintf(stderr, "kernel_launch: occupancy query says %d blocks per CU\n", per_cu); }
        (void)hipGetLastError();
        grid = cus;
    }
    if (grid < 0) return;
    unsigned char* ws = (unsigned char*)d_ws;
    (void)hipMemsetAsync(ws + WS_CTL, 0, CTL_BYTES, stream);
    Params P{};
    for (int i = 0; i < 35; ++i) P.in[i] = (const float*)d_in[i];
    P.out = (float*)d_out; P.ws = ws; P.pad = 0;
    int nbar = 0;
    auto run = [&](int lo, int hi) {
        P.ph_lo = lo; P.ph_hi = hi; P.bar_idx = (hi - lo > 1) ? nbar++ : 0;
        hipLaunchKernelGGL(fwd, dim3(grid), dim3(NWAVES * 64), LDS_BYTES, stream, P);
    };
    if (MK_LAUNCH_MODE == 1) run(0, 64);
    else if (MK_LAUNCH_MODE == 4) { for (int l = 0; l < 4; ++l) run(l * 16, l * 16 + 16); }
    else { for (int l = 0; l < 4; ++l) for (int k = 0; k <= 10; ++k) run(l * 16 + k, l * 16 + k + 1); }
}
```

```cpp
#include <hip/hip_runtime.h>
#include <cstdint>
#include <cstdio>

#ifndef MK_DBL
#define MK_DBL 0
#endif
#ifndef MK_CV_CUT_MOE
#define MK_CV_CUT_MOE 16896
#endif
#ifndef MK_CV_CUT_DENSE
#define MK_CV_CUT_DENSE 16896
#endif
#ifndef MK_RWKV_CHUNKED
#define MK_RWKV_CHUNKED 2
#endif
#ifndef MK_GEMM_8PH
#define MK_GEMM_8PH 0
#endif
#ifndef MK_LAUNCH_MODE
#define MK_LAUNCH_MODE 1
#endif
namespace {
constexpr int BATCH = 8, SEQ = 2048, M = BATCH * SEQ, D = 2048;
constexpr int HD = 64, SSD_H = 16, SSD_N = 128, CONV_DIM = 1536;
constexpr int RW_H = 16;
constexpr int IN_DIM = 5936, PROJ_LD = 5968;
constexpr int OFF_Z = 0, OFF_XBC = 1024, OFF_DT = 2560, OFF_RW = 2576, OFF_R = 2576, OFF_K = 3600, OFF_V = 4624, OFF_WLO = 5648, OFF_ALO = 5712, OFF_GLO = 5776, OFF_VLO = 5936;
constexpr int RW_SHIFT = 3360;
constexpr int DFF = 5632, NE = 8, DFE = 2816;
constexpr float ALPHA = 1.681792830507429f;
constexpr int LORA_LD = 320;

__device__ __forceinline__ float sigmoidf_(float x) { return 1.f / (1.f + expf(-x)); }
__device__ __forceinline__ float siluf_(float x) { return x / (1.f + expf(-x)); }
__device__ __forceinline__ float softplusf_(float x) { return fmaxf(x, 0.f) + log1pf(expf(-fabsf(x))); }
__device__ __forceinline__ float wave_sum(float v) {
#pragma unroll
    for (int o = 32; o >= 1; o >>= 1) v += __shfl_xor(v, o);
    return v;
}


#define LAS __attribute__((address_space(3)))
typedef unsigned short bf16_t;
typedef short bf16x8 __attribute__((ext_vector_type(8)));
typedef float f32x4 __attribute__((ext_vector_type(4)));
typedef float f32x2 __attribute__((ext_vector_type(2)));
typedef unsigned u32x4 __attribute__((ext_vector_type(4)));
typedef unsigned u32x2 __attribute__((ext_vector_type(2)));

typedef __bf16 bf16x2_t __attribute__((ext_vector_type(2)));
__device__ __forceinline__ unsigned cvt_pk_bf16(float lo, float hi) { const f32x2 v = {lo, hi}; const bf16x2_t b = __builtin_convertvector(v, bf16x2_t); return __builtin_bit_cast(unsigned, b); }
__device__ __forceinline__ float bf_lo(unsigned w) { return __uint_as_float(w << 16); }
__device__ __forceinline__ float bf_hi(unsigned w) { return __uint_as_float(w & 0xffff0000u); }
__device__ __forceinline__ float bf2f(bf16_t b) { return __uint_as_float(((unsigned)b) << 16); }
__device__ __forceinline__ float opaque0() { float z = 0.f; asm volatile("" : "+v"(z)); return z; }
#define ZERO4() ((f32x4){opaque0(), 0.f, 0.f, 0.f} * 0.f)
__device__ __forceinline__ float fast_silu(float x) { return x * __builtin_amdgcn_rcpf(1.f + __builtin_amdgcn_exp2f(-1.4426950408889634f * x)); }

namespace pg8 {
constexpr int BM = 256, BK = 64, HALF = 128, HTB = HALF * BK * 2, STAGE_BYTES = 8 * HTB, NXCD = 8, WGM = 8;
__host__ __device__ __forceinline__ int lds_byte(int r, int c) { const int st = (r >> 4) * 2 + (c >> 5), rr = r & 15, cc = c & 31, ob = rr * 64 + cc * 2; return st * 1024 + (ob ^ (((ob >> 9) & 1) << 5)); }
__host__ __device__ __forceinline__ void stage_rc(int b, int& R, int& C) { const int st = b / 1024, sb = b % 1024, swz = sb ^ (((sb >> 9) & 1) << 5); R = (st >> 1) * 16 + swz / 64; C = (st & 1) * 32 + (swz % 64) / 2; }
__host__ __device__ __forceinline__ int perm32(int rho) { const int n = rho >> 4, i = rho & 15; return 8 * (i >> 2) + 4 * n + (i & 3); }

struct Unit { int pm, pn, pb, rb, rv; };
constexpr int INVCAP = 16384;
struct Gemm { const bf16_t* A; const bf16_t* Bt; int K; const int* rowmap = nullptr; int nrows = 0; };

__device__ __forceinline__ void decode_unit(int wgid, int nM, int nN, int& pm, int& pn) {
    const int nwg = nM * nN;
    { const int q = nwg / NXCD, r = nwg % NXCD, xcd = wgid % NXCD, off = wgid / NXCD; wgid = (xcd < r ? xcd * (q + 1) : r * (q + 1) + (xcd - r) * q) + off; }
    const int nig = WGM * nN, gid = wgid / nig, fm = gid * WGM, gsz = (nM - fm) < WGM ? (nM - fm) : WGM;
    pm = fm + ((wgid % nig) % gsz); pn = (wgid % nig) / gsz;
}
struct StaticOrder {
    int nM, nN, nwg, G, c;
    __device__ void init(int Mrows, int N, int G_, int c_) { nM = Mrows / BM; nN = N / BM; nwg = nM * nN; G = G_; c = c_; }
    __device__ __forceinline__ bool next(int i, Unit& u) const {
        const long L = (long)i * G + c; if (L >= nwg) return false;
        decode_unit((int)L, nM, nN, u.pm, u.pn); u.pb = u.pn; return true;
    }
};
struct RepeatOrder : StaticOrder {
    int per, reps;
    __device__ void init2(int Mrows, int N, int G_, int c_, int reps_) { init(Mrows, N, G_, c_); per = (nwg + G - 1) / G; reps = reps_; }
    __device__ __forceinline__ bool next(int i, Unit& u) const { if (i >= per * reps) return false; return StaticOrder::next(i % per, u); }
};
struct GroupedOrder {
    int nM, nN, nwg, G, c; int cum[9];
    __device__ void init(const int* cnt, int N, int G_, int c_) {
        int acc = 0;
#pragma unroll
        for (int e = 0; e < 8; ++e) { cum[e] = acc; acc += (cnt[e] + 255) >> 8; }
        cum[8] = acc; nM = acc; nN = N / BM; nwg = nM * nN; G = G_; c = c_;
    }
    __device__ __forceinline__ bool next(int i, Unit& u) const {
        const long L = (long)i * G + c; if (L >= nwg) return false;
        decode_unit((int)L, nM, nN, u.pm, u.pn);
        int e = 0, lt = u.pm;
#pragma unroll
        for (int q = 1; q < 8; ++q) { const int d = u.pm - cum[q]; e += (d >= 0) ? 1 : 0; lt = (d >= 0) ? d : lt; }
        u.pb = e * nN + u.pn; u.rb = e * INVCAP + lt * BM; u.rv = 0; return true;
    }
};

struct EpiF32 {
    static constexpr bool PERM = false;
    float* C; int ldc;
    __device__ __forceinline__ void operator()(const f32x4 (&acc)[2][2][4][2], const Unit& u, int wr, int wc, int fr, int fq) const {
        const int row0 = u.pm * BM + wr * 64 + fr, col0 = u.pn * BM + wc * 32 + 4 * fq;
#pragma unroll
        for (int ai = 0; ai < 2; ++ai)
#pragma unroll
            for (int m = 0; m < 4; ++m) { float* rowp = C + (size_t)(row0 + ai * HALF + m * 16) * ldc + col0;
#pragma unroll
                for (int bj = 0; bj < 2; ++bj)
#pragma unroll
                    for (int n = 0; n < 2; ++n) *(f32x4*)(rowp + bj * HALF + n * 16) = acc[ai][bj][m][n]; }
    }
};
struct EpiBf16 {
    static constexpr bool PERM = true;
    bf16_t* O; int ldc;
    __device__ __forceinline__ void operator()(const f32x4 (&acc)[2][2][4][2], const Unit& u, int wr, int wc, int fr, int fq) const {
        const int row0 = u.pm * BM + wr * 64 + fr, col0 = u.pn * BM + wc * 32 + 8 * fq;
#pragma unroll
        for (int ai = 0; ai < 2; ++ai)
#pragma unroll
            for (int m = 0; m < 4; ++m) { bf16_t* rowp = O + (size_t)(row0 + ai * HALF + m * 16) * ldc + col0;
#pragma unroll
                for (int bj = 0; bj < 2; ++bj) { const f32x4 v0 = acc[ai][bj][m][0], v1 = acc[ai][bj][m][1];
                    u32x4 w; w.x = cvt_pk_bf16(v0[0], v0[1]); w.y = cvt_pk_bf16(v0[2], v0[3]); w.z = cvt_pk_bf16(v1[0], v1[1]); w.w = cvt_pk_bf16(v1[2], v1[3]);
                    *(u32x4*)(rowp + bj * HALF) = w; } }
    }
};
struct EpiSwiglu {
    static constexpr bool PERM = true;
    bf16_t* O; int ldc;
    __device__ __forceinline__ void operator()(const f32x4 (&acc)[2][2][4][2], const Unit& u, int wr, int wc, int fr, int fq) const {
        const int row0 = u.pm * BM + wr * 64 + fr, col0 = u.pn * HALF + wc * 32 + 8 * fq;
#pragma unroll
        for (int ai = 0; ai < 2; ++ai)
#pragma unroll
            for (int m = 0; m < 4; ++m) { bf16_t* rowp = O + (size_t)(row0 + ai * HALF + m * 16) * ldc + col0;
                float o[8];
#pragma unroll
                for (int n = 0; n < 2; ++n)
#pragma unroll
                    for (int i = 0; i < 4; ++i) o[n * 4 + i] = fast_silu(acc[ai][0][m][n][i]) * acc[ai][1][m][n][i];
                u32x4 w; w.x = cvt_pk_bf16(o[0], o[1]); w.y = cvt_pk_bf16(o[2], o[3]); w.z = cvt_pk_bf16(o[4], o[5]); w.w = cvt_pk_bf16(o[6], o[7]);
                *(u32x4*)rowp = w; }
    }
};

template <class Epi, class Sched, bool GATHER = false>
__device__ __forceinline__ void gemm_phase(LAS unsigned char* lds, const Gemm g, const Sched& S, const Epi& E, const int tid) {
    const int wid = __builtin_amdgcn_readfirstlane(tid >> 6), lane = tid & 63, wr = wid >> 2, wc = wid & 3, fr = lane & 15, fq = lane >> 4;
    const int K = g.K, nt = K / BK;
    unsigned voffA[2], voffB[2];
#pragma unroll
    for (int i = 0; i < 2; ++i) { int R, C; stage_rc(tid * 16 + i * 8192, R, C); const int Rb = Epi::PERM ? ((R & ~31) + perm32(R & 31)) : R;
        voffA[i] = (unsigned)(R * K + C) * 2u; voffB[i] = (unsigned)(Rb * K + C) * 2u; }
    unsigned goC[2][2], goN[2][2];
#define PG8_GLOOK(dst, unit_) do { _Pragma("unroll") for (int h_ = 0; h_ < 2; ++h_) _Pragma("unroll") for (int i_ = 0; i_ < 2; ++i_) { int R_, C_; stage_rc(tid * 16 + i_ * 8192, R_, C_); \
        const int r_ = h_ * HALF + R_; int ix_ = g.rowmap[(unit_).rb + r_]; ix_ = ((unsigned)ix_ < (unsigned)g.nrows) ? ix_ : 0;     dst[h_][i_] = (unsigned)(ix_ * K + C_) * 2u; } } while (0)
#define PG8_STAGE_G(bufoff, kb_, go_, h_) do { _Pragma("unroll") for (int _i = 0; _i < 2; ++_i) \
        __builtin_amdgcn_global_load_lds((const unsigned*)((const char*)g.A + (kb_) + (go_)[h_][_i]), (LAS unsigned*)(lds + (bufoff) + ldsw + _i * 8192), 16, 0, 0); } while (0)
#define PG8_STAGE_A(bufoff, base_, nx_, kb_, h_) do { if (GATHER) { if (nx_) PG8_STAGE_G(bufoff, kb_, goN, h_); else PG8_STAGE_G(bufoff, kb_, goC, h_); } \
        else PG8_STAGE(bufoff, (base_) + (kb_) + (h_) * hstep, voffA); } while (0)
    const size_t kstep = (size_t)(BK * 2);
    const size_t hstep = (size_t)HALF * K * 2;
    const size_t tstep = 2 * hstep;
    const unsigned ldsw = (unsigned)wid * 1024u;
    const int aoff = lds_byte(wr * 64 + fr, fq * 8), boff = lds_byte(wc * 32 + fr, fq * 8);
#define PG8_SA(b, h) (((b) * 2 + (h)) * HTB)
#define PG8_SB(b, h) ((4 + (b) * 2 + (h)) * HTB)
#define PG8_STAGE(bufoff, gbase, voff) do { _Pragma("unroll") for (int _i = 0; _i < 2; ++_i) \
        __builtin_amdgcn_global_load_lds((const unsigned*)((const char*)(gbase) + (voff)[_i]), (LAS unsigned*)(lds + (bufoff) + ldsw + _i * 8192), 16, 0, 0); } while (0)
#define PG8_LDA(dst, b, h) do { _Pragma("unroll") for (int m = 0; m < 4; ++m) _Pragma("unroll") for (int k = 0; k < 2; ++k) dst[m][k] = *(const LAS bf16x8*)(lds + PG8_SA(b, h) + aoff + m * 2048 + k * 1024); } while (0)
#define PG8_LDB(dst, b, h) do { _Pragma("unroll") for (int n = 0; n < 2; ++n) _Pragma("unroll") for (int k = 0; k < 2; ++k) dst[n][k] = *(const LAS bf16x8*)(lds + PG8_SB(b, h) + boff + n * 2048 + k * 1024); } while (0)
#define PG8_MMA(ai, bj, At, Bt) do { __builtin_amdgcn_s_setprio(1); _Pragma("unroll") for (int m = 0; m < 4; ++m) _Pragma("unroll") for (int n = 0; n < 2; ++n) _Pragma("unroll") for (int k = 0; k < 2; ++k) \
        acc[ai][bj][m][n] = __builtin_amdgcn_mfma_f32_16x16x32_bf16(Bt[n][k], At[m][k], acc[ai][bj][m][n], 0, 0, 0); __builtin_amdgcn_s_setprio(0); } while (0)
#define PG8_WAIT_V(n) asm volatile("s_waitcnt vmcnt(" #n ")" ::: "memory")
#define PG8_WAIT_L(n) asm volatile("s_waitcnt lgkmcnt(" #n ")" ::: "memory")
#define PG8_BAR __builtin_amdgcn_s_barrier()
#define PG8_SCHED __builtin_amdgcn_sched_barrier(0)
    Unit cur, nxt; int ui = 0;
    if (!S.next(0, cur)) return;
    f32x4 acc[2][2][4][2];
#pragma unroll
    for (int a = 0; a < 2; ++a)
#pragma unroll
        for (int b = 0; b < 2; ++b)
#pragma unroll
            for (int m = 0; m < 4; ++m)
#pragma unroll
                for (int n = 0; n < 2; ++n) acc[a][b][m][n] = ZERO4();
    bf16x8 At[4][2], B0[2][2], B1[2][2];
    const char* cA = (const char*)g.A + (size_t)cur.pm * tstep; const char* cB = (const char*)g.Bt + (size_t)cur.pb * tstep;
#if MK_GEMM_8PH
    PG8_STAGE(PG8_SB(0, 0), cB, voffB); PG8_STAGE(PG8_SA(0, 0), cA, voffA); PG8_STAGE(PG8_SB(0, 1), cB + hstep, voffB); PG8_STAGE(PG8_SA(0, 1), cA + hstep, voffA);
    if (wr == 1) PG8_BAR;
    PG8_WAIT_V(4); PG8_BAR;
    PG8_STAGE(PG8_SB(1, 0), cB + kstep, voffB); PG8_STAGE(PG8_SA(1, 0), cA + kstep, voffA); PG8_STAGE(PG8_SB(1, 1), cB + hstep + kstep, voffB);
    PG8_WAIT_V(6); PG8_BAR;
#else
    if (GATHER) { PG8_GLOOK(goC, cur); PG8_GLOOK(goN, cur); }
    PG8_STAGE(PG8_SB(0, 0), cB, voffB); PG8_STAGE(PG8_SB(0, 1), cB + hstep, voffB); PG8_STAGE_A(PG8_SA(0, 0), cA, false, 0, 0); PG8_STAGE_A(PG8_SA(0, 1), cA, false, 0, 1);
    if (wr == 1) PG8_BAR;
    PG8_WAIT_V(2); PG8_BAR;
    PG8_STAGE(PG8_SB(1, 0), cB + kstep, voffB); PG8_STAGE_A(PG8_SA(1, 0), cA, false, kstep, 0); PG8_STAGE(PG8_SB(1, 1), cB + hstep + kstep, voffB);
    PG8_WAIT_V(6); PG8_BAR;
#endif
    for (;;) {
        const bool has_next = S.next(ui + 1, nxt);
        const char* nA = has_next ? (const char*)g.A + (size_t)nxt.pm * tstep : cA; const char* nB = has_next ? (const char*)g.Bt + (size_t)nxt.pb * tstep : cB;
        if (GATHER && has_next && wid < 4) __builtin_amdgcn_global_load_lds((const unsigned*)(g.rowmap + nxt.rb + tid), (LAS unsigned*)(lds + STAGE_BYTES + ((ui + 1) & 1) * 1024 + wid * 256), 4, 0, 0);
        for (int t = 0; t < nt; t += 2) {
            const bool last = (t == nt - 2);
            const char* a1 = cA + (size_t)(t + 1) * kstep;
            const char* a2 = last ? nA : cA + (size_t)(t + 2) * kstep; const char* b2 = last ? nB : cB + (size_t)(t + 2) * kstep;
            const char* a3 = a2 + kstep; const char* b3 = b2 + kstep;
#if MK_GEMM_8PH
            PG8_LDB(B0, 0, 0); PG8_SCHED; PG8_LDA(At, 0, 0); PG8_STAGE(PG8_SA(1, 1), a1 + hstep, voffA);
            PG8_WAIT_L(8); PG8_BAR; PG8_WAIT_L(0); PG8_MMA(0, 0, At, B0); PG8_BAR; PG8_SCHED;
            PG8_LDB(B1, 0, 1); PG8_STAGE(PG8_SB(0, 0), b2, voffB);
            PG8_BAR; PG8_WAIT_L(0); PG8_MMA(0, 1, At, B1); PG8_BAR;
            PG8_LDA(At, 0, 1); PG8_STAGE(PG8_SA(0, 0), a2, voffA);
            PG8_BAR; PG8_WAIT_L(0); PG8_MMA(1, 0, At, B0); PG8_BAR; PG8_SCHED;
            PG8_STAGE(PG8_SB(0, 1), b2 + hstep, voffB);
            PG8_WAIT_V(6); PG8_BAR; PG8_MMA(1, 1, At, B1); PG8_BAR;
            PG8_LDB(B0, 1, 0); PG8_SCHED; PG8_LDA(At, 1, 0); PG8_STAGE(PG8_SA(0, 1), a2 + hstep, voffA);
            PG8_WAIT_L(8); PG8_BAR; PG8_WAIT_L(0); PG8_MMA(0, 0, At, B0); PG8_BAR; PG8_SCHED;
            PG8_LDB(B1, 1, 1); PG8_STAGE(PG8_SB(1, 0), b3, voffB);
            PG8_BAR; PG8_WAIT_L(0); PG8_MMA(0, 1, At, B1); PG8_BAR;
            PG8_LDA(At, 1, 1); PG8_STAGE(PG8_SA(1, 0), a3, voffA);
            PG8_BAR; PG8_WAIT_L(0); PG8_MMA(1, 0, At, B0); PG8_BAR; PG8_SCHED;
            PG8_STAGE(PG8_SB(1, 1), b3 + hstep, voffB);
            PG8_WAIT_V(6); PG8_BAR; PG8_MMA(1, 1, At, B1); PG8_BAR;
#else
            if (GATHER && last && has_next) {
                const LAS int* ib_ = (const LAS int*)(lds + STAGE_BYTES + ((ui + 1) & 1) * 1024);
#pragma unroll
                for (int h_ = 0; h_ < 2; ++h_)
#pragma unroll
                    for (int i_ = 0; i_ < 2; ++i_) { int R_, C_; stage_rc(tid * 16 + i_ * 8192, R_, C_); const int r_ = h_ * HALF + R_; int ix_ = ib_[r_]; ix_ = ((unsigned)ix_ < (unsigned)g.nrows) ? ix_ : 0; goN[h_][i_] = (unsigned)(ix_ * K + C_) * 2u; }
            }
            const size_t kb1 = (size_t)(t + 1) * kstep, kb2 = last ? (size_t)0 : (size_t)(t + 2) * kstep, kb3 = kb2 + kstep;
            PG8_LDB(B0, 0, 0); PG8_LDB(B1, 0, 1); PG8_SCHED; PG8_LDA(At, 0, 0); PG8_STAGE_A(PG8_SA(1, 1), cA, false, kb1, 1);
            PG8_WAIT_V(8); PG8_WAIT_L(0); PG8_BAR; PG8_MMA(0, 0, At, B0); PG8_MMA(0, 1, At, B1); PG8_BAR; PG8_SCHED;
            PG8_LDA(At, 0, 1); PG8_STAGE(PG8_SB(0, 0), b2, voffB); PG8_STAGE(PG8_SB(0, 1), b2 + hstep, voffB); PG8_STAGE_A(PG8_SA(0, 0), (last ? nA : cA), last, kb2, 0);
            PG8_WAIT_V(8); PG8_WAIT_L(0); PG8_BAR; PG8_MMA(1, 0, At, B0); PG8_MMA(1, 1, At, B1); PG8_BAR; PG8_SCHED;
            PG8_LDB(B0, 1, 0); PG8_LDB(B1, 1, 1); PG8_SCHED; PG8_LDA(At, 1, 0); PG8_STAGE_A(PG8_SA(0, 1), (last ? nA : cA), last, kb2, 1);
            PG8_WAIT_V(8); PG8_WAIT_L(0); PG8_BAR; PG8_MMA(0, 0, At, B0); PG8_MMA(0, 1, At, B1); PG8_BAR; PG8_SCHED;
            PG8_LDA(At, 1, 1); PG8_STAGE(PG8_SB(1, 0), b3, voffB); PG8_STAGE(PG8_SB(1, 1), b3 + hstep, voffB); PG8_STAGE_A(PG8_SA(1, 0), (last ? nA : cA), last, kb3, 0);
            PG8_WAIT_V(8); PG8_WAIT_L(0); PG8_BAR; PG8_MMA(1, 0, At, B0); PG8_MMA(1, 1, At, B1); PG8_BAR; PG8_SCHED;
#endif
        }
        if (wr == 0) PG8_BAR;
        E(acc, cur, wr, wc, fr, fq);
        if (!has_next) break;
#pragma unroll
        for (int a = 0; a < 2; ++a)
#pragma unroll
            for (int b = 0; b < 2; ++b)
#pragma unroll
                for (int m = 0; m < 4; ++m)
#pragma unroll
                    for (int n = 0; n < 2; ++n) acc[a][b][m][n] = ZERO4();
        cur = nxt; cA = nA; cB = nB; ++ui;
        if (GATHER) {
#pragma unroll
            for (int h_ = 0; h_ < 2; ++h_) { goC[h_][0] = goN[h_][0]; goC[h_][1] = goN[h_][1]; } }
        if (wr == 1) PG8_BAR;
    }
    PG8_WAIT_V(0);
    PG8_BAR;
#undef PG8_SA
#undef PG8_SB
#undef PG8_STAGE
#undef PG8_STAGE_A
#undef PG8_STAGE_G
#undef PG8_GLOOK
#undef PG8_LDA
#undef PG8_LDB
#undef PG8_MMA
#undef PG8_WAIT_V
#undef PG8_WAIT_L
#undef PG8_BAR
#undef PG8_SCHED
}
}

#define XB_TMO      128
#define XB_XCNT(j)  (256  + 64 * (j))
#define XB_XSUB(j)  (1280 + 64 * (j))
#define XB_XGEN(j)  (2304 + 64 * (j))
#define XB_TOP      3328
#define XB_TOPGEN   3392
#define XCD_BAR_WORDS 3456
#define XB_SPIN_CAP (1u << 18)
__device__ __forceinline__ unsigned xb_ld(unsigned* p)              { return __hip_atomic_load(p, __ATOMIC_RELAXED, __HIP_MEMORY_SCOPE_AGENT); }
__device__ __forceinline__ unsigned xb_add(unsigned* p, unsigned v) { return __hip_atomic_fetch_add(p, v, __ATOMIC_RELAXED, __HIP_MEMORY_SCOPE_AGENT); }
__device__ __forceinline__ unsigned xb_xcc_id() { return (unsigned)__builtin_amdgcn_s_getreg((3 << 11) | 20) & 0xFu; }
#define XB_SPIN(cond, bar) do { unsigned _sp = 0; while (cond) { __builtin_amdgcn_s_sleep(1); \
    if ((++_sp & 255u) == 0u) { if (xb_ld(&(bar)[XB_TMO])) break; if (_sp > XB_SPIN_CAP) { atomicAdd(&(bar)[XB_TMO], 1u); break; } } } } while (0)
struct XcdBarrier { unsigned* bar; unsigned x; volatile LAS unsigned* st; };
__device__ __forceinline__ XcdBarrier xcd_barrier_post(unsigned* bar, volatile LAS unsigned* st) {
    XcdBarrier b; b.bar = bar; b.x = xb_xcc_id(); b.st = st;
    if (threadIdx.x == 0) (void)xb_add(&bar[XB_XCNT(b.x)], 1u);
    return b;
}
__device__ __forceinline__ void xcd_barrier_complete(unsigned* bar, unsigned x, unsigned& nloc, unsigned& nx) {
    const unsigned G = gridDim.x * gridDim.y * gridDim.z;
    asm volatile("" : "+s"(x));
    unsigned sum, cnt, mine, sp = 0u;
    for (;;) {
        sum = 0u; cnt = 0u; mine = 0u;
#pragma unroll
        for (unsigned j = 0; j < 16; ++j) { const unsigned c = xb_ld(&bar[XB_XCNT(j)]); sum += c; cnt += (c > 0u) ? 1u : 0u; mine = (j == x) ? c : mine; }
        if (sum == G) break;
        __builtin_amdgcn_s_sleep(1);
        if ((++sp & 255u) == 0u) { if (xb_ld(&bar[XB_TMO])) break; if (sp > XB_SPIN_CAP) { atomicAdd(&bar[XB_TMO], 1u); break; } }
    }
    nloc = mine > 0u ? mine : 1u; nx = cnt > 0u ? cnt : 1u;
}
__device__ __forceinline__ void xcd_barrier(const XcdBarrier& b) {
    asm volatile("s_waitcnt vmcnt(0)" ::: "memory");
    __syncthreads();
    if (threadIdx.x == 0) {
        unsigned* bar = b.bar;
        __builtin_amdgcn_s_waitcnt(0);
        unsigned nloc = b.st[0], nx = b.st[1];
        if (nloc == 0u) { xcd_barrier_complete(bar, b.x, nloc, nx); b.st[0] = nloc; b.st[1] = nx; }
        const unsigned old = xb_add(&bar[XB_XSUB(b.x)], 1u);
        const unsigned gen = old / nloc;
        if (old + 1u == (gen + 1u) * nloc) {
            __builtin_amdgcn_fence(__ATOMIC_RELEASE, "agent");
            asm volatile("s_waitcnt vmcnt(0)" ::: "memory");
            const unsigned og = xb_add(&bar[XB_TOP], 1u);
            const unsigned tg = og / nx;
            if (og + 1u == (tg + 1u) * nx) xb_add(&bar[XB_TOPGEN], 1u);
            else XB_SPIN(xb_ld(&bar[XB_TOPGEN]) == tg, bar);
            __builtin_amdgcn_fence(__ATOMIC_ACQUIRE, "agent");
            xb_add(&bar[XB_XGEN(b.x)], 1u);
            asm volatile("s_waitcnt vmcnt(0)" ::: "memory");
        } else {
            XB_SPIN(xb_ld(&bar[XB_XGEN(b.x)]) == gen, bar);
            __builtin_amdgcn_fence(__ATOMIC_ACQUIRE, "agent");
            asm volatile("s_waitcnt vmcnt(0)" ::: "memory");
        }
    }
    __syncthreads();
}

constexpr size_t MiB = 1u << 20;
constexpr int NWAVES = 8;
constexpr int PROJ_BLD = 6144;
constexpr int PMAX = 34816;
constexpr int FLD = 2048 + 64;
constexpr size_t WS_CTL = 0, CTL_BYTES = 1 * MiB;
constexpr size_t WS_WIN = 1 * MiB, WS_WOUT = 25 * MiB, WS_WLORA = 33 * MiB;
constexpr size_t WS_XF = 34 * MiB, WS_XB = 162 * MiB, WS_VFIRST = 226 * MiB, WS_YMIXB = 290 * MiB, WS_TOK = 354 * MiB, WS_SCR = 356 * MiB;
constexpr size_t WS_PROJB = WS_SCR, WS_LW = WS_PROJB + 192 * MiB, WS_YRW = WS_LW + 128 * MiB, WS_BON = WS_YRW + 64 * MiB, WS_XBCC = WS_BON + 64 * MiB, WS_DTB = WS_XBCC + 48 * MiB, WS_YSSD = WS_DTB + 1 * MiB, WS_MIXED = WS_YSSD + 64 * MiB;
constexpr size_t WS_HBUF = WS_SCR, WS_XG = WS_HBUF + 187 * MiB, WS_YSLOT = WS_XG + 136 * MiB;
constexpr size_t WS_WFFN = WS_SCR + 860 * MiB, WS_END = WS_WFFN + 264 * MiB;
constexpr size_t WS_IMG = WS_MIXED;
static_assert(WS_MIXED + 132 * MiB <= WS_WFFN && WS_YSLOT + 281 * MiB <= WS_WFFN, "scratch inside the map");
static_assert((size_t)PMAX * DFE * 2 <= 187 * MiB && (size_t)PMAX * D * 2 <= 136 * MiB && (size_t)PMAX * FLD * 4 <= 281 * MiB && (size_t)M * FLD * 4 <= 132 * MiB, "moe buffers");
constexpr int CW_CNT = 16;
constexpr int CW_BAR = 4096;
constexpr int MAX_BAR_REGIONS = 48;
static_assert((CW_BAR + MAX_BAR_REGIONS * XCD_BAR_WORDS) * 4 <= (int)CTL_BYTES, "ctl");
constexpr int RING_BYTES = 131072, LDS_BYTES = 147456, MISC_OFF = LDS_BYTES - 256;

struct Params { const float* in[35]; float* out; unsigned char* ws; int ph_lo, ph_hi, bar_idx, pad; };

__device__ __forceinline__ float wave_sum_f(float v) {
#pragma unroll
    for (int o = 32; o >= 1; o >>= 1) v += __shfl_xor(v, o);
    return v;
}

__device__ __forceinline__ void cvt_item(const float* W, int K, int N, bf16_t* WT, int dst_row0, LAS float* scr, int k0, int n0, int lane) {
    const int kr = lane >> 3, c4 = (lane & 7) * 4;
    f32x4 v[8];
    if (n0 + 32 <= N && k0 + 64 <= K) {
#pragma unroll
        for (int i = 0; i < 8; ++i) v[i] = *(const f32x4*)(W + (size_t)(k0 + 8 * i + kr) * N + n0 + c4);
    } else {
#pragma unroll
        for (int i = 0; i < 8; ++i) { const int kk = k0 + 8 * i + kr;
#pragma unroll
            for (int e = 0; e < 4; ++e) v[i][e] = (kk < K && n0 + c4 + e < N) ? W[(size_t)kk * N + n0 + c4 + e] : 0.f; }
    }
#pragma unroll
    for (int i = 0; i < 8; ++i) { LAS float* d = scr + (8 * i + kr) * 33 + c4; d[0] = v[i][0]; d[1] = v[i][1]; d[2] = v[i][2]; d[3] = v[i][3]; }
    asm volatile("s_waitcnt lgkmcnt(0)" ::: "memory");
    const int c = lane & 7;
#pragma unroll
    for (int j = 0; j < 4; ++j) { const int n = (lane >> 3) + 8 * j; const LAS float* s = scr + (8 * c) * 33 + n;
        u32x4 o; o.x = cvt_pk_bf16(s[0 * 33], s[1 * 33]); o.y = cvt_pk_bf16(s[2 * 33], s[3 * 33]); o.z = cvt_pk_bf16(s[4 * 33], s[5 * 33]); o.w = cvt_pk_bf16(s[6 * 33], s[7 * 33]);
        if (n0 + n < N && k0 + 8 * c < K) *(u32x4*)(WT + (size_t)(dst_row0 + n) * K + k0 + 8 * c) = o; }
    asm volatile("s_waitcnt lgkmcnt(0)" ::: "memory");
}
template <int MODE>
__device__ __forceinline__ void cvt_job(const float* W, int K, int N, bf16_t* WT, int row_off, int half, LAS float* scr, int gw, int ngw, int lane) {
    const int nkb = (K + 63) / 64, nnb = (N + 31) / 32, nitems = nkb * nnb;
    for (int it = gw; it < nitems; it += ngw) {
        const int kb = it / nnb, nb = it % nnb, n0 = nb * 32;
        const int dr = MODE == 0 ? row_off + n0 : row_off + 256 * (n0 / 128) + half * 128 + (n0 % 128);
        cvt_item(W, K, N, WT, dr, scr, kb * 64, n0, lane);
    }
}

#define DPP_ROR(z, n) __uint_as_float(__builtin_amdgcn_update_dpp(0u, __float_as_uint(z), 0x120 + (n), 0xf, 0xf, false))
__device__ __forceinline__ float wave_allsum(float x) {
    { auto s = __builtin_amdgcn_permlane32_swap(__float_as_uint(x), __float_as_uint(x), false, false); x = __uint_as_float(s[0]) + __uint_as_float(s[1]); }
    { auto s = __builtin_amdgcn_permlane16_swap(__float_as_uint(x), __float_as_uint(x), false, false); x = __uint_as_float(s[0]) + __uint_as_float(s[1]); }
    x += DPP_ROR(x, 8); x += DPP_ROR(x, 4); x += DPP_ROR(x, 2); x += DPP_ROR(x, 1);
    return x;
}
__device__ __forceinline__ float reduce4(float x0, float x1, float x2, float x3) {
    float y0, y1, z;
    { auto s = __builtin_amdgcn_permlane32_swap(__float_as_uint(x0), __float_as_uint(x2), false, false); y0 = __uint_as_float(s[0]) + __uint_as_float(s[1]); }
    { auto s = __builtin_amdgcn_permlane32_swap(__float_as_uint(x1), __float_as_uint(x3), false, false); y1 = __uint_as_float(s[0]) + __uint_as_float(s[1]); }
    { auto s = __builtin_amdgcn_permlane16_swap(__float_as_uint(y0), __float_as_uint(y1), false, false); z = __uint_as_float(s[0]) + __uint_as_float(s[1]); }
    z += DPP_ROR(z, 8); z += DPP_ROR(z, 4); z += DPP_ROR(z, 2); z += DPP_ROR(z, 1);
    return z;
}
__device__ __forceinline__ float rdlane(float v, int l) { return __int_as_float(__builtin_amdgcn_readlane(__float_as_int(v), l)); }
__device__ __forceinline__ f32x4 ld_bf4(const bf16_t* p) { const u32x2 w = *(const u32x2*)p; return (f32x4){bf_lo(w.x), bf_hi(w.x), bf_lo(w.y), bf_hi(w.y)}; }
__device__ __forceinline__ void ln_finish(f32x4 (&v)[8], const f32x4 (&g8)[8], const f32x4 (&b8)[8], int lane, float* xf_row, bf16_t* xb_row) {
    float s = 0.f;
#pragma unroll
    for (int j = 0; j < 8; ++j) s += (v[j][0] + v[j][1]) + (v[j][2] + v[j][3]);
    const float mean = wave_allsum(s) * (1.f / D);
    float q = 0.f;
#pragma unroll
    for (int j = 0; j < 8; ++j) { v[j] = v[j] - mean; q += (v[j][0] * v[j][0] + v[j][1] * v[j][1]) + (v[j][2] * v[j][2] + v[j][3] * v[j][3]); }
    const float rstd = rsqrtf(wave_allsum(q) * (1.f / D) + 1e-5f);
#pragma unroll
    for (int j = 0; j < 8; ++j) { const int c = 4 * lane + 256 * j;
        v[j] = v[j] * rstd * g8[j] + b8[j];
        if (xf_row) *(f32x4*)(xf_row + c) = v[j];
        if (xb_row) { u32x2 w; w.x = cvt_pk_bf16(v[j][0], v[j][1]); w.y = cvt_pk_bf16(v[j][2], v[j][3]); *(u32x2*)(xb_row + c) = w; } }
}

__device__ __forceinline__ float fast_sigmoid(float x) { return __builtin_amdgcn_rcpf(1.f + __builtin_amdgcn_exp2f(-1.4426950408889634f * x)); }
__device__ __forceinline__ float fast_tanh(float x) { return 1.f - 2.f * __builtin_amdgcn_rcpf(1.f + __builtin_amdgcn_exp2f(2.8853900817779268f * x)); }

constexpr int LORA_PITCH = 328;
__device__ __forceinline__ void lora_phase(LAS unsigned char* lds, const bf16_t* projb, const float* mix, const float* vmix, const bf16_t* Wl_w, const bf16_t* Wl_a, const bf16_t* Wl_g, const bf16_t* Wl_v,
                                           bf16_t* lw, const bool has_v, const int vcu, const int G, const int tid) {
    const int wave = __builtin_amdgcn_readfirstlane(tid >> 6), lane = tid & 63, fr = lane & 15, fq = lane >> 4;
    LAS bf16_t* Aimg = (LAS bf16_t*)lds;
    for (int u = vcu; u < M / 64; u += G) {
        {
            const int tau = tid >> 3, part = tid & 7, m = u * 64 + tau; const bool first = (m % SEQ) == 0;
#pragma unroll
            for (int i = 0; i < 5; ++i) {
                const int j0 = 40 * part + 8 * i;
                const u32x4 cur = *(const u32x4*)(projb + (size_t)m * PROJ_BLD + OFF_WLO + j0);
                u32x4 prv = (u32x4){0u, 0u, 0u, 0u};
                if (!first) prv = *(const u32x4*)(projb + (size_t)(m - 1) * PROJ_BLD + OFF_WLO + j0);
                f32x4 mx0, mx1;
                if (j0 < 288) { mx0 = *(const f32x4*)(mix + (OFF_WLO - OFF_RW) + j0); mx1 = *(const f32x4*)(mix + (OFF_WLO - OFF_RW) + j0 + 4); }
                else if (has_v) { mx0 = *(const f32x4*)(vmix + (j0 - 288)); mx1 = *(const f32x4*)(vmix + (j0 - 288) + 4); }
                else { mx0 = (f32x4){0.f, 0.f, 0.f, 0.f}; mx1 = mx0; }
                float o[8];
#pragma unroll
                for (int e = 0; e < 4; ++e) {
                    const float c0 = bf_lo(cur[e]), c1 = bf_hi(cur[e]), p0 = bf_lo(prv[e]), p1 = bf_hi(prv[e]);
                    const float m0 = (e < 2) ? mx0[2 * e] : mx1[2 * e - 4], m1 = (e < 2) ? mx0[2 * e + 1] : mx1[2 * e - 3];
                    o[2 * e] = c0 + (p0 - c0) * m0; o[2 * e + 1] = c1 + (p1 - c1) * m1;
                }
                if (j0 < 64) {
#pragma unroll
                    for (int e = 0; e < 8; ++e) o[e] = fast_tanh(o[e]);
                } else if (j0 >= 128 && j0 < 288) {
#pragma unroll
                    for (int e = 0; e < 8; ++e) o[e] = fast_sigmoid(o[e]);
                }
                u32x4 w; w.x = cvt_pk_bf16(o[0], o[1]); w.y = cvt_pk_bf16(o[2], o[3]); w.z = cvt_pk_bf16(o[4], o[5]); w.w = cvt_pk_bf16(o[6], o[7]);
                *(LAS u32x4*)(Aimg + tau * LORA_PITCH + j0) = w;
            }
        }
        __syncthreads();
        for (int q = 0; q < 4; ++q) {
            if (q == 3 && !has_v) break;
            const int K = (q == 2) ? 160 : (q == 3 ? 32 : 64), koff = (q == 0) ? 0 : (q == 1 ? 64 : (q == 2 ? 128 : 288));
            const bf16_t* W = (q == 0) ? Wl_w : (q == 1 ? Wl_a : (q == 2 ? Wl_g : Wl_v));
            f32x4 acc[8][4];
#pragma unroll
            for (int ct = 0; ct < 8; ++ct)
#pragma unroll
                for (int tt = 0; tt < 4; ++tt) acc[ct][tt] = (f32x4){0.f, 0.f, 0.f, 0.f};
            for (int ks = 0; ks < K / 32; ++ks) {
                bf16x8 af[8], bfr[4];
#pragma unroll
                for (int ct = 0; ct < 8; ++ct) af[ct] = *(const bf16x8*)(W + (size_t)(128 * wave + 32 * (ct >> 1) + 8 * (fr >> 2) + 4 * (ct & 1) + (fr & 3)) * K + 32 * ks + 8 * fq);
#pragma unroll
                for (int tt = 0; tt < 4; ++tt) bfr[tt] = *(const LAS bf16x8*)(Aimg + (16 * tt + fr) * LORA_PITCH + koff + 32 * ks + 8 * fq);
#pragma unroll
                for (int ct = 0; ct < 8; ++ct)
#pragma unroll
                    for (int tt = 0; tt < 4; ++tt) acc[ct][tt] = __builtin_amdgcn_mfma_f32_16x16x32_bf16(af[ct], bfr[tt], acc[ct][tt], 0, 0, 0);
            }
            bf16_t* out = lw + (size_t)q * M * 1024;
#pragma unroll
            for (int cp = 0; cp < 4; ++cp)
#pragma unroll
                for (int tt = 0; tt < 4; ++tt) { u32x4 w; w.x = cvt_pk_bf16(acc[2 * cp][tt][0], acc[2 * cp][tt][1]); w.y = cvt_pk_bf16(acc[2 * cp][tt][2], acc[2 * cp][tt][3]);
                    w.z = cvt_pk_bf16(acc[2 * cp + 1][tt][0], acc[2 * cp + 1][tt][1]); w.w = cvt_pk_bf16(acc[2 * cp + 1][tt][2], acc[2 * cp + 1][tt][3]);
                    *(u32x4*)(out + (size_t)(u * 64 + 16 * tt + fr) * 1024 + 128 * wave + 32 * cp + 8 * fq) = w; }
        }
        __syncthreads();
    }
}

struct RwScan { const bf16_t* proj_; const bf16_t* lw_; const float* mix; const float* w0; const float* a0; const float* v0; const float* k_k; const float* k_a; const float* r_k; float* vf_; bf16_t* y_; bf16_t* bon_; int layer; int pad;
                const float* cw1; const float* cw3; const float* cw2; bf16_t* cwt; int cmoe; int pad2; };
constexpr int RWB_A = 0, RWB_DR = 8192, RWB_D = 16384, RWB_B = 24576, RWB_K = 32768, RWB_BIG = 40960, RWS_V = 0, RWS_SC = 4096, RWS_SIZE = 4608, RW_SMALL = 2 * RWB_BIG, RW_YST = RW_SMALL + 3 * RWS_SIZE, RW_YST_SIZE = 4096, RW_CVT = RW_YST + 2 * RW_YST_SIZE, RW_TB = 32, RW_NCH = SEQ / RW_TB;
static_assert(RW_CVT + 4 * 8448 <= MISC_OFF, "rwkv scan LDS map");
__device__ __forceinline__ float rowsum16(float z) { z += DPP_ROR(z, 8); asm("" : "+v"(z)); z += DPP_ROR(z, 4); asm("" : "+v"(z)); z += DPP_ROR(z, 2); asm("" : "+v"(z)); z += DPP_ROR(z, 1); asm("" : "+v"(z)); return z; }
__device__ __forceinline__ void rwkv_scan_phase(LAS unsigned char* lds, const RwScan& a, const int vcu, const int G, const int tid) {
    const int wave = __builtin_amdgcn_readfirstlane(tid >> 6), lane = tid & 63, jj = lane & 15, rg = lane >> 4;
    for (int u = vcu; u < BATCH * RW_H * 2; u += G) {
        const int b = u >> 5, h = (u >> 1) & 15, half = u & 1;
        if (wave >= 4) {
            const int pw_ = wave - 4, c = h * 64 + lane, ptid = tid - 256;
            const float mix_r = a.mix[c], mix_k = a.mix[1024 + c], mix_v = a.mix[2048 + c];
            const float w0c = a.w0[c], a0c = a.a0[c], v0c = a.layer ? a.v0[c] : 0.f, kkc = a.k_k[c], kac = a.k_a[c], rkc = a.r_k[c];
            const bf16_t* lw_w = a.lw_; const bf16_t* lw_a = a.lw_ + (size_t)M * 1024; const bf16_t* lw_v = a.lw_ + (size_t)3 * M * 1024;
            const int woff = (lane & 7) * 32 + (lane >> 3) * 4;
            unsigned pr[9], pk[9], pv[9], pw[8], pa[8], pvp[8]; float pvf[8];
#define RW_PREFETCH(t0_) do { const int tb_ = (t0_) + 8 * pw_; \
            _Pragma("unroll") for (int i = 0; i < 9; ++i) { const int t_ = tb_ + i - 1; \
                if (t_ >= 0) { const bf16_t* row_ = a.proj_ + (size_t)(b * SEQ + t_) * PROJ_BLD + h * 64 + lane; pr[i] = row_[OFF_R]; pk[i] = row_[OFF_K]; pv[i] = row_[OFF_V]; } \
                else { pr[i] = 0u; pk[i] = 0u; pv[i] = 0u; } } \
            _Pragma("unroll") for (int i = 0; i < 8; ++i) { const size_t o_ = (size_t)(b * SEQ + tb_ + i) * 1024 + c; pw[i] = lw_w[o_]; pa[i] = lw_a[o_]; \
                if (a.layer) { pvp[i] = lw_v[o_]; pvf[i] = a.vf_[o_]; } else { pvp[i] = 0u; pvf[i] = 0.f; } } } while (0)
#define RW_PREP(ch_) do { const int t0_ = (ch_) * RW_TB; LAS unsigned char* buf_ = lds + ((ch_) & 1) * RWB_BIG; LAS unsigned char* sm_ = lds + RW_SMALL + ((ch_) % 3) * RWS_SIZE; \
            _Pragma("unroll") for (int i = 0; i < 8; ++i) { \
                const int tau = 8 * pw_ + i; \
                const float rc = __uint_as_float(pr[i + 1] << 16), rp = __uint_as_float(pr[i] << 16), kc = __uint_as_float(pk[i + 1] << 16), kp = __uint_as_float(pk[i] << 16), vc = __uint_as_float(pv[i + 1] << 16), vp = __uint_as_float(pv[i] << 16); \
                const float r = rc + (rp - rc) * mix_r, kraw = kc + (kp - kc) * mix_k, vraw = vc + (vp - vc) * mix_v; \
                const float sg = fast_sigmoid(w0c + __uint_as_float(pw[i] << 16)); \
                const float dec = __builtin_amdgcn_exp2f(-1.4426950408889634f * 0.6065306597126334f * sg);     \
                const float as = fast_sigmoid(a0c + __uint_as_float(pa[i] << 16)); \
                float v = vraw; \
                if (a.layer) v = vraw + (pvf[i] - vraw) * fast_sigmoid(v0c + __uint_as_float(pvp[i] << 16)); \
                const float kkv = kraw * kkc; \
                const float km = kraw * (1.f + (as - 1.f) * kac); \
                const float z = reduce4(kkv * kkv, r * km * rkc, kkv * as * r, km * r);     \
                const float nrm2 = rdlane(z, 0), rks = rdlane(z, 16), bru = rdlane(z, 32), kr = rdlane(z, 48); \
                const float inv = __builtin_amdgcn_rsqf(fmaxf(nrm2, 1e-24f));     \
                const float kkn = kkv * inv; \
                *(LAS float*)(buf_ + RWB_A + tau * 256 + woff) = -kkn; *(LAS float*)(buf_ + RWB_DR + tau * 256 + woff) = dec * r; *(LAS float*)(buf_ + RWB_D + tau * 256 + woff) = dec; \
                *(LAS float*)(buf_ + RWB_B + tau * 256 + woff) = kkn * as; *(LAS float*)(buf_ + RWB_K + tau * 256 + woff) = km; \
                if ((lane >> 5) == half) { ((LAS float*)(sm_ + RWS_V))[tau * 32 + (lane & 31)] = v; \
                    if (a.layer == 0) a.vf_[(size_t)(b * SEQ + t0_ + tau) * 1024 + c] = vraw; } \
                if (lane == 0) { ((LAS float*)(sm_ + RWS_SC))[tau] = bru * inv; ((LAS float*)(sm_ + RWS_SC))[32 + tau] = kr; ((LAS float*)(sm_ + RWS_SC))[64 + tau] = rks; } \
            } } while (0)
#define RW_FLUSH(ch_) do { const int t0_ = (ch_) * RW_TB; const LAS unsigned char* sm_ = lds + RW_SMALL + ((ch_) % 3) * RWS_SIZE; const LAS float* yst_ = (const LAS float*)(lds + RW_YST + ((ch_) & 1) * RW_YST_SIZE); \
            _Pragma("unroll") for (int q = 0; q < 2; ++q) { const int idx = ptid + 256 * q, tau = idx >> 4, i = (idx & 15) * 2;     \
                const float y0 = yst_[(((tau >> 3) * 4 + (i >> 3)) * 64) + (i & 7) * 8 + (tau & 7)], y1 = yst_[(((tau >> 3) * 4 + (i >> 3)) * 64) + ((i & 7) + 1) * 8 + (tau & 7)]; \
                const float rk_ = ((const LAS float*)(sm_ + RWS_SC))[64 + tau]; const f32x2 v2_ = *(const LAS f32x2*)((const LAS float*)(sm_ + RWS_V) + tau * 32 + i); \
                const size_t o = (size_t)(b * SEQ + t0_ + tau) * 1024 + h * 64 + half * 32 + i; \
                *(unsigned*)(a.y_ + o) = cvt_pk_bf16(y0, y1); *(unsigned*)(a.bon_ + o) = cvt_pk_bf16(rk_ * v2_.x, rk_ * v2_.y); } } while (0)
            const int cv_total = a.cmoe ? NE * 3 * 2816 : 3 * 5632, cv_stride = G * 4;
            int cv_it = vcu * 4 + pw_; float cvv[32]; bool cv_pend = false;
#define CV_DECODE(it_) const int e_ = a.cmoe ? (it_) / 8448 : 0, rr_ = a.cmoe ? (it_) % 8448 : (it_), per_ = a.cmoe ? 2816 : 5632, j_ = rr_ / per_, r_ = rr_ % per_, dfe_ = a.cmoe ? DFE : DFF; \
            const int K_ = (j_ == 2) ? dfe_ : D, N_ = (j_ == 2) ? D : dfe_, nnb_ = N_ / 32, k0_ = (r_ / nnb_) * 64, n0_ = (r_ % nnb_) * 32; \
            const float* W_ = (j_ == 0 ? a.cw1 : (j_ == 1 ? a.cw3 : a.cw2)) + (size_t)e_ * D * dfe_;
#define CV_LOAD() do { if (cv_it < cv_total) { CV_DECODE(cv_it) \
                const float* src_ = W_ + (size_t)(k0_ + 32 * (lane >> 5)) * N_ + n0_ + (lane & 31);     \
                _Pragma("unroll") for (int i = 0; i < 32; ++i) cvv[i] = src_[(size_t)i * N_]; cv_pend = true; } } while (0)
#define CV_STORE() do { if (cv_pend) { CV_DECODE(cv_it) (void)W_; \
                const int drow_ = (j_ == 2) ? (a.cmoe ? e_ * D + n0_ : n0_) : (a.cmoe ? e_ * 2 * DFE : 0) + 256 * (n0_ / 128) + j_ * 128 + (n0_ % 128); \
                bf16_t* WT_ = a.cwt + ((j_ == 2) ? (size_t)(a.cmoe ? NE * 2 * DFE : 2 * DFF) * D : (size_t)0) + (size_t)(drow_ + (lane & 31)) * K_ + k0_ + 32 * (lane >> 5); \
                _Pragma("unroll") for (int q = 0; q < 4; ++q) { u32x4 o; o.x = cvt_pk_bf16(cvv[8 * q], cvv[8 * q + 1]); o.y = cvt_pk_bf16(cvv[8 * q + 2], cvv[8 * q + 3]); o.z = cvt_pk_bf16(cvv[8 * q + 4], cvv[8 * q + 5]); o.w = cvt_pk_bf16(cvv[8 * q + 6], cvv[8 * q + 7]); \
                    *(u32x4*)(WT_ + 8 * q) = o; } \
                cv_pend = false; cv_it += cv_stride; } } while (0)
            RW_PREFETCH(0);
            RW_PREP(0);
            RW_PREFETCH(RW_TB);
            CV_LOAD();
            __syncthreads();
            for (int ch = 0; ch < RW_NCH; ++ch) {
                if (ch > 0) RW_FLUSH(ch - 1);
                if (ch + 1 < RW_NCH) { RW_PREP(ch + 1);
#if (MK_DBL >> 12) & 1
                    RW_PREP(ch + 1);
#endif
                    if (ch + 2 < RW_NCH) RW_PREFETCH((ch + 2) * RW_TB); }
                CV_STORE(); CV_LOAD();
                __syncthreads();
            }
            RW_FLUSH(RW_NCH - 1);
            while (cv_pend) { CV_STORE(); CV_LOAD(); }
#undef CV_DECODE
#undef CV_LOAD
#undef CV_STORE
#undef RW_PREFETCH
#undef RW_PREP
#undef RW_FLUSH
        } else {
            const int jl = lane & 7, rr = lane >> 3;
            __builtin_amdgcn_s_setprio(3);
            f32x2 S01 = (f32x2){0.f, 0.f}, S23 = S01, S45 = S01, S67 = S01;
#define DPP_Q(z, ctrl) __uint_as_float(__builtin_amdgcn_update_dpp(0u, __float_as_uint(z), (ctrl), 0xf, 0xf, false))
#define SUM8(z) do { z += DPP_Q(z, 0xB1); asm("" : "+v"(z)); z += DPP_Q(z, 0x4E); asm("" : "+v"(z)); z += DPP_Q(z, 0x141); asm("" : "+v"(z)); } while (0)
            __syncthreads();
            for (int ch = 0; ch < RW_NCH; ++ch) {
                const LAS unsigned char* buf = lds + (ch & 1) * RWB_BIG; const LAS unsigned char* sm = lds + RW_SMALL + (ch % 3) * RWS_SIZE;
                const LAS unsigned char* ob = buf + jl * 32;
                const LAS float* Vb = (const LAS float*)(sm + RWS_V) + 8 * wave + rr; const LAS float* SC = (const LAS float*)(sm + RWS_SC);
                LAS float* Yst = (LAS float*)(lds + RW_YST + (ch & 1) * RW_YST_SIZE);
#define LD8(dst0, dst1, off) do { dst0 = *(const LAS f32x4*)(ob + (off)); dst1 = *(const LAS f32x4*)(ob + (off) + 16); } while (0)
                f32x4 a0, a1, q0, q1, d0, d1, b0, b1, k0, k1, na0, na1, nq0, nq1, nd0, nd1, nb0, nb1, nk0, nk1;
                LD8(a0, a1, RWB_A); LD8(q0, q1, RWB_DR); LD8(d0, d1, RWB_D); LD8(b0, b1, RWB_B); LD8(k0, k1, RWB_K);
                float vi = Vb[0], br = SC[0], kr = SC[32];
                LD8(na0, na1, RWB_A + 256); LD8(nq0, nq1, RWB_DR + 256); LD8(nd0, nd1, RWB_D + 256); LD8(nb0, nb1, RWB_B + 256); LD8(nk0, nk1, RWB_K + 256);
                float nvi = Vb[32], nbr = SC[1], nkr = SC[33];
#pragma unroll
                for (int blk = 0; blk < 4; ++blk) {
                    float yacc = 0.f;
#pragma unroll
                    for (int s = 0; s < 8; ++s) {
                        const int tn = blk * 8 + s + 2;
                        f32x4 ma0, ma1, mq0, mq1, md0, md1, mb0, mb1, mk0, mk1;
                        LD8(ma0, ma1, RWB_A + tn * 256); LD8(mq0, mq1, RWB_DR + tn * 256); LD8(md0, md1, RWB_D + tn * 256); LD8(mb0, mb1, RWB_B + tn * 256); LD8(mk0, mk1, RWB_K + tn * 256);
                        const float mvi = Vb[(tn & 31) * 32], mbr = SC[tn & 31], mkr = SC[32 + (tn & 31)];
                        const f32x2 pa2 = (S01 * (f32x2){a0[0], a0[1]} + S23 * (f32x2){a0[2], a0[3]}) + (S45 * (f32x2){a1[0], a1[1]} + S67 * (f32x2){a1[2], a1[3]});
                        const f32x2 pq2 = (S01 * (f32x2){q0[0], q0[1]} + S23 * (f32x2){q0[2], q0[3]}) + (S45 * (f32x2){q1[0], q1[1]} + S67 * (f32x2){q1[2], q1[3]});
                        float sa = pa2.x + pa2.y, zq = pq2.x + pq2.y;
                        SUM8(sa); SUM8(zq);
                        S01 = (S01 * (f32x2){d0[0], d0[1]} + vi * (f32x2){k0[0], k0[1]}) + sa * (f32x2){b0[0], b0[1]};
                        S23 = (S23 * (f32x2){d0[2], d0[3]} + vi * (f32x2){k0[2], k0[3]}) + sa * (f32x2){b0[2], b0[3]};
                        S45 = (S45 * (f32x2){d1[0], d1[1]} + vi * (f32x2){k1[0], k1[1]}) + sa * (f32x2){b1[0], b1[1]};
                        S67 = (S67 * (f32x2){d1[2], d1[3]} + vi * (f32x2){k1[2], k1[3]}) + sa * (f32x2){b1[2], b1[3]};
                        const float y = zq + sa * br + vi * kr;
                        yacc = (jl == s) ? y : yacc;
                        a0 = na0; a1 = na1; q0 = nq0; q1 = nq1; d0 = nd0; d1 = nd1; b0 = nb0; b1 = nb1; k0 = nk0; k1 = nk1; vi = nvi; br = nbr; kr = nkr;
                        na0 = ma0; na1 = ma1; nq0 = mq0; nq1 = mq1; nd0 = md0; nd1 = md1; nb0 = mb0; nb1 = mb1; nk0 = mk0; nk1 = mk1; nvi = mvi; nbr = mbr; nkr = mkr;
                    }
                    Yst[(blk * 4 + wave) * 64 + lane] = yacc;
                }
#undef LD8
                __syncthreads();
            }
#undef SUM8
#undef DPP_Q
            __builtin_amdgcn_s_setprio(0);
        }
        __syncthreads();
    }
}

constexpr int RP = 68, VP = 34;
constexpr int CK_RA = 0, CK_RB = 8704, CK_RK = 17408, CK_RR = 26112, CK_LD = 34816, CK_RV = 43520, CK_RRK = 47872, CK_CUM = 48000, CK_PL = 56976, CK_NAB = 57232,
              CK_AT = 61840, CK_RT = 66448, CK_BH = 71056, CK_KH = 75664, CK_S0 = 80272, CK_NAK = 84880, CK_MBR = 87440, CK_MKR = 90000, CK_TT = 92560, CK_VI = 95120, CK_WI = 97680, CK_UI = 100240,
              CK_BC = 102800, CK_KC = 107920, CK_CUM2 = 113040, CK_END = 122016;
constexpr int P64 = 72, P32 = 40;
static_assert(CK_END <= MISC_OFF, "chunked rwkv LDS map");
__device__ __forceinline__ bf16x8 ldfrag(const LAS bf16_t* img, int pitch, int row, int k0) { return *(const LAS bf16x8*)(img + row * pitch + k0); }
__device__ __forceinline__ void rwkv_chunk_phase(LAS unsigned char* lds, const RwScan& a, const int vcu, const int G, const int tid0_) {
    const int tid = tid0_, wave = __builtin_amdgcn_readfirstlane(tid >> 6), lane = tid & 63;
    LAS float* RA = (LAS float*)(lds + CK_RA); LAS float* RB = (LAS float*)(lds + CK_RB); LAS float* RKm = (LAS float*)(lds + CK_RK); LAS float* RR = (LAS float*)(lds + CK_RR);
    LAS float* RLD = (LAS float*)(lds + CK_LD); LAS float* RV = (LAS float*)(lds + CK_RV); LAS float* RRK = (LAS float*)(lds + CK_RRK); LAS float* CUM = (LAS float*)(lds + CK_CUM);
    LAS float* PL = (LAS float*)(lds + CK_PL); LAS float* NabT = (LAS float*)(lds + CK_NAB); LAS float* CUMB = (LAS float*)(lds + CK_CUM2);
#define CK_CUMSUM(buf_) do { LAS float* cu_ = (buf_) ? CUMB : CUM; float ldv[32]; \
        _Pragma("unroll") for (int t = 0; t < 32; ++t) ldv[t] = RLD[t * RP + lane]; \
        float cs = 0.f; cu_[lane] = 0.f; \
        _Pragma("unroll") for (int t = 0; t < 32; ++t) { cs += ldv[t]; cu_[(t + 1) * RP + lane] = cs; } } while (0)
    LAS bf16_t* AT = (LAS bf16_t*)(lds + CK_AT); LAS bf16_t* RT = (LAS bf16_t*)(lds + CK_RT); LAS bf16_t* BH = (LAS bf16_t*)(lds + CK_BH); LAS bf16_t* KH = (LAS bf16_t*)(lds + CK_KH); LAS bf16_t* S0 = (LAS bf16_t*)(lds + CK_S0);
    LAS bf16_t* NakT = (LAS bf16_t*)(lds + CK_NAK); LAS bf16_t* MbrT = (LAS bf16_t*)(lds + CK_MBR); LAS bf16_t* MkrT = (LAS bf16_t*)(lds + CK_MKR); LAS bf16_t* TT = (LAS bf16_t*)(lds + CK_TT);
    LAS bf16_t* Vi = (LAS bf16_t*)(lds + CK_VI); LAS bf16_t* Wi = (LAS bf16_t*)(lds + CK_WI); LAS bf16_t* Ui = (LAS bf16_t*)(lds + CK_UI); LAS bf16_t* BcT = (LAS bf16_t*)(lds + CK_BC); LAS bf16_t* KcT = (LAS bf16_t*)(lds + CK_KC);
    for (int u = vcu; u < BATCH * RW_H * 2; u += G) {
        const int b = u >> 5, h = (u >> 1) & 15, half = u & 1, c = h * 64 + lane;
        const float mix_r = a.mix[c], mix_k = a.mix[1024 + c], mix_v = a.mix[2048 + c];
        const float w0c = a.w0[c], a0c = a.a0[c], v0c = a.layer ? a.v0[c] : 0.f, kkc = a.k_k[c], kac = a.k_a[c], rkc = a.r_k[c];
        const bf16_t* lw_w = a.lw_; const bf16_t* lw_a = a.lw_ + (size_t)M * 1024; const bf16_t* lw_v = a.lw_ + (size_t)3 * M * 1024;
        const int ptok0 = (wave < 4) ? 4 * (wave - 1) : 12 + 5 * (wave - 4), pntok = (wave == 0) ? 0 : ((wave < 4) ? 4 : 5);
        unsigned pr[6], pk[6], pv[6], pw[5], pa[5], pvp[5]; float pvf[5];
#define CK_PREFETCH(t0_) do { if (pntok) { const int tb_ = (t0_) + ptok0; \
        _Pragma("unroll") for (int i = 0; i < 6; ++i) { const int t_ = tb_ + i - 1; \
            if (t_ >= 0 && i <= pntok) { const bf16_t* row_ = a.proj_ + (size_t)(b * SEQ + t_) * PROJ_BLD + h * 64 + lane; pr[i] = row_[OFF_R]; pk[i] = row_[OFF_K]; pv[i] = row_[OFF_V]; } \
            else { pr[i] = 0u; pk[i] = 0u; pv[i] = 0u; } } \
        _Pragma("unroll") for (int i = 0; i < 5; ++i) { if (i < pntok) { const size_t o_ = (size_t)(b * SEQ + tb_ + i) * 1024 + c; pw[i] = lw_w[o_]; pa[i] = lw_a[o_]; \
            if (a.layer) { pvp[i] = lw_v[o_]; pvf[i] = a.vf_[o_]; } else { pvp[i] = 0u; pvf[i] = 0.f; } } else { pw[i] = 0u; pa[i] = 0u; pvp[i] = 0u; pvf[i] = 0.f; } } } } while (0)
#define CK_PREP(t0_) do { \
            _Pragma("unroll") for (int i = 0; i < 5; ++i) if (i < pntok) { \
                const int tau = ptok0 + i; \
                const float rc = __uint_as_float(pr[i + 1] << 16), rp = __uint_as_float(pr[i] << 16), kc = __uint_as_float(pk[i + 1] << 16), kp = __uint_as_float(pk[i] << 16), vc = __uint_as_float(pv[i + 1] << 16), vp = __uint_as_float(pv[i] << 16); \
                const float r = rc + (rp - rc) * mix_r, kraw = kc + (kp - kc) * mix_k, vraw = vc + (vp - vc) * mix_v; \
                const float sg = fast_sigmoid(w0c + __uint_as_float(pw[i] << 16)); \
                const float ld = -1.4426950408889634f * 0.6065306597126334f * sg;       \
                const float as = fast_sigmoid(a0c + __uint_as_float(pa[i] << 16)); \
                float v = vraw; \
                if (a.layer) v = vraw + (pvf[i] - vraw) * fast_sigmoid(v0c + __uint_as_float(pvp[i] << 16)); \
                const float kkv = kraw * kkc; \
                const float km = kraw * (1.f + (as - 1.f) * kac); \
                const float z = reduce4(kkv * kkv, r * km * rkc, 0.f, 0.f); \
                const float nrm2 = rdlane(z, 0), rks = rdlane(z, 16); \
                const float kkn = kkv * __builtin_amdgcn_rsqf(fmaxf(nrm2, 1e-24f)); \
                RA[tau * RP + lane] = -kkn; RB[tau * RP + lane] = kkn * as; RKm[tau * RP + lane] = km; RR[tau * RP + lane] = r; RLD[tau * RP + lane] = ld; \
                if ((lane >> 5) == half) { RV[tau * VP + (lane & 31)] = v; \
                    if (a.layer == 0) a.vf_[(size_t)(b * SEQ + (t0_) + tau) * 1024 + c] = vraw; } \
                if (lane == 0) RRK[tau] = rks; \
            } } while (0)
        const int cv_total = a.cmoe ? NE * 3 * 2816 : 3 * 5632, cv_stride = G * 4;
        int cv_it = vcu * 4 + (wave & 3); bool cv_pend = false;
#define CV_DECODE(it_) const int e_ = a.cmoe ? (it_) / 8448 : 0, rr_ = a.cmoe ? (it_) % 8448 : (it_), per_ = a.cmoe ? 2816 : 5632, j_ = rr_ / per_, r_ = rr_ % per_, dfe_ = a.cmoe ? DFE : DFF; \
        const int K_ = (j_ == 2) ? dfe_ : D, N_ = (j_ == 2) ? D : dfe_, nnb_ = N_ / 32, k0_ = (r_ / nnb_) * 64, n0_ = (r_ % nnb_) * 32; \
        const float* W_ = (j_ == 0 ? a.cw1 : (j_ == 1 ? a.cw3 : a.cw2)) + (size_t)e_ * D * dfe_;
#define CV_LOAD() do { if (cv_it < cv_total) { CV_DECODE(cv_it) \
            const float* src_ = W_ + (size_t)(k0_ + 32 * (lane >> 5)) * N_ + n0_ + (lane & 31); \
            _Pragma("unroll") for (int i = 0; i < 32; ++i) cvv[i] = src_[(size_t)i * N_]; cv_pend = true; } } while (0)
#define CV_STORE() do { if (cv_pend) { CV_DECODE(cv_it) (void)W_; \
            const int drow_ = (j_ == 2) ? (a.cmoe ? e_ * D + n0_ : n0_) : (a.cmoe ? e_ * 2 * DFE : 0) + 256 * (n0_ / 128) + j_ * 128 + (n0_ % 128); \
            bf16_t* WT_ = a.cwt + ((j_ == 2) ? (size_t)(a.cmoe ? NE * 2 * DFE : 2 * DFF) * D : (size_t)0) + (size_t)(drow_ + (lane & 31)) * K_ + k0_ + 32 * (lane >> 5); \
            _Pragma("unroll") for (int q = 0; q < 4; ++q) { u32x4 o; o.x = cvt_pk_bf16(cvv[8 * q], cvv[8 * q + 1]); o.y = cvt_pk_bf16(cvv[8 * q + 2], cvv[8 * q + 3]); o.z = cvt_pk_bf16(cvv[8 * q + 4], cvv[8 * q + 5]); o.w = cvt_pk_bf16(cvv[8 * q + 6], cvv[8 * q + 7]); \
                *(u32x4*)(WT_ + 8 * q) = o; } \
            cv_pend = false; cv_it += cv_stride; } } while (0)
        f32x4 Sacc = ZERO4();
        for (int i = tid; i < 32 * P64 / 2; i += 512) ((LAS unsigned*)S0)[i] = 0u;
        CK_PREFETCH(0);
        CK_PREP(0);
        CK_PREFETCH(32);
        __syncthreads();
        if (wave == 4) CK_CUMSUM(0);
        __syncthreads();
        for (int ch = 0; ch < SEQ / 32; ++ch) {
            const int t0 = ch * 32;
            int tid_c = tid0_; asm volatile("" : "+v"(tid_c));
            const int tid = tid_c, lane = tid & 63, fr = lane & 15, fq = lane >> 4;
            const LAS float* CUMc = (ch & 1) ? CUMB : CUM;
            {
                const int t = tid & 31, j0 = 4 * (tid >> 5);
                const f32x4 ct = *(const LAS f32x4*)(CUMc + (t + 1) * RP + j0), cp = *(const LAS f32x4*)(CUMc + t * RP + j0), cL = *(const LAS f32x4*)(CUMc + 32 * RP + j0);
                const f32x4 ra = *(const LAS f32x4*)(RA + t * RP + j0), rb = *(const LAS f32x4*)(RB + t * RP + j0), rk = *(const LAS f32x4*)(RKm + t * RP + j0), rr = *(const LAS f32x4*)(RR + t * RP + j0);
                float at[4], rt[4], bh[4], kh[4], bc[4], kc_[4];
#pragma unroll
                for (int e = 0; e < 4; ++e) { const float ea = __builtin_amdgcn_exp2f(cp[e]), er = __builtin_amdgcn_exp2f(ct[e]), ei = __builtin_amdgcn_exp2f(-ct[e]), ec = __builtin_amdgcn_exp2f(cL[e] - ct[e]);
                    at[e] = ra[e] * ea; rt[e] = rr[e] * er; bh[e] = rb[e] * ei; kh[e] = rk[e] * ei; bc[e] = rb[e] * ec; kc_[e] = rk[e] * ec; }
                { u32x2 w; w.x = cvt_pk_bf16(at[0], at[1]); w.y = cvt_pk_bf16(at[2], at[3]); *(LAS u32x2*)(AT + t * P64 + j0) = w; }
                { u32x2 w; w.x = cvt_pk_bf16(rt[0], rt[1]); w.y = cvt_pk_bf16(rt[2], rt[3]); *(LAS u32x2*)(RT + t * P64 + j0) = w; }
                { u32x2 w; w.x = cvt_pk_bf16(bh[0], bh[1]); w.y = cvt_pk_bf16(bh[2], bh[3]); *(LAS u32x2*)(BH + t * P64 + j0) = w; }
                { u32x2 w; w.x = cvt_pk_bf16(kh[0], kh[1]); w.y = cvt_pk_bf16(kh[2], kh[3]); *(LAS u32x2*)(KH + t * P64 + j0) = w; }
                { const unsigned w0 = cvt_pk_bf16(bc[0], bc[1]), w1 = cvt_pk_bf16(bc[2], bc[3]), x0 = cvt_pk_bf16(kc_[0], kc_[1]), x1 = cvt_pk_bf16(kc_[2], kc_[3]);
                  BcT[(j0 + 0) * P32 + t] = (bf16_t)(w0 & 0xffffu); BcT[(j0 + 1) * P32 + t] = (bf16_t)(w0 >> 16); BcT[(j0 + 2) * P32 + t] = (bf16_t)(w1 & 0xffffu); BcT[(j0 + 3) * P32 + t] = (bf16_t)(w1 >> 16);
                  KcT[(j0 + 0) * P32 + t] = (bf16_t)(x0 & 0xffffu); KcT[(j0 + 1) * P32 + t] = (bf16_t)(x0 >> 16); KcT[(j0 + 2) * P32 + t] = (bf16_t)(x1 & 0xffffu); KcT[(j0 + 3) * P32 + t] = (bf16_t)(x1 >> 16); }
                if (t == 31) { f32x4 pl; pl[0] = __builtin_amdgcn_exp2f(cL[0]); pl[1] = __builtin_amdgcn_exp2f(cL[1]); pl[2] = __builtin_amdgcn_exp2f(cL[2]); pl[3] = __builtin_amdgcn_exp2f(cL[3]); *(LAS f32x4*)(PL + j0) = pl; }
                { const int i0 = 2 * (tid >> 5); const f32x2 vv = *(const LAS f32x2*)(RV + t * VP + i0); const unsigned w = cvt_pk_bf16(vv.x, vv.y);
                  Vi[i0 * P32 + t] = (bf16_t)(w & 0xffffu); Vi[(i0 + 1) * P32 + t] = (bf16_t)(w >> 16); }
                { const int tb = tid >> 4, ib = 2 * (tid & 15); const float rk_ = RRK[tb]; const f32x2 vb = *(const LAS f32x2*)(RV + tb * VP + ib);
                  *(unsigned*)(a.bon_ + (size_t)(b * SEQ + t0 + tb) * 1024 + h * 64 + half * 32 + ib) = cvt_pk_bf16(rk_ * vb.x, rk_ * vb.y); }
            }
            __syncthreads();
#pragma unroll
            for (int q = 0; q < 2; ++q) {
                const int id = 2 * wave + q, mat = id >> 2, mt = (id >> 1) & 1, nt = id & 1;
                const LAS bf16_t* Ai = (mat & 1) ? KH : BH; const LAS bf16_t* Bi = (mat & 2) ? RT : AT;
                f32x4 g = ZERO4();
#pragma unroll
                for (int ks = 0; ks < 2; ++ks) g = __builtin_amdgcn_mfma_f32_16x16x32_bf16(ldfrag(Ai, P64, 16 * mt + fr, 32 * ks + 8 * fq), ldfrag(Bi, P64, 16 * nt + fr, 32 * ks + 8 * fq), g, 0, 0, 0);
                const int t = 16 * nt + fr, s0 = 16 * mt + 4 * fq;
#pragma unroll
                for (int r = 0; r < 4; ++r) { const int s = s0 + r; const bool keep = (mat < 2) ? (s < t) : (s <= t); g[r] = keep ? g[r] : 0.f; }
                if (mat == 0) *(LAS f32x4*)(NabT + t * 36 + s0) = g;
                else { LAS bf16_t* Xo = (mat == 1) ? NakT : ((mat == 2) ? MbrT : MkrT); u32x2 w; w.x = cvt_pk_bf16(g[0], g[1]); w.y = cvt_pk_bf16(g[2], g[3]); *(LAS u32x2*)(Xo + t * P32 + s0) = w; }
            }
            __syncthreads();
            if (wave == 0) {
                int ln = lane; asm volatile("" : "+v"(ln));
                float Tr[32];
                f32x4 rowb[2][8];
#pragma unroll
                for (int t = 0; t < 32; ++t) {
                    if (t + 1 < 32) {
#pragma unroll
                        for (int q = 0; q < 8; ++q) if (4 * q < t + 1) rowb[(t + 1) & 1][q] = *(const LAS f32x4*)(NabT + (t + 1) * 36 + 4 * q);
                    }
                    float acc4[4] = {(ln == t) ? 1.f : 0.f, 0.f, 0.f, 0.f};
#pragma unroll
                    for (int q = 0; q < 8; ++q)
#pragma unroll
                        for (int e = 0; e < 4; ++e) if (4 * q + e < t) acc4[e] += Tr[4 * q + e] * rowb[t & 1][q][e];
                    const float acc = (acc4[0] + acc4[1]) + (acc4[2] + acc4[3]);
                    Tr[t] = acc;
                    if (ln < 32) TT[t * P32 + ln] = (bf16_t)(cvt_pk_bf16(acc, 0.f) & 0xffffu);
                }
            } else {
                if (wave >= 4) {
                    const int mt = (wave - 4) >> 1, nt = (wave - 4) & 1;
                    f32x4 w = ZERO4();
#pragma unroll
                    for (int ks = 0; ks < 2; ++ks) w = __builtin_amdgcn_mfma_f32_16x16x32_bf16(ldfrag(AT, P64, 16 * mt + fr, 32 * ks + 8 * fq), ldfrag(S0, P64, 16 * nt + fr, 32 * ks + 8 * fq), w, 0, 0, 0);
                    w = __builtin_amdgcn_mfma_f32_16x16x32_bf16(ldfrag(NakT, P32, 16 * mt + fr, 8 * fq), ldfrag(Vi, P32, 16 * nt + fr, 8 * fq), w, 0, 0, 0);
                    u32x2 o; o.x = cvt_pk_bf16(w[0], w[1]); o.y = cvt_pk_bf16(w[2], w[3]); *(LAS u32x2*)(Wi + (16 * nt + fr) * P32 + 16 * mt + 4 * fq) = o;
                }
                if (ch + 1 < SEQ / 32) { CK_PREP(t0 + 32); if (ch + 2 < SEQ / 32) CK_PREFETCH(t0 + 64); }
            }
            __syncthreads();
            float cvv[32];
            if (wave >= 4) CV_LOAD();
            if (wave == 4 && ch + 1 < SEQ / 32) CK_CUMSUM((ch + 1) & 1);
            if (wave < 4) {
                const int mt = wave >> 1, nt = wave & 1;
                f32x4 uu = ZERO4();
                uu = __builtin_amdgcn_mfma_f32_16x16x32_bf16(ldfrag(TT, P32, 16 * mt + fr, 8 * fq), ldfrag(Wi, P32, 16 * nt + fr, 8 * fq), uu, 0, 0, 0);
                u32x2 o; o.x = cvt_pk_bf16(uu[0], uu[1]); o.y = cvt_pk_bf16(uu[2], uu[3]); *(LAS u32x2*)(Ui + (16 * nt + fr) * P32 + 16 * mt + 4 * fq) = o;
            }
            __syncthreads();
            if (wave >= 4) CV_STORE();
            if (wave < 4) {
                const int mt = wave >> 1, nt = wave & 1;
                f32x4 y = ZERO4();
#pragma unroll
                for (int ks = 0; ks < 2; ++ks) y = __builtin_amdgcn_mfma_f32_16x16x32_bf16(ldfrag(S0, P64, 16 * mt + fr, 32 * ks + 8 * fq), ldfrag(RT, P64, 16 * nt + fr, 32 * ks + 8 * fq), y, 0, 0, 0);
                y = __builtin_amdgcn_mfma_f32_16x16x32_bf16(ldfrag(Ui, P32, 16 * mt + fr, 8 * fq), ldfrag(MbrT, P32, 16 * nt + fr, 8 * fq), y, 0, 0, 0);
                y = __builtin_amdgcn_mfma_f32_16x16x32_bf16(ldfrag(Vi, P32, 16 * mt + fr, 8 * fq), ldfrag(MkrT, P32, 16 * nt + fr, 8 * fq), y, 0, 0, 0);
                u32x2 o; o.x = cvt_pk_bf16(y[0], y[1]); o.y = cvt_pk_bf16(y[2], y[3]);
                *(u32x2*)(a.y_ + (size_t)(b * SEQ + t0 + 16 * nt + fr) * 1024 + h * 64 + half * 32 + 16 * mt + 4 * fq) = o;
            }
            {
                const int mt = wave >> 1, nt = wave & 1;
                const f32x4 pl = *(const LAS f32x4*)(PL + 16 * mt + 4 * fq);
                Sacc = Sacc * pl;
                Sacc = __builtin_amdgcn_mfma_f32_16x16x32_bf16(ldfrag(BcT, P32, 16 * mt + fr, 8 * fq), ldfrag(Ui, P32, 16 * nt + fr, 8 * fq), Sacc, 0, 0, 0);
                Sacc = __builtin_amdgcn_mfma_f32_16x16x32_bf16(ldfrag(KcT, P32, 16 * mt + fr, 8 * fq), ldfrag(Vi, P32, 16 * nt + fr, 8 * fq), Sacc, 0, 0, 0);
            }
            __syncthreads();
            { const int mt = wave >> 1, nt = wave & 1; u32x2 o; o.x = cvt_pk_bf16(Sacc[0], Sacc[1]); o.y = cvt_pk_bf16(Sacc[2], Sacc[3]);
              *(LAS u32x2*)(S0 + (16 * nt + fr) * P64 + 16 * mt + 4 * fq) = o; }
        }
        if (wave >= 4) { float cvv[32]; CV_LOAD(); while (cv_pend) { CV_STORE(); CV_LOAD(); } }
#undef CK_PREFETCH
#undef CK_CUMSUM
#undef CK_PREP
#undef CV_DECODE
#undef CV_LOAD
#undef CV_STORE
        __syncthreads();
    }
}

constexpr int IMG_AT = 0, IMG_RT = 4096, IMG_BH = 8192, IMG_KH = 12288, IMG_VI = 16384, IMG_NAK = 20480, IMG_MBR = 22528, IMG_MKR = 24576, IMG_TT = 26624, IMG_PL = 28672, IMG_UNIT = 28928;
constexpr int PW_AT = 0, PW_RT = 4608, PW_BH = 9216, PW_KH = 13824, PW_NAB = PW_BH, PW_SIZE = 18432, PW_NW = 7;
static_assert(PW_NW * PW_SIZE <= MISC_OFF, "rwkv pre-phase LDS map");
static_assert((size_t)BATCH * RW_H * (SEQ / 32) * IMG_UNIT <= (size_t)299 * MiB, "rwkv chunk images fit between yssd and the FFN weights");
template <bool MOE> __device__ __forceinline__ void cv_decode(const int it, int& e, int& j, int& k0, int& n0) {
    constexpr int per = MOE ? 2816 : 5632, nnb = MOE ? 88 : 176;
    e = MOE ? it / 8448 : 0; const int rr = MOE ? it - e * 8448 : it; j = rr / per; const int r = rr - j * per;
    if (j == 2) { k0 = (r >> 6) * 64; n0 = (r & 63) * 32; } else { const int q = r / nnb; k0 = q * 64; n0 = (r - q * nnb) * 32; }
}
__device__ __forceinline__ void rwkv_pre_phase(LAS unsigned char* lds, const RwScan& a_, unsigned char* img, const int vcu, const int G, const int tid0_, const bool do_cv, const bool do_work) {
    const int wave = __builtin_amdgcn_readfirstlane(tid0_ >> 6);
    const bf16_t* const a_proj = a_.proj_; const bf16_t* const a_lw = a_.lw_; const float* const a_mix = a_.mix; const float* const a_w0 = a_.w0; const float* const a_a0 = a_.a0; const float* const a_v0 = a_.v0;
    const float* const a_kk = a_.k_k; const float* const a_ka = a_.k_a; const float* const a_rk = a_.r_k; float* const a_vf = a_.vf_; bf16_t* const a_bon = a_.bon_; const int a_layer = a_.layer;
    const float* const a_cw1 = a_.cw1; const float* const a_cw3 = a_.cw3; const float* const a_cw2 = a_.cw2; bf16_t* const a_cwt = a_.cwt; const int a_cmoe = a_.cmoe;
    if (wave >= PW_NW) {
        const int lane = tid0_ & 63;
        const int cv_total = a_cmoe ? MK_CV_CUT_MOE : MK_CV_CUT_DENSE, cv_stride = G * (NWAVES - PW_NW);
        int cv_it = do_cv ? vcu * (NWAVES - PW_NW) + (wave - PW_NW) : cv_total;
        float va[32], vb[32];
#define CV_DECODE(it_) int e_, j_, k0_, n0_; if (a_cmoe) cv_decode<true>((it_), e_, j_, k0_, n0_); else cv_decode<false>((it_), e_, j_, k0_, n0_); \
        const int dfe_ = a_cmoe ? DFE : DFF, K_ = (j_ == 2) ? dfe_ : D, N_ = (j_ == 2) ? D : dfe_; \
        const float* W_ = (j_ == 0 ? a_cw1 : (j_ == 1 ? a_cw3 : a_cw2)) + (size_t)e_ * D * dfe_;
#define CV_LD(buf_, it_) do { CV_DECODE(it_) \
            const float* src_ = W_ + (size_t)(k0_ + 32 * (lane >> 5)) * N_ + n0_ + (lane & 31); \
            _Pragma("unroll") for (int i = 0; i < 32; ++i) { buf_[i] = *src_; src_ += N_; asm volatile("" : "+v"(src_)); } } while (0)
#define CV_ST(buf_, it_) do { CV_DECODE(it_) (void)W_; \
            const int drow_ = (j_ == 2) ? (a_cmoe ? e_ * D + n0_ : n0_) : (a_cmoe ? e_ * 2 * DFE : 0) + 256 * (n0_ / 128) + j_ * 128 + (n0_ % 128); \
            bf16_t* WT_ = a_cwt + ((j_ == 2) ? (size_t)(a_cmoe ? NE * 2 * DFE : 2 * DFF) * D : (size_t)0) + (size_t)(drow_ + (lane & 31)) * K_ + k0_ + 32 * (lane >> 5); \
            _Pragma("unroll") for (int q = 0; q < 4; ++q) { u32x4 o; o.x = cvt_pk_bf16(buf_[8 * q], buf_[8 * q + 1]); o.y = cvt_pk_bf16(buf_[8 * q + 2], buf_[8 * q + 3]); o.z = cvt_pk_bf16(buf_[8 * q + 4], buf_[8 * q + 5]); o.w = cvt_pk_bf16(buf_[8 * q + 6], buf_[8 * q + 7]); \
                *(u32x4*)(WT_ + 8 * q) = o; } } while (0)
#ifndef MK_X_NOCV
        if (cv_it < cv_total) CV_LD(va, cv_it);
        while (cv_it < cv_total) {
            const int n1 = cv_it + cv_stride;
            if (n1 < cv_total) CV_LD(vb, n1);
            CV_ST(va, cv_it);
            if (n1 >= cv_total) break;
            const int n2 = n1 + cv_stride;
            if (n2 < cv_total) CV_LD(va, n2);
            CV_ST(vb, n1);
            cv_it = n2;
        }
#endif
#undef CV_DECODE
#undef CV_LD
#undef CV_ST
        return;
    }
    LAS unsigned char* my = lds + wave * PW_SIZE;
    LAS bf16_t* AT = (LAS bf16_t*)(my + PW_AT); LAS bf16_t* RT = (LAS bf16_t*)(my + PW_RT); LAS bf16_t* BH = (LAS bf16_t*)(my + PW_BH); LAS bf16_t* KH = (LAS bf16_t*)(my + PW_KH); LAS float* NabT = (LAS float*)(my + PW_NAB);
    const bf16_t* lw_w = a_lw; const bf16_t* lw_a = a_lw + (size_t)M * 1024; const bf16_t* lw_v = a_lw + (size_t)3 * M * 1024;
    const __amdgpu_buffer_rsrc_t rs_proj = __builtin_amdgcn_make_buffer_rsrc((void*)a_proj, 0, 0x7fffffff, 0x00020000), rs_lw = __builtin_amdgcn_make_buffer_rsrc((void*)a_lw, 0, 0x7fffffff, 0x00020000),
                                 rs_vf = __builtin_amdgcn_make_buffer_rsrc((void*)a_vf, 0, 0x7fffffff, 0x00020000), rs_bon = __builtin_amdgcn_make_buffer_rsrc((void*)a_bon, 0, 0x7fffffff, 0x00020000),
                                 rs_img = __builtin_amdgcn_make_buffer_rsrc((void*)img, 0, 0x7fffffff, 0x00020000);
    if (do_work) for (int u = vcu; u < M / 64; u += G) {
        const int b = u >> 5, tbase = (u & 31) * 64;
        for (int id = wave; id < 32; id += PW_NW) {
            int ln = tid0_ & 63; asm volatile("" : "+v"(ln));
            const int lane = ln, fr = lane & 15, fq = lane >> 4;
            const int h = id >> 1, t0 = tbase + 32 * (id & 1), c = h * 64 + lane;
            const float mix_r = a_mix[c], mix_k = a_mix[1024 + c], mix_v = a_mix[2048 + c];
            const float w0c = a_w0[c], a0c = a_a0[c], v0c = a_layer ? a_v0[c] : 0.f, kkc = a_kk[c], kac = a_ka[c], rkc = a_rk[c];
            unsigned char* ug = img + (size_t)((b * RW_H + h) * (SEQ / 32) + (t0 >> 5)) * IMG_UNIT;
            float cum = 0.f, er = 1.f;
            const bool hasv = a_layer != 0;
            unsigned prA[5], pkA[5], pvA[5], pwA[4], paA[4], pvpA[4], prB[5], pkB[5], pvB[5], pwB[4], paB[4], pvpB[4]; float pvfA[4], pvfB[4];
            const unsigned vo2 = (unsigned)lane * 2u, vo4 = (unsigned)lane * 4u, vo2d = (unsigned)(lane >> 1) * 4u; const bool odd_lane = (lane & 1) != 0;
            const unsigned so_proj = (unsigned)((b * SEQ + t0) * PROJ_BLD + h * 64) * 2u, so_tok = (unsigned)((b * SEQ + t0) * 1024 + h * 64);
            const unsigned so_img = (unsigned)((b * RW_H + h) * (SEQ / 32) + (t0 >> 5)) * (unsigned)IMG_UNIT + IMG_VI;
#define PRE_FETCH(tb_, X) do { \
            _Pragma("unroll") for (int i = 0; i < 4; ++i) { const unsigned t_ = (unsigned)((tb_) + i); \
                pr##X[i + 1] = __builtin_amdgcn_raw_buffer_load_b32(rs_proj, vo2d, so_proj + t_ * (PROJ_BLD * 2u) + OFF_R * 2u, 0); \
                pk##X[i + 1] = __builtin_amdgcn_raw_buffer_load_b32(rs_proj, vo2d, so_proj + t_ * (PROJ_BLD * 2u) + OFF_K * 2u, 0); \
                pv##X[i + 1] = __builtin_amdgcn_raw_buffer_load_b32(rs_proj, vo2d, so_proj + t_ * (PROJ_BLD * 2u) + OFF_V * 2u, 0); \
                pw##X[i] = __builtin_amdgcn_raw_buffer_load_b32(rs_lw, vo2d, (so_tok + t_ * 1024u) * 2u, 0); \
                pa##X[i] = __builtin_amdgcn_raw_buffer_load_b32(rs_lw, vo2d, (so_tok + t_ * 1024u) * 2u + (unsigned)M * 2048u, 0); \
                if (hasv) { pvp##X[i] = __builtin_amdgcn_raw_buffer_load_b32(rs_lw, vo2d, (so_tok + t_ * 1024u) * 2u + (unsigned)M * 6144u, 0); \
                            pvf##X[i] = __uint_as_float(__builtin_amdgcn_raw_buffer_load_b32(rs_vf, vo2d, (so_tok + t_ * 1024u) * 2u, 0)); }   \
                else { pvp##X[i] = 0u; pvf##X[i] = 0.f; } } } while (0)
#define BFSEL(x_) __uint_as_float(odd_lane ? ((x_) & 0xffff0000u) : ((x_) << 16))
#define PRE_TOK8(tb_, X) do { \
            _Pragma("unroll") for (int i = 0; i < 4; ++i) { const int tau = (tb_) + i; \
                const float rc = BFSEL(pr##X[i + 1]), rp = BFSEL(pr##X[i]), kc = BFSEL(pk##X[i + 1]), kp = BFSEL(pk##X[i]), \
                            vc = BFSEL(pv##X[i + 1]), vp = BFSEL(pv##X[i]); \
                const float r = rc + (rp - rc) * mix_r, kraw = kc + (kp - kc) * mix_k, vraw = vc + (vp - vc) * mix_v; \
                const float sg = fast_sigmoid(w0c + BFSEL(pw##X[i])); \
                const float ld = -1.4426950408889634f * 0.6065306597126334f * sg;       \
                const float as = fast_sigmoid(a0c + BFSEL(pa##X[i])); \
                float v = vraw; \
                if (hasv) v = vraw + (BFSEL(__float_as_uint(pvf##X[i])) - vraw) * fast_sigmoid(v0c + BFSEL(pvp##X[i])); \
                const float kkv = kraw * kkc; \
                const float km = kraw * (1.f + (as - 1.f) * kac); \
                const float z = reduce4(kkv * kkv, r * km * rkc, 0.f, 0.f); \
                const float nrm2 = rdlane(z, 0), rks = rdlane(z, 16); \
                const float kkn = kkv * __builtin_amdgcn_rsqf(fmaxf(nrm2, 1e-24f)); \
                const float er_prev = er;                                          \
                cum += ld; er = __builtin_amdgcn_exp2f(cum); \
                const float ei = __builtin_amdgcn_exp2f(-cum); \
                const float at = -kkn * er_prev, rt = r * er, bh = kkn * as * ei, kh = km * ei; \
                const unsigned w0 = cvt_pk_bf16(at, rt), w1 = cvt_pk_bf16(bh, kh), w2 = cvt_pk_bf16(v, rks * v); \
                AT[tau * P64 + lane] = (bf16_t)(w0 & 0xffffu); RT[tau * P64 + lane] = (bf16_t)(w0 >> 16); BH[tau * P64 + lane] = (bf16_t)(w1 & 0xffffu); KH[tau * P64 + lane] = (bf16_t)(w1 >> 16); \
                __builtin_amdgcn_raw_buffer_store_b16((unsigned short)(w2 & 0xffffu), rs_img, vo2, so_img + (unsigned)tau * 128u, 0);        \
                __builtin_amdgcn_raw_buffer_store_b16((unsigned short)(w2 >> 16), rs_bon, vo2, (so_tok + (unsigned)tau * 1024u) * 2u, 0); \
                if (!hasv) __builtin_amdgcn_raw_buffer_store_b16((unsigned short)(cvt_pk_bf16(vraw, 0.f) & 0xffffu), rs_vf, vo2, (so_tok + (unsigned)tau * 1024u) * 2u, 0); \
            } } while (0)
            PRE_FETCH(0, A);
            if (t0 > 0) { prA[0] = __builtin_amdgcn_raw_buffer_load_b32(rs_proj, vo2d, so_proj - PROJ_BLD * 2u + OFF_R * 2u, 0); pkA[0] = __builtin_amdgcn_raw_buffer_load_b32(rs_proj, vo2d, so_proj - PROJ_BLD * 2u + OFF_K * 2u, 0);
                          pvA[0] = __builtin_amdgcn_raw_buffer_load_b32(rs_proj, vo2d, so_proj - PROJ_BLD * 2u + OFF_V * 2u, 0); }
            else { prA[0] = 0u; pkA[0] = 0u; pvA[0] = 0u; }
            for (int gg = 0; gg < 4; ++gg) {
                PRE_FETCH(8 * gg + 4, B);
                prB[0] = prA[4]; pkB[0] = pkA[4]; pvB[0] = pvA[4];
                PRE_TOK8(8 * gg, A);
                if (gg < 3) PRE_FETCH(8 * gg + 8, A);
                prA[0] = prB[4]; pkA[0] = pkB[4]; pvA[0] = pvB[4];
                PRE_TOK8(8 * gg + 4, B);
            }
#undef PRE_FETCH
#undef PRE_TOK8
#undef BFSEL
            *(float*)(ug + IMG_PL + lane * 4) = er;
            asm volatile("s_waitcnt lgkmcnt(0)" ::: "memory");
#pragma unroll
            for (int arr = 1; arr < 3; ++arr) {
                const LAS bf16_t* X = (arr == 1) ? BH : KH;
                unsigned pkd[16];
#pragma unroll
                for (int k = 0; k < 16; ++k) pkd[k] = (unsigned)X[(2 * k) * P64 + lane] | ((unsigned)X[(2 * k + 1) * P64 + lane] << 16);
                unsigned char* dst = ug + ((arr == 1) ? IMG_BH : IMG_KH) + lane * 64;
#pragma unroll
                for (int q = 0; q < 4; ++q) *(u32x4*)(dst + q * 16) = (u32x4){pkd[4 * q], pkd[4 * q + 1], pkd[4 * q + 2], pkd[4 * q + 3]};
            }
            asm volatile("s_waitcnt lgkmcnt(0)" ::: "memory");
#ifndef MK_X_NOGRAM
            {
                bf16x8 fB[2][2], fK[2][2], fA[2][2], fR[2][2];
#pragma unroll
                for (int m = 0; m < 2; ++m)
#pragma unroll
                    for (int ks = 0; ks < 2; ++ks) { fB[m][ks] = ldfrag(BH, P64, 16 * m + fr, 32 * ks + 8 * fq); fK[m][ks] = ldfrag(KH, P64, 16 * m + fr, 32 * ks + 8 * fq);
                                                     fA[m][ks] = ldfrag(AT, P64, 16 * m + fr, 32 * ks + 8 * fq); fR[m][ks] = ldfrag(RT, P64, 16 * m + fr, 32 * ks + 8 * fq); }
                asm volatile("s_waitcnt lgkmcnt(0)" ::: "memory");
#pragma unroll
                for (int mat = 0; mat < 4; ++mat)
#pragma unroll
                    for (int mt = 0; mt < 2; ++mt)
#pragma unroll
                        for (int nt = 0; nt < 2; ++nt) {
                            f32x4 g = ZERO4();
                            if (!(mt == 1 && nt == 0)) {
#pragma unroll
                                for (int ks = 0; ks < 2; ++ks) g = __builtin_amdgcn_mfma_f32_16x16x32_bf16((mat & 1) ? fK[mt][ks] : fB[mt][ks], (mat & 2) ? fR[nt][ks] : fA[nt][ks], g, 0, 0, 0);
                            }
                            const int t = 16 * nt + fr, s0 = 16 * mt + 4 * fq;
                            if (mt == nt) {
#pragma unroll
                                for (int r = 0; r < 4; ++r) { const int s = s0 + r; const bool keep = (mat < 2) ? (s < t) : (s <= t); g[r] = keep ? g[r] : 0.f; }
                            }
                            if (mat == 0) *(LAS f32x4*)(NabT + t * 36 + s0) = g;
                            else { u32x2 w; w.x = cvt_pk_bf16(g[0], g[1]); w.y = cvt_pk_bf16(g[2], g[3]); *(u32x2*)(ug + IMG_NAK + (mat - 1) * 2048 + (t * 32 + s0) * 2) = w; }
                        }
            }
#endif
            asm volatile("s_waitcnt lgkmcnt(0)" ::: "memory");
#ifndef MK_X_NOSOLVE
            {
                float Tr[32];
                f32x4 rowb[2][8];
#pragma unroll
                for (int t = 0; t < 32; ++t) {
                    if (t + 1 < 32) {
#pragma unroll
                        for (int q = 0; q < 8; ++q) if (4 * q < t + 1) rowb[(t + 1) & 1][q] = *(const LAS f32x4*)(NabT + (t + 1) * 36 + 4 * q);
                    }
                    float acc4[4] = {(ln == t) ? 1.f : 0.f, 0.f, 0.f, 0.f};
#pragma unroll
                    for (int q = 0; q < 8; ++q)
#pragma unroll
                        for (int e = 0; e < 4; ++e) if (4 * q + e < t) acc4[e] += Tr[4 * q + e] * rowb[t & 1][q][e];
                    const float acc = (acc4[0] + acc4[1]) + (acc4[2] + acc4[3]);
                    Tr[t] = acc;
                    if (ln < 32) *(bf16_t*)(ug + IMG_TT + (t * 32 + ln) * 2) = (bf16_t)(cvt_pk_bf16(acc, 0.f) & 0xffffu);
                }
            }
#endif
            {
                const int row = lane >> 1, hf = lane & 1;
#pragma unroll
                for (int q = 0; q < 4; ++q) {
                    *(u32x4*)(ug + IMG_AT + row * 128 + hf * 64 + q * 16) = *(const LAS u32x4*)(AT + row * P64 + hf * 32 + 8 * q);
                    *(u32x4*)(ug + IMG_RT + row * 128 + hf * 64 + q * 16) = *(const LAS u32x4*)(RT + row * P64 + hf * 32 + 8 * q);
                }
            }
            asm volatile("s_waitcnt lgkmcnt(0)" ::: "memory");
        }
    }
}

constexpr int SK_AT = 0, SK_RT = 4608, SK_S0 = 9216, SK_NAK = 13824, SK_MBR = 16384, SK_MKR = 18944, SK_TT = 21504, SK_VI = 24064, SK_WI = 26624, SK_UI = 29184, SK_BH = 31744, SK_KH = 36864, SK_PL = 41984, SK_END = 42240, SK_BUF = SK_END;
static_assert(2 * SK_BUF <= MISC_OFF, "rwkv state phase LDS map");
__device__ __forceinline__ void rwkv_state_phase(LAS unsigned char* lds, const unsigned char* img, bf16_t* y_, const RwScan& a_, const int vcu, const int G, const int tid0_) {
    const int wave = __builtin_amdgcn_readfirstlane(tid0_ >> 6);
    const float* const a_cw1 = a_.cw1; const float* const a_cw3 = a_.cw3; const float* const a_cw2 = a_.cw2; bf16_t* const a_cwt = a_.cwt; const int a_cmoe = a_.cmoe;
    const int cv_total = a_cmoe ? NE * 3 * 2816 : 3 * 5632, cv_stride = G * 4, cv_cut = a_cmoe ? MK_CV_CUT_MOE : MK_CV_CUT_DENSE;
#define CV_DECODE(it_) int e_, j_, k0_, n0_; if (a_cmoe) cv_decode<true>((it_), e_, j_, k0_, n0_); else cv_decode<false>((it_), e_, j_, k0_, n0_); \
        const int dfe_ = a_cmoe ? DFE : DFF, K_ = (j_ == 2) ? dfe_ : D, N_ = (j_ == 2) ? D : dfe_; \
        const float* W_ = (j_ == 0 ? a_cw1 : (j_ == 1 ? a_cw3 : a_cw2)) + (size_t)e_ * D * dfe_;
#define CV_LOAD(cvv, cv_it, cv_pend) do { if (cv_it < cv_total) { CV_DECODE(cv_it) const int cl_ = tid0_ & 63; \
            const float* src_ = W_ + (size_t)(k0_ + 32 * (cl_ >> 5)) * N_ + n0_ + (cl_ & 31); \
            _Pragma("unroll") for (int i = 0; i < 32; ++i) cvv[i] = src_[(size_t)i * N_]; cv_pend = true; } } while (0)
#define CV_STORE(cvv, cv_it, cv_pend) do { if (cv_pend) { CV_DECODE(cv_it) (void)W_; const int cl_ = tid0_ & 63; \
            const int drow_ = (j_ == 2) ? (a_cmoe ? e_ * D + n0_ : n0_) : (a_cmoe ? e_ * 2 * DFE : 0) + 256 * (n0_ / 128) + j_ * 128 + (n0_ % 128); \
            bf16_t* WT_ = a_cwt + ((j_ == 2) ? (size_t)(a_cmoe ? NE * 2 * DFE : 2 * DFF) * D : (size_t)0) + (size_t)(drow_ + (cl_ & 31)) * K_ + k0_ + 32 * (cl_ >> 5); \
            _Pragma("unroll") for (int q = 0; q < 4; ++q) { u32x4 o; o.x = cvt_pk_bf16(cvv[8 * q], cvv[8 * q + 1]); o.y = cvt_pk_bf16(cvv[8 * q + 2], cvv[8 * q + 3]); o.z = cvt_pk_bf16(cvv[8 * q + 4], cvv[8 * q + 5]); o.w = cvt_pk_bf16(cvv[8 * q + 6], cvv[8 * q + 7]); \
                *(u32x4*)(WT_ + 8 * q) = o; } \
            cv_pend = false; cv_it += cv_stride; } } while (0)
    LAS bf16_t* Wi = (LAS bf16_t*)(lds + SK_WI); LAS bf16_t* Ui = (LAS bf16_t*)(lds + SK_UI);
    for (int u = vcu; u < BATCH * RW_H * 2; u += G) {
        const int b = u >> 5, h = (u >> 1) & 15, half = u & 1;
        const unsigned char* ub = img + (size_t)((b * RW_H + h) * (SEQ / 32)) * IMG_UNIT;
        f32x4 Sacc = ZERO4();
        u32x4 q0a, q0b, q1a, q1b, q2a, q2b, q3;
        int cv_itA = cv_cut + vcu * 4 + (wave & 3); bool cv_pendA = false; float cvA[32];
#pragma unroll
        for (int i = 0; i < 32; ++i) cvA[i] = 0.f;
#define ST_FETCH(ch_) do { if (wave < 4) { const unsigned char* ug_ = ub + (size_t)(ch_) * IMG_UNIT; const int tf_ = tid0_; \
            q0a = *(const u32x4*)(ug_ + IMG_AT + tf_ * 16); q0b = *(const u32x4*)(ug_ + IMG_RT + tf_ * 16); q1a = *(const u32x4*)(ug_ + IMG_NAK + tf_ * 16); q1b = *(const u32x4*)(ug_ + IMG_MKR + tf_ * 16); \
            q2a = *(const u32x4*)(ug_ + IMG_BH + tf_ * 16); q2b = *(const u32x4*)(ug_ + IMG_KH + tf_ * 16); \
            if (tf_ < 128) q3 = *(const u32x4*)(ug_ + IMG_VI + (tf_ >> 2) * 128 + half * 64 + (tf_ & 3) * 16); else if (tf_ < 144) q3 = *(const u32x4*)(ug_ + IMG_PL + (tf_ - 128) * 16); } } while (0)
        q0a = q0b = q1a = q1b = q2a = q2b = q3 = (u32x4){0u, 0u, 0u, 0u};
        ST_FETCH(0);
        for (int ch = 0; ch < SEQ / 32; ++ch) {
            const int t0 = ch * 32;
            int tid_c = tid0_; asm volatile("" : "+v"(tid_c));
            const int tid = tid_c, lane = tid & 63, fr = lane & 15, fq = lane >> 4;
            LAS unsigned char* lb = lds + (ch & 1) * SK_BUF;
            LAS bf16_t* AT = (LAS bf16_t*)(lb + SK_AT); LAS bf16_t* RT = (LAS bf16_t*)(lb + SK_RT); LAS bf16_t* S0 = (LAS bf16_t*)(lb + SK_S0);
            LAS bf16_t* NakT = (LAS bf16_t*)(lb + SK_NAK); LAS bf16_t* MbrT = (LAS bf16_t*)(lb + SK_MBR); LAS bf16_t* MkrT = (LAS bf16_t*)(lb + SK_MKR); LAS bf16_t* TT = (LAS bf16_t*)(lb + SK_TT);
            LAS bf16_t* Vi = (LAS bf16_t*)(lb + SK_VI); LAS bf16_t* BhT = (LAS bf16_t*)(lb + SK_BH); LAS bf16_t* KhT = (LAS bf16_t*)(lb + SK_KH); LAS float* PL = (LAS float*)(lb + SK_PL);
            if (wave < 4) {
                { const int o_ = (tid >> 3) * 144 + (tid & 7) * 16; *(LAS u32x4*)(lb + SK_AT + o_) = q0a; *(LAS u32x4*)(lb + SK_RT + o_) = q0b; }
                { const int idx = tid & 127, o_ = (tid >> 7) * 2560 + (idx >> 2) * 80 + (idx & 3) * 16; *(LAS u32x4*)(lb + SK_NAK + o_) = q1a; *(LAS u32x4*)(lb + SK_MKR + o_) = q1b; }
                { const int o_ = (tid >> 2) * 80 + (tid & 3) * 16; *(LAS u32x4*)(lb + SK_BH + o_) = q2a; *(LAS u32x4*)(lb + SK_KH + o_) = q2b; }
                if (tid < 128) { const int t_ = tid >> 2, i0_ = 8 * (tid & 3); const unsigned wv_[4] = {q3.x, q3.y, q3.z, q3.w};
#pragma unroll
                    for (int e = 0; e < 4; ++e) { Vi[(i0_ + 2 * e) * P32 + t_] = (bf16_t)(wv_[e] & 0xffffu); Vi[(i0_ + 2 * e + 1) * P32 + t_] = (bf16_t)(wv_[e] >> 16); } }
                else if (tid < 144) *(LAS u32x4*)(lb + SK_PL + (tid - 128) * 16) = q3;
            }
            { const int mt = wave >> 1, nt = wave & 1; u32x2 o; o.x = cvt_pk_bf16(Sacc[0], Sacc[1]); o.y = cvt_pk_bf16(Sacc[2], Sacc[3]);
              *(LAS u32x2*)(S0 + (16 * nt + fr) * P64 + 16 * mt + 4 * fq) = o; }
            __syncthreads();
            if (ch + 1 < SEQ / 32) ST_FETCH(ch + 1);
            if (wave >= 4) {
                const int mt = (wave - 4) >> 1, nt = (wave - 4) & 1;
                f32x4 w = ZERO4();
#pragma unroll
                for (int ks = 0; ks < 2; ++ks) w = __builtin_amdgcn_mfma_f32_16x16x32_bf16(ldfrag(AT, P64, 16 * mt + fr, 32 * ks + 8 * fq), ldfrag(S0, P64, 16 * nt + fr, 32 * ks + 8 * fq), w, 0, 0, 0);
                w = __builtin_amdgcn_mfma_f32_16x16x32_bf16(ldfrag(NakT, P32, 16 * mt + fr, 8 * fq), ldfrag(Vi, P32, 16 * nt + fr, 8 * fq), w, 0, 0, 0);
                u32x2 o; o.x = cvt_pk_bf16(w[0], w[1]); o.y = cvt_pk_bf16(w[2], w[3]); *(LAS u32x2*)(Wi + (16 * nt + fr) * P32 + 16 * mt + 4 * fq) = o;
            }
            __syncthreads();
            if (wave < 4) {
                const int mt = wave >> 1, nt = wave & 1;
                f32x4 uu = ZERO4();
                uu = __builtin_amdgcn_mfma_f32_16x16x32_bf16(ldfrag(TT, P32, 16 * mt + fr, 8 * fq), ldfrag(Wi, P32, 16 * nt + fr, 8 * fq), uu, 0, 0, 0);
                u32x2 o; o.x = cvt_pk_bf16(uu[0], uu[1]); o.y = cvt_pk_bf16(uu[2], uu[3]); *(LAS u32x2*)(Ui + (16 * nt + fr) * P32 + 16 * mt + 4 * fq) = o;
            }
            if (wave >= 4) { CV_STORE(cvA, cv_itA, cv_pendA); CV_LOAD(cvA, cv_itA, cv_pendA); }
            __syncthreads();
            if (wave < 4) {
                const int mt = wave >> 1, nt = wave & 1;
                f32x4 y = ZERO4();
#pragma unroll
                for (int ks = 0; ks < 2; ++ks) y = __builtin_amdgcn_mfma_f32_16x16x32_bf16(ldfrag(S0, P64, 16 * mt + fr, 32 * ks + 8 * fq), ldfrag(RT, P64, 16 * nt + fr, 32 * ks + 8 * fq), y, 0, 0, 0);
                y = __builtin_amdgcn_mfma_f32_16x16x32_bf16(ldfrag(Ui, P32, 16 * mt + fr, 8 * fq), ldfrag(MbrT, P32, 16 * nt + fr, 8 * fq), y, 0, 0, 0);
                y = __builtin_amdgcn_mfma_f32_16x16x32_bf16(ldfrag(Vi, P32, 16 * mt + fr, 8 * fq), ldfrag(MkrT, P32, 16 * nt + fr, 8 * fq), y, 0, 0, 0);
                u32x2 o; o.x = cvt_pk_bf16(y[0], y[1]); o.y = cvt_pk_bf16(y[2], y[3]);
                *(u32x2*)(y_ + (size_t)(b * SEQ + t0 + 16 * nt + fr) * 1024 + h * 64 + half * 32 + 16 * mt + 4 * fq) = o;
            }
            {
                const int mt = wave >> 1, nt = wave & 1;
                const f32x4 pl = *(const LAS f32x4*)(PL + 16 * mt + 4 * fq);
                Sacc = __builtin_amdgcn_mfma_f32_16x16x32_bf16(ldfrag(BhT, P32, 16 * mt + fr, 8 * fq), ldfrag(Ui, P32, 16 * nt + fr, 8 * fq), Sacc, 0, 0, 0);
                Sacc = __builtin_amdgcn_mfma_f32_16x16x32_bf16(ldfrag(KhT, P32, 16 * mt + fr, 8 * fq), ldfrag(Vi, P32, 16 * nt + fr, 8 * fq), Sacc, 0, 0, 0);
                Sacc = Sacc * pl;
            }
        }
        if (wave >= 4) { do { CV_STORE(cvA, cv_itA, cv_pendA); CV_LOAD(cvA, cv_itA, cv_pendA); } while (cv_pendA); }
        __syncthreads();
#undef CV_DECODE
#undef CV_LOAD
#undef CV_STORE
#undef ST_FETCH
    }
}

__device__ __forceinline__ void ld_bf16x16(const bf16_t* p, f32x4 (&o)[4]) { const u32x4 a = *(const u32x4*)p, b = *(const u32x4*)(p + 8);
    o[0] = (f32x4){bf_lo(a.x), bf_hi(a.x), bf_lo(a.y), bf_hi(a.y)}; o[1] = (f32x4){bf_lo(a.z), bf_hi(a.z), bf_lo(a.w), bf_hi(a.w)};
    o[2] = (f32x4){bf_lo(b.x), bf_hi(b.x), bf_lo(b.y), bf_hi(b.y)}; o[3] = (f32x4){bf_lo(b.z), bf_hi(b.z), bf_lo(b.w), bf_hi(b.w)}; }
__device__ __forceinline__ void rwkv_post_phase(const bf16_t* __restrict__ yrw, const bf16_t* __restrict__ bon, const bf16_t* __restrict__ lw_g, const float* __restrict__ ln_w, const float* __restrict__ ln_b, bf16_t* __restrict__ ymixb, const int gw, const int NGW, const int lane) {
    const int c0 = 16 * lane;
    f32x4 lw4[4], lb4[4];
#pragma unroll
    for (int j = 0; j < 4; ++j) { lw4[j] = *(const f32x4*)(ln_w + c0 + 4 * j); lb4[j] = *(const f32x4*)(ln_b + c0 + 4 * j); }
#pragma unroll 2
    for (int m = gw; m < M; m += NGW) {
        f32x4 y[4], bo[4];
        ld_bf16x16(yrw + (size_t)m * 1024 + c0, y); ld_bf16x16(bon + (size_t)m * 1024 + c0, bo);
        const u32x4 g0 = *(const u32x4*)(lw_g + (size_t)m * 1024 + c0), g1 = *(const u32x4*)(lw_g + (size_t)m * 1024 + c0 + 8);
        float s = 0.f;
#pragma unroll
        for (int j = 0; j < 4; ++j) s += (y[j][0] + y[j][1]) + (y[j][2] + y[j][3]);
        s += __shfl_xor(s, 1); s += __shfl_xor(s, 2);
        const float mu = s * (1.f / 64.f);
        float q = 0.f;
#pragma unroll
        for (int j = 0; j < 4; ++j) { y[j] = y[j] - mu; q += (y[j][0] * y[j][0] + y[j][1] * y[j][1]) + (y[j][2] * y[j][2] + y[j][3] * y[j][3]); }
        q += __shfl_xor(q, 1); q += __shfl_xor(q, 2);
        const float rstd = rsqrtf(q * (1.f / 64.f) + 64e-5f);
        float o[16];
#pragma unroll
        for (int j = 0; j < 4; ++j) { const f32x4 t = y[j] * rstd * lw4[j] + lb4[j] + bo[j]; o[4 * j] = t[0]; o[4 * j + 1] = t[1]; o[4 * j + 2] = t[2]; o[4 * j + 3] = t[3]; }
        const unsigned gw_[8] = {g0.x, g0.y, g0.z, g0.w, g1.x, g1.y, g1.z, g1.w};
        u32x4 w0, w1;
        w0.x = cvt_pk_bf16(o[0] * bf_lo(gw_[0]), o[1] * bf_hi(gw_[0])); w0.y = cvt_pk_bf16(o[2] * bf_lo(gw_[1]), o[3] * bf_hi(gw_[1]));
        w0.z = cvt_pk_bf16(o[4] * bf_lo(gw_[2]), o[5] * bf_hi(gw_[2])); w0.w = cvt_pk_bf16(o[6] * bf_lo(gw_[3]), o[7] * bf_hi(gw_[3]));
        w1.x = cvt_pk_bf16(o[8] * bf_lo(gw_[4]), o[9] * bf_hi(gw_[4])); w1.y = cvt_pk_bf16(o[10] * bf_lo(gw_[5]), o[11] * bf_hi(gw_[5]));
        w1.z = cvt_pk_bf16(o[12] * bf_lo(gw_[6]), o[13] * bf_hi(gw_[6])); w1.w = cvt_pk_bf16(o[14] * bf_lo(gw_[7]), o[15] * bf_hi(gw_[7]));
        *(u32x4*)(ymixb + (size_t)m * 2048 + 1024 + c0) = w0; *(u32x4*)(ymixb + (size_t)m * 2048 + 1024 + c0 + 8) = w1;
    }
}

__device__ __forceinline__ void ssd_conv_phase(const bf16_t* projb, const float* cw, const float* cb, const float* dt_bias, bf16_t* xbcc, float* dtb, const int vcu, const int G, const int tid) {
    for (int u = vcu; u < M / 64; u += G) {
        if (tid < 384) {
            const int cg = tid % 192, hf = tid / 192, c0 = 8 * cg, m0 = u * 64 + 32 * hf, t_in_seq = m0 % SEQ;
            float w[4][8], bias[8];
#pragma unroll
            for (int q = 0; q < 4; ++q) { const f32x4 a = *(const f32x4*)(cw + q * CONV_DIM + c0), b = *(const f32x4*)(cw + q * CONV_DIM + c0 + 4);
                w[q][0] = a[0]; w[q][1] = a[1]; w[q][2] = a[2]; w[q][3] = a[3]; w[q][4] = b[0]; w[q][5] = b[1]; w[q][6] = b[2]; w[q][7] = b[3]; }
            { const f32x4 a = *(const f32x4*)(cb + c0), b = *(const f32x4*)(cb + c0 + 4); bias[0] = a[0]; bias[1] = a[1]; bias[2] = a[2]; bias[3] = a[3]; bias[4] = b[0]; bias[5] = b[1]; bias[6] = b[2]; bias[7] = b[3]; }
            float win[3][8];
#pragma unroll
            for (int q = 0; q < 3; ++q) {
                u32x4 r = (u32x4){0u, 0u, 0u, 0u};
                if (t_in_seq - 3 + q >= 0) r = *(const u32x4*)(projb + (size_t)(m0 - 3 + q) * PROJ_BLD + OFF_XBC + c0);
                win[q][0] = bf_lo(r.x); win[q][1] = bf_hi(r.x); win[q][2] = bf_lo(r.y); win[q][3] = bf_hi(r.y); win[q][4] = bf_lo(r.z); win[q][5] = bf_hi(r.z); win[q][6] = bf_lo(r.w); win[q][7] = bf_hi(r.w);
            }
            for (int i0 = 0; i0 < 32; i0 += 8) {
                u32x4 rr[8];
#pragma unroll
                for (int q = 0; q < 8; ++q) rr[q] = *(const u32x4*)(projb + (size_t)(m0 + i0 + q) * PROJ_BLD + OFF_XBC + c0);
#pragma unroll
                for (int q = 0; q < 8; ++q) {
                    const u32x4 r = rr[q];
                    float cur[8] = {bf_lo(r.x), bf_hi(r.x), bf_lo(r.y), bf_hi(r.y), bf_lo(r.z), bf_hi(r.z), bf_lo(r.w), bf_hi(r.w)};
                    float o[8];
#pragma unroll
                    for (int e = 0; e < 8; ++e) { const float acc = bias[e] + w[0][e] * win[0][e] + w[1][e] * win[1][e] + w[2][e] * win[2][e] + w[3][e] * cur[e]; o[e] = fast_silu(acc);
                        win[0][e] = win[1][e]; win[1][e] = win[2][e]; win[2][e] = cur[e]; }
                    u32x4 wv; wv.x = cvt_pk_bf16(o[0], o[1]); wv.y = cvt_pk_bf16(o[2], o[3]); wv.z = cvt_pk_bf16(o[4], o[5]); wv.w = cvt_pk_bf16(o[6], o[7]);
                    *(u32x4*)(xbcc + (size_t)(m0 + i0 + q) * CONV_DIM + c0) = wv;
                }
            }
        }
#pragma unroll
        for (int q = 0; q < 2; ++q) { const int idx = tid + 512 * q, m = u * 64 + (idx >> 4), h = idx & 15;
            const float x = bf2f(projb[(size_t)m * PROJ_BLD + OFF_DT + h]) + dt_bias[h];
            dtb[(size_t)m * SSD_H + h] = fmaxf(x, 0.f) + log1pf(expf(-fabsf(x))); }
    }
}

constexpr int SP = 136;
constexpr int SS_C = 0, SS_B = 34816, SS_BT = 69632, SS_XT = 104448, SS_XW = 113152, SS_HT = 121856, SS_AC = 130560, SS_DT = 131072, SS_END = 131584;
__device__ __forceinline__ void ssd_scan_phase(LAS unsigned char* lds, const bf16_t* xbcc, const float* dtb, const float* a_log, const float* dskip, bf16_t* yssd, const int vcu, const int G, const int tid) {
    const int wave = __builtin_amdgcn_readfirstlane(tid >> 6), lane = tid & 63, fr = lane & 15, fq = lane >> 4;
    const int lt = (wave < 4) ? 2 * wave : 15 - 2 * wave;
    LAS bf16_t* Cimg = (LAS bf16_t*)(lds + SS_C); LAS bf16_t* Bimg = (LAS bf16_t*)(lds + SS_B); LAS bf16_t* BTimg = (LAS bf16_t*)(lds + SS_BT);
    LAS bf16_t* xT = (LAS bf16_t*)(lds + SS_XT); LAS bf16_t* xwT = (LAS bf16_t*)(lds + SS_XW); LAS bf16_t* hT = (LAS bf16_t*)(lds + SS_HT);
    LAS float* acum = (LAS float*)(lds + SS_AC); LAS float* dtv = (LAS float*)(lds + SS_DT);
    for (int u = vcu; u < BATCH * SSD_H * 2; u += G) {
        const int b = u >> 5, h = (u >> 1) & 15, phalf = u & 1, g = h >> 3;
        const float Ah = -expf(a_log[h]) * 1.4426950408889634f;
        const float dsk = dskip[h];
        f32x4 hs[2] = {(f32x4){0.f, 0.f, 0.f, 0.f}, (f32x4){0.f, 0.f, 0.f, 0.f}};
        for (int i = tid; i < 32 * SP / 2; i += 512) ((LAS unsigned*)hT)[i] = 0u;
        const int row = tid >> 2, part = tid & 3;
        u32x4 cvn[4], bvn[4], xrn; float dtn = 0.f, dtn1 = 0.f;
#define SS_FETCH(ch_) do { const bf16_t* src_ = xbcc + (size_t)(b * SEQ + (ch_) * 128 + row) * CONV_DIM; \
        _Pragma("unroll") for (int j = 0; j < 4; ++j) { cvn[j] = *(const u32x4*)(src_ + 1280 + g * 128 + 32 * part + 8 * j); bvn[j] = *(const u32x4*)(src_ + 1024 + g * 128 + 32 * part + 8 * j); } \
        xrn = *(const u32x4*)(src_ + h * 64 + phalf * 32 + 8 * part); \
        if (tid < 64) { const float* dp_ = dtb + (size_t)(b * SEQ + (ch_) * 128 + 2 * tid) * SSD_H + h; dtn = dp_[0]; dtn1 = dp_[SSD_H]; } } while (0)
        SS_FETCH(0);
        for (int ch = 0; ch < SEQ / 128; ++ch) {
            const int mrow0 = b * SEQ + ch * 128;
            u32x4 xr;
            {
                u32x4 cv[4], bv[4];
#pragma unroll
                for (int j = 0; j < 4; ++j) { cv[j] = cvn[j]; bv[j] = bvn[j]; }
                xr = xrn;
                if (wave == 0) {
                    const float d0 = dtn, d1 = dtn1;
                    *(LAS f32x2*)(dtv + 2 * lane) = (f32x2){d0, d1};
                    const float v0 = d0 * Ah, v1 = d1 * Ah;
                    float s = v0 + v1;
#define SS_DPPF(x_, ctrl_, rm_, bc_) __int_as_float(__builtin_amdgcn_update_dpp(0, __float_as_int(x_), (ctrl_), (rm_), 0xF, (bc_)))
                    s += SS_DPPF(s, 0x111, 0xF, true); asm("" : "+v"(s));
                    s += SS_DPPF(s, 0x112, 0xF, true); asm("" : "+v"(s));
                    s += SS_DPPF(s, 0x114, 0xF, true); asm("" : "+v"(s));
                    s += SS_DPPF(s, 0x118, 0xF, true); asm("" : "+v"(s));
                    s += SS_DPPF(s, 0x142, 0xA, false); asm("" : "+v"(s));
                    s += SS_DPPF(s, 0x143, 0xC, false); asm("" : "+v"(s));
#undef SS_DPPF
                    *(LAS f32x2*)(acum + 2 * lane) = (f32x2){s - v1, s};
                }
                if (ch + 1 < SEQ / 128) SS_FETCH(ch + 1);
#pragma unroll
                for (int j = 0; j < 4; ++j) { *(LAS u32x4*)(Cimg + row * SP + 32 * part + 8 * j) = cv[j]; *(LAS u32x4*)(Bimg + row * SP + 32 * part + 8 * j) = bv[j]; }
#pragma unroll
                for (int j = 0; j < 4; ++j) { const unsigned wv[4] = {bv[j].x, bv[j].y, bv[j].z, bv[j].w};
#pragma unroll
                    for (int e = 0; e < 4; ++e) { const int n = 32 * part + 8 * j + 2 * e; BTimg[n * SP + row] = (bf16_t)(wv[e] & 0xffffu); BTimg[(n + 1) * SP + row] = (bf16_t)(wv[e] >> 16); } }
            }
            __syncthreads();
            const float atot = acum[127];
            {
                const float wgt = dtv[row] * __builtin_amdgcn_exp2f(atot - acum[row]);
                const unsigned wv[4] = {xr.x, xr.y, xr.z, xr.w};
#pragma unroll
                for (int e = 0; e < 4; ++e) { const int p = 8 * part + 2 * e; const float x0 = bf_lo(wv[e]), x1 = bf_hi(wv[e]);
                    xT[p * SP + row] = (bf16_t)(wv[e] & 0xffffu); xT[(p + 1) * SP + row] = (bf16_t)(wv[e] >> 16);
                    const unsigned pk = cvt_pk_bf16(x0 * wgt, x1 * wgt); xwT[p * SP + row] = (bf16_t)(pk & 0xffffu); xwT[(p + 1) * SP + row] = (bf16_t)(pk >> 16); }
            }
            f32x4 gacc[8];
#pragma unroll
            for (int st = 0; st < 8; ++st) gacc[st] = (f32x4){0.f, 0.f, 0.f, 0.f};
            {
                bf16x8 cf[4];
#pragma unroll
                for (int ks = 0; ks < 4; ++ks) cf[ks] = *(const LAS bf16x8*)(Cimg + (16 * lt + fr) * SP + 32 * ks + 8 * fq);
#pragma unroll
                for (int st = 0; st < 8; ++st) if (st <= lt) {
#pragma unroll
                    for (int ks = 0; ks < 4; ++ks) { const bf16x8 bfg = *(const LAS bf16x8*)(Bimg + (16 * st + fr) * SP + 32 * ks + 8 * fq);
                        gacc[st] = __builtin_amdgcn_mfma_f32_16x16x32_bf16(bfg, cf[ks], gacc[st], 0, 0, 0); }
                }
            }
            __syncthreads();
            {
                LAS bf16_t* Mimg = Bimg;
                const int l = 16 * lt + fr; const float al = acum[l];
#pragma unroll
                for (int st = 0; st < 8; ++st) if (st <= lt + 1) {
                    u32x2 wv = (u32x2){0u, 0u};
                    if (st <= lt) {
                        const f32x4 as4 = *(const LAS f32x4*)(acum + 16 * st + 4 * fq), dt4 = *(const LAS f32x4*)(dtv + 16 * st + 4 * fq);
                        float mv[4];
#pragma unroll
                        for (int r = 0; r < 4; ++r) { const int s = 16 * st + 4 * fq + r; mv[r] = (s <= l) ? gacc[st][r] * dt4[r] * __builtin_amdgcn_exp2f(al - as4[r]) : 0.f; }
                        wv.x = cvt_pk_bf16(mv[0], mv[1]); wv.y = cvt_pk_bf16(mv[2], mv[3]);
                    }
                    *(LAS u32x2*)(Mimg + l * SP + 16 * st + 4 * fq) = wv;
                }
            }
            __syncthreads();
            {
                const LAS bf16_t* Mimg = Bimg;
                f32x4 yd[2] = {(f32x4){0.f, 0.f, 0.f, 0.f}, (f32x4){0.f, 0.f, 0.f, 0.f}}, yo[2] = {(f32x4){0.f, 0.f, 0.f, 0.f}, (f32x4){0.f, 0.f, 0.f, 0.f}};
#pragma unroll
                for (int ks = 0; ks < 4; ++ks) {
                    const bf16x8 cfr = *(const LAS bf16x8*)(Cimg + (16 * lt + fr) * SP + 32 * ks + 8 * fq);
#pragma unroll
                    for (int pt = 0; pt < 2; ++pt) { const bf16x8 hf = *(const LAS bf16x8*)(hT + (16 * pt + fr) * SP + 32 * ks + 8 * fq);
                        yo[pt] = __builtin_amdgcn_mfma_f32_16x16x32_bf16(hf, cfr, yo[pt], 0, 0, 0); }
                    if (2 * ks <= lt) {
                        const bf16x8 mf = *(const LAS bf16x8*)(Mimg + (16 * lt + fr) * SP + 32 * ks + 8 * fq);
#pragma unroll
                        for (int pt = 0; pt < 2; ++pt) { const bf16x8 xf_ = *(const LAS bf16x8*)(xT + (16 * pt + fr) * SP + 32 * ks + 8 * fq);
                            yd[pt] = __builtin_amdgcn_mfma_f32_16x16x32_bf16(xf_, mf, yd[pt], 0, 0, 0); }
                    }
                }
                const int l = 16 * lt + fr; const float el = __builtin_amdgcn_exp2f(acum[l]);
#pragma unroll
                for (int pt = 0; pt < 2; ++pt) {
                    f32x4 o;
#pragma unroll
                    for (int r = 0; r < 4; ++r) o[r] = yd[pt][r] + el * yo[pt][r] + dsk * bf2f(xT[(16 * pt + 4 * fq + r) * SP + l]);
                    { u32x2 w2; w2.x = cvt_pk_bf16(o[0], o[1]); w2.y = cvt_pk_bf16(o[2], o[3]); *(u32x2*)(yssd + (size_t)(mrow0 + l) * 1024 + h * 64 + phalf * 32 + 16 * pt + 4 * fq) = w2; }
                }
            }
            {
                const float ea = __builtin_amdgcn_exp2f(atot);
                hs[0] = hs[0] * ea; hs[1] = hs[1] * ea;
#pragma unroll
                for (int ks = 0; ks < 4; ++ks) {
                    const bf16x8 btf = *(const LAS bf16x8*)(BTimg + (16 * wave + fr) * SP + 32 * ks + 8 * fq);
#pragma unroll
                    for (int pt = 0; pt < 2; ++pt) { const bf16x8 xwf = *(const LAS bf16x8*)(xwT + (16 * pt + fr) * SP + 32 * ks + 8 * fq);
                        hs[pt] = __builtin_amdgcn_mfma_f32_16x16x32_bf16(btf, xwf, hs[pt], 0, 0, 0); }
                }
            }
            __syncthreads();
#pragma unroll
            for (int pt = 0; pt < 2; ++pt) { u32x2 wv; wv.x = cvt_pk_bf16(hs[pt][0], hs[pt][1]); wv.y = cvt_pk_bf16(hs[pt][2], hs[pt][3]);
                *(LAS u32x2*)(hT + (16 * pt + fr) * SP + 16 * wave + 4 * fq) = wv; }
        }
#undef SS_FETCH
        __syncthreads();
    }
}

__device__ __forceinline__ void ssd_post_phase(const bf16_t* __restrict__ yssd, const bf16_t* __restrict__ projb, const float* __restrict__ norm_w, bf16_t* __restrict__ ymixb, const int gw, const int NGW, const int lane) {
    const int c0 = 16 * lane;
    f32x4 nw[4];
#pragma unroll
    for (int j = 0; j < 4; ++j) nw[j] = *(const f32x4*)(norm_w + c0 + 4 * j);
#pragma unroll 2
    for (int m = gw; m < M; m += NGW) {
        f32x4 y[4];
        ld_bf16x16(yssd + (size_t)m * 1024 + c0, y);
        const u32x4 z0 = *(const u32x4*)(projb + (size_t)m * PROJ_BLD + OFF_Z + c0), z1 = *(const u32x4*)(projb + (size_t)m * PROJ_BLD + OFF_Z + c0 + 8);
        const unsigned zw[8] = {z0.x, z0.y, z0.z, z0.w, z1.x, z1.y, z1.z, z1.w};
        float uu[16]; float ss = 0.f;
#pragma unroll
        for (int e = 0; e < 8; ++e) { uu[2 * e] = y[e >> 1][(2 * e) & 3] * fast_silu(bf_lo(zw[e])); uu[2 * e + 1] = y[e >> 1][(2 * e + 1) & 3] * fast_silu(bf_hi(zw[e])); ss += uu[2 * e] * uu[2 * e] + uu[2 * e + 1] * uu[2 * e + 1]; }
#pragma unroll
        for (int o = 1; o < 32; o <<= 1) ss += __shfl_xor(ss, o);
        const float rs = rsqrtf(ss * (1.f / 512.f) + 1e-5f);
        u32x4 w0, w1;
        w0.x = cvt_pk_bf16(uu[0] * rs * nw[0][0], uu[1] * rs * nw[0][1]); w0.y = cvt_pk_bf16(uu[2] * rs * nw[0][2], uu[3] * rs * nw[0][3]);
        w0.z = cvt_pk_bf16(uu[4] * rs * nw[1][0], uu[5] * rs * nw[1][1]); w0.w = cvt_pk_bf16(uu[6] * rs * nw[1][2], uu[7] * rs * nw[1][3]);
        w1.x = cvt_pk_bf16(uu[8] * rs * nw[2][0], uu[9] * rs * nw[2][1]); w1.y = cvt_pk_bf16(uu[10] * rs * nw[2][2], uu[11] * rs * nw[2][3]);
        w1.z = cvt_pk_bf16(uu[12] * rs * nw[3][0], uu[13] * rs * nw[3][1]); w1.w = cvt_pk_bf16(uu[14] * rs * nw[3][2], uu[15] * rs * nw[3][3]);
        *(u32x4*)(ymixb + (size_t)m * 2048 + c0) = w0; *(u32x4*)(ymixb + (size_t)m * 2048 + c0 + 8) = w1;
    }
}

#define PH_BEGIN int z_ = 0; asm volatile("" : "+s"(z_)); unsigned char* const wsq = P.ws + z_; int tid = tid0; asm volatile("" : "+v"(tid)); \
    const int G = G0 + z_, bx = bx0 + z_, vcu = vcu0 + z_, lane = tid & 63, wave = __builtin_amdgcn_readfirstlane(tid >> 6), gw = vcu * NWAVES + wave, NGW = G * NWAVES; (void)bx; (void)lane; (void)gw; (void)NGW; (void)wave;
#define CVT_MIXER_WEIGHTS(L_, gw, NGW, tix, tnum) do { const int L = (L_); \
            cvt_job<0>(INP(1) + (size_t)L * D * IN_DIM, D, IN_DIM, Win_t, 0, 0, scr, gw, NGW, lane); \
            if (L > 0) cvt_job<0>(INP(2) + (size_t)(L - 1) * D * 32, D, 32, Win_t, IN_DIM, 0, scr, gw, NGW, lane); \
            { const int r0 = L > 0 ? IN_DIM + 32 : IN_DIM, nz = (PROJ_BLD - r0) * (D / 8);       \
              const unsigned oz = __float_as_uint(opaque0()); for (int i = (tix); i < nz; i += (tnum)) *(u32x4*)(Win_t + (size_t)r0 * D + (size_t)i * 8) = (u32x4){oz, oz, oz, oz}; } \
            cvt_job<0>(INP(23) + (size_t)L * D * D, D, D, Wout_t, 0, 0, scr, gw, NGW, lane); \
            cvt_job<0>(INP(12) + (size_t)L * 64 * 1024, 64, 1024, Wl_w, 0, 0, scr, gw, NGW, lane); \
            cvt_job<0>(INP(14) + (size_t)L * 64 * 1024, 64, 1024, Wl_a, 0, 0, scr, gw, NGW, lane); \
            cvt_job<0>(INP(17) + (size_t)L * 160 * 1024, 160, 1024, Wl_g, 0, 0, scr, gw, NGW, lane); \
            if (L > 0) cvt_job<0>(INP(16) + (size_t)(L - 1) * 32 * 1024, 32, 1024, Wl_v, 0, 0, scr, gw, NGW, lane); } while (0)
#define INP(i) (P.in[(i) + z_])
#define RW_ARGS(a) RwScan a; a.proj_ = projb; a.lw_ = lw; a.mix = INP(9) + (size_t)l * RW_SHIFT; a.w0 = INP(11) + l * 1024; a.a0 = INP(13) + l * 1024; a.v0 = INP(15) + (l > 0 ? l - 1 : 0) * 1024; \
            a.k_k = INP(18) + l * 1024; a.k_a = INP(19) + l * 1024; a.r_k = INP(20) + l * 1024; a.vf_ = vfirst; a.y_ = (bf16_t*)yrw; a.bon_ = (bf16_t*)bon; a.layer = l; a.pad = 0; \
            a.cw1 = moe ? INP(32) + (size_t)li * NE * D * DFE : INP(28) + (size_t)li * D * DFF; a.cw3 = moe ? INP(33) + (size_t)li * NE * D * DFE : INP(29) + (size_t)li * D * DFF; a.cw2 = moe ? INP(34) + (size_t)li * NE * DFE * D : INP(30) + (size_t)li * DFF * D; a.cwt = Wffn; a.cmoe = moe ? 1 : 0; a.pad2 = 0;

#define Win_t ((bf16_t*)(wsq + WS_WIN))
#define Wout_t ((bf16_t*)(wsq + WS_WOUT))
#define Wffn ((bf16_t*)(wsq + WS_WFFN))
#define Wl_w ((bf16_t*)(wsq + WS_WLORA))
#define Wl_a (Wl_w + 1024 * 64)
#define Wl_g (Wl_a + 1024 * 64)
#define Wl_v (Wl_g + 1024 * 160)
#define xf ((float*)(wsq + WS_XF))
#define xb ((bf16_t*)(wsq + WS_XB))
#define projb ((bf16_t*)(wsq + WS_PROJB))
#define ymixb ((bf16_t*)(wsq + WS_YMIXB))
#define mixed ((float*)(wsq + WS_MIXED))
#define hbuf ((bf16_t*)(wsq + WS_HBUF))
#define xg ((bf16_t*)(wsq + WS_XG))
#define yslot ((float*)(wsq + WS_YSLOT))
#define xbcc ((bf16_t*)(wsq + WS_XBCC))
#define dtb ((float*)(wsq + WS_DTB))
#define yssd ((float*)(wsq + WS_YSSD))
#define lw ((bf16_t*)(wsq + WS_LW))
#define yrw ((float*)(wsq + WS_YRW))
#define bon ((float*)(wsq + WS_BON))
#define vfirst ((float*)(wsq + WS_VFIRST))
#define tok_e ((int*)(wsq + WS_TOK))
#define tok_pos (tok_e + 2 * M)
#define tok_g ((float*)(tok_pos + 2 * M))
#define tok_dest ((int*)(tok_g + 2 * M))
#define src_row (tok_dest + 2 * M)
#define inv_row (src_row + PMAX)
#define cnt ((int*)(wsq + WS_CTL) + CW_CNT + 8 * li)
__global__ void __launch_bounds__(NWAVES * 64, 2) fwd(Params P) {
    extern __shared__ __attribute__((aligned(16))) unsigned char lds_raw[];
    LAS unsigned char* lds = (LAS unsigned char*)lds_raw;
    volatile LAS unsigned* MISC = (volatile LAS unsigned*)(lds + MISC_OFF);
    const int tid0 = threadIdx.x;
    const int G0 = gridDim.x, bx0 = blockIdx.x;
    const int vcu0 = (G0 % 8 == 0) ? (bx0 % 8) * (G0 / 8) + bx0 / 8 : bx0;
    unsigned* ctl = (unsigned*)(P.ws + WS_CTL);
    if (tid0 < 64) MISC[tid0] = 0u;
    __syncthreads();
#if MK_LAUNCH_MODE == 1
    constexpr int lo = 0, hi = 64;
#else
    const int lo = P.ph_lo, hi = P.ph_hi;
#endif
    XcdBarrier bar; bar.bar = ctl + CW_BAR + P.bar_idx * XCD_BAR_WORDS; bar.x = 0; bar.st = MISC + 8;
    if (hi - lo > 1) bar = xcd_barrier_post(ctl + CW_BAR + P.bar_idx * XCD_BAR_WORDS, MISC + 8);
#define IN(k) (lo <= (k) && (k) < hi)
#ifndef MK_TS_MASK
#define MK_TS_MASK 0
#endif
#ifndef MK_TS_MULT
#define MK_TS_MULT 8
#endif
    unsigned long long ts_acc = 0ull, ts_t0 = 0ull; (void)ts_acc; (void)ts_t0;
#ifndef MK_TS_LAYERS
#define MK_TS_LAYERS 0xF
#endif
#define TS_ON(k) (MK_TS_MASK != 0 && ((MK_TS_MASK >> (k)) & 1) && ((MK_TS_LAYERS >> l) & 1))
#define TS_BEGIN(k) do { if (TS_ON(k)) ts_t0 = __builtin_amdgcn_s_memrealtime(); } while (0)
#define TS_END(k) do { if (TS_ON(k)) { __syncthreads(); ts_acc += __builtin_amdgcn_s_memrealtime() - ts_t0; } } while (0)
#define SEAM(k) do { if (((k) & 15) == 3 && TS_ON(21)) { TS_END(21); } if ((k) + 1 < hi) { TS_END((k) & 15); TS_BEGIN(20); xcd_barrier(bar); if ((MK_DBL >> 19) & 1) xcd_barrier(bar); TS_END(20); } else { TS_END((k) & 15); } } while (0)

    for (int l = 0; l < 4; ++l) {
        const int pb = l * 16, li = l >> 1; const bool moe = (l & 1) != 0;
        if (IN(pb + 0) && l == 0) {
            PH_BEGIN
            TS_BEGIN(0);
            for (int rep_ = 0; rep_ < 1 + ((MK_DBL >> 0) & 1); ++rep_) {
            LAS float* scr = (LAS float*)(lds + wave * 16384);
            CVT_MIXER_WEIGHTS(0, gw, NGW, bx * 512 + tid, G * 512);
            if (l == 0) {
                const float* x = INP(0);
                const size_t stride = (size_t)G * 512, total = (size_t)M * D / 8;
                size_t i = (size_t)bx * 512 + tid;
                for (; i + 3 * stride < total; i += 4 * stride) {
                    f32x4 a[4], b[4];
#pragma unroll
                    for (int q = 0; q < 4; ++q) { a[q] = *(const f32x4*)(x + (i + q * stride) * 8); b[q] = *(const f32x4*)(x + (i + q * stride) * 8 + 4); }
#pragma unroll
                    for (int q = 0; q < 4; ++q) { u32x4 w; w.x = cvt_pk_bf16(a[q][0], a[q][1]); w.y = cvt_pk_bf16(a[q][2], a[q][3]); w.z = cvt_pk_bf16(b[q][0], b[q][1]); w.w = cvt_pk_bf16(b[q][2], b[q][3]);
                        *(u32x4*)(xb + (i + q * stride) * 8) = w; }
                }
                for (; i < total; i += stride) {
                    const f32x4 a = *(const f32x4*)(x + i * 8), b = *(const f32x4*)(x + i * 8 + 4);
                    u32x4 w; w.x = cvt_pk_bf16(a[0], a[1]); w.y = cvt_pk_bf16(a[2], a[3]); w.z = cvt_pk_bf16(b[0], b[1]); w.w = cvt_pk_bf16(b[2], b[3]);
                    *(u32x4*)(xb + i * 8) = w; }
            }
            }
            __syncthreads();
            SEAM(pb + 0);
        }
        if (IN(pb + 1)) {
            PH_BEGIN
            TS_BEGIN(1);
            pg8::Gemm g{xb, Win_t, D}; pg8::StaticOrder S; S.init(M, PROJ_BLD, G, bx);
            pg8::EpiBf16 E{projb, PROJ_BLD};
            pg8::gemm_phase<pg8::EpiBf16, pg8::StaticOrder>(lds, g, S, E, tid);
#if (MK_DBL >> 1) & 1
            pg8::gemm_phase<pg8::EpiBf16, pg8::StaticOrder>(lds, g, S, E, tid);
#endif
            SEAM(pb + 1);
        }
        if (IN(pb + 2)) {
            PH_BEGIN
            TS_BEGIN(2);
            lora_phase(lds, projb, INP(9) + (size_t)l * RW_SHIFT, INP(10) + (size_t)(l > 0 ? l - 1 : 0) * 32, Wl_w, Wl_a, Wl_g, Wl_v, lw, l > 0, vcu, G, tid);
#if (MK_DBL >> 2) & 1
            lora_phase(lds, projb, INP(9) + (size_t)l * RW_SHIFT, INP(10) + (size_t)(l > 0 ? l - 1 : 0) * 32, Wl_w, Wl_a, Wl_g, Wl_v, lw, l > 0, vcu, G, tid);
#endif
            ssd_conv_phase(projb, INP(3) + (size_t)l * 4 * CONV_DIM, INP(4) + (size_t)l * CONV_DIM, INP(5) + l * SSD_H, xbcc, dtb, vcu, G, tid);
#if (MK_DBL >> 11) & 1
            ssd_conv_phase(projb, INP(3) + (size_t)l * 4 * CONV_DIM, INP(4) + (size_t)l * CONV_DIM, INP(5) + l * SSD_H, xbcc, dtb, vcu, G, tid);
#endif
#if MK_RWKV_CHUNKED == 2
            __syncthreads();
            {
                RW_ARGS(a);
                int tid3 = tid; asm volatile("" : "+v"(tid3));
                rwkv_pre_phase(lds, a, wsq + WS_IMG, vcu, G, tid3, true, true);
#if (MK_DBL >> 12) & 1
                __syncthreads();
                rwkv_pre_phase(lds, a, wsq + WS_IMG, vcu, G, tid3, false, true);
#endif
#if (MK_DBL >> 13) & 1
                __syncthreads();
                rwkv_pre_phase(lds, a, wsq + WS_IMG, vcu, G, tid3, true, false);
#endif
            }
#endif
            SEAM(pb + 2);
        }
        if (IN(pb + 3)) {
            PH_BEGIN
            TS_BEGIN(3);
#if MK_RWKV_CHUNKED == 2
            RW_ARGS(a);
            const bool ssd_first = ((vcu >> 1) & 1) != 0;
            if (ssd_first) { int tid4 = tid; asm volatile("" : "+v"(tid4)); ssd_scan_phase(lds, xbcc, dtb, INP(6) + l * SSD_H, INP(7) + l * SSD_H, (bf16_t*)yssd, vcu, G, tid4); }
            rwkv_state_phase(lds, wsq + WS_IMG, (bf16_t*)yrw, a, vcu, G, tid);
#if (MK_DBL >> 3) & 1
            rwkv_state_phase(lds, wsq + WS_IMG, (bf16_t*)yrw, a, vcu, G, tid);
#endif
#elif MK_RWKV_CHUNKED
            RW_ARGS(a);
            rwkv_chunk_phase(lds, a, vcu, G, tid);
#else
            RW_ARGS(a);
            rwkv_scan_phase(lds, a, vcu, G, tid);
#endif
            if (TS_ON(21)) { TS_END(3); TS_BEGIN(21); }
#if ((MK_DBL >> 3) & 1) && MK_RWKV_CHUNKED == 0
            rwkv_scan_phase(lds, a, vcu, G, tid);
#endif
            int tid2 = tid; asm volatile("" : "+v"(tid2));
#if MK_RWKV_CHUNKED == 2
            if (!ssd_first)
#endif
            ssd_scan_phase(lds, xbcc, dtb, INP(6) + l * SSD_H, INP(7) + l * SSD_H, (bf16_t*)yssd, vcu, G, tid2);
#if (MK_DBL >> 10) & 1
            ssd_scan_phase(lds, xbcc, dtb, INP(6) + l * SSD_H, INP(7) + l * SSD_H, (bf16_t*)yssd, vcu, G, tid);
#endif
            SEAM(pb + 3);
        }
        if (IN(pb + 4)) {
            PH_BEGIN
            TS_BEGIN(4);
            rwkv_post_phase((const bf16_t*)yrw, (const bf16_t*)bon, lw + (size_t)2 * M * 1024, INP(21) + l * 1024, INP(22) + l * 1024, ymixb, gw, NGW, lane);
#if (MK_DBL >> 4) & 1
            rwkv_post_phase((const bf16_t*)yrw, (const bf16_t*)bon, lw + (size_t)2 * M * 1024, INP(21) + l * 1024, INP(22) + l * 1024, ymixb, gw, NGW, lane);
#endif
            ssd_post_phase((const bf16_t*)yssd, projb, INP(8) + l * 1024, ymixb, gw, NGW, lane);
#if (MK_DBL >> 4) & 1
            ssd_post_phase((const bf16_t*)yssd, projb, INP(8) + l * 1024, ymixb, gw, NGW, lane);
#endif
            SEAM(pb + 4);
        }
        if (IN(pb + 5)) {
            PH_BEGIN
            TS_BEGIN(5);
            pg8::Gemm g{ymixb, Wout_t, D}; pg8::StaticOrder S; S.init(M, D, G, bx);
            pg8::EpiBf16 E{(bf16_t*)mixed, FLD};
#if (MK_DBL >> 14) & 1
            { pg8::RepeatOrder R; R.init2(M, D, G, bx, 2); pg8::gemm_phase<pg8::EpiBf16, pg8::RepeatOrder>(lds, g, R, E, tid); }
#else
            pg8::gemm_phase<pg8::EpiBf16, pg8::StaticOrder>(lds, g, S, E, tid);
#endif
#if (MK_DBL >> 5) & 1
            pg8::gemm_phase<pg8::EpiBf16, pg8::StaticOrder>(lds, g, S, E, tid);
#endif
            SEAM(pb + 5);
        }
        if (IN(pb + 6)) {
            PH_BEGIN
            TS_BEGIN(6);
            const float* xin = INP(0);
            f32x4 g8[8], b8[8];
#pragma unroll
            for (int j = 0; j < 8; ++j) { g8[j] = *(const f32x4*)(INP(24) + l * D + 4 * lane + 256 * j); b8[j] = *(const f32x4*)(INP(25) + l * D + 4 * lane + 256 * j); }
            LAS float* rs = (LAS float*)lds;
            LAS int* wgcnt = (LAS int*)(lds + 65536); LAS int* wgbase = wgcnt + 8; LAS int* rec = wgcnt + 16;
            if (moe) { const float* router = INP(31) + (size_t)li * D * NE;
                for (int i = tid; i < D * NE; i += 512) rs[(i & 7) * D + (i >> 3)] = router[i];
                if (tid < 16) wgcnt[tid] = 0;
                __syncthreads(); }
            int nrec = 0;
            for (int m0 = gw; m0 < M; m0 += 2 * NGW) {
                const int m1 = m0 + NGW; const bool has1 = m1 < M; const int m1c = has1 ? m1 : m0;
                f32x4 va[8], vb[8];
#pragma unroll
                for (int j = 0; j < 8; ++j) { const int c = 4 * lane + 256 * j;
                    const u32x2 ma = *(const u32x2*)((const bf16_t*)mixed + (size_t)m0 * FLD + c), mb = *(const u32x2*)((const bf16_t*)mixed + (size_t)m1c * FLD + c);
                    const f32x4 xa = (l == 0) ? *(const f32x4*)(xin + (size_t)m0 * D + c) : ld_bf4(xb + (size_t)m0 * D + c), xbv = (l == 0) ? *(const f32x4*)(xin + (size_t)m1c * D + c) : ld_bf4(xb + (size_t)m1c * D + c);
                    va[j] = ALPHA * xa + (f32x4){bf_lo(ma.x), bf_hi(ma.x), bf_lo(ma.y), bf_hi(ma.y)};
                    vb[j] = ALPHA * xbv + (f32x4){bf_lo(mb.x), bf_hi(mb.x), bf_lo(mb.y), bf_hi(mb.y)}; }
                ln_finish(va, g8, b8, lane, (float*)nullptr, xb + (size_t)m0 * D);
                if (has1) ln_finish(vb, g8, b8, lane, (float*)nullptr, xb + (size_t)m1 * D);
                if (moe) {
#pragma unroll
                    for (int r = 0; r < 2; ++r) {
                        if (r == 1 && !has1) break;
                        const int m = r ? m1 : m0;
                        float sl[8];
#pragma unroll
                        for (int e = 0; e < 8; ++e) { float s = 0.f;
#pragma unroll
                            for (int j = 0; j < 8; ++j) { const f32x4 rr = *(const LAS f32x4*)(rs + e * D + 4 * lane + 256 * j); const f32x4 vv = r ? vb[j] : va[j]; s += (vv[0] * rr[0] + vv[1] * rr[1]) + (vv[2] * rr[2] + vv[3] * rr[3]); }
                            sl[e] = s; }
                        const float z0 = reduce4(sl[0], sl[1], sl[2], sl[3]), z1 = reduce4(sl[4], sl[5], sl[6], sl[7]);
                        const float lg[8] = {rdlane(z0, 0), rdlane(z0, 16), rdlane(z0, 32), rdlane(z0, 48), rdlane(z1, 0), rdlane(z1, 16), rdlane(z1, 32), rdlane(z1, 48)};
                        if (lane == 0) {
                            int i0 = 0; float v0 = lg[0];
#pragma unroll
                            for (int e = 1; e < 8; ++e) if (lg[e] > v0) { v0 = lg[e]; i0 = e; }
                            int i1 = -1; float v1 = -3.4e38f;
#pragma unroll
                            for (int e = 0; e < 8; ++e) if (e != i0 && lg[e] > v1) { v1 = lg[e]; i1 = e; }
                            const float e1 = expf(v1 - v0);
                            tok_e[2 * m] = i0; tok_e[2 * m + 1] = i1; tok_g[2 * m] = 1.f / (1.f + e1); tok_g[2 * m + 1] = e1 / (1.f + e1);
                            const int lp0 = __hip_atomic_fetch_add(&wgcnt[i0], 1, __ATOMIC_RELAXED, __HIP_MEMORY_SCOPE_WORKGROUP), lp1 = __hip_atomic_fetch_add(&wgcnt[i1], 1, __ATOMIC_RELAXED, __HIP_MEMORY_SCOPE_WORKGROUP);
                            LAS int* rc = rec + ((nrec + r) * NWAVES + wave) * 5;
                            rc[0] = m; rc[1] = i0; rc[2] = i1; rc[3] = lp0; rc[4] = lp1;
                        }
                    }
                    nrec += has1 ? 2 : 1;
                }
            }
            if (moe) {
                __syncthreads();
                if (tid < 8) wgbase[tid] = atomicAdd(&cnt[tid], wgcnt[tid]);
                __syncthreads();
                for (int i = tid; i < nrec * NWAVES; i += 512) { const LAS int* rc = rec + i * 5; const int m = rc[0];
                    const int p0_ = wgbase[rc[1]] + rc[3], p1_ = wgbase[rc[2]] + rc[4];
                    tok_pos[2 * m] = p0_; tok_pos[2 * m + 1] = p1_;
                    inv_row[rc[1] * pg8::INVCAP + p0_] = m; inv_row[rc[2] * pg8::INVCAP + p1_] = m; }
            }
            __syncthreads();
            SEAM(pb + 6);
        }
        if (IN(pb + 8)) {
            PH_BEGIN
            TS_BEGIN(8);
            if (!moe) {
                pg8::Gemm g{xb, Wffn, D}; pg8::StaticOrder S; S.init(M, 2 * DFF, G, bx);
                pg8::EpiSwiglu E{hbuf, DFF};
                pg8::gemm_phase<pg8::EpiSwiglu, pg8::StaticOrder>(lds, g, S, E, tid);
#if (MK_DBL >> 15) & 1
                pg8::gemm_phase<pg8::EpiSwiglu, pg8::StaticOrder>(lds, g, S, E, tid);
#endif
            } else {
                pg8::Gemm g{xb, Wffn, D, inv_row, M}; pg8::GroupedOrder S; S.init(cnt, 2 * DFE, G, bx);
                pg8::EpiSwiglu E{hbuf, DFE};
                pg8::gemm_phase<pg8::EpiSwiglu, pg8::GroupedOrder, true>(lds, g, S, E, tid);
#if (MK_DBL >> 16) & 1
                pg8::gemm_phase<pg8::EpiSwiglu, pg8::GroupedOrder>(lds, g, S, E, tid);
#endif
            }
            SEAM(pb + 8);
        }
        if (IN(pb + 9)) {
            PH_BEGIN
            TS_BEGIN(9);
            if (!moe) {
                pg8::Gemm g{hbuf, Wffn + (size_t)2 * DFF * D, DFF}; pg8::StaticOrder S; S.init(M, D, G, bx);
                pg8::EpiBf16 E{(bf16_t*)yslot, FLD};
                pg8::gemm_phase<pg8::EpiBf16, pg8::StaticOrder>(lds, g, S, E, tid);
            } else {
                pg8::Gemm g{hbuf, Wffn + (size_t)NE * 2 * DFE * D, DFE}; pg8::GroupedOrder S; S.init(cnt, D, G, bx);
                pg8::EpiBf16 E{(bf16_t*)yslot, FLD};
                pg8::gemm_phase<pg8::EpiBf16, pg8::GroupedOrder>(lds, g, S, E, tid);
            }
            if (l < 3) {
                int tail = 0;
                if (moe) { int np = 0;
#pragma unroll
                    for (int e = 0; e < 8; ++e) np += (cnt[e] + 255) >> 8;
                    tail = (np * (D / 256)) % G; }
                if (bx >= tail) {
                    LAS float* scr = (LAS float*)(lds + wave * 16384);
                    const int fwg = bx - tail, nf = G - tail;
                    CVT_MIXER_WEIGHTS(l + 1, fwg * NWAVES + wave, nf * NWAVES, fwg * 512 + tid, nf * 512);
                }
            }
            SEAM(pb + 9);
        }
        if (IN(pb + 10)) {
            PH_BEGIN
            TS_BEGIN(10);
            f32x4 g8[8], b8[8];
#pragma unroll
            for (int j = 0; j < 8; ++j) { g8[j] = *(const f32x4*)(INP(26) + l * D + 4 * lane + 256 * j); b8[j] = *(const f32x4*)(INP(27) + l * D + 4 * lane + 256 * j); }
            float* dst = (l == 3) ? P.out : (float*)nullptr; const bf16_t* ysb = (const bf16_t*)yslot;
            int pstart[8]; { int acc_ = 0;
#pragma unroll
                for (int e = 0; e < 8; ++e) { pstart[e] = acc_; acc_ += moe ? (((cnt[e] + 255) >> 8) << 8) : 0; } }
            for (int m0 = gw; m0 < M; m0 += 2 * NGW) {
                const int m1 = m0 + NGW; const bool has1 = m1 < M; const int m1c = has1 ? m1 : m0;
                f32x4 va[8], vb[8];
                if (!moe) {
#pragma unroll
                    for (int j = 0; j < 8; ++j) { const int c = 4 * lane + 256 * j;
                        va[j] = ALPHA * ld_bf4(xb + (size_t)m0 * D + c) + ld_bf4(ysb + (size_t)m0 * FLD + c);
                        vb[j] = ALPHA * ld_bf4(xb + (size_t)m1c * D + c) + ld_bf4(ysb + (size_t)m1c * FLD + c); }
                } else {
#define MK_DEST(i_, o_) do { const int e_ = tok_e[(i_)]; int st_ = 0; _Pragma("unroll") for (int q = 0; q < 8; ++q) st_ = (e_ == q) ? pstart[q] : st_; o_ = st_ + tok_pos[(i_)]; } while (0)
                    int a0, a1, c0, c1; MK_DEST(2 * m0, a0); MK_DEST(2 * m0 + 1, a1); MK_DEST(2 * m1c, c0); MK_DEST(2 * m1c + 1, c1);
#undef MK_DEST
                    const float ga0 = tok_g[2 * m0], ga1 = tok_g[2 * m0 + 1], gc0 = tok_g[2 * m1c], gc1 = tok_g[2 * m1c + 1];
#pragma unroll
                    for (int j = 0; j < 8; ++j) { const int c = 4 * lane + 256 * j;
                        va[j] = ALPHA * ld_bf4(xb + (size_t)m0 * D + c) + ga0 * ld_bf4(ysb + (size_t)a0 * FLD + c) + ga1 * ld_bf4(ysb + (size_t)a1 * FLD + c);
                        vb[j] = ALPHA * ld_bf4(xb + (size_t)m1c * D + c) + gc0 * ld_bf4(ysb + (size_t)c0 * FLD + c) + gc1 * ld_bf4(ysb + (size_t)c1 * FLD + c); }
                }
                ln_finish(va, g8, b8, lane, dst ? dst + (size_t)m0 * D : (float*)nullptr, (l == 3) ? (bf16_t*)nullptr : xb + (size_t)m0 * D);
                if (has1) ln_finish(vb, g8, b8, lane, dst ? dst + (size_t)m1 * D : (float*)nullptr, (l == 3) ? (bf16_t*)nullptr : xb + (size_t)m1 * D);
            }
            SEAM(pb + 10);
        }
    }
    if (MK_TS_MASK != 0 && bx0 == 0 && tid0 < 64) {
        const unsigned long long t_end = __builtin_amdgcn_s_memrealtime() + (unsigned long long)MK_TS_MULT * ts_acc;
        while (__builtin_amdgcn_s_memrealtime() < t_end) __builtin_amdgcn_s_sleep(32);
    }
#undef IN
#undef SEAM
}
#undef PH_BEGIN
#undef CVT_MIXER_WEIGHTS
#undef INP
#undef Win_t
#undef Wout_t
#undef Wffn
#undef Wl_w
#undef Wl_a
#undef Wl_g
#undef Wl_v
#undef xf
#undef xb
#undef projb
#undef ymixb
#undef mixed
#undef hbuf
#undef xg
#undef yslot
#undef xbcc
#undef dtb
#undef yssd
#undef lw
#undef yrw
#undef bon
#undef vfirst
#undef tok_e
#undef tok_pos
#undef tok_g
#undef tok_dest
#undef src_row
#undef inv_row
#undef cnt


}

extern "C" void kernel_launch(void* const* d_in, const int* in_sizes, int n_in, void* d_out, int out_size, void* d_ws, size_t ws_size, hipStream_t stream) {
    (void)in_sizes; (void)out_size;
    static int grid = 0;
    if (grid == 0) {
        if (n_in != 35 || ws_size < WS_END) { fprintf(stderr, "kernel_launch: need 35 inputs and %zu bytes of workspace (got %d, %zu)\n", (size_t)WS_END, n_in, ws_size); grid = -1; return; }
        int dev = 0, cus = 0;
        if (hipGetDevice(&dev) != hipSuccess || hipDeviceGetAttribute(&cus, hipDeviceAttributeMultiprocessorCount, dev) != hipSuccess) { grid = -1; return; }
        if (hipFuncSetAttribute((const void*)fwd, hipFuncAttributeMaxDynamicSharedMemorySize, LDS_BYTES) != hipSuccess) { fprintf(stderr, "kernel_launch: hipFuncSetAttribute failed\n"); grid = -1; return; }
        int per_cu = 0;
        if (hipOccupancyMaxActiveBlocksPerMultiprocessor(&per_cu, (const void*)fwd, NWAVES * 64, LDS_BYTES) != hipSuccess || per_cu < 1) { fprintf(stderr, "kernel_launch: occupancy query says %d blocks per CU\n", per_cu); }
        (void)hipGetLastError();
        grid = cus;
    }
    if (grid < 0) return;
    unsigned char* ws = (unsigned char*)d_ws;
    (void)hipMemsetAsync(ws + WS_CTL, 0, CTL_BYTES, stream);
    Params P{};
    for (int i = 0; i < 35; ++i) P.in[i] = (const float*)d_in[i];
    P.out = (float*)d_out; P.ws = ws; P.pad = 0;
    int nbar = 0;
    auto run = [&](int lo, int hi) {
        P.ph_lo = lo; P.ph_hi = hi; P.bar_idx = (hi - lo > 1) ? nbar++ : 0;
        hipLaunchKernelGGL(fwd, dim3(grid), dim3(NWAVES * 64), LDS_BYTES, stream, P);
    };
    if (MK_LAUNCH_MODE == 1) run(0, 64);
    else if (MK_LAUNCH_MODE == 4) { for (int l = 0; l < 4; ++l) run(l * 16, l * 16 + 16); }
    else { for (int l = 0; l < 4; ++l) for (int k = 0; k <= 10; ++k) run(l * 16 + k, l * 16 + k + 1); }
}
```
